# Optimizing an MI355X kernel written in HIP

```python
import math
import jax, jax.numpy as jnp
from jax import lax
import numpy as np

D_MODEL = 2048
BATCH = 4
SEQ = 2048
DEPTH = 2

CHUNK = 64
F32 = jnp.float32
RMS_EPS = 1e-6

D_MIX = D_MODEL
GW = D_MIX // 4
HEAD_DIM = 128
NH = GW // HEAD_DIM
CONV_WIDTH = 4

GLA_GATE_RANK = 16
GLA_TAU = 16.0
LRU_BLOCKS = 8
LRU_BLOCK = GW // LRU_BLOCKS
LRU_C = 8.0
N_KEYS = 128
N_EXPERTS = N_KEYS * N_KEYS
PEER_HEADS = 8
PEER_TOPK = 16
PEER_QDIM = 256
PEER_HALF = PEER_QDIM // 2
PEER_TOKEN_BLOCK = 128

SPLIT_SIZES = (GW, GW, GW, GW, GLA_GATE_RANK,
               GW, GW,
               GW, GW, GW, GW, NH, NH,
               3 * GW, GW, NH, NH)
D_IN = 4 * GW + GLA_GATE_RANK + 2 * GW + 4 * GW + 2 * NH + 3 * GW + GW + 2 * NH

kernel_name = 'hybrid_parallel_group_peer_encoder'


def rms_norm(x, g, eps=RMS_EPS):
    xf = x.astype(F32)
    y = xf * lax.rsqrt(jnp.mean(xf * xf, axis=-1, keepdims=True) + eps)
    return (y * g.astype(F32)).astype(x.dtype)


def head_rms_norm(o, g):
    return rms_norm(o, g.reshape(o.shape[-2], o.shape[-1]))


def l2_normalize(x, eps=1e-6):
    return x * lax.rsqrt(jnp.sum(x * x, axis=-1, keepdims=True) + eps)


def causal_depthwise_conv(x, w):
    k = w.shape[0]
    return lax.conv_general_dilated(x, w.astype(x.dtype)[:, None, :], window_strides=(1,),
                                    padding=[(k - 1, 0)], dimension_numbers=('NWC', 'WIO', 'NWC'),
                                    feature_group_count=x.shape[-1])


def split_heads(a):
    b, t, _ = a.shape
    return a.reshape(b, t, NH, HEAD_DIM)


def to_chunks(x):
    b, t, h, d = x.shape
    return x.reshape(b, t // CHUNK, CHUNK, h, d).transpose(0, 3, 1, 2, 4)


def from_chunks(x):
    b, h, n, c, d = x.shape
    return x.transpose(0, 2, 3, 1, 4).reshape(b, n * c, h, d)


def gate_chunks(g):
    b, t, h = g.shape
    return g.transpose(0, 2, 1).reshape(b, h, t // CHUNK, CHUNK)


def causal_mask(strict=False):
    return jnp.tril(jnp.ones((CHUNK, CHUNK), bool), -1 if strict else 0)


def split_columns(p):
    offs, acc = [], 0
    for s in SPLIT_SIZES[:-1]:
        acc += s
        offs.append(acc)
    return jnp.split(p, offs, axis=-1)


def gla_mixer(q, k, v, g_out, lr, w2, b2, norm_g):
    log_a = jax.nn.log_sigmoid(lr @ w2.astype(F32) + b2.astype(F32)) / GLA_TAU
    qc = to_chunks(split_heads(q)) * HEAD_DIM ** -0.5
    kc = to_chunks(split_heads(k))
    vc = to_chunks(split_heads(v))
    bcum = jnp.cumsum(to_chunks(split_heads(log_a)), axis=3)
    q_dec = qc * jnp.exp(bcum)
    k_inv = kc * jnp.exp(-bcum)
    k_end = kc * jnp.exp(bcum[..., -1:, :] - bcum)
    scores = jnp.where(causal_mask(), jnp.einsum('bhncd,bhnsd->bhncs', q_dec, k_inv), 0.0)
    o_intra = jnp.einsum('bhncs,bhnsv->bhncv', scores, vc)
    inc = jnp.einsum('bhnsd,bhnsv->bhndv', k_end, vc)
    decay_end = jnp.exp(bcum[..., -1, :])[..., None]

    def step(s, inp):
        d, i = inp
        return d * s + i, s
    _, states = lax.scan(step, jnp.zeros_like(inc[:, :, 0]),
                         (jnp.moveaxis(decay_end, 2, 0), jnp.moveaxis(inc, 2, 0)))
    states = jnp.moveaxis(states, 0, 2)
    o = o_intra + jnp.einsum('bhncd,bhndv->bhncv', q_dec, states)
    o = head_rms_norm(from_chunks(o), norm_g) * jax.nn.silu(split_heads(g_out))
    return o.reshape(q.shape)


def rglru_mixer(xb, yb, conv_w, conv_b, wa, ba, wx, bx, lam):
    b, t, _ = xb.shape
    xc = causal_depthwise_conv(xb, conv_w) + conv_b.astype(F32)
    xblk = xc.reshape(b, t, LRU_BLOCKS, LRU_BLOCK)
    r = jax.nn.sigmoid(jnp.einsum('btni,nij->btnj', xblk, wa.astype(F32)).reshape(b, t, GW) + ba.astype(F32))
    i = jax.nn.sigmoid(jnp.einsum('btni,nij->btnj', xblk, wx.astype(F32)).reshape(b, t, GW) + bx.astype(F32))
    log_a = -LRU_C * r * jax.nn.softplus(-lam.astype(F32))
    a = jnp.exp(log_a)
    u = jnp.sqrt(-jnp.expm1(2.0 * log_a)) * (i * xc)

    def combine(left, right):
        a1, b1 = left
        a2, b2 = right
        return a1 * a2, a2 * b1 + b2
    _, h = lax.associative_scan(combine, (a, u), axis=1)
    return jax.nn.gelu(yb) * h


def mlstm_mixer(q, k, v, o_pre, i_pre, f_pre, ib, fb, norm_g):
    b, t, _ = q.shape
    qc = to_chunks(split_heads(q))
    kc = to_chunks(split_heads(k)) * HEAD_DIM ** -0.5
    vc = to_chunks(split_heads(v))
    ig = gate_chunks(i_pre + ib.astype(F32))
    bcum = jnp.cumsum(gate_chunks(jax.nn.log_sigmoid(f_pre + fb.astype(F32))), axis=-1)
    log_end = bcum[..., -1:] - bcum + ig
    m_loc = jnp.max(log_end, axis=-1)
    kw = kc * jnp.exp(log_end - m_loc[..., None])[..., None]
    inc_c = jnp.einsum('bhnsd,bhnsv->bhndv', kw, vc)
    inc_n = jnp.sum(kw, axis=3)
    b_last = bcum[..., -1]

    def step(carry, inp):
        c_st, n_st, m_st = carry
        ic, inn, ml, bl = inp
        m_new = jnp.maximum(bl + m_st, ml)
        a_old = jnp.exp(bl + m_st - m_new)
        a_inc = jnp.exp(ml - m_new)
        c_new = a_old[..., None, None] * c_st + a_inc[..., None, None] * ic
        n_new = a_old[..., None] * n_st + a_inc[..., None] * inn
        return (c_new, n_new, m_new), (c_st, n_st, m_st)
    init = (jnp.zeros((b, NH, HEAD_DIM, HEAD_DIM), F32), jnp.zeros((b, NH, HEAD_DIM), F32), jnp.zeros((b, NH), F32))
    xs = tuple(jnp.moveaxis(a_, 2, 0) for a_ in (inc_c, inc_n, m_loc, b_last))
    _, (c_prev, n_prev, m_prev) = lax.scan(step, init, xs)
    c_prev, n_prev, m_prev = (jnp.moveaxis(a_, 0, 2) for a_ in (c_prev, n_prev, m_prev))
    logw = jnp.where(causal_mask(), bcum[..., :, None] - bcum[..., None, :] + ig[..., None, :], -jnp.inf)
    m_inter = bcum + m_prev[..., None]
    m_t = jnp.maximum(jnp.max(logw, axis=-1), m_inter)
    sw = jnp.einsum('bhncd,bhnsd->bhncs', qc, kc) * jnp.exp(logw - m_t[..., None])
    s_inter = jnp.exp(m_inter - m_t)
    num = jnp.einsum('bhncs,bhnsv->bhncv', sw, vc) + s_inter[..., None] * jnp.einsum('bhncd,bhndv->bhncv', qc, c_prev)
    dot = jnp.sum(sw, axis=-1) + s_inter * jnp.einsum('bhncd,bhnd->bhnc', qc, n_prev)
    h = num / jnp.maximum(jnp.abs(dot), jnp.exp(-m_t))[..., None]
    h = from_chunks(h) * jax.nn.sigmoid(split_heads(o_pre))
    return head_rms_norm(h, norm_g).reshape(b, t, GW)


def gdn_mixer(qkv, gate, beta_pre, a_pre, conv_w, a_log, dt_bias, norm_g):
    b, t, _ = gate.shape
    qkv = jax.nn.silu(causal_depthwise_conv(qkv, conv_w))
    q, k, v = jnp.split(qkv, 3, axis=-1)
    qc = to_chunks(l2_normalize(split_heads(q))) * HEAD_DIM ** -0.5
    kc = to_chunks(l2_normalize(split_heads(k)))
    vc = to_chunks(split_heads(v))
    beta = gate_chunks(jax.nn.sigmoid(beta_pre))
    g = -jnp.exp(a_log.astype(F32)) * jax.nn.softplus(a_pre + dt_bias.astype(F32))
    gam = jnp.cumsum(gate_chunks(g), axis=-1)
    decay = jnp.exp(jnp.where(causal_mask(), gam[..., :, None] - gam[..., None, :], -jnp.inf))
    kk = jnp.einsum('bhncd,bhnsd->bhncs', kc, kc)
    m_low = jnp.where(causal_mask(strict=True), beta[..., :, None] * kk * decay, 0.0)
    a_mat = jnp.eye(CHUNK, dtype=F32) + m_low
    rhs = jnp.concatenate([vc * beta[..., None], kc * (beta * jnp.exp(gam))[..., None]], axis=-1)
    sol = lax.linalg.triangular_solve(a_mat, rhs, left_side=True, lower=True)
    u0, w = jnp.split(sol, 2, axis=-1)
    qk = jnp.einsum('bhncd,bhnsd->bhncs', qc, kc) * decay
    q_dec = qc * jnp.exp(gam)[..., None]
    k_end = kc * jnp.exp(gam[..., -1:] - gam)[..., None]
    decay_end = jnp.exp(gam[..., -1])

    def step(s, inp):
        u0_n, w_n, qd_n, qk_n, ke_n, de_n = inp
        u = u0_n - jnp.einsum('bhcd,bhdv->bhcv', w_n, s)
        o = jnp.einsum('bhcd,bhdv->bhcv', qd_n, s) + jnp.einsum('bhcs,bhsv->bhcv', qk_n, u)
        s_new = de_n[..., None, None] * s + jnp.einsum('bhsd,bhsv->bhdv', ke_n, u)
        return s_new, o
    xs = tuple(jnp.moveaxis(a_, 2, 0) for a_ in (u0, w, q_dec, qk, k_end, decay_end))
    _, o = lax.scan(step, jnp.zeros((b, NH, HEAD_DIM, HEAD_DIM), F32), xs)
    o = from_chunks(jnp.moveaxis(o, 0, 2))
    o = head_rms_norm(o, norm_g) * jax.nn.silu(split_heads(gate))
    return o.reshape(b, t, GW)


def peer_ffn(h, wq, k1, k2, u_tab, v_tab):
    b, t, d = h.shape
    x2 = h.reshape(b * t, d)
    q = (x2 @ wq).reshape(-1, PEER_HEADS, 2, PEER_HALF)
    s1 = jnp.einsum('nhd,hkd->nhk', q[:, :, 0], k1).astype(F32)
    s2 = jnp.einsum('nhd,hkd->nhk', q[:, :, 1], k2).astype(F32)
    v1, i1 = lax.top_k(s1, PEER_TOPK)
    v2, i2 = lax.top_k(s2, PEER_TOPK)
    n_tok = x2.shape[0]
    cand_s = (v1[..., :, None] + v2[..., None, :]).reshape(n_tok, PEER_HEADS, PEER_TOPK * PEER_TOPK)
    cand_i = (i1[..., :, None] * N_KEYS + i2[..., None, :]).reshape(n_tok, PEER_HEADS, PEER_TOPK * PEER_TOPK)
    top_s, pos = lax.top_k(cand_s, PEER_TOPK)
    idx = jnp.take_along_axis(cand_i, pos, axis=-1)
    gates = jax.nn.softmax(top_s, axis=-1).astype(x2.dtype)
    nb = n_tok // PEER_TOKEN_BLOCK

    def block(args):
        xb, ib, gb = args
        act = jnp.einsum('td,thkd->thk', xb, u_tab[ib])
        return jnp.einsum('thk,thkd->td', gb * jax.nn.gelu(act), v_tab[ib])
    y = lax.map(block, (x2.reshape(nb, PEER_TOKEN_BLOCK, d),
                        idx.reshape(nb, PEER_TOKEN_BLOCK, PEER_HEADS, PEER_TOPK),
                        gates.reshape(nb, PEER_TOKEN_BLOCK, PEER_HEADS, PEER_TOPK)))
    return y.reshape(b, t, d)


def setup_inputs(seed: int = 0) -> dict:
    key = jax.random.key(seed)
    ks = iter(jax.random.split(key, 40))
    nrm = lambda shape, std: std * jax.random.normal(next(ks), shape, F32)
    gain = lambda shape: 1.0 + 0.02 * jax.random.normal(next(ks), shape, F32)
    x = jax.random.normal(next(ks), (BATCH, SEQ, D_MODEL), F32)
    norm1_g = gain((DEPTH, D_MODEL))
    w_in = nrm((DEPTH, D_MODEL, D_IN), D_MODEL ** -0.5)
    w_out = nrm((DEPTH, D_MIX, D_MODEL), D_MIX ** -0.5)
    gla_w2 = nrm((DEPTH, GLA_GATE_RANK, GW), GLA_GATE_RANK ** -0.5)
    gla_b2 = nrm((DEPTH, GW), 0.1)
    gla_norm_g = gain((DEPTH, GW))
    lru_conv_w = nrm((DEPTH, CONV_WIDTH, GW), CONV_WIDTH ** -0.5)
    lru_conv_b = nrm((DEPTH, GW), 0.02)
    lru_wa = nrm((DEPTH, LRU_BLOCKS, LRU_BLOCK, LRU_BLOCK), LRU_BLOCK ** -0.5)
    lru_ba = nrm((DEPTH, GW), 0.02)
    lru_wx = nrm((DEPTH, LRU_BLOCKS, LRU_BLOCK, LRU_BLOCK), LRU_BLOCK ** -0.5)
    lru_bx = nrm((DEPTH, GW), 0.02)
    a_c = jax.random.uniform(next(ks), (DEPTH, GW), F32, minval=0.9, maxval=0.999)
    a_base = a_c ** (1.0 / LRU_C)
    lru_lambda = jnp.log(a_base) - jnp.log1p(-a_base)
    ml_ib = nrm((DEPTH, NH), 0.1)
    ml_fb = jnp.linspace(3.0, 6.0, NH, dtype=F32)[None, :] + nrm((DEPTH, NH), 0.02)
    ml_norm_g = gain((DEPTH, GW))
    gdn_conv_w = nrm((DEPTH, CONV_WIDTH, 3 * GW), CONV_WIDTH ** -0.5)
    gdn_a_log = jnp.log(jax.random.uniform(next(ks), (DEPTH, NH), F32, minval=1.0, maxval=16.0))
    dt = jnp.exp(jax.random.uniform(next(ks), (DEPTH, NH), F32, minval=math.log(1e-3), maxval=math.log(1e-1)))
    gdn_dt_bias = dt + jnp.log(-jnp.expm1(-dt))
    gdn_norm_g = gain((DEPTH, GW))
    norm2_g = gain((DEPTH, D_MODEL))
    peer_wq = nrm((DEPTH, D_MODEL, PEER_HEADS * PEER_QDIM), D_MODEL ** -0.5)
    peer_k1 = nrm((DEPTH, PEER_HEADS, N_KEYS, PEER_HALF), PEER_HALF ** -0.5)
    peer_k2 = nrm((DEPTH, PEER_HEADS, N_KEYS, PEER_HALF), PEER_HALF ** -0.5)
    peer_u = nrm((DEPTH, N_EXPERTS, D_MODEL), D_MODEL ** -0.5)
    peer_v = nrm((DEPTH, N_EXPERTS, D_MODEL), PEER_HEADS ** -0.5)
    final_norm_g = gain((D_MODEL,))
    return {'x': x, 'norm1_g': norm1_g, 'w_in': w_in, 'w_out': w_out,
            'gla_w2': gla_w2, 'gla_b2': gla_b2, 'gla_norm_g': gla_norm_g,
            'lru_conv_w': lru_conv_w, 'lru_conv_b': lru_conv_b, 'lru_wa': lru_wa, 'lru_ba': lru_ba,
            'lru_wx': lru_wx, 'lru_bx': lru_bx, 'lru_lambda': lru_lambda,
            'ml_ib': ml_ib, 'ml_fb': ml_fb, 'ml_norm_g': ml_norm_g,
            'gdn_conv_w': gdn_conv_w, 'gdn_a_log': gdn_a_log, 'gdn_dt_bias': gdn_dt_bias, 'gdn_norm_g': gdn_norm_g,
            'norm2_g': norm2_g, 'peer_wq': peer_wq, 'peer_k1': peer_k1, 'peer_k2': peer_k2,
            'peer_u': peer_u, 'peer_v': peer_v, 'final_norm_g': final_norm_g}


def reference(x, norm1_g, w_in, w_out, gla_w2, gla_b2, gla_norm_g,
              lru_conv_w, lru_conv_b, lru_wa, lru_ba, lru_wx, lru_bx, lru_lambda,
              ml_ib, ml_fb, ml_norm_g, gdn_conv_w, gdn_a_log, gdn_dt_bias, gdn_norm_g,
              norm2_g, peer_wq, peer_k1, peer_k2, peer_u, peer_v, final_norm_g):
    for l in range(DEPTH):
        h = rms_norm(x, norm1_g[l])
        proj = (h @ w_in[l]).astype(F32)
        (gla_q, gla_k, gla_v, gla_g, gla_lr, lru_x, lru_y,
         ml_q, ml_k, ml_v, ml_o, ml_i, ml_f,
         gdn_qkv, gdn_g, gdn_b, gdn_a) = split_columns(proj)
        y_a = gla_mixer(gla_q, gla_k, gla_v, gla_g, gla_lr, gla_w2[l], gla_b2[l], gla_norm_g[l])
        y_b = rglru_mixer(lru_x, lru_y, lru_conv_w[l], lru_conv_b[l], lru_wa[l], lru_ba[l],
                          lru_wx[l], lru_bx[l], lru_lambda[l])
        y_c = mlstm_mixer(ml_q, ml_k, ml_v, ml_o, ml_i, ml_f, ml_ib[l], ml_fb[l], ml_norm_g[l])
        y_d = gdn_mixer(gdn_qkv, gdn_g, gdn_b, gdn_a, gdn_conv_w[l], gdn_a_log[l], gdn_dt_bias[l], gdn_norm_g[l])
        mix = jnp.concatenate([y_a, y_b, y_c, y_d], axis=-1).astype(x.dtype)
        x = x + mix @ w_out[l]
        x = x + peer_ffn(rms_norm(x, norm2_g[l]), peer_wq[l], peer_k1[l], peer_k2[l], peer_u[l], peer_v[l])
    return rms_norm(x, final_norm_g)
```

```cpp
#include <hip/hip_runtime.h>
#include <cstdio>
#include <cstdint>
#define MK_PER_PHASE 0
namespace pg8 {
__device__ __forceinline__ int fresh_tid() { int t = threadIdx.x; asm volatile("" : "+v"(t)); return t; }
#define PG8_LAS __attribute__((address_space(3)))
typedef unsigned short bf16_t;
typedef short bf16x8 __attribute__((ext_vector_type(8)));
typedef float f32x4 __attribute__((ext_vector_type(4)));
typedef unsigned u32x4 __attribute__((ext_vector_type(4)));
constexpr int BM = 256, BK = 64, HALF = 128, HTB = HALF * BK * 2  , STAGE_BYTES = 8 * HTB, NXCD = 8, WGM = 8;

__host__ __device__ __forceinline__ int lds_byte(int r, int c) { const int st = (r >> 4) * 2 + (c >> 5), rr = r & 15, cc = c & 31, ob = rr * 64 + cc * 2; return st * 1024 + (ob ^ (((ob >> 9) & 1) << 5)); }
__host__ __device__ __forceinline__ void stage_rc(int b, int& R, int& C) { const int st = b / 1024, sb = b % 1024, swz = sb ^ (((sb >> 9) & 1) << 5); R = (st >> 1) * 16 + swz / 64; C = (st & 1) * 32 + (swz % 64) / 2; }
__host__ __device__ __forceinline__ int perm32(int rho) { const int n = rho >> 4, i = rho & 15; return 8 * (i >> 2) + 4 * n + (i & 3); }

struct Unit { int pm, pn; };
struct Gemm { const bf16_t* A; const bf16_t* Bt; int M, N, K; };

struct StaticOrder {
    int nM, nN, nwg, G, c;
    __host__ __device__ void init(int M, int N, int G_, int c_) { nM = M / BM; nN = N / BM; nwg = nM * nN; G = G_; c = c_; }
    __host__ __device__ bool next(int i, Unit& u) const {
        const long L = (long)i * G + c; if (L >= nwg) return false;
        int wgid = (int)L; { const int q = nwg / NXCD, r = nwg % NXCD, xcd = wgid % NXCD, off = wgid / NXCD; wgid = (xcd < r ? xcd * (q + 1) : r * (q + 1) + (xcd - r) * q) + off; }
        const int nig = WGM * nN, gid = wgid / nig, fm = gid * WGM, gsz = (nM - fm) < WGM ? (nM - fm) : WGM;
        u.pm = fm + ((wgid % nig) % gsz); u.pn = (wgid % nig) / gsz; return true;
    }
    __device__ __forceinline__ void a_ready(const Unit&) const {}
    __device__ __forceinline__ void done(const Unit&) const {}
};


__device__ __forceinline__ unsigned cvt_pk_bf16(float lo, float hi) { unsigned r; asm volatile("v_cvt_pk_bf16_f32 %0, %1, %2" : "=v"(r) : "v"(lo), "v"(hi)); return r; }

struct EpiP {
    static constexpr bool PERM = true, AFTER_DRAIN = false;
    bf16_t* P; float* Ps; const float* rstd;
    __device__ __forceinline__ void operator()(const f32x4 (&acc)[2][2][4][2], const Unit& u, int wr, int wc, int fr, int fq) const {
        const int row0 = u.pm * BM + wr * 64 + fr;
        if (u.pn < 28) {
            const int col0 = u.pn * BM + wc * 32 + 8 * fq;
#pragma unroll
            for (int ai = 0; ai < 2; ++ai)
#pragma unroll
                for (int m = 0; m < 4; ++m) { const int row = row0 + ai * HALF + m * 16; const float r = rstd[row]; bf16_t* rowp = P + (size_t)row * 7168 + col0;
#pragma unroll
                    for (int bj = 0; bj < 2; ++bj) { const f32x4 v0 = acc[ai][bj][m][0] * r, v1 = acc[ai][bj][m][1] * r;
                        u32x4 w; w.x = cvt_pk_bf16(v0[0], v0[1]); w.y = cvt_pk_bf16(v0[2], v0[3]); w.z = cvt_pk_bf16(v1[0], v1[1]); w.w = cvt_pk_bf16(v1[2], v1[3]);
                        *(u32x4*)(rowp + bj * HALF) = w; } }
        } else if (wc == 0) {
#pragma unroll
            for (int ai = 0; ai < 2; ++ai)
#pragma unroll
                for (int m = 0; m < 4; ++m) { const int row = row0 + ai * HALF + m * 16; const float r = rstd[row]; float* p = Ps + (size_t)row * 32 + 8 * fq;
                    *(f32x4*)p = acc[ai][0][m][0] * r; *(f32x4*)(p + 4) = acc[ai][0][m][1] * r; }
        }
    }
};
struct EpiX {
    static constexpr bool PERM = true, AFTER_DRAIN = false;
    const float* xres; float* xout; bf16_t* xb; float* ssp;
    __device__ __forceinline__ void operator()(const f32x4 (&acc)[2][2][4][2], const Unit& u, int wr, int wc, int fr, int fq) const {
        const int row0 = u.pm * BM + wr * 64 + fr, col0 = u.pn * BM + wc * 32 + 8 * fq;
#pragma unroll
        for (int ai = 0; ai < 2; ++ai)
#pragma unroll
            for (int m = 0; m < 4; ++m) { const int row = row0 + ai * HALF + m * 16; float ss = 0.f;
#pragma unroll
                for (int bj = 0; bj < 2; ++bj) { const size_t off = (size_t)row * 2048 + col0 + bj * HALF;
                    const f32x4 r0 = *(const f32x4*)(xres + off), r1 = *(const f32x4*)(xres + off + 4);
                    const f32x4 v0 = acc[ai][bj][m][0] + r0, v1 = acc[ai][bj][m][1] + r1;
                    *(f32x4*)(xout + off) = v0; *(f32x4*)(xout + off + 4) = v1;
                    u32x4 w; w.x = cvt_pk_bf16(v0[0], v0[1]); w.y = cvt_pk_bf16(v0[2], v0[3]); w.z = cvt_pk_bf16(v1[0], v1[1]); w.w = cvt_pk_bf16(v1[2], v1[3]);
                    *(u32x4*)(xb + off) = w;
                    ss += (v0[0] * v0[0] + v0[1] * v0[1]) + (v0[2] * v0[2] + v0[3] * v0[3]) + (v1[0] * v1[0] + v1[1] * v1[1]) + (v1[2] * v1[2] + v1[3] * v1[3]); }
                ss += __shfl_xor(ss, 16); ss += __shfl_xor(ss, 32);
                if (fq == 0) ssp[(size_t)row * 32 + u.pn * 4 + wc] = ss; }
    }
};
struct EpiQ {
    static constexpr bool PERM = true, AFTER_DRAIN = false;
    bf16_t* Q; const float* ssp;
    __device__ __forceinline__ void operator()(const f32x4 (&acc)[2][2][4][2], const Unit& u, int wr, int wc, int fr, int fq) const {
        const int row0 = u.pm * BM + wr * 64 + fr, col0 = u.pn * BM + wc * 32 + 8 * fq;
#pragma unroll
        for (int ai = 0; ai < 2; ++ai)
#pragma unroll
            for (int m = 0; m < 4; ++m) { const int row = row0 + ai * HALF + m * 16;
                const f32x4* sp = (const f32x4*)(ssp + (size_t)row * 32 + 8 * fq); const f32x4 a = sp[0], b = sp[1];
                float s = ((a[0] + a[1]) + (a[2] + a[3])) + ((b[0] + b[1]) + (b[2] + b[3]));
                s += __shfl_xor(s, 16); s += __shfl_xor(s, 32);
                const float r = rsqrtf(s * (1.0f / 2048.0f) + 1e-6f); bf16_t* rowp = Q + (size_t)row * 2048 + col0;
#pragma unroll
                for (int bj = 0; bj < 2; ++bj) { const f32x4 v0 = acc[ai][bj][m][0] * r, v1 = acc[ai][bj][m][1] * r;
                    u32x4 w; w.x = cvt_pk_bf16(v0[0], v0[1]); w.y = cvt_pk_bf16(v0[2], v0[3]); w.z = cvt_pk_bf16(v1[0], v1[1]); w.w = cvt_pk_bf16(v1[2], v1[3]);
                    *(u32x4*)(rowp + bj * HALF) = w; } }
    }
};

template <class Epi, class Sched, bool ALIGN_EPI = false, bool SP2 = false>
__device__ __forceinline__ void gemm_phase(PG8_LAS unsigned char* lds, const Gemm g, const Sched& S, const Epi& E) {
    const int tid = fresh_tid(), wid = __builtin_amdgcn_readfirstlane(tid >> 6), lane = tid & 63, wr = wid >> 2, wc = wid & 3, fr = lane & 15, fq = lane >> 4;
    const int K = g.K, nt = K / BK;
    unsigned voffA[2], voffB[2];
#pragma unroll
    for (int i = 0; i < 2; ++i) { int R, C; stage_rc(tid * 16 + i * 8192, R, C); const int Rb = Epi::PERM ? ((R & ~31) + perm32(R & 31)) : R;
        voffA[i] = (unsigned)(R * K + C) * 2u; voffB[i] = (unsigned)(Rb * K + C) * 2u; }
    const size_t kstep = (size_t)(BK * 2);
    const size_t hstep = (size_t)HALF * K * 2;
    const size_t tstep = 2 * hstep;
    const unsigned ldsw = (unsigned)wid * 1024u;
    const int aoff = lds_byte(wr * 64 + fr, fq * 8), boff = lds_byte(wc * 32 + fr, fq * 8);
#define PG8_SA(b, h) (((b) * 2 + (h)) * HTB)
#define PG8_SB(b, h) ((4 + (b) * 2 + (h)) * HTB)
#define PG8_STAGE(bufoff, gbase, voff) do { _Pragma("unroll") for (int _i = 0; _i < 2; ++_i) \
        __builtin_amdgcn_global_load_lds((const unsigned*)((const char*)(gbase) + (voff)[_i]), (PG8_LAS unsigned*)(lds + (bufoff) + ldsw + _i * 8192), 16, 0, 0); } while (0)
#define PG8_LDA(dst, b, h) do { _Pragma("unroll") for (int m = 0; m < 4; ++m) _Pragma("unroll") for (int k = 0; k < 2; ++k) dst[m][k] = *(const PG8_LAS bf16x8*)(lds + PG8_SA(b, h) + aoff + m * 2048 + k * 1024); } while (0)
#define PG8_LDB(dst, b, h) do { _Pragma("unroll") for (int n = 0; n < 2; ++n) _Pragma("unroll") for (int k = 0; k < 2; ++k) dst[n][k] = *(const PG8_LAS bf16x8*)(lds + PG8_SB(b, h) + boff + n * 2048 + k * 1024); } while (0)
#define PG8_MMA(ai, bj, At, Bt) do { __builtin_amdgcn_s_setprio(1); _Pragma("unroll") for (int m = 0; m < 4; ++m) _Pragma("unroll") for (int n = 0; n < 2; ++n) _Pragma("unroll") for (int k = 0; k < 2; ++k) \
        acc[ai][bj][m][n] = __builtin_amdgcn_mfma_f32_16x16x32_bf16(Bt[n][k], At[m][k], acc[ai][bj][m][n], 0, 0, 0); __builtin_amdgcn_s_setprio(0); } while (0)
#define PG8_WAIT_V(n) asm volatile("s_waitcnt vmcnt(" #n ")" ::: "memory")
#define PG8_WAIT_L(n) asm volatile("s_waitcnt lgkmcnt(" #n ")" ::: "memory")
#define PG8_BAR __builtin_amdgcn_s_barrier()
#define PG8_SCHED __builtin_amdgcn_sched_barrier(0)
    Unit cur, nxt; int ui = 0;
    if (!S.next(0, cur)) return;
    f32x4 acc[2][2][4][2];
#pragma unroll
    for (int a = 0; a < 2; ++a)
#pragma unroll
        for (int b = 0; b < 2; ++b)
#pragma unroll
            for (int m = 0; m < 4; ++m)
#pragma unroll
                for (int n = 0; n < 2; ++n) acc[a][b][m][n] = (f32x4){0.f, 0.f, 0.f, 0.f};
    bf16x8 At[4][2], B0[2][2], B1[2][2];
    const char* cA = (const char*)g.A + (size_t)cur.pm * tstep; const char* cB = (const char*)g.Bt + (size_t)cur.pn * tstep;
    S.a_ready(cur);
    if constexpr (SP2) {
        PG8_STAGE(PG8_SB(0, 0), cB, voffB); PG8_STAGE(PG8_SB(0, 1), cB + hstep, voffB); PG8_STAGE(PG8_SA(0, 0), cA, voffA); PG8_STAGE(PG8_SA(0, 1), cA + hstep, voffA);
        if (wr == 1) PG8_BAR;
        PG8_WAIT_V(2); PG8_BAR;
        PG8_STAGE(PG8_SB(1, 0), cB + kstep, voffB); PG8_STAGE(PG8_SA(1, 0), cA + kstep, voffA); PG8_STAGE(PG8_SB(1, 1), cB + hstep + kstep, voffB);
        PG8_WAIT_V(6); PG8_BAR;
    } else {
        PG8_STAGE(PG8_SB(0, 0), cB, voffB); PG8_STAGE(PG8_SA(0, 0), cA, voffA); PG8_STAGE(PG8_SB(0, 1), cB + hstep, voffB); PG8_STAGE(PG8_SA(0, 1), cA + hstep, voffA);
        if (wr == 1) PG8_BAR;
        PG8_WAIT_V(4); PG8_BAR;
        PG8_STAGE(PG8_SB(1, 0), cB + kstep, voffB); PG8_STAGE(PG8_SA(1, 0), cA + kstep, voffA); PG8_STAGE(PG8_SB(1, 1), cB + hstep + kstep, voffB);
        PG8_WAIT_V(6); PG8_BAR;
    }
    for (;;) {
        const bool has_next = S.next(ui + 1, nxt);
        const char* nA = has_next ? (const char*)g.A + (size_t)nxt.pm * tstep : cA; const char* nB = has_next ? (const char*)g.Bt + (size_t)nxt.pn * tstep : cB;
        for (int t = 0; t < nt; t += 2) {
            const bool last = (t == nt - 2);
            const char* a1 = cA + (size_t)(t + 1) * kstep;
            const char* a2 = last ? nA : cA + (size_t)(t + 2) * kstep; const char* b2 = last ? nB : cB + (size_t)(t + 2) * kstep;
            const char* a3 = a2 + kstep; const char* b3 = b2 + kstep;
            if (last && has_next) S.a_ready(nxt);
            if constexpr (SP2) {
            PG8_LDB(B0, 0, 0); PG8_LDB(B1, 0, 1); PG8_SCHED; PG8_LDA(At, 0, 0); PG8_STAGE(PG8_SA(1, 1), a1 + hstep, voffA);
            PG8_WAIT_V(8); PG8_WAIT_L(0); PG8_BAR; PG8_MMA(0, 0, At, B0); PG8_MMA(0, 1, At, B1); PG8_BAR; PG8_SCHED;
            PG8_LDA(At, 0, 1); PG8_STAGE(PG8_SB(0, 0), b2, voffB); PG8_STAGE(PG8_SB(0, 1), b2 + hstep, voffB); PG8_STAGE(PG8_SA(0, 0), a2, voffA);
            PG8_WAIT_V(8); PG8_WAIT_L(0); PG8_BAR; PG8_MMA(1, 0, At, B0); PG8_MMA(1, 1, At, B1); PG8_BAR; PG8_SCHED;
            PG8_LDB(B0, 1, 0); PG8_LDB(B1, 1, 1); PG8_SCHED; PG8_LDA(At, 1, 0); PG8_STAGE(PG8_SA(0, 1), a2 + hstep, voffA);
            PG8_WAIT_V(8); PG8_WAIT_L(0); PG8_BAR; PG8_MMA(0, 0, At, B0); PG8_MMA(0, 1, At, B1); PG8_BAR; PG8_SCHED;
            PG8_LDA(At, 1, 1); PG8_STAGE(PG8_SB(1, 0), b3, voffB); PG8_STAGE(PG8_SB(1, 1), b3 + hstep, voffB); PG8_STAGE(PG8_SA(1, 0), a3, voffA);
            PG8_WAIT_V(8); PG8_WAIT_L(0); PG8_BAR; PG8_MMA(1, 0, At, B0); PG8_MMA(1, 1, At, B1); PG8_BAR; PG8_SCHED;
            } else {
            PG8_LDB(B0, 0, 0); PG8_SCHED; PG8_LDA(At, 0, 0); PG8_STAGE(PG8_SA(1, 1), a1 + hstep, voffA);
            PG8_WAIT_L(8); PG8_BAR; PG8_WAIT_L(0); PG8_MMA(0, 0, At, B0); PG8_BAR; PG8_SCHED;
            PG8_LDB(B1, 0, 1); PG8_STAGE(PG8_SB(0, 0), b2, voffB);
            PG8_BAR; PG8_WAIT_L(0); PG8_MMA(0, 1, At, B1); PG8_BAR;
            PG8_LDA(At, 0, 1); PG8_STAGE(PG8_SA(0, 0), a2, voffA);
            PG8_BAR; PG8_WAIT_L(0); PG8_MMA(1, 0, At, B0); PG8_BAR; PG8_SCHED;
            PG8_STAGE(PG8_SB(0, 1), b2 + hstep, voffB);
            PG8_WAIT_V(6); PG8_BAR; PG8_MMA(1, 1, At, B1); PG8_BAR;
            PG8_LDB(B0, 1, 0); PG8_SCHED; PG8_LDA(At, 1, 0); PG8_STAGE(PG8_SA(0, 1), a2 + hstep, voffA);
            PG8_WAIT_L(8); PG8_BAR; PG8_WAIT_L(0); PG8_MMA(0, 0, At, B0); PG8_BAR; PG8_SCHED;
            PG8_LDB(B1, 1, 1); PG8_STAGE(PG8_SB(1, 0), b3, voffB);
            PG8_BAR; PG8_WAIT_L(0); PG8_MMA(0, 1, At, B1); PG8_BAR;
            PG8_LDA(At, 1, 1); PG8_STAGE(PG8_SA(1, 0), a3, voffA);
            PG8_BAR; PG8_WAIT_L(0); PG8_MMA(1, 0, At, B0); PG8_BAR; PG8_SCHED;
            PG8_STAGE(PG8_SB(1, 1), b3 + hstep, voffB);
            PG8_WAIT_V(6); PG8_BAR; PG8_MMA(1, 1, At, B1); PG8_BAR;
            }
        }
        if constexpr (ALIGN_EPI) { if (wr == 0) PG8_BAR; }
        if constexpr (!Epi::AFTER_DRAIN) { E(acc, cur, wr, wc, fr, fq); S.done(cur); }
        if (!has_next) break;
#pragma unroll
        for (int a = 0; a < 2; ++a)
#pragma unroll
            for (int b = 0; b < 2; ++b)
#pragma unroll
                for (int m = 0; m < 4; ++m)
#pragma unroll
                    for (int n = 0; n < 2; ++n) acc[a][b][m][n] = (f32x4){0.f, 0.f, 0.f, 0.f};
        cur = nxt; cA = nA; cB = nB; ++ui;
        if constexpr (ALIGN_EPI) { if (wr == 1) PG8_BAR; }
    }
    PG8_WAIT_V(0);
    if constexpr (!ALIGN_EPI) { if (wr == 0) PG8_BAR; }
    PG8_BAR;
    if constexpr (Epi::AFTER_DRAIN) { E.fused(acc, cur, wr, wc, fr, fq, lds, wid, lane); S.done(cur); }
#undef PG8_SA
#undef PG8_SB
#undef PG8_STAGE
#undef PG8_LDA
#undef PG8_LDB
#undef PG8_MMA
#undef PG8_WAIT_V
#undef PG8_WAIT_L
#undef PG8_BAR
#undef PG8_SCHED
}
}

constexpr int NWAVES = 8, NTHREADS = 512;
constexpr int NT = 8192, DM = 2048, SEQ = 2048, NBATCH = 4, DEPTH = 2, CHK = 64, NCHK = 32, GW = 512, NH = 4, HD = 128;
constexpr int DIN = 7200, NINP = 7424, PBW = 7168;
constexpr int NEXP = 16384;
constexpr int PC_GLA_Q = 0, PC_GLA_K = 512, PC_GLA_V = 1024, PC_GLA_G = 1536, PC_LRU_X = 2048, PC_LRU_Y = 2560, PC_ML_Q = 3072, PC_ML_K = 3584, PC_ML_V = 4096, PC_ML_O = 4608,
              PC_GDN_Q = 5120, PC_GDN_K = 5632, PC_GDN_V = 6144, PC_GDN_G = 6656;
constexpr int PS_LR = 0, PS_MI = 16, PS_MF = 20, PS_GB = 24, PS_GA = 28;
constexpr float RMS_EPS = 1e-6f;
enum { I_X = 0, I_N1G, I_WIN, I_WOUT, I_GLA_W2, I_GLA_B2, I_GLA_NG, I_LRU_CW, I_LRU_CB, I_LRU_WA, I_LRU_BA, I_LRU_WX, I_LRU_BX, I_LRU_LAM, I_ML_IB, I_ML_FB, I_ML_NG,
       I_GDN_CW, I_GDN_ALOG, I_GDN_DTB, I_GDN_NG, I_N2G, I_PWQ, I_PK1, I_PK2, I_PU, I_PV, I_FNG, N_IN };

constexpr size_t MiB = 1u << 20;
constexpr size_t WS_CTL = 0, CTL_ZERO_BYTES = 1 * MiB;
constexpr size_t WS_WIN = 2 * MiB;
constexpr size_t WIN_L = (size_t)NINP * DM * 2;
constexpr size_t WS_WOUT = 60 * MiB;
constexpr size_t WS_WQ = 76 * MiB;
constexpr size_t WSQ_L = (size_t)DM * DM * 2;
constexpr size_t WS_K1 = 92 * MiB, WS_K2 = 92 * MiB + 512 * 1024;
constexpr size_t WS_RSTD1 = 93 * MiB;
constexpr size_t WS_SSP = 94 * MiB;
constexpr size_t WS_XB = 96 * MiB;
constexpr size_t WS_P = 128 * MiB;
constexpr size_t WS_PS = 240 * MiB;
constexpr size_t WS_MIX = 242 * MiB;
constexpr size_t WS_Q = 274 * MiB;
constexpr size_t WS_UB = 306 * MiB;
constexpr size_t WS_VB = 434 * MiB;
constexpr size_t TAB_L = (size_t)NEXP * DM * 2;
constexpr size_t WS_SCR = 562 * MiB;
constexpr size_t WS_END = 900 * MiB;

constexpr int LDS_BYTES = 155648;
constexpr int MISC_OFF = LDS_BYTES - 256;

#define GAS __attribute__((address_space(1)))
#define LAS __attribute__((address_space(3)))
typedef unsigned short bf16;
typedef unsigned v4u __attribute__((ext_vector_type(4)));
typedef unsigned v2u __attribute__((ext_vector_type(2)));
typedef float f32x4 __attribute__((ext_vector_type(4)));
typedef float f32x2 __attribute__((ext_vector_type(2)));
typedef short bf16x8 __attribute__((ext_vector_type(8)));
typedef short bf16x4 __attribute__((ext_vector_type(4)));
typedef __bf16 bf2_t __attribute__((ext_vector_type(2)));
typedef GAS unsigned gu32;
#define RLX_AGENT __ATOMIC_RELAXED, __HIP_MEMORY_SCOPE_AGENT
__device__ __forceinline__ unsigned f2bf(float f) { unsigned u = __builtin_bit_cast(unsigned, f); return (u + 0x7fffu + ((u >> 16) & 1u)) >> 16; }
__device__ __forceinline__ unsigned pk2(float lo, float hi) { return f2bf(lo) | (f2bf(hi) << 16); }
__device__ __forceinline__ float bf2f(unsigned b) { return __builtin_bit_cast(float, b << 16); }
__device__ __forceinline__ float bflo(unsigned w) { return __builtin_bit_cast(float, w << 16); }
__device__ __forceinline__ float bfhi(unsigned w) { return __builtin_bit_cast(float, w & 0xffff0000u); }
__device__ __forceinline__ float wave_sum(float v) {
#pragma unroll
    for (int o = 1; o < 64; o <<= 1) v += __shfl_xor(v, o);
    return v;
}
__device__ __forceinline__ float sigmoidf_(float x) { return 1.0f / (1.0f + __expf(-x)); }
__device__ __forceinline__ float siluf_(float x) { return x / (1.0f + __expf(-x)); }
__device__ __forceinline__ float softplusf_(float x) { return fmaxf(x, 0.f) + log1pf(__expf(-fabsf(x))); }
__device__ __forceinline__ float logsigmoidf_(float x) { return -softplusf_(-x); }
__device__ __forceinline__ float gelu_tanh(float x) { const float u = 0.7978845608028654f * (x + 0.044715f * x * x * x); return 0.5f * x * (1.0f + tanhf(u)); }

#define XB_TMO      128
#define XB_XCNT(j)  (256  + 64 * (j))
#define XB_XSUB(j)  (1280 + 64 * (j))
#define XB_XGEN(j)  (2304 + 64 * (j))
#define XB_TOP      3328
#define XB_TOPGEN   3392
#define XCD_BAR_WORDS 3456
#define XB_SPIN_CAP (1u << 18)

__device__ __forceinline__ unsigned xb_ld(unsigned* p)              { return __hip_atomic_load(p, __ATOMIC_RELAXED, __HIP_MEMORY_SCOPE_AGENT); }
__device__ __forceinline__ unsigned xb_add(unsigned* p, unsigned v) { return __hip_atomic_fetch_add(p, v, __ATOMIC_RELAXED, __HIP_MEMORY_SCOPE_AGENT); }
__device__ __forceinline__ unsigned xb_xcc_id() { return (unsigned)__builtin_amdgcn_s_getreg((3 << 11) | 20) & 0xFu; }
#define XB_SPIN(cond, bar) do { unsigned _sp = 0; while (cond) { __builtin_amdgcn_s_sleep(1); \
    if ((++_sp & 255u) == 0u) { if (xb_ld(&(bar)[XB_TMO])) break; if (_sp > XB_SPIN_CAP) { atomicAdd(&(bar)[XB_TMO], 1u); break; } } } } while (0)

struct XcdBarrier {
    unsigned* bar; unsigned x;
    volatile LAS unsigned* st;
};

__device__ __forceinline__ XcdBarrier xcd_barrier_post(unsigned* bar, volatile LAS unsigned* st) {
    XcdBarrier b; b.bar = bar; b.x = xb_xcc_id(); b.st = st;
    if (threadIdx.x == 0) (void)xb_add(&bar[XB_XCNT(b.x)], 1u);
    return b;
}
__device__ __forceinline__ void xcd_barrier_complete(unsigned* bar, unsigned x, unsigned& nloc, unsigned& nx) {
    const unsigned G = gridDim.x * gridDim.y * gridDim.z;
    unsigned sum, cnt, mine, sp = 0u;
    for (;;) {
        sum = 0u; cnt = 0u; mine = 0u;
#pragma unroll
        for (unsigned j = 0; j < 16; ++j) { const unsigned c = xb_ld(&bar[XB_XCNT(j)]); sum += c; cnt += (c > 0u) ? 1u : 0u; mine = (j == x) ? c : mine; }
        if (sum == G) break;
        __builtin_amdgcn_s_sleep(1);
        if ((++sp & 255u) == 0u) { if (xb_ld(&bar[XB_TMO])) break; if (sp > XB_SPIN_CAP) { atomicAdd(&bar[XB_TMO], 1u); break; } }
    }
    nloc = mine > 0u ? mine : 1u; nx = cnt > 0u ? cnt : 1u;
}

__device__ __forceinline__ void xcd_barrier(const XcdBarrier& b) {
    asm volatile("s_waitcnt vmcnt(0)" ::: "memory");
    __syncthreads();
    if (threadIdx.x == 0) {
        unsigned* bar = b.bar;
        __builtin_amdgcn_s_waitcnt(0);
        unsigned nloc = b.st[0], nx = b.st[1];
        if (nloc == 0u) { xcd_barrier_complete(bar, b.x, nloc, nx); b.st[0] = nloc; b.st[1] = nx; }
        const unsigned old = xb_add(&bar[XB_XSUB(b.x)], 1u);
        const unsigned gen = old / nloc;
        if (old + 1u == (gen + 1u) * nloc) {
            __builtin_amdgcn_fence(__ATOMIC_RELEASE, "agent");
            asm volatile("s_waitcnt vmcnt(0)" ::: "memory");
            const unsigned og = xb_add(&bar[XB_TOP], 1u);
            const unsigned tg = og / nx;
            if (og + 1u == (tg + 1u) * nx) xb_add(&bar[XB_TOPGEN], 1u);
            else XB_SPIN(xb_ld(&bar[XB_TOPGEN]) == tg, bar);
            __builtin_amdgcn_fence(__ATOMIC_ACQUIRE, "agent");
            xb_add(&bar[XB_XGEN(b.x)], 1u);
            asm volatile("s_waitcnt vmcnt(0)" ::: "memory");
        } else {
            XB_SPIN(xb_ld(&bar[XB_XGEN(b.x)]) == gen, bar);
            __builtin_amdgcn_fence(__ATOMIC_ACQUIRE, "agent");
            asm volatile("s_waitcnt vmcnt(0)" ::: "memory");
        }
    }
    __syncthreads();
}


struct Args { const float* in[N_IN]; float* out; unsigned char* ws; int ph_lo, ph_hi, li, pad; };

__device__ __forceinline__ int win_src_col(int n) {
    if (n < 2048) return n;
    if (n < 3072) return 2064 + (n - 2048);
    if (n < 5120) return 3088 + (n - 3072);
    if (n < 7168) return 5144 + (n - 5120);
    if (n < 7184) return 2048 + (n - 7168);
    if (n < 7192) return 5136 + (n - 7184);
    if (n < 7200) return n;
    return -1;
}
template <bool MAP>
__device__ __forceinline__ void p0_transpose_item(const float* W, int K, int Nsrc, int Ndst, const float* gain, bf16* WT, LAS float* scr, int item, int lane) {
    const int nblk = Ndst / 32, kb = item / nblk, nb = item % nblk, k0 = 64 * kb, n0 = 32 * nb;
    const int nn = n0 + (lane & 31); const int src = MAP ? win_src_col(nn) : nn;
#pragma unroll 8
    for (int i = 0; i < 32; ++i) { const int kk = 2 * i + (lane >> 5); float v = 0.f; if (src >= 0) v = W[(size_t)(k0 + kk) * Nsrc + src]; if (gain) v *= gain[k0 + kk]; scr[kk * 33 + (lane & 31)] = v; }
    asm volatile("s_waitcnt lgkmcnt(0)" ::: "memory");
    const int c = lane & 7;
#pragma unroll
    for (int j = 0; j < 4; ++j) { const int n = (lane >> 3) + 8 * j; const LAS float* s = scr + (8 * c) * 33 + n;
        v4u o; o.x = pk2(s[0 * 33], s[1 * 33]); o.y = pk2(s[2 * 33], s[3 * 33]); o.z = pk2(s[4 * 33], s[5 * 33]); o.w = pk2(s[6 * 33], s[7 * 33]);
        *(GAS v4u*)(WT + (size_t)(n0 + n) * K + k0 + 8 * c) = o; }
    asm volatile("s_waitcnt lgkmcnt(0)" ::: "memory");
}
__device__ __forceinline__ void p0_convert(const float* src, bf16* dst, size_t n, size_t gtid, size_t gthreads) {
    for (size_t i = gtid * 8; i < n; i += gthreads * 8) {
        const f32x4 a = *(const GAS f32x4*)(src + i), b = *(const GAS f32x4*)(src + i + 4);
        v4u o; o.x = pk2(a[0], a[1]); o.y = pk2(a[2], a[3]); o.z = pk2(b[0], b[1]); o.w = pk2(b[2], b[3]);
        *(GAS v4u*)(dst + i) = o; }
}
__device__ __forceinline__ void p0_prologue(const Args& A, LAS unsigned char* lds, int vcu, int G, int wave, int lane) {
    unsigned char* ws = A.ws;
    LAS float* scr = (LAS float*)(lds + wave * 16384);
    const int gw = vcu * NWAVES + wave, NGW = G * NWAVES;
    constexpr int I_IN = (DM / 64) * (NINP / 32), I_SQ = (DM / 64) * (DM / 32), I_LAYER = I_IN + 2 * I_SQ, NITEMS = DEPTH * I_LAYER;
    for (int it = gw; it < NITEMS; it += NGW) {
        const int l = it / I_LAYER; int r = it % I_LAYER;
        if (r < I_IN) { p0_transpose_item<true>(A.in[I_WIN] + (size_t)l * DM * DIN, DM, DIN, NINP, A.in[I_N1G] + l * DM, (bf16*)(ws + WS_WIN + l * WIN_L), scr, r, lane); continue; } r -= I_IN;
        if (r < I_SQ) { p0_transpose_item<false>(A.in[I_WOUT] + (size_t)l * DM * DM, DM, DM, DM, nullptr, (bf16*)(ws + WS_WOUT + l * WSQ_L), scr, r, lane); continue; } r -= I_SQ;
        p0_transpose_item<false>(A.in[I_PWQ] + (size_t)l * DM * DM, DM, DM, DM, A.in[I_N2G] + l * DM, (bf16*)(ws + WS_WQ + l * WSQ_L), scr, r, lane);
    }
    const size_t gtid = (size_t)gw * 64 + lane, gthreads = (size_t)NGW * 64;
    p0_convert(A.in[I_PU], (bf16*)(ws + WS_UB), (size_t)DEPTH * NEXP * DM, gtid, gthreads);
    p0_convert(A.in[I_PV], (bf16*)(ws + WS_VB), (size_t)DEPTH * NEXP * DM, gtid, gthreads);
    p0_convert(A.in[I_PK1], (bf16*)(ws + WS_K1), (size_t)DEPTH * 8 * 128 * 128, gtid, gthreads);
    p0_convert(A.in[I_PK2], (bf16*)(ws + WS_K2), (size_t)DEPTH * 8 * 128 * 128, gtid, gthreads);
    const float* x = A.in[I_X]; bf16* xb = (bf16*)(ws + WS_XB); float* rstd1 = (float*)(ws + WS_RSTD1);
    for (int m = gw; m < NT; m += NGW) {
        const GAS f32x4* xr = (const GAS f32x4*)(x + (size_t)m * DM) + lane;
        f32x4 v[8]; float s = 0.f;
#pragma unroll
        for (int j = 0; j < 8; ++j) { v[j] = xr[64 * j]; s += (v[j][0] * v[j][0] + v[j][1] * v[j][1]) + (v[j][2] * v[j][2] + v[j][3] * v[j][3]); }
        s = wave_sum(s);
        GAS v2u* o = (GAS v2u*)(xb + (size_t)m * DM) + lane;
#pragma unroll
        for (int j = 0; j < 8; ++j) { v2u w; w.x = pk2(v[j][0], v[j][1]); w.y = pk2(v[j][2], v[j][3]); o[64 * j] = w; }
        if (lane == 0) rstd1[m] = rsqrtf(s * (1.0f / DM) + RMS_EPS);
    }
}

constexpr int NM_Q = 0, NM_K = 32768, NM_A = 65536, NM_V = 98304, NM_PARTS = 131072  , NM_SC = 135168  ;

__device__ __forceinline__ void nm_load_tile(const bf16* g, size_t ld, LAS float* dst, int tid) {
#pragma unroll
    for (int i = 0; i < 2; ++i) { const int idx = tid + i * NTHREADS, r = idx >> 4, c8 = (idx & 15) * 8;
        const v4u w = *(const GAS v4u*)(g + (size_t)r * ld + c8);
        f32x4 a = {bflo(w.x), bfhi(w.x), bflo(w.y), bfhi(w.y)}, b = {bflo(w.z), bfhi(w.z), bflo(w.w), bfhi(w.w)};
        *(LAS f32x4*)(dst + r * 128 + c8) = a; *(LAS f32x4*)(dst + r * 128 + c8 + 4) = b; }
}
template <int GATE>
__device__ __forceinline__ void nm_finalize(const LAS float* vs, const float* ng, const bf16* gate, size_t gld, bf16* mixp, int wave, int lane) {
#pragma unroll 1
    for (int rr = 0; rr < 8; ++rr) { const int c = wave * 8 + rr;
        const float o1 = vs[c * 128 + lane], o2 = vs[c * 128 + 64 + lane];
        const float ss = wave_sum(o1 * o1 + o2 * o2), rs = rsqrtf(ss * (1.0f / 128.0f) + RMS_EPS);
        float r1 = o1 * rs * ng[lane], r2 = o2 * rs * ng[64 + lane];
        if (GATE == 1) { r1 *= siluf_(bf2f(gate[(size_t)c * gld + lane])); r2 *= siluf_(bf2f(gate[(size_t)c * gld + 64 + lane])); }
        mixp[(size_t)c * DM + lane] = (bf16)f2bf(r1); mixp[(size_t)c * DM + 64 + lane] = (bf16)f2bf(r2); }
}

__device__ __forceinline__ void nm_gla(const Args& A, int l, int b, int h, LAS unsigned char* lds, int tid) {
    const bf16* P = (const bf16*)(A.ws + WS_P); const float* Ps = (const float*)(A.ws + WS_PS); bf16* mix = (bf16*)(A.ws + WS_MIX);
    LAS float* qs = (LAS float*)(lds + NM_Q); LAS float* ks = (LAS float*)(lds + NM_K); LAS float* as = (LAS float*)(lds + NM_A); LAS float* vs = (LAS float*)(lds + NM_V);
    LAS float* parts = (LAS float*)(lds + NM_PARTS); LAS float* lrs = (LAS float*)(lds + NM_SC);
    const int v = tid & 127, dq = tid >> 7, wave = tid >> 6, lane = tid & 63;
    const float* w2 = A.in[I_GLA_W2] + (size_t)l * 16 * GW + h * HD + v;
    float w2c[16];
#pragma unroll
    for (int r = 0; r < 16; ++r) w2c[r] = w2[r * GW];
    const float b2 = A.in[I_GLA_B2][l * GW + h * HD + v];
    const float* ng = A.in[I_GLA_NG] + l * GW + h * HD;
    float S[32];
#pragma unroll
    for (int i = 0; i < 32; ++i) S[i] = 0.f;
#pragma unroll 1
    for (int n = 0; n < NCHK; ++n) {
        const size_t r0 = (size_t)b * SEQ + n * CHK;
        nm_load_tile(P + r0 * PBW + PC_GLA_Q + h * HD, PBW, qs, tid);
        nm_load_tile(P + r0 * PBW + PC_GLA_K + h * HD, PBW, ks, tid);
        nm_load_tile(P + r0 * PBW + PC_GLA_V + h * HD, PBW, vs, tid);
        for (int i = tid; i < 64 * 16; i += NTHREADS) lrs[i] = Ps[(r0 + (i >> 4)) * 32 + PS_LR + (i & 15)];
        __syncthreads();
#pragma unroll 1
        for (int i = 0; i < 16; ++i) { const int c = dq * 16 + i; float z = b2;
#pragma unroll
            for (int r = 0; r < 16; ++r) z += lrs[c * 16 + r] * w2c[r];
            as[c * 128 + v] = __expf(logsigmoidf_(z) * (1.0f / 16.0f)); }
        __syncthreads();
#pragma unroll 1
        for (int c = 0; c < CHK; ++c) {
            const float vt = vs[c * 128 + v]; float part = 0.f;
            const LAS f32x4* q4 = (const LAS f32x4*)(qs + c * 128 + dq * 32); const LAS f32x4* k4 = (const LAS f32x4*)(ks + c * 128 + dq * 32); const LAS f32x4* a4 = (const LAS f32x4*)(as + c * 128 + dq * 32);
#pragma unroll
            for (int i4 = 0; i4 < 8; ++i4) { const f32x4 qv = q4[i4], kv = k4[i4], av = a4[i4];
#pragma unroll
                for (int j = 0; j < 4; ++j) { S[i4 * 4 + j] = av[j] * S[i4 * 4 + j] + kv[j] * vt; part += qv[j] * S[i4 * 4 + j]; } }
            parts[((c & 1) * 4 + dq) * 128 + v] = part;
            __syncthreads();
            if (dq == 0) { const LAS float* pp = parts + (c & 1) * 512 + v; vs[c * 128 + v] = ((pp[0] + pp[128]) + (pp[256] + pp[384])) * 0.08838834764831845f; }
        }
        __syncthreads();
        nm_finalize<1>(vs, ng, P + r0 * PBW + PC_GLA_G + h * HD, PBW, mix + r0 * DM + 0 + h * HD, wave, lane);
        __syncthreads();
    }
}

__device__ __forceinline__ void nm_mlstm(const Args& A, int l, int b, int h, LAS unsigned char* lds, int tid) {
    const bf16* P = (const bf16*)(A.ws + WS_P); const float* Ps = (const float*)(A.ws + WS_PS); bf16* mix = (bf16*)(A.ws + WS_MIX);
    LAS float* qs = (LAS float*)(lds + NM_Q); LAS float* ks = (LAS float*)(lds + NM_K); LAS float* vs = (LAS float*)(lds + NM_V);
    LAS float* parts = (LAS float*)(lds + NM_PARTS); LAS float* dparts = (LAS float*)(lds + NM_A);
    LAS float* fs = (LAS float*)(lds + NM_SC); LAS float* es = fs + 64;
    const int v = tid & 127, dq = tid >> 7, wave = tid >> 6, lane = tid & 63;
    const float ib = A.in[I_ML_IB][l * NH + h], fb = A.in[I_ML_FB][l * NH + h];
    const float* ng = A.in[I_ML_NG] + l * GW + h * HD;
    float C[32], nn[32];
#pragma unroll
    for (int i = 0; i < 32; ++i) { C[i] = 0.f; nn[i] = 0.f; }
#pragma unroll 1
    for (int n = 0; n < NCHK; ++n) {
        const size_t r0 = (size_t)b * SEQ + n * CHK;
        nm_load_tile(P + r0 * PBW + PC_ML_Q + h * HD, PBW, qs, tid);
        nm_load_tile(P + r0 * PBW + PC_ML_K + h * HD, PBW, ks, tid);
        nm_load_tile(P + r0 * PBW + PC_ML_V + h * HD, PBW, vs, tid);
        if (tid < 64) { fs[tid] = sigmoidf_(Ps[(r0 + tid) * 32 + PS_MF + h] + fb); es[tid] = __expf(Ps[(r0 + tid) * 32 + PS_MI + h] + ib) * 0.08838834764831845f; }
        __syncthreads();
#pragma unroll 1
        for (int c = 0; c < CHK; ++c) {
            const float vt = vs[c * 128 + v], f = fs[c], ei = es[c]; float part = 0.f, dpart = 0.f;
            const LAS f32x4* q4 = (const LAS f32x4*)(qs + c * 128 + dq * 32); const LAS f32x4* k4 = (const LAS f32x4*)(ks + c * 128 + dq * 32);
#pragma unroll
            for (int i4 = 0; i4 < 8; ++i4) { const f32x4 qv = q4[i4], kv = k4[i4];
#pragma unroll
                for (int j = 0; j < 4; ++j) { const float kd = kv[j] * ei; C[i4 * 4 + j] = f * C[i4 * 4 + j] + kd * vt; nn[i4 * 4 + j] = f * nn[i4 * 4 + j] + kd;
                    part += qv[j] * C[i4 * 4 + j]; dpart += qv[j] * nn[i4 * 4 + j]; } }
            parts[((c & 1) * 4 + dq) * 128 + v] = part; if (v == 0) dparts[(c & 1) * 4 + dq] = dpart;
            __syncthreads();
            if (dq == 0) { const LAS float* pp = parts + (c & 1) * 512 + v; const LAS float* dp = dparts + (c & 1) * 4;
                const float num = (pp[0] + pp[128]) + (pp[256] + pp[384]), dot = (dp[0] + dp[1]) + (dp[2] + dp[3]);
                const float og = bf2f(P[(r0 + c) * PBW + PC_ML_O + h * HD + v]);
                vs[c * 128 + v] = num / fmaxf(fabsf(dot), 1.0f) * sigmoidf_(og); }
        }
        __syncthreads();
        nm_finalize<0>(vs, ng, nullptr, 0, mix + r0 * DM + 1024 + h * HD, wave, lane);
        __syncthreads();
    }
}

__device__ __forceinline__ void nm_gdn(const Args& A, int l, int b, int h, LAS unsigned char* lds, int tid) {
    const bf16* P = (const bf16*)(A.ws + WS_P); const float* Ps = (const float*)(A.ws + WS_PS); bf16* mix = (bf16*)(A.ws + WS_MIX);
    LAS float* qs = (LAS float*)(lds + NM_Q); LAS float* ks = (LAS float*)(lds + NM_K); LAS float* vs = (LAS float*)(lds + NM_V);
    LAS float* parts = (LAS float*)(lds + NM_PARTS);
    LAS float* egs = (LAS float*)(lds + NM_SC); LAS float* bts = egs + 64; LAS float* rq = egs + 128; LAS float* rk = egs + 192;
    const int v = tid & 127, dq = tid >> 7, wave = tid >> 6, lane = tid & 63;
    const float* cw = A.in[I_GDN_CW] + (size_t)l * 4 * 1536;
    const float nalog = -__expf(A.in[I_GDN_ALOG][l * NH + h]), dtb = A.in[I_GDN_DTB][l * NH + h];
    const float* ng = A.in[I_GDN_NG] + l * GW + h * HD;
    float S[32];
#pragma unroll
    for (int i = 0; i < 32; ++i) S[i] = 0.f;
#pragma unroll 1
    for (int n = 0; n < NCHK; ++n) {
        const size_t r0 = (size_t)b * SEQ + n * CHK;
#pragma unroll 1
        for (int part = 0; part < 3; ++part) {
            const int pc = (part == 0 ? PC_GDN_Q : part == 1 ? PC_GDN_K : PC_GDN_V) + h * HD + v, wc = part * 512 + h * HD + v;
            const float w0 = cw[wc], w1 = cw[1536 + wc], w2 = cw[2 * 1536 + wc], w3 = cw[3 * 1536 + wc];
            LAS float* dst = part == 0 ? qs : part == 1 ? ks : vs;
            const int c0 = dq * 16; const long t0 = (long)n * CHK + c0;
            float xm3 = (t0 - 3 >= 0) ? bf2f(P[(r0 + c0 - 3) * PBW + pc]) : 0.f, xm2 = (t0 - 2 >= 0) ? bf2f(P[(r0 + c0 - 2) * PBW + pc]) : 0.f, xm1 = (t0 - 1 >= 0) ? bf2f(P[(r0 + c0 - 1) * PBW + pc]) : 0.f;
#pragma unroll 4
            for (int i = 0; i < 16; ++i) { const float x0 = bf2f(P[(r0 + c0 + i) * PBW + pc]); const float y = w0 * xm3 + w1 * xm2 + w2 * xm1 + w3 * x0;
                dst[(c0 + i) * 128 + v] = siluf_(y); xm3 = xm2; xm2 = xm1; xm1 = x0; }
        }
        if (tid < 64) { bts[tid] = sigmoidf_(Ps[(r0 + tid) * 32 + PS_GB + h]); egs[tid] = __expf(nalog * softplusf_(Ps[(r0 + tid) * 32 + PS_GA + h] + dtb)); }
        __syncthreads();
#pragma unroll 1
        for (int rr = 0; rr < 8; ++rr) { const int c = wave * 8 + rr;
            const float q1 = qs[c * 128 + lane], q2 = qs[c * 128 + 64 + lane], k1 = ks[c * 128 + lane], k2 = ks[c * 128 + 64 + lane];
            const float sq = wave_sum(q1 * q1 + q2 * q2), sk = wave_sum(k1 * k1 + k2 * k2);
            if (lane == 0) { rq[c] = rsqrtf(sq + 1e-6f) * 0.08838834764831845f; rk[c] = rsqrtf(sk + 1e-6f); } }
        __syncthreads();
#pragma unroll 1
        for (int c = 0; c < CHK; ++c) {
            const float vt = vs[c * 128 + v], e = egs[c], bt = bts[c], sq = rq[c], sk = rk[c]; float part = 0.f;
            const LAS f32x4* q4 = (const LAS f32x4*)(qs + c * 128 + dq * 32); const LAS f32x4* k4 = (const LAS f32x4*)(ks + c * 128 + dq * 32);
            f32x4 kv[8];
#pragma unroll
            for (int i4 = 0; i4 < 8; ++i4) { kv[i4] = k4[i4] * sk;
#pragma unroll
                for (int j = 0; j < 4; ++j) { S[i4 * 4 + j] *= e; part += kv[i4][j] * S[i4 * 4 + j]; } }
            parts[dq * 128 + v] = part;
            __syncthreads();
            const float kS = (parts[v] + parts[128 + v]) + (parts[256 + v] + parts[384 + v]);
            const float u = bt * (vt - kS); float part2 = 0.f;
#pragma unroll
            for (int i4 = 0; i4 < 8; ++i4) { const f32x4 qv = q4[i4] * sq;
#pragma unroll
                for (int j = 0; j < 4; ++j) { S[i4 * 4 + j] += kv[i4][j] * u; part2 += qv[j] * S[i4 * 4 + j]; } }
            parts[512 + dq * 128 + v] = part2;
            __syncthreads();
            if (dq == 0) vs[c * 128 + v] = (parts[512 + v] + parts[640 + v]) + (parts[768 + v] + parts[896 + v]);
        }
        __syncthreads();
        nm_finalize<1>(vs, ng, P + r0 * PBW + PC_GDN_G + h * HD, PBW, mix + r0 * DM + 1536 + h * HD, wave, lane);
        __syncthreads();
    }
}

__device__ __forceinline__ void nm_lru(const Args& A, int l, int b, int j, LAS unsigned char* lds, int tid) {
    const bf16* P = (const bf16*)(A.ws + WS_P); bf16* mix = (bf16*)(A.ws + WS_MIX);
    LAS float* xc = (LAS float*)(lds);
    LAS float* was = (LAS float*)(lds + 20480);
    LAS float* wxs = (LAS float*)(lds + 36864);
    LAS float* aa = (LAS float*)(lds + 53248);
    LAS float* uu = (LAS float*)(lds + 69632);
    const float* wa = A.in[I_LRU_WA] + ((size_t)l * 8 + j) * 4096; const float* wx = A.in[I_LRU_WX] + ((size_t)l * 8 + j) * 4096;
    for (int i = tid; i < 4096; i += NTHREADS) { was[i] = wa[i]; wxs[i] = wx[i]; }
    const float* cw = A.in[I_LRU_CW] + (size_t)l * 4 * GW; const float* cb = A.in[I_LRU_CB] + l * GW;
    const float* ba = A.in[I_LRU_BA] + l * GW + j * 64; const float* bx = A.in[I_LRU_BX] + l * GW + j * 64; const float* lam = A.in[I_LRU_LAM] + l * GW + j * 64;
    float hstate = 0.f;
#pragma unroll 1
    for (int n = 0; n < NCHK; ++n) {
        const size_t r0 = (size_t)b * SEQ + n * CHK;
        { const int cc = tid & 63, c0 = (tid >> 6) * 8, ch = j * 64 + cc, pc = PC_LRU_X + ch; const long t0 = (long)n * CHK + c0;
            const float w0 = cw[ch], w1 = cw[GW + ch], w2 = cw[2 * GW + ch], w3 = cw[3 * GW + ch], bias = cb[ch];
            float xm3 = (t0 - 3 >= 0) ? bf2f(P[(r0 + c0 - 3) * PBW + pc]) : 0.f, xm2 = (t0 - 2 >= 0) ? bf2f(P[(r0 + c0 - 2) * PBW + pc]) : 0.f, xm1 = (t0 - 1 >= 0) ? bf2f(P[(r0 + c0 - 1) * PBW + pc]) : 0.f;
#pragma unroll
            for (int i = 0; i < 8; ++i) { const float x0 = bf2f(P[(r0 + c0 + i) * PBW + pc]); xc[(c0 + i) * 65 + cc] = w0 * xm3 + w1 * xm2 + w2 * xm1 + w3 * x0 + bias; xm3 = xm2; xm2 = xm1; xm1 = x0; } }
        __syncthreads();
        { const int tok = tid >> 3, cg = tid & 7; float ra[8], ri[8];
#pragma unroll
            for (int q = 0; q < 8; ++q) { ra[q] = ba[cg * 8 + q]; ri[q] = bx[cg * 8 + q]; }
#pragma unroll 4
            for (int i = 0; i < 64; ++i) { const float xv = xc[tok * 65 + i];
                const f32x4 a0 = *(const LAS f32x4*)(was + i * 64 + cg * 8), a1 = *(const LAS f32x4*)(was + i * 64 + cg * 8 + 4);
                const f32x4 x0 = *(const LAS f32x4*)(wxs + i * 64 + cg * 8), x1 = *(const LAS f32x4*)(wxs + i * 64 + cg * 8 + 4);
#pragma unroll
                for (int q = 0; q < 4; ++q) { ra[q] += xv * a0[q]; ra[4 + q] += xv * a1[q]; ri[q] += xv * x0[q]; ri[4 + q] += xv * x1[q]; } }
#pragma unroll
            for (int q = 0; q < 8; ++q) { const int jj = cg * 8 + q; const float r = sigmoidf_(ra[q]), ig = sigmoidf_(ri[q]);
                const float log_a = -8.0f * r * softplusf_(-lam[jj]); const float a = __expf(log_a), u = sqrtf(-expm1f(2.0f * log_a)) * (ig * xc[tok * 65 + jj]);
                aa[tok * 64 + jj] = a; uu[tok * 64 + jj] = u; } }
        __syncthreads();
        if (tid < 64) { const int ch = j * 64 + tid;
#pragma unroll 4
            for (int c = 0; c < CHK; ++c) { hstate = aa[c * 64 + tid] * hstate + uu[c * 64 + tid];
                const float y = bf2f(P[(r0 + c) * PBW + PC_LRU_Y + ch]); mix[(r0 + c) * DM + 512 + ch] = (bf16)f2bf(gelu_tanh(y) * hstate); } }
        __syncthreads();
    }
}

__device__ __forceinline__ void nm_phase(const Args& A, int l, LAS unsigned char* lds, int G, int tid) {
    for (int it = blockIdx.x; it < 80; it += G) {
        if (it < 16) nm_gla(A, l, it >> 2, it & 3, lds, tid);
        else if (it < 32) nm_mlstm(A, l, (it - 16) >> 2, (it - 16) & 3, lds, tid);
        else if (it < 48) nm_gdn(A, l, (it - 32) >> 2, (it - 32) & 3, lds, tid);
        else nm_lru(A, l, (it - 48) >> 3, (it - 48) & 7, lds, tid);
        __syncthreads();
    }
}

constexpr int PE_SC = 0, PE_TV = 66560, PE_TI = 75264, PE_SEL = 83968;
constexpr int SC_LD = 129, TL_LD = 17;

__device__ __forceinline__ float dot2bf(unsigned a, unsigned b, float c) { asm("v_dot2c_f32_bf16 %0, %1, %2" : "+v"(c) : "v"(a), "v"(b)); return c; }
__device__ __forceinline__ unsigned f2sortable(float f) { const unsigned u = __builtin_bit_cast(unsigned, f); return (u & 0x80000000u) ? ~u : (u | 0x80000000u); }

__device__ __forceinline__ void peer_phase(const Args& A, int l, bool last, LAS unsigned char* lds, int G, int tid) {
    const int wave = __builtin_amdgcn_readfirstlane(tid >> 6), lane = tid & 63;
    unsigned char* ws = A.ws;
    const bf16* Q = (const bf16*)(ws + WS_Q);
    const bf16* K1 = (const bf16*)(ws + WS_K1) + (size_t)l * 8 * 128 * 128; const bf16* K2 = (const bf16*)(ws + WS_K2) + (size_t)l * 8 * 128 * 128;
    const unsigned char* Ub = ws + WS_UB + (size_t)l * TAB_L; const unsigned char* Vb = ws + WS_VB + (size_t)l * TAB_L;
    const float* ssp = (const float*)(ws + WS_SSP); float* X = A.out; bf16* xb = (bf16*)(ws + WS_XB); float* rstd1 = (float*)(ws + WS_RSTD1);
    const float* g2 = A.in[I_N2G] + l * DM; const float* gf = A.in[I_FNG];
    LAS float* sc = (LAS float*)(lds + PE_SC); LAS float* tv = (LAS float*)(lds + PE_TV); LAS int* ti = (LAS int*)(lds + PE_TI); LAS v2u* sel = (LAS v2u*)(lds + PE_SEL);
#pragma unroll 1
    for (int item = blockIdx.x; item < NT / 32; item += G) {
        const int tok0 = item * 32;
#pragma unroll 1
        for (int pass = 0; pass < 4; ++pass) {
            { const int hh = wave >> 2, side = (wave >> 1) & 1, mt = wave & 1, h = 2 * pass + hh, fr = lane & 15, fq = lane >> 4;
                const bf16* qa = Q + (size_t)(tok0 + 16 * mt + fr) * DM + h * 256 + side * 128 + 8 * fq;
                const bf16* kb = (side ? K2 : K1) + (size_t)h * 128 * 128 + (size_t)fr * 128 + 8 * fq;
                bf16x8 af[4];
#pragma unroll
                for (int ks = 0; ks < 4; ++ks) af[ks] = *(const GAS bf16x8*)(qa + 32 * ks);
#pragma unroll
                for (int nt = 0; nt < 8; ++nt) { f32x4 acc = {0.f, 0.f, 0.f, 0.f};
#pragma unroll
                    for (int ks = 0; ks < 4; ++ks) { const bf16x8 bfr = *(const GAS bf16x8*)(kb + (size_t)nt * 16 * 128 + 32 * ks); acc = __builtin_amdgcn_mfma_f32_16x16x32_bf16(af[ks], bfr, acc, 0, 0, 0); }
                    const int rowb = (hh * 2 + side) * 32 + 16 * mt + 4 * fq;
#pragma unroll
                    for (int r = 0; r < 4; ++r) sc[(rowb + r) * SC_LD + 16 * nt + fr] = acc[r]; } }
            __syncthreads();
            if (tid < 128) { unsigned L[16];
#pragma unroll
                for (int i = 0; i < 16; ++i) L[i] = 0u;
                const LAS float* row = sc + tid * SC_LD;
#pragma unroll 4
                for (int i = 0; i < 128; ++i) { unsigned x = (f2sortable(row[i]) & ~127u) | (unsigned)i;
#pragma unroll
                    for (int s = 0; s < 16; ++s) { const unsigned hi = L[s] > x ? L[s] : x, lo = L[s] > x ? x : L[s]; L[s] = hi; x = lo; } }
#pragma unroll
                for (int s = 0; s < 16; ++s) { const int idx = (int)(L[s] & 127u); tv[tid * TL_LD + s] = row[idx]; ti[tid * TL_LD + s] = idx; } }
            __syncthreads();
            if (tid < 64) { const int hh = tid >> 5, tk = tid & 31, r1 = (hh * 2) * 32 + tk, r2 = (hh * 2 + 1) * 32 + tk, h = 2 * pass + hh;
                float LV[16]; int LI[16];
#pragma unroll
                for (int s = 0; s < 16; ++s) { LV[s] = -3.0e38f; LI[s] = 0; }
#pragma unroll 1
                for (int a = 0; a < 16; ++a) { const float va = tv[r1 * TL_LD + a]; const int ia = ti[r1 * TL_LD + a] * 128; const int nb = 16 / (a + 1);
#pragma unroll 1
                    for (int bb = 0; bb < nb; ++bb) { float x = va + tv[r2 * TL_LD + bb]; int xi = ia + ti[r2 * TL_LD + bb];
#pragma unroll
                        for (int s = 0; s < 16; ++s) { const bool gt = x > LV[s]; const float tvv = gt ? x : LV[s]; const int tii = gt ? xi : LI[s]; x = gt ? LV[s] : x; xi = gt ? LI[s] : xi; LV[s] = tvv; LI[s] = tii; } } }
                float den = 0.f, e[16];
#pragma unroll
                for (int s = 0; s < 16; ++s) { e[s] = __expf(LV[s] - LV[0]); den += e[s]; }
                const float inv = 1.0f / den;
#pragma unroll
                for (int s = 0; s < 16; ++s) { v2u w; w.x = (unsigned)LI[s]; w.y = __builtin_bit_cast(unsigned, e[s] * inv); sel[(tk * 8 + h) * 16 + s] = w; } }
            __syncthreads();
        }
#pragma unroll 1
        for (int tt = 0; tt < 4; ++tt) {
            const int tl = wave * 4 + tt; const size_t t = (size_t)tok0 + tl;
            float s2 = (lane < 32) ? ssp[t * 32 + lane] : 0.f; s2 = wave_sum(s2);
            const float rstd2 = rsqrtf(s2 * (1.0f / DM) + RMS_EPS);
            v4u hb[4];
#pragma unroll
            for (int j = 0; j < 4; ++j) { const size_t e0 = 8 * (size_t)(lane + 64 * j);
                const f32x4 xa = *(const GAS f32x4*)(X + t * DM + e0), xc = *(const GAS f32x4*)(X + t * DM + e0 + 4);
                const f32x4 ga = *(const GAS f32x4*)(g2 + e0), gc = *(const GAS f32x4*)(g2 + e0 + 4);
                hb[j].x = pk2(xa[0] * rstd2 * ga[0], xa[1] * rstd2 * ga[1]); hb[j].y = pk2(xa[2] * rstd2 * ga[2], xa[3] * rstd2 * ga[3]);
                hb[j].z = pk2(xc[0] * rstd2 * gc[0], xc[1] * rstd2 * gc[1]); hb[j].w = pk2(xc[2] * rstd2 * gc[2], xc[3] * rstd2 * gc[3]); }
            float y[32];
#pragma unroll
            for (int i = 0; i < 32; ++i) y[i] = 0.f;
#pragma unroll 1
            for (int g = 0; g < 32; ++g) {
                int ids[4]; float gts[4];
#pragma unroll
                for (int e = 0; e < 4; ++e) { const v2u w = sel[tl * 128 + g * 4 + e]; ids[e] = __builtin_amdgcn_readfirstlane((int)w.x); gts[e] = __builtin_bit_cast(float, __builtin_amdgcn_readfirstlane((int)w.y)); }
                const unsigned lo16 = (unsigned)lane * 16u;
                v4u uu[4][4];
#pragma unroll
                for (int e = 0; e < 4; ++e) { const GAS unsigned char* rb = (const GAS unsigned char*)Ub + (size_t)ids[e] * 4096;
#pragma unroll
                    for (int j = 0; j < 4; ++j) uu[e][j] = *(const GAS v4u*)(rb + lo16 + j * 1024); }
                float cf[4];
#pragma unroll
                for (int e = 0; e < 4; ++e) { float d = 0.f;
#pragma unroll
                    for (int j = 0; j < 4; ++j) {
                        d = dot2bf(uu[e][j].x, hb[j].x, d);
                        d = dot2bf(uu[e][j].y, hb[j].y, d);
                        d = dot2bf(uu[e][j].z, hb[j].z, d);
                        d = dot2bf(uu[e][j].w, hb[j].w, d); }
                    d = wave_sum(d); cf[e] = gts[e] * gelu_tanh(d); }
                v4u vv[4][4];
#pragma unroll
                for (int e = 0; e < 4; ++e) { const GAS unsigned char* rb = (const GAS unsigned char*)Vb + (size_t)ids[e] * 4096;
#pragma unroll
                    for (int j = 0; j < 4; ++j) vv[e][j] = *(const GAS v4u*)(rb + lo16 + j * 1024); }
#pragma unroll
                for (int e = 0; e < 4; ++e)
#pragma unroll
                    for (int j = 0; j < 4; ++j) { const v4u w = vv[e][j]; const float c = cf[e];
                        y[j * 8 + 0] += c * bflo(w.x); y[j * 8 + 1] += c * bfhi(w.x); y[j * 8 + 2] += c * bflo(w.y); y[j * 8 + 3] += c * bfhi(w.y);
                        y[j * 8 + 4] += c * bflo(w.z); y[j * 8 + 5] += c * bfhi(w.z); y[j * 8 + 6] += c * bflo(w.w); y[j * 8 + 7] += c * bfhi(w.w); }
            }
            float ss = 0.f;
#pragma unroll
            for (int j = 0; j < 4; ++j) { const size_t e0 = 8 * (size_t)(lane + 64 * j);
                const f32x4 xa = *(const GAS f32x4*)(X + t * DM + e0), xc = *(const GAS f32x4*)(X + t * DM + e0 + 4);
#pragma unroll
                for (int k = 0; k < 4; ++k) { y[j * 8 + k] += xa[k]; y[j * 8 + 4 + k] += xc[k]; }
#pragma unroll
                for (int k = 0; k < 8; ++k) ss += y[j * 8 + k] * y[j * 8 + k]; }
            ss = wave_sum(ss);
            const float rs = rsqrtf(ss * (1.0f / DM) + RMS_EPS);
            if (last) {
#pragma unroll
                for (int j = 0; j < 4; ++j) { const size_t e0 = 8 * (size_t)(lane + 64 * j);
                    const f32x4 ga = *(const GAS f32x4*)(gf + e0), gc = *(const GAS f32x4*)(gf + e0 + 4);
                    f32x4 oa = {y[j * 8 + 0] * rs * ga[0], y[j * 8 + 1] * rs * ga[1], y[j * 8 + 2] * rs * ga[2], y[j * 8 + 3] * rs * ga[3]};
                    f32x4 oc = {y[j * 8 + 4] * rs * gc[0], y[j * 8 + 5] * rs * gc[1], y[j * 8 + 6] * rs * gc[2], y[j * 8 + 7] * rs * gc[3]};
                    *(GAS f32x4*)(X + t * DM + e0) = oa; *(GAS f32x4*)(X + t * DM + e0 + 4) = oc; }
            } else {
#pragma unroll
                for (int j = 0; j < 4; ++j) { const size_t e0 = 8 * (size_t)(lane + 64 * j);
                    f32x4 oa = {y[j * 8 + 0], y[j * 8 + 1], y[j * 8 + 2], y[j * 8 + 3]}, oc = {y[j * 8 + 4], y[j * 8 + 5], y[j * 8 + 6], y[j * 8 + 7]};
                    *(GAS f32x4*)(X + t * DM + e0) = oa; *(GAS f32x4*)(X + t * DM + e0 + 4) = oc;
                    v4u w; w.x = pk2(oa[0], oa[1]); w.y = pk2(oa[2], oa[3]); w.z = pk2(oc[0], oc[1]); w.w = pk2(oc[2], oc[3]);
                    *(GAS v4u*)(xb + t * DM + e0) = w; }
                if (lane == 0) rstd1[t] = rs;
            }
        }
        __syncthreads();
    }
}

#ifndef MK_PER_PHASE
#define MK_PER_PHASE 0
#endif
constexpr int NPHASE = 1 + 5 * DEPTH;
constexpr int CW_BAR = 4096;

__global__ void __launch_bounds__(NTHREADS, 2) mk_fwd(Args args) {
    extern __shared__ __attribute__((aligned(16))) unsigned char lds_raw[];
    LAS unsigned char* lds = (LAS unsigned char*)lds_raw;
    volatile LAS unsigned* MISC = (volatile LAS unsigned*)(lds + MISC_OFF);
    const int tid = threadIdx.x, lane = tid & 63, wave = __builtin_amdgcn_readfirstlane(tid >> 6);
    const int G = gridDim.x; const int bx = blockIdx.x; const int vcu = (G % 8 == 0) ? (bx % 8) * (G / 8) + bx / 8 : bx;
    unsigned char* ws = args.ws;
    if (tid < 64) MISC[tid] = 0u;
    __syncthreads();
    XcdBarrier bar; bar.bar = (unsigned*)(ws + WS_CTL) + CW_BAR; bar.x = 0; bar.st = nullptr;
    if (!MK_PER_PHASE) bar = xcd_barrier_post((unsigned*)(ws + WS_CTL) + CW_BAR, MISC + 8);
    const int lo = args.ph_lo, hi = args.ph_hi;
#define IN(k) (lo <= (k) && (k) < hi)
#define SEAM(k) do { if (IN(k) && IN((k) + 1)) xcd_barrier(bar); } while (0)

    if (IN(0)) { const int t0 = pg8::fresh_tid(); p0_prologue(args, lds, vcu, G, __builtin_amdgcn_readfirstlane(t0 >> 6), t0 & 63); SEAM(0); }
#pragma unroll 1
    for (int l = 0; l < DEPTH; ++l) {
        const int pb = 1 + 5 * l;
        if (IN(pb)) {
            pg8::Gemm g{(const pg8::bf16_t*)(ws + WS_XB), (const pg8::bf16_t*)(ws + WS_WIN + l * WIN_L), NT, NINP, DM}; pg8::StaticOrder S; S.init(NT, NINP, G, bx);
            pg8::EpiP E{(pg8::bf16_t*)(ws + WS_P), (float*)(ws + WS_PS), (const float*)(ws + WS_RSTD1)};
            pg8::gemm_phase<pg8::EpiP, pg8::StaticOrder, true, true>(lds, g, S, E);
            SEAM(pb);
        }
        if (IN(pb + 1)) { nm_phase(args, l, lds, G, pg8::fresh_tid()); SEAM(pb + 1); }
        if (IN(pb + 2)) {
            pg8::Gemm g{(const pg8::bf16_t*)(ws + WS_MIX), (const pg8::bf16_t*)(ws + WS_WOUT + l * WSQ_L), NT, DM, DM}; pg8::StaticOrder S; S.init(NT, DM, G, bx);
            pg8::EpiX E{l == 0 ? args.in[I_X] : (const float*)args.out, args.out, (pg8::bf16_t*)(ws + WS_XB), (float*)(ws + WS_SSP)};
            pg8::gemm_phase<pg8::EpiX, pg8::StaticOrder, true, true>(lds, g, S, E);
            SEAM(pb + 2);
        }
        if (IN(pb + 3)) {
            pg8::Gemm g{(const pg8::bf16_t*)(ws + WS_XB), (const pg8::bf16_t*)(ws + WS_WQ + l * WSQ_L), NT, DM, DM}; pg8::StaticOrder S; S.init(NT, DM, G, bx);
            pg8::EpiQ E{(pg8::bf16_t*)(ws + WS_Q), (const float*)(ws + WS_SSP)};
            pg8::gemm_phase<pg8::EpiQ, pg8::StaticOrder, true, true>(lds, g, S, E);
            SEAM(pb + 3);
        }
        if (IN(pb + 4)) { peer_phase(args, l, l == DEPTH - 1, lds, G, pg8::fresh_tid()); SEAM(pb + 4); }
    }
#undef IN
#undef SEAM
}

extern "C" void kernel_launch(void* const* d_in, const int* in_sizes, int n_in, void* d_out, int out_size, void* d_ws, size_t ws_size, hipStream_t stream) {
    static int grid = 0;
    if (grid == 0) {
        if (n_in != N_IN || out_size != NT * DM || ws_size < WS_END) { fprintf(stderr, "kernel_launch: unexpected shapes: n_in %d out %d ws %zu (need %zu)\n", n_in, out_size, ws_size, (size_t)WS_END); grid = -1; return; }
        int dev = 0, cus = 0, per_cu = 0;
        if (hipGetDevice(&dev) != hipSuccess || hipDeviceGetAttribute(&cus, hipDeviceAttributeMultiprocessorCount, dev) != hipSuccess) { grid = -1; return; }
        if (hipFuncSetAttribute((const void*)mk_fwd, hipFuncAttributeMaxDynamicSharedMemorySize, LDS_BYTES) != hipSuccess) { fprintf(stderr, "kernel_launch: hipFuncSetAttribute failed\n"); grid = -1; return; }
        if (hipOccupancyMaxActiveBlocksPerMultiprocessor(&per_cu, (const void*)mk_fwd, NTHREADS, LDS_BYTES) != hipSuccess || per_cu < 1) { fprintf(stderr, "kernel_launch: occupancy query says %d blocks per CU\n", per_cu); (void)hipGetLastError(); grid = -1; return; }
        grid = cus;
    }
    if (grid < 0) return;
    if (hipMemsetAsync((char*)d_ws + WS_CTL, 0, CTL_ZERO_BYTES, stream) != hipSuccess) return;
    Args a{};
    for (int i = 0; i < N_IN; ++i) a.in[i] = (const float*)d_in[i];
    a.out = (float*)d_out; a.ws = (unsigned char*)d_ws;
#if MK_PER_PHASE
    for (int p = 0; p < NPHASE; ++p) { a.ph_lo = p; a.ph_hi = p + 1; a.li = 0; hipLaunchKernelGGL(mk_fwd, dim3(grid), dim3(NTHREADS), LDS_BYTES, stream, a); }
#else
    a.ph_lo = 0; a.ph_hi = NPHASE; a.li = 0;
    hipLaunchKernelGGL(mk_fwd, dim3(grid), dim3(NTHREADS), LDS_BYTES, stream, a);
#endif
}
```

```cpp
#include <hip/hip_runtime.h>
#include <cstdio>
#include <cstdint>
#define MK_PER_PHASE 0
namespace pg8 {
__device__ __forceinline__ int fresh_tid() { int t = threadIdx.x; asm volatile("" : "+v"(t)); return t; }
#define PG8_LAS __attribute__((address_space(3)))
typedef unsigned short bf16_t;
typedef short bf16x8 __attribute__((ext_vector_type(8)));
typedef float f32x4 __attribute__((ext_vector_type(4)));
typedef unsigned u32x4 __attribute__((ext_vector_type(4)));
constexpr int BM = 256, BK = 64, HALF = 128, HTB = HALF * BK * 2  , STAGE_BYTES = 8 * HTB, NXCD = 8, WGM = 8;

__host__ __device__ __forceinline__ int lds_byte(int r, int c) { const int st = (r >> 4) * 2 + (c >> 5), rr = r & 15, cc = c & 31, ob = rr * 64 + cc * 2; return st * 1024 + (ob ^ (((ob >> 9) & 1) << 5)); }
__host__ __device__ __forceinline__ void stage_rc(int b, int& R, int& C) { const int st = b / 1024, sb = b % 1024, swz = sb ^ (((sb >> 9) & 1) << 5); R = (st >> 1) * 16 + swz / 64; C = (st & 1) * 32 + (swz % 64) / 2; }
__host__ __device__ __forceinline__ int perm32(int rho) { const int n = rho >> 4, i = rho & 15; return 8 * (i >> 2) + 4 * n + (i & 3); }

struct Unit { int pm, pn; };
struct Gemm { const bf16_t* A; const bf16_t* Bt; int M, N, K; };

struct StaticOrder {
    int nM, nN, nwg, G, c;
    __host__ __device__ void init(int M, int N, int G_, int c_) { nM = M / BM; nN = N / BM; nwg = nM * nN; G = G_; c = c_; }
    __host__ __device__ bool next(int i, Unit& u) const {
        const long L = (long)i * G + c; if (L >= nwg) return false;
        int wgid = (int)L; { const int q = nwg / NXCD, r = nwg % NXCD, xcd = wgid % NXCD, off = wgid / NXCD; wgid = (xcd < r ? xcd * (q + 1) : r * (q + 1) + (xcd - r) * q) + off; }
        const int nig = WGM * nN, gid = wgid / nig, fm = gid * WGM, gsz = (nM - fm) < WGM ? (nM - fm) : WGM;
        u.pm = fm + ((wgid % nig) % gsz); u.pn = (wgid % nig) / gsz; return true;
    }
    __device__ __forceinline__ void a_ready(const Unit&) const {}
    __device__ __forceinline__ void done(const Unit&) const {}
};


__device__ __forceinline__ unsigned cvt_pk_bf16(float lo, float hi) { unsigned r; asm volatile("v_cvt_pk_bf16_f32 %0, %1, %2" : "=v"(r) : "v"(lo), "v"(hi)); return r; }

struct EpiP {
    static constexpr bool PERM = true, AFTER_DRAIN = false;
    bf16_t* P; float* Ps; const float* rstd;
    __device__ __forceinline__ void operator()(const f32x4 (&acc)[2][2][4][2], const Unit& u, int wr, int wc, int fr, int fq) const {
        const int row0 = u.pm * BM + wr * 64 + fr;
        if (u.pn < 28) {
            const int col0 = u.pn * BM + wc * 32 + 8 * fq;
#pragma unroll
            for (int ai = 0; ai < 2; ++ai)
#pragma unroll
                for (int m = 0; m < 4; ++m) { const int row = row0 + ai * HALF + m * 16; const float r = rstd[row]; bf16_t* rowp = P + (size_t)row * 7168 + col0;
#pragma unroll
                    for (int bj = 0; bj < 2; ++bj) { const f32x4 v0 = acc[ai][bj][m][0] * r, v1 = acc[ai][bj][m][1] * r;
                        u32x4 w; w.x = cvt_pk_bf16(v0[0], v0[1]); w.y = cvt_pk_bf16(v0[2], v0[3]); w.z = cvt_pk_bf16(v1[0], v1[1]); w.w = cvt_pk_bf16(v1[2], v1[3]);
                        *(u32x4*)(rowp + bj * HALF) = w; } }
        } else if (wc == 0) {
#pragma unroll
            for (int ai = 0; ai < 2; ++ai)
#pragma unroll
                for (int m = 0; m < 4; ++m) { const int row = row0 + ai * HALF + m * 16; const float r = rstd[row]; float* p = Ps + (size_t)row * 32 + 8 * fq;
                    *(f32x4*)p = acc[ai][0][m][0] * r; *(f32x4*)(p + 4) = acc[ai][0][m][1] * r; }
        }
    }
};
struct EpiX {
    static constexpr bool PERM = true, AFTER_DRAIN = false;
    const float* xres; float* xout; bf16_t* xb; float* ssp;
    __device__ __forceinline__ void operator()(const f32x4 (&acc)[2][2][4][2], const Unit& u, int wr, int wc, int fr, int fq) const {
        const int row0 = u.pm * BM + wr * 64 + fr, col0 = u.pn * BM + wc * 32 + 8 * fq;
#pragma unroll
        for (int ai = 0; ai < 2; ++ai)
#pragma unroll
            for (int m = 0; m < 4; ++m) { const int row = row0 + ai * HALF + m * 16; float ss = 0.f;
#pragma unroll
                for (int bj = 0; bj < 2; ++bj) { const size_t off = (size_t)row * 2048 + col0 + bj * HALF;
                    const f32x4 r0 = *(const f32x4*)(xres + off), r1 = *(const f32x4*)(xres + off + 4);
                    const f32x4 v0 = acc[ai][bj][m][0] + r0, v1 = acc[ai][bj][m][1] + r1;
                    *(f32x4*)(xout + off) = v0; *(f32x4*)(xout + off + 4) = v1;
                    u32x4 w; w.x = cvt_pk_bf16(v0[0], v0[1]); w.y = cvt_pk_bf16(v0[2], v0[3]); w.z = cvt_pk_bf16(v1[0], v1[1]); w.w = cvt_pk_bf16(v1[2], v1[3]);
                    *(u32x4*)(xb + off) = w;
                    ss += (v0[0] * v0[0] + v0[1] * v0[1]) + (v0[2] * v0[2] + v0[3] * v0[3]) + (v1[0] * v1[0] + v1[1] * v1[1]) + (v1[2] * v1[2] + v1[3] * v1[3]); }
                ss += __shfl_xor(ss, 16); ss += __shfl_xor(ss, 32);
                if (fq == 0) ssp[(size_t)row * 32 + u.pn * 4 + wc] = ss; }
    }
};
struct EpiQ {
    static constexpr bool PERM = true, AFTER_DRAIN = false;
    bf16_t* Q; const float* ssp;
    __device__ __forceinline__ void operator()(const f32x4 (&acc)[2][2][4][2], const Unit& u, int wr, int wc, int fr, int fq) const {
        const int row0 = u.pm * BM + wr * 64 + fr, col0 = u.pn * BM + wc * 32 + 8 * fq;
#pragma unroll
        for (int ai = 0; ai < 2; ++ai)
#pragma unroll
            for (int m = 0; m < 4; ++m) { const int row = row0 + ai * HALF + m * 16;
                const f32x4* sp = (const f32x4*)(ssp + (size_t)row * 32 + 8 * fq); const f32x4 a = sp[0], b = sp[1];
                float s = ((a[0] + a[1]) + (a[2] + a[3])) + ((b[0] + b[1]) + (b[2] + b[3]));
                s += __shfl_xor(s, 16); s += __shfl_xor(s, 32);
                const float r = rsqrtf(s * (1.0f / 2048.0f) + 1e-6f); bf16_t* rowp = Q + (size_t)row * 2048 + col0;
#pragma unroll
                for (int bj = 0; bj < 2; ++bj) { const f32x4 v0 = acc[ai][bj][m][0] * r, v1 = acc[ai][bj][m][1] * r;
                    u32x4 w; w.x = cvt_pk_bf16(v0[0], v0[1]); w.y = cvt_pk_bf16(v0[2], v0[3]); w.z = cvt_pk_bf16(v1[0], v1[1]); w.w = cvt_pk_bf16(v1[2], v1[3]);
                    *(u32x4*)(rowp + bj * HALF) = w; } }
    }
};

template <class Epi, class Sched, bool ALIGN_EPI = false, bool SP2 = false>
__device__ __forceinline__ void gemm_phase(PG8_LAS unsigned char* lds, const Gemm g, const Sched& S, const Epi& E) {
    const int tid = fresh_tid(), wid = __builtin_amdgcn_readfirstlane(tid >> 6), lane = tid & 63, wr = wid >> 2, wc = wid & 3, fr = lane & 15, fq = lane >> 4;
    const int K = g.K, nt = K / BK;
    unsigned voffA[2], voffB[2];
#pragma unroll
    for (int i = 0; i < 2; ++i) { int R, C; stage_rc(tid * 16 + i * 8192, R, C); const int Rb = Epi::PERM ? ((R & ~31) + perm32(R & 31)) : R;
        voffA[i] = (unsigned)(R * K + C) * 2u; voffB[i] = (unsigned)(Rb * K + C) * 2u; }
    const size_t kstep = (size_t)(BK * 2);
    const size_t hstep = (size_t)HALF * K * 2;
    const size_t tstep = 2 * hstep;
    const unsigned ldsw = (unsigned)wid * 1024u;
    const int aoff = lds_byte(wr * 64 + fr, fq * 8), boff = lds_byte(wc * 32 + fr, fq * 8);
#define PG8_SA(b, h) (((b) * 2 + (h)) * HTB)
#define PG8_SB(b, h) ((4 + (b) * 2 + (h)) * HTB)
#define PG8_STAGE(bufoff, gbase, voff) do { _Pragma("unroll") for (int _i = 0; _i < 2; ++_i) \
        __builtin_amdgcn_global_load_lds((const unsigned*)((const char*)(gbase) + (voff)[_i]), (PG8_LAS unsigned*)(lds + (bufoff) + ldsw + _i * 8192), 16, 0, 0); } while (0)
#define PG8_LDA(dst, b, h) do { _Pragma("unroll") for (int m = 0; m < 4; ++m) _Pragma("unroll") for (int k = 0; k < 2; ++k) dst[m][k] = *(const PG8_LAS bf16x8*)(lds + PG8_SA(b, h) + aoff + m * 2048 + k * 1024); } while (0)
#define PG8_LDB(dst, b, h) do { _Pragma("unroll") for (int n = 0; n < 2; ++n) _Pragma("unroll") for (int k = 0; k < 2; ++k) dst[n][k] = *(const PG8_LAS bf16x8*)(lds + PG8_SB(b, h) + boff + n * 2048 + k * 1024); } while (0)
#define PG8_MMA(ai, bj, At, Bt) do { __builtin_amdgcn_s_setprio(1); _Pragma("unroll") for (int m = 0; m < 4; ++m) _Pragma("unroll") for (int n = 0; n < 2; ++n) _Pragma("unroll") for (int k = 0; k < 2; ++k) \
        acc[ai][bj][m][n] = __builtin_amdgcn_mfma_f32_16x16x32_bf16(Bt[n][k], At[m][k], acc[ai][bj][m][n], 0, 0, 0); __builtin_amdgcn_s_setprio(0); } while (0)
#define PG8_WAIT_V(n) asm volatile("s_waitcnt vmcnt(" #n ")" ::: "memory")
#define PG8_WAIT_L(n) asm volatile("s_waitcnt lgkmcnt(" #n ")" ::: "memory")
#define PG8_BAR __builtin_amdgcn_s_barrier()
#define PG8_SCHED __builtin_amdgcn_sched_barrier(0)
    Unit cur, nxt; int ui = 0;
    if (!S.next(0, cur)) return;
    f32x4 acc[2][2][4][2];
#pragma unroll
    for (int a = 0; a < 2; ++a)
#pragma unroll
        for (int b = 0; b < 2; ++b)
#pragma unroll
            for (int m = 0; m < 4; ++m)
#pragma unroll
                for (int n = 0; n < 2; ++n) acc[a][b][m][n] = (f32x4){0.f, 0.f, 0.f, 0.f};
    bf16x8 At[4][2], B0[2][2], B1[2][2];
    const char* cA = (const char*)g.A + (size_t)cur.pm * tstep; const char* cB = (const char*)g.Bt + (size_t)cur.pn * tstep;
    S.a_ready(cur);
    if constexpr (SP2) {
        PG8_STAGE(PG8_SB(0, 0), cB, voffB); PG8_STAGE(PG8_SB(0, 1), cB + hstep, voffB); PG8_STAGE(PG8_SA(0, 0), cA, voffA); PG8_STAGE(PG8_SA(0, 1), cA + hstep, voffA);
        if (wr == 1) PG8_BAR;
        PG8_WAIT_V(2); PG8_BAR;
        PG8_STAGE(PG8_SB(1, 0), cB + kstep, voffB); PG8_STAGE(PG8_SA(1, 0), cA + kstep, voffA); PG8_STAGE(PG8_SB(1, 1), cB + hstep + kstep, voffB);
        PG8_WAIT_V(6); PG8_BAR;
    } else {
        PG8_STAGE(PG8_SB(0, 0), cB, voffB); PG8_STAGE(PG8_SA(0, 0), cA, voffA); PG8_STAGE(PG8_SB(0, 1), cB + hstep, voffB); PG8_STAGE(PG8_SA(0, 1), cA + hstep, voffA);
        if (wr == 1) PG8_BAR;
        PG8_WAIT_V(4); PG8_BAR;
        PG8_STAGE(PG8_SB(1, 0), cB + kstep, voffB); PG8_STAGE(PG8_SA(1, 0), cA + kstep, voffA); PG8_STAGE(PG8_SB(1, 1), cB + hstep + kstep, voffB);
        PG8_WAIT_V(6); PG8_BAR;
    }
    for (;;) {
        const bool has_next = S.next(ui + 1, nxt);
        const char* nA = has_next ? (const char*)g.A + (size_t)nxt.pm * tstep : cA; const char* nB = has_next ? (const char*)g.Bt + (size_t)nxt.pn * tstep : cB;
        for (int t = 0; t < nt; t += 2) {
            const bool last = (t == nt - 2);
            const char* a1 = cA + (size_t)(t + 1) * kstep;
            const char* a2 = last ? nA : cA + (size_t)(t + 2) * kstep; const char* b2 = last ? nB : cB + (size_t)(t + 2) * kstep;
            const char* a3 = a2 + kstep; const char* b3 = b2 + kstep;
            if (last && has_next) S.a_ready(nxt);
            if constexpr (SP2) {
            PG8_LDB(B0, 0, 0); PG8_LDB(B1, 0, 1); PG8_SCHED; PG8_LDA(At, 0, 0); PG8_STAGE(PG8_SA(1, 1), a1 + hstep, voffA);
            PG8_WAIT_V(8); PG8_WAIT_L(0); PG8_BAR; PG8_MMA(0, 0, At, B0); PG8_MMA(0, 1, At, B1); PG8_BAR; PG8_SCHED;
            PG8_LDA(At, 0, 1); PG8_STAGE(PG8_SB(0, 0), b2, voffB); PG8_STAGE(PG8_SB(0, 1), b2 + hstep, voffB); PG8_STAGE(PG8_SA(0, 0), a2, voffA);
            PG8_WAIT_V(8); PG8_WAIT_L(0); PG8_BAR; PG8_MMA(1, 0, At, B0); PG8_MMA(1, 1, At, B1); PG8_BAR; PG8_SCHED;
            PG8_LDB(B0, 1, 0); PG8_LDB(B1, 1, 1); PG8_SCHED; PG8_LDA(At, 1, 0); PG8_STAGE(PG8_SA(0, 1), a2 + hstep, voffA);
            PG8_WAIT_V(8); PG8_WAIT_L(0); PG8_BAR; PG8_MMA(0, 0, At, B0); PG8_MMA(0, 1, At, B1); PG8_BAR; PG8_SCHED;
            PG8_LDA(At, 1, 1); PG8_STAGE(PG8_SB(1, 0), b3, voffB); PG8_STAGE(PG8_SB(1, 1), b3 + hstep, voffB); PG8_STAGE(PG8_SA(1, 0), a3, voffA);
            PG8_WAIT_V(8); PG8_WAIT_L(0); PG8_BAR; PG8_MMA(1, 0, At, B0); PG8_MMA(1, 1, At, B1); PG8_BAR; PG8_SCHED;
            } else {
            PG8_LDB(B0, 0, 0); PG8_SCHED; PG8_LDA(At, 0, 0); PG8_STAGE(PG8_SA(1, 1), a1 + hstep, voffA);
            PG8_WAIT_L(8); PG8_BAR; PG8_WAIT_L(0); PG8_MMA(0, 0, At, B0); PG8_BAR; PG8_SCHED;
            PG8_LDB(B1, 0, 1); PG8_STAGE(PG8_SB(0, 0), b2, voffB);
            PG8_BAR; PG8_WAIT_L(0); PG8_MMA(0, 1, At, B1); PG8_BAR;
            PG8_LDA(At, 0, 1); PG8_STAGE(PG8_SA(0, 0), a2, voffA);
            PG8_BAR; PG8_WAIT_L(0); PG8_MMA(1, 0, At, B0); PG8_BAR; PG8_SCHED;
            PG8_STAGE(PG8_SB(0, 1), b2 + hstep, voffB);
            PG8_WAIT_V(6); PG8_BAR; PG8_MMA(1, 1, At, B1); PG8_BAR;
            PG8_LDB(B0, 1, 0); PG8_SCHED; PG8_LDA(At, 1, 0); PG8_STAGE(PG8_SA(0, 1), a2 + hstep, voffA);
            PG8_WAIT_L(8); PG8_BAR; PG8_WAIT_L(0); PG8_MMA(0, 0, At, B0); PG8_BAR; PG8_SCHED;
            PG8_LDB(B1, 1, 1); PG8_STAGE(PG8_SB(1, 0), b3, voffB);
            PG8_BAR; PG8_WAIT_L(0); PG8_MMA(0, 1, At, B1); PG8_BAR;
            PG8_LDA(At, 1, 1); PG8_STAGE(PG8_SA(1, 0), a3, voffA);
            PG8_BAR; PG8_WAIT_L(0); PG8_MMA(1, 0, At, B0); PG8_BAR; PG8_SCHED;
            PG8_STAGE(PG8_SB(1, 1), b3 + hstep, voffB);
            PG8_WAIT_V(6); PG8_BAR; PG8_MMA(1, 1, At, B1); PG8_BAR;
            }
        }
        if constexpr (ALIGN_EPI) { if (wr == 0) PG8_BAR; }
        if constexpr (!Epi::AFTER_DRAIN) { E(acc, cur, wr, wc, fr, fq); S.done(cur); }
        if (!has_next) break;
#pragma unroll
        for (int a = 0; a < 2; ++a)
#pragma unroll
            for (int b = 0; b < 2; ++b)
#pragma unroll
                for (int m = 0; m < 4; ++m)
#pragma unroll
                    for (int n = 0; n < 2; ++n) acc[a][b][m][n] = (f32x4){0.f, 0.f, 0.f, 0.f};
        cur = nxt; cA = nA; cB = nB; ++ui;
        if constexpr (ALIGN_EPI) { if (wr == 1) PG8_BAR; }
    }
    PG8_WAIT_V(0);
    if constexpr (!ALIGN_EPI) { if (wr == 0) PG8_BAR; }
    PG8_BAR;
    if constexpr (Epi::AFTER_DRAIN) { E.fused(acc, cur, wr, wc, fr, fq, lds, wid, lane); S.done(cur); }
#undef PG8_SA
#undef PG8_SB
#undef PG8_STAGE
#undef PG8_LDA
#undef PG8_LDB
#undef PG8_MMA
#undef PG8_WAIT_V
#undef PG8_WAIT_L
#undef PG8_BAR
#undef PG8_SCHED
}
}

constexpr int NWAVES = 8, NTHREADS = 512;
constexpr int NT = 8192, DM = 2048, SEQ = 2048, NBATCH = 4, DEPTH = 2, CHK = 64, NCHK = 32, GW = 512, NH = 4, HD = 128;
constexpr int DIN = 7200, NINP = 7424, PBW = 7168;
constexpr int NEXP = 16384;
constexpr int PC_GLA_Q = 0, PC_GLA_K = 512, PC_GLA_V = 1024, PC_GLA_G = 1536, PC_LRU_X = 2048, PC_LRU_Y = 2560, PC_ML_Q = 3072, PC_ML_K = 3584, PC_ML_V = 4096, PC_ML_O = 4608,
              PC_GDN_Q = 5120, PC_GDN_K = 5632, PC_GDN_V = 6144, PC_GDN_G = 6656;
constexpr int PS_LR = 0, PS_MI = 16, PS_MF = 20, PS_GB = 24, PS_GA = 28;
constexpr float RMS_EPS = 1e-6f;
enum { I_X = 0, I_N1G, I_WIN, I_WOUT, I_GLA_W2, I_GLA_B2, I_GLA_NG, I_LRU_CW, I_LRU_CB, I_LRU_WA, I_LRU_BA, I_LRU_WX, I_LRU_BX, I_LRU_LAM, I_ML_IB, I_ML_FB, I_ML_NG,
       I_GDN_CW, I_GDN_ALOG, I_GDN_DTB, I_GDN_NG, I_N2G, I_PWQ, I_PK1, I_PK2, I_PU, I_PV, I_FNG, N_IN };

constexpr size_t MiB = 1u << 20;
constexpr size_t WS_CTL = 0, CTL_ZERO_BYTES = 1 * MiB;
constexpr size_t WS_WIN = 2 * MiB;
constexpr size_t WIN_L = (size_t)NINP * DM * 2;
constexpr size_t WS_WOUT = 60 * MiB;
constexpr size_t WS_WQ = 76 * MiB;
constexpr size_t WSQ_L = (size_t)DM * DM * 2;
constexpr size_t WS_K1 = 92 * MiB, WS_K2 = 92 * MiB + 512 * 1024;
constexpr size_t WS_RSTD1 = 93 * MiB;
constexpr size_t WS_SSP = 94 * MiB;
constexpr size_t WS_XB = 96 * MiB;
constexpr size_t WS_P = 128 * MiB;
constexpr size_t WS_PS = 240 * MiB;
constexpr size_t WS_MIX = 242 * MiB;
constexpr size_t WS_Q = 274 * MiB;
constexpr size_t WS_UB = 306 * MiB;
constexpr size_t WS_VB = 434 * MiB;
constexpr size_t TAB_L = (size_t)NEXP * DM * 2;
constexpr size_t WS_SCR = 562 * MiB;
constexpr size_t WS_END = 900 * MiB;

constexpr int LDS_BYTES = 155648;
constexpr int MISC_OFF = LDS_BYTES - 256;

#define GAS __attribute__((address_space(1)))
#define LAS __attribute__((address_space(3)))
typedef unsigned short bf16;
typedef unsigned v4u __attribute__((ext_vector_type(4)));
typedef unsigned v2u __attribute__((ext_vector_type(2)));
typedef float f32x4 __attribute__((ext_vector_type(4)));
typedef float f32x2 __attribute__((ext_vector_type(2)));
typedef short bf16x8 __attribute__((ext_vector_type(8)));
typedef short bf16x4 __attribute__((ext_vector_type(4)));
typedef __bf16 bf2_t __attribute__((ext_vector_type(2)));
typedef GAS unsigned gu32;
#define RLX_AGENT __ATOMIC_RELAXED, __HIP_MEMORY_SCOPE_AGENT
__device__ __forceinline__ unsigned f2bf(float f) { unsigned u = __builtin_bit_cast(unsigned, f); return (u + 0x7fffu + ((u >> 16) & 1u)) >> 16; }
__device__ __forceinline__ unsigned pk2(float lo, float hi) { return f2bf(lo) | (f2bf(hi) << 16); }
__device__ __forceinline__ float bf2f(unsigned b) { return __builtin_bit_cast(float, b << 16); }
__device__ __forceinline__ float bflo(unsigned w) { return __builtin_bit_cast(float, w << 16); }
__device__ __forceinline__ float bfhi(unsigned w) { return __builtin_bit_cast(float, w & 0xffff0000u); }
__device__ __forceinline__ float wave_sum(float v) {
#pragma unroll
    for (int o = 1; o < 64; o <<= 1) v += __shfl_xor(v, o);
    return v;
}
__device__ __forceinline__ float sigmoidf_(float x) { return 1.0f / (1.0f + __expf(-x)); }
__device__ __forceinline__ float siluf_(float x) { return x / (1.0f + __expf(-x)); }
__device__ __forceinline__ float softplusf_(float x) { return fmaxf(x, 0.f) + log1pf(__expf(-fabsf(x))); }
__device__ __forceinline__ float logsigmoidf_(float x) { return -softplusf_(-x); }
__device__ __forceinline__ float gelu_tanh(float x) { const float u = 0.7978845608028654f * (x + 0.044715f * x * x * x); return 0.5f * x * (1.0f + tanhf(u)); }

#define XB_TMO      128
#define XB_XCNT(j)  (256  + 64 * (j))
#define XB_XSUB(j)  (1280 + 64 * (j))
#define XB_XGEN(j)  (2304 + 64 * (j))
#define XB_TOP      3328
#define XB_TOPGEN   3392
#define XCD_BAR_WORDS 3456
#define XB_SPIN_CAP (1u << 18)

__device__ __forceinline__ unsigned xb_ld(unsigned* p)              { return __hip_atomic_load(p, __ATOMIC_RELAXED, __HIP_MEMORY_SCOPE_AGENT); }
__device__ __forceinline__ unsigned xb_add(unsigned* p, unsigned v) { return __hip_atomic_fetch_add(p, v, __ATOMIC_RELAXED, __HIP_MEMORY_SCOPE_AGENT); }
__device__ __forceinline__ unsigned xb_xcc_id() { return (unsigned)__builtin_amdgcn_s_getreg((3 << 11) | 20) & 0xFu; }
#define XB_SPIN(cond, bar) do { unsigned _sp = 0; while (cond) { __builtin_amdgcn_s_sleep(1); \
    if ((++_sp & 255u) == 0u) { if (xb_ld(&(bar)[XB_TMO])) break; if (_sp > XB_SPIN_CAP) { atomicAdd(&(bar)[XB_TMO], 1u); break; } } } } while (0)

struct XcdBarrier {
    unsigned* bar; unsigned x;
    volatile LAS unsigned* st;
};

__device__ __forceinline__ XcdBarrier xcd_barrier_post(unsigned* bar, volatile LAS unsigned* st) {
    XcdBarrier b; b.bar = bar; b.x = xb_xcc_id(); b.st = st;
    if (threadIdx.x == 0) (void)xb_add(&bar[XB_XCNT(b.x)], 1u);
    return b;
}
__device__ __forceinline__ void xcd_barrier_complete(unsigned* bar, unsigned x, unsigned& nloc, unsigned& nx) {
    const unsigned G = gridDim.x * gridDim.y * gridDim.z;
    unsigned sum, cnt, mine, sp = 0u;
    for (;;) {
        sum = 0u; cnt = 0u; mine = 0u;
#pragma unroll
        for (unsigned j = 0; j < 16; ++j) { const unsigned c = xb_ld(&bar[XB_XCNT(j)]); sum += c; cnt += (c > 0u) ? 1u : 0u; mine = (j == x) ? c : mine; }
        if (sum == G) break;
        __builtin_amdgcn_s_sleep(1);
        if ((++sp & 255u) == 0u) { if (xb_ld(&bar[XB_TMO])) break; if (sp > XB_SPIN_CAP) { atomicAdd(&bar[XB_TMO], 1u); break; } }
    }
    nloc = mine > 0u ? mine : 1u; nx = cnt > 0u ? cnt : 1u;
}

__device__ __forceinline__ void xcd_barrier(const XcdBarrier& b) {
    asm volatile("s_waitcnt vmcnt(0)" ::: "memory");
    __syncthreads();
    if (threadIdx.x == 0) {
        unsigned* bar = b.bar;
        __builtin_amdgcn_s_waitcnt(0);
        unsigned nloc = b.st[0], nx = b.st[1];
        if (nloc == 0u) { xcd_barrier_complete(bar, b.x, nloc, nx); b.st[0] = nloc; b.st[1] = nx; }
        const unsigned old = xb_add(&bar[XB_XSUB(b.x)], 1u);
        const unsigned gen = old / nloc;
        if (old + 1u == (gen + 1u) * nloc) {
            __builtin_amdgcn_fence(__ATOMIC_RELEASE, "agent");
            asm volatile("s_waitcnt vmcnt(0)" ::: "memory");
            const unsigned og = xb_add(&bar[XB_TOP], 1u);
            const unsigned tg = og / nx;
            if (og + 1u == (tg + 1u) * nx) xb_add(&bar[XB_TOPGEN], 1u);
            else XB_SPIN(xb_ld(&bar[XB_TOPGEN]) == tg, bar);
            __builtin_amdgcn_fence(__ATOMIC_ACQUIRE, "agent");
            xb_add(&bar[XB_XGEN(b.x)], 1u);
            asm volatile("s_waitcnt vmcnt(0)" ::: "memory");
        } else {
            XB_SPIN(xb_ld(&bar[XB_XGEN(b.x)]) == gen, bar);
            __builtin_amdgcn_fence(__ATOMIC_ACQUIRE, "agent");
            asm volatile("s_waitcnt vmcnt(0)" ::: "memory");
        }
    }
    __syncthreads();
}


struct Args { const float* in[N_IN]; float* out; unsigned char* ws; int ph_lo, ph_hi, li, pad; };
typedef const __attribute__((address_space(4))) Args& ArgsR;
__device__ __forceinline__ const __attribute__((address_space(4))) Args* kargs() { unsigned long long p = (unsigned long long)__builtin_amdgcn_kernarg_segment_ptr(); asm volatile("" : "+s"(p)); return (const __attribute__((address_space(4))) Args*)p; }

__device__ __forceinline__ int win_src_col(int n) {
    if (n < 2048) return n;
    if (n < 3072) return 2064 + (n - 2048);
    if (n < 5120) return 3088 + (n - 3072);
    if (n < 7168) return 5144 + (n - 5120);
    if (n < 7184) return 2048 + (n - 7168);
    if (n < 7192) return 5136 + (n - 7184);
    if (n < 7200) return n;
    return -1;
}
template <bool MAP>
__device__ __forceinline__ void p0_transpose_item(const float* W, int K, int Nsrc, int Ndst, const float* gain, bf16* WT, LAS float* scr, int item, int lane) {
    const int nblk = Ndst / 32, kb = item / nblk, nb = item % nblk, k0 = 64 * kb, n0 = 32 * nb;
    const int nn = n0 + (lane & 31); const int src = MAP ? win_src_col(nn) : nn;
#pragma unroll 8
    for (int i = 0; i < 32; ++i) { const int kk = 2 * i + (lane >> 5); float v = 0.f; if (src >= 0) v = W[(size_t)(k0 + kk) * Nsrc + src]; if (gain) v *= gain[k0 + kk]; scr[kk * 33 + (lane & 31)] = v; }
    asm volatile("s_waitcnt lgkmcnt(0)" ::: "memory");
    const int c = lane & 7;
#pragma unroll
    for (int j = 0; j < 4; ++j) { const int n = (lane >> 3) + 8 * j; const LAS float* s = scr + (8 * c) * 33 + n;
        v4u o; o.x = pk2(s[0 * 33], s[1 * 33]); o.y = pk2(s[2 * 33], s[3 * 33]); o.z = pk2(s[4 * 33], s[5 * 33]); o.w = pk2(s[6 * 33], s[7 * 33]);
        *(GAS v4u*)(WT + (size_t)(n0 + n) * K + k0 + 8 * c) = o; }
    asm volatile("s_waitcnt lgkmcnt(0)" ::: "memory");
}
__device__ __forceinline__ void p0_convert(const float* src, bf16* dst, size_t n, size_t gtid, size_t gthreads) {
    for (size_t i = gtid * 8; i < n; i += gthreads * 8) {
        const f32x4 a = *(const GAS f32x4*)(src + i), b = *(const GAS f32x4*)(src + i + 4);
        v4u o; o.x = pk2(a[0], a[1]); o.y = pk2(a[2], a[3]); o.z = pk2(b[0], b[1]); o.w = pk2(b[2], b[3]);
        *(GAS v4u*)(dst + i) = o; }
}
__device__ __forceinline__ void p0_prologue(ArgsR A, LAS unsigned char* lds, int vcu, int G, int wave, int lane) {
    unsigned char* ws = A.ws;
    LAS float* scr = (LAS float*)(lds + wave * 16384);
    const int gw = vcu * NWAVES + wave, NGW = G * NWAVES;
    constexpr int I_IN = (DM / 64) * (NINP / 32), I_SQ = (DM / 64) * (DM / 32), I_LAYER = I_IN + 2 * I_SQ, NITEMS = DEPTH * I_LAYER;
    for (int it = gw; it < NITEMS; it += NGW) {
        const int l = it / I_LAYER; int r = it % I_LAYER;
        if (r < I_IN) { p0_transpose_item<true>(A.in[I_WIN] + (size_t)l * DM * DIN, DM, DIN, NINP, A.in[I_N1G] + l * DM, (bf16*)(ws + WS_WIN + l * WIN_L), scr, r, lane); continue; } r -= I_IN;
        if (r < I_SQ) { p0_transpose_item<false>(A.in[I_WOUT] + (size_t)l * DM * DM, DM, DM, DM, nullptr, (bf16*)(ws + WS_WOUT + l * WSQ_L), scr, r, lane); continue; } r -= I_SQ;
        p0_transpose_item<false>(A.in[I_PWQ] + (size_t)l * DM * DM, DM, DM, DM, A.in[I_N2G] + l * DM, (bf16*)(ws + WS_WQ + l * WSQ_L), scr, r, lane);
    }
    const size_t gtid = (size_t)gw * 64 + lane, gthreads = (size_t)NGW * 64;
    p0_convert(A.in[I_PU], (bf16*)(ws + WS_UB), (size_t)DEPTH * NEXP * DM, gtid, gthreads);
    p0_convert(A.in[I_PV], (bf16*)(ws + WS_VB), (size_t)DEPTH * NEXP * DM, gtid, gthreads);
    p0_convert(A.in[I_PK1], (bf16*)(ws + WS_K1), (size_t)DEPTH * 8 * 128 * 128, gtid, gthreads);
    p0_convert(A.in[I_PK2], (bf16*)(ws + WS_K2), (size_t)DEPTH * 8 * 128 * 128, gtid, gthreads);
    const float* x = A.in[I_X]; bf16* xb = (bf16*)(ws + WS_XB); float* rstd1 = (float*)(ws + WS_RSTD1);
    for (int m = gw; m < NT; m += NGW) {
        const GAS f32x4* xr = (const GAS f32x4*)(x + (size_t)m * DM) + lane;
        f32x4 v[8]; float s = 0.f;
#pragma unroll
        for (int j = 0; j < 8; ++j) { v[j] = xr[64 * j]; s += (v[j][0] * v[j][0] + v[j][1] * v[j][1]) + (v[j][2] * v[j][2] + v[j][3] * v[j][3]); }
        s = wave_sum(s);
        GAS v2u* o = (GAS v2u*)(xb + (size_t)m * DM) + lane;
#pragma unroll
        for (int j = 0; j < 8; ++j) { v2u w; w.x = pk2(v[j][0], v[j][1]); w.y = pk2(v[j][2], v[j][3]); o[64 * j] = w; }
        if (lane == 0) rstd1[m] = rsqrtf(s * (1.0f / DM) + RMS_EPS);
    }
}

constexpr int NM_Q = 0, NM_K = 32768, NM_A = 65536, NM_V = 98304, NM_PARTS = 131072  , NM_SC = 135168  ;

__device__ __forceinline__ void nm_load_tile(const bf16* g, size_t ld, LAS float* dst, int tid) {
#pragma unroll
    for (int i = 0; i < 2; ++i) { const int idx = tid + i * NTHREADS, r = idx >> 4, c8 = (idx & 15) * 8;
        const v4u w = *(const GAS v4u*)(g + (size_t)r * ld + c8);
        f32x4 a = {bflo(w.x), bfhi(w.x), bflo(w.y), bfhi(w.y)}, b = {bflo(w.z), bfhi(w.z), bflo(w.w), bfhi(w.w)};
        *(LAS f32x4*)(dst + r * 128 + c8) = a; *(LAS f32x4*)(dst + r * 128 + c8 + 4) = b; }
}
template <int GATE>
__device__ __forceinline__ void nm_finalize(const LAS float* vs, const float* ng, const bf16* gate, size_t gld, bf16* mixp, int wave, int lane) {
#pragma unroll 1
    for (int rr = 0; rr < 8; ++rr) { const int c = wave * 8 + rr;
        const float o1 = vs[c * 128 + lane], o2 = vs[c * 128 + 64 + lane];
        const float ss = wave_sum(o1 * o1 + o2 * o2), rs = rsqrtf(ss * (1.0f / 128.0f) + RMS_EPS);
        float r1 = o1 * rs * ng[lane], r2 = o2 * rs * ng[64 + lane];
        if (GATE == 1) { r1 *= siluf_(bf2f(gate[(size_t)c * gld + lane])); r2 *= siluf_(bf2f(gate[(size_t)c * gld + 64 + lane])); }
        mixp[(size_t)c * DM + lane] = (bf16)f2bf(r1); mixp[(size_t)c * DM + 64 + lane] = (bf16)f2bf(r2); }
}

__device__ __forceinline__ void nm_gla(ArgsR A, int l, int b, int h, LAS unsigned char* lds, int tid) {
    const bf16* P = (const bf16*)(A.ws + WS_P); const float* Ps = (const float*)(A.ws + WS_PS); bf16* mix = (bf16*)(A.ws + WS_MIX);
    LAS float* qs = (LAS float*)(lds + NM_Q); LAS float* ks = (LAS float*)(lds + NM_K); LAS float* as = (LAS float*)(lds + NM_A); LAS float* vs = (LAS float*)(lds + NM_V);
    LAS float* parts = (LAS float*)(lds + NM_PARTS); LAS float* lrs = (LAS float*)(lds + NM_SC);
    const int v = tid & 127, dq = tid >> 7, wave = tid >> 6, lane = tid & 63;
    const float* w2 = A.in[I_GLA_W2] + (size_t)l * 16 * GW + h * HD + v;
    float w2c[16];
#pragma unroll
    for (int r = 0; r < 16; ++r) w2c[r] = w2[r * GW];
    const float b2 = A.in[I_GLA_B2][l * GW + h * HD + v];
    const float* ng = A.in[I_GLA_NG] + l * GW + h * HD;
    float S[32];
#pragma unroll
    for (int i = 0; i < 32; ++i) S[i] = 0.f;
#pragma unroll 1
    for (int n = 0; n < NCHK; ++n) {
        const size_t r0 = (size_t)b * SEQ + n * CHK;
        nm_load_tile(P + r0 * PBW + PC_GLA_Q + h * HD, PBW, qs, tid);
        nm_load_tile(P + r0 * PBW + PC_GLA_K + h * HD, PBW, ks, tid);
        nm_load_tile(P + r0 * PBW + PC_GLA_V + h * HD, PBW, vs, tid);
        for (int i = tid; i < 64 * 16; i += NTHREADS) lrs[i] = Ps[(r0 + (i >> 4)) * 32 + PS_LR + (i & 15)];
        __syncthreads();
#pragma unroll 1
        for (int i = 0; i < 16; ++i) { const int c = dq * 16 + i; float z = b2;
#pragma unroll
            for (int r = 0; r < 16; ++r) z += lrs[c * 16 + r] * w2c[r];
            as[c * 128 + v] = __expf(logsigmoidf_(z) * (1.0f / 16.0f)); }
        __syncthreads();
#pragma unroll 1
        for (int c = 0; c < CHK; ++c) {
            const float vt = vs[c * 128 + v]; float part = 0.f;
            const LAS f32x4* q4 = (const LAS f32x4*)(qs + c * 128 + dq * 32); const LAS f32x4* k4 = (const LAS f32x4*)(ks + c * 128 + dq * 32); const LAS f32x4* a4 = (const LAS f32x4*)(as + c * 128 + dq * 32);
#pragma unroll
            for (int i4 = 0; i4 < 8; ++i4) { const f32x4 qv = q4[i4], kv = k4[i4], av = a4[i4];
#pragma unroll
                for (int j = 0; j < 4; ++j) { S[i4 * 4 + j] = av[j] * S[i4 * 4 + j] + kv[j] * vt; part += qv[j] * S[i4 * 4 + j]; } }
            parts[((c & 1) * 4 + dq) * 128 + v] = part;
            __syncthreads();
            if (dq == 0) { const LAS float* pp = parts + (c & 1) * 512 + v; vs[c * 128 + v] = ((pp[0] + pp[128]) + (pp[256] + pp[384])) * 0.08838834764831845f; }
        }
        __syncthreads();
        nm_finalize<1>(vs, ng, P + r0 * PBW + PC_GLA_G + h * HD, PBW, mix + r0 * DM + 0 + h * HD, wave, lane);
        __syncthreads();
    }
}

__device__ __forceinline__ void nm_mlstm(ArgsR A, int l, int b, int h, LAS unsigned char* lds, int tid) {
    const bf16* P = (const bf16*)(A.ws + WS_P); const float* Ps = (const float*)(A.ws + WS_PS); bf16* mix = (bf16*)(A.ws + WS_MIX);
    LAS float* qs = (LAS float*)(lds + NM_Q); LAS float* ks = (LAS float*)(lds + NM_K); LAS float* vs = (LAS float*)(lds + NM_V);
    LAS float* parts = (LAS float*)(lds + NM_PARTS); LAS float* dparts = (LAS float*)(lds + NM_A);
    LAS float* fs = (LAS float*)(lds + NM_SC); LAS float* es = fs + 64;
    const int v = tid & 127, dq = tid >> 7, wave = tid >> 6, lane = tid & 63;
    const float ib = A.in[I_ML_IB][l * NH + h], fb = A.in[I_ML_FB][l * NH + h];
    const float* ng = A.in[I_ML_NG] + l * GW + h * HD;
    float C[32], nn[32];
#pragma unroll
    for (int i = 0; i < 32; ++i) { C[i] = 0.f; nn[i] = 0.f; }
#pragma unroll 1
    for (int n = 0; n < NCHK; ++n) {
        const size_t r0 = (size_t)b * SEQ + n * CHK;
        nm_load_tile(P + r0 * PBW + PC_ML_Q + h * HD, PBW, qs, tid);
        nm_load_tile(P + r0 * PBW + PC_ML_K + h * HD, PBW, ks, tid);
        nm_load_tile(P + r0 * PBW + PC_ML_V + h * HD, PBW, vs, tid);
        if (tid < 64) { fs[tid] = sigmoidf_(Ps[(r0 + tid) * 32 + PS_MF + h] + fb); es[tid] = __expf(Ps[(r0 + tid) * 32 + PS_MI + h] + ib) * 0.08838834764831845f; }
        __syncthreads();
#pragma unroll 1
        for (int c = 0; c < CHK; ++c) {
            const float vt = vs[c * 128 + v], f = fs[c], ei = es[c]; float part = 0.f, dpart = 0.f;
            const LAS f32x4* q4 = (const LAS f32x4*)(qs + c * 128 + dq * 32); const LAS f32x4* k4 = (const LAS f32x4*)(ks + c * 128 + dq * 32);
#pragma unroll
            for (int i4 = 0; i4 < 8; ++i4) { const f32x4 qv = q4[i4], kv = k4[i4];
#pragma unroll
                for (int j = 0; j < 4; ++j) { const float kd = kv[j] * ei; C[i4 * 4 + j] = f * C[i4 * 4 + j] + kd * vt; nn[i4 * 4 + j] = f * nn[i4 * 4 + j] + kd;
                    part += qv[j] * C[i4 * 4 + j]; dpart += qv[j] * nn[i4 * 4 + j]; } }
            parts[((c & 1) * 4 + dq) * 128 + v] = part; if (v == 0) dparts[(c & 1) * 4 + dq] = dpart;
            __syncthreads();
            if (dq == 0) { const LAS float* pp = parts + (c & 1) * 512 + v; const LAS float* dp = dparts + (c & 1) * 4;
                const float num = (pp[0] + pp[128]) + (pp[256] + pp[384]), dot = (dp[0] + dp[1]) + (dp[2] + dp[3]);
                const float og = bf2f(P[(r0 + c) * PBW + PC_ML_O + h * HD + v]);
                vs[c * 128 + v] = num / fmaxf(fabsf(dot), 1.0f) * sigmoidf_(og); }
        }
        __syncthreads();
        nm_finalize<0>(vs, ng, nullptr, 0, mix + r0 * DM + 1024 + h * HD, wave, lane);
        __syncthreads();
    }
}

__device__ __forceinline__ void nm_gdn(ArgsR A, int l, int b, int h, LAS unsigned char* lds, int tid) {
    const bf16* P = (const bf16*)(A.ws + WS_P); const float* Ps = (const float*)(A.ws + WS_PS); bf16* mix = (bf16*)(A.ws + WS_MIX);
    LAS float* qs = (LAS float*)(lds + NM_Q); LAS float* ks = (LAS float*)(lds + NM_K); LAS float* vs = (LAS float*)(lds + NM_V);
    LAS float* parts = (LAS float*)(lds + NM_PARTS);
    LAS float* egs = (LAS float*)(lds + NM_SC); LAS float* bts = egs + 64; LAS float* rq = egs + 128; LAS float* rk = egs + 192;
    const int v = tid & 127, dq = tid >> 7, wave = tid >> 6, lane = tid & 63;
    const float* cw = A.in[I_GDN_CW] + (size_t)l * 4 * 1536;
    const float nalog = -__expf(A.in[I_GDN_ALOG][l * NH + h]), dtb = A.in[I_GDN_DTB][l * NH + h];
    const float* ng = A.in[I_GDN_NG] + l * GW + h * HD;
    float S[32];
#pragma unroll
    for (int i = 0; i < 32; ++i) S[i] = 0.f;
#pragma unroll 1
    for (int n = 0; n < NCHK; ++n) {
        const size_t r0 = (size_t)b * SEQ + n * CHK;
#pragma unroll 1
        for (int part = 0; part < 3; ++part) {
            const int pc = (part == 0 ? PC_GDN_Q : part == 1 ? PC_GDN_K : PC_GDN_V) + h * HD + v, wc = part * 512 + h * HD + v;
            const float w0 = cw[wc], w1 = cw[1536 + wc], w2 = cw[2 * 1536 + wc], w3 = cw[3 * 1536 + wc];
            LAS float* dst = part == 0 ? qs : part == 1 ? ks : vs;
            const int c0 = dq * 16; const long t0 = (long)n * CHK + c0;
            float xm3 = (t0 - 3 >= 0) ? bf2f(P[(r0 + c0 - 3) * PBW + pc]) : 0.f, xm2 = (t0 - 2 >= 0) ? bf2f(P[(r0 + c0 - 2) * PBW + pc]) : 0.f, xm1 = (t0 - 1 >= 0) ? bf2f(P[(r0 + c0 - 1) * PBW + pc]) : 0.f;
#pragma unroll 4
            for (int i = 0; i < 16; ++i) { const float x0 = bf2f(P[(r0 + c0 + i) * PBW + pc]); const float y = w0 * xm3 + w1 * xm2 + w2 * xm1 + w3 * x0;
                dst[(c0 + i) * 128 + v] = siluf_(y); xm3 = xm2; xm2 = xm1; xm1 = x0; }
        }
        if (tid < 64) { bts[tid] = sigmoidf_(Ps[(r0 + tid) * 32 + PS_GB + h]); egs[tid] = __expf(nalog * softplusf_(Ps[(r0 + tid) * 32 + PS_GA + h] + dtb)); }
        __syncthreads();
#pragma unroll 1
        for (int rr = 0; rr < 8; ++rr) { const int c = wave * 8 + rr;
            const float q1 = qs[c * 128 + lane], q2 = qs[c * 128 + 64 + lane], k1 = ks[c * 128 + lane], k2 = ks[c * 128 + 64 + lane];
            const float sq = wave_sum(q1 * q1 + q2 * q2), sk = wave_sum(k1 * k1 + k2 * k2);
            if (lane == 0) { rq[c] = rsqrtf(sq + 1e-6f) * 0.08838834764831845f; rk[c] = rsqrtf(sk + 1e-6f); } }
        __syncthreads();
#pragma unroll 1
        for (int c = 0; c < CHK; ++c) {
            const float vt = vs[c * 128 + v], e = egs[c], bt = bts[c], sq = rq[c], sk = rk[c]; float part = 0.f;
            const LAS f32x4* q4 = (const LAS f32x4*)(qs + c * 128 + dq * 32); const LAS f32x4* k4 = (const LAS f32x4*)(ks + c * 128 + dq * 32);
            f32x4 kv[8];
#pragma unroll
            for (int i4 = 0; i4 < 8; ++i4) { kv[i4] = k4[i4] * sk;
#pragma unroll
                for (int j = 0; j < 4; ++j) { S[i4 * 4 + j] *= e; part += kv[i4][j] * S[i4 * 4 + j]; } }
            parts[dq * 128 + v] = part;
            __syncthreads();
            const float kS = (parts[v] + parts[128 + v]) + (parts[256 + v] + parts[384 + v]);
            const float u = bt * (vt - kS); float part2 = 0.f;
#pragma unroll
            for (int i4 = 0; i4 < 8; ++i4) { const f32x4 qv = q4[i4] * sq;
#pragma unroll
                for (int j = 0; j < 4; ++j) { S[i4 * 4 + j] += kv[i4][j] * u; part2 += qv[j] * S[i4 * 4 + j]; } }
            parts[512 + dq * 128 + v] = part2;
            __syncthreads();
            if (dq == 0) vs[c * 128 + v] = (parts[512 + v] + parts[640 + v]) + (parts[768 + v] + parts[896 + v]);
        }
        __syncthreads();
        nm_finalize<1>(vs, ng, P + r0 * PBW + PC_GDN_G + h * HD, PBW, mix + r0 * DM + 1536 + h * HD, wave, lane);
        __syncthreads();
    }
}

__device__ __forceinline__ void nm_lru(ArgsR A, int l, int b, int j, LAS unsigned char* lds, int tid) {
    const bf16* P = (const bf16*)(A.ws + WS_P); bf16* mix = (bf16*)(A.ws + WS_MIX);
    LAS float* xc = (LAS float*)(lds);
    LAS float* was = (LAS float*)(lds + 20480);
    LAS float* wxs = (LAS float*)(lds + 36864);
    LAS float* aa = (LAS float*)(lds + 53248);
    LAS float* uu = (LAS float*)(lds + 69632);
    const float* wa = A.in[I_LRU_WA] + ((size_t)l * 8 + j) * 4096; const float* wx = A.in[I_LRU_WX] + ((size_t)l * 8 + j) * 4096;
    for (int i = tid; i < 4096; i += NTHREADS) { was[i] = wa[i]; wxs[i] = wx[i]; }
    const float* cw = A.in[I_LRU_CW] + (size_t)l * 4 * GW; const float* cb = A.in[I_LRU_CB] + l * GW;
    const float* ba = A.in[I_LRU_BA] + l * GW + j * 64; const float* bx = A.in[I_LRU_BX] + l * GW + j * 64; const float* lam = A.in[I_LRU_LAM] + l * GW + j * 64;
    float hstate = 0.f;
#pragma unroll 1
    for (int n = 0; n < NCHK; ++n) {
        const size_t r0 = (size_t)b * SEQ + n * CHK;
        { const int cc = tid & 63, c0 = (tid >> 6) * 8, ch = j * 64 + cc, pc = PC_LRU_X + ch; const long t0 = (long)n * CHK + c0;
            const float w0 = cw[ch], w1 = cw[GW + ch], w2 = cw[2 * GW + ch], w3 = cw[3 * GW + ch], bias = cb[ch];
            float xm3 = (t0 - 3 >= 0) ? bf2f(P[(r0 + c0 - 3) * PBW + pc]) : 0.f, xm2 = (t0 - 2 >= 0) ? bf2f(P[(r0 + c0 - 2) * PBW + pc]) : 0.f, xm1 = (t0 - 1 >= 0) ? bf2f(P[(r0 + c0 - 1) * PBW + pc]) : 0.f;
#pragma unroll
            for (int i = 0; i < 8; ++i) { const float x0 = bf2f(P[(r0 + c0 + i) * PBW + pc]); xc[(c0 + i) * 65 + cc] = w0 * xm3 + w1 * xm2 + w2 * xm1 + w3 * x0 + bias; xm3 = xm2; xm2 = xm1; xm1 = x0; } }
        __syncthreads();
        { const int tok = tid >> 3, cg = tid & 7; float ra[8], ri[8];
#pragma unroll
            for (int q = 0; q < 8; ++q) { ra[q] = ba[cg * 8 + q]; ri[q] = bx[cg * 8 + q]; }
#pragma unroll 4
            for (int i = 0; i < 64; ++i) { const float xv = xc[tok * 65 + i];
                const f32x4 a0 = *(const LAS f32x4*)(was + i * 64 + cg * 8), a1 = *(const LAS f32x4*)(was + i * 64 + cg * 8 + 4);
                const f32x4 x0 = *(const LAS f32x4*)(wxs + i * 64 + cg * 8), x1 = *(const LAS f32x4*)(wxs + i * 64 + cg * 8 + 4);
#pragma unroll
                for (int q = 0; q < 4; ++q) { ra[q] += xv * a0[q]; ra[4 + q] += xv * a1[q]; ri[q] += xv * x0[q]; ri[4 + q] += xv * x1[q]; } }
#pragma unroll
            for (int q = 0; q < 8; ++q) { const int jj = cg * 8 + q; const float r = sigmoidf_(ra[q]), ig = sigmoidf_(ri[q]);
                const float log_a = -8.0f * r * softplusf_(-lam[jj]); const float a = __expf(log_a), u = sqrtf(-expm1f(2.0f * log_a)) * (ig * xc[tok * 65 + jj]);
                aa[tok * 64 + jj] = a; uu[tok * 64 + jj] = u; } }
        __syncthreads();
        if (tid < 64) { const int ch = j * 64 + tid;
#pragma unroll 4
            for (int c = 0; c < CHK; ++c) { hstate = aa[c * 64 + tid] * hstate + uu[c * 64 + tid];
                const float y = bf2f(P[(r0 + c) * PBW + PC_LRU_Y + ch]); mix[(r0 + c) * DM + 512 + ch] = (bf16)f2bf(gelu_tanh(y) * hstate); } }
        __syncthreads();
    }
}

__device__ __forceinline__ void nm_phase(ArgsR A, int l, LAS unsigned char* lds, int G, int tid) {
    for (int it = blockIdx.x; it < 80; it += G) {
        if (it < 16) nm_gla(A, l, it >> 2, it & 3, lds, tid);
        else if (it < 32) nm_mlstm(A, l, (it - 16) >> 2, (it - 16) & 3, lds, tid);
        else if (it < 48) nm_gdn(A, l, (it - 32) >> 2, (it - 32) & 3, lds, tid);
        else nm_lru(A, l, (it - 48) >> 3, (it - 48) & 7, lds, tid);
        __syncthreads();
    }
}

constexpr size_t WS_GLA_INC = 562 * MiB;
constexpr size_t WS_GLA_DEC = 594 * MiB;
constexpr size_t WS_GLA_ST = 595 * MiB;
constexpr size_t WS_ML_INC = 611 * MiB;
constexpr size_t WS_ML_N = 643 * MiB;
constexpr size_t WS_ML_SC = 643 * MiB + 512 * 1024;
constexpr size_t WS_ML_ST = 644 * MiB;
constexpr size_t WS_ML_NP = 660 * MiB;
constexpr size_t WS_ML_MP = 660 * MiB + 512 * 1024;
constexpr size_t WS_GDN_U0 = 661 * MiB, WS_GDN_W = 669 * MiB, WS_GDN_QD = 677 * MiB, WS_GDN_KE = 685 * MiB;
constexpr size_t WS_GDN_QK = 693 * MiB;
constexpr size_t WS_GDN_DE = 697 * MiB;
constexpr size_t WS_GDN_O = 698 * MiB;
constexpr size_t WS_LRU_HL = 714 * MiB, WS_LRU_AP = 730 * MiB;
constexpr size_t WS_LRU_CARRY = 746 * MiB;
static_assert(WS_LRU_CARRY + 4 * 32 * 512 * 4 <= WS_END, "ws map");

typedef short v4i16_t __attribute__((ext_vector_type(4)));
constexpr int LD128 = 136, LD64 = 72;

__device__ __forceinline__ bf16x8 frag_rd(const LAS bf16* t, int ld, int row0, int k0, int lane) { return *(const LAS bf16x8*)(t + (row0 + (lane & 15)) * ld + k0 + 8 * (lane >> 4)); }
__device__ __forceinline__ bf16x8 frag_rd_perm(const LAS bf16* t, int ld, int row0, int k0, int lane) {
    const LAS bf16* p = t + (row0 + (lane & 15)) * ld + k0 + 4 * (lane >> 4);
    const bf16x4 a = *(const LAS bf16x4*)p, b = *(const LAS bf16x4*)(p + 16);
    return (bf16x8){a[0], a[1], a[2], a[3], b[0], b[1], b[2], b[3]};
}
__device__ __forceinline__ bf16x8 frag_tr(const LAS bf16* t, int ld, int k0, int n0, int lane) {
    const int i = lane & 15, g = lane >> 4; const LAS bf16* p = t + (k0 + 8 * g + (i >> 2)) * ld + n0 + 4 * (i & 3);
    const v4i16_t a = __builtin_amdgcn_ds_read_tr16_b64_v4i16((LAS v4i16_t*)p), b = __builtin_amdgcn_ds_read_tr16_b64_v4i16((LAS v4i16_t*)(p + 4 * ld));
    return (bf16x8){a[0], a[1], a[2], a[3], b[0], b[1], b[2], b[3]};
}
__device__ __forceinline__ bf16x8 frag_tr_perm(const LAS bf16* t, int ld, int k0, int n0, int lane) {
    const int i = lane & 15, g = lane >> 4; const LAS bf16* p = t + (k0 + 4 * g + (i >> 2)) * ld + n0 + 4 * (i & 3);
    const v4i16_t a = __builtin_amdgcn_ds_read_tr16_b64_v4i16((LAS v4i16_t*)p), b = __builtin_amdgcn_ds_read_tr16_b64_v4i16((LAS v4i16_t*)(p + 16 * ld));
    return (bf16x8){a[0], a[1], a[2], a[3], b[0], b[1], b[2], b[3]};
}
__device__ __forceinline__ bf16x8 pack_acc(const f32x4& lo, const f32x4& hi) {
    v4u w; w.x = pg8::cvt_pk_bf16(lo[0], lo[1]); w.y = pg8::cvt_pk_bf16(lo[2], lo[3]); w.z = pg8::cvt_pk_bf16(hi[0], hi[1]); w.w = pg8::cvt_pk_bf16(hi[2], hi[3]);
    return __builtin_bit_cast(bf16x8, w);
}
#define MFMA16(a, b, c) __builtin_amdgcn_mfma_f32_16x16x32_bf16((a), (b), (c), 0, 0, 0)

template <int ROWS>
__device__ __forceinline__ void tile_g2l_128(const bf16* g, size_t gld, LAS bf16* t, int tid) {
#pragma unroll
    for (int i = 0; i < ROWS * 16 / NTHREADS; ++i) { const int idx = tid + i * NTHREADS, r = idx >> 4, c8 = (idx & 15) * 8;
        *(LAS v4u*)(t + r * LD128 + c8) = *(const GAS v4u*)(g + (size_t)r * gld + c8); }
}
__device__ __forceinline__ float wave_scan_add(float v, int lane) {
#pragma unroll
    for (int o = 1; o < 64; o <<= 1) { const float t = __shfl_up(v, o); if (lane >= o) v += t; }
    return v;
}
__device__ __forceinline__ float wave_scan_max(float v, int lane) {
#pragma unroll
    for (int o = 1; o < 64; o <<= 1) { const float t = __shfl_up(v, o); if (lane >= o) v = fmaxf(v, t); }
    return v;
}
__device__ __forceinline__ float wave_max(float v) {
#pragma unroll
    for (int o = 1; o < 64; o <<= 1) v = fmaxf(v, __shfl_xor(v, o));
    return v;
}

__device__ __forceinline__ void f_lru_p2(ArgsR A, int l, int item, LAS unsigned char* lds, int tid) {
    const int j = item & 7, n = (item >> 3) & 31, b = item >> 8;
    const bf16* P = (const bf16*)(A.ws + WS_P); float* HLg = (float*)(A.ws + WS_LRU_HL); float* APg = (float*)(A.ws + WS_LRU_AP);
    LAS float* xc = (LAS float*)(lds); LAS float* was = (LAS float*)(lds + 20480); LAS float* wxs = (LAS float*)(lds + 36864);
    LAS float* aa = (LAS float*)(lds + 53248); LAS float* uu = (LAS float*)(lds + 69632); LAS float* segA = (LAS float*)(lds + 86016); LAS float* segH = (LAS float*)(lds + 88064);
    const float* wa = A.in[I_LRU_WA] + ((size_t)l * 8 + j) * 4096; const float* wx = A.in[I_LRU_WX] + ((size_t)l * 8 + j) * 4096;
    for (int i = tid; i < 4096; i += NTHREADS) { was[i] = wa[i]; wxs[i] = wx[i]; }
    const float* cw = A.in[I_LRU_CW] + (size_t)l * 4 * GW; const float* cb = A.in[I_LRU_CB] + l * GW;
    const float* ba = A.in[I_LRU_BA] + l * GW + j * 64; const float* bx = A.in[I_LRU_BX] + l * GW + j * 64; const float* lam = A.in[I_LRU_LAM] + l * GW + j * 64;
    const size_t r0 = (size_t)b * SEQ + n * CHK;
    { const int cc = tid & 63, c0 = (tid >> 6) * 8, ch = j * 64 + cc, pc = PC_LRU_X + ch; const long t0 = (long)n * CHK + c0;
        const float w0 = cw[ch], w1 = cw[GW + ch], w2 = cw[2 * GW + ch], w3 = cw[3 * GW + ch], bias = cb[ch];
        float xm3 = (t0 - 3 >= 0) ? bf2f(P[(r0 + c0 - 3) * PBW + pc]) : 0.f, xm2 = (t0 - 2 >= 0) ? bf2f(P[(r0 + c0 - 2) * PBW + pc]) : 0.f, xm1 = (t0 - 1 >= 0) ? bf2f(P[(r0 + c0 - 1) * PBW + pc]) : 0.f;
#pragma unroll
        for (int i = 0; i < 8; ++i) { const float x0 = bf2f(P[(r0 + c0 + i) * PBW + pc]); xc[(c0 + i) * 65 + cc] = w0 * xm3 + w1 * xm2 + w2 * xm1 + w3 * x0 + bias; xm3 = xm2; xm2 = xm1; xm1 = x0; } }
    __syncthreads();
    { const int tok = tid >> 3, cg = tid & 7; float ra[8], ri[8];
#pragma unroll
        for (int q = 0; q < 8; ++q) { ra[q] = ba[cg * 8 + q]; ri[q] = bx[cg * 8 + q]; }
#pragma unroll 4
        for (int i = 0; i < 64; ++i) { const float xv = xc[tok * 65 + i];
            const f32x4 a0 = *(const LAS f32x4*)(was + i * 64 + cg * 8), a1 = *(const LAS f32x4*)(was + i * 64 + cg * 8 + 4);
            const f32x4 x0 = *(const LAS f32x4*)(wxs + i * 64 + cg * 8), x1 = *(const LAS f32x4*)(wxs + i * 64 + cg * 8 + 4);
#pragma unroll
            for (int q = 0; q < 4; ++q) { ra[q] += xv * a0[q]; ra[4 + q] += xv * a1[q]; ri[q] += xv * x0[q]; ri[4 + q] += xv * x1[q]; } }
#pragma unroll
        for (int q = 0; q < 8; ++q) { const int jj = cg * 8 + q; const float r = sigmoidf_(ra[q]), ig = sigmoidf_(ri[q]);
            const float log_a = -8.0f * r * softplusf_(-lam[jj]); const float a = __expf(log_a), u = sqrtf(-expm1f(2.0f * log_a)) * (ig * xc[tok * 65 + jj]);
            aa[tok * 64 + jj] = a; uu[tok * 64 + jj] = u; } }
    __syncthreads();
    const int cc = tid & 63, seg = tid >> 6;
    { float Ap = 1.f, Hl = 0.f;
#pragma unroll
        for (int i = 0; i < 8; ++i) { const int c = seg * 8 + i; const float a = aa[c * 64 + cc], u = uu[c * 64 + cc]; Hl = a * Hl + u; Ap *= a; aa[c * 64 + cc] = Ap; uu[c * 64 + cc] = Hl; }
        segA[seg * 64 + cc] = Ap; segH[seg * 64 + cc] = Hl; }
    __syncthreads();
    { float Ac = 1.f, Hc = 0.f;
#pragma unroll 1
        for (int s = 0; s < seg; ++s) { const float sa = segA[s * 64 + cc]; Hc = sa * Hc + segH[s * 64 + cc]; Ac *= sa; }
#pragma unroll
        for (int i = 0; i < 8; ++i) { const int c = seg * 8 + i; const float ap = aa[c * 64 + cc], hl = uu[c * 64 + cc];
            HLg[(r0 + c) * GW + j * 64 + cc] = ap * Hc + hl; APg[(r0 + c) * GW + j * 64 + cc] = ap * Ac; } }
    __syncthreads();
}
__device__ __forceinline__ void f_lru_p3(ArgsR A, int b, int tid) {
    const float* HLg = (const float*)(A.ws + WS_LRU_HL); const float* APg = (const float*)(A.ws + WS_LRU_AP); float* carry = (float*)(A.ws + WS_LRU_CARRY);
    float c = 0.f;
#pragma unroll 8
    for (int n = 0; n < NCHK; ++n) { carry[((size_t)b * NCHK + n) * GW + tid] = c; const size_t t = (size_t)b * SEQ + n * CHK + 63; c = APg[t * GW + tid] * c + HLg[t * GW + tid]; }
}
__device__ __forceinline__ void f_lru_p4(ArgsR A, int item, int tid) {
    const bf16* P = (const bf16*)(A.ws + WS_P); bf16* mix = (bf16*)(A.ws + WS_MIX);
    const float* HLg = (const float*)(A.ws + WS_LRU_HL); const float* APg = (const float*)(A.ws + WS_LRU_AP); const float* carry = (const float*)(A.ws + WS_LRU_CARRY);
    const float cr = carry[(size_t)item * GW + tid]; const size_t r0 = (size_t)item * CHK;
#pragma unroll 8
    for (int c = 0; c < CHK; ++c) { const float h = APg[(r0 + c) * GW + tid] * cr + HLg[(r0 + c) * GW + tid]; const float y = bf2f(P[(r0 + c) * PBW + PC_LRU_Y + tid]);
        mix[(r0 + c) * DM + 512 + tid] = (bf16)f2bf(gelu_tanh(y) * h); }
}

constexpr int FL_Q = 0, FL_K = 17408, FL_V = 34816, FL_ST = 52224, FL_SC = 87040, FL_BC = 96256, FL_LR = 129024, FL_SEG = 133120, FL_RS = 135168;
__device__ __forceinline__ void gla_bcum(ArgsR A, int l, int h, LAS float* bc, LAS float* segt, const LAS float* lrs, int tid) {
    const int d = tid & 127, seg = tid >> 7;
    const float* w2 = A.in[I_GLA_W2] + (size_t)l * 16 * GW + h * HD + d; float w2c[16];
#pragma unroll
    for (int r = 0; r < 16; ++r) w2c[r] = w2[r * GW];
    const float b2 = A.in[I_GLA_B2][l * GW + h * HD + d]; float run = 0.f;
#pragma unroll 4
    for (int i = 0; i < 16; ++i) { const int c = seg * 16 + i; float z = b2;
#pragma unroll
        for (int r = 0; r < 16; ++r) z += lrs[c * 16 + r] * w2c[r];
        run += logsigmoidf_(z) * (1.0f / 16.0f); bc[c * 128 + d] = run; }
    segt[seg * 128 + d] = run;
}
__device__ __forceinline__ void f_gla_p2(ArgsR A, int l, int item, LAS unsigned char* lds, int tid) {
    const int n = item & 31, h = (item >> 5) & 3, b = item >> 7; const int lane = tid & 63, wave = __builtin_amdgcn_readfirstlane(tid >> 6);
    const bf16* P = (const bf16*)(A.ws + WS_P); const float* Ps = (const float*)(A.ws + WS_PS);
    float* inc = (float*)(A.ws + WS_GLA_INC) + (size_t)item * 16384; float* dec = (float*)(A.ws + WS_GLA_DEC) + (size_t)item * 128;
    LAS bf16* ks = (LAS bf16*)(lds + FL_K); LAS bf16* vs = (LAS bf16*)(lds + FL_V); LAS float* bc = (LAS float*)(lds + FL_BC); LAS float* lrs = (LAS float*)(lds + FL_LR); LAS float* segt = (LAS float*)(lds + FL_SEG);
    const size_t r0 = (size_t)b * SEQ + n * CHK;
    tile_g2l_128<64>(P + r0 * PBW + PC_GLA_K + h * HD, PBW, ks, tid);
    tile_g2l_128<64>(P + r0 * PBW + PC_GLA_V + h * HD, PBW, vs, tid);
    for (int i = tid; i < 64 * 16; i += NTHREADS) lrs[i] = Ps[(r0 + (i >> 4)) * 32 + PS_LR + (i & 15)];
    __syncthreads();
    gla_bcum(A, l, h, bc, segt, lrs, tid);
    __syncthreads();
    { const int d = tid & 127, seg = tid >> 7; float pre = 0.f, tot = 0.f;
#pragma unroll
        for (int s = 0; s < 4; ++s) { const float v = segt[s * 128 + d]; if (s < seg) pre += v; tot += v; }
#pragma unroll 4
        for (int i = 0; i < 16; ++i) { const int c = seg * 16 + i; const float bcm = bc[c * 128 + d] + pre; ks[c * LD128 + d] = (bf16)f2bf(bf2f(ks[c * LD128 + d]) * __expf(tot - bcm)); }
        if (seg == 0) dec[d] = __expf(tot); }
    __syncthreads();
    { f32x4 acc[8];
#pragma unroll
        for (int nt = 0; nt < 8; ++nt) acc[nt] = (f32x4){0.f, 0.f, 0.f, 0.f};
#pragma unroll
        for (int kk = 0; kk < 2; ++kk) { const bf16x8 af = frag_tr(vs, LD128, 32 * kk, 16 * wave, lane);
#pragma unroll
            for (int nt = 0; nt < 8; ++nt) acc[nt] = MFMA16(af, frag_tr(ks, LD128, 32 * kk, 16 * nt, lane), acc[nt]); }
        const int fr = lane & 15, fq = lane >> 4;
#pragma unroll
        for (int nt = 0; nt < 8; ++nt)
#pragma unroll
            for (int r = 0; r < 4; ++r) inc[(16 * wave + 4 * fq + r) * 128 + 16 * nt + fr] = acc[nt][r]; }
    __syncthreads();
}
__device__ __forceinline__ void f_gla_p3(ArgsR A, int item, int tid) {
    const int bh = item >> 4, sl = item & 15; const int e = sl * 1024 + tid * 2, d = e & 127;
    const float* inc = (const float*)(A.ws + WS_GLA_INC) + (size_t)bh * 32 * 16384 + e; const float* dec = (const float*)(A.ws + WS_GLA_DEC) + (size_t)bh * 32 * 128 + d;
    bf16* st = (bf16*)(A.ws + WS_GLA_ST) + (size_t)bh * 32 * 16384 + e;
    float s0 = 0.f, s1 = 0.f;
#pragma unroll 8
    for (int n = 0; n < NCHK; ++n) { *(GAS unsigned*)(st + (size_t)n * 16384) = pk2(s0, s1);
        const f32x2 iv = *(const GAS f32x2*)(inc + (size_t)n * 16384), dv = *(const GAS f32x2*)(dec + (size_t)n * 128); s0 = dv[0] * s0 + iv[0]; s1 = dv[1] * s1 + iv[1]; }
}
__device__ __forceinline__ void f_gla_p4(ArgsR A, int l, int item, LAS unsigned char* lds, int tid) {
    const int n = item & 31, h = (item >> 5) & 3, b = item >> 7; const int lane = tid & 63, wave = __builtin_amdgcn_readfirstlane(tid >> 6), fr = lane & 15, fq = lane >> 4;
    const bf16* P = (const bf16*)(A.ws + WS_P); const float* Ps = (const float*)(A.ws + WS_PS); bf16* mix = (bf16*)(A.ws + WS_MIX);
    const bf16* stg = (const bf16*)(A.ws + WS_GLA_ST) + (size_t)item * 16384;
    LAS bf16* qs = (LAS bf16*)(lds + FL_Q); LAS bf16* ks = (LAS bf16*)(lds + FL_K); LAS bf16* vs = (LAS bf16*)(lds + FL_V); LAS bf16* sts = (LAS bf16*)(lds + FL_ST); LAS bf16* scs = (LAS bf16*)(lds + FL_SC);
    LAS float* bc = (LAS float*)(lds + FL_BC); LAS float* lrs = (LAS float*)(lds + FL_LR); LAS float* segt = (LAS float*)(lds + FL_SEG); LAS float* rsp = (LAS float*)(lds + FL_RS);
    const size_t r0 = (size_t)b * SEQ + n * CHK;
    tile_g2l_128<64>(P + r0 * PBW + PC_GLA_Q + h * HD, PBW, qs, tid);
    tile_g2l_128<64>(P + r0 * PBW + PC_GLA_K + h * HD, PBW, ks, tid);
    tile_g2l_128<64>(P + r0 * PBW + PC_GLA_V + h * HD, PBW, vs, tid);
    tile_g2l_128<128>(stg, 128, sts, tid);
    for (int i = tid; i < 64 * 16; i += NTHREADS) lrs[i] = Ps[(r0 + (i >> 4)) * 32 + PS_LR + (i & 15)];
    __syncthreads();
    gla_bcum(A, l, h, bc, segt, lrs, tid);
    __syncthreads();
    { const int d = tid & 127, seg = tid >> 7; float pre = 0.f;
#pragma unroll
        for (int s = 0; s < 4; ++s) { const float v = segt[s * 128 + d]; if (s < seg) pre += v; }
#pragma unroll 4
        for (int i = 0; i < 16; ++i) { const int c = seg * 16 + i; const float bcm = bc[c * 128 + d] + pre; const float eb = __expf(bcm);
            qs[c * LD128 + d] = (bf16)f2bf(bf2f(qs[c * LD128 + d]) * eb * 0.08838834764831845f); ks[c * LD128 + d] = (bf16)f2bf(bf2f(ks[c * LD128 + d]) / eb); } }
    __syncthreads();
    { const int mt = wave >> 1; f32x4 acc[2] = {{0.f, 0.f, 0.f, 0.f}, {0.f, 0.f, 0.f, 0.f}};
#pragma unroll
        for (int kk = 0; kk < 4; ++kk) { const bf16x8 af = frag_rd(qs, LD128, 16 * mt, 32 * kk, lane);
#pragma unroll
            for (int q = 0; q < 2; ++q) acc[q] = MFMA16(af, frag_rd(ks, LD128, 16 * (2 * (wave & 1) + q), 32 * kk, lane), acc[q]); }
#pragma unroll
        for (int q = 0; q < 2; ++q) { const int s = 16 * (2 * (wave & 1) + q) + fr;
#pragma unroll
            for (int r = 0; r < 4; ++r) { const int c = 16 * mt + 4 * fq + r; scs[c * LD64 + s] = (bf16)f2bf(s <= c ? acc[q][r] : 0.f); } } }
    __syncthreads();
    f32x4 o[4];
#pragma unroll
    for (int mt = 0; mt < 4; ++mt) o[mt] = (f32x4){0.f, 0.f, 0.f, 0.f};
#pragma unroll
    for (int kk = 0; kk < 2; ++kk) { const bf16x8 bfv = frag_tr(vs, LD128, 32 * kk, 16 * wave, lane);
#pragma unroll
        for (int mt = 0; mt < 4; ++mt) o[mt] = MFMA16(frag_rd(scs, LD64, 16 * mt, 32 * kk, lane), bfv, o[mt]); }
#pragma unroll
    for (int kk = 0; kk < 4; ++kk) { const bf16x8 bfs = frag_rd(sts, LD128, 16 * wave, 32 * kk, lane);
#pragma unroll
        for (int mt = 0; mt < 4; ++mt) o[mt] = MFMA16(frag_rd(qs, LD128, 16 * mt, 32 * kk, lane), bfs, o[mt]); }
#pragma unroll
    for (int mt = 0; mt < 4; ++mt)
#pragma unroll
        for (int r = 0; r < 4; ++r) { float s = o[mt][r] * o[mt][r]; s += __shfl_xor(s, 1); s += __shfl_xor(s, 2); s += __shfl_xor(s, 4); s += __shfl_xor(s, 8);
            if (fr == 0) rsp[wave * 64 + 16 * mt + 4 * fq + r] = s; }
    __syncthreads();
    const float* ng = A.in[I_GLA_NG] + l * GW + h * HD; const float gn = ng[16 * wave + fr];
#pragma unroll
    for (int mt = 0; mt < 4; ++mt)
#pragma unroll
        for (int r = 0; r < 4; ++r) { const int c = 16 * mt + 4 * fq + r; float ss = 0.f;
#pragma unroll
            for (int w = 0; w < 8; ++w) ss += rsp[w * 64 + c];
            const float rs = rsqrtf(ss * (1.0f / 128.0f) + RMS_EPS);
            const float g = bf2f(P[(r0 + c) * PBW + PC_GLA_G + h * HD + 16 * wave + fr]);
            mix[(r0 + c) * DM + h * HD + 16 * wave + fr] = (bf16)f2bf(o[mt][r] * rs * gn * siluf_(g)); }
    __syncthreads();
}

constexpr int FM_Q2 = 96256, FM_S = 129024;
__device__ __forceinline__ void f_ml_p2(ArgsR A, int l, int item, LAS unsigned char* lds, int tid) {
    const int n = item & 31, h = (item >> 5) & 3, b = item >> 7; const int lane = tid & 63, wave = __builtin_amdgcn_readfirstlane(tid >> 6);
    const bf16* P = (const bf16*)(A.ws + WS_P); const float* Ps = (const float*)(A.ws + WS_PS);
    float* inc = (float*)(A.ws + WS_ML_INC) + (size_t)item * 16384; float* incn = (float*)(A.ws + WS_ML_N) + (size_t)item * 128; float* scg = (float*)(A.ws + WS_ML_SC) + (size_t)item * 2;
    LAS bf16* ks = (LAS bf16*)(lds + FL_K); LAS bf16* vs = (LAS bf16*)(lds + FL_V); LAS float* sc = (LAS float*)(lds + FM_S);
    const size_t r0 = (size_t)b * SEQ + n * CHK;
    tile_g2l_128<64>(P + r0 * PBW + PC_ML_K + h * HD, PBW, ks, tid);
    tile_g2l_128<64>(P + r0 * PBW + PC_ML_V + h * HD, PBW, vs, tid);
    if (wave == 0) { const float lf = logsigmoidf_(Ps[(r0 + lane) * 32 + PS_MF + h] + A.in[I_ML_FB][l * NH + h]), ig = Ps[(r0 + lane) * 32 + PS_MI + h] + A.in[I_ML_IB][l * NH + h];
        const float bcum = wave_scan_add(lf, lane), blast = __shfl(bcum, 63), le = blast - bcum + ig, mloc = wave_max(le);
        sc[lane] = __expf(le - mloc) * 0.08838834764831845f; if (lane == 0) { scg[0] = mloc; scg[1] = blast; } }
    __syncthreads();
#pragma unroll
    for (int i = 0; i < 2; ++i) { const int idx = tid + i * NTHREADS, r = idx >> 4, c8 = (idx & 15) * 8; const float w = sc[r];
        v4u x = *(LAS v4u*)(ks + r * LD128 + c8);
        x.x = pk2(bflo(x.x) * w, bfhi(x.x) * w); x.y = pk2(bflo(x.y) * w, bfhi(x.y) * w); x.z = pk2(bflo(x.z) * w, bfhi(x.z) * w); x.w = pk2(bflo(x.w) * w, bfhi(x.w) * w);
        *(LAS v4u*)(ks + r * LD128 + c8) = x; }
    __syncthreads();
    if (tid < 128) { float s = 0.f;
#pragma unroll 8
        for (int c = 0; c < 64; ++c) s += bf2f(ks[c * LD128 + tid]);
        incn[tid] = s; }
    { f32x4 acc[8];
#pragma unroll
        for (int nt = 0; nt < 8; ++nt) acc[nt] = (f32x4){0.f, 0.f, 0.f, 0.f};
#pragma unroll
        for (int kk = 0; kk < 2; ++kk) { const bf16x8 af = frag_tr(vs, LD128, 32 * kk, 16 * wave, lane);
#pragma unroll
            for (int nt = 0; nt < 8; ++nt) acc[nt] = MFMA16(af, frag_tr(ks, LD128, 32 * kk, 16 * nt, lane), acc[nt]); }
        const int fr = lane & 15, fq = lane >> 4;
#pragma unroll
        for (int nt = 0; nt < 8; ++nt)
#pragma unroll
            for (int r = 0; r < 4; ++r) inc[(16 * wave + 4 * fq + r) * 128 + 16 * nt + fr] = acc[nt][r]; }
    __syncthreads();
}
__device__ __forceinline__ void f_ml_p3(ArgsR A, int item, int tid) {
    const int bh = item >> 4, sl = item & 15; const int e = sl * 1024 + tid * 2;
    const float* inc = (const float*)(A.ws + WS_ML_INC) + (size_t)bh * 32 * 16384 + e; const float* incn = (const float*)(A.ws + WS_ML_N) + (size_t)bh * 32 * 128;
    const float* scg = (const float*)(A.ws + WS_ML_SC) + (size_t)bh * 32 * 2;
    bf16* st = (bf16*)(A.ws + WS_ML_ST) + (size_t)bh * 32 * 16384 + e; float* np = (float*)(A.ws + WS_ML_NP) + (size_t)bh * 32 * 128; float* mp = (float*)(A.ws + WS_ML_MP) + (size_t)bh * 32;
    float c0 = 0.f, c1 = 0.f, nv = 0.f, m = 0.f; const int dn = sl * 8 + tid;
#pragma unroll 4
    for (int n = 0; n < NCHK; ++n) {
        *(GAS unsigned*)(st + (size_t)n * 16384) = pk2(c0, c1);
        if (tid < 8) np[n * 128 + dn] = nv;
        if (sl == 0 && tid == 0) mp[n] = m;
        const float ml = scg[2 * n], bl = scg[2 * n + 1]; const float mn = fmaxf(bl + m, ml), ao = __expf(bl + m - mn), ai = __expf(ml - mn);
        const f32x2 iv = *(const GAS f32x2*)(inc + (size_t)n * 16384); c0 = ao * c0 + ai * iv[0]; c1 = ao * c1 + ai * iv[1];
        if (tid < 8) nv = ao * nv + ai * incn[n * 128 + dn];
        m = mn; }
}
__device__ __forceinline__ void f_ml_p4(ArgsR A, int l, int item, LAS unsigned char* lds, int tid) {
    const int n = item & 31, h = (item >> 5) & 3, b = item >> 7; const int lane = tid & 63, wave = __builtin_amdgcn_readfirstlane(tid >> 6), fr = lane & 15, fq = lane >> 4;
    const bf16* P = (const bf16*)(A.ws + WS_P); const float* Ps = (const float*)(A.ws + WS_PS); bf16* mix = (bf16*)(A.ws + WS_MIX);
    const bf16* stg = (const bf16*)(A.ws + WS_ML_ST) + (size_t)item * 16384; const float* npg = (const float*)(A.ws + WS_ML_NP) + (size_t)item * 128; const float mprev = ((const float*)(A.ws + WS_ML_MP))[item];
    LAS bf16* qs = (LAS bf16*)(lds + FL_Q); LAS bf16* ks = (LAS bf16*)(lds + FL_K); LAS bf16* vs = (LAS bf16*)(lds + FL_V); LAS bf16* sts = (LAS bf16*)(lds + FL_ST); LAS bf16* scs = (LAS bf16*)(lds + FL_SC);
    LAS bf16* q2 = (LAS bf16*)(lds + FM_Q2); LAS float* sc = (LAS float*)(lds + FM_S); LAS float* rsp = (LAS float*)(lds + FL_RS + 4096);
    const size_t r0 = (size_t)b * SEQ + n * CHK;
    tile_g2l_128<64>(P + r0 * PBW + PC_ML_Q + h * HD, PBW, qs, tid);
    tile_g2l_128<64>(P + r0 * PBW + PC_ML_K + h * HD, PBW, ks, tid);
    tile_g2l_128<64>(P + r0 * PBW + PC_ML_V + h * HD, PBW, vs, tid);
    tile_g2l_128<128>(stg, 128, sts, tid);
    if (wave == 0) { const float lf = logsigmoidf_(Ps[(r0 + lane) * 32 + PS_MF + h] + A.in[I_ML_FB][l * NH + h]), ig = Ps[(r0 + lane) * 32 + PS_MI + h] + A.in[I_ML_IB][l * NH + h];
        const float bcum = wave_scan_add(lf, lane), as = ig - bcum, pm = wave_scan_max(as, lane);
        const float mintra = bcum + pm, minter = bcum + mprev, mt = fmaxf(mintra, minter);
        sc[lane] = bcum - mt; sc[64 + lane] = as; sc[128 + lane] = __expf(minter - mt); sc[192 + lane] = __expf(-mt); }
    if (wave == 1) { sc[320 + lane] = npg[lane]; sc[384 + lane] = npg[64 + lane]; }
    __syncthreads();
#pragma unroll
    for (int i = 0; i < 2; ++i) { const int idx = tid + i * NTHREADS, r = idx >> 4, c8 = (idx & 15) * 8; const float w = sc[128 + r];
        v4u x = *(LAS v4u*)(qs + r * LD128 + c8);
        x.x = pk2(bflo(x.x) * w, bfhi(x.x) * w); x.y = pk2(bflo(x.y) * w, bfhi(x.y) * w); x.z = pk2(bflo(x.z) * w, bfhi(x.z) * w); x.w = pk2(bflo(x.w) * w, bfhi(x.w) * w);
        *(LAS v4u*)(q2 + r * LD128 + c8) = x; }
    { const int mt = wave >> 1; f32x4 acc[2] = {{0.f, 0.f, 0.f, 0.f}, {0.f, 0.f, 0.f, 0.f}};
#pragma unroll
        for (int kk = 0; kk < 4; ++kk) { const bf16x8 af = frag_rd(qs, LD128, 16 * mt, 32 * kk, lane);
#pragma unroll
            for (int q = 0; q < 2; ++q) acc[q] = MFMA16(af, frag_rd(ks, LD128, 16 * (2 * (wave & 1) + q), 32 * kk, lane), acc[q]); }
#pragma unroll
        for (int q = 0; q < 2; ++q) { const int s = 16 * (2 * (wave & 1) + q) + fr; const float asv = sc[64 + s];
#pragma unroll
            for (int r = 0; r < 4; ++r) { const int c = 16 * mt + 4 * fq + r; scs[c * LD64 + s] = (bf16)f2bf(s <= c ? acc[q][r] * 0.08838834764831845f * __expf(sc[c] + asv) : 0.f); } } }
    __syncthreads();
    { const int c = tid >> 3, part = tid & 7; float s = 0.f;
#pragma unroll
        for (int i = 0; i < 8; ++i) s += bf2f(scs[c * LD64 + part * 8 + i]);
#pragma unroll
        for (int i = 0; i < 16; ++i) s += bf2f(q2[c * LD128 + part * 16 + i]) * sc[320 + part * 16 + i];
        s += __shfl_xor(s, 1); s += __shfl_xor(s, 2); s += __shfl_xor(s, 4);
        if (part == 0) sc[256 + c] = fmaxf(fabsf(s), sc[192 + c]); }
    f32x4 o[4];
#pragma unroll
    for (int mt = 0; mt < 4; ++mt) o[mt] = (f32x4){0.f, 0.f, 0.f, 0.f};
#pragma unroll
    for (int kk = 0; kk < 2; ++kk) { const bf16x8 bfv = frag_tr(vs, LD128, 32 * kk, 16 * wave, lane);
#pragma unroll
        for (int mt = 0; mt < 4; ++mt) o[mt] = MFMA16(frag_rd(scs, LD64, 16 * mt, 32 * kk, lane), bfv, o[mt]); }
#pragma unroll
    for (int kk = 0; kk < 4; ++kk) { const bf16x8 bfs = frag_rd(sts, LD128, 16 * wave, 32 * kk, lane);
#pragma unroll
        for (int mt = 0; mt < 4; ++mt) o[mt] = MFMA16(frag_rd(q2, LD128, 16 * mt, 32 * kk, lane), bfs, o[mt]); }
    __syncthreads();
#pragma unroll
    for (int mt = 0; mt < 4; ++mt)
#pragma unroll
        for (int r = 0; r < 4; ++r) { const int c = 16 * mt + 4 * fq + r; const float og = bf2f(P[(r0 + c) * PBW + PC_ML_O + h * HD + 16 * wave + fr]);
            const float hv = o[mt][r] / sc[256 + c] * sigmoidf_(og); o[mt][r] = hv;
            float s = hv * hv; s += __shfl_xor(s, 1); s += __shfl_xor(s, 2); s += __shfl_xor(s, 4); s += __shfl_xor(s, 8);
            if (fr == 0) rsp[wave * 64 + c] = s; }
    __syncthreads();
    const float* ng = A.in[I_ML_NG] + l * GW + h * HD; const float gn = ng[16 * wave + fr];
#pragma unroll
    for (int mt = 0; mt < 4; ++mt)
#pragma unroll
        for (int r = 0; r < 4; ++r) { const int c = 16 * mt + 4 * fq + r; float ss = 0.f;
#pragma unroll
            for (int w = 0; w < 8; ++w) ss += rsp[w * 64 + c];
            mix[(r0 + c) * DM + 1024 + h * HD + 16 * wave + fr] = (bf16)f2bf(o[mt][r] * rsqrtf(ss * (1.0f / 128.0f) + RMS_EPS) * gn); }
    __syncthreads();
}

constexpr int FG_LM = 52224, FG_S = 129024;
template <int C> struct GdnSolve {
    static __device__ __forceinline__ void run(float (&sol)[64], const LAS float* Lm) {
        if constexpr (C < 64) {
            float acc = sol[C];
#pragma unroll
            for (int s = 0; s < C; ++s) acc -= Lm[C * 64 + s] * sol[s];
            sol[C] = acc;
            GdnSolve<C + 1>::run(sol, Lm);
        }
    }
};
__device__ __forceinline__ void f_gdn_p2(ArgsR A, int l, int item, LAS unsigned char* lds, int tid) {
    const int n = item & 31, h = (item >> 5) & 3, b = item >> 7; const int lane = tid & 63, wave = __builtin_amdgcn_readfirstlane(tid >> 6), fr = lane & 15, fq = lane >> 4;
    const bf16* P = (const bf16*)(A.ws + WS_P); const float* Ps = (const float*)(A.ws + WS_PS);
    bf16* U0 = (bf16*)(A.ws + WS_GDN_U0) + (size_t)item * 8192; bf16* Wg = (bf16*)(A.ws + WS_GDN_W) + (size_t)item * 8192; bf16* QD = (bf16*)(A.ws + WS_GDN_QD) + (size_t)item * 8192;
    bf16* KE = (bf16*)(A.ws + WS_GDN_KE) + (size_t)item * 8192; bf16* QK = (bf16*)(A.ws + WS_GDN_QK) + (size_t)item * 4096; float* DE = (float*)(A.ws + WS_GDN_DE);
    LAS bf16* qs = (LAS bf16*)(lds + FL_Q); LAS bf16* ks = (LAS bf16*)(lds + FL_K); LAS bf16* vs = (LAS bf16*)(lds + FL_V); LAS float* Lm = (LAS float*)(lds + FG_LM); LAS float* sc = (LAS float*)(lds + FG_S);
    const float* cw = A.in[I_GDN_CW] + (size_t)l * 4 * 1536;
    const size_t r0 = (size_t)b * SEQ + n * CHK;
    { const int v = tid & 127, dq = tid >> 7;
#pragma unroll 1
        for (int part = 0; part < 3; ++part) {
            const int pc = (part == 0 ? PC_GDN_Q : part == 1 ? PC_GDN_K : PC_GDN_V) + h * HD + v, wc = part * 512 + h * HD + v;
            const float w0 = cw[wc], w1 = cw[1536 + wc], w2 = cw[2 * 1536 + wc], w3 = cw[3 * 1536 + wc];
            LAS bf16* dst = part == 0 ? qs : part == 1 ? ks : vs;
            const int c0 = dq * 16; const long t0 = (long)n * CHK + c0;
            float xm3 = (t0 - 3 >= 0) ? bf2f(P[(r0 + c0 - 3) * PBW + pc]) : 0.f, xm2 = (t0 - 2 >= 0) ? bf2f(P[(r0 + c0 - 2) * PBW + pc]) : 0.f, xm1 = (t0 - 1 >= 0) ? bf2f(P[(r0 + c0 - 1) * PBW + pc]) : 0.f;
#pragma unroll 4
            for (int i = 0; i < 16; ++i) { const float x0 = bf2f(P[(r0 + c0 + i) * PBW + pc]); const float y = w0 * xm3 + w1 * xm2 + w2 * xm1 + w3 * x0;
                dst[(c0 + i) * LD128 + v] = (bf16)f2bf(siluf_(y)); xm3 = xm2; xm2 = xm1; xm1 = x0; } } }
    if (wave == 0) { const float bt = sigmoidf_(Ps[(r0 + lane) * 32 + PS_GB + h]);
        const float g = -__expf(A.in[I_GDN_ALOG][l * NH + h]) * softplusf_(Ps[(r0 + lane) * 32 + PS_GA + h] + A.in[I_GDN_DTB][l * NH + h]);
        const float gam = wave_scan_add(g, lane); sc[lane] = bt; sc[64 + lane] = gam; if (lane == 63) DE[item] = __expf(gam); }
    __syncthreads();
#pragma unroll 1
    for (int rr = 0; rr < 8; ++rr) { const int c = wave * 8 + rr;
        const float q1 = bf2f(qs[c * LD128 + lane]), q2 = bf2f(qs[c * LD128 + 64 + lane]), k1 = bf2f(ks[c * LD128 + lane]), k2 = bf2f(ks[c * LD128 + 64 + lane]);
        const float sq = wave_sum(q1 * q1 + q2 * q2), sk = wave_sum(k1 * k1 + k2 * k2);
        if (lane == 0) { sc[128 + c] = rsqrtf(sq + 1e-6f) * 0.08838834764831845f; sc[192 + c] = rsqrtf(sk + 1e-6f); } }
    __syncthreads();
    { const int mt = wave >> 1; f32x4 akk[2] = {{0.f, 0.f, 0.f, 0.f}, {0.f, 0.f, 0.f, 0.f}}, aqk[2] = {{0.f, 0.f, 0.f, 0.f}, {0.f, 0.f, 0.f, 0.f}};
#pragma unroll
        for (int kk = 0; kk < 4; ++kk) { const bf16x8 ak = frag_rd(ks, LD128, 16 * mt, 32 * kk, lane), aq = frag_rd(qs, LD128, 16 * mt, 32 * kk, lane);
#pragma unroll
            for (int q = 0; q < 2; ++q) { const bf16x8 bk = frag_rd(ks, LD128, 16 * (2 * (wave & 1) + q), 32 * kk, lane); akk[q] = MFMA16(ak, bk, akk[q]); aqk[q] = MFMA16(aq, bk, aqk[q]); } }
#pragma unroll
        for (int q = 0; q < 2; ++q) { const int s = 16 * (2 * (wave & 1) + q) + fr; const float rks = sc[192 + s], gs = sc[64 + s];
#pragma unroll
            for (int r = 0; r < 4; ++r) { const int c = 16 * mt + 4 * fq + r; const float dcy = __expf(sc[64 + c] - gs);
                Lm[c * 64 + s] = (s < c) ? sc[c] * akk[q][r] * sc[192 + c] * rks * dcy : 0.f;
                QK[c * 64 + s] = (bf16)f2bf((s <= c) ? aqk[q][r] * sc[128 + c] * rks * dcy : 0.f); } } }
    __syncthreads();
    if (tid < 256) {
        float sol[64]; const bool isw = tid >= 128; const int j = tid & 127;
#pragma unroll
        for (int c = 0; c < 64; ++c) { const float bt = sc[c]; sol[c] = isw ? bf2f(ks[c * LD128 + j]) * sc[192 + c] * bt * __expf(sc[64 + c]) : bf2f(vs[c * LD128 + j]) * bt; }
        GdnSolve<1>::run(sol, Lm);
        bf16* dst = isw ? Wg : U0;
#pragma unroll
        for (int c = 0; c < 64; ++c) dst[c * 128 + j] = (bf16)f2bf(sol[c]);
    } else {
        const int t2 = tid - 256; const float glast = sc[64 + 63];
#pragma unroll
        for (int i = 0; i < 8; ++i) { const int idx = t2 + i * 256, which = idx >> 10, pi = idx & 1023, r = pi >> 4, c8 = (pi & 15) * 8;
            const float w = which == 0 ? sc[128 + r] * __expf(sc[64 + r]) : sc[192 + r] * __expf(glast - sc[64 + r]);
            v4u x = *(LAS v4u*)((which == 0 ? qs : ks) + r * LD128 + c8);
            x.x = pk2(bflo(x.x) * w, bfhi(x.x) * w); x.y = pk2(bflo(x.y) * w, bfhi(x.y) * w); x.z = pk2(bflo(x.z) * w, bfhi(x.z) * w); x.w = pk2(bflo(x.w) * w, bfhi(x.w) * w);
            *(GAS v4u*)((which == 0 ? QD : KE) + r * 128 + c8) = x; }
    }
    __syncthreads();
}

constexpr int FC_W = 0, FC_QD = 17408, FC_KE = 34816, FC_U0 = 52224, FC_QK = 69632;
__device__ __forceinline__ void f_gdn_p3(ArgsR A, int bh, LAS unsigned char* lds, int tid) {
    const int lane = tid & 63, wave = __builtin_amdgcn_readfirstlane(tid >> 6), fr = lane & 15, fq = lane >> 4; const int b = bh >> 2, h = bh & 3;
    const bf16* U0 = (const bf16*)(A.ws + WS_GDN_U0) + (size_t)bh * 32 * 8192; const bf16* Wg = (const bf16*)(A.ws + WS_GDN_W) + (size_t)bh * 32 * 8192; const bf16* QD = (const bf16*)(A.ws + WS_GDN_QD) + (size_t)bh * 32 * 8192;
    const bf16* KE = (const bf16*)(A.ws + WS_GDN_KE) + (size_t)bh * 32 * 8192; const bf16* QK = (const bf16*)(A.ws + WS_GDN_QK) + (size_t)bh * 32 * 4096; const float* DE = (const float*)(A.ws + WS_GDN_DE) + bh * 32;
    float* Og = (float*)(A.ws + WS_GDN_O);
    LAS bf16* ws_ = (LAS bf16*)(lds + FC_W); LAS bf16* qds = (LAS bf16*)(lds + FC_QD); LAS bf16* kes = (LAS bf16*)(lds + FC_KE); LAS bf16* u0s = (LAS bf16*)(lds + FC_U0); LAS bf16* qks = (LAS bf16*)(lds + FC_QK);
    f32x4 S[8];
#pragma unroll
    for (int i = 0; i < 8; ++i) S[i] = (f32x4){0.f, 0.f, 0.f, 0.f};
    v4u st[9];
    auto issue = [&](int n) {
#pragma unroll
        for (int i = 0; i < 8; ++i) { const int idx = tid + i * NTHREADS, which = idx >> 10, pi = idx & 1023;
            const bf16* src = (which == 0 ? Wg : which == 1 ? QD : which == 2 ? KE : U0) + (size_t)n * 8192; st[i] = *(const GAS v4u*)(src + pi * 8); }
        st[8] = *(const GAS v4u*)(QK + (size_t)n * 4096 + tid * 8);
    };
    auto commit = [&]() {
#pragma unroll
        for (int i = 0; i < 8; ++i) { const int idx = tid + i * NTHREADS, which = idx >> 10, pi = idx & 1023, r = pi >> 4, c8 = (pi & 15) * 8;
            *(LAS v4u*)((LAS bf16*)(lds + which * 17408) + r * LD128 + c8) = st[i]; }
        { const int r = tid >> 3, c8 = (tid & 7) * 8; *(LAS v4u*)(qks + r * LD64 + c8) = st[8]; }
    };
    issue(0);
#pragma unroll 1
    for (int n = 0; n < NCHK; ++n) {
        __syncthreads();
        commit();
        __syncthreads();
        if (n + 1 < NCHK) issue(n + 1);
        const float de = DE[n];
        bf16x8 SB[4];
#pragma unroll
        for (int kb = 0; kb < 4; ++kb) SB[kb] = pack_acc(S[2 * kb], S[2 * kb + 1]);
        f32x4 u[4], o[4];
#pragma unroll
        for (int mt = 0; mt < 4; ++mt) { f32x4 ws2 = {0.f, 0.f, 0.f, 0.f}; o[mt] = (f32x4){0.f, 0.f, 0.f, 0.f};
#pragma unroll
            for (int kb = 0; kb < 4; ++kb) { ws2 = MFMA16(frag_rd_perm(ws_, LD128, 16 * mt, 32 * kb, lane), SB[kb], ws2); o[mt] = MFMA16(frag_rd_perm(qds, LD128, 16 * mt, 32 * kb, lane), SB[kb], o[mt]); }
#pragma unroll
            for (int r = 0; r < 4; ++r) u[mt][r] = bf2f(u0s[(16 * mt + 4 * fq + r) * LD128 + 16 * wave + fr]) - ws2[r]; }
        const bf16x8 UB0 = pack_acc(u[0], u[1]), UB1 = pack_acc(u[2], u[3]);
#pragma unroll
        for (int mt = 0; mt < 4; ++mt) { o[mt] = MFMA16(frag_rd_perm(qks, LD64, 16 * mt, 0, lane), UB0, o[mt]); o[mt] = MFMA16(frag_rd_perm(qks, LD64, 16 * mt, 32, lane), UB1, o[mt]); }
#pragma unroll
        for (int dt = 0; dt < 8; ++dt) { f32x4 sn = S[dt] * de;
            sn = MFMA16(frag_tr_perm(kes, LD128, 0, 16 * dt, lane), UB0, sn); sn = MFMA16(frag_tr_perm(kes, LD128, 32, 16 * dt, lane), UB1, sn); S[dt] = sn; }
        const size_t r0 = (size_t)b * SEQ + n * CHK;
#pragma unroll
        for (int mt = 0; mt < 4; ++mt)
#pragma unroll
            for (int r = 0; r < 4; ++r) Og[(r0 + 16 * mt + 4 * fq + r) * GW + h * HD + 16 * wave + fr] = o[mt][r];
    }
    __syncthreads();
}
__device__ __forceinline__ void f_gdn_p4(ArgsR A, int l, int item, int tid) {
    const int lane = tid & 63, wave = tid >> 6; const bf16* P = (const bf16*)(A.ws + WS_P); bf16* mix = (bf16*)(A.ws + WS_MIX); const float* Og = (const float*)(A.ws + WS_GDN_O);
    const float* ng = A.in[I_GDN_NG] + l * GW + lane * 8;
    const f32x4 g0 = *(const GAS f32x4*)ng, g1 = *(const GAS f32x4*)(ng + 4);
#pragma unroll 2
    for (int rr = 0; rr < 8; ++rr) { const size_t t = (size_t)item * 64 + wave * 8 + rr;
        const f32x4 a = *(const GAS f32x4*)(Og + t * GW + lane * 8), c = *(const GAS f32x4*)(Og + t * GW + lane * 8 + 4);
        float s = (a[0] * a[0] + a[1] * a[1]) + (a[2] * a[2] + a[3] * a[3]) + (c[0] * c[0] + c[1] * c[1]) + (c[2] * c[2] + c[3] * c[3]);
        s += __shfl_xor(s, 1); s += __shfl_xor(s, 2); s += __shfl_xor(s, 4); s += __shfl_xor(s, 8);
        const float rs = rsqrtf(s * (1.0f / 128.0f) + RMS_EPS);
        const v4u gw = *(const GAS v4u*)(P + t * PBW + PC_GDN_G + lane * 8);
        v4u o; o.x = pk2(a[0] * rs * g0[0] * siluf_(bflo(gw.x)), a[1] * rs * g0[1] * siluf_(bfhi(gw.x))); o.y = pk2(a[2] * rs * g0[2] * siluf_(bflo(gw.y)), a[3] * rs * g0[3] * siluf_(bfhi(gw.y)));
        o.z = pk2(c[0] * rs * g1[0] * siluf_(bflo(gw.z)), c[1] * rs * g1[1] * siluf_(bfhi(gw.z))); o.w = pk2(c[2] * rs * g1[2] * siluf_(bflo(gw.w)), c[3] * rs * g1[3] * siluf_(bfhi(gw.w)));
        *(GAS v4u*)(mix + t * DM + 1536 + lane * 8) = o; }
}

#ifndef FAST_MASK
#define FAST_MASK 15
#endif
__device__ __forceinline__ void mix_p2(ArgsR A, int l, LAS unsigned char* lds, int G, int tid) {
    const int bx = blockIdx.x;
    if (FAST_MASK & 2) for (int it = bx; it < 512; it += G) f_gla_p2(A, l, it, lds, pg8::fresh_tid());
    if (FAST_MASK & 4) for (int it = bx; it < 512; it += G) f_ml_p2(A, l, it, lds, pg8::fresh_tid());
    if (FAST_MASK & 8) for (int it = bx; it < 512; it += G) f_gdn_p2(A, l, it, lds, pg8::fresh_tid());
    if (FAST_MASK & 1) for (int it = bx; it < 1024; it += G) f_lru_p2(A, l, it, lds, pg8::fresh_tid());
    if ((FAST_MASK & 15) != 15) {
        for (int it = bx; it < 80; it += G) {
            if (it < 16) { if (!(FAST_MASK & 2)) nm_gla(A, l, it >> 2, it & 3, lds, pg8::fresh_tid()); }
            else if (it < 32) { if (!(FAST_MASK & 4)) nm_mlstm(A, l, (it - 16) >> 2, (it - 16) & 3, lds, pg8::fresh_tid()); }
            else if (it < 48) { if (!(FAST_MASK & 8)) nm_gdn(A, l, (it - 32) >> 2, (it - 32) & 3, lds, pg8::fresh_tid()); }
            else { if (!(FAST_MASK & 1)) nm_lru(A, l, (it - 48) >> 3, (it - 48) & 7, lds, pg8::fresh_tid()); }
            __syncthreads();
        }
    }
}
__device__ __forceinline__ void mix_p3(ArgsR A, int l, LAS unsigned char* lds, int G, int tid) {
    const int bx = blockIdx.x; (void)l;
    int first = 0, nb = G;
    if ((FAST_MASK & 8) && G > 32) { if (bx < 16) { f_gdn_p3(A, bx, lds, pg8::fresh_tid()); return; } first = 16; nb = G - 16; }
    else if (FAST_MASK & 8) { for (int it = bx; it < 16; it += G) f_gdn_p3(A, it, lds, pg8::fresh_tid()); }
    for (int it = bx - first; it < 516; it += nb) {
        if (it < 256) { if (FAST_MASK & 2) f_gla_p3(A, it, pg8::fresh_tid()); }
        else if (it < 512) { if (FAST_MASK & 4) f_ml_p3(A, it - 256, pg8::fresh_tid()); }
        else { if (FAST_MASK & 1) f_lru_p3(A, it - 512, pg8::fresh_tid()); }
    }
}
__device__ __forceinline__ void mix_p4(ArgsR A, int l, LAS unsigned char* lds, int G, int tid) {
    const int bx = blockIdx.x;
    if (FAST_MASK & 2) for (int it = bx; it < 512; it += G) f_gla_p4(A, l, it, lds, pg8::fresh_tid());
    if (FAST_MASK & 4) for (int it = bx; it < 512; it += G) f_ml_p4(A, l, it, lds, pg8::fresh_tid());
    for (int it = bx; it < 256; it += G) {
        if (it < 128) { if (FAST_MASK & 8) f_gdn_p4(A, l, it, pg8::fresh_tid()); }
        else { if (FAST_MASK & 1) f_lru_p4(A, it - 128, pg8::fresh_tid()); }
    }
}

constexpr int PE_SC = 0, PE_TV = 66560, PE_TI = 75264, PE_SEL = 83968;
constexpr int SC_LD = 129, TL_LD = 17;

__device__ __forceinline__ float dot2bf(unsigned a, unsigned b, float c) { asm("v_dot2c_f32_bf16 %0, %1, %2" : "+v"(c) : "v"(a), "v"(b)); return c; }
__device__ __forceinline__ unsigned f2sortable(float f) { const unsigned u = __builtin_bit_cast(unsigned, f); return (u & 0x80000000u) ? ~u : (u | 0x80000000u); }

__device__ __forceinline__ void peer_phase(ArgsR A, int l, bool last, LAS unsigned char* lds, int G, int tid) {
    const int wave = __builtin_amdgcn_readfirstlane(tid >> 6), lane = tid & 63;
    unsigned char* ws = A.ws;
    const bf16* Q = (const bf16*)(ws + WS_Q);
    const bf16* K1 = (const bf16*)(ws + WS_K1) + (size_t)l * 8 * 128 * 128; const bf16* K2 = (const bf16*)(ws + WS_K2) + (size_t)l * 8 * 128 * 128;
    const unsigned char* Ub = ws + WS_UB + (size_t)l * TAB_L; const unsigned char* Vb = ws + WS_VB + (size_t)l * TAB_L;
    const float* ssp = (const float*)(ws + WS_SSP); float* X = A.out; bf16* xb = (bf16*)(ws + WS_XB); float* rstd1 = (float*)(ws + WS_RSTD1);
    const float* g2 = A.in[I_N2G] + l * DM; const float* gf = A.in[I_FNG];
    LAS float* sc = (LAS float*)(lds + PE_SC); LAS float* tv = (LAS float*)(lds + PE_TV); LAS int* ti = (LAS int*)(lds + PE_TI); LAS v2u* sel = (LAS v2u*)(lds + PE_SEL);
#pragma unroll 1
    for (int item = blockIdx.x; item < NT / 32; item += G) {
        const int tok0 = item * 32;
#pragma unroll 1
        for (int pass = 0; pass < 4; ++pass) {
            { const int hh = wave >> 2, side = (wave >> 1) & 1, mt = wave & 1, h = 2 * pass + hh, fr = lane & 15, fq = lane >> 4;
                const bf16* qa = Q + (size_t)(tok0 + 16 * mt + fr) * DM + h * 256 + side * 128 + 8 * fq;
                const bf16* kb = (side ? K2 : K1) + (size_t)h * 128 * 128 + (size_t)fr * 128 + 8 * fq;
                bf16x8 af[4];
#pragma unroll
                for (int ks = 0; ks < 4; ++ks) af[ks] = *(const GAS bf16x8*)(qa + 32 * ks);
#pragma unroll
                for (int nt = 0; nt < 8; ++nt) { f32x4 acc = {0.f, 0.f, 0.f, 0.f};
#pragma unroll
                    for (int ks = 0; ks < 4; ++ks) { const bf16x8 bfr = *(const GAS bf16x8*)(kb + (size_t)nt * 16 * 128 + 32 * ks); acc = __builtin_amdgcn_mfma_f32_16x16x32_bf16(af[ks], bfr, acc, 0, 0, 0); }
                    const int rowb = (hh * 2 + side) * 32 + 16 * mt + 4 * fq;
#pragma unroll
                    for (int r = 0; r < 4; ++r) sc[(rowb + r) * SC_LD + 16 * nt + fr] = acc[r]; } }
            __syncthreads();
            if (tid < 128) { unsigned L[16];
#pragma unroll
                for (int i = 0; i < 16; ++i) L[i] = 0u;
                const LAS float* row = sc + tid * SC_LD;
#pragma unroll 4
                for (int i = 0; i < 128; ++i) { unsigned x = (f2sortable(row[i]) & ~127u) | (unsigned)i;
#pragma unroll
                    for (int s = 0; s < 16; ++s) { const unsigned hi = L[s] > x ? L[s] : x, lo = L[s] > x ? x : L[s]; L[s] = hi; x = lo; } }
#pragma unroll
                for (int s = 0; s < 16; ++s) { const int idx = (int)(L[s] & 127u); tv[tid * TL_LD + s] = row[idx]; ti[tid * TL_LD + s] = idx; } }
            __syncthreads();
            if (tid < 64) { const int hh = tid >> 5, tk = tid & 31, r1 = (hh * 2) * 32 + tk, r2 = (hh * 2 + 1) * 32 + tk, h = 2 * pass + hh;
                float LV[16]; int LI[16];
#pragma unroll
                for (int s = 0; s < 16; ++s) { LV[s] = -3.0e38f; LI[s] = 0; }
#pragma unroll 1
                for (int a = 0; a < 16; ++a) { const float va = tv[r1 * TL_LD + a]; const int ia = ti[r1 * TL_LD + a] * 128; const int nb = 16 / (a + 1);
#pragma unroll 1
                    for (int bb = 0; bb < nb; ++bb) { float x = va + tv[r2 * TL_LD + bb]; int xi = ia + ti[r2 * TL_LD + bb];
#pragma unroll
                        for (int s = 0; s < 16; ++s) { const bool gt = x > LV[s]; const float tvv = gt ? x : LV[s]; const int tii = gt ? xi : LI[s]; x = gt ? LV[s] : x; xi = gt ? LI[s] : xi; LV[s] = tvv; LI[s] = tii; } } }
                float den = 0.f, e[16];
#pragma unroll
                for (int s = 0; s < 16; ++s) { e[s] = __expf(LV[s] - LV[0]); den += e[s]; }
                const float inv = 1.0f / den;
#pragma unroll
                for (int s = 0; s < 16; ++s) { v2u w; w.x = (unsigned)LI[s]; w.y = __builtin_bit_cast(unsigned, e[s] * inv); sel[(tk * 8 + h) * 16 + s] = w; } }
            __syncthreads();
        }
#pragma unroll 1
        for (int tt = 0; tt < 4; ++tt) {
            const int tl = wave * 4 + tt; const size_t t = (size_t)tok0 + tl;
            float s2 = (lane < 32) ? ssp[t * 32 + lane] : 0.f; s2 = wave_sum(s2);
            const float rstd2 = rsqrtf(s2 * (1.0f / DM) + RMS_EPS);
            v4u hb[4];
#pragma unroll
            for (int j = 0; j < 4; ++j) { const size_t e0 = 8 * (size_t)(lane + 64 * j);
                const f32x4 xa = *(const GAS f32x4*)(X + t * DM + e0), xc = *(const GAS f32x4*)(X + t * DM + e0 + 4);
                const f32x4 ga = *(const GAS f32x4*)(g2 + e0), gc = *(const GAS f32x4*)(g2 + e0 + 4);
                hb[j].x = pk2(xa[0] * rstd2 * ga[0], xa[1] * rstd2 * ga[1]); hb[j].y = pk2(xa[2] * rstd2 * ga[2], xa[3] * rstd2 * ga[3]);
                hb[j].z = pk2(xc[0] * rstd2 * gc[0], xc[1] * rstd2 * gc[1]); hb[j].w = pk2(xc[2] * rstd2 * gc[2], xc[3] * rstd2 * gc[3]); }
            float y[32];
#pragma unroll
            for (int i = 0; i < 32; ++i) y[i] = 0.f;
#pragma unroll 1
            for (int g = 0; g < 32; ++g) {
                int ids[4]; float gts[4];
#pragma unroll
                for (int e = 0; e < 4; ++e) { const v2u w = sel[tl * 128 + g * 4 + e]; ids[e] = __builtin_amdgcn_readfirstlane((int)w.x); gts[e] = __builtin_bit_cast(float, __builtin_amdgcn_readfirstlane((int)w.y)); }
                const unsigned lo16 = (unsigned)lane * 16u;
                v4u uu[4][4];
#pragma unroll
                for (int e = 0; e < 4; ++e) { const GAS unsigned char* rb = (const GAS unsigned char*)Ub + (size_t)ids[e] * 4096;
#pragma unroll
                    for (int j = 0; j < 4; ++j) uu[e][j] = *(const GAS v4u*)(rb + lo16 + j * 1024); }
                float cf[4];
#pragma unroll
                for (int e = 0; e < 4; ++e) { float d = 0.f;
#pragma unroll
                    for (int j = 0; j < 4; ++j) {
                        d = dot2bf(uu[e][j].x, hb[j].x, d);
                        d = dot2bf(uu[e][j].y, hb[j].y, d);
                        d = dot2bf(uu[e][j].z, hb[j].z, d);
                        d = dot2bf(uu[e][j].w, hb[j].w, d); }
                    d = wave_sum(d); cf[e] = gts[e] * gelu_tanh(d); }
                v4u vv[4][4];
#pragma unroll
                for (int e = 0; e < 4; ++e) { const GAS unsigned char* rb = (const GAS unsigned char*)Vb + (size_t)ids[e] * 4096;
#pragma unroll
                    for (int j = 0; j < 4; ++j) vv[e][j] = *(const GAS v4u*)(rb + lo16 + j * 1024); }
#pragma unroll
                for (int e = 0; e < 4; ++e)
#pragma unroll
                    for (int j = 0; j < 4; ++j) { const v4u w = vv[e][j]; const float c = cf[e];
                        y[j * 8 + 0] += c * bflo(w.x); y[j * 8 + 1] += c * bfhi(w.x); y[j * 8 + 2] += c * bflo(w.y); y[j * 8 + 3] += c * bfhi(w.y);
                        y[j * 8 + 4] += c * bflo(w.z); y[j * 8 + 5] += c * bfhi(w.z); y[j * 8 + 6] += c * bflo(w.w); y[j * 8 + 7] += c * bfhi(w.w); }
            }
            float ss = 0.f;
#pragma unroll
            for (int j = 0; j < 4; ++j) { const size_t e0 = 8 * (size_t)(lane + 64 * j);
                const f32x4 xa = *(const GAS f32x4*)(X + t * DM + e0), xc = *(const GAS f32x4*)(X + t * DM + e0 + 4);
#pragma unroll
                for (int k = 0; k < 4; ++k) { y[j * 8 + k] += xa[k]; y[j * 8 + 4 + k] += xc[k]; }
#pragma unroll
                for (int k = 0; k < 8; ++k) ss += y[j * 8 + k] * y[j * 8 + k]; }
            ss = wave_sum(ss);
            const float rs = rsqrtf(ss * (1.0f / DM) + RMS_EPS);
            if (last) {
#pragma unroll
                for (int j = 0; j < 4; ++j) { const size_t e0 = 8 * (size_t)(lane + 64 * j);
                    const f32x4 ga = *(const GAS f32x4*)(gf + e0), gc = *(const GAS f32x4*)(gf + e0 + 4);
                    f32x4 oa = {y[j * 8 + 0] * rs * ga[0], y[j * 8 + 1] * rs * ga[1], y[j * 8 + 2] * rs * ga[2], y[j * 8 + 3] * rs * ga[3]};
                    f32x4 oc = {y[j * 8 + 4] * rs * gc[0], y[j * 8 + 5] * rs * gc[1], y[j * 8 + 6] * rs * gc[2], y[j * 8 + 7] * rs * gc[3]};
                    *(GAS f32x4*)(X + t * DM + e0) = oa; *(GAS f32x4*)(X + t * DM + e0 + 4) = oc; }
            } else {
#pragma unroll
                for (int j = 0; j < 4; ++j) { const size_t e0 = 8 * (size_t)(lane + 64 * j);
                    f32x4 oa = {y[j * 8 + 0], y[j * 8 + 1], y[j * 8 + 2], y[j * 8 + 3]}, oc = {y[j * 8 + 4], y[j * 8 + 5], y[j * 8 + 6], y[j * 8 + 7]};
                    *(GAS f32x4*)(X + t * DM + e0) = oa; *(GAS f32x4*)(X + t * DM + e0 + 4) = oc;
                    v4u w; w.x = pk2(oa[0], oa[1]); w.y = pk2(oa[2], oa[3]); w.z = pk2(oc[0], oc[1]); w.w = pk2(oc[2], oc[3]);
                    *(GAS v4u*)(xb + t * DM + e0) = w; }
                if (lane == 0) rstd1[t] = rs;
            }
        }
        __syncthreads();
    }
}

#ifndef MK_PER_PHASE
#define MK_PER_PHASE 0
#endif
constexpr int PPL = 7, NPHASE = 1 + PPL * DEPTH;
constexpr int CW_BAR = 4096;

__global__ void __launch_bounds__(NTHREADS, 2) mk_fwd(Args args) {
    extern __shared__ __attribute__((aligned(16))) unsigned char lds_raw[];
    LAS unsigned char* lds = (LAS unsigned char*)lds_raw;
    volatile LAS unsigned* MISC = (volatile LAS unsigned*)(lds + MISC_OFF);
    const int tid = threadIdx.x, lane = tid & 63, wave = __builtin_amdgcn_readfirstlane(tid >> 6);
    const int G = gridDim.x; const int bx = blockIdx.x; const int vcu = (G % 8 == 0) ? (bx % 8) * (G / 8) + bx / 8 : bx;
    unsigned char* ws = args.ws;
    if (tid < 64) MISC[tid] = 0u;
    __syncthreads();
    XcdBarrier bar; bar.bar = (unsigned*)(ws + WS_CTL) + CW_BAR; bar.x = 0; bar.st = nullptr;
    if (!MK_PER_PHASE) bar = xcd_barrier_post((unsigned*)(ws + WS_CTL) + CW_BAR, MISC + 8);
    const int lo = args.ph_lo, hi = args.ph_hi;
#define IN(k) (lo <= (k) && (k) < hi)
#define SEAM(k) do { if (IN(k) && IN((k) + 1)) xcd_barrier(bar); } while (0)

    if (IN(0)) { const int t0 = pg8::fresh_tid(); p0_prologue(*kargs(), lds, vcu, G, __builtin_amdgcn_readfirstlane(t0 >> 6), t0 & 63); SEAM(0); }
#pragma unroll 1
    for (int l = 0; l < DEPTH; ++l) {
        const int pb = 1 + PPL * l;
        if (IN(pb)) {
            pg8::Gemm g{(const pg8::bf16_t*)(ws + WS_XB), (const pg8::bf16_t*)(ws + WS_WIN + l * WIN_L), NT, NINP, DM}; pg8::StaticOrder S; S.init(NT, NINP, G, bx);
            pg8::EpiP E{(pg8::bf16_t*)(ws + WS_P), (float*)(ws + WS_PS), (const float*)(ws + WS_RSTD1)};
            pg8::gemm_phase<pg8::EpiP, pg8::StaticOrder, true, true>(lds, g, S, E);
            SEAM(pb);
        }
        if (IN(pb + 1)) { mix_p2(*kargs(), l, lds, G, pg8::fresh_tid()); SEAM(pb + 1); }
        if (IN(pb + 2)) { mix_p3(*kargs(), l, lds, G, pg8::fresh_tid()); SEAM(pb + 2); }
        if (IN(pb + 3)) { mix_p4(*kargs(), l, lds, G, pg8::fresh_tid()); SEAM(pb + 3); }
        if (IN(pb + 4)) {
            pg8::Gemm g{(const pg8::bf16_t*)(ws + WS_MIX), (const pg8::bf16_t*)(ws + WS_WOUT + l * WSQ_L), NT, DM, DM}; pg8::StaticOrder S; S.init(NT, DM, G, bx);
            pg8::EpiX E{l == 0 ? args.in[I_X] : (const float*)args.out, args.out, (pg8::bf16_t*)(ws + WS_XB), (float*)(ws + WS_SSP)};
            pg8::gemm_phase<pg8::EpiX, pg8::StaticOrder, true, true>(lds, g, S, E);
            SEAM(pb + 4);
        }
        if (IN(pb + 5)) {
            pg8::Gemm g{(const pg8::bf16_t*)(ws + WS_XB), (const pg8::bf16_t*)(ws + WS_WQ + l * WSQ_L), NT, DM, DM}; pg8::StaticOrder S; S.init(NT, DM, G, bx);
            pg8::EpiQ E{(pg8::bf16_t*)(ws + WS_Q), (const float*)(ws + WS_SSP)};
            pg8::gemm_phase<pg8::EpiQ, pg8::StaticOrder, true, true>(lds, g, S, E);
            SEAM(pb + 5);
        }
        if (IN(pb + 6)) { peer_phase(*kargs(), l, l == DEPTH - 1, lds, G, pg8::fresh_tid()); SEAM(pb + 6); }
    }
#undef IN
#undef SEAM
}

extern "C" void kernel_launch(void* const* d_in, const int* in_sizes, int n_in, void* d_out, int out_size, void* d_ws, size_t ws_size, hipStream_t stream) {
    static int grid = 0;
    if (grid == 0) {
        if (n_in != N_IN || out_size != NT * DM || ws_size < WS_END) { fprintf(stderr, "kernel_launch: unexpected shapes: n_in %d out %d ws %zu (need %zu)\n", n_in, out_size, ws_size, (size_t)WS_END); grid = -1; return; }
        int dev = 0, cus = 0, per_cu = 0;
        if (hipGetDevice(&dev) != hipSuccess || hipDeviceGetAttribute(&cus, hipDeviceAttributeMultiprocessorCount, dev) != hipSuccess) { grid = -1; return; }
        if (hipFuncSetAttribute((const void*)mk_fwd, hipFuncAttributeMaxDynamicSharedMemorySize, LDS_BYTES) != hipSuccess) { fprintf(stderr, "kernel_launch: hipFuncSetAttribute failed\n"); grid = -1; return; }
        if (hipOccupancyMaxActiveBlocksPerMultiprocessor(&per_cu, (const void*)mk_fwd, NTHREADS, LDS_BYTES) != hipSuccess || per_cu < 1) { fprintf(stderr, "kernel_launch: occupancy query says %d blocks per CU\n", per_cu); (void)hipGetLastError(); grid = -1; return; }
        grid = cus;
    }
    if (grid < 0) return;
    if (hipMemsetAsync((char*)d_ws + WS_CTL, 0, CTL_ZERO_BYTES, stream) != hipSuccess) return;
    Args a{};
    for (int i = 0; i < N_IN; ++i) a.in[i] = (const float*)d_in[i];
    a.out = (float*)d_out; a.ws = (unsigned char*)d_ws;
#if MK_PER_PHASE
    for (int p = 0; p < NPHASE; ++p) { a.ph_lo = p; a.ph_hi = p + 1; a.li = 0; hipLaunchKernelGGL(mk_fwd, dim3(grid), dim3(NTHREADS), LDS_BYTES, stream, a); }
#else
    a.ph_lo = 0; a.ph_hi = NPHASE; a.li = 0;
    hipLaunchKernelGGL(mk_fwd, dim3(grid), dim3(NTHREADS), LDS_BYTES, stream, a);
#endif
}
```

```cpp
#include <hip/hip_runtime.h>
#include <cstdio>
#include <cstdint>
#define TAB_FP8 1
namespace pg8 {
__device__ __forceinline__ int fresh_tid() { int t = threadIdx.x; asm volatile("" : "+v"(t)); return t; }
#define PG8_LAS __attribute__((address_space(3)))
typedef unsigned short bf16_t;
typedef short bf16x8 __attribute__((ext_vector_type(8)));
typedef float f32x4 __attribute__((ext_vector_type(4)));
typedef unsigned u32x4 __attribute__((ext_vector_type(4)));
constexpr int BM = 256, BK = 64, HALF = 128, HTB = HALF * BK * 2  , STAGE_BYTES = 8 * HTB, NXCD = 8, WGM = 8;

__host__ __device__ __forceinline__ int lds_byte(int r, int c) { const int st = (r >> 4) * 2 + (c >> 5), rr = r & 15, cc = c & 31, ob = rr * 64 + cc * 2; return st * 1024 + (ob ^ (((ob >> 9) & 1) << 5)); }
__host__ __device__ __forceinline__ void stage_rc(int b, int& R, int& C) { const int st = b / 1024, sb = b % 1024, swz = sb ^ (((sb >> 9) & 1) << 5); R = (st >> 1) * 16 + swz / 64; C = (st & 1) * 32 + (swz % 64) / 2; }
__host__ __device__ __forceinline__ int perm32(int rho) { const int n = rho >> 4, i = rho & 15; return 8 * (i >> 2) + 4 * n + (i & 3); }

struct Unit { int pm, pn; };
struct Gemm { const bf16_t* A; const bf16_t* Bt; int M, N, K; };

struct StaticOrder {
    int nM, nN, nwg, G, c;
    __host__ __device__ void init(int M, int N, int G_, int c_) { nM = M / BM; nN = N / BM; nwg = nM * nN; G = G_; c = c_; }
    __host__ __device__ bool next(int i, Unit& u) const {
        const long L = (long)i * G + c; if (L >= nwg) return false;
        int wgid = (int)L; { const int q = nwg / NXCD, r = nwg % NXCD, xcd = wgid % NXCD, off = wgid / NXCD; wgid = (xcd < r ? xcd * (q + 1) : r * (q + 1) + (xcd - r) * q) + off; }
        const int nig = WGM * nN, gid = wgid / nig, fm = gid * WGM, gsz = (nM - fm) < WGM ? (nM - fm) : WGM;
        u.pm = fm + ((wgid % nig) % gsz); u.pn = (wgid % nig) / gsz; return true;
    }
    __device__ __forceinline__ void a_ready(const Unit&) const {}
    __device__ __forceinline__ void done(const Unit&) const {}
};


__device__ __forceinline__ unsigned cvt_pk_bf16(float lo, float hi) { unsigned r; asm volatile("v_cvt_pk_bf16_f32 %0, %1, %2" : "=v"(r) : "v"(lo), "v"(hi)); return r; }

struct EpiP {
    static constexpr bool PERM = true, AFTER_DRAIN = false;
    bf16_t* P; float* Ps; const float* rstd;
    __device__ __forceinline__ void operator()(const f32x4 (&acc)[2][2][4][2], const Unit& u, int wr, int wc, int fr, int fq) const {
        const int row0 = u.pm * BM + wr * 64 + fr;
        if (u.pn < 28) {
            const int col0 = u.pn * BM + wc * 32 + 8 * fq;
#pragma unroll
            for (int ai = 0; ai < 2; ++ai)
#pragma unroll
                for (int m = 0; m < 4; ++m) { const int row = row0 + ai * HALF + m * 16; const float r = rstd[row]; bf16_t* rowp = P + (size_t)row * 7168 + col0;
#pragma unroll
                    for (int bj = 0; bj < 2; ++bj) { const f32x4 v0 = acc[ai][bj][m][0] * r, v1 = acc[ai][bj][m][1] * r;
                        u32x4 w; w.x = cvt_pk_bf16(v0[0], v0[1]); w.y = cvt_pk_bf16(v0[2], v0[3]); w.z = cvt_pk_bf16(v1[0], v1[1]); w.w = cvt_pk_bf16(v1[2], v1[3]);
                        *(u32x4*)(rowp + bj * HALF) = w; } }
        } else if (wc == 0) {
#pragma unroll
            for (int ai = 0; ai < 2; ++ai)
#pragma unroll
                for (int m = 0; m < 4; ++m) { const int row = row0 + ai * HALF + m * 16; const float r = rstd[row]; float* p = Ps + (size_t)row * 32 + 8 * fq;
                    *(f32x4*)p = acc[ai][0][m][0] * r; *(f32x4*)(p + 4) = acc[ai][0][m][1] * r; }
        }
    }
};
struct EpiX {
    static constexpr bool PERM = true, AFTER_DRAIN = false;
    const float* xres; float* xout; bf16_t* xb; float* ssp;
    __device__ __forceinline__ void operator()(const f32x4 (&acc)[2][2][4][2], const Unit& u, int wr, int wc, int fr, int fq) const {
        const int row0 = u.pm * BM + wr * 64 + fr, col0 = u.pn * BM + wc * 32 + 8 * fq;
#pragma unroll
        for (int ai = 0; ai < 2; ++ai)
#pragma unroll
            for (int m = 0; m < 4; ++m) { const int row = row0 + ai * HALF + m * 16; float ss = 0.f;
#pragma unroll
                for (int bj = 0; bj < 2; ++bj) { const size_t off = (size_t)row * 2048 + col0 + bj * HALF;
                    const f32x4 r0 = *(const f32x4*)(xres + off), r1 = *(const f32x4*)(xres + off + 4);
                    const f32x4 v0 = acc[ai][bj][m][0] + r0, v1 = acc[ai][bj][m][1] + r1;
                    *(f32x4*)(xout + off) = v0; *(f32x4*)(xout + off + 4) = v1;
                    u32x4 w; w.x = cvt_pk_bf16(v0[0], v0[1]); w.y = cvt_pk_bf16(v0[2], v0[3]); w.z = cvt_pk_bf16(v1[0], v1[1]); w.w = cvt_pk_bf16(v1[2], v1[3]);
                    *(u32x4*)(xb + off) = w;
                    ss += (v0[0] * v0[0] + v0[1] * v0[1]) + (v0[2] * v0[2] + v0[3] * v0[3]) + (v1[0] * v1[0] + v1[1] * v1[1]) + (v1[2] * v1[2] + v1[3] * v1[3]); }
                ss += __shfl_xor(ss, 16); ss += __shfl_xor(ss, 32);
                if (fq == 0) ssp[(size_t)row * 32 + u.pn * 4 + wc] = ss; }
    }
};
struct EpiQ {
    static constexpr bool PERM = true, AFTER_DRAIN = false;
    bf16_t* Q; const float* ssp;
    __device__ __forceinline__ void operator()(const f32x4 (&acc)[2][2][4][2], const Unit& u, int wr, int wc, int fr, int fq) const {
        const int row0 = u.pm * BM + wr * 64 + fr, col0 = u.pn * BM + wc * 32 + 8 * fq;
#pragma unroll
        for (int ai = 0; ai < 2; ++ai)
#pragma unroll
            for (int m = 0; m < 4; ++m) { const int row = row0 + ai * HALF + m * 16;
                const f32x4* sp = (const f32x4*)(ssp + (size_t)row * 32 + 8 * fq); const f32x4 a = sp[0], b = sp[1];
                float s = ((a[0] + a[1]) + (a[2] + a[3])) + ((b[0] + b[1]) + (b[2] + b[3]));
                s += __shfl_xor(s, 16); s += __shfl_xor(s, 32);
                const float r = rsqrtf(s * (1.0f / 2048.0f) + 1e-6f); bf16_t* rowp = Q + (size_t)row * 2048 + col0;
#pragma unroll
                for (int bj = 0; bj < 2; ++bj) { const f32x4 v0 = acc[ai][bj][m][0] * r, v1 = acc[ai][bj][m][1] * r;
                    u32x4 w; w.x = cvt_pk_bf16(v0[0], v0[1]); w.y = cvt_pk_bf16(v0[2], v0[3]); w.z = cvt_pk_bf16(v1[0], v1[1]); w.w = cvt_pk_bf16(v1[2], v1[3]);
                    *(u32x4*)(rowp + bj * HALF) = w; } }
    }
};

template <class Epi, class Sched, bool ALIGN_EPI = false, bool SP2 = false>
__device__ __forceinline__ void gemm_phase(PG8_LAS unsigned char* lds, const Gemm g, const Sched& S, const Epi& E) {
    const int tid = fresh_tid(), wid = __builtin_amdgcn_readfirstlane(tid >> 6), lane = tid & 63, wr = wid >> 2, wc = wid & 3, fr = lane & 15, fq = lane >> 4;
    const int K = g.K, nt = K / BK;
    unsigned voffA[2], voffB[2];
#pragma unroll
    for (int i = 0; i < 2; ++i) { int R, C; stage_rc(tid * 16 + i * 8192, R, C); const int Rb = Epi::PERM ? ((R & ~31) + perm32(R & 31)) : R;
        voffA[i] = (unsigned)(R * K + C) * 2u; voffB[i] = (unsigned)(Rb * K + C) * 2u; }
    const size_t kstep = (size_t)(BK * 2);
    const size_t hstep = (size_t)HALF * K * 2;
    const size_t tstep = 2 * hstep;
    const unsigned ldsw = (unsigned)wid * 1024u;
    const int aoff = lds_byte(wr * 64 + fr, fq * 8), boff = lds_byte(wc * 32 + fr, fq * 8);
#define PG8_SA(b, h) (((b) * 2 + (h)) * HTB)
#define PG8_SB(b, h) ((4 + (b) * 2 + (h)) * HTB)
#define PG8_STAGE(bufoff, gbase, voff) do { _Pragma("unroll") for (int _i = 0; _i < 2; ++_i) \
        __builtin_amdgcn_global_load_lds((const unsigned*)((const char*)(gbase) + (voff)[_i]), (PG8_LAS unsigned*)(lds + (bufoff) + ldsw + _i * 8192), 16, 0, 0); } while (0)
#define PG8_LDA(dst, b, h) do { _Pragma("unroll") for (int m = 0; m < 4; ++m) _Pragma("unroll") for (int k = 0; k < 2; ++k) dst[m][k] = *(const PG8_LAS bf16x8*)(lds + PG8_SA(b, h) + aoff + m * 2048 + k * 1024); } while (0)
#define PG8_LDB(dst, b, h) do { _Pragma("unroll") for (int n = 0; n < 2; ++n) _Pragma("unroll") for (int k = 0; k < 2; ++k) dst[n][k] = *(const PG8_LAS bf16x8*)(lds + PG8_SB(b, h) + boff + n * 2048 + k * 1024); } while (0)
#define PG8_MMA(ai, bj, At, Bt) do { __builtin_amdgcn_s_setprio(1); _Pragma("unroll") for (int m = 0; m < 4; ++m) _Pragma("unroll") for (int n = 0; n < 2; ++n) _Pragma("unroll") for (int k = 0; k < 2; ++k) \
        acc[ai][bj][m][n] = __builtin_amdgcn_mfma_f32_16x16x32_bf16(Bt[n][k], At[m][k], acc[ai][bj][m][n], 0, 0, 0); __builtin_amdgcn_s_setprio(0); } while (0)
#define PG8_WAIT_V(n) asm volatile("s_waitcnt vmcnt(" #n ")" ::: "memory")
#define PG8_WAIT_L(n) asm volatile("s_waitcnt lgkmcnt(" #n ")" ::: "memory")
#define PG8_BAR __builtin_amdgcn_s_barrier()
#define PG8_SCHED __builtin_amdgcn_sched_barrier(0)
    Unit cur, nxt; int ui = 0;
    if (!S.next(0, cur)) return;
    f32x4 acc[2][2][4][2];
#pragma unroll
    for (int a = 0; a < 2; ++a)
#pragma unroll
        for (int b = 0; b < 2; ++b)
#pragma unroll
            for (int m = 0; m < 4; ++m)
#pragma unroll
                for (int n = 0; n < 2; ++n) acc[a][b][m][n] = (f32x4){0.f, 0.f, 0.f, 0.f};
    bf16x8 At[4][2], B0[2][2], B1[2][2];
    const char* cA = (const char*)g.A + (size_t)cur.pm * tstep; const char* cB = (const char*)g.Bt + (size_t)cur.pn * tstep;
    S.a_ready(cur);
    if constexpr (SP2) {
        PG8_STAGE(PG8_SB(0, 0), cB, voffB); PG8_STAGE(PG8_SB(0, 1), cB + hstep, voffB); PG8_STAGE(PG8_SA(0, 0), cA, voffA); PG8_STAGE(PG8_SA(0, 1), cA + hstep, voffA);
        if (wr == 1) PG8_BAR;
        PG8_WAIT_V(2); PG8_BAR;
        PG8_STAGE(PG8_SB(1, 0), cB + kstep, voffB); PG8_STAGE(PG8_SA(1, 0), cA + kstep, voffA); PG8_STAGE(PG8_SB(1, 1), cB + hstep + kstep, voffB);
        PG8_WAIT_V(6); PG8_BAR;
    } else {
        PG8_STAGE(PG8_SB(0, 0), cB, voffB); PG8_STAGE(PG8_SA(0, 0), cA, voffA); PG8_STAGE(PG8_SB(0, 1), cB + hstep, voffB); PG8_STAGE(PG8_SA(0, 1), cA + hstep, voffA);
        if (wr == 1) PG8_BAR;
        PG8_WAIT_V(4); PG8_BAR;
        PG8_STAGE(PG8_SB(1, 0), cB + kstep, voffB); PG8_STAGE(PG8_SA(1, 0), cA + kstep, voffA); PG8_STAGE(PG8_SB(1, 1), cB + hstep + kstep, voffB);
        PG8_WAIT_V(6); PG8_BAR;
    }
    for (;;) {
        const bool has_next = S.next(ui + 1, nxt);
        const char* nA = has_next ? (const char*)g.A + (size_t)nxt.pm * tstep : cA; const char* nB = has_next ? (const char*)g.Bt + (size_t)nxt.pn * tstep : cB;
        for (int t = 0; t < nt; t += 2) {
            const bool last = (t == nt - 2);
            const char* a1 = cA + (size_t)(t + 1) * kstep;
            const char* a2 = last ? nA : cA + (size_t)(t + 2) * kstep; const char* b2 = last ? nB : cB + (size_t)(t + 2) * kstep;
            const char* a3 = a2 + kstep; const char* b3 = b2 + kstep;
            if (last && has_next) S.a_ready(nxt);
            if constexpr (SP2) {
            PG8_LDB(B0, 0, 0); PG8_LDB(B1, 0, 1); PG8_SCHED; PG8_LDA(At, 0, 0); PG8_STAGE(PG8_SA(1, 1), a1 + hstep, voffA);
            PG8_WAIT_V(8); PG8_WAIT_L(0); PG8_BAR; PG8_MMA(0, 0, At, B0); PG8_MMA(0, 1, At, B1); PG8_BAR; PG8_SCHED;
            PG8_LDA(At, 0, 1); PG8_STAGE(PG8_SB(0, 0), b2, voffB); PG8_STAGE(PG8_SB(0, 1), b2 + hstep, voffB); PG8_STAGE(PG8_SA(0, 0), a2, voffA);
            PG8_WAIT_V(8); PG8_WAIT_L(0); PG8_BAR; PG8_MMA(1, 0, At, B0); PG8_MMA(1, 1, At, B1); PG8_BAR; PG8_SCHED;
            PG8_LDB(B0, 1, 0); PG8_LDB(B1, 1, 1); PG8_SCHED; PG8_LDA(At, 1, 0); PG8_STAGE(PG8_SA(0, 1), a2 + hstep, voffA);
            PG8_WAIT_V(8); PG8_WAIT_L(0); PG8_BAR; PG8_MMA(0, 0, At, B0); PG8_MMA(0, 1, At, B1); PG8_BAR; PG8_SCHED;
            PG8_LDA(At, 1, 1); PG8_STAGE(PG8_SB(1, 0), b3, voffB); PG8_STAGE(PG8_SB(1, 1), b3 + hstep, voffB); PG8_STAGE(PG8_SA(1, 0), a3, voffA);
            PG8_WAIT_V(8); PG8_WAIT_L(0); PG8_BAR; PG8_MMA(1, 0, At, B0); PG8_MMA(1, 1, At, B1); PG8_BAR; PG8_SCHED;
            } else {
            PG8_LDB(B0, 0, 0); PG8_SCHED; PG8_LDA(At, 0, 0); PG8_STAGE(PG8_SA(1, 1), a1 + hstep, voffA);
            PG8_WAIT_L(8); PG8_BAR; PG8_WAIT_L(0); PG8_MMA(0, 0, At, B0); PG8_BAR; PG8_SCHED;
            PG8_LDB(B1, 0, 1); PG8_STAGE(PG8_SB(0, 0), b2, voffB);
            PG8_BAR; PG8_WAIT_L(0); PG8_MMA(0, 1, At, B1); PG8_BAR;
            PG8_LDA(At, 0, 1); PG8_STAGE(PG8_SA(0, 0), a2, voffA);
            PG8_BAR; PG8_WAIT_L(0); PG8_MMA(1, 0, At, B0); PG8_BAR; PG8_SCHED;
            PG8_STAGE(PG8_SB(0, 1), b2 + hstep, voffB);
            PG8_WAIT_V(6); PG8_BAR; PG8_MMA(1, 1, At, B1); PG8_BAR;
            PG8_LDB(B0, 1, 0); PG8_SCHED; PG8_LDA(At, 1, 0); PG8_STAGE(PG8_SA(0, 1), a2 + hstep, voffA);
            PG8_WAIT_L(8); PG8_BAR; PG8_WAIT_L(0); PG8_MMA(0, 0, At, B0); PG8_BAR; PG8_SCHED;
            PG8_LDB(B1, 1, 1); PG8_STAGE(PG8_SB(1, 0), b3, voffB);
            PG8_BAR; PG8_WAIT_L(0); PG8_MMA(0, 1, At, B1); PG8_BAR;
            PG8_LDA(At, 1, 1); PG8_STAGE(PG8_SA(1, 0), a3, voffA);
            PG8_BAR; PG8_WAIT_L(0); PG8_MMA(1, 0, At, B0); PG8_BAR; PG8_SCHED;
            PG8_STAGE(PG8_SB(1, 1), b3 + hstep, voffB);
            PG8_WAIT_V(6); PG8_BAR; PG8_MMA(1, 1, At, B1); PG8_BAR;
            }
        }
        if constexpr (ALIGN_EPI) { if (wr == 0) PG8_BAR; }
        if constexpr (!Epi::AFTER_DRAIN) { E(acc, cur, wr, wc, fr, fq); S.done(cur); }
        if (!has_next) break;
#pragma unroll
        for (int a = 0; a < 2; ++a)
#pragma unroll
            for (int b = 0; b < 2; ++b)
#pragma unroll
                for (int m = 0; m < 4; ++m)
#pragma unroll
                    for (int n = 0; n < 2; ++n) acc[a][b][m][n] = (f32x4){0.f, 0.f, 0.f, 0.f};
        cur = nxt; cA = nA; cB = nB; ++ui;
        if constexpr (ALIGN_EPI) { if (wr == 1) PG8_BAR; }
    }
    PG8_WAIT_V(0);
    if constexpr (!ALIGN_EPI) { if (wr == 0) PG8_BAR; }
    PG8_BAR;
    if constexpr (Epi::AFTER_DRAIN) { E.fused(acc, cur, wr, wc, fr, fq, lds, wid, lane); S.done(cur); }
#undef PG8_SA
#undef PG8_SB
#undef PG8_STAGE
#undef PG8_LDA
#undef PG8_LDB
#undef PG8_MMA
#undef PG8_WAIT_V
#undef PG8_WAIT_L
#undef PG8_BAR
#undef PG8_SCHED
}
}

constexpr int NWAVES = 8, NTHREADS = 512;
constexpr int NT = 8192, DM = 2048, SEQ = 2048, NBATCH = 4, DEPTH = 2, CHK = 64, NCHK = 32, GW = 512, NH = 4, HD = 128;
constexpr int DIN = 7200, NINP = 7424, PBW = 7168;
constexpr int NEXP = 16384;
constexpr int PC_GLA_Q = 0, PC_GLA_K = 512, PC_GLA_V = 1024, PC_GLA_G = 1536, PC_LRU_X = 2048, PC_LRU_Y = 2560, PC_ML_Q = 3072, PC_ML_K = 3584, PC_ML_V = 4096, PC_ML_O = 4608,
              PC_GDN_Q = 5120, PC_GDN_K = 5632, PC_GDN_V = 6144, PC_GDN_G = 6656;
constexpr int PS_LR = 0, PS_MI = 16, PS_MF = 20, PS_GB = 24, PS_GA = 28;
constexpr float RMS_EPS = 1e-6f;
enum { I_X = 0, I_N1G, I_WIN, I_WOUT, I_GLA_W2, I_GLA_B2, I_GLA_NG, I_LRU_CW, I_LRU_CB, I_LRU_WA, I_LRU_BA, I_LRU_WX, I_LRU_BX, I_LRU_LAM, I_ML_IB, I_ML_FB, I_ML_NG,
       I_GDN_CW, I_GDN_ALOG, I_GDN_DTB, I_GDN_NG, I_N2G, I_PWQ, I_PK1, I_PK2, I_PU, I_PV, I_FNG, N_IN };

constexpr size_t MiB = 1u << 20;
constexpr size_t WS_CTL = 0, CTL_ZERO_BYTES = 1 * MiB;
constexpr size_t WS_WIN = 2 * MiB;
constexpr size_t WIN_L = (size_t)NINP * DM * 2;
constexpr size_t WS_WOUT = 60 * MiB;
constexpr size_t WS_WQ = 76 * MiB;
constexpr size_t WSQ_L = (size_t)DM * DM * 2;
constexpr size_t WS_K1 = 92 * MiB, WS_K2 = 92 * MiB + 512 * 1024;
constexpr size_t WS_RSTD1 = 93 * MiB;
constexpr size_t WS_SSP = 94 * MiB;
constexpr size_t WS_XB = 96 * MiB;
constexpr size_t WS_P = 128 * MiB;
constexpr size_t WS_PS = 240 * MiB;
constexpr size_t WS_MIX = 242 * MiB;
constexpr size_t WS_Q = 274 * MiB;
constexpr size_t WS_UB = 306 * MiB;
constexpr size_t WS_VB = 434 * MiB;
constexpr size_t TAB_L = (size_t)NEXP * DM * 2;
constexpr size_t WS_SCR = 562 * MiB;
constexpr size_t WS_END = 900 * MiB;

constexpr int LDS_BYTES = 155648;
constexpr int MISC_OFF = LDS_BYTES - 256;

#define GAS __attribute__((address_space(1)))
#define LAS __attribute__((address_space(3)))
typedef unsigned short bf16;
typedef unsigned v4u __attribute__((ext_vector_type(4)));
typedef unsigned v2u __attribute__((ext_vector_type(2)));
typedef float f32x4 __attribute__((ext_vector_type(4)));
typedef float f32x2 __attribute__((ext_vector_type(2)));
typedef short bf16x8 __attribute__((ext_vector_type(8)));
typedef short bf16x4 __attribute__((ext_vector_type(4)));
typedef __bf16 bf2_t __attribute__((ext_vector_type(2)));
typedef GAS unsigned gu32;
#define RLX_AGENT __ATOMIC_RELAXED, __HIP_MEMORY_SCOPE_AGENT
__device__ __forceinline__ unsigned f2bf(float f) { unsigned u = __builtin_bit_cast(unsigned, f); return (u + 0x7fffu + ((u >> 16) & 1u)) >> 16; }
__device__ __forceinline__ unsigned pk2(float lo, float hi) { return f2bf(lo) | (f2bf(hi) << 16); }
__device__ __forceinline__ float bf2f(unsigned b) { return __builtin_bit_cast(float, b << 16); }
__device__ __forceinline__ float bflo(unsigned w) { return __builtin_bit_cast(float, w << 16); }
__device__ __forceinline__ float bfhi(unsigned w) { return __builtin_bit_cast(float, w & 0xffff0000u); }
__device__ __forceinline__ float wave_sum(float v) {
#pragma unroll
    for (int o = 1; o < 64; o <<= 1) v += __shfl_xor(v, o);
    return v;
}
__device__ __forceinline__ float sigmoidf_(float x) { return 1.0f / (1.0f + __expf(-x)); }
__device__ __forceinline__ float siluf_(float x) { return x / (1.0f + __expf(-x)); }
__device__ __forceinline__ float softplusf_(float x) { return fmaxf(x, 0.f) + log1pf(__expf(-fabsf(x))); }
__device__ __forceinline__ float logsigmoidf_(float x) { return -softplusf_(-x); }
__device__ __forceinline__ float gelu_tanh(float x) { const float u = 0.7978845608028654f * (x + 0.044715f * x * x * x); return 0.5f * x * (1.0f + tanhf(u)); }

#define XB_TMO      128
#define XB_XCNT(j)  (256  + 64 * (j))
#define XB_XSUB(j)  (1280 + 64 * (j))
#define XB_XGEN(j)  (2304 + 64 * (j))
#define XB_TOP      3328
#define XB_TOPGEN   3392
#define XCD_BAR_WORDS 3456
#define XB_SPIN_CAP (1u << 18)

__device__ __forceinline__ unsigned xb_ld(unsigned* p)              { return __hip_atomic_load(p, __ATOMIC_RELAXED, __HIP_MEMORY_SCOPE_AGENT); }
__device__ __forceinline__ unsigned xb_add(unsigned* p, unsigned v) { return __hip_atomic_fetch_add(p, v, __ATOMIC_RELAXED, __HIP_MEMORY_SCOPE_AGENT); }
__device__ __forceinline__ unsigned xb_xcc_id() { return (unsigned)__builtin_amdgcn_s_getreg((3 << 11) | 20) & 0xFu; }
#define XB_SPIN(cond, bar) do { unsigned _sp = 0; while (cond) { __builtin_amdgcn_s_sleep(1); \
    if ((++_sp & 255u) == 0u) { if (xb_ld(&(bar)[XB_TMO])) break; if (_sp > XB_SPIN_CAP) { atomicAdd(&(bar)[XB_TMO], 1u); break; } } } } while (0)

struct XcdBarrier {
    unsigned* bar; unsigned x;
    volatile LAS unsigned* st;
};

__device__ __forceinline__ XcdBarrier xcd_barrier_post(unsigned* bar, volatile LAS unsigned* st) {
    XcdBarrier b; b.bar = bar; b.x = xb_xcc_id(); b.st = st;
    if (threadIdx.x == 0) (void)xb_add(&bar[XB_XCNT(b.x)], 1u);
    return b;
}
__device__ __forceinline__ void xcd_barrier_complete(unsigned* bar, unsigned x, unsigned& nloc, unsigned& nx) {
    const unsigned G = gridDim.x * gridDim.y * gridDim.z;
    unsigned sum, cnt, mine, sp = 0u;
    for (;;) {
        sum = 0u; cnt = 0u; mine = 0u;
#pragma unroll
        for (unsigned j = 0; j < 16; ++j) { const unsigned c = xb_ld(&bar[XB_XCNT(j)]); sum += c; cnt += (c > 0u) ? 1u : 0u; mine = (j == x) ? c : mine; }
        if (sum == G) break;
        __builtin_amdgcn_s_sleep(1);
        if ((++sp & 255u) == 0u) { if (xb_ld(&bar[XB_TMO])) break; if (sp > XB_SPIN_CAP) { atomicAdd(&bar[XB_TMO], 1u); break; } }
    }
    nloc = mine > 0u ? mine : 1u; nx = cnt > 0u ? cnt : 1u;
}

__device__ __forceinline__ void xcd_barrier(const XcdBarrier& b) {
    asm volatile("s_waitcnt vmcnt(0)" ::: "memory");
    __syncthreads();
    if (threadIdx.x == 0) {
        unsigned* bar = b.bar;
        __builtin_amdgcn_s_waitcnt(0);
        unsigned nloc = b.st[0], nx = b.st[1];
        if (nloc == 0u) { xcd_barrier_complete(bar, b.x, nloc, nx); b.st[0] = nloc; b.st[1] = nx; }
        const unsigned old = xb_add(&bar[XB_XSUB(b.x)], 1u);
        const unsigned gen = old / nloc;
        if (old + 1u == (gen + 1u) * nloc) {
            __builtin_amdgcn_fence(__ATOMIC_RELEASE, "agent");
            asm volatile("s_waitcnt vmcnt(0)" ::: "memory");
            const unsigned og = xb_add(&bar[XB_TOP], 1u);
            const unsigned tg = og / nx;
            if (og + 1u == (tg + 1u) * nx) xb_add(&bar[XB_TOPGEN], 1u);
            else XB_SPIN(xb_ld(&bar[XB_TOPGEN]) == tg, bar);
            __builtin_amdgcn_fence(__ATOMIC_ACQUIRE, "agent");
            xb_add(&bar[XB_XGEN(b.x)], 1u);
            asm volatile("s_waitcnt vmcnt(0)" ::: "memory");
        } else {
            XB_SPIN(xb_ld(&bar[XB_XGEN(b.x)]) == gen, bar);
            __builtin_amdgcn_fence(__ATOMIC_ACQUIRE, "agent");
            asm volatile("s_waitcnt vmcnt(0)" ::: "memory");
        }
    }
    __syncthreads();
}


struct Args { const float* in[N_IN]; float* out; unsigned char* ws; int ph_lo, ph_hi, li, pad; };
typedef const __attribute__((address_space(4))) Args& ArgsR;
__device__ __forceinline__ const __attribute__((address_space(4))) Args* kargs() { unsigned long long p = (unsigned long long)__builtin_amdgcn_kernarg_segment_ptr(); asm volatile("" : "+s"(p)); return (const __attribute__((address_space(4))) Args*)p; }

__device__ __forceinline__ int win_src_col(int n) {
    if (n < 2048) return n;
    if (n < 3072) return 2064 + (n - 2048);
    if (n < 5120) return 3088 + (n - 3072);
    if (n < 7168) return 5144 + (n - 5120);
    if (n < 7184) return 2048 + (n - 7168);
    if (n < 7192) return 5136 + (n - 7184);
    if (n < 7200) return n;
    return -1;
}
template <bool MAP>
__device__ __forceinline__ void p0_transpose_item(const float* W, int K, int Nsrc, int Ndst, const float* gain, bf16* WT, LAS float* scr, int item, int lane) {
    const int nblk = Ndst / 32, kb = item / nblk, nb = item % nblk, k0 = 64 * kb, n0 = 32 * nb;
    const int nn = n0 + (lane & 31); const int src = MAP ? win_src_col(nn) : nn;
#pragma unroll 8
    for (int i = 0; i < 32; ++i) { const int kk = 2 * i + (lane >> 5); float v = 0.f; if (src >= 0) v = W[(size_t)(k0 + kk) * Nsrc + src]; if (gain) v *= gain[k0 + kk]; scr[kk * 33 + (lane & 31)] = v; }
    asm volatile("s_waitcnt lgkmcnt(0)" ::: "memory");
    const int c = lane & 7;
#pragma unroll
    for (int j = 0; j < 4; ++j) { const int n = (lane >> 3) + 8 * j; const LAS float* s = scr + (8 * c) * 33 + n;
        v4u o; o.x = pk2(s[0 * 33], s[1 * 33]); o.y = pk2(s[2 * 33], s[3 * 33]); o.z = pk2(s[4 * 33], s[5 * 33]); o.w = pk2(s[6 * 33], s[7 * 33]);
        *(GAS v4u*)(WT + (size_t)(n0 + n) * K + k0 + 8 * c) = o; }
    asm volatile("s_waitcnt lgkmcnt(0)" ::: "memory");
}
__device__ __forceinline__ void p0_convert(const float* src, bf16* dst, size_t n, size_t gtid, size_t gthreads) {
    for (size_t i = gtid * 8; i < n; i += gthreads * 8) {
        const f32x4 a = *(const GAS f32x4*)(src + i), b = *(const GAS f32x4*)(src + i + 4);
        v4u o; o.x = pk2(a[0], a[1]); o.y = pk2(a[2], a[3]); o.z = pk2(b[0], b[1]); o.w = pk2(b[2], b[3]);
        *(GAS v4u*)(dst + i) = o; }
}
__device__ __forceinline__ void p0_prologue(ArgsR A, LAS unsigned char* lds, int vcu, int G, int wave, int lane) {
    unsigned char* ws = A.ws;
    LAS float* scr = (LAS float*)(lds + wave * 16384);
    const int gw = vcu * NWAVES + wave, NGW = G * NWAVES;
    constexpr int I_IN = (DM / 64) * (NINP / 32), I_SQ = (DM / 64) * (DM / 32), I_LAYER = I_IN + 2 * I_SQ, NITEMS = DEPTH * I_LAYER;
    for (int it = gw; it < NITEMS; it += NGW) {
        const int l = it / I_LAYER; int r = it % I_LAYER;
        if (r < I_IN) { p0_transpose_item<true>(A.in[I_WIN] + (size_t)l * DM * DIN, DM, DIN, NINP, A.in[I_N1G] + l * DM, (bf16*)(ws + WS_WIN + l * WIN_L), scr, r, lane); continue; } r -= I_IN;
        if (r < I_SQ) { p0_transpose_item<false>(A.in[I_WOUT] + (size_t)l * DM * DM, DM, DM, DM, nullptr, (bf16*)(ws + WS_WOUT + l * WSQ_L), scr, r, lane); continue; } r -= I_SQ;
        p0_transpose_item<false>(A.in[I_PWQ] + (size_t)l * DM * DM, DM, DM, DM, A.in[I_N2G] + l * DM, (bf16*)(ws + WS_WQ + l * WSQ_L), scr, r, lane);
    }
    const size_t gtid = (size_t)gw * 64 + lane, gthreads = (size_t)NGW * 64;
    p0_convert(A.in[I_PK1], (bf16*)(ws + WS_K1), (size_t)DEPTH * 8 * 128 * 128, gtid, gthreads);
    p0_convert(A.in[I_PK2], (bf16*)(ws + WS_K2), (size_t)DEPTH * 8 * 128 * 128, gtid, gthreads);
    const float* x = A.in[I_X]; bf16* xb = (bf16*)(ws + WS_XB); float* rstd1 = (float*)(ws + WS_RSTD1);
    for (int m = gw; m < NT; m += NGW) {
        const GAS f32x4* xr = (const GAS f32x4*)(x + (size_t)m * DM) + lane;
        f32x4 v[8]; float s = 0.f;
#pragma unroll
        for (int j = 0; j < 8; ++j) { v[j] = xr[64 * j]; s += (v[j][0] * v[j][0] + v[j][1] * v[j][1]) + (v[j][2] * v[j][2] + v[j][3] * v[j][3]); }
        s = wave_sum(s);
        GAS v2u* o = (GAS v2u*)(xb + (size_t)m * DM) + lane;
#pragma unroll
        for (int j = 0; j < 8; ++j) { v2u w; w.x = pk2(v[j][0], v[j][1]); w.y = pk2(v[j][2], v[j][3]); o[64 * j] = w; }
        if (lane == 0) rstd1[m] = rsqrtf(s * (1.0f / DM) + RMS_EPS);
    }
}

constexpr int NM_Q = 0, NM_K = 32768, NM_A = 65536, NM_V = 98304, NM_PARTS = 131072  , NM_SC = 135168  ;

__device__ __forceinline__ void nm_load_tile(const bf16* g, size_t ld, LAS float* dst, int tid) {
#pragma unroll
    for (int i = 0; i < 2; ++i) { const int idx = tid + i * NTHREADS, r = idx >> 4, c8 = (idx & 15) * 8;
        const v4u w = *(const GAS v4u*)(g + (size_t)r * ld + c8);
        f32x4 a = {bflo(w.x), bfhi(w.x), bflo(w.y), bfhi(w.y)}, b = {bflo(w.z), bfhi(w.z), bflo(w.w), bfhi(w.w)};
        *(LAS f32x4*)(dst + r * 128 + c8) = a; *(LAS f32x4*)(dst + r * 128 + c8 + 4) = b; }
}
template <int GATE>
__device__ __forceinline__ void nm_finalize(const LAS float* vs, const float* ng, const bf16* gate, size_t gld, bf16* mixp, int wave, int lane) {
#pragma unroll 1
    for (int rr = 0; rr < 8; ++rr) { const int c = wave * 8 + rr;
        const float o1 = vs[c * 128 + lane], o2 = vs[c * 128 + 64 + lane];
        const float ss = wave_sum(o1 * o1 + o2 * o2), rs = rsqrtf(ss * (1.0f / 128.0f) + RMS_EPS);
        float r1 = o1 * rs * ng[lane], r2 = o2 * rs * ng[64 + lane];
        if (GATE == 1) { r1 *= siluf_(bf2f(gate[(size_t)c * gld + lane])); r2 *= siluf_(bf2f(gate[(size_t)c * gld + 64 + lane])); }
        mixp[(size_t)c * DM + lane] = (bf16)f2bf(r1); mixp[(size_t)c * DM + 64 + lane] = (bf16)f2bf(r2); }
}

__device__ __forceinline__ void nm_gla(ArgsR A, int l, int b, int h, LAS unsigned char* lds, int tid) {
    const bf16* P = (const bf16*)(A.ws + WS_P); const float* Ps = (const float*)(A.ws + WS_PS); bf16* mix = (bf16*)(A.ws + WS_MIX);
    LAS float* qs = (LAS float*)(lds + NM_Q); LAS float* ks = (LAS float*)(lds + NM_K); LAS float* as = (LAS float*)(lds + NM_A); LAS float* vs = (LAS float*)(lds + NM_V);
    LAS float* parts = (LAS float*)(lds + NM_PARTS); LAS float* lrs = (LAS float*)(lds + NM_SC);
    const int v = tid & 127, dq = tid >> 7, wave = tid >> 6, lane = tid & 63;
    const float* w2 = A.in[I_GLA_W2] + (size_t)l * 16 * GW + h * HD + v;
    float w2c[16];
#pragma unroll
    for (int r = 0; r < 16; ++r) w2c[r] = w2[r * GW];
    const float b2 = A.in[I_GLA_B2][l * GW + h * HD + v];
    const float* ng = A.in[I_GLA_NG] + l * GW + h * HD;
    float S[32];
#pragma unroll
    for (int i = 0; i < 32; ++i) S[i] = 0.f;
#pragma unroll 1
    for (int n = 0; n < NCHK; ++n) {
        const size_t r0 = (size_t)b * SEQ + n * CHK;
        nm_load_tile(P + r0 * PBW + PC_GLA_Q + h * HD, PBW, qs, tid);
        nm_load_tile(P + r0 * PBW + PC_GLA_K + h * HD, PBW, ks, tid);
        nm_load_tile(P + r0 * PBW + PC_GLA_V + h * HD, PBW, vs, tid);
        for (int i = tid; i < 64 * 16; i += NTHREADS) lrs[i] = Ps[(r0 + (i >> 4)) * 32 + PS_LR + (i & 15)];
        __syncthreads();
#pragma unroll 1
        for (int i = 0; i < 16; ++i) { const int c = dq * 16 + i; float z = b2;
#pragma unroll
            for (int r = 0; r < 16; ++r) z += lrs[c * 16 + r] * w2c[r];
            as[c * 128 + v] = __expf(logsigmoidf_(z) * (1.0f / 16.0f)); }
        __syncthreads();
#pragma unroll 1
        for (int c = 0; c < CHK; ++c) {
            const float vt = vs[c * 128 + v]; float part = 0.f;
            const LAS f32x4* q4 = (const LAS f32x4*)(qs + c * 128 + dq * 32); const LAS f32x4* k4 = (const LAS f32x4*)(ks + c * 128 + dq * 32); const LAS f32x4* a4 = (const LAS f32x4*)(as + c * 128 + dq * 32);
#pragma unroll
            for (int i4 = 0; i4 < 8; ++i4) { const f32x4 qv = q4[i4], kv = k4[i4], av = a4[i4];
#pragma unroll
                for (int j = 0; j < 4; ++j) { S[i4 * 4 + j] = av[j] * S[i4 * 4 + j] + kv[j] * vt; part += qv[j] * S[i4 * 4 + j]; } }
            parts[((c & 1) * 4 + dq) * 128 + v] = part;
            __syncthreads();
            if (dq == 0) { const LAS float* pp = parts + (c & 1) * 512 + v; vs[c * 128 + v] = ((pp[0] + pp[128]) + (pp[256] + pp[384])) * 0.08838834764831845f; }
        }
        __syncthreads();
        nm_finalize<1>(vs, ng, P + r0 * PBW + PC_GLA_G + h * HD, PBW, mix + r0 * DM + 0 + h * HD, wave, lane);
        __syncthreads();
    }
}

__device__ __forceinline__ void nm_mlstm(ArgsR A, int l, int b, int h, LAS unsigned char* lds, int tid) {
    const bf16* P = (const bf16*)(A.ws + WS_P); const float* Ps = (const float*)(A.ws + WS_PS); bf16* mix = (bf16*)(A.ws + WS_MIX);
    LAS float* qs = (LAS float*)(lds + NM_Q); LAS float* ks = (LAS float*)(lds + NM_K); LAS float* vs = (LAS float*)(lds + NM_V);
    LAS float* parts = (LAS float*)(lds + NM_PARTS); LAS float* dparts = (LAS float*)(lds + NM_A);
    LAS float* fs = (LAS float*)(lds + NM_SC); LAS float* es = fs + 64;
    const int v = tid & 127, dq = tid >> 7, wave = tid >> 6, lane = tid & 63;
    const float ib = A.in[I_ML_IB][l * NH + h], fb = A.in[I_ML_FB][l * NH + h];
    const float* ng = A.in[I_ML_NG] + l * GW + h * HD;
    float C[32], nn[32];
#pragma unroll
    for (int i = 0; i < 32; ++i) { C[i] = 0.f; nn[i] = 0.f; }
#pragma unroll 1
    for (int n = 0; n < NCHK; ++n) {
        const size_t r0 = (size_t)b * SEQ + n * CHK;
        nm_load_tile(P + r0 * PBW + PC_ML_Q + h * HD, PBW, qs, tid);
        nm_load_tile(P + r0 * PBW + PC_ML_K + h * HD, PBW, ks, tid);
        nm_load_tile(P + r0 * PBW + PC_ML_V + h * HD, PBW, vs, tid);
        if (tid < 64) { fs[tid] = sigmoidf_(Ps[(r0 + tid) * 32 + PS_MF + h] + fb); es[tid] = __expf(Ps[(r0 + tid) * 32 + PS_MI + h] + ib) * 0.08838834764831845f; }
        __syncthreads();
#pragma unroll 1
        for (int c = 0; c < CHK; ++c) {
            const float vt = vs[c * 128 + v], f = fs[c], ei = es[c]; float part = 0.f, dpart = 0.f;
            const LAS f32x4* q4 = (const LAS f32x4*)(qs + c * 128 + dq * 32); const LAS f32x4* k4 = (const LAS f32x4*)(ks + c * 128 + dq * 32);
#pragma unroll
            for (int i4 = 0; i4 < 8; ++i4) { const f32x4 qv = q4[i4], kv = k4[i4];
#pragma unroll
                for (int j = 0; j < 4; ++j) { const float kd = kv[j] * ei; C[i4 * 4 + j] = f * C[i4 * 4 + j] + kd * vt; nn[i4 * 4 + j] = f * nn[i4 * 4 + j] + kd;
                    part += qv[j] * C[i4 * 4 + j]; dpart += qv[j] * nn[i4 * 4 + j]; } }
            parts[((c & 1) * 4 + dq) * 128 + v] = part; if (v == 0) dparts[(c & 1) * 4 + dq] = dpart;
            __syncthreads();
            if (dq == 0) { const LAS float* pp = parts + (c & 1) * 512 + v; const LAS float* dp = dparts + (c & 1) * 4;
                const float num = (pp[0] + pp[128]) + (pp[256] + pp[384]), dot = (dp[0] + dp[1]) + (dp[2] + dp[3]);
                const float og = bf2f(P[(r0 + c) * PBW + PC_ML_O + h * HD + v]);
                vs[c * 128 + v] = num / fmaxf(fabsf(dot), 1.0f) * sigmoidf_(og); }
        }
        __syncthreads();
        nm_finalize<0>(vs, ng, nullptr, 0, mix + r0 * DM + 1024 + h * HD, wave, lane);
        __syncthreads();
    }
}

__device__ __forceinline__ void nm_gdn(ArgsR A, int l, int b, int h, LAS unsigned char* lds, int tid) {
    const bf16* P = (const bf16*)(A.ws + WS_P); const float* Ps = (const float*)(A.ws + WS_PS); bf16* mix = (bf16*)(A.ws + WS_MIX);
    LAS float* qs = (LAS float*)(lds + NM_Q); LAS float* ks = (LAS float*)(lds + NM_K); LAS float* vs = (LAS float*)(lds + NM_V);
    LAS float* parts = (LAS float*)(lds + NM_PARTS);
    LAS float* egs = (LAS float*)(lds + NM_SC); LAS float* bts = egs + 64; LAS float* rq = egs + 128; LAS float* rk = egs + 192;
    const int v = tid & 127, dq = tid >> 7, wave = tid >> 6, lane = tid & 63;
    const float* cw = A.in[I_GDN_CW] + (size_t)l * 4 * 1536;
    const float nalog = -__expf(A.in[I_GDN_ALOG][l * NH + h]), dtb = A.in[I_GDN_DTB][l * NH + h];
    const float* ng = A.in[I_GDN_NG] + l * GW + h * HD;
    float S[32];
#pragma unroll
    for (int i = 0; i < 32; ++i) S[i] = 0.f;
#pragma unroll 1
    for (int n = 0; n < NCHK; ++n) {
        const size_t r0 = (size_t)b * SEQ + n * CHK;
#pragma unroll 1
        for (int part = 0; part < 3; ++part) {
            const int pc = (part == 0 ? PC_GDN_Q : part == 1 ? PC_GDN_K : PC_GDN_V) + h * HD + v, wc = part * 512 + h * HD + v;
            const float w0 = cw[wc], w1 = cw[1536 + wc], w2 = cw[2 * 1536 + wc], w3 = cw[3 * 1536 + wc];
            LAS float* dst = part == 0 ? qs : part == 1 ? ks : vs;
            const int c0 = dq * 16; const long t0 = (long)n * CHK + c0;
            float xm3 = (t0 - 3 >= 0) ? bf2f(P[(r0 + c0 - 3) * PBW + pc]) : 0.f, xm2 = (t0 - 2 >= 0) ? bf2f(P[(r0 + c0 - 2) * PBW + pc]) : 0.f, xm1 = (t0 - 1 >= 0) ? bf2f(P[(r0 + c0 - 1) * PBW + pc]) : 0.f;
#pragma unroll 4
            for (int i = 0; i < 16; ++i) { const float x0 = bf2f(P[(r0 + c0 + i) * PBW + pc]); const float y = w0 * xm3 + w1 * xm2 + w2 * xm1 + w3 * x0;
                dst[(c0 + i) * 128 + v] = siluf_(y); xm3 = xm2; xm2 = xm1; xm1 = x0; }
        }
        if (tid < 64) { bts[tid] = sigmoidf_(Ps[(r0 + tid) * 32 + PS_GB + h]); egs[tid] = __expf(nalog * softplusf_(Ps[(r0 + tid) * 32 + PS_GA + h] + dtb)); }
        __syncthreads();
#pragma unroll 1
        for (int rr = 0; rr < 8; ++rr) { const int c = wave * 8 + rr;
            const float q1 = qs[c * 128 + lane], q2 = qs[c * 128 + 64 + lane], k1 = ks[c * 128 + lane], k2 = ks[c * 128 + 64 + lane];
            const float sq = wave_sum(q1 * q1 + q2 * q2), sk = wave_sum(k1 * k1 + k2 * k2);
            if (lane == 0) { rq[c] = rsqrtf(sq + 1e-6f) * 0.08838834764831845f; rk[c] = rsqrtf(sk + 1e-6f); } }
        __syncthreads();
#pragma unroll 1
        for (int c = 0; c < CHK; ++c) {
            const float vt = vs[c * 128 + v], e = egs[c], bt = bts[c], sq = rq[c], sk = rk[c]; float part = 0.f;
            const LAS f32x4* q4 = (const LAS f32x4*)(qs + c * 128 + dq * 32); const LAS f32x4* k4 = (const LAS f32x4*)(ks + c * 128 + dq * 32);
            f32x4 kv[8];
#pragma unroll
            for (int i4 = 0; i4 < 8; ++i4) { kv[i4] = k4[i4] * sk;
#pragma unroll
                for (int j = 0; j < 4; ++j) { S[i4 * 4 + j] *= e; part += kv[i4][j] * S[i4 * 4 + j]; } }
            parts[dq * 128 + v] = part;
            __syncthreads();
            const float kS = (parts[v] + parts[128 + v]) + (parts[256 + v] + parts[384 + v]);
            const float u = bt * (vt - kS); float part2 = 0.f;
#pragma unroll
            for (int i4 = 0; i4 < 8; ++i4) { const f32x4 qv = q4[i4] * sq;
#pragma unroll
                for (int j = 0; j < 4; ++j) { S[i4 * 4 + j] += kv[i4][j] * u; part2 += qv[j] * S[i4 * 4 + j]; } }
            parts[512 + dq * 128 + v] = part2;
            __syncthreads();
            if (dq == 0) vs[c * 128 + v] = (parts[512 + v] + parts[640 + v]) + (parts[768 + v] + parts[896 + v]);
        }
        __syncthreads();
        nm_finalize<1>(vs, ng, P + r0 * PBW + PC_GDN_G + h * HD, PBW, mix + r0 * DM + 1536 + h * HD, wave, lane);
        __syncthreads();
    }
}

__device__ __forceinline__ void nm_lru(ArgsR A, int l, int b, int j, LAS unsigned char* lds, int tid) {
    const bf16* P = (const bf16*)(A.ws + WS_P); bf16* mix = (bf16*)(A.ws + WS_MIX);
    LAS float* xc = (LAS float*)(lds);
    LAS float* was = (LAS float*)(lds + 20480);
    LAS float* wxs = (LAS float*)(lds + 36864);
    LAS float* aa = (LAS float*)(lds + 53248);
    LAS float* uu = (LAS float*)(lds + 69632);
    const float* wa = A.in[I_LRU_WA] + ((size_t)l * 8 + j) * 4096; const float* wx = A.in[I_LRU_WX] + ((size_t)l * 8 + j) * 4096;
    for (int i = tid; i < 4096; i += NTHREADS) { was[i] = wa[i]; wxs[i] = wx[i]; }
    const float* cw = A.in[I_LRU_CW] + (size_t)l * 4 * GW; const float* cb = A.in[I_LRU_CB] + l * GW;
    const float* ba = A.in[I_LRU_BA] + l * GW + j * 64; const float* bx = A.in[I_LRU_BX] + l * GW + j * 64; const float* lam = A.in[I_LRU_LAM] + l * GW + j * 64;
    float hstate = 0.f;
#pragma unroll 1
    for (int n = 0; n < NCHK; ++n) {
        const size_t r0 = (size_t)b * SEQ + n * CHK;
        { const int cc = tid & 63, c0 = (tid >> 6) * 8, ch = j * 64 + cc, pc = PC_LRU_X + ch; const long t0 = (long)n * CHK + c0;
            const float w0 = cw[ch], w1 = cw[GW + ch], w2 = cw[2 * GW + ch], w3 = cw[3 * GW + ch], bias = cb[ch];
            float xm3 = (t0 - 3 >= 0) ? bf2f(P[(r0 + c0 - 3) * PBW + pc]) : 0.f, xm2 = (t0 - 2 >= 0) ? bf2f(P[(r0 + c0 - 2) * PBW + pc]) : 0.f, xm1 = (t0 - 1 >= 0) ? bf2f(P[(r0 + c0 - 1) * PBW + pc]) : 0.f;
#pragma unroll
            for (int i = 0; i < 8; ++i) { const float x0 = bf2f(P[(r0 + c0 + i) * PBW + pc]); xc[(c0 + i) * 65 + cc] = w0 * xm3 + w1 * xm2 + w2 * xm1 + w3 * x0 + bias; xm3 = xm2; xm2 = xm1; xm1 = x0; } }
        __syncthreads();
        { const int tok = tid >> 3, cg = tid & 7; float ra[8], ri[8];
#pragma unroll
            for (int q = 0; q < 8; ++q) { ra[q] = ba[cg * 8 + q]; ri[q] = bx[cg * 8 + q]; }
#pragma unroll 4
            for (int i = 0; i < 64; ++i) { const float xv = xc[tok * 65 + i];
                const f32x4 a0 = *(const LAS f32x4*)(was + i * 64 + cg * 8), a1 = *(const LAS f32x4*)(was + i * 64 + cg * 8 + 4);
                const f32x4 x0 = *(const LAS f32x4*)(wxs + i * 64 + cg * 8), x1 = *(const LAS f32x4*)(wxs + i * 64 + cg * 8 + 4);
#pragma unroll
                for (int q = 0; q < 4; ++q) { ra[q] += xv * a0[q]; ra[4 + q] += xv * a1[q]; ri[q] += xv * x0[q]; ri[4 + q] += xv * x1[q]; } }
#pragma unroll
            for (int q = 0; q < 8; ++q) { const int jj = cg * 8 + q; const float r = sigmoidf_(ra[q]), ig = sigmoidf_(ri[q]);
                const float log_a = -8.0f * r * softplusf_(-lam[jj]); const float a = __expf(log_a), u = sqrtf(-expm1f(2.0f * log_a)) * (ig * xc[tok * 65 + jj]);
                aa[tok * 64 + jj] = a; uu[tok * 64 + jj] = u; } }
        __syncthreads();
        if (tid < 64) { const int ch = j * 64 + tid;
#pragma unroll 4
            for (int c = 0; c < CHK; ++c) { hstate = aa[c * 64 + tid] * hstate + uu[c * 64 + tid];
                const float y = bf2f(P[(r0 + c) * PBW + PC_LRU_Y + ch]); mix[(r0 + c) * DM + 512 + ch] = (bf16)f2bf(gelu_tanh(y) * hstate); } }
        __syncthreads();
    }
}

__device__ __forceinline__ void nm_phase(ArgsR A, int l, LAS unsigned char* lds, int G, int tid) {
    for (int it = blockIdx.x; it < 80; it += G) {
        if (it < 16) nm_gla(A, l, it >> 2, it & 3, lds, tid);
        else if (it < 32) nm_mlstm(A, l, (it - 16) >> 2, (it - 16) & 3, lds, tid);
        else if (it < 48) nm_gdn(A, l, (it - 32) >> 2, (it - 32) & 3, lds, tid);
        else nm_lru(A, l, (it - 48) >> 3, (it - 48) & 7, lds, tid);
        __syncthreads();
    }
}

constexpr size_t WS_GLA_INC = 562 * MiB;
constexpr size_t WS_GLA_DEC = 594 * MiB;
constexpr size_t WS_GLA_ST = 595 * MiB;
constexpr size_t WS_ML_INC = 611 * MiB;
constexpr size_t WS_ML_N = 643 * MiB;
constexpr size_t WS_ML_SC = 643 * MiB + 512 * 1024;
constexpr size_t WS_ML_ST = 644 * MiB;
constexpr size_t WS_ML_NP = 660 * MiB;
constexpr size_t WS_ML_MP = 660 * MiB + 512 * 1024;
constexpr size_t WS_GDN_U0 = 661 * MiB, WS_GDN_W = 669 * MiB, WS_GDN_QD = 677 * MiB, WS_GDN_KE = 685 * MiB;
constexpr size_t WS_GDN_QK = 693 * MiB;
constexpr size_t WS_GDN_DE = 697 * MiB;
constexpr size_t WS_GDN_O = 698 * MiB;
constexpr size_t WS_LRU_HL = 714 * MiB, WS_LRU_AP = 730 * MiB;
constexpr size_t WS_LRU_CARRY = 746 * MiB;
static_assert(WS_LRU_CARRY + 4 * 32 * 512 * 4 <= WS_END, "ws map");

typedef short v4i16_t __attribute__((ext_vector_type(4)));
constexpr int LD128 = 136, LD64 = 72;

__device__ __forceinline__ bf16x8 frag_rd(const LAS bf16* t, int ld, int row0, int k0, int lane) { return *(const LAS bf16x8*)(t + (row0 + (lane & 15)) * ld + k0 + 8 * (lane >> 4)); }
__device__ __forceinline__ bf16x8 frag_rd_perm(const LAS bf16* t, int ld, int row0, int k0, int lane) {
    const LAS bf16* p = t + (row0 + (lane & 15)) * ld + k0 + 4 * (lane >> 4);
    const bf16x4 a = *(const LAS bf16x4*)p, b = *(const LAS bf16x4*)(p + 16);
    return (bf16x8){a[0], a[1], a[2], a[3], b[0], b[1], b[2], b[3]};
}
__device__ __forceinline__ bf16x8 frag_tr(const LAS bf16* t, int ld, int k0, int n0, int lane) {
    const int i = lane & 15, g = lane >> 4; const LAS bf16* p = t + (k0 + 8 * g + (i >> 2)) * ld + n0 + 4 * (i & 3);
    const v4i16_t a = __builtin_amdgcn_ds_read_tr16_b64_v4i16((LAS v4i16_t*)p), b = __builtin_amdgcn_ds_read_tr16_b64_v4i16((LAS v4i16_t*)(p + 4 * ld));
    return (bf16x8){a[0], a[1], a[2], a[3], b[0], b[1], b[2], b[3]};
}
__device__ __forceinline__ bf16x8 frag_tr_perm(const LAS bf16* t, int ld, int k0, int n0, int lane) {
    const int i = lane & 15, g = lane >> 4; const LAS bf16* p = t + (k0 + 4 * g + (i >> 2)) * ld + n0 + 4 * (i & 3);
    const v4i16_t a = __builtin_amdgcn_ds_read_tr16_b64_v4i16((LAS v4i16_t*)p), b = __builtin_amdgcn_ds_read_tr16_b64_v4i16((LAS v4i16_t*)(p + 16 * ld));
    return (bf16x8){a[0], a[1], a[2], a[3], b[0], b[1], b[2], b[3]};
}
__device__ __forceinline__ bf16x8 pack_acc(const f32x4& lo, const f32x4& hi) {
    v4u w; w.x = pg8::cvt_pk_bf16(lo[0], lo[1]); w.y = pg8::cvt_pk_bf16(lo[2], lo[3]); w.z = pg8::cvt_pk_bf16(hi[0], hi[1]); w.w = pg8::cvt_pk_bf16(hi[2], hi[3]);
    return __builtin_bit_cast(bf16x8, w);
}
#define MFMA16(a, b, c) __builtin_amdgcn_mfma_f32_16x16x32_bf16((a), (b), (c), 0, 0, 0)

template <int ROWS>
__device__ __forceinline__ void tile_g2l_128(const bf16* g, size_t gld, LAS bf16* t, int tid) {
#pragma unroll
    for (int i = 0; i < ROWS * 16 / NTHREADS; ++i) { const int idx = tid + i * NTHREADS, r = idx >> 4, c8 = (idx & 15) * 8;
        *(LAS v4u*)(t + r * LD128 + c8) = *(const GAS v4u*)(g + (size_t)r * gld + c8); }
}
__device__ __forceinline__ float wave_scan_add(float v, int lane) {
#pragma unroll
    for (int o = 1; o < 64; o <<= 1) { const float t = __shfl_up(v, o); if (lane >= o) v += t; }
    return v;
}
__device__ __forceinline__ float wave_scan_max(float v, int lane) {
#pragma unroll
    for (int o = 1; o < 64; o <<= 1) { const float t = __shfl_up(v, o); if (lane >= o) v = fmaxf(v, t); }
    return v;
}
__device__ __forceinline__ float wave_max(float v) {
#pragma unroll
    for (int o = 1; o < 64; o <<= 1) v = fmaxf(v, __shfl_xor(v, o));
    return v;
}

__device__ __forceinline__ void f_lru_p2(ArgsR A, int l, int item, LAS unsigned char* lds, int tid) {
    const int j = item & 7, n = (item >> 3) & 31, b = item >> 8;
    const bf16* P = (const bf16*)(A.ws + WS_P); float* HLg = (float*)(A.ws + WS_LRU_HL); float* APg = (float*)(A.ws + WS_LRU_AP);
    LAS float* xc = (LAS float*)(lds); LAS float* was = (LAS float*)(lds + 20480); LAS float* wxs = (LAS float*)(lds + 36864);
    LAS float* aa = (LAS float*)(lds + 53248); LAS float* uu = (LAS float*)(lds + 69632); LAS float* segA = (LAS float*)(lds + 86016); LAS float* segH = (LAS float*)(lds + 88064);
    const float* wa = A.in[I_LRU_WA] + ((size_t)l * 8 + j) * 4096; const float* wx = A.in[I_LRU_WX] + ((size_t)l * 8 + j) * 4096;
    for (int i = tid; i < 4096; i += NTHREADS) { was[i] = wa[i]; wxs[i] = wx[i]; }
    const float* cw = A.in[I_LRU_CW] + (size_t)l * 4 * GW; const float* cb = A.in[I_LRU_CB] + l * GW;
    const float* ba = A.in[I_LRU_BA] + l * GW + j * 64; const float* bx = A.in[I_LRU_BX] + l * GW + j * 64; const float* lam = A.in[I_LRU_LAM] + l * GW + j * 64;
    const size_t r0 = (size_t)b * SEQ + n * CHK;
    { const int cc = tid & 63, c0 = (tid >> 6) * 8, ch = j * 64 + cc, pc = PC_LRU_X + ch; const long t0 = (long)n * CHK + c0;
        const float w0 = cw[ch], w1 = cw[GW + ch], w2 = cw[2 * GW + ch], w3 = cw[3 * GW + ch], bias = cb[ch];
        float xm3 = (t0 - 3 >= 0) ? bf2f(P[(r0 + c0 - 3) * PBW + pc]) : 0.f, xm2 = (t0 - 2 >= 0) ? bf2f(P[(r0 + c0 - 2) * PBW + pc]) : 0.f, xm1 = (t0 - 1 >= 0) ? bf2f(P[(r0 + c0 - 1) * PBW + pc]) : 0.f;
#pragma unroll
        for (int i = 0; i < 8; ++i) { const float x0 = bf2f(P[(r0 + c0 + i) * PBW + pc]); xc[(c0 + i) * 65 + cc] = w0 * xm3 + w1 * xm2 + w2 * xm1 + w3 * x0 + bias; xm3 = xm2; xm2 = xm1; xm1 = x0; } }
    __syncthreads();
    { const int tok = tid >> 3, cg = tid & 7; float ra[8], ri[8];
#pragma unroll
        for (int q = 0; q < 8; ++q) { ra[q] = ba[cg * 8 + q]; ri[q] = bx[cg * 8 + q]; }
#pragma unroll 4
        for (int i = 0; i < 64; ++i) { const float xv = xc[tok * 65 + i];
            const f32x4 a0 = *(const LAS f32x4*)(was + i * 64 + cg * 8), a1 = *(const LAS f32x4*)(was + i * 64 + cg * 8 + 4);
            const f32x4 x0 = *(const LAS f32x4*)(wxs + i * 64 + cg * 8), x1 = *(const LAS f32x4*)(wxs + i * 64 + cg * 8 + 4);
#pragma unroll
            for (int q = 0; q < 4; ++q) { ra[q] += xv * a0[q]; ra[4 + q] += xv * a1[q]; ri[q] += xv * x0[q]; ri[4 + q] += xv * x1[q]; } }
#pragma unroll
        for (int q = 0; q < 8; ++q) { const int jj = cg * 8 + q; const float r = sigmoidf_(ra[q]), ig = sigmoidf_(ri[q]);
            const float log_a = -8.0f * r * softplusf_(-lam[jj]); const float a = __expf(log_a), u = sqrtf(-expm1f(2.0f * log_a)) * (ig * xc[tok * 65 + jj]);
            aa[tok * 64 + jj] = a; uu[tok * 64 + jj] = u; } }
    __syncthreads();
    const int cc = tid & 63, seg = tid >> 6;
    { float Ap = 1.f, Hl = 0.f;
#pragma unroll
        for (int i = 0; i < 8; ++i) { const int c = seg * 8 + i; const float a = aa[c * 64 + cc], u = uu[c * 64 + cc]; Hl = a * Hl + u; Ap *= a; aa[c * 64 + cc] = Ap; uu[c * 64 + cc] = Hl; }
        segA[seg * 64 + cc] = Ap; segH[seg * 64 + cc] = Hl; }
    __syncthreads();
    { float Ac = 1.f, Hc = 0.f;
#pragma unroll 1
        for (int s = 0; s < seg; ++s) { const float sa = segA[s * 64 + cc]; Hc = sa * Hc + segH[s * 64 + cc]; Ac *= sa; }
#pragma unroll
        for (int i = 0; i < 8; ++i) { const int c = seg * 8 + i; const float ap = aa[c * 64 + cc], hl = uu[c * 64 + cc];
            HLg[(r0 + c) * GW + j * 64 + cc] = ap * Hc + hl; APg[(r0 + c) * GW + j * 64 + cc] = ap * Ac; } }
    __syncthreads();
}
__device__ __forceinline__ void f_lru_p3(ArgsR A, int b, int tid) {
    const float* HLg = (const float*)(A.ws + WS_LRU_HL); const float* APg = (const float*)(A.ws + WS_LRU_AP); float* carry = (float*)(A.ws + WS_LRU_CARRY);
    float c = 0.f;
#pragma unroll 8
    for (int n = 0; n < NCHK; ++n) { carry[((size_t)b * NCHK + n) * GW + tid] = c; const size_t t = (size_t)b * SEQ + n * CHK + 63; c = APg[t * GW + tid] * c + HLg[t * GW + tid]; }
}
__device__ __forceinline__ void f_lru_p4(ArgsR A, int item, int tid) {
    const bf16* P = (const bf16*)(A.ws + WS_P); bf16* mix = (bf16*)(A.ws + WS_MIX);
    const float* HLg = (const float*)(A.ws + WS_LRU_HL); const float* APg = (const float*)(A.ws + WS_LRU_AP); const float* carry = (const float*)(A.ws + WS_LRU_CARRY);
    const float cr = carry[(size_t)item * GW + tid]; const size_t r0 = (size_t)item * CHK;
#pragma unroll 8
    for (int c = 0; c < CHK; ++c) { const float h = APg[(r0 + c) * GW + tid] * cr + HLg[(r0 + c) * GW + tid]; const float y = bf2f(P[(r0 + c) * PBW + PC_LRU_Y + tid]);
        mix[(r0 + c) * DM + 512 + tid] = (bf16)f2bf(gelu_tanh(y) * h); }
}

constexpr int FL_Q = 0, FL_K = 17408, FL_V = 34816, FL_ST = 52224, FL_SC = 87040, FL_BC = 96256, FL_LR = 129024, FL_SEG = 133120, FL_RS = 135168;
__device__ __forceinline__ void gla_bcum(ArgsR A, int l, int h, LAS float* bc, LAS float* segt, const LAS float* lrs, int tid) {
    const int d = tid & 127, seg = tid >> 7;
    const float* w2 = A.in[I_GLA_W2] + (size_t)l * 16 * GW + h * HD + d; float w2c[16];
#pragma unroll
    for (int r = 0; r < 16; ++r) w2c[r] = w2[r * GW];
    const float b2 = A.in[I_GLA_B2][l * GW + h * HD + d]; float run = 0.f;
#pragma unroll 4
    for (int i = 0; i < 16; ++i) { const int c = seg * 16 + i; float z = b2;
#pragma unroll
        for (int r = 0; r < 16; ++r) z += lrs[c * 16 + r] * w2c[r];
        run += logsigmoidf_(z) * (1.0f / 16.0f); bc[c * 128 + d] = run; }
    segt[seg * 128 + d] = run;
}
__device__ __forceinline__ void f_gla_p2(ArgsR A, int l, int item, LAS unsigned char* lds, int tid) {
    const int n = item & 31, h = (item >> 5) & 3, b = item >> 7; const int lane = tid & 63, wave = __builtin_amdgcn_readfirstlane(tid >> 6);
    const bf16* P = (const bf16*)(A.ws + WS_P); const float* Ps = (const float*)(A.ws + WS_PS);
    float* inc = (float*)(A.ws + WS_GLA_INC) + (size_t)item * 16384; float* dec = (float*)(A.ws + WS_GLA_DEC) + (size_t)item * 128;
    LAS bf16* ks = (LAS bf16*)(lds + FL_K); LAS bf16* vs = (LAS bf16*)(lds + FL_V); LAS float* bc = (LAS float*)(lds + FL_BC); LAS float* lrs = (LAS float*)(lds + FL_LR); LAS float* segt = (LAS float*)(lds + FL_SEG);
    const size_t r0 = (size_t)b * SEQ + n * CHK;
    tile_g2l_128<64>(P + r0 * PBW + PC_GLA_K + h * HD, PBW, ks, tid);
    tile_g2l_128<64>(P + r0 * PBW + PC_GLA_V + h * HD, PBW, vs, tid);
    for (int i = tid; i < 64 * 16; i += NTHREADS) lrs[i] = Ps[(r0 + (i >> 4)) * 32 + PS_LR + (i & 15)];
    __syncthreads();
    gla_bcum(A, l, h, bc, segt, lrs, tid);
    __syncthreads();
    { const int d = tid & 127, seg = tid >> 7; float pre = 0.f, tot = 0.f;
#pragma unroll
        for (int s = 0; s < 4; ++s) { const float v = segt[s * 128 + d]; if (s < seg) pre += v; tot += v; }
#pragma unroll 4
        for (int i = 0; i < 16; ++i) { const int c = seg * 16 + i; const float bcm = bc[c * 128 + d] + pre; ks[c * LD128 + d] = (bf16)f2bf(bf2f(ks[c * LD128 + d]) * __expf(tot - bcm)); }
        if (seg == 0) dec[d] = __expf(tot); }
    __syncthreads();
    { f32x4 acc[8];
#pragma unroll
        for (int nt = 0; nt < 8; ++nt) acc[nt] = (f32x4){0.f, 0.f, 0.f, 0.f};
#pragma unroll
        for (int kk = 0; kk < 2; ++kk) { const bf16x8 af = frag_tr(vs, LD128, 32 * kk, 16 * wave, lane);
#pragma unroll
            for (int nt = 0; nt < 8; ++nt) acc[nt] = MFMA16(af, frag_tr(ks, LD128, 32 * kk, 16 * nt, lane), acc[nt]); }
        const int fr = lane & 15, fq = lane >> 4;
#pragma unroll
        for (int nt = 0; nt < 8; ++nt)
#pragma unroll
            for (int r = 0; r < 4; ++r) inc[(16 * wave + 4 * fq + r) * 128 + 16 * nt + fr] = acc[nt][r]; }
    __syncthreads();
}
__device__ __forceinline__ void f_gla_p3(ArgsR A, int item, int tid) {
    const int bh = item >> 4, sl = item & 15; const int e = sl * 1024 + tid * 2, d = e & 127;
    const float* inc = (const float*)(A.ws + WS_GLA_INC) + (size_t)bh * 32 * 16384 + e; const float* dec = (const float*)(A.ws + WS_GLA_DEC) + (size_t)bh * 32 * 128 + d;
    bf16* st = (bf16*)(A.ws + WS_GLA_ST) + (size_t)bh * 32 * 16384 + e;
    float s0 = 0.f, s1 = 0.f;
#pragma unroll 8
    for (int n = 0; n < NCHK; ++n) { *(GAS unsigned*)(st + (size_t)n * 16384) = pk2(s0, s1);
        const f32x2 iv = *(const GAS f32x2*)(inc + (size_t)n * 16384), dv = *(const GAS f32x2*)(dec + (size_t)n * 128); s0 = dv[0] * s0 + iv[0]; s1 = dv[1] * s1 + iv[1]; }
}
__device__ __forceinline__ void f_gla_p4(ArgsR A, int l, int item, LAS unsigned char* lds, int tid) {
    const int n = item & 31, h = (item >> 5) & 3, b = item >> 7; const int lane = tid & 63, wave = __builtin_amdgcn_readfirstlane(tid >> 6), fr = lane & 15, fq = lane >> 4;
    const bf16* P = (const bf16*)(A.ws + WS_P); const float* Ps = (const float*)(A.ws + WS_PS); bf16* mix = (bf16*)(A.ws + WS_MIX);
    const bf16* stg = (const bf16*)(A.ws + WS_GLA_ST) + (size_t)item * 16384;
    LAS bf16* qs = (LAS bf16*)(lds + FL_Q); LAS bf16* ks = (LAS bf16*)(lds + FL_K); LAS bf16* vs = (LAS bf16*)(lds + FL_V); LAS bf16* sts = (LAS bf16*)(lds + FL_ST); LAS bf16* scs = (LAS bf16*)(lds + FL_SC);
    LAS float* bc = (LAS float*)(lds + FL_BC); LAS float* lrs = (LAS float*)(lds + FL_LR); LAS float* segt = (LAS float*)(lds + FL_SEG); LAS float* rsp = (LAS float*)(lds + FL_RS);
    const size_t r0 = (size_t)b * SEQ + n * CHK;
    tile_g2l_128<64>(P + r0 * PBW + PC_GLA_Q + h * HD, PBW, qs, tid);
    tile_g2l_128<64>(P + r0 * PBW + PC_GLA_K + h * HD, PBW, ks, tid);
    tile_g2l_128<64>(P + r0 * PBW + PC_GLA_V + h * HD, PBW, vs, tid);
    tile_g2l_128<128>(stg, 128, sts, tid);
    for (int i = tid; i < 64 * 16; i += NTHREADS) lrs[i] = Ps[(r0 + (i >> 4)) * 32 + PS_LR + (i & 15)];
    __syncthreads();
    gla_bcum(A, l, h, bc, segt, lrs, tid);
    __syncthreads();
    { const int d = tid & 127, seg = tid >> 7; float pre = 0.f;
#pragma unroll
        for (int s = 0; s < 4; ++s) { const float v = segt[s * 128 + d]; if (s < seg) pre += v; }
#pragma unroll 4
        for (int i = 0; i < 16; ++i) { const int c = seg * 16 + i; const float bcm = bc[c * 128 + d] + pre; const float eb = __expf(bcm);
            qs[c * LD128 + d] = (bf16)f2bf(bf2f(qs[c * LD128 + d]) * eb * 0.08838834764831845f); ks[c * LD128 + d] = (bf16)f2bf(bf2f(ks[c * LD128 + d]) / eb); } }
    __syncthreads();
    { const int mt = wave >> 1; f32x4 acc[2] = {{0.f, 0.f, 0.f, 0.f}, {0.f, 0.f, 0.f, 0.f}};
#pragma unroll
        for (int kk = 0; kk < 4; ++kk) { const bf16x8 af = frag_rd(qs, LD128, 16 * mt, 32 * kk, lane);
#pragma unroll
            for (int q = 0; q < 2; ++q) acc[q] = MFMA16(af, frag_rd(ks, LD128, 16 * (2 * (wave & 1) + q), 32 * kk, lane), acc[q]); }
#pragma unroll
        for (int q = 0; q < 2; ++q) { const int s = 16 * (2 * (wave & 1) + q) + fr;
#pragma unroll
            for (int r = 0; r < 4; ++r) { const int c = 16 * mt + 4 * fq + r; scs[c * LD64 + s] = (bf16)f2bf(s <= c ? acc[q][r] : 0.f); } } }
    __syncthreads();
    f32x4 o[4];
#pragma unroll
    for (int mt = 0; mt < 4; ++mt) o[mt] = (f32x4){0.f, 0.f, 0.f, 0.f};
#pragma unroll
    for (int kk = 0; kk < 2; ++kk) { const bf16x8 bfv = frag_tr(vs, LD128, 32 * kk, 16 * wave, lane);
#pragma unroll
        for (int mt = 0; mt < 4; ++mt) o[mt] = MFMA16(frag_rd(scs, LD64, 16 * mt, 32 * kk, lane), bfv, o[mt]); }
#pragma unroll
    for (int kk = 0; kk < 4; ++kk) { const bf16x8 bfs = frag_rd(sts, LD128, 16 * wave, 32 * kk, lane);
#pragma unroll
        for (int mt = 0; mt < 4; ++mt) o[mt] = MFMA16(frag_rd(qs, LD128, 16 * mt, 32 * kk, lane), bfs, o[mt]); }
#pragma unroll
    for (int mt = 0; mt < 4; ++mt)
#pragma unroll
        for (int r = 0; r < 4; ++r) { float s = o[mt][r] * o[mt][r]; s += __shfl_xor(s, 1); s += __shfl_xor(s, 2); s += __shfl_xor(s, 4); s += __shfl_xor(s, 8);
            if (fr == 0) rsp[wave * 64 + 16 * mt + 4 * fq + r] = s; }
    __syncthreads();
    const float* ng = A.in[I_GLA_NG] + l * GW + h * HD; const float gn = ng[16 * wave + fr];
#pragma unroll
    for (int mt = 0; mt < 4; ++mt)
#pragma unroll
        for (int r = 0; r < 4; ++r) { const int c = 16 * mt + 4 * fq + r; float ss = 0.f;
#pragma unroll
            for (int w = 0; w < 8; ++w) ss += rsp[w * 64 + c];
            const float rs = rsqrtf(ss * (1.0f / 128.0f) + RMS_EPS);
            const float g = bf2f(P[(r0 + c) * PBW + PC_GLA_G + h * HD + 16 * wave + fr]);
            mix[(r0 + c) * DM + h * HD + 16 * wave + fr] = (bf16)f2bf(o[mt][r] * rs * gn * siluf_(g)); }
    __syncthreads();
}

constexpr int FM_Q2 = 96256, FM_S = 129024;
__device__ __forceinline__ void f_ml_p2(ArgsR A, int l, int item, LAS unsigned char* lds, int tid) {
    const int n = item & 31, h = (item >> 5) & 3, b = item >> 7; const int lane = tid & 63, wave = __builtin_amdgcn_readfirstlane(tid >> 6);
    const bf16* P = (const bf16*)(A.ws + WS_P); const float* Ps = (const float*)(A.ws + WS_PS);
    float* inc = (float*)(A.ws + WS_ML_INC) + (size_t)item * 16384; float* incn = (float*)(A.ws + WS_ML_N) + (size_t)item * 128; float* scg = (float*)(A.ws + WS_ML_SC) + (size_t)item * 2;
    LAS bf16* ks = (LAS bf16*)(lds + FL_K); LAS bf16* vs = (LAS bf16*)(lds + FL_V); LAS float* sc = (LAS float*)(lds + FM_S);
    const size_t r0 = (size_t)b * SEQ + n * CHK;
    tile_g2l_128<64>(P + r0 * PBW + PC_ML_K + h * HD, PBW, ks, tid);
    tile_g2l_128<64>(P + r0 * PBW + PC_ML_V + h * HD, PBW, vs, tid);
    if (wave == 0) { const float lf = logsigmoidf_(Ps[(r0 + lane) * 32 + PS_MF + h] + A.in[I_ML_FB][l * NH + h]), ig = Ps[(r0 + lane) * 32 + PS_MI + h] + A.in[I_ML_IB][l * NH + h];
        const float bcum = wave_scan_add(lf, lane), blast = __shfl(bcum, 63), le = blast - bcum + ig, mloc = wave_max(le);
        sc[lane] = __expf(le - mloc) * 0.08838834764831845f; if (lane == 0) { scg[0] = mloc; scg[1] = blast; } }
    __syncthreads();
#pragma unroll
    for (int i = 0; i < 2; ++i) { const int idx = tid + i * NTHREADS, r = idx >> 4, c8 = (idx & 15) * 8; const float w = sc[r];
        v4u x = *(LAS v4u*)(ks + r * LD128 + c8);
        x.x = pk2(bflo(x.x) * w, bfhi(x.x) * w); x.y = pk2(bflo(x.y) * w, bfhi(x.y) * w); x.z = pk2(bflo(x.z) * w, bfhi(x.z) * w); x.w = pk2(bflo(x.w) * w, bfhi(x.w) * w);
        *(LAS v4u*)(ks + r * LD128 + c8) = x; }
    __syncthreads();
    if (tid < 128) { float s = 0.f;
#pragma unroll 8
        for (int c = 0; c < 64; ++c) s += bf2f(ks[c * LD128 + tid]);
        incn[tid] = s; }
    { f32x4 acc[8];
#pragma unroll
        for (int nt = 0; nt < 8; ++nt) acc[nt] = (f32x4){0.f, 0.f, 0.f, 0.f};
#pragma unroll
        for (int kk = 0; kk < 2; ++kk) { const bf16x8 af = frag_tr(vs, LD128, 32 * kk, 16 * wave, lane);
#pragma unroll
            for (int nt = 0; nt < 8; ++nt) acc[nt] = MFMA16(af, frag_tr(ks, LD128, 32 * kk, 16 * nt, lane), acc[nt]); }
        const int fr = lane & 15, fq = lane >> 4;
#pragma unroll
        for (int nt = 0; nt < 8; ++nt)
#pragma unroll
            for (int r = 0; r < 4; ++r) inc[(16 * wave + 4 * fq + r) * 128 + 16 * nt + fr] = acc[nt][r]; }
    __syncthreads();
}
__device__ __forceinline__ void f_ml_p3(ArgsR A, int item, int tid) {
    const int bh = item >> 4, sl = item & 15; const int e = sl * 1024 + tid * 2;
    const float* inc = (const float*)(A.ws + WS_ML_INC) + (size_t)bh * 32 * 16384 + e; const float* incn = (const float*)(A.ws + WS_ML_N) + (size_t)bh * 32 * 128;
    const float* scg = (const float*)(A.ws + WS_ML_SC) + (size_t)bh * 32 * 2;
    bf16* st = (bf16*)(A.ws + WS_ML_ST) + (size_t)bh * 32 * 16384 + e; float* np = (float*)(A.ws + WS_ML_NP) + (size_t)bh * 32 * 128; float* mp = (float*)(A.ws + WS_ML_MP) + (size_t)bh * 32;
    float c0 = 0.f, c1 = 0.f, nv = 0.f, m = 0.f; const int dn = sl * 8 + tid;
#pragma unroll 4
    for (int n = 0; n < NCHK; ++n) {
        *(GAS unsigned*)(st + (size_t)n * 16384) = pk2(c0, c1);
        if (tid < 8) np[n * 128 + dn] = nv;
        if (sl == 0 && tid == 0) mp[n] = m;
        const float ml = scg[2 * n], bl = scg[2 * n + 1]; const float mn = fmaxf(bl + m, ml), ao = __expf(bl + m - mn), ai = __expf(ml - mn);
        const f32x2 iv = *(const GAS f32x2*)(inc + (size_t)n * 16384); c0 = ao * c0 + ai * iv[0]; c1 = ao * c1 + ai * iv[1];
        if (tid < 8) nv = ao * nv + ai * incn[n * 128 + dn];
        m = mn; }
}
__device__ __forceinline__ void f_ml_p4(ArgsR A, int l, int item, LAS unsigned char* lds, int tid) {
    const int n = item & 31, h = (item >> 5) & 3, b = item >> 7; const int lane = tid & 63, wave = __builtin_amdgcn_readfirstlane(tid >> 6), fr = lane & 15, fq = lane >> 4;
    const bf16* P = (const bf16*)(A.ws + WS_P); const float* Ps = (const float*)(A.ws + WS_PS); bf16* mix = (bf16*)(A.ws + WS_MIX);
    const bf16* stg = (const bf16*)(A.ws + WS_ML_ST) + (size_t)item * 16384; const float* npg = (const float*)(A.ws + WS_ML_NP) + (size_t)item * 128; const float mprev = ((const float*)(A.ws + WS_ML_MP))[item];
    LAS bf16* qs = (LAS bf16*)(lds + FL_Q); LAS bf16* ks = (LAS bf16*)(lds + FL_K); LAS bf16* vs = (LAS bf16*)(lds + FL_V); LAS bf16* sts = (LAS bf16*)(lds + FL_ST); LAS bf16* scs = (LAS bf16*)(lds + FL_SC);
    LAS bf16* q2 = (LAS bf16*)(lds + FM_Q2); LAS float* sc = (LAS float*)(lds + FM_S); LAS float* rsp = (LAS float*)(lds + FL_RS + 4096);
    const size_t r0 = (size_t)b * SEQ + n * CHK;
    tile_g2l_128<64>(P + r0 * PBW + PC_ML_Q + h * HD, PBW, qs, tid);
    tile_g2l_128<64>(P + r0 * PBW + PC_ML_K + h * HD, PBW, ks, tid);
    tile_g2l_128<64>(P + r0 * PBW + PC_ML_V + h * HD, PBW, vs, tid);
    tile_g2l_128<128>(stg, 128, sts, tid);
    if (wave == 0) { const float lf = logsigmoidf_(Ps[(r0 + lane) * 32 + PS_MF + h] + A.in[I_ML_FB][l * NH + h]), ig = Ps[(r0 + lane) * 32 + PS_MI + h] + A.in[I_ML_IB][l * NH + h];
        const float bcum = wave_scan_add(lf, lane), as = ig - bcum, pm = wave_scan_max(as, lane);
        const float mintra = bcum + pm, minter = bcum + mprev, mt = fmaxf(mintra, minter);
        sc[lane] = bcum - mt; sc[64 + lane] = as; sc[128 + lane] = __expf(minter - mt); sc[192 + lane] = __expf(-mt); }
    if (wave == 1) { sc[320 + lane] = npg[lane]; sc[384 + lane] = npg[64 + lane]; }
    __syncthreads();
#pragma unroll
    for (int i = 0; i < 2; ++i) { const int idx = tid + i * NTHREADS, r = idx >> 4, c8 = (idx & 15) * 8; const float w = sc[128 + r];
        v4u x = *(LAS v4u*)(qs + r * LD128 + c8);
        x.x = pk2(bflo(x.x) * w, bfhi(x.x) * w); x.y = pk2(bflo(x.y) * w, bfhi(x.y) * w); x.z = pk2(bflo(x.z) * w, bfhi(x.z) * w); x.w = pk2(bflo(x.w) * w, bfhi(x.w) * w);
        *(LAS v4u*)(q2 + r * LD128 + c8) = x; }
    { const int mt = wave >> 1; f32x4 acc[2] = {{0.f, 0.f, 0.f, 0.f}, {0.f, 0.f, 0.f, 0.f}};
#pragma unroll
        for (int kk = 0; kk < 4; ++kk) { const bf16x8 af = frag_rd(qs, LD128, 16 * mt, 32 * kk, lane);
#pragma unroll
            for (int q = 0; q < 2; ++q) acc[q] = MFMA16(af, frag_rd(ks, LD128, 16 * (2 * (wave & 1) + q), 32 * kk, lane), acc[q]); }
#pragma unroll
        for (int q = 0; q < 2; ++q) { const int s = 16 * (2 * (wave & 1) + q) + fr; const float asv = sc[64 + s];
#pragma unroll
            for (int r = 0; r < 4; ++r) { const int c = 16 * mt + 4 * fq + r; scs[c * LD64 + s] = (bf16)f2bf(s <= c ? acc[q][r] * 0.08838834764831845f * __expf(sc[c] + asv) : 0.f); } } }
    __syncthreads();
    { const int c = tid >> 3, part = tid & 7; float s = 0.f;
#pragma unroll
        for (int i = 0; i < 8; ++i) s += bf2f(scs[c * LD64 + part * 8 + i]);
#pragma unroll
        for (int i = 0; i < 16; ++i) s += bf2f(q2[c * LD128 + part * 16 + i]) * sc[320 + part * 16 + i];
        s += __shfl_xor(s, 1); s += __shfl_xor(s, 2); s += __shfl_xor(s, 4);
        if (part == 0) sc[256 + c] = fmaxf(fabsf(s), sc[192 + c]); }
    f32x4 o[4];
#pragma unroll
    for (int mt = 0; mt < 4; ++mt) o[mt] = (f32x4){0.f, 0.f, 0.f, 0.f};
#pragma unroll
    for (int kk = 0; kk < 2; ++kk) { const bf16x8 bfv = frag_tr(vs, LD128, 32 * kk, 16 * wave, lane);
#pragma unroll
        for (int mt = 0; mt < 4; ++mt) o[mt] = MFMA16(frag_rd(scs, LD64, 16 * mt, 32 * kk, lane), bfv, o[mt]); }
#pragma unroll
    for (int kk = 0; kk < 4; ++kk) { const bf16x8 bfs = frag_rd(sts, LD128, 16 * wave, 32 * kk, lane);
#pragma unroll
        for (int mt = 0; mt < 4; ++mt) o[mt] = MFMA16(frag_rd(q2, LD128, 16 * mt, 32 * kk, lane), bfs, o[mt]); }
    __syncthreads();
#pragma unroll
    for (int mt = 0; mt < 4; ++mt)
#pragma unroll
        for (int r = 0; r < 4; ++r) { const int c = 16 * mt + 4 * fq + r; const float og = bf2f(P[(r0 + c) * PBW + PC_ML_O + h * HD + 16 * wave + fr]);
            const float hv = o[mt][r] / sc[256 + c] * sigmoidf_(og); o[mt][r] = hv;
            float s = hv * hv; s += __shfl_xor(s, 1); s += __shfl_xor(s, 2); s += __shfl_xor(s, 4); s += __shfl_xor(s, 8);
            if (fr == 0) rsp[wave * 64 + c] = s; }
    __syncthreads();
    const float* ng = A.in[I_ML_NG] + l * GW + h * HD; const float gn = ng[16 * wave + fr];
#pragma unroll
    for (int mt = 0; mt < 4; ++mt)
#pragma unroll
        for (int r = 0; r < 4; ++r) { const int c = 16 * mt + 4 * fq + r; float ss = 0.f;
#pragma unroll
            for (int w = 0; w < 8; ++w) ss += rsp[w * 64 + c];
            mix[(r0 + c) * DM + 1024 + h * HD + 16 * wave + fr] = (bf16)f2bf(o[mt][r] * rsqrtf(ss * (1.0f / 128.0f) + RMS_EPS) * gn); }
    __syncthreads();
}

constexpr int FG_LM = 52224, FG_S = 129024;
template <int C> struct GdnSolve {
    static __device__ __forceinline__ void run(float (&sol)[64], const LAS float* Lm) {
        if constexpr (C < 64) {
            float acc = sol[C];
#pragma unroll
            for (int s = 0; s < C; ++s) acc -= Lm[C * 64 + s] * sol[s];
            sol[C] = acc;
            GdnSolve<C + 1>::run(sol, Lm);
        }
    }
};
__device__ __forceinline__ void f_gdn_p2(ArgsR A, int l, int item, LAS unsigned char* lds, int tid) {
    const int n = item & 31, h = (item >> 5) & 3, b = item >> 7; const int lane = tid & 63, wave = __builtin_amdgcn_readfirstlane(tid >> 6), fr = lane & 15, fq = lane >> 4;
    const bf16* P = (const bf16*)(A.ws + WS_P); const float* Ps = (const float*)(A.ws + WS_PS);
    bf16* U0 = (bf16*)(A.ws + WS_GDN_U0) + (size_t)item * 8192; bf16* Wg = (bf16*)(A.ws + WS_GDN_W) + (size_t)item * 8192; bf16* QD = (bf16*)(A.ws + WS_GDN_QD) + (size_t)item * 8192;
    bf16* KE = (bf16*)(A.ws + WS_GDN_KE) + (size_t)item * 8192; bf16* QK = (bf16*)(A.ws + WS_GDN_QK) + (size_t)item * 4096; float* DE = (float*)(A.ws + WS_GDN_DE);
    LAS bf16* qs = (LAS bf16*)(lds + FL_Q); LAS bf16* ks = (LAS bf16*)(lds + FL_K); LAS bf16* vs = (LAS bf16*)(lds + FL_V); LAS float* Lm = (LAS float*)(lds + FG_LM); LAS float* sc = (LAS float*)(lds + FG_S);
    const float* cw = A.in[I_GDN_CW] + (size_t)l * 4 * 1536;
    const size_t r0 = (size_t)b * SEQ + n * CHK;
    { const int v = tid & 127, dq = tid >> 7;
#pragma unroll 1
        for (int part = 0; part < 3; ++part) {
            const int pc = (part == 0 ? PC_GDN_Q : part == 1 ? PC_GDN_K : PC_GDN_V) + h * HD + v, wc = part * 512 + h * HD + v;
            const float w0 = cw[wc], w1 = cw[1536 + wc], w2 = cw[2 * 1536 + wc], w3 = cw[3 * 1536 + wc];
            LAS bf16* dst = part == 0 ? qs : part == 1 ? ks : vs;
            const int c0 = dq * 16; const long t0 = (long)n * CHK + c0;
            float xm3 = (t0 - 3 >= 0) ? bf2f(P[(r0 + c0 - 3) * PBW + pc]) : 0.f, xm2 = (t0 - 2 >= 0) ? bf2f(P[(r0 + c0 - 2) * PBW + pc]) : 0.f, xm1 = (t0 - 1 >= 0) ? bf2f(P[(r0 + c0 - 1) * PBW + pc]) : 0.f;
#pragma unroll 4
            for (int i = 0; i < 16; ++i) { const float x0 = bf2f(P[(r0 + c0 + i) * PBW + pc]); const float y = w0 * xm3 + w1 * xm2 + w2 * xm1 + w3 * x0;
                dst[(c0 + i) * LD128 + v] = (bf16)f2bf(siluf_(y)); xm3 = xm2; xm2 = xm1; xm1 = x0; } } }
    if (wave == 0) { const float bt = sigmoidf_(Ps[(r0 + lane) * 32 + PS_GB + h]);
        const float g = -__expf(A.in[I_GDN_ALOG][l * NH + h]) * softplusf_(Ps[(r0 + lane) * 32 + PS_GA + h] + A.in[I_GDN_DTB][l * NH + h]);
        const float gam = wave_scan_add(g, lane); sc[lane] = bt; sc[64 + lane] = gam; if (lane == 63) DE[item] = __expf(gam); }
    __syncthreads();
#pragma unroll 1
    for (int rr = 0; rr < 8; ++rr) { const int c = wave * 8 + rr;
        const float q1 = bf2f(qs[c * LD128 + lane]), q2 = bf2f(qs[c * LD128 + 64 + lane]), k1 = bf2f(ks[c * LD128 + lane]), k2 = bf2f(ks[c * LD128 + 64 + lane]);
        const float sq = wave_sum(q1 * q1 + q2 * q2), sk = wave_sum(k1 * k1 + k2 * k2);
        if (lane == 0) { sc[128 + c] = rsqrtf(sq + 1e-6f) * 0.08838834764831845f; sc[192 + c] = rsqrtf(sk + 1e-6f); } }
    __syncthreads();
    { const int mt = wave >> 1; f32x4 akk[2] = {{0.f, 0.f, 0.f, 0.f}, {0.f, 0.f, 0.f, 0.f}}, aqk[2] = {{0.f, 0.f, 0.f, 0.f}, {0.f, 0.f, 0.f, 0.f}};
#pragma unroll
        for (int kk = 0; kk < 4; ++kk) { const bf16x8 ak = frag_rd(ks, LD128, 16 * mt, 32 * kk, lane), aq = frag_rd(qs, LD128, 16 * mt, 32 * kk, lane);
#pragma unroll
            for (int q = 0; q < 2; ++q) { const bf16x8 bk = frag_rd(ks, LD128, 16 * (2 * (wave & 1) + q), 32 * kk, lane); akk[q] = MFMA16(ak, bk, akk[q]); aqk[q] = MFMA16(aq, bk, aqk[q]); } }
#pragma unroll
        for (int q = 0; q < 2; ++q) { const int s = 16 * (2 * (wave & 1) + q) + fr; const float rks = sc[192 + s], gs = sc[64 + s];
#pragma unroll
            for (int r = 0; r < 4; ++r) { const int c = 16 * mt + 4 * fq + r; const float dcy = __expf(sc[64 + c] - gs);
                Lm[c * 64 + s] = (s < c) ? sc[c] * akk[q][r] * sc[192 + c] * rks * dcy : 0.f;
                QK[c * 64 + s] = (bf16)f2bf((s <= c) ? aqk[q][r] * sc[128 + c] * rks * dcy : 0.f); } } }
    __syncthreads();
    if (tid < 256) {
        float sol[64]; const bool isw = tid >= 128; const int j = tid & 127;
#pragma unroll
        for (int c = 0; c < 64; ++c) { const float bt = sc[c]; sol[c] = isw ? bf2f(ks[c * LD128 + j]) * sc[192 + c] * bt * __expf(sc[64 + c]) : bf2f(vs[c * LD128 + j]) * bt; }
        GdnSolve<1>::run(sol, Lm);
        bf16* dst = isw ? Wg : U0;
#pragma unroll
        for (int c = 0; c < 64; ++c) dst[c * 128 + j] = (bf16)f2bf(sol[c]);
    } else {
        const int t2 = tid - 256; const float glast = sc[64 + 63];
#pragma unroll
        for (int i = 0; i < 8; ++i) { const int idx = t2 + i * 256, which = idx >> 10, pi = idx & 1023, r = pi >> 4, c8 = (pi & 15) * 8;
            const float w = which == 0 ? sc[128 + r] * __expf(sc[64 + r]) : sc[192 + r] * __expf(glast - sc[64 + r]);
            v4u x = *(LAS v4u*)((which == 0 ? qs : ks) + r * LD128 + c8);
            x.x = pk2(bflo(x.x) * w, bfhi(x.x) * w); x.y = pk2(bflo(x.y) * w, bfhi(x.y) * w); x.z = pk2(bflo(x.z) * w, bfhi(x.z) * w); x.w = pk2(bflo(x.w) * w, bfhi(x.w) * w);
            *(GAS v4u*)((which == 0 ? QD : KE) + r * 128 + c8) = x; }
    }
    __syncthreads();
}

constexpr int FC_W = 0, FC_QD = 17408, FC_KE = 34816, FC_U0 = 52224, FC_QK = 69632;
__device__ __forceinline__ void f_gdn_p3(ArgsR A, int bh, LAS unsigned char* lds, int tid) {
    const int lane = tid & 63, wave = __builtin_amdgcn_readfirstlane(tid >> 6), fr = lane & 15, fq = lane >> 4; const int b = bh >> 2, h = bh & 3;
    const bf16* U0 = (const bf16*)(A.ws + WS_GDN_U0) + (size_t)bh * 32 * 8192; const bf16* Wg = (const bf16*)(A.ws + WS_GDN_W) + (size_t)bh * 32 * 8192; const bf16* QD = (const bf16*)(A.ws + WS_GDN_QD) + (size_t)bh * 32 * 8192;
    const bf16* KE = (const bf16*)(A.ws + WS_GDN_KE) + (size_t)bh * 32 * 8192; const bf16* QK = (const bf16*)(A.ws + WS_GDN_QK) + (size_t)bh * 32 * 4096; const float* DE = (const float*)(A.ws + WS_GDN_DE) + bh * 32;
    float* Og = (float*)(A.ws + WS_GDN_O);
    LAS bf16* ws_ = (LAS bf16*)(lds + FC_W); LAS bf16* qds = (LAS bf16*)(lds + FC_QD); LAS bf16* kes = (LAS bf16*)(lds + FC_KE); LAS bf16* u0s = (LAS bf16*)(lds + FC_U0); LAS bf16* qks = (LAS bf16*)(lds + FC_QK);
    f32x4 S[8];
#pragma unroll
    for (int i = 0; i < 8; ++i) S[i] = (f32x4){0.f, 0.f, 0.f, 0.f};
    v4u st[9];
    auto issue = [&](int n) {
#pragma unroll
        for (int i = 0; i < 8; ++i) { const int idx = tid + i * NTHREADS, which = idx >> 10, pi = idx & 1023;
            const bf16* src = (which == 0 ? Wg : which == 1 ? QD : which == 2 ? KE : U0) + (size_t)n * 8192; st[i] = *(const GAS v4u*)(src + pi * 8); }
        st[8] = *(const GAS v4u*)(QK + (size_t)n * 4096 + tid * 8);
    };
    auto commit = [&]() {
#pragma unroll
        for (int i = 0; i < 8; ++i) { const int idx = tid + i * NTHREADS, which = idx >> 10, pi = idx & 1023, r = pi >> 4, c8 = (pi & 15) * 8;
            *(LAS v4u*)((LAS bf16*)(lds + which * 17408) + r * LD128 + c8) = st[i]; }
        { const int r = tid >> 3, c8 = (tid & 7) * 8; *(LAS v4u*)(qks + r * LD64 + c8) = st[8]; }
    };
    issue(0);
#pragma unroll 1
    for (int n = 0; n < NCHK; ++n) {
        __syncthreads();
        commit();
        __syncthreads();
        if (n + 1 < NCHK) issue(n + 1);
        const float de = DE[n];
        bf16x8 SB[4];
#pragma unroll
        for (int kb = 0; kb < 4; ++kb) SB[kb] = pack_acc(S[2 * kb], S[2 * kb + 1]);
        f32x4 u[4], o[4];
#pragma unroll
        for (int mt = 0; mt < 4; ++mt) { f32x4 ws2 = {0.f, 0.f, 0.f, 0.f}; o[mt] = (f32x4){0.f, 0.f, 0.f, 0.f};
#pragma unroll
            for (int kb = 0; kb < 4; ++kb) { ws2 = MFMA16(frag_rd_perm(ws_, LD128, 16 * mt, 32 * kb, lane), SB[kb], ws2); o[mt] = MFMA16(frag_rd_perm(qds, LD128, 16 * mt, 32 * kb, lane), SB[kb], o[mt]); }
#pragma unroll
            for (int r = 0; r < 4; ++r) u[mt][r] = bf2f(u0s[(16 * mt + 4 * fq + r) * LD128 + 16 * wave + fr]) - ws2[r]; }
        const bf16x8 UB0 = pack_acc(u[0], u[1]), UB1 = pack_acc(u[2], u[3]);
#pragma unroll
        for (int mt = 0; mt < 4; ++mt) { o[mt] = MFMA16(frag_rd_perm(qks, LD64, 16 * mt, 0, lane), UB0, o[mt]); o[mt] = MFMA16(frag_rd_perm(qks, LD64, 16 * mt, 32, lane), UB1, o[mt]); }
#pragma unroll
        for (int dt = 0; dt < 8; ++dt) { f32x4 sn = S[dt] * de;
            sn = MFMA16(frag_tr_perm(kes, LD128, 0, 16 * dt, lane), UB0, sn); sn = MFMA16(frag_tr_perm(kes, LD128, 32, 16 * dt, lane), UB1, sn); S[dt] = sn; }
        const size_t r0 = (size_t)b * SEQ + n * CHK;
#pragma unroll
        for (int mt = 0; mt < 4; ++mt)
#pragma unroll
            for (int r = 0; r < 4; ++r) Og[(r0 + 16 * mt + 4 * fq + r) * GW + h * HD + 16 * wave + fr] = o[mt][r];
    }
    __syncthreads();
}
__device__ __forceinline__ void f_gdn_p4(ArgsR A, int l, int item, int tid) {
    const int lane = tid & 63, wave = tid >> 6; const bf16* P = (const bf16*)(A.ws + WS_P); bf16* mix = (bf16*)(A.ws + WS_MIX); const float* Og = (const float*)(A.ws + WS_GDN_O);
    const float* ng = A.in[I_GDN_NG] + l * GW + lane * 8;
    const f32x4 g0 = *(const GAS f32x4*)ng, g1 = *(const GAS f32x4*)(ng + 4);
#pragma unroll 2
    for (int rr = 0; rr < 8; ++rr) { const size_t t = (size_t)item * 64 + wave * 8 + rr;
        const f32x4 a = *(const GAS f32x4*)(Og + t * GW + lane * 8), c = *(const GAS f32x4*)(Og + t * GW + lane * 8 + 4);
        float s = (a[0] * a[0] + a[1] * a[1]) + (a[2] * a[2] + a[3] * a[3]) + (c[0] * c[0] + c[1] * c[1]) + (c[2] * c[2] + c[3] * c[3]);
        s += __shfl_xor(s, 1); s += __shfl_xor(s, 2); s += __shfl_xor(s, 4); s += __shfl_xor(s, 8);
        const float rs = rsqrtf(s * (1.0f / 128.0f) + RMS_EPS);
        const v4u gw = *(const GAS v4u*)(P + t * PBW + PC_GDN_G + lane * 8);
        v4u o; o.x = pk2(a[0] * rs * g0[0] * siluf_(bflo(gw.x)), a[1] * rs * g0[1] * siluf_(bfhi(gw.x))); o.y = pk2(a[2] * rs * g0[2] * siluf_(bflo(gw.y)), a[3] * rs * g0[3] * siluf_(bfhi(gw.y)));
        o.z = pk2(c[0] * rs * g1[0] * siluf_(bflo(gw.z)), c[1] * rs * g1[1] * siluf_(bfhi(gw.z))); o.w = pk2(c[2] * rs * g1[2] * siluf_(bflo(gw.w)), c[3] * rs * g1[3] * siluf_(bfhi(gw.w)));
        *(GAS v4u*)(mix + t * DM + 1536 + lane * 8) = o; }
}

constexpr int PE_SC = 0, PE_TV = 66560, PE_TI = 75264, PE_SEL = 83968;
constexpr int SC_LD = 129, TL_LD = 17;
#ifndef TAB_FP8
#define TAB_FP8 1
#endif
constexpr size_t WS_TSC = 93 * MiB + 256 * 1024;


__device__ __forceinline__ void tab_convert(ArgsR A, int gw, int NGW, int lane) {
    unsigned char* ws = A.ws; float* tsc = (float*)(ws + WS_TSC);
#pragma unroll 1
    for (int r = gw; r < 2 * DEPTH * NEXP; r += NGW) {
        const int t = r / (DEPTH * NEXP), rr = r % (DEPTH * NEXP);
        const float* src = A.in[t ? I_PV : I_PU] + (size_t)rr * DM;
        f32x4 v[8];
#pragma unroll
        for (int i = 0; i < 8; ++i) v[i] = *(const GAS f32x4*)(src + 4 * (lane + 64 * i));
        unsigned char* dst = ws + (t ? WS_VB : WS_UB) + (size_t)(rr / NEXP) * TAB_L + (size_t)(rr % NEXP) * DM * (TAB_FP8 ? 1 : 2);
#if TAB_FP8
        float am = 0.f;
#pragma unroll
        for (int i = 0; i < 8; ++i) am = fmaxf(fmaxf(am, fmaxf(fabsf(v[i][0]), fabsf(v[i][1]))), fmaxf(fabsf(v[i][2]), fabsf(v[i][3])));
        am = wave_max(am); const float sc = am > 0.f ? 256.0f / am : 1.0f;
#pragma unroll
        for (int i = 0; i < 8; ++i) { int p = 0; p = __builtin_amdgcn_cvt_pk_fp8_f32(v[i][0] * sc, v[i][1] * sc, p, false); p = __builtin_amdgcn_cvt_pk_fp8_f32(v[i][2] * sc, v[i][3] * sc, p, true);
            *(GAS unsigned*)(dst + 4 * (lane + 64 * i)) = (unsigned)p; }
        if (lane == 0) tsc[r] = am > 0.f ? am * (1.0f / 256.0f) : 1.0f;
#else
#pragma unroll
        for (int i = 0; i < 8; ++i) { v2u w; w.x = pk2(v[i][0], v[i][1]); w.y = pk2(v[i][2], v[i][3]); *(GAS v2u*)(dst + 8 * (lane + 64 * i)) = w; }
#endif
    }
}
__device__ __forceinline__ f32x2 cvt8_lo(unsigned dw) { f32x2 r; asm volatile("v_cvt_pk_f32_fp8 %0, %1" : "=v"(r) : "v"(dw)); return r; }
__device__ __forceinline__ f32x2 cvt8_hi(unsigned dw) { f32x2 r; asm volatile("v_cvt_pk_f32_fp8_sdwa %0, %1 src0_sel:WORD_1" : "=v"(r) : "v"(dw)); return r; }
#define TOUCH16(a, o) asm volatile("" : "+v"(a[(o)+0]), "+v"(a[(o)+1]), "+v"(a[(o)+2]), "+v"(a[(o)+3]), "+v"(a[(o)+4]), "+v"(a[(o)+5]), "+v"(a[(o)+6]), "+v"(a[(o)+7]), "+v"(a[(o)+8]), "+v"(a[(o)+9]), "+v"(a[(o)+10]), "+v"(a[(o)+11]), "+v"(a[(o)+12]), "+v"(a[(o)+13]), "+v"(a[(o)+14]), "+v"(a[(o)+15]))
__device__ __forceinline__ float dot2bf(unsigned a, unsigned b, float c) { asm("v_dot2c_f32_bf16 %0, %1, %2" : "+v"(c) : "v"(a), "v"(b)); return c; }
__device__ __forceinline__ unsigned f2sortable(float f) { const unsigned u = __builtin_bit_cast(unsigned, f); return (u & 0x80000000u) ? ~u : (u | 0x80000000u); }

template <bool DRY>
__device__ __forceinline__ void peer_phase(ArgsR A, int l, bool last, LAS unsigned char* lds, int G, int tid) {
    const int wave = __builtin_amdgcn_readfirstlane(tid >> 6), lane = tid & 63;
    unsigned char* ws = A.ws;
    const bf16* Q = (const bf16*)(ws + WS_Q);
    const bf16* K1 = (const bf16*)(ws + WS_K1) + (size_t)l * 8 * 128 * 128; const bf16* K2 = (const bf16*)(ws + WS_K2) + (size_t)l * 8 * 128 * 128;
    const unsigned char* Ub = ws + WS_UB + (size_t)l * TAB_L; const unsigned char* Vb = ws + WS_VB + (size_t)l * TAB_L;
    const float* ssp = (const float*)(ws + WS_SSP); const float* X = A.out; float* XO = DRY ? (float*)(ws + WS_P) : A.out; bf16* xb = (bf16*)(ws + (DRY ? WS_MIX : WS_XB)); float* rstd1 = (float*)(ws + (DRY ? WS_PS : WS_RSTD1));
    const float* g2 = A.in[I_N2G] + l * DM; const float* gf = A.in[I_FNG];
    LAS float* sc = (LAS float*)(lds + PE_SC); LAS float* tv = (LAS float*)(lds + PE_TV); LAS int* ti = (LAS int*)(lds + PE_TI); LAS v2u* sel = (LAS v2u*)(lds + PE_SEL);
#pragma unroll 1
    for (int item = blockIdx.x; item < NT / 32; item += G) {
        const int tok0 = item * 32;
#pragma unroll 1
        for (int pass = 0; pass < 4; ++pass) {
            { const int hh = wave >> 2, side = (wave >> 1) & 1, mt = wave & 1, h = 2 * pass + hh, fr = lane & 15, fq = lane >> 4;
                const bf16* qa = Q + (size_t)(tok0 + 16 * mt + fr) * DM + h * 256 + side * 128 + 8 * fq;
                const bf16* kb = (side ? K2 : K1) + (size_t)h * 128 * 128 + (size_t)fr * 128 + 8 * fq;
                bf16x8 af[4];
#pragma unroll
                for (int ks = 0; ks < 4; ++ks) af[ks] = *(const GAS bf16x8*)(qa + 32 * ks);
#pragma unroll
                for (int nt = 0; nt < 8; ++nt) { f32x4 acc = {0.f, 0.f, 0.f, 0.f};
#pragma unroll
                    for (int ks = 0; ks < 4; ++ks) { const bf16x8 bfr = *(const GAS bf16x8*)(kb + (size_t)nt * 16 * 128 + 32 * ks); acc = __builtin_amdgcn_mfma_f32_16x16x32_bf16(af[ks], bfr, acc, 0, 0, 0); }
                    const int rowb = (hh * 2 + side) * 32 + 16 * mt + 4 * fq;
#pragma unroll
                    for (int r = 0; r < 4; ++r) sc[(rowb + r) * SC_LD + 16 * nt + fr] = acc[r]; } }
            __syncthreads();
            if (tid < 128) { unsigned L[16];
#pragma unroll
                for (int i = 0; i < 16; ++i) L[i] = 0u;
                const LAS float* row = sc + tid * SC_LD;
#pragma unroll 4
                for (int i = 0; i < 128; ++i) { unsigned x = (f2sortable(row[i]) & ~127u) | (unsigned)i;
#pragma unroll
                    for (int s = 0; s < 16; ++s) { const unsigned hi = L[s] > x ? L[s] : x, lo = L[s] > x ? x : L[s]; L[s] = hi; x = lo; } }
#pragma unroll
                for (int s = 0; s < 16; ++s) { const int idx = (int)(L[s] & 127u); tv[tid * TL_LD + s] = row[idx]; ti[tid * TL_LD + s] = idx; } }
            __syncthreads();
            if (tid < 64) { const int hh = tid >> 5, tk = tid & 31, r1 = (hh * 2) * 32 + tk, r2 = (hh * 2 + 1) * 32 + tk, h = 2 * pass + hh;
                float LV[16]; int LI[16];
#pragma unroll
                for (int s = 0; s < 16; ++s) { LV[s] = -3.0e38f; LI[s] = 0; }
#pragma unroll 1
                for (int a = 0; a < 16; ++a) { const float va = tv[r1 * TL_LD + a]; const int ia = ti[r1 * TL_LD + a] * 128; const int nb = 16 / (a + 1);
#pragma unroll 1
                    for (int bb = 0; bb < nb; ++bb) { float x = va + tv[r2 * TL_LD + bb]; int xi = ia + ti[r2 * TL_LD + bb];
#pragma unroll
                        for (int s = 0; s < 16; ++s) { const bool gt = x > LV[s]; const float tvv = gt ? x : LV[s]; const int tii = gt ? xi : LI[s]; x = gt ? LV[s] : x; xi = gt ? LI[s] : xi; LV[s] = tvv; LI[s] = tii; } } }
                float den = 0.f, e[16];
#pragma unroll
                for (int s = 0; s < 16; ++s) { e[s] = __expf(LV[s] - LV[0]); den += e[s]; }
                const float inv = 1.0f / den;
#pragma unroll
                for (int s = 0; s < 16; ++s) { v2u w; w.x = (unsigned)LI[s]; w.y = __builtin_bit_cast(unsigned, e[s] * inv); sel[(tk * 8 + h) * 16 + s] = w; } }
            __syncthreads();
        }
#if TAB_FP8
        const float* tscU = (const float*)(ws + WS_TSC) + (size_t)l * NEXP; const float* tscV = tscU + (size_t)DEPTH * NEXP;
#pragma unroll 1
        for (int tt = 0; tt < 4; ++tt) {
            const int tl = wave * 4 + tt; const size_t t = (size_t)tok0 + tl;
            float s2 = (lane < 32) ? ssp[t * 32 + lane] : 0.f; s2 = wave_sum(s2);
            const float rstd2 = rsqrtf(s2 * (1.0f / DM) + RMS_EPS);
            float h2[32];
#pragma unroll
            for (int j = 0; j < 2; ++j)
#pragma unroll
                for (int q = 0; q < 4; ++q) { const size_t e0 = 16 * (size_t)(lane + 64 * j) + 4 * q;
                    const f32x4 xa = *(const GAS f32x4*)(X + t * DM + e0), ga = *(const GAS f32x4*)(g2 + e0);
#pragma unroll
                    for (int k = 0; k < 4; ++k) h2[j * 16 + q * 4 + k] = xa[k] * rstd2 * ga[k]; }
            float y[32];
#pragma unroll
            for (int i = 0; i < 32; ++i) y[i] = 0.f;
            const unsigned lo16 = (unsigned)lane * 16u;
#pragma unroll 1
            for (int g = 0; g < 16; ++g) {
                int ids[8]; float gts[8];
#pragma unroll
                for (int e = 0; e < 8; ++e) { const v2u w = sel[tl * 128 + g * 8 + e]; ids[e] = __builtin_amdgcn_readfirstlane((int)w.x); gts[e] = __builtin_bit_cast(float, __builtin_amdgcn_readfirstlane((int)w.y)); }
                v4u uu[8][2];
#pragma unroll
                for (int e = 0; e < 8; ++e) { const GAS unsigned char* rb = (const GAS unsigned char*)Ub + (size_t)ids[e] * 2048;
#pragma unroll
                    for (int j = 0; j < 2; ++j) uu[e][j] = *(const GAS v4u*)(rb + lo16 + j * 1024); }
                float cf[8];
#pragma unroll
                for (int e = 0; e < 8; ++e) { float d = 0.f;
#pragma unroll
                    for (int j = 0; j < 2; ++j)
#pragma unroll
                        for (int w = 0; w < 4; ++w) { const unsigned dw = uu[e][j][w]; const f32x2 lo = cvt8_lo(dw), hi = cvt8_hi(dw);
                            d += lo[0] * h2[j * 16 + w * 4 + 0]; d += lo[1] * h2[j * 16 + w * 4 + 1]; d += hi[0] * h2[j * 16 + w * 4 + 2]; d += hi[1] * h2[j * 16 + w * 4 + 3]; }
                    asm volatile("" : "+v"(d));
                    d = wave_sum(d) * tscU[ids[e]]; cf[e] = gts[e] * gelu_tanh(d) * tscV[ids[e]]; }
                asm volatile("" ::: "memory");
                v4u vv[8][2];
#pragma unroll
                for (int e = 0; e < 8; ++e) { const GAS unsigned char* rb = (const GAS unsigned char*)Vb + (size_t)ids[e] * 2048;
#pragma unroll
                    for (int j = 0; j < 2; ++j) vv[e][j] = *(const GAS v4u*)(rb + lo16 + j * 1024); }
#pragma unroll
                for (int e = 0; e < 8; ++e) { const float c = cf[e];
#pragma unroll
                    for (int j = 0; j < 2; ++j)
#pragma unroll
                        for (int w = 0; w < 4; ++w) { const unsigned dw = vv[e][j][w]; const f32x2 lo = cvt8_lo(dw), hi = cvt8_hi(dw);
                            y[j * 16 + w * 4 + 0] += c * lo[0]; y[j * 16 + w * 4 + 1] += c * lo[1]; y[j * 16 + w * 4 + 2] += c * hi[0]; y[j * 16 + w * 4 + 3] += c * hi[1]; }
                    TOUCH16(y, 0); TOUCH16(y, 16); }
            }
            float ss = 0.f;
#pragma unroll
            for (int j = 0; j < 2; ++j)
#pragma unroll
                for (int q = 0; q < 4; ++q) { const size_t e0 = 16 * (size_t)(lane + 64 * j) + 4 * q; const f32x4 xa = *(const GAS f32x4*)(X + t * DM + e0);
#pragma unroll
                    for (int k = 0; k < 4; ++k) { y[j * 16 + q * 4 + k] += xa[k]; ss += y[j * 16 + q * 4 + k] * y[j * 16 + q * 4 + k]; } }
            ss = wave_sum(ss);
            const float rs = rsqrtf(ss * (1.0f / DM) + RMS_EPS);
            if (last) {
#pragma unroll
                for (int j = 0; j < 2; ++j)
#pragma unroll
                    for (int q = 0; q < 4; ++q) { const size_t e0 = 16 * (size_t)(lane + 64 * j) + 4 * q; const f32x4 ga = *(const GAS f32x4*)(gf + e0);
                        f32x4 oa = {y[j * 16 + q * 4 + 0] * rs * ga[0], y[j * 16 + q * 4 + 1] * rs * ga[1], y[j * 16 + q * 4 + 2] * rs * ga[2], y[j * 16 + q * 4 + 3] * rs * ga[3]};
                        *(GAS f32x4*)(XO + t * DM + e0) = oa; }
            } else {
#pragma unroll
                for (int j = 0; j < 2; ++j) {
#pragma unroll
                    for (int q = 0; q < 4; ++q) { const size_t e0 = 16 * (size_t)(lane + 64 * j) + 4 * q;
                        f32x4 oa = {y[j * 16 + q * 4 + 0], y[j * 16 + q * 4 + 1], y[j * 16 + q * 4 + 2], y[j * 16 + q * 4 + 3]}; *(GAS f32x4*)(XO + t * DM + e0) = oa; }
                    const size_t e0 = 16 * (size_t)(lane + 64 * j);
                    v4u w0, w1; w0.x = pk2(y[j * 16 + 0], y[j * 16 + 1]); w0.y = pk2(y[j * 16 + 2], y[j * 16 + 3]); w0.z = pk2(y[j * 16 + 4], y[j * 16 + 5]); w0.w = pk2(y[j * 16 + 6], y[j * 16 + 7]);
                    w1.x = pk2(y[j * 16 + 8], y[j * 16 + 9]); w1.y = pk2(y[j * 16 + 10], y[j * 16 + 11]); w1.z = pk2(y[j * 16 + 12], y[j * 16 + 13]); w1.w = pk2(y[j * 16 + 14], y[j * 16 + 15]);
                    *(GAS v4u*)(xb + t * DM + e0) = w0; *(GAS v4u*)(xb + t * DM + e0 + 8) = w1; }
                if (lane == 0) rstd1[t] = rs;
            }
        }
#else
#pragma unroll 1
        for (int tt = 0; tt < 4; ++tt) {
            const int tl = wave * 4 + tt; const size_t t = (size_t)tok0 + tl;
            float s2 = (lane < 32) ? ssp[t * 32 + lane] : 0.f; s2 = wave_sum(s2);
            const float rstd2 = rsqrtf(s2 * (1.0f / DM) + RMS_EPS);
            v4u hb[4];
#pragma unroll
            for (int j = 0; j < 4; ++j) { const size_t e0 = 8 * (size_t)(lane + 64 * j);
                const f32x4 xa = *(const GAS f32x4*)(X + t * DM + e0), xc = *(const GAS f32x4*)(X + t * DM + e0 + 4);
                const f32x4 ga = *(const GAS f32x4*)(g2 + e0), gc = *(const GAS f32x4*)(g2 + e0 + 4);
                hb[j].x = pk2(xa[0] * rstd2 * ga[0], xa[1] * rstd2 * ga[1]); hb[j].y = pk2(xa[2] * rstd2 * ga[2], xa[3] * rstd2 * ga[3]);
                hb[j].z = pk2(xc[0] * rstd2 * gc[0], xc[1] * rstd2 * gc[1]); hb[j].w = pk2(xc[2] * rstd2 * gc[2], xc[3] * rstd2 * gc[3]); }
            float y[32];
#pragma unroll
            for (int i = 0; i < 32; ++i) y[i] = 0.f;
#pragma unroll 1
            for (int g = 0; g < 32; ++g) {
                int ids[4]; float gts[4];
#pragma unroll
                for (int e = 0; e < 4; ++e) { const v2u w = sel[tl * 128 + g * 4 + e]; ids[e] = __builtin_amdgcn_readfirstlane((int)w.x); gts[e] = __builtin_bit_cast(float, __builtin_amdgcn_readfirstlane((int)w.y)); }
                const unsigned lo16 = (unsigned)lane * 16u;
                v4u uu[4][4];
#pragma unroll
                for (int e = 0; e < 4; ++e) { const GAS unsigned char* rb = (const GAS unsigned char*)Ub + (size_t)ids[e] * 4096;
#pragma unroll
                    for (int j = 0; j < 4; ++j) uu[e][j] = *(const GAS v4u*)(rb + lo16 + j * 1024); }
                float cf[4];
#pragma unroll
                for (int e = 0; e < 4; ++e) { float d = 0.f;
#pragma unroll
                    for (int j = 0; j < 4; ++j) {
                        d = dot2bf(uu[e][j].x, hb[j].x, d);
                        d = dot2bf(uu[e][j].y, hb[j].y, d);
                        d = dot2bf(uu[e][j].z, hb[j].z, d);
                        d = dot2bf(uu[e][j].w, hb[j].w, d); }
                    d = wave_sum(d); cf[e] = gts[e] * gelu_tanh(d); }
                v4u vv[4][4];
#pragma unroll
                for (int e = 0; e < 4; ++e) { const GAS unsigned char* rb = (const GAS unsigned char*)Vb + (size_t)ids[e] * 4096;
#pragma unroll
                    for (int j = 0; j < 4; ++j) vv[e][j] = *(const GAS v4u*)(rb + lo16 + j * 1024); }
#pragma unroll
                for (int e = 0; e < 4; ++e)
#pragma unroll
                    for (int j = 0; j < 4; ++j) { const v4u w = vv[e][j]; const float c = cf[e];
                        y[j * 8 + 0] += c * bflo(w.x); y[j * 8 + 1] += c * bfhi(w.x); y[j * 8 + 2] += c * bflo(w.y); y[j * 8 + 3] += c * bfhi(w.y);
                        y[j * 8 + 4] += c * bflo(w.z); y[j * 8 + 5] += c * bfhi(w.z); y[j * 8 + 6] += c * bflo(w.w); y[j * 8 + 7] += c * bfhi(w.w); }
            }
            float ss = 0.f;
#pragma unroll
            for (int j = 0; j < 4; ++j) { const size_t e0 = 8 * (size_t)(lane + 64 * j);
                const f32x4 xa = *(const GAS f32x4*)(X + t * DM + e0), xc = *(const GAS f32x4*)(X + t * DM + e0 + 4);
#pragma unroll
                for (int k = 0; k < 4; ++k) { y[j * 8 + k] += xa[k]; y[j * 8 + 4 + k] += xc[k]; }
#pragma unroll
                for (int k = 0; k < 8; ++k) ss += y[j * 8 + k] * y[j * 8 + k]; }
            ss = wave_sum(ss);
            const float rs = rsqrtf(ss * (1.0f / DM) + RMS_EPS);
            if (last) {
#pragma unroll
                for (int j = 0; j < 4; ++j) { const size_t e0 = 8 * (size_t)(lane + 64 * j);
                    const f32x4 ga = *(const GAS f32x4*)(gf + e0), gc = *(const GAS f32x4*)(gf + e0 + 4);
                    f32x4 oa = {y[j * 8 + 0] * rs * ga[0], y[j * 8 + 1] * rs * ga[1], y[j * 8 + 2] * rs * ga[2], y[j * 8 + 3] * rs * ga[3]};
                    f32x4 oc = {y[j * 8 + 4] * rs * gc[0], y[j * 8 + 5] * rs * gc[1], y[j * 8 + 6] * rs * gc[2], y[j * 8 + 7] * rs * gc[3]};
                    *(GAS f32x4*)(XO + t * DM + e0) = oa; *(GAS f32x4*)(XO + t * DM + e0 + 4) = oc; }
            } else {
#pragma unroll
                for (int j = 0; j < 4; ++j) { const size_t e0 = 8 * (size_t)(lane + 64 * j);
                    f32x4 oa = {y[j * 8 + 0], y[j * 8 + 1], y[j * 8 + 2], y[j * 8 + 3]}, oc = {y[j * 8 + 4], y[j * 8 + 5], y[j * 8 + 6], y[j * 8 + 7]};
                    *(GAS f32x4*)(XO + t * DM + e0) = oa; *(GAS f32x4*)(XO + t * DM + e0 + 4) = oc;
                    v4u w; w.x = pk2(oa[0], oa[1]); w.y = pk2(oa[2], oa[3]); w.z = pk2(oc[0], oc[1]); w.w = pk2(oc[2], oc[3]);
                    *(GAS v4u*)(xb + t * DM + e0) = w; }
                if (lane == 0) rstd1[t] = rs;
            }
        }
#endif
        __syncthreads();
    }
}

#ifndef FAST_MASK
#define FAST_MASK 15
#endif
__device__ __forceinline__ void mix_p2(ArgsR A, int l, LAS unsigned char* lds, int G, int tid) {
    const int bx = blockIdx.x;
    if (FAST_MASK & 2) for (int it = bx; it < 512; it += G) f_gla_p2(A, l, it, lds, pg8::fresh_tid());
    if (FAST_MASK & 4) for (int it = bx; it < 512; it += G) f_ml_p2(A, l, it, lds, pg8::fresh_tid());
    if (FAST_MASK & 8) for (int it = bx; it < 512; it += G) f_gdn_p2(A, l, it, lds, pg8::fresh_tid());
    if (FAST_MASK & 1) for (int it = bx; it < 1024; it += G) f_lru_p2(A, l, it, lds, pg8::fresh_tid());
    if ((FAST_MASK & 15) != 15) {
        for (int it = bx; it < 80; it += G) {
            if (it < 16) { if (!(FAST_MASK & 2)) nm_gla(A, l, it >> 2, it & 3, lds, pg8::fresh_tid()); }
            else if (it < 32) { if (!(FAST_MASK & 4)) nm_mlstm(A, l, (it - 16) >> 2, (it - 16) & 3, lds, pg8::fresh_tid()); }
            else if (it < 48) { if (!(FAST_MASK & 8)) nm_gdn(A, l, (it - 32) >> 2, (it - 32) & 3, lds, pg8::fresh_tid()); }
            else { if (!(FAST_MASK & 1)) nm_lru(A, l, (it - 48) >> 3, (it - 48) & 7, lds, pg8::fresh_tid()); }
            __syncthreads();
        }
    }
}
__device__ __forceinline__ void mix_p3(ArgsR A, int l, LAS unsigned char* lds, int G, int tid) {
    const int bx = blockIdx.x;
    int first = 0, nb = G;
    if ((FAST_MASK & 8) && G > 32) { if (bx < 16) { f_gdn_p3(A, bx, lds, pg8::fresh_tid()); return; } first = 16; nb = G - 16; }
    else if (FAST_MASK & 8) { for (int it = bx; it < 16; it += G) f_gdn_p3(A, it, lds, pg8::fresh_tid()); }
    for (int it = bx - first; it < 516; it += nb) {
        if (it < 256) { if (FAST_MASK & 2) f_gla_p3(A, it, pg8::fresh_tid()); }
        else if (it < 512) { if (FAST_MASK & 4) f_ml_p3(A, it - 256, pg8::fresh_tid()); }
        else { if (FAST_MASK & 1) f_lru_p3(A, it - 512, pg8::fresh_tid()); }
    }
    if (l == 0) { const int t2 = pg8::fresh_tid(); tab_convert(A, (bx - first) * NWAVES + __builtin_amdgcn_readfirstlane(t2 >> 6), nb * NWAVES, t2 & 63); }
}
__device__ __forceinline__ void mix_p4(ArgsR A, int l, LAS unsigned char* lds, int G, int tid) {
    const int bx = blockIdx.x;
    if (FAST_MASK & 2) for (int it = bx; it < 512; it += G) f_gla_p4(A, l, it, lds, pg8::fresh_tid());
    if (FAST_MASK & 4) for (int it = bx; it < 512; it += G) f_ml_p4(A, l, it, lds, pg8::fresh_tid());
    for (int it = bx; it < 256; it += G) {
        if (it < 128) { if (FAST_MASK & 8) f_gdn_p4(A, l, it, pg8::fresh_tid()); }
        else { if (FAST_MASK & 1) f_lru_p4(A, it - 128, pg8::fresh_tid()); }
    }
}

#ifndef PROBE_PHASE
#define PROBE_PHASE -1
#endif
#ifndef MK_PER_PHASE
#define MK_PER_PHASE 0
#endif
constexpr int PPL = 7, NPHASE = 1 + PPL * DEPTH;
constexpr int CW_BAR = 4096;

__global__ void __launch_bounds__(NTHREADS, 2) mk_fwd(Args args) {
    extern __shared__ __attribute__((aligned(16))) unsigned char lds_raw[];
    LAS unsigned char* lds = (LAS unsigned char*)lds_raw;
    volatile LAS unsigned* MISC = (volatile LAS unsigned*)(lds + MISC_OFF);
    const int tid = threadIdx.x, lane = tid & 63, wave = __builtin_amdgcn_readfirstlane(tid >> 6);
    const int G = gridDim.x; const int bx = blockIdx.x; const int vcu = (G % 8 == 0) ? (bx % 8) * (G / 8) + bx / 8 : bx;
    unsigned char* ws = args.ws;
    if (tid < 64) MISC[tid] = 0u;
    __syncthreads();
    XcdBarrier bar; bar.bar = (unsigned*)(ws + WS_CTL) + CW_BAR; bar.x = 0; bar.st = nullptr;
    if (!MK_PER_PHASE) bar = xcd_barrier_post((unsigned*)(ws + WS_CTL) + CW_BAR, MISC + 8);
    const int lo = args.ph_lo, hi = args.ph_hi;
#define IN(k) (lo <= (k) && (k) < hi)
#define SEAM(k) do { if (IN(k) && IN((k) + 1)) xcd_barrier(bar); } while (0)
#define REP(kind) for (int rep = (PROBE_PHASE == (kind)) ? 0 : 1; rep < 2; ++rep)
#define REPBAR() do { if (rep == 0) xcd_barrier(bar); } while (0)

    if (IN(0)) { REP(0) { const int t0 = pg8::fresh_tid(); p0_prologue(*kargs(), lds, vcu, G, __builtin_amdgcn_readfirstlane(t0 >> 6), t0 & 63); REPBAR(); } SEAM(0); }
#pragma unroll 1
    for (int l = 0; l < DEPTH; ++l) {
        const int pb = 1 + PPL * l;
        if (IN(pb)) {
            pg8::Gemm g{(const pg8::bf16_t*)(ws + WS_XB), (const pg8::bf16_t*)(ws + WS_WIN + l * WIN_L), NT, NINP, DM}; pg8::StaticOrder S; S.init(NT, NINP, G, bx);
            pg8::EpiP E{(pg8::bf16_t*)(ws + WS_P), (float*)(ws + WS_PS), (const float*)(ws + WS_RSTD1)};
            REP(1) { pg8::gemm_phase<pg8::EpiP, pg8::StaticOrder, true, true>(lds, g, S, E); REPBAR(); }
            SEAM(pb);
        }
        if (IN(pb + 1)) { REP(2) { mix_p2(*kargs(), l, lds, G, pg8::fresh_tid()); REPBAR(); } SEAM(pb + 1); }
        if (IN(pb + 2)) { REP(3) { mix_p3(*kargs(), l, lds, G, pg8::fresh_tid()); REPBAR(); } SEAM(pb + 2); }
        if (IN(pb + 3)) { REP(4) { mix_p4(*kargs(), l, lds, G, pg8::fresh_tid()); REPBAR(); } SEAM(pb + 3); }
        if (IN(pb + 4)) {
            pg8::Gemm g{(const pg8::bf16_t*)(ws + WS_MIX), (const pg8::bf16_t*)(ws + WS_WOUT + l * WSQ_L), NT, DM, DM}; pg8::StaticOrder S; S.init(NT, DM, G, bx);
            REP(5) { const bool dry = (rep == 0);
                pg8::EpiX E{l == 0 ? args.in[I_X] : (const float*)args.out, dry ? (float*)(ws + WS_P) : args.out, (pg8::bf16_t*)(ws + (dry ? WS_Q : WS_XB)), (float*)(ws + (dry ? WS_PS : WS_SSP))};
                pg8::gemm_phase<pg8::EpiX, pg8::StaticOrder, true, true>(lds, g, S, E); REPBAR(); }
            SEAM(pb + 4);
        }
        if (IN(pb + 5)) {
            pg8::Gemm g{(const pg8::bf16_t*)(ws + WS_XB), (const pg8::bf16_t*)(ws + WS_WQ + l * WSQ_L), NT, DM, DM}; pg8::StaticOrder S; S.init(NT, DM, G, bx);
            pg8::EpiQ E{(pg8::bf16_t*)(ws + WS_Q), (const float*)(ws + WS_SSP)};
            REP(6) { pg8::gemm_phase<pg8::EpiQ, pg8::StaticOrder, true, true>(lds, g, S, E); REPBAR(); }
            SEAM(pb + 5);
        }
        if (IN(pb + 6)) { if (PROBE_PHASE == 7) { peer_phase<true>(*kargs(), l, l == DEPTH - 1, lds, G, pg8::fresh_tid()); xcd_barrier(bar); }
            peer_phase<false>(*kargs(), l, l == DEPTH - 1, lds, G, pg8::fresh_tid()); SEAM(pb + 6); }
    }
#undef IN
#undef SEAM
}

extern "C" void kernel_launch(void* const* d_in, const int* in_sizes, int n_in, void* d_out, int out_size, void* d_ws, size_t ws_size, hipStream_t stream) {
    static int grid = 0;
    if (grid == 0) {
        if (n_in != N_IN || out_size != NT * DM || ws_size < WS_END) { fprintf(stderr, "kernel_launch: unexpected shapes: n_in %d out %d ws %zu (need %zu)\n", n_in, out_size, ws_size, (size_t)WS_END); grid = -1; return; }
        int dev = 0, cus = 0, per_cu = 0;
        if (hipGetDevice(&dev) != hipSuccess || hipDeviceGetAttribute(&cus, hipDeviceAttributeMultiprocessorCount, dev) != hipSuccess) { grid = -1; return; }
        if (hipFuncSetAttribute((const void*)mk_fwd, hipFuncAttributeMaxDynamicSharedMemorySize, LDS_BYTES) != hipSuccess) { fprintf(stderr, "kernel_launch: hipFuncSetAttribute failed\n"); grid = -1; return; }
        if (hipOccupancyMaxActiveBlocksPerMultiprocessor(&per_cu, (const void*)mk_fwd, NTHREADS, LDS_BYTES) != hipSuccess || per_cu < 1) { fprintf(stderr, "kernel_launch: occupancy query says %d blocks per CU\n", per_cu); (void)hipGetLastError(); grid = -1; return; }
        grid = cus;
    }
    if (grid < 0) return;
    if (hipMemsetAsync((char*)d_ws + WS_CTL, 0, CTL_ZERO_BYTES, stream) != hipSuccess) return;
    Args a{};
    for (int i = 0; i < N_IN; ++i) a.in[i] = (const float*)d_in[i];
    a.out = (float*)d_out; a.ws = (unsigned char*)d_ws;
#if MK_PER_PHASE
    for (int p = 0; p < NPHASE; ++p) { a.ph_lo = p; a.ph_hi = p + 1; a.li = 0; hipLaunchKernelGGL(mk_fwd, dim3(grid), dim3(NTHREADS), LDS_BYTES, stream, a); }
#else
    a.ph_lo = 0; a.ph_hi = NPHASE; a.li = 0;
    hipLaunchKernelGGL(mk_fwd, dim3(grid), dim3(NTHREADS), LDS_BYTES, stream, a);
#endif
}
```

```cpp
#include <hip/hip_runtime.h>
#include <cstdio>
#include <cstdint>
#define TAB_FP8 1
namespace pg8 {
__device__ __forceinline__ int fresh_tid() { int t = threadIdx.x; asm volatile("" : "+v"(t)); return t; }
#define PG8_LAS __attribute__((address_space(3)))
typedef unsigned short bf16_t;
typedef short bf16x8 __attribute__((ext_vector_type(8)));
typedef float f32x4 __attribute__((ext_vector_type(4)));
typedef unsigned u32x4 __attribute__((ext_vector_type(4)));
constexpr int BM = 256, BK = 64, HALF = 128, HTB = HALF * BK * 2  , STAGE_BYTES = 8 * HTB, NXCD = 8, WGM = 8;

__host__ __device__ __forceinline__ int lds_byte(int r, int c) { const int st = (r >> 4) * 2 + (c >> 5), rr = r & 15, cc = c & 31, ob = rr * 64 + cc * 2; return st * 1024 + (ob ^ (((ob >> 9) & 1) << 5)); }
__host__ __device__ __forceinline__ void stage_rc(int b, int& R, int& C) { const int st = b / 1024, sb = b % 1024, swz = sb ^ (((sb >> 9) & 1) << 5); R = (st >> 1) * 16 + swz / 64; C = (st & 1) * 32 + (swz % 64) / 2; }
__host__ __device__ __forceinline__ int perm32(int rho) { const int n = rho >> 4, i = rho & 15; return 8 * (i >> 2) + 4 * n + (i & 3); }

struct Unit { int pm, pn; };
struct Gemm { const bf16_t* A; const bf16_t* Bt; int M, N, K; };

struct StaticOrder {
    int nM, nN, nwg, G, c;
    __host__ __device__ void init(int M, int N, int G_, int c_) { nM = M / BM; nN = N / BM; nwg = nM * nN; G = G_; c = c_; }
    __host__ __device__ bool next(int i, Unit& u) const {
        const long L = (long)i * G + c; if (L >= nwg) return false;
        int wgid = (int)L; { const int q = nwg / NXCD, r = nwg % NXCD, xcd = wgid % NXCD, off = wgid / NXCD; wgid = (xcd < r ? xcd * (q + 1) : r * (q + 1) + (xcd - r) * q) + off; }
        const int nig = WGM * nN, gid = wgid / nig, fm = gid * WGM, gsz = (nM - fm) < WGM ? (nM - fm) : WGM;
        u.pm = fm + ((wgid % nig) % gsz); u.pn = (wgid % nig) / gsz; return true;
    }
    __device__ __forceinline__ void a_ready(const Unit&) const {}
    __device__ __forceinline__ void done(const Unit&) const {}
};


__device__ __forceinline__ unsigned cvt_pk_bf16(float lo, float hi) { unsigned r; asm volatile("v_cvt_pk_bf16_f32 %0, %1, %2" : "=v"(r) : "v"(lo), "v"(hi)); return r; }

struct EpiP {
    static constexpr bool PERM = true, AFTER_DRAIN = false;
    bf16_t* P; float* Ps; const float* rstd;
    __device__ __forceinline__ void operator()(const f32x4 (&acc)[2][2][4][2], const Unit& u, int wr, int wc, int fr, int fq) const {
        const int row0 = u.pm * BM + wr * 64 + fr;
        if (u.pn < 28) {
            const int col0 = u.pn * BM + wc * 32 + 8 * fq;
#pragma unroll
            for (int ai = 0; ai < 2; ++ai)
#pragma unroll
                for (int m = 0; m < 4; ++m) { const int row = row0 + ai * HALF + m * 16; const float r = rstd[row]; bf16_t* rowp = P + (size_t)row * 7168 + col0;
#pragma unroll
                    for (int bj = 0; bj < 2; ++bj) { const f32x4 v0 = acc[ai][bj][m][0] * r, v1 = acc[ai][bj][m][1] * r;
                        u32x4 w; w.x = cvt_pk_bf16(v0[0], v0[1]); w.y = cvt_pk_bf16(v0[2], v0[3]); w.z = cvt_pk_bf16(v1[0], v1[1]); w.w = cvt_pk_bf16(v1[2], v1[3]);
                        *(u32x4*)(rowp + bj * HALF) = w; } }
        } else if (wc == 0) {
#pragma unroll
            for (int ai = 0; ai < 2; ++ai)
#pragma unroll
                for (int m = 0; m < 4; ++m) { const int row = row0 + ai * HALF + m * 16; const float r = rstd[row]; float* p = Ps + (size_t)row * 32 + 8 * fq;
                    *(f32x4*)p = acc[ai][0][m][0] * r; *(f32x4*)(p + 4) = acc[ai][0][m][1] * r; }
        }
    }
};
struct EpiX {
    static constexpr bool PERM = true, AFTER_DRAIN = false;
    const float* xres; float* xout; bf16_t* xb; float* ssp;
    __device__ __forceinline__ void operator()(const f32x4 (&acc)[2][2][4][2], const Unit& u, int wr, int wc, int fr, int fq) const {
        const int row0 = u.pm * BM + wr * 64 + fr, col0 = u.pn * BM + wc * 32 + 8 * fq;
#pragma unroll
        for (int ai = 0; ai < 2; ++ai)
#pragma unroll
            for (int m = 0; m < 4; ++m) { const int row = row0 + ai * HALF + m * 16; float ss = 0.f;
#pragma unroll
                for (int bj = 0; bj < 2; ++bj) { const size_t off = (size_t)row * 2048 + col0 + bj * HALF;
                    const f32x4 r0 = *(const f32x4*)(xres + off), r1 = *(const f32x4*)(xres + off + 4);
                    const f32x4 v0 = acc[ai][bj][m][0] + r0, v1 = acc[ai][bj][m][1] + r1;
                    *(f32x4*)(xout + off) = v0; *(f32x4*)(xout + off + 4) = v1;
                    u32x4 w; w.x = cvt_pk_bf16(v0[0], v0[1]); w.y = cvt_pk_bf16(v0[2], v0[3]); w.z = cvt_pk_bf16(v1[0], v1[1]); w.w = cvt_pk_bf16(v1[2], v1[3]);
                    *(u32x4*)(xb + off) = w;
                    ss += (v0[0] * v0[0] + v0[1] * v0[1]) + (v0[2] * v0[2] + v0[3] * v0[3]) + (v1[0] * v1[0] + v1[1] * v1[1]) + (v1[2] * v1[2] + v1[3] * v1[3]); }
                ss += __shfl_xor(ss, 16); ss += __shfl_xor(ss, 32);
                if (fq == 0) ssp[(size_t)row * 32 + u.pn * 4 + wc] = ss; }
    }
};
struct EpiQ {
    static constexpr bool PERM = true, AFTER_DRAIN = false;
    bf16_t* Q; const float* ssp;
    __device__ __forceinline__ void operator()(const f32x4 (&acc)[2][2][4][2], const Unit& u, int wr, int wc, int fr, int fq) const {
        const int row0 = u.pm * BM + wr * 64 + fr, col0 = u.pn * BM + wc * 32 + 8 * fq;
#pragma unroll
        for (int ai = 0; ai < 2; ++ai)
#pragma unroll
            for (int m = 0; m < 4; ++m) { const int row = row0 + ai * HALF + m * 16;
                const f32x4* sp = (const f32x4*)(ssp + (size_t)row * 32 + 8 * fq); const f32x4 a = sp[0], b = sp[1];
                float s = ((a[0] + a[1]) + (a[2] + a[3])) + ((b[0] + b[1]) + (b[2] + b[3]));
                s += __shfl_xor(s, 16); s += __shfl_xor(s, 32);
                const float r = rsqrtf(s * (1.0f / 2048.0f) + 1e-6f); bf16_t* rowp = Q + (size_t)row * 2048 + col0;
#pragma unroll
                for (int bj = 0; bj < 2; ++bj) { const f32x4 v0 = acc[ai][bj][m][0] * r, v1 = acc[ai][bj][m][1] * r;
                    u32x4 w; w.x = cvt_pk_bf16(v0[0], v0[1]); w.y = cvt_pk_bf16(v0[2], v0[3]); w.z = cvt_pk_bf16(v1[0], v1[1]); w.w = cvt_pk_bf16(v1[2], v1[3]);
                    *(u32x4*)(rowp + bj * HALF) = w; } }
    }
};

template <class Epi, class Sched, bool ALIGN_EPI = false, bool SP2 = false>
__device__ __forceinline__ void gemm_phase(PG8_LAS unsigned char* lds, const Gemm g, const Sched& S, const Epi& E) {
    const int tid = fresh_tid(), wid = __builtin_amdgcn_readfirstlane(tid >> 6), lane = tid & 63, wr = wid >> 2, wc = wid & 3, fr = lane & 15, fq = lane >> 4;
    const int K = g.K, nt = K / BK;
    unsigned voffA[2], voffB[2];
#pragma unroll
    for (int i = 0; i < 2; ++i) { int R, C; stage_rc(tid * 16 + i * 8192, R, C); const int Rb = Epi::PERM ? ((R & ~31) + perm32(R & 31)) : R;
        voffA[i] = (unsigned)(R * K + C) * 2u; voffB[i] = (unsigned)(Rb * K + C) * 2u; }
    const size_t kstep = (size_t)(BK * 2);
    const size_t hstep = (size_t)HALF * K * 2;
    const size_t tstep = 2 * hstep;
    const unsigned ldsw = (unsigned)wid * 1024u;
    const int aoff = lds_byte(wr * 64 + fr, fq * 8), boff = lds_byte(wc * 32 + fr, fq * 8);
#define PG8_SA(b, h) (((b) * 2 + (h)) * HTB)
#define PG8_SB(b, h) ((4 + (b) * 2 + (h)) * HTB)
#define PG8_STAGE(bufoff, gbase, voff) do { _Pragma("unroll") for (int _i = 0; _i < 2; ++_i) \
        __builtin_amdgcn_global_load_lds((const unsigned*)((const char*)(gbase) + (voff)[_i]), (PG8_LAS unsigned*)(lds + (bufoff) + ldsw + _i * 8192), 16, 0, 0); } while (0)
#define PG8_LDA(dst, b, h) do { _Pragma("unroll") for (int m = 0; m < 4; ++m) _Pragma("unroll") for (int k = 0; k < 2; ++k) dst[m][k] = *(const PG8_LAS bf16x8*)(lds + PG8_SA(b, h) + aoff + m * 2048 + k * 1024); } while (0)
#define PG8_LDB(dst, b, h) do { _Pragma("unroll") for (int n = 0; n < 2; ++n) _Pragma("unroll") for (int k = 0; k < 2; ++k) dst[n][k] = *(const PG8_LAS bf16x8*)(lds + PG8_SB(b, h) + boff + n * 2048 + k * 1024); } while (0)
#define PG8_MMA(ai, bj, At, Bt) do { __builtin_amdgcn_s_setprio(1); _Pragma("unroll") for (int m = 0; m < 4; ++m) _Pragma("unroll") for (int n = 0; n < 2; ++n) _Pragma("unroll") for (int k = 0; k < 2; ++k) \
        acc[ai][bj][m][n] = __builtin_amdgcn_mfma_f32_16x16x32_bf16(Bt[n][k], At[m][k], acc[ai][bj][m][n], 0, 0, 0); __builtin_amdgcn_s_setprio(0); } while (0)
#define PG8_WAIT_V(n) asm volatile("s_waitcnt vmcnt(" #n ")" ::: "memory")
#define PG8_WAIT_L(n) asm volatile("s_waitcnt lgkmcnt(" #n ")" ::: "memory")
#define PG8_BAR __builtin_amdgcn_s_barrier()
#define PG8_SCHED __builtin_amdgcn_sched_barrier(0)
    Unit cur, nxt; int ui = 0;
    if (!S.next(0, cur)) return;
    f32x4 acc[2][2][4][2];
#pragma unroll
    for (int a = 0; a < 2; ++a)
#pragma unroll
        for (int b = 0; b < 2; ++b)
#pragma unroll
            for (int m = 0; m < 4; ++m)
#pragma unroll
                for (int n = 0; n < 2; ++n) acc[a][b][m][n] = (f32x4){0.f, 0.f, 0.f, 0.f};
    bf16x8 At[4][2], B0[2][2], B1[2][2];
    const char* cA = (const char*)g.A + (size_t)cur.pm * tstep; const char* cB = (const char*)g.Bt + (size_t)cur.pn * tstep;
    S.a_ready(cur);
    if constexpr (SP2) {
        PG8_STAGE(PG8_SB(0, 0), cB, voffB); PG8_STAGE(PG8_SB(0, 1), cB + hstep, voffB); PG8_STAGE(PG8_SA(0, 0), cA, voffA); PG8_STAGE(PG8_SA(0, 1), cA + hstep, voffA);
        if (wr == 1) PG8_BAR;
        PG8_WAIT_V(2); PG8_BAR;
        PG8_STAGE(PG8_SB(1, 0), cB + kstep, voffB); PG8_STAGE(PG8_SA(1, 0), cA + kstep, voffA); PG8_STAGE(PG8_SB(1, 1), cB + hstep + kstep, voffB);
        PG8_WAIT_V(6); PG8_BAR;
    } else {
        PG8_STAGE(PG8_SB(0, 0), cB, voffB); PG8_STAGE(PG8_SA(0, 0), cA, voffA); PG8_STAGE(PG8_SB(0, 1), cB + hstep, voffB); PG8_STAGE(PG8_SA(0, 1), cA + hstep, voffA);
        if (wr == 1) PG8_BAR;
        PG8_WAIT_V(4); PG8_BAR;
        PG8_STAGE(PG8_SB(1, 0), cB + kstep, voffB); PG8_STAGE(PG8_SA(1, 0), cA + kstep, voffA); PG8_STAGE(PG8_SB(1, 1), cB + hstep + kstep, voffB);
        PG8_WAIT_V(6); PG8_BAR;
    }
    for (;;) {
        const bool has_next = S.next(ui + 1, nxt);
        const char* nA = has_next ? (const char*)g.A + (size_t)nxt.pm * tstep : cA; const char* nB = has_next ? (const char*)g.Bt + (size_t)nxt.pn * tstep : cB;
        for (int t = 0; t < nt; t += 2) {
            const bool last = (t == nt - 2);
            const char* a1 = cA + (size_t)(t + 1) * kstep;
            const char* a2 = last ? nA : cA + (size_t)(t + 2) * kstep; const char* b2 = last ? nB : cB + (size_t)(t + 2) * kstep;
            const char* a3 = a2 + kstep; const char* b3 = b2 + kstep;
            if (last && has_next) S.a_ready(nxt);
            if constexpr (SP2) {
            PG8_LDB(B0, 0, 0); PG8_LDB(B1, 0, 1); PG8_SCHED; PG8_LDA(At, 0, 0); PG8_STAGE(PG8_SA(1, 1), a1 + hstep, voffA);
            PG8_WAIT_V(8); PG8_WAIT_L(0); PG8_BAR; PG8_MMA(0, 0, At, B0); PG8_MMA(0, 1, At, B1); PG8_BAR; PG8_SCHED;
            PG8_LDA(At, 0, 1); PG8_STAGE(PG8_SB(0, 0), b2, voffB); PG8_STAGE(PG8_SB(0, 1), b2 + hstep, voffB); PG8_STAGE(PG8_SA(0, 0), a2, voffA);
            PG8_WAIT_V(8); PG8_WAIT_L(0); PG8_BAR; PG8_MMA(1, 0, At, B0); PG8_MMA(1, 1, At, B1); PG8_BAR; PG8_SCHED;
            PG8_LDB(B0, 1, 0); PG8_LDB(B1, 1, 1); PG8_SCHED; PG8_LDA(At, 1, 0); PG8_STAGE(PG8_SA(0, 1), a2 + hstep, voffA);
            PG8_WAIT_V(8); PG8_WAIT_L(0); PG8_BAR; PG8_MMA(0, 0, At, B0); PG8_MMA(0, 1, At, B1); PG8_BAR; PG8_SCHED;
            PG8_LDA(At, 1, 1); PG8_STAGE(PG8_SB(1, 0), b3, voffB); PG8_STAGE(PG8_SB(1, 1), b3 + hstep, voffB); PG8_STAGE(PG8_SA(1, 0), a3, voffA);
            PG8_WAIT_V(8); PG8_WAIT_L(0); PG8_BAR; PG8_MMA(1, 0, At, B0); PG8_MMA(1, 1, At, B1); PG8_BAR; PG8_SCHED;
            } else {
            PG8_LDB(B0, 0, 0); PG8_SCHED; PG8_LDA(At, 0, 0); PG8_STAGE(PG8_SA(1, 1), a1 + hstep, voffA);
            PG8_WAIT_L(8); PG8_BAR; PG8_WAIT_L(0); PG8_MMA(0, 0, At, B0); PG8_BAR; PG8_SCHED;
            PG8_LDB(B1, 0, 1); PG8_STAGE(PG8_SB(0, 0), b2, voffB);
            PG8_BAR; PG8_WAIT_L(0); PG8_MMA(0, 1, At, B1); PG8_BAR;
            PG8_LDA(At, 0, 1); PG8_STAGE(PG8_SA(0, 0), a2, voffA);
            PG8_BAR; PG8_WAIT_L(0); PG8_MMA(1, 0, At, B0); PG8_BAR; PG8_SCHED;
            PG8_STAGE(PG8_SB(0, 1), b2 + hstep, voffB);
            PG8_WAIT_V(6); PG8_BAR; PG8_MMA(1, 1, At, B1); PG8_BAR;
            PG8_LDB(B0, 1, 0); PG8_SCHED; PG8_LDA(At, 1, 0); PG8_STAGE(PG8_SA(0, 1), a2 + hstep, voffA);
            PG8_WAIT_L(8); PG8_BAR; PG8_WAIT_L(0); PG8_MMA(0, 0, At, B0); PG8_BAR; PG8_SCHED;
            PG8_LDB(B1, 1, 1); PG8_STAGE(PG8_SB(1, 0), b3, voffB);
            PG8_BAR; PG8_WAIT_L(0); PG8_MMA(0, 1, At, B1); PG8_BAR;
            PG8_LDA(At, 1, 1); PG8_STAGE(PG8_SA(1, 0), a3, voffA);
            PG8_BAR; PG8_WAIT_L(0); PG8_MMA(1, 0, At, B0); PG8_BAR; PG8_SCHED;
            PG8_STAGE(PG8_SB(1, 1), b3 + hstep, voffB);
            PG8_WAIT_V(6); PG8_BAR; PG8_MMA(1, 1, At, B1); PG8_BAR;
            }
        }
        if constexpr (ALIGN_EPI) { if (wr == 0) PG8_BAR; }
        if constexpr (!Epi::AFTER_DRAIN) { E(acc, cur, wr, wc, fr, fq); S.done(cur); }
        if (!has_next) break;
#pragma unroll
        for (int a = 0; a < 2; ++a)
#pragma unroll
            for (int b = 0; b < 2; ++b)
#pragma unroll
                for (int m = 0; m < 4; ++m)
#pragma unroll
                    for (int n = 0; n < 2; ++n) acc[a][b][m][n] = (f32x4){0.f, 0.f, 0.f, 0.f};
        cur = nxt; cA = nA; cB = nB; ++ui;
        if constexpr (ALIGN_EPI) { if (wr == 1) PG8_BAR; }
    }
    PG8_WAIT_V(0);
    if constexpr (!ALIGN_EPI) { if (wr == 0) PG8_BAR; }
    PG8_BAR;
    if constexpr (Epi::AFTER_DRAIN) { E.fused(acc, cur, wr, wc, fr, fq, lds, wid, lane); S.done(cur); }
#undef PG8_SA
#undef PG8_SB
#undef PG8_STAGE
#undef PG8_LDA
#undef PG8_LDB
#undef PG8_MMA
#undef PG8_WAIT_V
#undef PG8_WAIT_L
#undef PG8_BAR
#undef PG8_SCHED
}
}

constexpr int NWAVES = 8, NTHREADS = 512;
constexpr int NT = 8192, DM = 2048, SEQ = 2048, NBATCH = 4, DEPTH = 2, CHK = 64, NCHK = 32, GW = 512, NH = 4, HD = 128;
constexpr int DIN = 7200, NINP = 7424, PBW = 7168;
constexpr int NEXP = 16384;
constexpr int PC_GLA_Q = 0, PC_GLA_K = 512, PC_GLA_V = 1024, PC_GLA_G = 1536, PC_LRU_X = 2048, PC_LRU_Y = 2560, PC_ML_Q = 3072, PC_ML_K = 3584, PC_ML_V = 4096, PC_ML_O = 4608,
              PC_GDN_Q = 5120, PC_GDN_K = 5632, PC_GDN_V = 6144, PC_GDN_G = 6656;
constexpr int PS_LR = 0, PS_MI = 16, PS_MF = 20, PS_GB = 24, PS_GA = 28;
constexpr float RMS_EPS = 1e-6f;
enum { I_X = 0, I_N1G, I_WIN, I_WOUT, I_GLA_W2, I_GLA_B2, I_GLA_NG, I_LRU_CW, I_LRU_CB, I_LRU_WA, I_LRU_BA, I_LRU_WX, I_LRU_BX, I_LRU_LAM, I_ML_IB, I_ML_FB, I_ML_NG,
       I_GDN_CW, I_GDN_ALOG, I_GDN_DTB, I_GDN_NG, I_N2G, I_PWQ, I_PK1, I_PK2, I_PU, I_PV, I_FNG, N_IN };

constexpr size_t MiB = 1u << 20;
constexpr size_t WS_CTL = 0, CTL_ZERO_BYTES = 1 * MiB;
constexpr size_t WS_WIN = 2 * MiB;
constexpr size_t WIN_L = (size_t)NINP * DM * 2;
constexpr size_t WS_WOUT = 60 * MiB;
constexpr size_t WS_WQ = 76 * MiB;
constexpr size_t WSQ_L = (size_t)DM * DM * 2;
constexpr size_t WS_K1 = 92 * MiB, WS_K2 = 92 * MiB + 512 * 1024;
constexpr size_t WS_RSTD1 = 93 * MiB;
constexpr size_t WS_SSP = 94 * MiB;
constexpr size_t WS_XB = 96 * MiB;
constexpr size_t WS_P = 128 * MiB;
constexpr size_t WS_PS = 240 * MiB;
constexpr size_t WS_MIX = 242 * MiB;
constexpr size_t WS_Q = 274 * MiB;
constexpr size_t WS_UB = 306 * MiB;
constexpr size_t WS_VB = 434 * MiB;
constexpr size_t TAB_L = (size_t)NEXP * DM * 2;
constexpr size_t WS_SCR = 562 * MiB;
constexpr size_t WS_END = 900 * MiB;

constexpr int LDS_BYTES = 155648;
constexpr int MISC_OFF = LDS_BYTES - 256;

#define GAS __attribute__((address_space(1)))
#define LAS __attribute__((address_space(3)))
typedef unsigned short bf16;
typedef unsigned v4u __attribute__((ext_vector_type(4)));
typedef unsigned v2u __attribute__((ext_vector_type(2)));
typedef float f32x4 __attribute__((ext_vector_type(4)));
typedef float f32x2 __attribute__((ext_vector_type(2)));
typedef short bf16x8 __attribute__((ext_vector_type(8)));
typedef short bf16x4 __attribute__((ext_vector_type(4)));
typedef __bf16 bf2_t __attribute__((ext_vector_type(2)));
typedef GAS unsigned gu32;
#define RLX_AGENT __ATOMIC_RELAXED, __HIP_MEMORY_SCOPE_AGENT
__device__ __forceinline__ unsigned f2bf(float f) { unsigned u = __builtin_bit_cast(unsigned, f); return (u + 0x7fffu + ((u >> 16) & 1u)) >> 16; }
__device__ __forceinline__ unsigned pk2(float lo, float hi) { return f2bf(lo) | (f2bf(hi) << 16); }
__device__ __forceinline__ float bf2f(unsigned b) { return __builtin_bit_cast(float, b << 16); }
__device__ __forceinline__ float bflo(unsigned w) { return __builtin_bit_cast(float, w << 16); }
__device__ __forceinline__ float bfhi(unsigned w) { return __builtin_bit_cast(float, w & 0xffff0000u); }
__device__ __forceinline__ float wave_sum(float v) {
#pragma unroll
    for (int o = 1; o < 64; o <<= 1) v += __shfl_xor(v, o);
    return v;
}
__device__ __forceinline__ float rcpf_(float x) { return __builtin_amdgcn_rcpf(x); }
__device__ __forceinline__ float sigmoidf_(float x) { return rcpf_(1.0f + __expf(-x)); }
__device__ __forceinline__ float siluf_(float x) { return x * rcpf_(1.0f + __expf(-x)); }
__device__ __forceinline__ float softplusf_(float x) { return fmaxf(x, 0.f) + __logf(1.0f + __expf(-fabsf(x))); }
__device__ __forceinline__ float logsigmoidf_(float x) { return fminf(x, 0.f) - __logf(1.0f + __expf(-fabsf(x))); }
__device__ __forceinline__ float gelu_tanh(float x) { const float u = 1.5957691216057308f * (x + 0.044715f * x * x * x); return x * rcpf_(1.0f + __expf(-u)); }

#define XB_TMO      128
#define XB_XCNT(j)  (256  + 64 * (j))
#define XB_XSUB(j)  (1280 + 64 * (j))
#define XB_XGEN(j)  (2304 + 64 * (j))
#define XB_TOP      3328
#define XB_TOPGEN   3392
#define XCD_BAR_WORDS 3456
#define XB_SPIN_CAP (1u << 18)

__device__ __forceinline__ unsigned xb_ld(unsigned* p)              { return __hip_atomic_load(p, __ATOMIC_RELAXED, __HIP_MEMORY_SCOPE_AGENT); }
__device__ __forceinline__ unsigned xb_add(unsigned* p, unsigned v) { return __hip_atomic_fetch_add(p, v, __ATOMIC_RELAXED, __HIP_MEMORY_SCOPE_AGENT); }
__device__ __forceinline__ unsigned xb_xcc_id() { return (unsigned)__builtin_amdgcn_s_getreg((3 << 11) | 20) & 0xFu; }
#define XB_SPIN(cond, bar) do { unsigned _sp = 0; while (cond) { __builtin_amdgcn_s_sleep(1); \
    if ((++_sp & 255u) == 0u) { if (xb_ld(&(bar)[XB_TMO])) break; if (_sp > XB_SPIN_CAP) { atomicAdd(&(bar)[XB_TMO], 1u); break; } } } } while (0)

struct XcdBarrier {
    unsigned* bar; unsigned x;
    volatile LAS unsigned* st;
};

__device__ __forceinline__ XcdBarrier xcd_barrier_post(unsigned* bar, volatile LAS unsigned* st) {
    XcdBarrier b; b.bar = bar; b.x = xb_xcc_id(); b.st = st;
    if (threadIdx.x == 0) (void)xb_add(&bar[XB_XCNT(b.x)], 1u);
    return b;
}
__device__ __forceinline__ void xcd_barrier_complete(unsigned* bar, unsigned x, unsigned& nloc, unsigned& nx) {
    const unsigned G = gridDim.x * gridDim.y * gridDim.z;
    unsigned sum, cnt, mine, sp = 0u;
    for (;;) {
        sum = 0u; cnt = 0u; mine = 0u;
#pragma unroll
        for (unsigned j = 0; j < 16; ++j) { const unsigned c = xb_ld(&bar[XB_XCNT(j)]); sum += c; cnt += (c > 0u) ? 1u : 0u; mine = (j == x) ? c : mine; }
        if (sum == G) break;
        __builtin_amdgcn_s_sleep(1);
        if ((++sp & 255u) == 0u) { if (xb_ld(&bar[XB_TMO])) break; if (sp > XB_SPIN_CAP) { atomicAdd(&bar[XB_TMO], 1u); break; } }
    }
    nloc = mine > 0u ? mine : 1u; nx = cnt > 0u ? cnt : 1u;
}

__device__ __forceinline__ void xcd_barrier(const XcdBarrier& b) {
    asm volatile("s_waitcnt vmcnt(0)" ::: "memory");
    __syncthreads();
    if (threadIdx.x == 0) {
        unsigned* bar = b.bar;
        __builtin_amdgcn_s_waitcnt(0);
        unsigned nloc = b.st[0], nx = b.st[1];
        if (nloc == 0u) { xcd_barrier_complete(bar, b.x, nloc, nx); b.st[0] = nloc; b.st[1] = nx; }
        const unsigned old = xb_add(&bar[XB_XSUB(b.x)], 1u);
        const unsigned gen = old / nloc;
        if (old + 1u == (gen + 1u) * nloc) {
            __builtin_amdgcn_fence(__ATOMIC_RELEASE, "agent");
            asm volatile("s_waitcnt vmcnt(0)" ::: "memory");
            const unsigned og = xb_add(&bar[XB_TOP], 1u);
            const unsigned tg = og / nx;
            if (og + 1u == (tg + 1u) * nx) xb_add(&bar[XB_TOPGEN], 1u);
            else XB_SPIN(xb_ld(&bar[XB_TOPGEN]) == tg, bar);
            __builtin_amdgcn_fence(__ATOMIC_ACQUIRE, "agent");
            xb_add(&bar[XB_XGEN(b.x)], 1u);
            asm volatile("s_waitcnt vmcnt(0)" ::: "memory");
        } else {
            XB_SPIN(xb_ld(&bar[XB_XGEN(b.x)]) == gen, bar);
            __builtin_amdgcn_fence(__ATOMIC_ACQUIRE, "agent");
            asm volatile("s_waitcnt vmcnt(0)" ::: "memory");
        }
    }
    __syncthreads();
}


struct Args { const float* in[N_IN]; float* out; unsigned char* ws; int ph_lo, ph_hi, li, pad; };
typedef const __attribute__((address_space(4))) Args& ArgsR;
__device__ __forceinline__ const __attribute__((address_space(4))) Args* kargs() { unsigned long long p = (unsigned long long)__builtin_amdgcn_kernarg_segment_ptr(); asm volatile("" : "+s"(p)); return (const __attribute__((address_space(4))) Args*)p; }

__device__ __forceinline__ int win_src_col(int n) {
    if (n < 2048) return n;
    if (n < 3072) return 2064 + (n - 2048);
    if (n < 5120) return 3088 + (n - 3072);
    if (n < 7168) return 5144 + (n - 5120);
    if (n < 7184) return 2048 + (n - 7168);
    if (n < 7192) return 5136 + (n - 7184);
    if (n < 7200) return n;
    return -1;
}
template <bool MAP>
__device__ __forceinline__ void p0_transpose_item(const float* W, int K, int Nsrc, int Ndst, const float* gain, bf16* WT, LAS float* scr, int item, int lane) {
    const int nblk = Ndst / 32, kb = item / nblk, nb = item % nblk, k0 = 64 * kb, n0 = 32 * nb;
    const int nn = n0 + (lane & 31); const int src = MAP ? win_src_col(nn) : nn;
    float tv[32];
#pragma unroll
    for (int i = 0; i < 32; ++i) { const int kk = 2 * i + (lane >> 5); tv[i] = (src >= 0) ? W[(size_t)(k0 + kk) * Nsrc + src] : 0.f; }
#pragma unroll
    for (int i = 0; i < 32; ++i) { const int kk = 2 * i + (lane >> 5); float v = tv[i]; if (gain) v *= gain[k0 + kk]; scr[kk * 33 + (lane & 31)] = v; }
    asm volatile("s_waitcnt lgkmcnt(0)" ::: "memory");
    const int c = lane & 7;
#pragma unroll
    for (int j = 0; j < 4; ++j) { const int n = (lane >> 3) + 8 * j; const LAS float* s = scr + (8 * c) * 33 + n;
        v4u o; o.x = pk2(s[0 * 33], s[1 * 33]); o.y = pk2(s[2 * 33], s[3 * 33]); o.z = pk2(s[4 * 33], s[5 * 33]); o.w = pk2(s[6 * 33], s[7 * 33]);
        *(GAS v4u*)(WT + (size_t)(n0 + n) * K + k0 + 8 * c) = o; }
    asm volatile("s_waitcnt lgkmcnt(0)" ::: "memory");
}
__device__ __forceinline__ void p0_convert(const float* src, bf16* dst, size_t n, size_t gtid, size_t gthreads) {
    for (size_t i = gtid * 8; i < n; i += gthreads * 8) {
        const f32x4 a = *(const GAS f32x4*)(src + i), b = *(const GAS f32x4*)(src + i + 4);
        v4u o; o.x = pk2(a[0], a[1]); o.y = pk2(a[2], a[3]); o.z = pk2(b[0], b[1]); o.w = pk2(b[2], b[3]);
        *(GAS v4u*)(dst + i) = o; }
}
__device__ __forceinline__ void p0_prologue(ArgsR A, LAS unsigned char* lds, int vcu, int G, int wave, int lane) {
    unsigned char* ws = A.ws;
    LAS float* scr = (LAS float*)(lds + wave * 16384);
    const int gw = vcu * NWAVES + wave, NGW = G * NWAVES;
    constexpr int I_IN = (DM / 64) * (NINP / 32), I_SQ = (DM / 64) * (DM / 32), I_LAYER = I_IN + 2 * I_SQ, NITEMS = DEPTH * I_LAYER;
    for (int it = gw; it < NITEMS; it += NGW) {
        const int l = it / I_LAYER; int r = it % I_LAYER;
        if (r < I_IN) { p0_transpose_item<true>(A.in[I_WIN] + (size_t)l * DM * DIN, DM, DIN, NINP, A.in[I_N1G] + l * DM, (bf16*)(ws + WS_WIN + l * WIN_L), scr, r, lane); continue; } r -= I_IN;
        if (r < I_SQ) { p0_transpose_item<false>(A.in[I_WOUT] + (size_t)l * DM * DM, DM, DM, DM, nullptr, (bf16*)(ws + WS_WOUT + l * WSQ_L), scr, r, lane); continue; } r -= I_SQ;
        p0_transpose_item<false>(A.in[I_PWQ] + (size_t)l * DM * DM, DM, DM, DM, A.in[I_N2G] + l * DM, (bf16*)(ws + WS_WQ + l * WSQ_L), scr, r, lane);
    }
    const size_t gtid = (size_t)gw * 64 + lane, gthreads = (size_t)NGW * 64;
    p0_convert(A.in[I_PK1], (bf16*)(ws + WS_K1), (size_t)DEPTH * 8 * 128 * 128, gtid, gthreads);
    p0_convert(A.in[I_PK2], (bf16*)(ws + WS_K2), (size_t)DEPTH * 8 * 128 * 128, gtid, gthreads);
    const float* x = A.in[I_X]; bf16* xb = (bf16*)(ws + WS_XB); float* rstd1 = (float*)(ws + WS_RSTD1);
    for (int m = gw; m < NT; m += NGW) {
        const GAS f32x4* xr = (const GAS f32x4*)(x + (size_t)m * DM) + lane;
        f32x4 v[8]; float s = 0.f;
#pragma unroll
        for (int j = 0; j < 8; ++j) { v[j] = xr[64 * j]; s += (v[j][0] * v[j][0] + v[j][1] * v[j][1]) + (v[j][2] * v[j][2] + v[j][3] * v[j][3]); }
        s = wave_sum(s);
        GAS v2u* o = (GAS v2u*)(xb + (size_t)m * DM) + lane;
#pragma unroll
        for (int j = 0; j < 8; ++j) { v2u w; w.x = pk2(v[j][0], v[j][1]); w.y = pk2(v[j][2], v[j][3]); o[64 * j] = w; }
        if (lane == 0) rstd1[m] = rsqrtf(s * (1.0f / DM) + RMS_EPS);
    }
}

constexpr int NM_Q = 0, NM_K = 32768, NM_A = 65536, NM_V = 98304, NM_PARTS = 131072  , NM_SC = 135168  ;

__device__ __forceinline__ void nm_load_tile(const bf16* g, size_t ld, LAS float* dst, int tid) {
#pragma unroll
    for (int i = 0; i < 2; ++i) { const int idx = tid + i * NTHREADS, r = idx >> 4, c8 = (idx & 15) * 8;
        const v4u w = *(const GAS v4u*)(g + (size_t)r * ld + c8);
        f32x4 a = {bflo(w.x), bfhi(w.x), bflo(w.y), bfhi(w.y)}, b = {bflo(w.z), bfhi(w.z), bflo(w.w), bfhi(w.w)};
        *(LAS f32x4*)(dst + r * 128 + c8) = a; *(LAS f32x4*)(dst + r * 128 + c8 + 4) = b; }
}
template <int GATE>
__device__ __forceinline__ void nm_finalize(const LAS float* vs, const float* ng, const bf16* gate, size_t gld, bf16* mixp, int wave, int lane) {
#pragma unroll 1
    for (int rr = 0; rr < 8; ++rr) { const int c = wave * 8 + rr;
        const float o1 = vs[c * 128 + lane], o2 = vs[c * 128 + 64 + lane];
        const float ss = wave_sum(o1 * o1 + o2 * o2), rs = rsqrtf(ss * (1.0f / 128.0f) + RMS_EPS);
        float r1 = o1 * rs * ng[lane], r2 = o2 * rs * ng[64 + lane];
        if (GATE == 1) { r1 *= siluf_(bf2f(gate[(size_t)c * gld + lane])); r2 *= siluf_(bf2f(gate[(size_t)c * gld + 64 + lane])); }
        mixp[(size_t)c * DM + lane] = (bf16)f2bf(r1); mixp[(size_t)c * DM + 64 + lane] = (bf16)f2bf(r2); }
}

__device__ __forceinline__ void nm_gla(ArgsR A, int l, int b, int h, LAS unsigned char* lds, int tid) {
    const bf16* P = (const bf16*)(A.ws + WS_P); const float* Ps = (const float*)(A.ws + WS_PS); bf16* mix = (bf16*)(A.ws + WS_MIX);
    LAS float* qs = (LAS float*)(lds + NM_Q); LAS float* ks = (LAS float*)(lds + NM_K); LAS float* as = (LAS float*)(lds + NM_A); LAS float* vs = (LAS float*)(lds + NM_V);
    LAS float* parts = (LAS float*)(lds + NM_PARTS); LAS float* lrs = (LAS float*)(lds + NM_SC);
    const int v = tid & 127, dq = tid >> 7, wave = tid >> 6, lane = tid & 63;
    const float* w2 = A.in[I_GLA_W2] + (size_t)l * 16 * GW + h * HD + v;
    float w2c[16];
#pragma unroll
    for (int r = 0; r < 16; ++r) w2c[r] = w2[r * GW];
    const float b2 = A.in[I_GLA_B2][l * GW + h * HD + v];
    const float* ng = A.in[I_GLA_NG] + l * GW + h * HD;
    float S[32];
#pragma unroll
    for (int i = 0; i < 32; ++i) S[i] = 0.f;
#pragma unroll 1
    for (int n = 0; n < NCHK; ++n) {
        const size_t r0 = (size_t)b * SEQ + n * CHK;
        nm_load_tile(P + r0 * PBW + PC_GLA_Q + h * HD, PBW, qs, tid);
        nm_load_tile(P + r0 * PBW + PC_GLA_K + h * HD, PBW, ks, tid);
        nm_load_tile(P + r0 * PBW + PC_GLA_V + h * HD, PBW, vs, tid);
        for (int i = tid; i < 64 * 16; i += NTHREADS) lrs[i] = Ps[(r0 + (i >> 4)) * 32 + PS_LR + (i & 15)];
        __syncthreads();
#pragma unroll 1
        for (int i = 0; i < 16; ++i) { const int c = dq * 16 + i; float z = b2;
#pragma unroll
            for (int r = 0; r < 16; ++r) z += lrs[c * 16 + r] * w2c[r];
            as[c * 128 + v] = __expf(logsigmoidf_(z) * (1.0f / 16.0f)); }
        __syncthreads();
#pragma unroll 1
        for (int c = 0; c < CHK; ++c) {
            const float vt = vs[c * 128 + v]; float part = 0.f;
            const LAS f32x4* q4 = (const LAS f32x4*)(qs + c * 128 + dq * 32); const LAS f32x4* k4 = (const LAS f32x4*)(ks + c * 128 + dq * 32); const LAS f32x4* a4 = (const LAS f32x4*)(as + c * 128 + dq * 32);
#pragma unroll
            for (int i4 = 0; i4 < 8; ++i4) { const f32x4 qv = q4[i4], kv = k4[i4], av = a4[i4];
#pragma unroll
                for (int j = 0; j < 4; ++j) { S[i4 * 4 + j] = av[j] * S[i4 * 4 + j] + kv[j] * vt; part += qv[j] * S[i4 * 4 + j]; } }
            parts[((c & 1) * 4 + dq) * 128 + v] = part;
            __syncthreads();
            if (dq == 0) { const LAS float* pp = parts + (c & 1) * 512 + v; vs[c * 128 + v] = ((pp[0] + pp[128]) + (pp[256] + pp[384])) * 0.08838834764831845f; }
        }
        __syncthreads();
        nm_finalize<1>(vs, ng, P + r0 * PBW + PC_GLA_G + h * HD, PBW, mix + r0 * DM + 0 + h * HD, wave, lane);
        __syncthreads();
    }
}

__device__ __forceinline__ void nm_mlstm(ArgsR A, int l, int b, int h, LAS unsigned char* lds, int tid) {
    const bf16* P = (const bf16*)(A.ws + WS_P); const float* Ps = (const float*)(A.ws + WS_PS); bf16* mix = (bf16*)(A.ws + WS_MIX);
    LAS float* qs = (LAS float*)(lds + NM_Q); LAS float* ks = (LAS float*)(lds + NM_K); LAS float* vs = (LAS float*)(lds + NM_V);
    LAS float* parts = (LAS float*)(lds + NM_PARTS); LAS float* dparts = (LAS float*)(lds + NM_A);
    LAS float* fs = (LAS float*)(lds + NM_SC); LAS float* es = fs + 64;
    const int v = tid & 127, dq = tid >> 7, wave = tid >> 6, lane = tid & 63;
    const float ib = A.in[I_ML_IB][l * NH + h], fb = A.in[I_ML_FB][l * NH + h];
    const float* ng = A.in[I_ML_NG] + l * GW + h * HD;
    float C[32], nn[32];
#pragma unroll
    for (int i = 0; i < 32; ++i) { C[i] = 0.f; nn[i] = 0.f; }
#pragma unroll 1
    for (int n = 0; n < NCHK; ++n) {
        const size_t r0 = (size_t)b * SEQ + n * CHK;
        nm_load_tile(P + r0 * PBW + PC_ML_Q + h * HD, PBW, qs, tid);
        nm_load_tile(P + r0 * PBW + PC_ML_K + h * HD, PBW, ks, tid);
        nm_load_tile(P + r0 * PBW + PC_ML_V + h * HD, PBW, vs, tid);
        if (tid < 64) { fs[tid] = sigmoidf_(Ps[(r0 + tid) * 32 + PS_MF + h] + fb); es[tid] = __expf(Ps[(r0 + tid) * 32 + PS_MI + h] + ib) * 0.08838834764831845f; }
        __syncthreads();
#pragma unroll 1
        for (int c = 0; c < CHK; ++c) {
            const float vt = vs[c * 128 + v], f = fs[c], ei = es[c]; float part = 0.f, dpart = 0.f;
            const LAS f32x4* q4 = (const LAS f32x4*)(qs + c * 128 + dq * 32); const LAS f32x4* k4 = (const LAS f32x4*)(ks + c * 128 + dq * 32);
#pragma unroll
            for (int i4 = 0; i4 < 8; ++i4) { const f32x4 qv = q4[i4], kv = k4[i4];
#pragma unroll
                for (int j = 0; j < 4; ++j) { const float kd = kv[j] * ei; C[i4 * 4 + j] = f * C[i4 * 4 + j] + kd * vt; nn[i4 * 4 + j] = f * nn[i4 * 4 + j] + kd;
                    part += qv[j] * C[i4 * 4 + j]; dpart += qv[j] * nn[i4 * 4 + j]; } }
            parts[((c & 1) * 4 + dq) * 128 + v] = part; if (v == 0) dparts[(c & 1) * 4 + dq] = dpart;
            __syncthreads();
            if (dq == 0) { const LAS float* pp = parts + (c & 1) * 512 + v; const LAS float* dp = dparts + (c & 1) * 4;
                const float num = (pp[0] + pp[128]) + (pp[256] + pp[384]), dot = (dp[0] + dp[1]) + (dp[2] + dp[3]);
                const float og = bf2f(P[(r0 + c) * PBW + PC_ML_O + h * HD + v]);
                vs[c * 128 + v] = num / fmaxf(fabsf(dot), 1.0f) * sigmoidf_(og); }
        }
        __syncthreads();
        nm_finalize<0>(vs, ng, nullptr, 0, mix + r0 * DM + 1024 + h * HD, wave, lane);
        __syncthreads();
    }
}

__device__ __forceinline__ void nm_gdn(ArgsR A, int l, int b, int h, LAS unsigned char* lds, int tid) {
    const bf16* P = (const bf16*)(A.ws + WS_P); const float* Ps = (const float*)(A.ws + WS_PS); bf16* mix = (bf16*)(A.ws + WS_MIX);
    LAS float* qs = (LAS float*)(lds + NM_Q); LAS float* ks = (LAS float*)(lds + NM_K); LAS float* vs = (LAS float*)(lds + NM_V);
    LAS float* parts = (LAS float*)(lds + NM_PARTS);
    LAS float* egs = (LAS float*)(lds + NM_SC); LAS float* bts = egs + 64; LAS float* rq = egs + 128; LAS float* rk = egs + 192;
    const int v = tid & 127, dq = tid >> 7, wave = tid >> 6, lane = tid & 63;
    const float* cw = A.in[I_GDN_CW] + (size_t)l * 4 * 1536;
    const float nalog = -__expf(A.in[I_GDN_ALOG][l * NH + h]), dtb = A.in[I_GDN_DTB][l * NH + h];
    const float* ng = A.in[I_GDN_NG] + l * GW + h * HD;
    float S[32];
#pragma unroll
    for (int i = 0; i < 32; ++i) S[i] = 0.f;
#pragma unroll 1
    for (int n = 0; n < NCHK; ++n) {
        const size_t r0 = (size_t)b * SEQ + n * CHK;
#pragma unroll 1
        for (int part = 0; part < 3; ++part) {
            const int pc = (part == 0 ? PC_GDN_Q : part == 1 ? PC_GDN_K : PC_GDN_V) + h * HD + v, wc = part * 512 + h * HD + v;
            const float w0 = cw[wc], w1 = cw[1536 + wc], w2 = cw[2 * 1536 + wc], w3 = cw[3 * 1536 + wc];
            LAS float* dst = part == 0 ? qs : part == 1 ? ks : vs;
            const int c0 = dq * 16; const long t0 = (long)n * CHK + c0;
            float xm3 = (t0 - 3 >= 0) ? bf2f(P[(r0 + c0 - 3) * PBW + pc]) : 0.f, xm2 = (t0 - 2 >= 0) ? bf2f(P[(r0 + c0 - 2) * PBW + pc]) : 0.f, xm1 = (t0 - 1 >= 0) ? bf2f(P[(r0 + c0 - 1) * PBW + pc]) : 0.f;
#pragma unroll 4
            for (int i = 0; i < 16; ++i) { const float x0 = bf2f(P[(r0 + c0 + i) * PBW + pc]); const float y = w0 * xm3 + w1 * xm2 + w2 * xm1 + w3 * x0;
                dst[(c0 + i) * 128 + v] = siluf_(y); xm3 = xm2; xm2 = xm1; xm1 = x0; }
        }
        if (tid < 64) { bts[tid] = sigmoidf_(Ps[(r0 + tid) * 32 + PS_GB + h]); egs[tid] = __expf(nalog * softplusf_(Ps[(r0 + tid) * 32 + PS_GA + h] + dtb)); }
        __syncthreads();
#pragma unroll 1
        for (int rr = 0; rr < 8; ++rr) { const int c = wave * 8 + rr;
            const float q1 = qs[c * 128 + lane], q2 = qs[c * 128 + 64 + lane], k1 = ks[c * 128 + lane], k2 = ks[c * 128 + 64 + lane];
            const float sq = wave_sum(q1 * q1 + q2 * q2), sk = wave_sum(k1 * k1 + k2 * k2);
            if (lane == 0) { rq[c] = rsqrtf(sq + 1e-6f) * 0.08838834764831845f; rk[c] = rsqrtf(sk + 1e-6f); } }
        __syncthreads();
#pragma unroll 1
        for (int c = 0; c < CHK; ++c) {
            const float vt = vs[c * 128 + v], e = egs[c], bt = bts[c], sq = rq[c], sk = rk[c]; float part = 0.f;
            const LAS f32x4* q4 = (const LAS f32x4*)(qs + c * 128 + dq * 32); const LAS f32x4* k4 = (const LAS f32x4*)(ks + c * 128 + dq * 32);
            f32x4 kv[8];
#pragma unroll
            for (int i4 = 0; i4 < 8; ++i4) { kv[i4] = k4[i4] * sk;
#pragma unroll
                for (int j = 0; j < 4; ++j) { S[i4 * 4 + j] *= e; part += kv[i4][j] * S[i4 * 4 + j]; } }
            parts[dq * 128 + v] = part;
            __syncthreads();
            const float kS = (parts[v] + parts[128 + v]) + (parts[256 + v] + parts[384 + v]);
            const float u = bt * (vt - kS); float part2 = 0.f;
#pragma unroll
            for (int i4 = 0; i4 < 8; ++i4) { const f32x4 qv = q4[i4] * sq;
#pragma unroll
                for (int j = 0; j < 4; ++j) { S[i4 * 4 + j] += kv[i4][j] * u; part2 += qv[j] * S[i4 * 4 + j]; } }
            parts[512 + dq * 128 + v] = part2;
            __syncthreads();
            if (dq == 0) vs[c * 128 + v] = (parts[512 + v] + parts[640 + v]) + (parts[768 + v] + parts[896 + v]);
        }
        __syncthreads();
        nm_finalize<1>(vs, ng, P + r0 * PBW + PC_GDN_G + h * HD, PBW, mix + r0 * DM + 1536 + h * HD, wave, lane);
        __syncthreads();
    }
}

__device__ __forceinline__ void nm_lru(ArgsR A, int l, int b, int j, LAS unsigned char* lds, int tid) {
    const bf16* P = (const bf16*)(A.ws + WS_P); bf16* mix = (bf16*)(A.ws + WS_MIX);
    LAS float* xc = (LAS float*)(lds);
    LAS float* was = (LAS float*)(lds + 20480);
    LAS float* wxs = (LAS float*)(lds + 36864);
    LAS float* aa = (LAS float*)(lds + 53248);
    LAS float* uu = (LAS float*)(lds + 69632);
    const float* wa = A.in[I_LRU_WA] + ((size_t)l * 8 + j) * 4096; const float* wx = A.in[I_LRU_WX] + ((size_t)l * 8 + j) * 4096;
    for (int i = tid; i < 4096; i += NTHREADS) { was[i] = wa[i]; wxs[i] = wx[i]; }
    const float* cw = A.in[I_LRU_CW] + (size_t)l * 4 * GW; const float* cb = A.in[I_LRU_CB] + l * GW;
    const float* ba = A.in[I_LRU_BA] + l * GW + j * 64; const float* bx = A.in[I_LRU_BX] + l * GW + j * 64; const float* lam = A.in[I_LRU_LAM] + l * GW + j * 64;
    float hstate = 0.f;
#pragma unroll 1
    for (int n = 0; n < NCHK; ++n) {
        const size_t r0 = (size_t)b * SEQ + n * CHK;
        { const int cc = tid & 63, c0 = (tid >> 6) * 8, ch = j * 64 + cc, pc = PC_LRU_X + ch; const long t0 = (long)n * CHK + c0;
            const float w0 = cw[ch], w1 = cw[GW + ch], w2 = cw[2 * GW + ch], w3 = cw[3 * GW + ch], bias = cb[ch];
            float xm3 = (t0 - 3 >= 0) ? bf2f(P[(r0 + c0 - 3) * PBW + pc]) : 0.f, xm2 = (t0 - 2 >= 0) ? bf2f(P[(r0 + c0 - 2) * PBW + pc]) : 0.f, xm1 = (t0 - 1 >= 0) ? bf2f(P[(r0 + c0 - 1) * PBW + pc]) : 0.f;
#pragma unroll
            for (int i = 0; i < 8; ++i) { const float x0 = bf2f(P[(r0 + c0 + i) * PBW + pc]); xc[(c0 + i) * 65 + cc] = w0 * xm3 + w1 * xm2 + w2 * xm1 + w3 * x0 + bias; xm3 = xm2; xm2 = xm1; xm1 = x0; } }
        __syncthreads();
        { const int tok = tid >> 3, cg = tid & 7; float ra[8], ri[8];
#pragma unroll
            for (int q = 0; q < 8; ++q) { ra[q] = ba[cg * 8 + q]; ri[q] = bx[cg * 8 + q]; }
#pragma unroll 4
            for (int i = 0; i < 64; ++i) { const float xv = xc[tok * 65 + i];
                const f32x4 a0 = *(const LAS f32x4*)(was + i * 64 + cg * 8), a1 = *(const LAS f32x4*)(was + i * 64 + cg * 8 + 4);
                const f32x4 x0 = *(const LAS f32x4*)(wxs + i * 64 + cg * 8), x1 = *(const LAS f32x4*)(wxs + i * 64 + cg * 8 + 4);
#pragma unroll
                for (int q = 0; q < 4; ++q) { ra[q] += xv * a0[q]; ra[4 + q] += xv * a1[q]; ri[q] += xv * x0[q]; ri[4 + q] += xv * x1[q]; } }
#pragma unroll
            for (int q = 0; q < 8; ++q) { const int jj = cg * 8 + q; const float r = sigmoidf_(ra[q]), ig = sigmoidf_(ri[q]);
                const float log_a = -8.0f * r * softplusf_(-lam[jj]); const float a = __expf(log_a), u = sqrtf(-expm1f(2.0f * log_a)) * (ig * xc[tok * 65 + jj]);
                aa[tok * 64 + jj] = a; uu[tok * 64 + jj] = u; } }
        __syncthreads();
        if (tid < 64) { const int ch = j * 64 + tid;
#pragma unroll 4
            for (int c = 0; c < CHK; ++c) { hstate = aa[c * 64 + tid] * hstate + uu[c * 64 + tid];
                const float y = bf2f(P[(r0 + c) * PBW + PC_LRU_Y + ch]); mix[(r0 + c) * DM + 512 + ch] = (bf16)f2bf(gelu_tanh(y) * hstate); } }
        __syncthreads();
    }
}

__device__ __forceinline__ void nm_phase(ArgsR A, int l, LAS unsigned char* lds, int G, int tid) {
    for (int it = blockIdx.x; it < 80; it += G) {
        if (it < 16) nm_gla(A, l, it >> 2, it & 3, lds, tid);
        else if (it < 32) nm_mlstm(A, l, (it - 16) >> 2, (it - 16) & 3, lds, tid);
        else if (it < 48) nm_gdn(A, l, (it - 32) >> 2, (it - 32) & 3, lds, tid);
        else nm_lru(A, l, (it - 48) >> 3, (it - 48) & 7, lds, tid);
        __syncthreads();
    }
}

constexpr size_t WS_GLA_INC = 562 * MiB;
constexpr size_t WS_GLA_DEC = 594 * MiB;
constexpr size_t WS_GLA_ST = 595 * MiB;
constexpr size_t WS_ML_INC = 611 * MiB;
constexpr size_t WS_ML_N = 643 * MiB;
constexpr size_t WS_ML_SC = 643 * MiB + 512 * 1024;
constexpr size_t WS_ML_ST = 644 * MiB;
constexpr size_t WS_ML_NP = 660 * MiB;
constexpr size_t WS_ML_MP = 660 * MiB + 512 * 1024;
constexpr size_t WS_GDN_U0 = 661 * MiB, WS_GDN_W = 669 * MiB, WS_GDN_QD = 677 * MiB, WS_GDN_KE = 685 * MiB;
constexpr size_t WS_GDN_QK = 693 * MiB;
constexpr size_t WS_GDN_DE = 697 * MiB;
constexpr size_t WS_GDN_O = 698 * MiB;
constexpr size_t WS_LRU_HL = 714 * MiB, WS_LRU_AP = 730 * MiB;
constexpr size_t WS_LRU_CARRY = 746 * MiB;
static_assert(WS_LRU_CARRY + 4 * 32 * 512 * 4 <= WS_END, "ws map");

constexpr int CW_PBAR = 2048;
typedef short v4i16_t __attribute__((ext_vector_type(4)));
constexpr int LD128 = 136, LD64 = 72;

__device__ __forceinline__ bf16x8 frag_rd(const LAS bf16* t, int ld, int row0, int k0, int lane) { return *(const LAS bf16x8*)(t + (row0 + (lane & 15)) * ld + k0 + 8 * (lane >> 4)); }
__device__ __forceinline__ bf16x8 frag_rd_perm(const LAS bf16* t, int ld, int row0, int k0, int lane) {
    const LAS bf16* p = t + (row0 + (lane & 15)) * ld + k0 + 4 * (lane >> 4);
    const bf16x4 a = *(const LAS bf16x4*)p, b = *(const LAS bf16x4*)(p + 16);
    return (bf16x8){a[0], a[1], a[2], a[3], b[0], b[1], b[2], b[3]};
}
__device__ __forceinline__ bf16x8 frag_tr(const LAS bf16* t, int ld, int k0, int n0, int lane) {
    const int i = lane & 15, g = lane >> 4; const LAS bf16* p = t + (k0 + 8 * g + (i >> 2)) * ld + n0 + 4 * (i & 3);
    const v4i16_t a = __builtin_amdgcn_ds_read_tr16_b64_v4i16((LAS v4i16_t*)p), b = __builtin_amdgcn_ds_read_tr16_b64_v4i16((LAS v4i16_t*)(p + 4 * ld));
    return (bf16x8){a[0], a[1], a[2], a[3], b[0], b[1], b[2], b[3]};
}
__device__ __forceinline__ bf16x8 frag_tr_perm(const LAS bf16* t, int ld, int k0, int n0, int lane) {
    const int i = lane & 15, g = lane >> 4; const LAS bf16* p = t + (k0 + 4 * g + (i >> 2)) * ld + n0 + 4 * (i & 3);
    const v4i16_t a = __builtin_amdgcn_ds_read_tr16_b64_v4i16((LAS v4i16_t*)p), b = __builtin_amdgcn_ds_read_tr16_b64_v4i16((LAS v4i16_t*)(p + 16 * ld));
    return (bf16x8){a[0], a[1], a[2], a[3], b[0], b[1], b[2], b[3]};
}
__device__ __forceinline__ bf16x8 pack_acc(const f32x4& lo, const f32x4& hi) {
    v4u w; w.x = pg8::cvt_pk_bf16(lo[0], lo[1]); w.y = pg8::cvt_pk_bf16(lo[2], lo[3]); w.z = pg8::cvt_pk_bf16(hi[0], hi[1]); w.w = pg8::cvt_pk_bf16(hi[2], hi[3]);
    return __builtin_bit_cast(bf16x8, w);
}
#define MFMA16(a, b, c) __builtin_amdgcn_mfma_f32_16x16x32_bf16((a), (b), (c), 0, 0, 0)

template <int ROWS>
__device__ __forceinline__ void tile_g2l_128(const bf16* g, size_t gld, LAS bf16* t, int tid) {
#pragma unroll
    for (int i = 0; i < ROWS * 16 / NTHREADS; ++i) { const int idx = tid + i * NTHREADS, r = idx >> 4, c8 = (idx & 15) * 8;
        *(LAS v4u*)(t + r * LD128 + c8) = *(const GAS v4u*)(g + (size_t)r * gld + c8); }
}
__device__ __forceinline__ float wave_scan_add(float v, int lane) {
#pragma unroll
    for (int o = 1; o < 64; o <<= 1) { const float t = __shfl_up(v, o); if (lane >= o) v += t; }
    return v;
}
__device__ __forceinline__ float wave_scan_max(float v, int lane) {
#pragma unroll
    for (int o = 1; o < 64; o <<= 1) { const float t = __shfl_up(v, o); if (lane >= o) v = fmaxf(v, t); }
    return v;
}
__device__ __forceinline__ float wave_max(float v) {
#pragma unroll
    for (int o = 1; o < 64; o <<= 1) v = fmaxf(v, __shfl_xor(v, o));
    return v;
}

__device__ __forceinline__ void f_lru_p2(ArgsR A, int l, int item, LAS unsigned char* lds, int tid) {
    const int j = item & 7, n = (item >> 3) & 31, b = item >> 8;
    const bf16* P = (const bf16*)(A.ws + WS_P); float* HLg = (float*)(A.ws + WS_LRU_HL); float* APg = (float*)(A.ws + WS_LRU_AP);
    LAS float* xc = (LAS float*)(lds); LAS float* was = (LAS float*)(lds + 20480); LAS float* wxs = (LAS float*)(lds + 36864);
    LAS float* aa = (LAS float*)(lds + 53248); LAS float* uu = (LAS float*)(lds + 69632); LAS float* segA = (LAS float*)(lds + 86016); LAS float* segH = (LAS float*)(lds + 88064);
    const float* wa = A.in[I_LRU_WA] + ((size_t)l * 8 + j) * 4096; const float* wx = A.in[I_LRU_WX] + ((size_t)l * 8 + j) * 4096;
    for (int i = tid; i < 4096; i += NTHREADS) { was[i] = wa[i]; wxs[i] = wx[i]; }
    const float* cw = A.in[I_LRU_CW] + (size_t)l * 4 * GW; const float* cb = A.in[I_LRU_CB] + l * GW;
    const float* ba = A.in[I_LRU_BA] + l * GW + j * 64; const float* bx = A.in[I_LRU_BX] + l * GW + j * 64; const float* lam = A.in[I_LRU_LAM] + l * GW + j * 64;
    const size_t r0 = (size_t)b * SEQ + n * CHK;
    { const int cc = tid & 63, c0 = (tid >> 6) * 8, ch = j * 64 + cc, pc = PC_LRU_X + ch; const long t0 = (long)n * CHK + c0;
        const float w0 = cw[ch], w1 = cw[GW + ch], w2 = cw[2 * GW + ch], w3 = cw[3 * GW + ch], bias = cb[ch];
        float xm3 = (t0 - 3 >= 0) ? bf2f(P[(r0 + c0 - 3) * PBW + pc]) : 0.f, xm2 = (t0 - 2 >= 0) ? bf2f(P[(r0 + c0 - 2) * PBW + pc]) : 0.f, xm1 = (t0 - 1 >= 0) ? bf2f(P[(r0 + c0 - 1) * PBW + pc]) : 0.f;
#pragma unroll
        for (int i = 0; i < 8; ++i) { const float x0 = bf2f(P[(r0 + c0 + i) * PBW + pc]); xc[(c0 + i) * 65 + cc] = w0 * xm3 + w1 * xm2 + w2 * xm1 + w3 * x0 + bias; xm3 = xm2; xm2 = xm1; xm1 = x0; } }
    __syncthreads();
    { const int tok = tid >> 3, cg = tid & 7; float ra[8], ri[8], spl[8];
#pragma unroll
        for (int q = 0; q < 8; ++q) { ra[q] = ba[cg * 8 + q]; ri[q] = bx[cg * 8 + q]; spl[q] = softplusf_(-lam[cg * 8 + q]); }
#pragma unroll 4
        for (int i = 0; i < 64; ++i) { const float xv = xc[tok * 65 + i];
            const f32x4 a0 = *(const LAS f32x4*)(was + i * 64 + cg * 8), a1 = *(const LAS f32x4*)(was + i * 64 + cg * 8 + 4);
            const f32x4 x0 = *(const LAS f32x4*)(wxs + i * 64 + cg * 8), x1 = *(const LAS f32x4*)(wxs + i * 64 + cg * 8 + 4);
#pragma unroll
            for (int q = 0; q < 4; ++q) { ra[q] += xv * a0[q]; ra[4 + q] += xv * a1[q]; ri[q] += xv * x0[q]; ri[4 + q] += xv * x1[q]; } }
#pragma unroll
        for (int q = 0; q < 8; ++q) { const int jj = cg * 8 + q; const float r = sigmoidf_(ra[q]), ig = sigmoidf_(ri[q]);
            const float log_a = -8.0f * r * spl[q]; const float a = __expf(log_a), u = sqrtf(fmaxf(1.0f - a * a, 0.f)) * (ig * xc[tok * 65 + jj]);
            aa[tok * 64 + jj] = a; uu[tok * 64 + jj] = u; } }
    __syncthreads();
    const int cc = tid & 63, seg = tid >> 6;
    { float Ap = 1.f, Hl = 0.f;
#pragma unroll
        for (int i = 0; i < 8; ++i) { const int c = seg * 8 + i; const float a = aa[c * 64 + cc], u = uu[c * 64 + cc]; Hl = a * Hl + u; Ap *= a; aa[c * 64 + cc] = Ap; uu[c * 64 + cc] = Hl; }
        segA[seg * 64 + cc] = Ap; segH[seg * 64 + cc] = Hl; }
    __syncthreads();
    { float Ac = 1.f, Hc = 0.f;
#pragma unroll 1
        for (int s = 0; s < seg; ++s) { const float sa = segA[s * 64 + cc]; Hc = sa * Hc + segH[s * 64 + cc]; Ac *= sa; }
#pragma unroll
        for (int i = 0; i < 8; ++i) { const int c = seg * 8 + i; const float ap = aa[c * 64 + cc], hl = uu[c * 64 + cc];
            HLg[(r0 + c) * GW + j * 64 + cc] = ap * Hc + hl; APg[(r0 + c) * GW + j * 64 + cc] = ap * Ac; } }
    __syncthreads();
}
__device__ __forceinline__ void f_lru_p3(ArgsR A, int b, int tid) {
    const float* HLg = (const float*)(A.ws + WS_LRU_HL); const float* APg = (const float*)(A.ws + WS_LRU_AP); float* carry = (float*)(A.ws + WS_LRU_CARRY);
    float c = 0.f;
#pragma unroll 8
    for (int n = 0; n < NCHK; ++n) { carry[((size_t)b * NCHK + n) * GW + tid] = c; const size_t t = (size_t)b * SEQ + n * CHK + 63; c = APg[t * GW + tid] * c + HLg[t * GW + tid]; }
}
__device__ __forceinline__ void f_lru_p4(ArgsR A, int item, int tid) {
    const bf16* P = (const bf16*)(A.ws + WS_P); bf16* mix = (bf16*)(A.ws + WS_MIX);
    const float* HLg = (const float*)(A.ws + WS_LRU_HL); const float* APg = (const float*)(A.ws + WS_LRU_AP); const float* carry = (const float*)(A.ws + WS_LRU_CARRY);
    const float cr = carry[(size_t)item * GW + tid]; const size_t r0 = (size_t)item * CHK;
#pragma unroll 8
    for (int c = 0; c < CHK; ++c) { const float h = APg[(r0 + c) * GW + tid] * cr + HLg[(r0 + c) * GW + tid]; const float y = bf2f(P[(r0 + c) * PBW + PC_LRU_Y + tid]);
        mix[(r0 + c) * DM + 512 + tid] = (bf16)f2bf(gelu_tanh(y) * h); }
}

constexpr int FL_Q = 0, FL_K = 17408, FL_V = 34816, FL_ST = 52224, FL_SC = 87040, FL_BC = 96256, FL_LR = 129024, FL_SEG = 133120, FL_RS = 135168;
__device__ __forceinline__ void gla_bcum(ArgsR A, int l, int h, LAS float* bc, LAS float* segt, const LAS float* lrs, int tid) {
    const int d = tid & 127, seg = tid >> 7;
    const float* w2 = A.in[I_GLA_W2] + (size_t)l * 16 * GW + h * HD + d; float w2c[16];
#pragma unroll
    for (int r = 0; r < 16; ++r) w2c[r] = w2[r * GW];
    const float b2 = A.in[I_GLA_B2][l * GW + h * HD + d]; float run = 0.f;
#pragma unroll 4
    for (int i = 0; i < 16; ++i) { const int c = seg * 16 + i; float z = b2;
#pragma unroll
        for (int r = 0; r < 16; ++r) z += lrs[c * 16 + r] * w2c[r];
        run += logsigmoidf_(z) * (1.0f / 16.0f); bc[c * 128 + d] = run; }
    segt[seg * 128 + d] = run;
}
__device__ __forceinline__ void f_gla_p2(ArgsR A, int l, int item, LAS unsigned char* lds, int tid) {
    const int n = item & 31, h = (item >> 5) & 3, b = item >> 7; const int lane = tid & 63, wave = __builtin_amdgcn_readfirstlane(tid >> 6);
    const bf16* P = (const bf16*)(A.ws + WS_P); const float* Ps = (const float*)(A.ws + WS_PS);
    float* inc = (float*)(A.ws + WS_GLA_INC) + (size_t)item * 16384; float* dec = (float*)(A.ws + WS_GLA_DEC) + (size_t)item * 128;
    LAS bf16* ks = (LAS bf16*)(lds + FL_K); LAS bf16* vs = (LAS bf16*)(lds + FL_V); LAS float* bc = (LAS float*)(lds + FL_BC); LAS float* lrs = (LAS float*)(lds + FL_LR); LAS float* segt = (LAS float*)(lds + FL_SEG);
    const size_t r0 = (size_t)b * SEQ + n * CHK;
    tile_g2l_128<64>(P + r0 * PBW + PC_GLA_K + h * HD, PBW, ks, tid);
    tile_g2l_128<64>(P + r0 * PBW + PC_GLA_V + h * HD, PBW, vs, tid);
    for (int i = tid; i < 64 * 16; i += NTHREADS) lrs[i] = Ps[(r0 + (i >> 4)) * 32 + PS_LR + (i & 15)];
    __syncthreads();
    gla_bcum(A, l, h, bc, segt, lrs, tid);
    __syncthreads();
    { const int d = tid & 127, seg = tid >> 7; float pre = 0.f, tot = 0.f;
#pragma unroll
        for (int s = 0; s < 4; ++s) { const float v = segt[s * 128 + d]; if (s < seg) pre += v; tot += v; }
#pragma unroll 4
        for (int i = 0; i < 16; ++i) { const int c = seg * 16 + i; const float bcm = bc[c * 128 + d] + pre; ks[c * LD128 + d] = (bf16)f2bf(bf2f(ks[c * LD128 + d]) * __expf(tot - bcm)); }
        if (seg == 0) dec[d] = __expf(tot); }
    __syncthreads();
    { f32x4 acc[8];
#pragma unroll
        for (int nt = 0; nt < 8; ++nt) acc[nt] = (f32x4){0.f, 0.f, 0.f, 0.f};
#pragma unroll
        for (int kk = 0; kk < 2; ++kk) { const bf16x8 af = frag_tr(vs, LD128, 32 * kk, 16 * wave, lane);
#pragma unroll
            for (int nt = 0; nt < 8; ++nt) acc[nt] = MFMA16(af, frag_tr(ks, LD128, 32 * kk, 16 * nt, lane), acc[nt]); }
        const int fr = lane & 15, fq = lane >> 4;
#pragma unroll
        for (int nt = 0; nt < 8; ++nt)
#pragma unroll
            for (int r = 0; r < 4; ++r) inc[(16 * wave + 4 * fq + r) * 128 + 16 * nt + fr] = acc[nt][r]; }
    __syncthreads();
}
__device__ __forceinline__ void f_gla_p3(ArgsR A, int item, int tid) {
    const int bh = item >> 4, sl = item & 15; const int e = sl * 1024 + tid * 2, d = e & 127;
    const float* inc = (const float*)(A.ws + WS_GLA_INC) + (size_t)bh * 32 * 16384 + e; const float* dec = (const float*)(A.ws + WS_GLA_DEC) + (size_t)bh * 32 * 128 + d;
    bf16* st = (bf16*)(A.ws + WS_GLA_ST) + (size_t)bh * 32 * 16384 + e;
    float s0 = 0.f, s1 = 0.f;
#pragma unroll 8
    for (int n = 0; n < NCHK; ++n) { *(GAS unsigned*)(st + (size_t)n * 16384) = pk2(s0, s1);
        const f32x2 iv = *(const GAS f32x2*)(inc + (size_t)n * 16384), dv = *(const GAS f32x2*)(dec + (size_t)n * 128); s0 = dv[0] * s0 + iv[0]; s1 = dv[1] * s1 + iv[1]; }
}
__device__ __forceinline__ void f_gla_p4(ArgsR A, int l, int item, LAS unsigned char* lds, int tid) {
    const int n = item & 31, h = (item >> 5) & 3, b = item >> 7; const int lane = tid & 63, wave = __builtin_amdgcn_readfirstlane(tid >> 6), fr = lane & 15, fq = lane >> 4;
    const bf16* P = (const bf16*)(A.ws + WS_P); const float* Ps = (const float*)(A.ws + WS_PS); bf16* mix = (bf16*)(A.ws + WS_MIX);
    const bf16* stg = (const bf16*)(A.ws + WS_GLA_ST) + (size_t)item * 16384;
    LAS bf16* qs = (LAS bf16*)(lds + FL_Q); LAS bf16* ks = (LAS bf16*)(lds + FL_K); LAS bf16* vs = (LAS bf16*)(lds + FL_V); LAS bf16* sts = (LAS bf16*)(lds + FL_ST); LAS bf16* scs = (LAS bf16*)(lds + FL_SC);
    LAS float* bc = (LAS float*)(lds + FL_BC); LAS float* lrs = (LAS float*)(lds + FL_LR); LAS float* segt = (LAS float*)(lds + FL_SEG); LAS float* rsp = (LAS float*)(lds + FL_RS);
    const size_t r0 = (size_t)b * SEQ + n * CHK;
    tile_g2l_128<64>(P + r0 * PBW + PC_GLA_Q + h * HD, PBW, qs, tid);
    tile_g2l_128<64>(P + r0 * PBW + PC_GLA_K + h * HD, PBW, ks, tid);
    tile_g2l_128<64>(P + r0 * PBW + PC_GLA_V + h * HD, PBW, vs, tid);
    tile_g2l_128<128>(stg, 128, sts, tid);
    for (int i = tid; i < 64 * 16; i += NTHREADS) lrs[i] = Ps[(r0 + (i >> 4)) * 32 + PS_LR + (i & 15)];
    __syncthreads();
    gla_bcum(A, l, h, bc, segt, lrs, tid);
    __syncthreads();
    { const int d = tid & 127, seg = tid >> 7; float pre = 0.f;
#pragma unroll
        for (int s = 0; s < 4; ++s) { const float v = segt[s * 128 + d]; if (s < seg) pre += v; }
#pragma unroll 4
        for (int i = 0; i < 16; ++i) { const int c = seg * 16 + i; const float bcm = bc[c * 128 + d] + pre;
            qs[c * LD128 + d] = (bf16)f2bf(bf2f(qs[c * LD128 + d]) * __expf(bcm) * 0.08838834764831845f); ks[c * LD128 + d] = (bf16)f2bf(bf2f(ks[c * LD128 + d]) * __expf(-bcm)); } }
    __syncthreads();
    { const int mt = wave >> 1; f32x4 acc[2] = {{0.f, 0.f, 0.f, 0.f}, {0.f, 0.f, 0.f, 0.f}};
#pragma unroll
        for (int kk = 0; kk < 4; ++kk) { const bf16x8 af = frag_rd(qs, LD128, 16 * mt, 32 * kk, lane);
#pragma unroll
            for (int q = 0; q < 2; ++q) acc[q] = MFMA16(af, frag_rd(ks, LD128, 16 * (2 * (wave & 1) + q), 32 * kk, lane), acc[q]); }
#pragma unroll
        for (int q = 0; q < 2; ++q) { const int s = 16 * (2 * (wave & 1) + q) + fr;
#pragma unroll
            for (int r = 0; r < 4; ++r) { const int c = 16 * mt + 4 * fq + r; scs[c * LD64 + s] = (bf16)f2bf(s <= c ? acc[q][r] : 0.f); } } }
    __syncthreads();
    f32x4 o[4];
#pragma unroll
    for (int mt = 0; mt < 4; ++mt) o[mt] = (f32x4){0.f, 0.f, 0.f, 0.f};
#pragma unroll
    for (int kk = 0; kk < 2; ++kk) { const bf16x8 bfv = frag_tr(vs, LD128, 32 * kk, 16 * wave, lane);
#pragma unroll
        for (int mt = 0; mt < 4; ++mt) o[mt] = MFMA16(frag_rd(scs, LD64, 16 * mt, 32 * kk, lane), bfv, o[mt]); }
#pragma unroll
    for (int kk = 0; kk < 4; ++kk) { const bf16x8 bfs = frag_rd(sts, LD128, 16 * wave, 32 * kk, lane);
#pragma unroll
        for (int mt = 0; mt < 4; ++mt) o[mt] = MFMA16(frag_rd(qs, LD128, 16 * mt, 32 * kk, lane), bfs, o[mt]); }
#pragma unroll
    for (int mt = 0; mt < 4; ++mt)
#pragma unroll
        for (int r = 0; r < 4; ++r) { float s = o[mt][r] * o[mt][r]; s += __shfl_xor(s, 1); s += __shfl_xor(s, 2); s += __shfl_xor(s, 4); s += __shfl_xor(s, 8);
            if (fr == 0) rsp[wave * 64 + 16 * mt + 4 * fq + r] = s; }
    __syncthreads();
    const float* ng = A.in[I_GLA_NG] + l * GW + h * HD; const float gn = ng[16 * wave + fr];
    float gt[4][4];
#pragma unroll
    for (int mt = 0; mt < 4; ++mt)
#pragma unroll
        for (int r = 0; r < 4; ++r) gt[mt][r] = bf2f(P[(r0 + 16 * mt + 4 * fq + r) * PBW + PC_GLA_G + h * HD + 16 * wave + fr]);
#pragma unroll
    for (int mt = 0; mt < 4; ++mt)
#pragma unroll
        for (int r = 0; r < 4; ++r) { const int c = 16 * mt + 4 * fq + r; float ss = 0.f;
#pragma unroll
            for (int w = 0; w < 8; ++w) ss += rsp[w * 64 + c];
            const float rs = rsqrtf(ss * (1.0f / 128.0f) + RMS_EPS);
            mix[(r0 + c) * DM + h * HD + 16 * wave + fr] = (bf16)f2bf(o[mt][r] * rs * gn * siluf_(gt[mt][r])); }
    __syncthreads();
}

constexpr int FM_Q2 = 96256, FM_S = 129024;
__device__ __forceinline__ void f_ml_p2(ArgsR A, int l, int item, LAS unsigned char* lds, int tid) {
    const int n = item & 31, h = (item >> 5) & 3, b = item >> 7; const int lane = tid & 63, wave = __builtin_amdgcn_readfirstlane(tid >> 6);
    const bf16* P = (const bf16*)(A.ws + WS_P); const float* Ps = (const float*)(A.ws + WS_PS);
    float* inc = (float*)(A.ws + WS_ML_INC) + (size_t)item * 16384; float* incn = (float*)(A.ws + WS_ML_N) + (size_t)item * 128; float* scg = (float*)(A.ws + WS_ML_SC) + (size_t)item * 2;
    LAS bf16* ks = (LAS bf16*)(lds + FL_K); LAS bf16* vs = (LAS bf16*)(lds + FL_V); LAS float* sc = (LAS float*)(lds + FM_S);
    const size_t r0 = (size_t)b * SEQ + n * CHK;
    tile_g2l_128<64>(P + r0 * PBW + PC_ML_K + h * HD, PBW, ks, tid);
    tile_g2l_128<64>(P + r0 * PBW + PC_ML_V + h * HD, PBW, vs, tid);
    if (wave == 0) { const float lf = logsigmoidf_(Ps[(r0 + lane) * 32 + PS_MF + h] + A.in[I_ML_FB][l * NH + h]), ig = Ps[(r0 + lane) * 32 + PS_MI + h] + A.in[I_ML_IB][l * NH + h];
        const float bcum = wave_scan_add(lf, lane), blast = __shfl(bcum, 63), le = blast - bcum + ig, mloc = wave_max(le);
        sc[lane] = __expf(le - mloc) * 0.08838834764831845f; if (lane == 0) { scg[0] = mloc; scg[1] = blast; } }
    __syncthreads();
#pragma unroll
    for (int i = 0; i < 2; ++i) { const int idx = tid + i * NTHREADS, r = idx >> 4, c8 = (idx & 15) * 8; const float w = sc[r];
        v4u x = *(LAS v4u*)(ks + r * LD128 + c8);
        x.x = pk2(bflo(x.x) * w, bfhi(x.x) * w); x.y = pk2(bflo(x.y) * w, bfhi(x.y) * w); x.z = pk2(bflo(x.z) * w, bfhi(x.z) * w); x.w = pk2(bflo(x.w) * w, bfhi(x.w) * w);
        *(LAS v4u*)(ks + r * LD128 + c8) = x; }
    __syncthreads();
    if (tid < 128) { float s = 0.f;
#pragma unroll 8
        for (int c = 0; c < 64; ++c) s += bf2f(ks[c * LD128 + tid]);
        incn[tid] = s; }
    { f32x4 acc[8];
#pragma unroll
        for (int nt = 0; nt < 8; ++nt) acc[nt] = (f32x4){0.f, 0.f, 0.f, 0.f};
#pragma unroll
        for (int kk = 0; kk < 2; ++kk) { const bf16x8 af = frag_tr(vs, LD128, 32 * kk, 16 * wave, lane);
#pragma unroll
            for (int nt = 0; nt < 8; ++nt) acc[nt] = MFMA16(af, frag_tr(ks, LD128, 32 * kk, 16 * nt, lane), acc[nt]); }
        const int fr = lane & 15, fq = lane >> 4;
#pragma unroll
        for (int nt = 0; nt < 8; ++nt)
#pragma unroll
            for (int r = 0; r < 4; ++r) inc[(16 * wave + 4 * fq + r) * 128 + 16 * nt + fr] = acc[nt][r]; }
    __syncthreads();
}
__device__ __forceinline__ void f_ml_p3(ArgsR A, int item, int tid) {
    const int bh = item >> 4, sl = item & 15; const int e = sl * 1024 + tid * 2;
    const float* inc = (const float*)(A.ws + WS_ML_INC) + (size_t)bh * 32 * 16384 + e; const float* incn = (const float*)(A.ws + WS_ML_N) + (size_t)bh * 32 * 128;
    const float* scg = (const float*)(A.ws + WS_ML_SC) + (size_t)bh * 32 * 2;
    bf16* st = (bf16*)(A.ws + WS_ML_ST) + (size_t)bh * 32 * 16384 + e; float* np = (float*)(A.ws + WS_ML_NP) + (size_t)bh * 32 * 128; float* mp = (float*)(A.ws + WS_ML_MP) + (size_t)bh * 32;
    float c0 = 0.f, c1 = 0.f, nv = 0.f, m = 0.f; const int dn = sl * 8 + tid;
#pragma unroll 4
    for (int n = 0; n < NCHK; ++n) {
        *(GAS unsigned*)(st + (size_t)n * 16384) = pk2(c0, c1);
        if (tid < 8) np[n * 128 + dn] = nv;
        if (sl == 0 && tid == 0) mp[n] = m;
        const float ml = scg[2 * n], bl = scg[2 * n + 1]; const float mn = fmaxf(bl + m, ml), ao = __expf(bl + m - mn), ai = __expf(ml - mn);
        const f32x2 iv = *(const GAS f32x2*)(inc + (size_t)n * 16384); c0 = ao * c0 + ai * iv[0]; c1 = ao * c1 + ai * iv[1];
        if (tid < 8) nv = ao * nv + ai * incn[n * 128 + dn];
        m = mn; }
}
__device__ __forceinline__ void f_ml_p4(ArgsR A, int l, int item, LAS unsigned char* lds, int tid) {
    const int n = item & 31, h = (item >> 5) & 3, b = item >> 7; const int lane = tid & 63, wave = __builtin_amdgcn_readfirstlane(tid >> 6), fr = lane & 15, fq = lane >> 4;
    const bf16* P = (const bf16*)(A.ws + WS_P); const float* Ps = (const float*)(A.ws + WS_PS); bf16* mix = (bf16*)(A.ws + WS_MIX);
    const bf16* stg = (const bf16*)(A.ws + WS_ML_ST) + (size_t)item * 16384; const float* npg = (const float*)(A.ws + WS_ML_NP) + (size_t)item * 128; const float mprev = ((const float*)(A.ws + WS_ML_MP))[item];
    LAS bf16* qs = (LAS bf16*)(lds + FL_Q); LAS bf16* ks = (LAS bf16*)(lds + FL_K); LAS bf16* vs = (LAS bf16*)(lds + FL_V); LAS bf16* sts = (LAS bf16*)(lds + FL_ST); LAS bf16* scs = (LAS bf16*)(lds + FL_SC);
    LAS bf16* q2 = (LAS bf16*)(lds + FM_Q2); LAS float* sc = (LAS float*)(lds + FM_S); LAS float* rsp = (LAS float*)(lds + FL_RS + 4096);
    const size_t r0 = (size_t)b * SEQ + n * CHK;
    tile_g2l_128<64>(P + r0 * PBW + PC_ML_Q + h * HD, PBW, qs, tid);
    tile_g2l_128<64>(P + r0 * PBW + PC_ML_K + h * HD, PBW, ks, tid);
    tile_g2l_128<64>(P + r0 * PBW + PC_ML_V + h * HD, PBW, vs, tid);
    tile_g2l_128<128>(stg, 128, sts, tid);
    if (wave == 0) { const float lf = logsigmoidf_(Ps[(r0 + lane) * 32 + PS_MF + h] + A.in[I_ML_FB][l * NH + h]), ig = Ps[(r0 + lane) * 32 + PS_MI + h] + A.in[I_ML_IB][l * NH + h];
        const float bcum = wave_scan_add(lf, lane), as = ig - bcum, pm = wave_scan_max(as, lane);
        const float mintra = bcum + pm, minter = bcum + mprev, mt = fmaxf(mintra, minter);
        sc[lane] = bcum - mt; sc[64 + lane] = as; sc[128 + lane] = __expf(minter - mt); sc[192 + lane] = __expf(-mt); }
    if (wave == 1) { sc[320 + lane] = npg[lane]; sc[384 + lane] = npg[64 + lane]; }
    __syncthreads();
#pragma unroll
    for (int i = 0; i < 2; ++i) { const int idx = tid + i * NTHREADS, r = idx >> 4, c8 = (idx & 15) * 8; const float w = sc[128 + r];
        v4u x = *(LAS v4u*)(qs + r * LD128 + c8);
        x.x = pk2(bflo(x.x) * w, bfhi(x.x) * w); x.y = pk2(bflo(x.y) * w, bfhi(x.y) * w); x.z = pk2(bflo(x.z) * w, bfhi(x.z) * w); x.w = pk2(bflo(x.w) * w, bfhi(x.w) * w);
        *(LAS v4u*)(q2 + r * LD128 + c8) = x; }
    { const int mt = wave >> 1; f32x4 acc[2] = {{0.f, 0.f, 0.f, 0.f}, {0.f, 0.f, 0.f, 0.f}};
#pragma unroll
        for (int kk = 0; kk < 4; ++kk) { const bf16x8 af = frag_rd(qs, LD128, 16 * mt, 32 * kk, lane);
#pragma unroll
            for (int q = 0; q < 2; ++q) acc[q] = MFMA16(af, frag_rd(ks, LD128, 16 * (2 * (wave & 1) + q), 32 * kk, lane), acc[q]); }
#pragma unroll
        for (int q = 0; q < 2; ++q) { const int s = 16 * (2 * (wave & 1) + q) + fr; const float asv = sc[64 + s];
#pragma unroll
            for (int r = 0; r < 4; ++r) { const int c = 16 * mt + 4 * fq + r; scs[c * LD64 + s] = (bf16)f2bf(s <= c ? acc[q][r] * 0.08838834764831845f * __expf(sc[c] + asv) : 0.f); } } }
    __syncthreads();
    { const int c = tid >> 3, part = tid & 7; float s = 0.f;
#pragma unroll
        for (int i = 0; i < 8; ++i) s += bf2f(scs[c * LD64 + part * 8 + i]);
#pragma unroll
        for (int i = 0; i < 16; ++i) s += bf2f(q2[c * LD128 + part * 16 + i]) * sc[320 + part * 16 + i];
        s += __shfl_xor(s, 1); s += __shfl_xor(s, 2); s += __shfl_xor(s, 4);
        if (part == 0) sc[256 + c] = fmaxf(fabsf(s), sc[192 + c]); }
    f32x4 o[4];
#pragma unroll
    for (int mt = 0; mt < 4; ++mt) o[mt] = (f32x4){0.f, 0.f, 0.f, 0.f};
#pragma unroll
    for (int kk = 0; kk < 2; ++kk) { const bf16x8 bfv = frag_tr(vs, LD128, 32 * kk, 16 * wave, lane);
#pragma unroll
        for (int mt = 0; mt < 4; ++mt) o[mt] = MFMA16(frag_rd(scs, LD64, 16 * mt, 32 * kk, lane), bfv, o[mt]); }
#pragma unroll
    for (int kk = 0; kk < 4; ++kk) { const bf16x8 bfs = frag_rd(sts, LD128, 16 * wave, 32 * kk, lane);
#pragma unroll
        for (int mt = 0; mt < 4; ++mt) o[mt] = MFMA16(frag_rd(q2, LD128, 16 * mt, 32 * kk, lane), bfs, o[mt]); }
    __syncthreads();
#pragma unroll
    for (int mt = 0; mt < 4; ++mt)
#pragma unroll
        for (int r = 0; r < 4; ++r) { const int c = 16 * mt + 4 * fq + r; const float og = bf2f(P[(r0 + c) * PBW + PC_ML_O + h * HD + 16 * wave + fr]);
            const float hv = o[mt][r] / sc[256 + c] * sigmoidf_(og); o[mt][r] = hv;
            float s = hv * hv; s += __shfl_xor(s, 1); s += __shfl_xor(s, 2); s += __shfl_xor(s, 4); s += __shfl_xor(s, 8);
            if (fr == 0) rsp[wave * 64 + c] = s; }
    __syncthreads();
    const float* ng = A.in[I_ML_NG] + l * GW + h * HD; const float gn = ng[16 * wave + fr];
#pragma unroll
    for (int mt = 0; mt < 4; ++mt)
#pragma unroll
        for (int r = 0; r < 4; ++r) { const int c = 16 * mt + 4 * fq + r; float ss = 0.f;
#pragma unroll
            for (int w = 0; w < 8; ++w) ss += rsp[w * 64 + c];
            mix[(r0 + c) * DM + 1024 + h * HD + 16 * wave + fr] = (bf16)f2bf(o[mt][r] * rsqrtf(ss * (1.0f / 128.0f) + RMS_EPS) * gn); }
    __syncthreads();
}

constexpr int FG_LM = 52224, FG_S = 129024, FG_RAW = 68608, FG_RAWT = 9216  ;
template <int C> struct GdnSolve {
    static __device__ __forceinline__ void run(float (&sol)[64], const LAS float* Lm) {
        if constexpr (C < 64) {
            float a0 = sol[C], a1 = 0.f, a2 = 0.f, a3 = 0.f;
#pragma unroll
            for (int s = 0; s < C; ++s) { const float t = Lm[C * 64 + s] * sol[s]; if ((s & 3) == 0) a0 -= t; else if ((s & 3) == 1) a1 -= t; else if ((s & 3) == 2) a2 -= t; else a3 -= t; }
            sol[C] = (a0 + a1) + (a2 + a3);
            GdnSolve<C + 1>::run(sol, Lm);
        }
    }
};
__device__ __forceinline__ void f_gdn_p2(ArgsR A, int l, int item, LAS unsigned char* lds, int tid) {
    const int n = item & 31, h = (item >> 5) & 3, b = item >> 7; const int lane = tid & 63, wave = __builtin_amdgcn_readfirstlane(tid >> 6), fr = lane & 15, fq = lane >> 4;
    const bf16* P = (const bf16*)(A.ws + WS_P); const float* Ps = (const float*)(A.ws + WS_PS);
    bf16* U0 = (bf16*)(A.ws + WS_GDN_U0) + (size_t)item * 8192; bf16* Wg = (bf16*)(A.ws + WS_GDN_W) + (size_t)item * 8192; bf16* QD = (bf16*)(A.ws + WS_GDN_QD) + (size_t)item * 8192;
    bf16* KE = (bf16*)(A.ws + WS_GDN_KE) + (size_t)item * 8192; bf16* QK = (bf16*)(A.ws + WS_GDN_QK) + (size_t)item * 4096; float* DE = (float*)(A.ws + WS_GDN_DE);
    LAS bf16* qs = (LAS bf16*)(lds + FL_Q); LAS bf16* ks = (LAS bf16*)(lds + FL_K); LAS bf16* vs = (LAS bf16*)(lds + FL_V); LAS float* Lm = (LAS float*)(lds + FG_LM); LAS float* sc = (LAS float*)(lds + FG_S);
    const float* cw = A.in[I_GDN_CW] + (size_t)l * 4 * 1536;
    const size_t r0 = (size_t)b * SEQ + n * CHK;
    { LAS bf16* raw = (LAS bf16*)(lds + FG_RAW);
#pragma unroll
        for (int i = 0; i < 7; ++i) { const int idx = tid + i * NTHREADS; if (idx < 3 * 67 * 16) { const int part = idx / (67 * 16), pi = idx % (67 * 16), rr = pi >> 4, c8 = (pi & 15) * 8;
            const int pc = (part == 0 ? PC_GDN_Q : part == 1 ? PC_GDN_K : PC_GDN_V) + h * HD + c8; v4u w = {0u, 0u, 0u, 0u};
            if (n > 0 || rr >= 3) w = *(const GAS v4u*)(P + (r0 + rr - 3) * PBW + pc);
            *(LAS v4u*)(raw + part * FG_RAWT + rr * LD128 + c8) = w; } }
        __syncthreads();
        const int v = tid & 127, dq = tid >> 7;
#pragma unroll
        for (int part = 0; part < 3; ++part) {
            const int wc = part * 512 + h * HD + v;
            const float w0 = cw[wc], w1 = cw[1536 + wc], w2 = cw[2 * 1536 + wc], w3 = cw[3 * 1536 + wc];
            LAS bf16* dst = part == 0 ? qs : part == 1 ? ks : vs; const LAS bf16* src = raw + part * FG_RAWT + v;
            const int c0 = dq * 16;
            float xm3 = bf2f(src[(c0 + 0) * LD128]), xm2 = bf2f(src[(c0 + 1) * LD128]), xm1 = bf2f(src[(c0 + 2) * LD128]);
#pragma unroll
            for (int i = 0; i < 16; ++i) { const float x0 = bf2f(src[(c0 + i + 3) * LD128]); const float y = w0 * xm3 + w1 * xm2 + w2 * xm1 + w3 * x0;
                dst[(c0 + i) * LD128 + v] = (bf16)f2bf(siluf_(y)); xm3 = xm2; xm2 = xm1; xm1 = x0; } } }
    if (wave == 0) { const float bt = sigmoidf_(Ps[(r0 + lane) * 32 + PS_GB + h]);
        const float g = -__expf(A.in[I_GDN_ALOG][l * NH + h]) * softplusf_(Ps[(r0 + lane) * 32 + PS_GA + h] + A.in[I_GDN_DTB][l * NH + h]);
        const float gam = wave_scan_add(g, lane); sc[lane] = bt; sc[64 + lane] = gam; if (lane == 63) DE[item] = __expf(gam); }
    __syncthreads();
#pragma unroll 1
    for (int rr = 0; rr < 8; ++rr) { const int c = wave * 8 + rr;
        const float q1 = bf2f(qs[c * LD128 + lane]), q2 = bf2f(qs[c * LD128 + 64 + lane]), k1 = bf2f(ks[c * LD128 + lane]), k2 = bf2f(ks[c * LD128 + 64 + lane]);
        const float sq = wave_sum(q1 * q1 + q2 * q2), sk = wave_sum(k1 * k1 + k2 * k2);
        if (lane == 0) { sc[128 + c] = rsqrtf(sq + 1e-6f) * 0.08838834764831845f; sc[192 + c] = rsqrtf(sk + 1e-6f); } }
    __syncthreads();
    { const int mt = wave >> 1; f32x4 akk[2] = {{0.f, 0.f, 0.f, 0.f}, {0.f, 0.f, 0.f, 0.f}}, aqk[2] = {{0.f, 0.f, 0.f, 0.f}, {0.f, 0.f, 0.f, 0.f}};
#pragma unroll
        for (int kk = 0; kk < 4; ++kk) { const bf16x8 ak = frag_rd(ks, LD128, 16 * mt, 32 * kk, lane), aq = frag_rd(qs, LD128, 16 * mt, 32 * kk, lane);
#pragma unroll
            for (int q = 0; q < 2; ++q) { const bf16x8 bk = frag_rd(ks, LD128, 16 * (2 * (wave & 1) + q), 32 * kk, lane); akk[q] = MFMA16(ak, bk, akk[q]); aqk[q] = MFMA16(aq, bk, aqk[q]); } }
#pragma unroll
        for (int q = 0; q < 2; ++q) { const int s = 16 * (2 * (wave & 1) + q) + fr; const float rks = sc[192 + s], gs = sc[64 + s];
#pragma unroll
            for (int r = 0; r < 4; ++r) { const int c = 16 * mt + 4 * fq + r; const float dcy = __expf(sc[64 + c] - gs);
                Lm[c * 64 + s] = (s < c) ? sc[c] * akk[q][r] * sc[192 + c] * rks * dcy : 0.f;
                QK[c * 64 + s] = (bf16)f2bf((s <= c) ? aqk[q][r] * sc[128 + c] * rks * dcy : 0.f); } } }
    __syncthreads();
    if (tid < 256) {
        float sol[64]; const bool isw = tid >= 128; const int j = tid & 127;
#pragma unroll
        for (int c = 0; c < 64; ++c) { const float bt = sc[c]; sol[c] = isw ? bf2f(ks[c * LD128 + j]) * sc[192 + c] * bt * __expf(sc[64 + c]) : bf2f(vs[c * LD128 + j]) * bt; }
        GdnSolve<1>::run(sol, Lm);
        bf16* dst = isw ? Wg : U0;
#pragma unroll
        for (int c = 0; c < 64; ++c) dst[c * 128 + j] = (bf16)f2bf(sol[c]);
    } else {
        const int t2 = tid - 256; const float glast = sc[64 + 63];
#pragma unroll
        for (int i = 0; i < 8; ++i) { const int idx = t2 + i * 256, which = idx >> 10, pi = idx & 1023, r = pi >> 4, c8 = (pi & 15) * 8;
            const float w = which == 0 ? sc[128 + r] * __expf(sc[64 + r]) : sc[192 + r] * __expf(glast - sc[64 + r]);
            v4u x = *(LAS v4u*)((which == 0 ? qs : ks) + r * LD128 + c8);
            x.x = pk2(bflo(x.x) * w, bfhi(x.x) * w); x.y = pk2(bflo(x.y) * w, bfhi(x.y) * w); x.z = pk2(bflo(x.z) * w, bfhi(x.z) * w); x.w = pk2(bflo(x.w) * w, bfhi(x.w) * w);
            *(GAS v4u*)((which == 0 ? QD : KE) + r * 128 + c8) = x; }
    }
    __syncthreads();
}

constexpr int FC_W = 0, FC_QD = 17408, FC_KE = 34816, FC_U0 = 52224, FC_QK = 69632, FC_RS = 78848  ;
__device__ __forceinline__ void f_gdn_p3(ArgsR A, int l, int bh, LAS unsigned char* lds, int tid) {
    const int lane = tid & 63, wave = __builtin_amdgcn_readfirstlane(tid >> 6), fr = lane & 15, fq = lane >> 4; const int b = bh >> 2, h = bh & 3;
    const bf16* U0 = (const bf16*)(A.ws + WS_GDN_U0) + (size_t)bh * 32 * 8192; const bf16* Wg = (const bf16*)(A.ws + WS_GDN_W) + (size_t)bh * 32 * 8192; const bf16* QD = (const bf16*)(A.ws + WS_GDN_QD) + (size_t)bh * 32 * 8192;
    const bf16* KE = (const bf16*)(A.ws + WS_GDN_KE) + (size_t)bh * 32 * 8192; const bf16* QK = (const bf16*)(A.ws + WS_GDN_QK) + (size_t)bh * 32 * 4096; const float* DE = (const float*)(A.ws + WS_GDN_DE) + bh * 32;
    const bf16* P = (const bf16*)(A.ws + WS_P); bf16* mix = (bf16*)(A.ws + WS_MIX); LAS float* rsp = (LAS float*)(lds + FC_RS);
    const float gn = A.in[I_GDN_NG][l * GW + h * HD + 16 * wave + fr];
    LAS bf16* ws_ = (LAS bf16*)(lds + FC_W); LAS bf16* qds = (LAS bf16*)(lds + FC_QD); LAS bf16* kes = (LAS bf16*)(lds + FC_KE); LAS bf16* u0s = (LAS bf16*)(lds + FC_U0); LAS bf16* qks = (LAS bf16*)(lds + FC_QK);
    f32x4 S[8];
#pragma unroll
    for (int i = 0; i < 8; ++i) S[i] = (f32x4){0.f, 0.f, 0.f, 0.f};
    v4u st[9];
    auto issue = [&](int n) {
#pragma unroll
        for (int i = 0; i < 8; ++i) { const int idx = tid + i * NTHREADS, which = idx >> 10, pi = idx & 1023;
            const bf16* src = (which == 0 ? Wg : which == 1 ? QD : which == 2 ? KE : U0) + (size_t)n * 8192; st[i] = *(const GAS v4u*)(src + pi * 8); }
        st[8] = *(const GAS v4u*)(QK + (size_t)n * 4096 + tid * 8);
    };
    auto commit = [&]() {
#pragma unroll
        for (int i = 0; i < 8; ++i) { const int idx = tid + i * NTHREADS, which = idx >> 10, pi = idx & 1023, r = pi >> 4, c8 = (pi & 15) * 8;
            *(LAS v4u*)((LAS bf16*)(lds + which * 17408) + r * LD128 + c8) = st[i]; }
        { const int r = tid >> 3, c8 = (tid & 7) * 8; *(LAS v4u*)(qks + r * LD64 + c8) = st[8]; }
    };
    issue(0);
#pragma unroll 1
    for (int n = 0; n < NCHK; ++n) {
        __syncthreads();
        commit();
        __syncthreads();
        if (n + 1 < NCHK) issue(n + 1);
        const float de = DE[n];
        bf16x8 SB[4];
#pragma unroll
        for (int kb = 0; kb < 4; ++kb) SB[kb] = pack_acc(S[2 * kb], S[2 * kb + 1]);
        f32x4 u[4], o[4];
#pragma unroll
        for (int mt = 0; mt < 4; ++mt) { f32x4 ws2 = {0.f, 0.f, 0.f, 0.f}; o[mt] = (f32x4){0.f, 0.f, 0.f, 0.f};
#pragma unroll
            for (int kb = 0; kb < 4; ++kb) { ws2 = MFMA16(frag_rd_perm(ws_, LD128, 16 * mt, 32 * kb, lane), SB[kb], ws2); o[mt] = MFMA16(frag_rd_perm(qds, LD128, 16 * mt, 32 * kb, lane), SB[kb], o[mt]); }
#pragma unroll
            for (int r = 0; r < 4; ++r) u[mt][r] = bf2f(u0s[(16 * mt + 4 * fq + r) * LD128 + 16 * wave + fr]) - ws2[r]; }
        const bf16x8 UB0 = pack_acc(u[0], u[1]), UB1 = pack_acc(u[2], u[3]);
#pragma unroll
        for (int mt = 0; mt < 4; ++mt) { o[mt] = MFMA16(frag_rd_perm(qks, LD64, 16 * mt, 0, lane), UB0, o[mt]); o[mt] = MFMA16(frag_rd_perm(qks, LD64, 16 * mt, 32, lane), UB1, o[mt]); }
#pragma unroll
        for (int dt = 0; dt < 8; ++dt) { f32x4 sn = S[dt] * de;
            sn = MFMA16(frag_tr_perm(kes, LD128, 0, 16 * dt, lane), UB0, sn); sn = MFMA16(frag_tr_perm(kes, LD128, 32, 16 * dt, lane), UB1, sn); S[dt] = sn; }
        const size_t r0 = (size_t)b * SEQ + n * CHK;
        float gt[4][4];
#pragma unroll
        for (int mt = 0; mt < 4; ++mt)
#pragma unroll
            for (int r = 0; r < 4; ++r) gt[mt][r] = bf2f(P[(r0 + 16 * mt + 4 * fq + r) * PBW + PC_GDN_G + h * HD + 16 * wave + fr]);
        LAS float* rs_ = rsp + (n & 1) * 512;
#pragma unroll
        for (int mt = 0; mt < 4; ++mt)
#pragma unroll
            for (int r = 0; r < 4; ++r) { float s = o[mt][r] * o[mt][r]; s += __shfl_xor(s, 1); s += __shfl_xor(s, 2); s += __shfl_xor(s, 4); s += __shfl_xor(s, 8);
                if (fr == 0) rs_[wave * 64 + 16 * mt + 4 * fq + r] = s; }
        __syncthreads();
#pragma unroll
        for (int mt = 0; mt < 4; ++mt)
#pragma unroll
            for (int r = 0; r < 4; ++r) { const int c = 16 * mt + 4 * fq + r; float ss = 0.f;
#pragma unroll
                for (int w = 0; w < 8; ++w) ss += rs_[w * 64 + c];
                mix[(r0 + c) * DM + 1536 + h * HD + 16 * wave + fr] = (bf16)f2bf(o[mt][r] * rsqrtf(ss * (1.0f / 128.0f) + RMS_EPS) * gn * siluf_(gt[mt][r])); }
    }
    __syncthreads();
}

constexpr int PE_SC = 0, PE_TV = 66560, PE_TI = 75264, PE_SEL = 83968;
constexpr int SC_LD = 129, TL_LD = 17;
#ifndef TAB_FP8
#define TAB_FP8 1
#endif
constexpr size_t WS_TSC = 93 * MiB + 256 * 1024;


__device__ __forceinline__ void tab_convert(ArgsR A, int l, int gw, int NGW, int lane) {
    unsigned char* ws = A.ws; float* tsc = (float*)(ws + WS_TSC);
#pragma unroll 1
    for (int q = gw; q < 2 * NEXP; q += NGW) {
        const int t = q / NEXP, rr = l * NEXP + q % NEXP, r = t * DEPTH * NEXP + rr;
        const float* src = A.in[t ? I_PV : I_PU] + (size_t)rr * DM;
        f32x4 v[8];
#pragma unroll
        for (int i = 0; i < 8; ++i) v[i] = *(const GAS f32x4*)(src + 4 * (lane + 64 * i));
        unsigned char* dst = ws + (t ? WS_VB : WS_UB) + (size_t)(rr / NEXP) * TAB_L + (size_t)(rr % NEXP) * DM * (TAB_FP8 ? 1 : 2);
#if TAB_FP8
        float am = 0.f;
#pragma unroll
        for (int i = 0; i < 8; ++i) am = fmaxf(fmaxf(am, fmaxf(fabsf(v[i][0]), fabsf(v[i][1]))), fmaxf(fabsf(v[i][2]), fabsf(v[i][3])));
        am = wave_max(am); const float sc = am > 0.f ? 256.0f / am : 1.0f;
#pragma unroll
        for (int i = 0; i < 8; ++i) { int p = 0; p = __builtin_amdgcn_cvt_pk_fp8_f32(v[i][0] * sc, v[i][1] * sc, p, false); p = __builtin_amdgcn_cvt_pk_fp8_f32(v[i][2] * sc, v[i][3] * sc, p, true);
            *(GAS unsigned*)(dst + 4 * (lane + 64 * i)) = (unsigned)p; }
        if (lane == 0) tsc[r] = am > 0.f ? am * (1.0f / 256.0f) : 1.0f;
#else
#pragma unroll
        for (int i = 0; i < 8; ++i) { v2u w; w.x = pk2(v[i][0], v[i][1]); w.y = pk2(v[i][2], v[i][3]); *(GAS v2u*)(dst + 8 * (lane + 64 * i)) = w; }
#endif
    }
}
__device__ __forceinline__ f32x2 cvt8_lo(unsigned dw) { f32x2 r; asm volatile("v_cvt_pk_f32_fp8 %0, %1" : "=v"(r) : "v"(dw)); return r; }
__device__ __forceinline__ f32x2 cvt8_hi(unsigned dw) { f32x2 r; asm volatile("v_cvt_pk_f32_fp8_sdwa %0, %1 src0_sel:WORD_1" : "=v"(r) : "v"(dw)); return r; }
#define TOUCH16(a, o) asm volatile("" : "+v"(a[(o)+0]), "+v"(a[(o)+1]), "+v"(a[(o)+2]), "+v"(a[(o)+3]), "+v"(a[(o)+4]), "+v"(a[(o)+5]), "+v"(a[(o)+6]), "+v"(a[(o)+7]), "+v"(a[(o)+8]), "+v"(a[(o)+9]), "+v"(a[(o)+10]), "+v"(a[(o)+11]), "+v"(a[(o)+12]), "+v"(a[(o)+13]), "+v"(a[(o)+14]), "+v"(a[(o)+15]))
__device__ __forceinline__ float dot2bf(unsigned a, unsigned b, float c) { asm("v_dot2c_f32_bf16 %0, %1, %2" : "+v"(c) : "v"(a), "v"(b)); return c; }
__device__ __forceinline__ unsigned f2sortable(float f) { const unsigned u = __builtin_bit_cast(unsigned, f); return (u & 0x80000000u) ? ~u : (u | 0x80000000u); }

template <int CTRL> __device__ __forceinline__ unsigned dpp_rot_u(unsigned v) { return (unsigned)__builtin_amdgcn_update_dpp(0, (int)v, CTRL, 0xf, 0xf, false); }
__device__ __forceinline__ unsigned row_max_u(unsigned v) { v = max(v, dpp_rot_u<0x121>(v)); v = max(v, dpp_rot_u<0x122>(v)); v = max(v, dpp_rot_u<0x124>(v)); v = max(v, dpp_rot_u<0x128>(v)); return v; }
__device__ __forceinline__ float row_max_f(float v) { v = fmaxf(v, __builtin_bit_cast(float, dpp_rot_u<0x121>(__builtin_bit_cast(unsigned, v)))); v = fmaxf(v, __builtin_bit_cast(float, dpp_rot_u<0x122>(__builtin_bit_cast(unsigned, v))));
    v = fmaxf(v, __builtin_bit_cast(float, dpp_rot_u<0x124>(__builtin_bit_cast(unsigned, v)))); v = fmaxf(v, __builtin_bit_cast(float, dpp_rot_u<0x128>(__builtin_bit_cast(unsigned, v)))); return v; }
__device__ __forceinline__ float row_sum_f(float v) { v += __builtin_bit_cast(float, dpp_rot_u<0x121>(__builtin_bit_cast(unsigned, v))); v += __builtin_bit_cast(float, dpp_rot_u<0x122>(__builtin_bit_cast(unsigned, v)));
    v += __builtin_bit_cast(float, dpp_rot_u<0x124>(__builtin_bit_cast(unsigned, v))); v += __builtin_bit_cast(float, dpp_rot_u<0x128>(__builtin_bit_cast(unsigned, v))); return v; }
__device__ __forceinline__ float unsortable(unsigned k) { const unsigned u = (k & 0x80000000u) ? (k & 0x7fffffffu) : ~k; return __builtin_bit_cast(float, u); }
template <bool DRY>
__device__ __forceinline__ void peer_phase(ArgsR A, int l, bool last, LAS unsigned char* lds, int G, int tid) {
    const int wave = __builtin_amdgcn_readfirstlane(tid >> 6), lane = tid & 63;
    unsigned char* ws = A.ws;
    const bf16* Q = (const bf16*)(ws + WS_Q);
    const bf16* K1 = (const bf16*)(ws + WS_K1) + (size_t)l * 8 * 128 * 128; const bf16* K2 = (const bf16*)(ws + WS_K2) + (size_t)l * 8 * 128 * 128;
    const unsigned char* Ub = ws + WS_UB + (size_t)l * TAB_L; const unsigned char* Vb = ws + WS_VB + (size_t)l * TAB_L;
    const float* ssp = (const float*)(ws + WS_SSP); const float* X = A.out; float* XO = DRY ? (float*)(ws + WS_P) : A.out; bf16* xb = (bf16*)(ws + (DRY ? WS_MIX : WS_XB)); float* rstd1 = (float*)(ws + (DRY ? WS_PS : WS_RSTD1));
    const float* g2 = A.in[I_N2G] + l * DM; const float* gf = A.in[I_FNG];
    LAS unsigned* keysL = (LAS unsigned*)(lds + PE_SC); LAS unsigned* cab = (LAS unsigned*)(lds + PE_SC + 16384); LAS v2u* sel = (LAS v2u*)(lds + PE_SEL);
    if (tid < 64) { int a = 0, b = tid, found = 0;
        for (int aa = 0, base = 0; aa < 16; ++aa) { const int nbb = 16 / (aa + 1); if (!found && tid < base + nbb) { a = aa; b = tid - base; found = 1; } base += nbb; }
        cab[tid] = found ? (unsigned)(a * 16 + b) : 0xffu; }
    __syncthreads();
#pragma unroll 1
    for (int item = blockIdx.x; item < NT / 32; item += G) {
        const int tok0 = item * 32;
#pragma unroll 1
        for (int pass = 0; pass < 4; ++pass) {
            LAS unsigned* kl = keysL + (pass & 1) * 2048;
            { const int hh = wave >> 2, side = (wave >> 1) & 1, mt = wave & 1, h = 2 * pass + hh, fr = lane & 15, fq = lane >> 4;
                const bf16* qa = Q + (size_t)(tok0 + 16 * mt + fr) * DM + h * 256 + side * 128 + 8 * fq;
                const bf16* kb = (side ? K2 : K1) + (size_t)h * 128 * 128 + (size_t)fr * 128 + 8 * fq;
                bf16x8 af[4];
#pragma unroll
                for (int ks = 0; ks < 4; ++ks) af[ks] = *(const GAS bf16x8*)(qa + 32 * ks);
                unsigned key[8][4];
#pragma unroll
                for (int nt = 0; nt < 8; ++nt) { f32x4 acc = {0.f, 0.f, 0.f, 0.f};
#pragma unroll
                    for (int ks = 0; ks < 4; ++ks) { const bf16x8 bfr = *(const GAS bf16x8*)(kb + (size_t)nt * 16 * 128 + 32 * ks); acc = __builtin_amdgcn_mfma_f32_16x16x32_bf16(af[ks], bfr, acc, 0, 0, 0); }
#pragma unroll
                    for (int r = 0; r < 4; ++r) key[nt][r] = (f2sortable(acc[r]) & ~127u) | (unsigned)(nt * 16 + fr); }
                unsigned res[4] = {0u, 0u, 0u, 0u};
#pragma unroll 1
                for (int j = 0; j < 16; ++j) {
#pragma unroll
                    for (int r = 0; r < 4; ++r) {
                        unsigned m = max(max(max(key[0][r], key[1][r]), max(key[2][r], key[3][r])), max(max(key[4][r], key[5][r]), max(key[6][r], key[7][r])));
                        const unsigned w = row_max_u(m);
#pragma unroll
                        for (int nt = 0; nt < 8; ++nt) key[nt][r] = (key[nt][r] == w) ? 0u : key[nt][r];
                        res[r] = (fr == j) ? w : res[r]; } }
                const int rowb = (hh * 2 + side) * 32 + 16 * mt + 4 * fq;
#pragma unroll
                for (int r = 0; r < 4; ++r) kl[(rowb + r) * 16 + fr] = res[r]; }
            __syncthreads();
#pragma unroll 1
            for (int rnd = 0; rnd < 2; ++rnd) { const int fr = lane & 15, fq = lane >> 4, pidx = rnd * 32 + wave * 4 + fq, hh = pidx >> 5, tk = pidx & 31, h = 2 * pass + hh;
                const LAS unsigned* k1 = kl + ((hh * 2) * 32 + tk) * 16; const LAS unsigned* k2 = k1 + 32 * 16;
                unsigned ck[4];
#pragma unroll
                for (int sl = 0; sl < 4; ++sl) { const int ci = fr + 16 * sl; const unsigned ab = cab[ci];
                    const float v = unsortable(k1[(ab >> 4) & 15] & ~127u) + unsortable(k2[ab & 15] & ~127u);
                    ck[sl] = (ab == 0xffu) ? 0u : ((f2sortable(v) & ~63u) | (unsigned)ci); }
                unsigned rk = 0u;
#pragma unroll 1
                for (int j = 0; j < 16; ++j) { const unsigned w = row_max_u(max(max(ck[0], ck[1]), max(ck[2], ck[3])));
#pragma unroll
                    for (int sl = 0; sl < 4; ++sl) ck[sl] = (ck[sl] == w) ? 0u : ck[sl];
                    rk = (fr == j) ? w : rk; }
                const unsigned ab = cab[rk & 63u]; const float v = unsortable(rk & ~63u);
                const float vmax = row_max_f(v), e = __expf(v - vmax), den = row_sum_f(e);
                v2u wv; wv.x = (k1[(ab >> 4) & 15] & 127u) * 128u + (k2[ab & 15] & 127u); wv.y = __builtin_bit_cast(unsigned, e * rcpf_(den));
                sel[(tk * 8 + h) * 16 + fr] = wv; }
        }
        __syncthreads();
#if TAB_FP8
        const float* tscU = (const float*)(ws + WS_TSC) + (size_t)l * NEXP; const float* tscV = tscU + (size_t)DEPTH * NEXP;
#pragma unroll 1
        for (int tt = 0; tt < 4; ++tt) {
            const int tl = wave * 4 + tt; const size_t t = (size_t)tok0 + tl;
            float s2 = (lane < 32) ? ssp[t * 32 + lane] : 0.f; s2 = wave_sum(s2);
            const float rstd2 = rsqrtf(s2 * (1.0f / DM) + RMS_EPS);
            float h2[32], y[32];
#pragma unroll
            for (int j = 0; j < 2; ++j)
#pragma unroll
                for (int q = 0; q < 4; ++q) { const size_t e0 = 16 * (size_t)(lane + 64 * j) + 4 * q;
                    const f32x4 xa = *(const GAS f32x4*)(X + t * DM + e0), ga = *(const GAS f32x4*)(g2 + e0);
#pragma unroll
                    for (int k = 0; k < 4; ++k) { h2[j * 16 + q * 4 + k] = xa[k] * rstd2 * ga[k]; y[j * 16 + q * 4 + k] = xa[k]; } }
            const unsigned lo16 = (unsigned)lane * 16u;
#pragma unroll 1
            for (int g = 0; g < 16; ++g) {
                int ids[8]; float gts[8];
#pragma unroll
                for (int e = 0; e < 8; ++e) { const v2u w = sel[tl * 128 + g * 8 + e]; ids[e] = __builtin_amdgcn_readfirstlane((int)w.x); gts[e] = __builtin_bit_cast(float, __builtin_amdgcn_readfirstlane((int)w.y)); }
                v4u uu[8][2];
#pragma unroll
                for (int e = 0; e < 8; ++e) { const GAS unsigned char* rb = (const GAS unsigned char*)Ub + (size_t)ids[e] * 2048;
#pragma unroll
                    for (int j = 0; j < 2; ++j) uu[e][j] = *(const GAS v4u*)(rb + lo16 + j * 1024); }
                float cf[8];
#pragma unroll
                for (int e = 0; e < 8; ++e) { float d = 0.f;
#pragma unroll
                    for (int j = 0; j < 2; ++j)
#pragma unroll
                        for (int w = 0; w < 4; ++w) { const unsigned dw = uu[e][j][w]; const f32x2 lo = cvt8_lo(dw), hi = cvt8_hi(dw);
                            d += lo[0] * h2[j * 16 + w * 4 + 0]; d += lo[1] * h2[j * 16 + w * 4 + 1]; d += hi[0] * h2[j * 16 + w * 4 + 2]; d += hi[1] * h2[j * 16 + w * 4 + 3]; }
                    asm volatile("" : "+v"(d));
                    d = wave_sum(d) * tscU[ids[e]]; cf[e] = gts[e] * gelu_tanh(d) * tscV[ids[e]]; }
                asm volatile("" ::: "memory");
                v4u vv[8][2];
#pragma unroll
                for (int e = 0; e < 8; ++e) { const GAS unsigned char* rb = (const GAS unsigned char*)Vb + (size_t)ids[e] * 2048;
#pragma unroll
                    for (int j = 0; j < 2; ++j) vv[e][j] = *(const GAS v4u*)(rb + lo16 + j * 1024); }
#pragma unroll
                for (int e = 0; e < 8; ++e) { const float c = cf[e];
#pragma unroll
                    for (int j = 0; j < 2; ++j)
#pragma unroll
                        for (int w = 0; w < 4; ++w) { const unsigned dw = vv[e][j][w]; const f32x2 lo = cvt8_lo(dw), hi = cvt8_hi(dw);
                            y[j * 16 + w * 4 + 0] += c * lo[0]; y[j * 16 + w * 4 + 1] += c * lo[1]; y[j * 16 + w * 4 + 2] += c * hi[0]; y[j * 16 + w * 4 + 3] += c * hi[1]; }
                    TOUCH16(y, 0); TOUCH16(y, 16); }
            }
            float ss = 0.f;
#pragma unroll
            for (int j = 0; j < 2; ++j)
#pragma unroll
                for (int q = 0; q < 4; ++q) {
#pragma unroll
                    for (int k = 0; k < 4; ++k) ss += y[j * 16 + q * 4 + k] * y[j * 16 + q * 4 + k]; }
            ss = wave_sum(ss);
            const float rs = rsqrtf(ss * (1.0f / DM) + RMS_EPS);
            if (last) {
#pragma unroll
                for (int j = 0; j < 2; ++j)
#pragma unroll
                    for (int q = 0; q < 4; ++q) { const size_t e0 = 16 * (size_t)(lane + 64 * j) + 4 * q; const f32x4 ga = *(const GAS f32x4*)(gf + e0);
                        f32x4 oa = {y[j * 16 + q * 4 + 0] * rs * ga[0], y[j * 16 + q * 4 + 1] * rs * ga[1], y[j * 16 + q * 4 + 2] * rs * ga[2], y[j * 16 + q * 4 + 3] * rs * ga[3]};
                        *(GAS f32x4*)(XO + t * DM + e0) = oa; }
            } else {
#pragma unroll
                for (int j = 0; j < 2; ++j) {
#pragma unroll
                    for (int q = 0; q < 4; ++q) { const size_t e0 = 16 * (size_t)(lane + 64 * j) + 4 * q;
                        f32x4 oa = {y[j * 16 + q * 4 + 0], y[j * 16 + q * 4 + 1], y[j * 16 + q * 4 + 2], y[j * 16 + q * 4 + 3]}; *(GAS f32x4*)(XO + t * DM + e0) = oa; }
                    const size_t e0 = 16 * (size_t)(lane + 64 * j);
                    v4u w0, w1; w0.x = pk2(y[j * 16 + 0], y[j * 16 + 1]); w0.y = pk2(y[j * 16 + 2], y[j * 16 + 3]); w0.z = pk2(y[j * 16 + 4], y[j * 16 + 5]); w0.w = pk2(y[j * 16 + 6], y[j * 16 + 7]);
                    w1.x = pk2(y[j * 16 + 8], y[j * 16 + 9]); w1.y = pk2(y[j * 16 + 10], y[j * 16 + 11]); w1.z = pk2(y[j * 16 + 12], y[j * 16 + 13]); w1.w = pk2(y[j * 16 + 14], y[j * 16 + 15]);
                    *(GAS v4u*)(xb + t * DM + e0) = w0; *(GAS v4u*)(xb + t * DM + e0 + 8) = w1; }
                if (lane == 0) rstd1[t] = rs;
            }
        }
#else
#pragma unroll 1
        for (int tt = 0; tt < 4; ++tt) {
            const int tl = wave * 4 + tt; const size_t t = (size_t)tok0 + tl;
            float s2 = (lane < 32) ? ssp[t * 32 + lane] : 0.f; s2 = wave_sum(s2);
            const float rstd2 = rsqrtf(s2 * (1.0f / DM) + RMS_EPS);
            v4u hb[4];
#pragma unroll
            for (int j = 0; j < 4; ++j) { const size_t e0 = 8 * (size_t)(lane + 64 * j);
                const f32x4 xa = *(const GAS f32x4*)(X + t * DM + e0), xc = *(const GAS f32x4*)(X + t * DM + e0 + 4);
                const f32x4 ga = *(const GAS f32x4*)(g2 + e0), gc = *(const GAS f32x4*)(g2 + e0 + 4);
                hb[j].x = pk2(xa[0] * rstd2 * ga[0], xa[1] * rstd2 * ga[1]); hb[j].y = pk2(xa[2] * rstd2 * ga[2], xa[3] * rstd2 * ga[3]);
                hb[j].z = pk2(xc[0] * rstd2 * gc[0], xc[1] * rstd2 * gc[1]); hb[j].w = pk2(xc[2] * rstd2 * gc[2], xc[3] * rstd2 * gc[3]); }
            float y[32];
#pragma unroll
            for (int i = 0; i < 32; ++i) y[i] = 0.f;
#pragma unroll 1
            for (int g = 0; g < 32; ++g) {
                int ids[4]; float gts[4];
#pragma unroll
                for (int e = 0; e < 4; ++e) { const v2u w = sel[tl * 128 + g * 4 + e]; ids[e] = __builtin_amdgcn_readfirstlane((int)w.x); gts[e] = __builtin_bit_cast(float, __builtin_amdgcn_readfirstlane((int)w.y)); }
                const unsigned lo16 = (unsigned)lane * 16u;
                v4u uu[4][4];
#pragma unroll
                for (int e = 0; e < 4; ++e) { const GAS unsigned char* rb = (const GAS unsigned char*)Ub + (size_t)ids[e] * 4096;
#pragma unroll
                    for (int j = 0; j < 4; ++j) uu[e][j] = *(const GAS v4u*)(rb + lo16 + j * 1024); }
                float cf[4];
#pragma unroll
                for (int e = 0; e < 4; ++e) { float d = 0.f;
#pragma unroll
                    for (int j = 0; j < 4; ++j) {
                        d = dot2bf(uu[e][j].x, hb[j].x, d);
                        d = dot2bf(uu[e][j].y, hb[j].y, d);
                        d = dot2bf(uu[e][j].z, hb[j].z, d);
                        d = dot2bf(uu[e][j].w, hb[j].w, d); }
                    d = wave_sum(d); cf[e] = gts[e] * gelu_tanh(d); }
                v4u vv[4][4];
#pragma unroll
                for (int e = 0; e < 4; ++e) { const GAS unsigned char* rb = (const GAS unsigned char*)Vb + (size_t)ids[e] * 4096;
#pragma unroll
                    for (int j = 0; j < 4; ++j) vv[e][j] = *(const GAS v4u*)(rb + lo16 + j * 1024); }
#pragma unroll
                for (int e = 0; e < 4; ++e)
#pragma unroll
                    for (int j = 0; j < 4; ++j) { const v4u w = vv[e][j]; const float c = cf[e];
                        y[j * 8 + 0] += c * bflo(w.x); y[j * 8 + 1] += c * bfhi(w.x); y[j * 8 + 2] += c * bflo(w.y); y[j * 8 + 3] += c * bfhi(w.y);
                        y[j * 8 + 4] += c * bflo(w.z); y[j * 8 + 5] += c * bfhi(w.z); y[j * 8 + 6] += c * bflo(w.w); y[j * 8 + 7] += c * bfhi(w.w); }
            }
            float ss = 0.f;
#pragma unroll
            for (int j = 0; j < 4; ++j) { const size_t e0 = 8 * (size_t)(lane + 64 * j);
                const f32x4 xa = *(const GAS f32x4*)(X + t * DM + e0), xc = *(const GAS f32x4*)(X + t * DM + e0 + 4);
#pragma unroll
                for (int k = 0; k < 4; ++k) { y[j * 8 + k] += xa[k]; y[j * 8 + 4 + k] += xc[k]; }
#pragma unroll
                for (int k = 0; k < 8; ++k) ss += y[j * 8 + k] * y[j * 8 + k]; }
            ss = wave_sum(ss);
            const float rs = rsqrtf(ss * (1.0f / DM) + RMS_EPS);
            if (last) {
#pragma unroll
                for (int j = 0; j < 4; ++j) { const size_t e0 = 8 * (size_t)(lane + 64 * j);
                    const f32x4 ga = *(const GAS f32x4*)(gf + e0), gc = *(const GAS f32x4*)(gf + e0 + 4);
                    f32x4 oa = {y[j * 8 + 0] * rs * ga[0], y[j * 8 + 1] * rs * ga[1], y[j * 8 + 2] * rs * ga[2], y[j * 8 + 3] * rs * ga[3]};
                    f32x4 oc = {y[j * 8 + 4] * rs * gc[0], y[j * 8 + 5] * rs * gc[1], y[j * 8 + 6] * rs * gc[2], y[j * 8 + 7] * rs * gc[3]};
                    *(GAS f32x4*)(XO + t * DM + e0) = oa; *(GAS f32x4*)(XO + t * DM + e0 + 4) = oc; }
            } else {
#pragma unroll
                for (int j = 0; j < 4; ++j) { const size_t e0 = 8 * (size_t)(lane + 64 * j);
                    f32x4 oa = {y[j * 8 + 0], y[j * 8 + 1], y[j * 8 + 2], y[j * 8 + 3]}, oc = {y[j * 8 + 4], y[j * 8 + 5], y[j * 8 + 6], y[j * 8 + 7]};
                    *(GAS f32x4*)(XO + t * DM + e0) = oa; *(GAS f32x4*)(XO + t * DM + e0 + 4) = oc;
                    v4u w; w.x = pk2(oa[0], oa[1]); w.y = pk2(oa[2], oa[3]); w.z = pk2(oc[0], oc[1]); w.w = pk2(oc[2], oc[3]);
                    *(GAS v4u*)(xb + t * DM + e0) = w; }
                if (lane == 0) rstd1[t] = rs;
            }
        }
#endif
        __syncthreads();
    }
}

#ifndef PROBE_ITEM
#define PROBE_ITEM -1
#endif
#define IREP(k) for (int irep = (PROBE_ITEM == (k)) ? 0 : 1; irep < 2; ++irep)
#ifndef FAST_MASK
#define FAST_MASK 15
#endif
__device__ __forceinline__ void mix_p2(ArgsR A, int l, LAS unsigned char* lds, int G, int tid) {
    const int bx = blockIdx.x;
    if (FAST_MASK & 2) IREP(1) for (int it = bx; it < 512; it += G) f_gla_p2(A, l, it, lds, pg8::fresh_tid());
    if (FAST_MASK & 4) IREP(2) for (int it = bx; it < 512; it += G) f_ml_p2(A, l, it, lds, pg8::fresh_tid());
    if (FAST_MASK & 8) IREP(3) for (int it = bx; it < 512; it += G) f_gdn_p2(A, l, it, lds, pg8::fresh_tid());
    if (FAST_MASK & 1) IREP(4) for (int it = bx; it < 1024; it += G) f_lru_p2(A, l, it, lds, pg8::fresh_tid());
    if ((FAST_MASK & 15) != 15) {
        for (int it = bx; it < 80; it += G) {
            if (it < 16) { if (!(FAST_MASK & 2)) nm_gla(A, l, it >> 2, it & 3, lds, pg8::fresh_tid()); }
            else if (it < 32) { if (!(FAST_MASK & 4)) nm_mlstm(A, l, (it - 16) >> 2, (it - 16) & 3, lds, pg8::fresh_tid()); }
            else if (it < 48) { if (!(FAST_MASK & 8)) nm_gdn(A, l, (it - 32) >> 2, (it - 32) & 3, lds, pg8::fresh_tid()); }
            else { if (!(FAST_MASK & 1)) nm_lru(A, l, (it - 48) >> 3, (it - 48) & 7, lds, pg8::fresh_tid()); }
            __syncthreads();
        }
    }
}
__device__ __forceinline__ void part_barrier(unsigned* word, unsigned nb, int tid) {
    asm volatile("s_waitcnt vmcnt(0)" ::: "memory");
    __syncthreads();
    if (tid == 0) {
        __builtin_amdgcn_fence(__ATOMIC_RELEASE, "agent");
        asm volatile("s_waitcnt vmcnt(0)" ::: "memory");
        __hip_atomic_fetch_add(word, 1u, __ATOMIC_RELAXED, __HIP_MEMORY_SCOPE_AGENT);
        unsigned sp = 0;
        while (__hip_atomic_load(word, __ATOMIC_RELAXED, __HIP_MEMORY_SCOPE_AGENT) < nb) { __builtin_amdgcn_s_sleep(2); if (++sp > (1u << 22)) break; }
        __builtin_amdgcn_fence(__ATOMIC_ACQUIRE, "agent");
        asm volatile("s_waitcnt vmcnt(0)" ::: "memory");
    }
    __syncthreads();
}
__device__ __forceinline__ void mix_p3(ArgsR A, int l, LAS unsigned char* lds, int G, const XcdBarrier& bar) {
    const int bx = blockIdx.x;
    const bool split = G > 32;
    int first = 0, nb = G;
    if (split) { if (bx < 16) { f_gdn_p3(A, l, bx, lds, pg8::fresh_tid()); return; } first = 16; nb = G - 16; }
    else { for (int it = bx; it < 16; it += G) f_gdn_p3(A, l, it, lds, pg8::fresh_tid()); }
    for (int it = bx - first; it < 516; it += nb) {
        if (it < 256) f_gla_p3(A, it, pg8::fresh_tid());
        else if (it < 512) f_ml_p3(A, it - 256, pg8::fresh_tid());
        else f_lru_p3(A, it - 512, pg8::fresh_tid());
    }
    IREP(7) { const int t2 = pg8::fresh_tid(); tab_convert(A, l, (bx - first) * NWAVES + __builtin_amdgcn_readfirstlane(t2 >> 6), nb * NWAVES, t2 & 63); }
    if (split) part_barrier((unsigned*)(A.ws + WS_CTL) + CW_PBAR + 64 * l, (unsigned)nb, pg8::fresh_tid());
    else xcd_barrier(bar);
    IREP(5) for (int it = bx - first; it < 512; it += nb) f_gla_p4(A, l, it, lds, pg8::fresh_tid());
    IREP(6) for (int it = nb - 1 - (bx - first); it < 512; it += nb) f_ml_p4(       A, l, it, lds, pg8::fresh_tid());
    for (int it = bx - first; it < 128; it += nb) f_lru_p4(A, it, pg8::fresh_tid());
}

#ifndef PROBE_PHASE
#define PROBE_PHASE -1
#endif
#ifndef MK_PER_PHASE
#define MK_PER_PHASE 0
#endif
constexpr int PPL = 6, NPHASE = 1 + PPL * DEPTH;
constexpr int CW_BAR = 4096;

__global__ void __launch_bounds__(NTHREADS, 2) mk_fwd(Args args) {
    extern __shared__ __attribute__((aligned(16))) unsigned char lds_raw[];
    LAS unsigned char* lds = (LAS unsigned char*)lds_raw;
    volatile LAS unsigned* MISC = (volatile LAS unsigned*)(lds + MISC_OFF);
    const int tid = threadIdx.x, lane = tid & 63, wave = __builtin_amdgcn_readfirstlane(tid >> 6);
    const int G = gridDim.x; const int bx = blockIdx.x; const int vcu = (G % 8 == 0) ? (bx % 8) * (G / 8) + bx / 8 : bx;
    unsigned char* ws = args.ws;
    if (tid < 64) MISC[tid] = 0u;
    __syncthreads();
    XcdBarrier bar; bar.bar = (unsigned*)(ws + WS_CTL) + CW_BAR; bar.x = 0; bar.st = nullptr;
    if (!MK_PER_PHASE) bar = xcd_barrier_post((unsigned*)(ws + WS_CTL) + CW_BAR, MISC + 8);
    const int lo = args.ph_lo, hi = args.ph_hi;
#define IN(k) (lo <= (k) && (k) < hi)
#define SEAM(k) do { if (IN(k) && IN((k) + 1)) xcd_barrier(bar); } while (0)
#define REP(kind) for (int rep = (PROBE_PHASE == (kind)) ? 0 : 1; rep < 2; ++rep)
#define REPBAR() do { if (rep == 0) xcd_barrier(bar); } while (0)

    if (IN(0)) { REP(0) { const int t0 = pg8::fresh_tid(); p0_prologue(*kargs(), lds, vcu, G, __builtin_amdgcn_readfirstlane(t0 >> 6), t0 & 63); REPBAR(); } SEAM(0); }
#pragma unroll 1
    for (int l = 0; l < DEPTH; ++l) {
        const int pb = 1 + PPL * l;
        if (IN(pb)) {
            pg8::Gemm g{(const pg8::bf16_t*)(ws + WS_XB), (const pg8::bf16_t*)(ws + WS_WIN + l * WIN_L), NT, NINP, DM}; pg8::StaticOrder S; S.init(NT, NINP, G, bx);
            pg8::EpiP E{(pg8::bf16_t*)(ws + WS_P), (float*)(ws + WS_PS), (const float*)(ws + WS_RSTD1)};
            REP(1) { pg8::gemm_phase<pg8::EpiP, pg8::StaticOrder, true, true>(lds, g, S, E); REPBAR(); }
            SEAM(pb);
        }
        if (IN(pb + 1)) { REP(2) { mix_p2(*kargs(), l, lds, G, pg8::fresh_tid()); REPBAR(); } SEAM(pb + 1); }
        if (IN(pb + 2)) { mix_p3(*kargs(), l, lds, G, bar); SEAM(pb + 2); }
        if (IN(pb + 3)) {
            pg8::Gemm g{(const pg8::bf16_t*)(ws + WS_MIX), (const pg8::bf16_t*)(ws + WS_WOUT + l * WSQ_L), NT, DM, DM}; pg8::StaticOrder S; S.init(NT, DM, G, bx);
            REP(5) { const bool dry = (rep == 0);
                pg8::EpiX E{l == 0 ? args.in[I_X] : (const float*)args.out, dry ? (float*)(ws + WS_P) : args.out, (pg8::bf16_t*)(ws + (dry ? WS_Q : WS_XB)), (float*)(ws + (dry ? WS_PS : WS_SSP))};
                pg8::gemm_phase<pg8::EpiX, pg8::StaticOrder, true, true>(lds, g, S, E); REPBAR(); }
            SEAM(pb + 3);
        }
        if (IN(pb + 4)) {
            pg8::Gemm g{(const pg8::bf16_t*)(ws + WS_XB), (const pg8::bf16_t*)(ws + WS_WQ + l * WSQ_L), NT, DM, DM}; pg8::StaticOrder S; S.init(NT, DM, G, bx);
            pg8::EpiQ E{(pg8::bf16_t*)(ws + WS_Q), (const float*)(ws + WS_SSP)};
            REP(6) { pg8::gemm_phase<pg8::EpiQ, pg8::StaticOrder, true, true>(lds, g, S, E); REPBAR(); }
            SEAM(pb + 4);
        }
        if (IN(pb + 5)) { if (PROBE_PHASE == 7) { peer_phase<true>(*kargs(), l, l == DEPTH - 1, lds, G, pg8::fresh_tid()); xcd_barrier(bar); }
            peer_phase<false>(*kargs(), l, l == DEPTH - 1, lds, G, pg8::fresh_tid()); SEAM(pb + 5); }
    }
#undef IN
#undef SEAM
}

extern "C" void kernel_launch(void* const* d_in, const int* in_sizes, int n_in, void* d_out, int out_size, void* d_ws, size_t ws_size, hipStream_t stream) {
    static int grid = 0;
    if (grid == 0) {
        if (n_in != N_IN || out_size != NT * DM || ws_size < WS_END) { fprintf(stderr, "kernel_launch: unexpected shapes: n_in %d out %d ws %zu (need %zu)\n", n_in, out_size, ws_size, (size_t)WS_END); grid = -1; return; }
        int dev = 0, cus = 0, per_cu = 0;
        if (hipGetDevice(&dev) != hipSuccess || hipDeviceGetAttribute(&cus, hipDeviceAttributeMultiprocessorCount, dev) != hipSuccess) { grid = -1; return; }
        if (hipFuncSetAttribute((const void*)mk_fwd, hipFuncAttributeMaxDynamicSharedMemorySize, LDS_BYTES) != hipSuccess) { fprintf(stderr, "kernel_launch: hipFuncSetAttribute failed\n"); grid = -1; return; }
        if (hipOccupancyMaxActiveBlocksPerMultiprocessor(&per_cu, (const void*)mk_fwd, NTHREADS, LDS_BYTES) != hipSuccess || per_cu < 1) { fprintf(stderr, "kernel_launch: occupancy query says %d blocks per CU\n", per_cu); (void)hipGetLastError(); grid = -1; return; }
        grid = cus;
    }
    if (grid < 0) return;
    if (hipMemsetAsync((char*)d_ws + WS_CTL, 0, CTL_ZERO_BYTES, stream) != hipSuccess) return;
    Args a{};
    for (int i = 0; i < N_IN; ++i) a.in[i] = (const float*)d_in[i];
    a.out = (float*)d_out; a.ws = (unsigned char*)d_ws;
#if MK_PER_PHASE
    for (int p = 0; p < NPHASE; ++p) { a.ph_lo = p; a.ph_hi = p + 1; a.li = 0; hipLaunchKernelGGL(mk_fwd, dim3(grid), dim3(NTHREADS), LDS_BYTES, stream, a); }
#else
    a.ph_lo = 0; a.ph_hi = NPHASE; a.li = 0;
    hipLaunchKernelGGL(mk_fwd, dim3(grid), dim3(NTHREADS), LDS_BYTES, stream, a);
#endif
}
```

```cpp
#include <hip/hip_runtime.h>
#include <cstdio>
#include <cstdint>
#define TAB_FP8 1
namespace pg8 {
__device__ __forceinline__ int fresh_tid() { int t = threadIdx.x; asm volatile("" : "+v"(t)); return t; }
#define PG8_LAS __attribute__((address_space(3)))
typedef unsigned short bf16_t;
typedef short bf16x8 __attribute__((ext_vector_type(8)));
typedef float f32x4 __attribute__((ext_vector_type(4)));
typedef unsigned u32x4 __attribute__((ext_vector_type(4)));
constexpr int BM = 256, BK = 64, HALF = 128, HTB = HALF * BK * 2  , STAGE_BYTES = 8 * HTB, NXCD = 8, WGM = 8;

__host__ __device__ __forceinline__ int lds_byte(int r, int c) { const int st = (r >> 4) * 2 + (c >> 5), rr = r & 15, cc = c & 31, ob = rr * 64 + cc * 2; return st * 1024 + (ob ^ (((ob >> 9) & 1) << 5)); }
__host__ __device__ __forceinline__ void stage_rc(int b, int& R, int& C) { const int st = b / 1024, sb = b % 1024, swz = sb ^ (((sb >> 9) & 1) << 5); R = (st >> 1) * 16 + swz / 64; C = (st & 1) * 32 + (swz % 64) / 2; }
__host__ __device__ __forceinline__ int perm32(int rho) { const int n = rho >> 4, i = rho & 15; return 8 * (i >> 2) + 4 * n + (i & 3); }

struct Unit { int pm, pn; };
struct Gemm { const bf16_t* A; const bf16_t* Bt; int M, N, K; };

struct StaticOrder {
    int nM, nN, nwg, G, c;
    __host__ __device__ void init(int M, int N, int G_, int c_) { nM = M / BM; nN = N / BM; nwg = nM * nN; G = G_; c = c_; }
    __host__ __device__ bool next(int i, Unit& u) const {
        const long L = (long)i * G + c; if (L >= nwg) return false;
        int wgid = (int)L; { const int q = nwg / NXCD, r = nwg % NXCD, xcd = wgid % NXCD, off = wgid / NXCD; wgid = (xcd < r ? xcd * (q + 1) : r * (q + 1) + (xcd - r) * q) + off; }
        const int nig = WGM * nN, gid = wgid / nig, fm = gid * WGM, gsz = (nM - fm) < WGM ? (nM - fm) : WGM;
        u.pm = fm + ((wgid % nig) % gsz); u.pn = (wgid % nig) / gsz; return true;
    }
    __device__ __forceinline__ void a_ready(const Unit&) const {}
    __device__ __forceinline__ void done(const Unit&) const {}
};


__device__ __forceinline__ unsigned cvt_pk_bf16(float lo, float hi) { unsigned r; asm volatile("v_cvt_pk_bf16_f32 %0, %1, %2" : "=v"(r) : "v"(lo), "v"(hi)); return r; }

struct EpiP {
    static constexpr bool PERM = true, AFTER_DRAIN = false;
    bf16_t* P; float* Ps; const float* rstd;
    __device__ __forceinline__ void operator()(const f32x4 (&acc)[2][2][4][2], const Unit& u, int wr, int wc, int fr, int fq) const {
        const int row0 = u.pm * BM + wr * 64 + fr;
        if (u.pn < 28) {
            const int col0 = u.pn * BM + wc * 32 + 8 * fq;
#pragma unroll
            for (int ai = 0; ai < 2; ++ai)
#pragma unroll
                for (int m = 0; m < 4; ++m) { const int row = row0 + ai * HALF + m * 16; const float r = rstd[row]; bf16_t* rowp = P + (size_t)row * 7168 + col0;
#pragma unroll
                    for (int bj = 0; bj < 2; ++bj) { const f32x4 v0 = acc[ai][bj][m][0] * r, v1 = acc[ai][bj][m][1] * r;
                        u32x4 w; w.x = cvt_pk_bf16(v0[0], v0[1]); w.y = cvt_pk_bf16(v0[2], v0[3]); w.z = cvt_pk_bf16(v1[0], v1[1]); w.w = cvt_pk_bf16(v1[2], v1[3]);
                        *(u32x4*)(rowp + bj * HALF) = w; } }
        } else if (wc == 0) {
#pragma unroll
            for (int ai = 0; ai < 2; ++ai)
#pragma unroll
                for (int m = 0; m < 4; ++m) { const int row = row0 + ai * HALF + m * 16; const float r = rstd[row]; float* p = Ps + (size_t)row * 32 + 8 * fq;
                    *(f32x4*)p = acc[ai][0][m][0] * r; *(f32x4*)(p + 4) = acc[ai][0][m][1] * r; }
        }
    }
};
struct EpiX {
    static constexpr bool PERM = true, AFTER_DRAIN = false;
    const float* xres; float* xout; bf16_t* xb; float* ssp;
    __device__ __forceinline__ void operator()(const f32x4 (&acc)[2][2][4][2], const Unit& u, int wr, int wc, int fr, int fq) const {
        const int row0 = u.pm * BM + wr * 64 + fr, col0 = u.pn * BM + wc * 32 + 8 * fq;
#pragma unroll
        for (int ai = 0; ai < 2; ++ai)
#pragma unroll
            for (int m = 0; m < 4; ++m) { const int row = row0 + ai * HALF + m * 16; float ss = 0.f;
#pragma unroll
                for (int bj = 0; bj < 2; ++bj) { const size_t off = (size_t)row * 2048 + col0 + bj * HALF;
                    const f32x4 r0 = *(const f32x4*)(xres + off), r1 = *(const f32x4*)(xres + off + 4);
                    const f32x4 v0 = acc[ai][bj][m][0] + r0, v1 = acc[ai][bj][m][1] + r1;
                    *(f32x4*)(xout + off) = v0; *(f32x4*)(xout + off + 4) = v1;
                    u32x4 w; w.x = cvt_pk_bf16(v0[0], v0[1]); w.y = cvt_pk_bf16(v0[2], v0[3]); w.z = cvt_pk_bf16(v1[0], v1[1]); w.w = cvt_pk_bf16(v1[2], v1[3]);
                    *(u32x4*)(xb + off) = w;
                    ss += (v0[0] * v0[0] + v0[1] * v0[1]) + (v0[2] * v0[2] + v0[3] * v0[3]) + (v1[0] * v1[0] + v1[1] * v1[1]) + (v1[2] * v1[2] + v1[3] * v1[3]); }
                ss += __shfl_xor(ss, 16); ss += __shfl_xor(ss, 32);
                if (fq == 0) ssp[(size_t)row * 32 + u.pn * 4 + wc] = ss; }
    }
};
struct EpiQ {
    static constexpr bool PERM = true, AFTER_DRAIN = false;
    bf16_t* Q; const float* ssp;
    __device__ __forceinline__ void operator()(const f32x4 (&acc)[2][2][4][2], const Unit& u, int wr, int wc, int fr, int fq) const {
        const int row0 = u.pm * BM + wr * 64 + fr, col0 = u.pn * BM + wc * 32 + 8 * fq;
#pragma unroll
        for (int ai = 0; ai < 2; ++ai)
#pragma unroll
            for (int m = 0; m < 4; ++m) { const int row = row0 + ai * HALF + m * 16;
                const f32x4* sp = (const f32x4*)(ssp + (size_t)row * 32 + 8 * fq); const f32x4 a = sp[0], b = sp[1];
                float s = ((a[0] + a[1]) + (a[2] + a[3])) + ((b[0] + b[1]) + (b[2] + b[3]));
                s += __shfl_xor(s, 16); s += __shfl_xor(s, 32);
                const float r = rsqrtf(s * (1.0f / 2048.0f) + 1e-6f); bf16_t* rowp = Q + (size_t)row * 2048 + col0;
#pragma unroll
                for (int bj = 0; bj < 2; ++bj) { const f32x4 v0 = acc[ai][bj][m][0] * r, v1 = acc[ai][bj][m][1] * r;
                    u32x4 w; w.x = cvt_pk_bf16(v0[0], v0[1]); w.y = cvt_pk_bf16(v0[2], v0[3]); w.z = cvt_pk_bf16(v1[0], v1[1]); w.w = cvt_pk_bf16(v1[2], v1[3]);
                    *(u32x4*)(rowp + bj * HALF) = w; } }
    }
};

template <class Epi, class Sched, bool ALIGN_EPI = false, bool SP2 = false>
__device__ __forceinline__ void gemm_phase(PG8_LAS unsigned char* lds, const Gemm g, const Sched& S, const Epi& E) {
    const int tid = fresh_tid(), wid = __builtin_amdgcn_readfirstlane(tid >> 6), lane = tid & 63, wr = wid >> 2, wc = wid & 3, fr = lane & 15, fq = lane >> 4;
    const int K = g.K, nt = K / BK;
    unsigned voffA[2], voffB[2];
#pragma unroll
    for (int i = 0; i < 2; ++i) { int R, C; stage_rc(tid * 16 + i * 8192, R, C); const int Rb = Epi::PERM ? ((R & ~31) + perm32(R & 31)) : R;
        voffA[i] = (unsigned)(R * K + C) * 2u; voffB[i] = (unsigned)(Rb * K + C) * 2u; }
    const size_t kstep = (size_t)(BK * 2);
    const size_t hstep = (size_t)HALF * K * 2;
    const size_t tstep = 2 * hstep;
    const unsigned ldsw = (unsigned)wid * 1024u;
    const int aoff = lds_byte(wr * 64 + fr, fq * 8), boff = lds_byte(wc * 32 + fr, fq * 8);
#define PG8_SA(b, h) (((b) * 2 + (h)) * HTB)
#define PG8_SB(b, h) ((4 + (b) * 2 + (h)) * HTB)
#define PG8_STAGE(bufoff, gbase, voff) do { _Pragma("unroll") for (int _i = 0; _i < 2; ++_i) \
        __builtin_amdgcn_global_load_lds((const unsigned*)((const char*)(gbase) + (voff)[_i]), (PG8_LAS unsigned*)(lds + (bufoff) + ldsw + _i * 8192), 16, 0, 0); } while (0)
#define PG8_LDA(dst, b, h) do { _Pragma("unroll") for (int m = 0; m < 4; ++m) _Pragma("unroll") for (int k = 0; k < 2; ++k) dst[m][k] = *(const PG8_LAS bf16x8*)(lds + PG8_SA(b, h) + aoff + m * 2048 + k * 1024); } while (0)
#define PG8_LDB(dst, b, h) do { _Pragma("unroll") for (int n = 0; n < 2; ++n) _Pragma("unroll") for (int k = 0; k < 2; ++k) dst[n][k] = *(const PG8_LAS bf16x8*)(lds + PG8_SB(b, h) + boff + n * 2048 + k * 1024); } while (0)
#define PG8_MMA(ai, bj, At, Bt) do { __builtin_amdgcn_s_setprio(1); _Pragma("unroll") for (int m = 0; m < 4; ++m) _Pragma("unroll") for (int n = 0; n < 2; ++n) _Pragma("unroll") for (int k = 0; k < 2; ++k) \
        acc[ai][bj][m][n] = __builtin_amdgcn_mfma_f32_16x16x32_bf16(Bt[n][k], At[m][k], acc[ai][bj][m][n], 0, 0, 0); __builtin_amdgcn_s_setprio(0); } while (0)
#define PG8_WAIT_V(n) asm volatile("s_waitcnt vmcnt(" #n ")" ::: "memory")
#define PG8_WAIT_L(n) asm volatile("s_waitcnt lgkmcnt(" #n ")" ::: "memory")
#define PG8_BAR __builtin_amdgcn_s_barrier()
#define PG8_SCHED __builtin_amdgcn_sched_barrier(0)
    Unit cur, nxt; int ui = 0;
    if (!S.next(0, cur)) return;
    f32x4 acc[2][2][4][2];
#pragma unroll
    for (int a = 0; a < 2; ++a)
#pragma unroll
        for (int b = 0; b < 2; ++b)
#pragma unroll
            for (int m = 0; m < 4; ++m)
#pragma unroll
                for (int n = 0; n < 2; ++n) acc[a][b][m][n] = (f32x4){0.f, 0.f, 0.f, 0.f};
    bf16x8 At[4][2], B0[2][2], B1[2][2];
    const char* cA = (const char*)g.A + (size_t)cur.pm * tstep; const char* cB = (const char*)g.Bt + (size_t)cur.pn * tstep;
    S.a_ready(cur);
    if constexpr (SP2) {
        PG8_STAGE(PG8_SB(0, 0), cB, voffB); PG8_STAGE(PG8_SB(0, 1), cB + hstep, voffB); PG8_STAGE(PG8_SA(0, 0), cA, voffA); PG8_STAGE(PG8_SA(0, 1), cA + hstep, voffA);
        if (wr == 1) PG8_BAR;
        PG8_WAIT_V(2); PG8_BAR;
        PG8_STAGE(PG8_SB(1, 0), cB + kstep, voffB); PG8_STAGE(PG8_SA(1, 0), cA + kstep, voffA); PG8_STAGE(PG8_SB(1, 1), cB + hstep + kstep, voffB);
        PG8_WAIT_V(6); PG8_BAR;
    } else {
        PG8_STAGE(PG8_SB(0, 0), cB, voffB); PG8_STAGE(PG8_SA(0, 0), cA, voffA); PG8_STAGE(PG8_SB(0, 1), cB + hstep, voffB); PG8_STAGE(PG8_SA(0, 1), cA + hstep, voffA);
        if (wr == 1) PG8_BAR;
        PG8_WAIT_V(4); PG8_BAR;
        PG8_STAGE(PG8_SB(1, 0), cB + kstep, voffB); PG8_STAGE(PG8_SA(1, 0), cA + kstep, voffA); PG8_STAGE(PG8_SB(1, 1), cB + hstep + kstep, voffB);
        PG8_WAIT_V(6); PG8_BAR;
    }
    for (;;) {
        const bool has_next = S.next(ui + 1, nxt);
        const char* nA = has_next ? (const char*)g.A + (size_t)nxt.pm * tstep : cA; const char* nB = has_next ? (const char*)g.Bt + (size_t)nxt.pn * tstep : cB;
        for (int t = 0; t < nt; t += 2) {
            const bool last = (t == nt - 2);
            const char* a1 = cA + (size_t)(t + 1) * kstep;
            const char* a2 = last ? nA : cA + (size_t)(t + 2) * kstep; const char* b2 = last ? nB : cB + (size_t)(t + 2) * kstep;
            const char* a3 = a2 + kstep; const char* b3 = b2 + kstep;
            if (last && has_next) S.a_ready(nxt);
            if constexpr (SP2) {
            PG8_LDB(B0, 0, 0); PG8_LDB(B1, 0, 1); PG8_SCHED; PG8_LDA(At, 0, 0); PG8_STAGE(PG8_SA(1, 1), a1 + hstep, voffA);
            PG8_WAIT_V(8); PG8_WAIT_L(0); PG8_BAR; PG8_MMA(0, 0, At, B0); PG8_MMA(0, 1, At, B1); PG8_BAR; PG8_SCHED;
            PG8_LDA(At, 0, 1); PG8_STAGE(PG8_SB(0, 0), b2, voffB); PG8_STAGE(PG8_SB(0, 1), b2 + hstep, voffB); PG8_STAGE(PG8_SA(0, 0), a2, voffA);
            PG8_WAIT_V(8); PG8_WAIT_L(0); PG8_BAR; PG8_MMA(1, 0, At, B0); PG8_MMA(1, 1, At, B1); PG8_BAR; PG8_SCHED;
            PG8_LDB(B0, 1, 0); PG8_LDB(B1, 1, 1); PG8_SCHED; PG8_LDA(At, 1, 0); PG8_STAGE(PG8_SA(0, 1), a2 + hstep, voffA);
            PG8_WAIT_V(8); PG8_WAIT_L(0); PG8_BAR; PG8_MMA(0, 0, At, B0); PG8_MMA(0, 1, At, B1); PG8_BAR; PG8_SCHED;
            PG8_LDA(At, 1, 1); PG8_STAGE(PG8_SB(1, 0), b3, voffB); PG8_STAGE(PG8_SB(1, 1), b3 + hstep, voffB); PG8_STAGE(PG8_SA(1, 0), a3, voffA);
            PG8_WAIT_V(8); PG8_WAIT_L(0); PG8_BAR; PG8_MMA(1, 0, At, B0); PG8_MMA(1, 1, At, B1); PG8_BAR; PG8_SCHED;
            } else {
            PG8_LDB(B0, 0, 0); PG8_SCHED; PG8_LDA(At, 0, 0); PG8_STAGE(PG8_SA(1, 1), a1 + hstep, voffA);
            PG8_WAIT_L(8); PG8_BAR; PG8_WAIT_L(0); PG8_MMA(0, 0, At, B0); PG8_BAR; PG8_SCHED;
            PG8_LDB(B1, 0, 1); PG8_STAGE(PG8_SB(0, 0), b2, voffB);
            PG8_BAR; PG8_WAIT_L(0); PG8_MMA(0, 1, At, B1); PG8_BAR;
            PG8_LDA(At, 0, 1); PG8_STAGE(PG8_SA(0, 0), a2, voffA);
            PG8_BAR; PG8_WAIT_L(0); PG8_MMA(1, 0, At, B0); PG8_BAR; PG8_SCHED;
            PG8_STAGE(PG8_SB(0, 1), b2 + hstep, voffB);
            PG8_WAIT_V(6); PG8_BAR; PG8_MMA(1, 1, At, B1); PG8_BAR;
            PG8_LDB(B0, 1, 0); PG8_SCHED; PG8_LDA(At, 1, 0); PG8_STAGE(PG8_SA(0, 1), a2 + hstep, voffA);
            PG8_WAIT_L(8); PG8_BAR; PG8_WAIT_L(0); PG8_MMA(0, 0, At, B0); PG8_BAR; PG8_SCHED;
            PG8_LDB(B1, 1, 1); PG8_STAGE(PG8_SB(1, 0), b3, voffB);
            PG8_BAR; PG8_WAIT_L(0); PG8_MMA(0, 1, At, B1); PG8_BAR;
            PG8_LDA(At, 1, 1); PG8_STAGE(PG8_SA(1, 0), a3, voffA);
            PG8_BAR; PG8_WAIT_L(0); PG8_MMA(1, 0, At, B0); PG8_BAR; PG8_SCHED;
            PG8_STAGE(PG8_SB(1, 1), b3 + hstep, voffB);
            PG8_WAIT_V(6); PG8_BAR; PG8_MMA(1, 1, At, B1); PG8_BAR;
            }
        }
        if constexpr (ALIGN_EPI) { if (wr == 0) PG8_BAR; }
        if constexpr (!Epi::AFTER_DRAIN) { E(acc, cur, wr, wc, fr, fq); S.done(cur); }
        if (!has_next) break;
#pragma unroll
        for (int a = 0; a < 2; ++a)
#pragma unroll
            for (int b = 0; b < 2; ++b)
#pragma unroll
                for (int m = 0; m < 4; ++m)
#pragma unroll
                    for (int n = 0; n < 2; ++n) acc[a][b][m][n] = (f32x4){0.f, 0.f, 0.f, 0.f};
        cur = nxt; cA = nA; cB = nB; ++ui;
        if constexpr (ALIGN_EPI) { if (wr == 1) PG8_BAR; }
    }
    PG8_WAIT_V(0);
    if constexpr (!ALIGN_EPI) { if (wr == 0) PG8_BAR; }
    PG8_BAR;
    if constexpr (Epi::AFTER_DRAIN) { E.fused(acc, cur, wr, wc, fr, fq, lds, wid, lane); S.done(cur); }
#undef PG8_SA
#undef PG8_SB
#undef PG8_STAGE
#undef PG8_LDA
#undef PG8_LDB
#undef PG8_MMA
#undef PG8_WAIT_V
#undef PG8_WAIT_L
#undef PG8_BAR
#undef PG8_SCHED
}
}

constexpr int NWAVES = 8, NTHREADS = 512;
constexpr int NT = 8192, DM = 2048, SEQ = 2048, NBATCH = 4, DEPTH = 2, CHK = 64, NCHK = 32, GW = 512, NH = 4, HD = 128;
constexpr int DIN = 7200, NINP = 7424, PBW = 7168;
constexpr int NEXP = 16384;
constexpr int PC_GLA_Q = 0, PC_GLA_K = 512, PC_GLA_V = 1024, PC_GLA_G = 1536, PC_LRU_X = 2048, PC_LRU_Y = 2560, PC_ML_Q = 3072, PC_ML_K = 3584, PC_ML_V = 4096, PC_ML_O = 4608,
              PC_GDN_Q = 5120, PC_GDN_K = 5632, PC_GDN_V = 6144, PC_GDN_G = 6656;
constexpr int PS_LR = 0, PS_MI = 16, PS_MF = 20, PS_GB = 24, PS_GA = 28;
constexpr float RMS_EPS = 1e-6f;
enum { I_X = 0, I_N1G, I_WIN, I_WOUT, I_GLA_W2, I_GLA_B2, I_GLA_NG, I_LRU_CW, I_LRU_CB, I_LRU_WA, I_LRU_BA, I_LRU_WX, I_LRU_BX, I_LRU_LAM, I_ML_IB, I_ML_FB, I_ML_NG,
       I_GDN_CW, I_GDN_ALOG, I_GDN_DTB, I_GDN_NG, I_N2G, I_PWQ, I_PK1, I_PK2, I_PU, I_PV, I_FNG, N_IN };

constexpr size_t MiB = 1u << 20;
constexpr size_t WS_CTL = 0, CTL_ZERO_BYTES = 1 * MiB;
constexpr size_t WS_WIN = 2 * MiB;
constexpr size_t WIN_L = (size_t)NINP * DM * 2;
constexpr size_t WS_WOUT = 60 * MiB;
constexpr size_t WS_WQ = 76 * MiB;
constexpr size_t WSQ_L = (size_t)DM * DM * 2;
constexpr size_t WS_K1 = 92 * MiB, WS_K2 = 92 * MiB + 512 * 1024;
constexpr size_t WS_RSTD1 = 93 * MiB;
constexpr size_t WS_SSP = 94 * MiB;
constexpr size_t WS_XB = 96 * MiB;
constexpr size_t WS_P = 128 * MiB;
constexpr size_t WS_PS = 240 * MiB;
constexpr size_t WS_MIX = 242 * MiB;
constexpr size_t WS_Q = 274 * MiB;
constexpr size_t WS_UB = 306 * MiB;
constexpr size_t WS_VB = 434 * MiB;
constexpr size_t TAB_L = (size_t)NEXP * DM * 2;
constexpr size_t WS_SCR = 562 * MiB;
constexpr size_t WS_END = 900 * MiB;

constexpr int LDS_BYTES = 155648;
constexpr int MISC_OFF = LDS_BYTES - 256;

#define GAS __attribute__((address_space(1)))
#define LAS __attribute__((address_space(3)))
typedef unsigned short bf16;
typedef unsigned v4u __attribute__((ext_vector_type(4)));
typedef unsigned v2u __attribute__((ext_vector_type(2)));
typedef float f32x4 __attribute__((ext_vector_type(4)));
typedef float f32x2 __attribute__((ext_vector_type(2)));
typedef short bf16x8 __attribute__((ext_vector_type(8)));
typedef short bf16x4 __attribute__((ext_vector_type(4)));
typedef __bf16 bf2_t __attribute__((ext_vector_type(2)));
typedef GAS unsigned gu32;
#define RLX_AGENT __ATOMIC_RELAXED, __HIP_MEMORY_SCOPE_AGENT
__device__ __forceinline__ unsigned f2bf(float f) { unsigned u = __builtin_bit_cast(unsigned, f); return (u + 0x7fffu + ((u >> 16) & 1u)) >> 16; }
__device__ __forceinline__ unsigned pk2(float lo, float hi) { return f2bf(lo) | (f2bf(hi) << 16); }
__device__ __forceinline__ float bf2f(unsigned b) { return __builtin_bit_cast(float, b << 16); }
__device__ __forceinline__ float bflo(unsigned w) { return __builtin_bit_cast(float, w << 16); }
__device__ __forceinline__ float bfhi(unsigned w) { return __builtin_bit_cast(float, w & 0xffff0000u); }
__device__ __forceinline__ float wave_sum(float v) {
#pragma unroll
    for (int o = 1; o < 64; o <<= 1) v += __shfl_xor(v, o);
    return v;
}
__device__ __forceinline__ float rcpf_(float x) { return __builtin_amdgcn_rcpf(x); }
__device__ __forceinline__ float sigmoidf_(float x) { return rcpf_(1.0f + __expf(-x)); }
__device__ __forceinline__ float siluf_(float x) { return x * rcpf_(1.0f + __expf(-x)); }
__device__ __forceinline__ float softplusf_(float x) { return fmaxf(x, 0.f) + __logf(1.0f + __expf(-fabsf(x))); }
__device__ __forceinline__ float logsigmoidf_(float x) { return fminf(x, 0.f) - __logf(1.0f + __expf(-fabsf(x))); }
__device__ __forceinline__ float gelu_tanh(float x) { const float u = 1.5957691216057308f * (x + 0.044715f * x * x * x); return x * rcpf_(1.0f + __expf(-u)); }

#define XB_TMO      128
#define XB_XCNT(j)  (256  + 64 * (j))
#define XB_XSUB(j)  (1280 + 64 * (j))
#define XB_XGEN(j)  (2304 + 64 * (j))
#define XB_TOP      3328
#define XB_TOPGEN   3392
#define XCD_BAR_WORDS 3456
#define XB_SPIN_CAP (1u << 18)

__device__ __forceinline__ unsigned xb_ld(unsigned* p)              { return __hip_atomic_load(p, __ATOMIC_RELAXED, __HIP_MEMORY_SCOPE_AGENT); }
__device__ __forceinline__ unsigned xb_add(unsigned* p, unsigned v) { return __hip_atomic_fetch_add(p, v, __ATOMIC_RELAXED, __HIP_MEMORY_SCOPE_AGENT); }
__device__ __forceinline__ unsigned xb_xcc_id() { return (unsigned)__builtin_amdgcn_s_getreg((3 << 11) | 20) & 0xFu; }
#define XB_SPIN(cond, bar) do { unsigned _sp = 0; while (cond) { __builtin_amdgcn_s_sleep(1); \
    if ((++_sp & 255u) == 0u) { if (xb_ld(&(bar)[XB_TMO])) break; if (_sp > XB_SPIN_CAP) { atomicAdd(&(bar)[XB_TMO], 1u); break; } } } } while (0)

struct XcdBarrier {
    unsigned* bar; unsigned x;
    volatile LAS unsigned* st;
};

__device__ __forceinline__ XcdBarrier xcd_barrier_post(unsigned* bar, volatile LAS unsigned* st) {
    XcdBarrier b; b.bar = bar; b.x = xb_xcc_id(); b.st = st;
    if (threadIdx.x == 0) (void)xb_add(&bar[XB_XCNT(b.x)], 1u);
    return b;
}
__device__ __forceinline__ void xcd_barrier_complete(unsigned* bar, unsigned x, unsigned& nloc, unsigned& nx) {
    const unsigned G = gridDim.x * gridDim.y * gridDim.z;
    unsigned sum, cnt, mine, sp = 0u;
    for (;;) {
        sum = 0u; cnt = 0u; mine = 0u;
#pragma unroll
        for (unsigned j = 0; j < 16; ++j) { const unsigned c = xb_ld(&bar[XB_XCNT(j)]); sum += c; cnt += (c > 0u) ? 1u : 0u; mine = (j == x) ? c : mine; }
        if (sum == G) break;
        __builtin_amdgcn_s_sleep(1);
        if ((++sp & 255u) == 0u) { if (xb_ld(&bar[XB_TMO])) break; if (sp > XB_SPIN_CAP) { atomicAdd(&bar[XB_TMO], 1u); break; } }
    }
    nloc = mine > 0u ? mine : 1u; nx = cnt > 0u ? cnt : 1u;
}

__device__ __forceinline__ void xcd_barrier(const XcdBarrier& b) {
    asm volatile("s_waitcnt vmcnt(0)" ::: "memory");
    __syncthreads();
    if (threadIdx.x == 0) {
        unsigned* bar = b.bar; asm volatile("" : "+s"(bar));
        __builtin_amdgcn_s_waitcnt(0);
        unsigned nloc = b.st[0], nx = b.st[1];
        if (nloc == 0u) { xcd_barrier_complete(bar, b.x, nloc, nx); b.st[0] = nloc; b.st[1] = nx; }
        const unsigned old = xb_add(&bar[XB_XSUB(b.x)], 1u);
        const unsigned gen = old / nloc;
        if (old + 1u == (gen + 1u) * nloc) {
            __builtin_amdgcn_fence(__ATOMIC_RELEASE, "agent");
            asm volatile("s_waitcnt vmcnt(0)" ::: "memory");
            const unsigned og = xb_add(&bar[XB_TOP], 1u);
            const unsigned tg = og / nx;
            if (og + 1u == (tg + 1u) * nx) xb_add(&bar[XB_TOPGEN], 1u);
            else XB_SPIN(xb_ld(&bar[XB_TOPGEN]) == tg, bar);
            __builtin_amdgcn_fence(__ATOMIC_ACQUIRE, "agent");
            xb_add(&bar[XB_XGEN(b.x)], 1u);
            asm volatile("s_waitcnt vmcnt(0)" ::: "memory");
        } else {
            XB_SPIN(xb_ld(&bar[XB_XGEN(b.x)]) == gen, bar);
            __builtin_amdgcn_fence(__ATOMIC_ACQUIRE, "agent");
            asm volatile("s_waitcnt vmcnt(0)" ::: "memory");
        }
    }
    __syncthreads();
}


struct Args { const float* in[N_IN]; float* out; unsigned char* ws; int ph_lo, ph_hi, li, pad; };
typedef const __attribute__((address_space(4))) Args& ArgsR;
__device__ __forceinline__ const __attribute__((address_space(4))) Args* kargs() { unsigned long long p = (unsigned long long)__builtin_amdgcn_kernarg_segment_ptr(); asm volatile("" : "+s"(p)); return (const __attribute__((address_space(4))) Args*)p; }

__device__ __forceinline__ int win_src_col(int n) {
    if (n < 2048) return n;
    if (n < 3072) return 2064 + (n - 2048);
    if (n < 5120) return 3088 + (n - 3072);
    if (n < 7168) return 5144 + (n - 5120);
    if (n < 7184) return 2048 + (n - 7168);
    if (n < 7192) return 5136 + (n - 7184);
    if (n < 7200) return n;
    return -1;
}
template <bool MAP>
__device__ __forceinline__ void p0_transpose_item(const float* W, int K, int Nsrc, int Ndst, const float* gain, bf16* WT, LAS float* scr, int item, int lane) {
    const int nblk = Ndst / 32, kb = item / nblk, nb = item % nblk, k0 = 64 * kb, n0 = 32 * nb;
    const int nn = n0 + (lane & 31); const int src = MAP ? win_src_col(nn) : nn;
    float tv[32];
#pragma unroll
    for (int i = 0; i < 32; ++i) { const int kk = 2 * i + (lane >> 5); tv[i] = (src >= 0) ? W[(size_t)(k0 + kk) * Nsrc + src] : 0.f; }
#pragma unroll
    for (int i = 0; i < 32; ++i) { const int kk = 2 * i + (lane >> 5); float v = tv[i]; if (gain) v *= gain[k0 + kk]; scr[kk * 33 + (lane & 31)] = v; }
    asm volatile("s_waitcnt lgkmcnt(0)" ::: "memory");
    const int c = lane & 7;
#pragma unroll
    for (int j = 0; j < 4; ++j) { const int n = (lane >> 3) + 8 * j; const LAS float* s = scr + (8 * c) * 33 + n;
        v4u o; o.x = pk2(s[0 * 33], s[1 * 33]); o.y = pk2(s[2 * 33], s[3 * 33]); o.z = pk2(s[4 * 33], s[5 * 33]); o.w = pk2(s[6 * 33], s[7 * 33]);
        *(GAS v4u*)(WT + (size_t)(n0 + n) * K + k0 + 8 * c) = o; }
    asm volatile("s_waitcnt lgkmcnt(0)" ::: "memory");
}
__device__ __forceinline__ void p0_convert(const float* src, bf16* dst, size_t n, size_t gtid, size_t gthreads) {
    for (size_t i = gtid * 8; i < n; i += gthreads * 8) {
        const f32x4 a = *(const GAS f32x4*)(src + i), b = *(const GAS f32x4*)(src + i + 4);
        v4u o; o.x = pk2(a[0], a[1]); o.y = pk2(a[2], a[3]); o.z = pk2(b[0], b[1]); o.w = pk2(b[2], b[3]);
        *(GAS v4u*)(dst + i) = o; }
}
__device__ __forceinline__ void p0_prologue(ArgsR A, LAS unsigned char* lds, int vcu, int G, int wave, int lane) {
    unsigned char* ws = A.ws;
    LAS float* scr = (LAS float*)(lds + wave * 16384);
    const int gw = vcu * NWAVES + wave, NGW = G * NWAVES;
    constexpr int I_IN = (DM / 64) * (NINP / 32), I_SQ = (DM / 64) * (DM / 32), I_LAYER = I_IN + 2 * I_SQ, NITEMS = DEPTH * I_LAYER;
    for (int it = gw; it < NITEMS; it += NGW) {
        const int l = it / I_LAYER; int r = it % I_LAYER;
        if (r < I_IN) { p0_transpose_item<true>(A.in[I_WIN] + (size_t)l * DM * DIN, DM, DIN, NINP, A.in[I_N1G] + l * DM, (bf16*)(ws + WS_WIN + l * WIN_L), scr, r, lane); continue; } r -= I_IN;
        if (r < I_SQ) { p0_transpose_item<false>(A.in[I_WOUT] + (size_t)l * DM * DM, DM, DM, DM, nullptr, (bf16*)(ws + WS_WOUT + l * WSQ_L), scr, r, lane); continue; } r -= I_SQ;
        p0_transpose_item<false>(A.in[I_PWQ] + (size_t)l * DM * DM, DM, DM, DM, A.in[I_N2G] + l * DM, (bf16*)(ws + WS_WQ + l * WSQ_L), scr, r, lane);
    }
    const size_t gtid = (size_t)gw * 64 + lane, gthreads = (size_t)NGW * 64;
    p0_convert(A.in[I_PK1], (bf16*)(ws + WS_K1), (size_t)DEPTH * 8 * 128 * 128, gtid, gthreads);
    p0_convert(A.in[I_PK2], (bf16*)(ws + WS_K2), (size_t)DEPTH * 8 * 128 * 128, gtid, gthreads);
    const float* x = A.in[I_X]; bf16* xb = (bf16*)(ws + WS_XB); float* rstd1 = (float*)(ws + WS_RSTD1);
    for (int m = gw; m < NT; m += NGW) {
        const GAS f32x4* xr = (const GAS f32x4*)(x + (size_t)m * DM) + lane;
        f32x4 v[8]; float s = 0.f;
#pragma unroll
        for (int j = 0; j < 8; ++j) { v[j] = xr[64 * j]; s += (v[j][0] * v[j][0] + v[j][1] * v[j][1]) + (v[j][2] * v[j][2] + v[j][3] * v[j][3]); }
        s = wave_sum(s);
        GAS v2u* o = (GAS v2u*)(xb + (size_t)m * DM) + lane;
#pragma unroll
        for (int j = 0; j < 8; ++j) { v2u w; w.x = pk2(v[j][0], v[j][1]); w.y = pk2(v[j][2], v[j][3]); o[64 * j] = w; }
        if (lane == 0) rstd1[m] = rsqrtf(s * (1.0f / DM) + RMS_EPS);
    }
}

constexpr int NM_Q = 0, NM_K = 32768, NM_A = 65536, NM_V = 98304, NM_PARTS = 131072  , NM_SC = 135168  ;

__device__ __forceinline__ void nm_load_tile(const bf16* g, size_t ld, LAS float* dst, int tid) {
#pragma unroll
    for (int i = 0; i < 2; ++i) { const int idx = tid + i * NTHREADS, r = idx >> 4, c8 = (idx & 15) * 8;
        const v4u w = *(const GAS v4u*)(g + (size_t)r * ld + c8);
        f32x4 a = {bflo(w.x), bfhi(w.x), bflo(w.y), bfhi(w.y)}, b = {bflo(w.z), bfhi(w.z), bflo(w.w), bfhi(w.w)};
        *(LAS f32x4*)(dst + r * 128 + c8) = a; *(LAS f32x4*)(dst + r * 128 + c8 + 4) = b; }
}
template <int GATE>
__device__ __forceinline__ void nm_finalize(const LAS float* vs, const float* ng, const bf16* gate, size_t gld, bf16* mixp, int wave, int lane) {
#pragma unroll 1
    for (int rr = 0; rr < 8; ++rr) { const int c = wave * 8 + rr;
        const float o1 = vs[c * 128 + lane], o2 = vs[c * 128 + 64 + lane];
        const float ss = wave_sum(o1 * o1 + o2 * o2), rs = rsqrtf(ss * (1.0f / 128.0f) + RMS_EPS);
        float r1 = o1 * rs * ng[lane], r2 = o2 * rs * ng[64 + lane];
        if (GATE == 1) { r1 *= siluf_(bf2f(gate[(size_t)c * gld + lane])); r2 *= siluf_(bf2f(gate[(size_t)c * gld + 64 + lane])); }
        mixp[(size_t)c * DM + lane] = (bf16)f2bf(r1); mixp[(size_t)c * DM + 64 + lane] = (bf16)f2bf(r2); }
}

__device__ __forceinline__ void nm_gla(ArgsR A, int l, int b, int h, LAS unsigned char* lds, int tid) {
    const bf16* P = (const bf16*)(A.ws + WS_P); const float* Ps = (const float*)(A.ws + WS_PS); bf16* mix = (bf16*)(A.ws + WS_MIX);
    LAS float* qs = (LAS float*)(lds + NM_Q); LAS float* ks = (LAS float*)(lds + NM_K); LAS float* as = (LAS float*)(lds + NM_A); LAS float* vs = (LAS float*)(lds + NM_V);
    LAS float* parts = (LAS float*)(lds + NM_PARTS); LAS float* lrs = (LAS float*)(lds + NM_SC);
    const int v = tid & 127, dq = tid >> 7, wave = tid >> 6, lane = tid & 63;
    const float* w2 = A.in[I_GLA_W2] + (size_t)l * 16 * GW + h * HD + v;
    float w2c[16];
#pragma unroll
    for (int r = 0; r < 16; ++r) w2c[r] = w2[r * GW];
    const float b2 = A.in[I_GLA_B2][l * GW + h * HD + v];
    const float* ng = A.in[I_GLA_NG] + l * GW + h * HD;
    float S[32];
#pragma unroll
    for (int i = 0; i < 32; ++i) S[i] = 0.f;
#pragma unroll 1
    for (int n = 0; n < NCHK; ++n) {
        const size_t r0 = (size_t)b * SEQ + n * CHK;
        nm_load_tile(P + r0 * PBW + PC_GLA_Q + h * HD, PBW, qs, tid);
        nm_load_tile(P + r0 * PBW + PC_GLA_K + h * HD, PBW, ks, tid);
        nm_load_tile(P + r0 * PBW + PC_GLA_V + h * HD, PBW, vs, tid);
        for (int i = tid; i < 64 * 16; i += NTHREADS) lrs[i] = Ps[(r0 + (i >> 4)) * 32 + PS_LR + (i & 15)];
        __syncthreads();
#pragma unroll 1
        for (int i = 0; i < 16; ++i) { const int c = dq * 16 + i; float z = b2;
#pragma unroll
            for (int r = 0; r < 16; ++r) z += lrs[c * 16 + r] * w2c[r];
            as[c * 128 + v] = __expf(logsigmoidf_(z) * (1.0f / 16.0f)); }
        __syncthreads();
#pragma unroll 1
        for (int c = 0; c < CHK; ++c) {
            const float vt = vs[c * 128 + v]; float part = 0.f;
            const LAS f32x4* q4 = (const LAS f32x4*)(qs + c * 128 + dq * 32); const LAS f32x4* k4 = (const LAS f32x4*)(ks + c * 128 + dq * 32); const LAS f32x4* a4 = (const LAS f32x4*)(as + c * 128 + dq * 32);
#pragma unroll
            for (int i4 = 0; i4 < 8; ++i4) { const f32x4 qv = q4[i4], kv = k4[i4], av = a4[i4];
#pragma unroll
                for (int j = 0; j < 4; ++j) { S[i4 * 4 + j] = av[j] * S[i4 * 4 + j] + kv[j] * vt; part += qv[j] * S[i4 * 4 + j]; } }
            parts[((c & 1) * 4 + dq) * 128 + v] = part;
            __syncthreads();
            if (dq == 0) { const LAS float* pp = parts + (c & 1) * 512 + v; vs[c * 128 + v] = ((pp[0] + pp[128]) + (pp[256] + pp[384])) * 0.08838834764831845f; }
        }
        __syncthreads();
        nm_finalize<1>(vs, ng, P + r0 * PBW + PC_GLA_G + h * HD, PBW, mix + r0 * DM + 0 + h * HD, wave, lane);
        __syncthreads();
    }
}

__device__ __forceinline__ void nm_mlstm(ArgsR A, int l, int b, int h, LAS unsigned char* lds, int tid) {
    const bf16* P = (const bf16*)(A.ws + WS_P); const float* Ps = (const float*)(A.ws + WS_PS); bf16* mix = (bf16*)(A.ws + WS_MIX);
    LAS float* qs = (LAS float*)(lds + NM_Q); LAS float* ks = (LAS float*)(lds + NM_K); LAS float* vs = (LAS float*)(lds + NM_V);
    LAS float* parts = (LAS float*)(lds + NM_PARTS); LAS float* dparts = (LAS float*)(lds + NM_A);
    LAS float* fs = (LAS float*)(lds + NM_SC); LAS float* es = fs + 64;
    const int v = tid & 127, dq = tid >> 7, wave = tid >> 6, lane = tid & 63;
    const float ib = A.in[I_ML_IB][l * NH + h], fb = A.in[I_ML_FB][l * NH + h];
    const float* ng = A.in[I_ML_NG] + l * GW + h * HD;
    float C[32], nn[32];
#pragma unroll
    for (int i = 0; i < 32; ++i) { C[i] = 0.f; nn[i] = 0.f; }
#pragma unroll 1
    for (int n = 0; n < NCHK; ++n) {
        const size_t r0 = (size_t)b * SEQ + n * CHK;
        nm_load_tile(P + r0 * PBW + PC_ML_Q + h * HD, PBW, qs, tid);
        nm_load_tile(P + r0 * PBW + PC_ML_K + h * HD, PBW, ks, tid);
        nm_load_tile(P + r0 * PBW + PC_ML_V + h * HD, PBW, vs, tid);
        if (tid < 64) { fs[tid] = sigmoidf_(Ps[(r0 + tid) * 32 + PS_MF + h] + fb); es[tid] = __expf(Ps[(r0 + tid) * 32 + PS_MI + h] + ib) * 0.08838834764831845f; }
        __syncthreads();
#pragma unroll 1
        for (int c = 0; c < CHK; ++c) {
            const float vt = vs[c * 128 + v], f = fs[c], ei = es[c]; float part = 0.f, dpart = 0.f;
            const LAS f32x4* q4 = (const LAS f32x4*)(qs + c * 128 + dq * 32); const LAS f32x4* k4 = (const LAS f32x4*)(ks + c * 128 + dq * 32);
#pragma unroll
            for (int i4 = 0; i4 < 8; ++i4) { const f32x4 qv = q4[i4], kv = k4[i4];
#pragma unroll
                for (int j = 0; j < 4; ++j) { const float kd = kv[j] * ei; C[i4 * 4 + j] = f * C[i4 * 4 + j] + kd * vt; nn[i4 * 4 + j] = f * nn[i4 * 4 + j] + kd;
                    part += qv[j] * C[i4 * 4 + j]; dpart += qv[j] * nn[i4 * 4 + j]; } }
            parts[((c & 1) * 4 + dq) * 128 + v] = part; if (v == 0) dparts[(c & 1) * 4 + dq] = dpart;
            __syncthreads();
            if (dq == 0) { const LAS float* pp = parts + (c & 1) * 512 + v; const LAS float* dp = dparts + (c & 1) * 4;
                const float num = (pp[0] + pp[128]) + (pp[256] + pp[384]), dot = (dp[0] + dp[1]) + (dp[2] + dp[3]);
                const float og = bf2f(P[(r0 + c) * PBW + PC_ML_O + h * HD + v]);
                vs[c * 128 + v] = num / fmaxf(fabsf(dot), 1.0f) * sigmoidf_(og); }
        }
        __syncthreads();
        nm_finalize<0>(vs, ng, nullptr, 0, mix + r0 * DM + 1024 + h * HD, wave, lane);
        __syncthreads();
    }
}

__device__ __forceinline__ void nm_gdn(ArgsR A, int l, int b, int h, LAS unsigned char* lds, int tid) {
    const bf16* P = (const bf16*)(A.ws + WS_P); const float* Ps = (const float*)(A.ws + WS_PS); bf16* mix = (bf16*)(A.ws + WS_MIX);
    LAS float* qs = (LAS float*)(lds + NM_Q); LAS float* ks = (LAS float*)(lds + NM_K); LAS float* vs = (LAS float*)(lds + NM_V);
    LAS float* parts = (LAS float*)(lds + NM_PARTS);
    LAS float* egs = (LAS float*)(lds + NM_SC); LAS float* bts = egs + 64; LAS float* rq = egs + 128; LAS float* rk = egs + 192;
    const int v = tid & 127, dq = tid >> 7, wave = tid >> 6, lane = tid & 63;
    const float* cw = A.in[I_GDN_CW] + (size_t)l * 4 * 1536;
    const float nalog = -__expf(A.in[I_GDN_ALOG][l * NH + h]), dtb = A.in[I_GDN_DTB][l * NH + h];
    const float* ng = A.in[I_GDN_NG] + l * GW + h * HD;
    float S[32];
#pragma unroll
    for (int i = 0; i < 32; ++i) S[i] = 0.f;
#pragma unroll 1
    for (int n = 0; n < NCHK; ++n) {
        const size_t r0 = (size_t)b * SEQ + n * CHK;
#pragma unroll 1
        for (int part = 0; part < 3; ++part) {
            const int pc = (part == 0 ? PC_GDN_Q : part == 1 ? PC_GDN_K : PC_GDN_V) + h * HD + v, wc = part * 512 + h * HD + v;
            const float w0 = cw[wc], w1 = cw[1536 + wc], w2 = cw[2 * 1536 + wc], w3 = cw[3 * 1536 + wc];
            LAS float* dst = part == 0 ? qs : part == 1 ? ks : vs;
            const int c0 = dq * 16; const long t0 = (long)n * CHK + c0;
            float xm3 = (t0 - 3 >= 0) ? bf2f(P[(r0 + c0 - 3) * PBW + pc]) : 0.f, xm2 = (t0 - 2 >= 0) ? bf2f(P[(r0 + c0 - 2) * PBW + pc]) : 0.f, xm1 = (t0 - 1 >= 0) ? bf2f(P[(r0 + c0 - 1) * PBW + pc]) : 0.f;
#pragma unroll 4
            for (int i = 0; i < 16; ++i) { const float x0 = bf2f(P[(r0 + c0 + i) * PBW + pc]); const float y = w0 * xm3 + w1 * xm2 + w2 * xm1 + w3 * x0;
                dst[(c0 + i) * 128 + v] = siluf_(y); xm3 = xm2; xm2 = xm1; xm1 = x0; }
        }
        if (tid < 64) { bts[tid] = sigmoidf_(Ps[(r0 + tid) * 32 + PS_GB + h]); egs[tid] = __expf(nalog * softplusf_(Ps[(r0 + tid) * 32 + PS_GA + h] + dtb)); }
        __syncthreads();
#pragma unroll 1
        for (int rr = 0; rr < 8; ++rr) { const int c = wave * 8 + rr;
            const float q1 = qs[c * 128 + lane], q2 = qs[c * 128 + 64 + lane], k1 = ks[c * 128 + lane], k2 = ks[c * 128 + 64 + lane];
            const float sq = wave_sum(q1 * q1 + q2 * q2), sk = wave_sum(k1 * k1 + k2 * k2);
            if (lane == 0) { rq[c] = rsqrtf(sq + 1e-6f) * 0.08838834764831845f; rk[c] = rsqrtf(sk + 1e-6f); } }
        __syncthreads();
#pragma unroll 1
        for (int c = 0; c < CHK; ++c) {
            const float vt = vs[c * 128 + v], e = egs[c], bt = bts[c], sq = rq[c], sk = rk[c]; float part = 0.f;
            const LAS f32x4* q4 = (const LAS f32x4*)(qs + c * 128 + dq * 32); const LAS f32x4* k4 = (const LAS f32x4*)(ks + c * 128 + dq * 32);
            f32x4 kv[8];
#pragma unroll
            for (int i4 = 0; i4 < 8; ++i4) { kv[i4] = k4[i4] * sk;
#pragma unroll
                for (int j = 0; j < 4; ++j) { S[i4 * 4 + j] *= e; part += kv[i4][j] * S[i4 * 4 + j]; } }
            parts[dq * 128 + v] = part;
            __syncthreads();
            const float kS = (parts[v] + parts[128 + v]) + (parts[256 + v] + parts[384 + v]);
            const float u = bt * (vt - kS); float part2 = 0.f;
#pragma unroll
            for (int i4 = 0; i4 < 8; ++i4) { const f32x4 qv = q4[i4] * sq;
#pragma unroll
                for (int j = 0; j < 4; ++j) { S[i4 * 4 + j] += kv[i4][j] * u; part2 += qv[j] * S[i4 * 4 + j]; } }
            parts[512 + dq * 128 + v] = part2;
            __syncthreads();
            if (dq == 0) vs[c * 128 + v] = (parts[512 + v] + parts[640 + v]) + (parts[768 + v] + parts[896 + v]);
        }
        __syncthreads();
        nm_finalize<1>(vs, ng, P + r0 * PBW + PC_GDN_G + h * HD, PBW, mix + r0 * DM + 1536 + h * HD, wave, lane);
        __syncthreads();
    }
}

__device__ __forceinline__ void nm_lru(ArgsR A, int l, int b, int j, LAS unsigned char* lds, int tid) {
    const bf16* P = (const bf16*)(A.ws + WS_P); bf16* mix = (bf16*)(A.ws + WS_MIX);
    LAS float* xc = (LAS float*)(lds);
    LAS float* was = (LAS float*)(lds + 20480);
    LAS float* wxs = (LAS float*)(lds + 36864);
    LAS float* aa = (LAS float*)(lds + 53248);
    LAS float* uu = (LAS float*)(lds + 69632);
    const float* wa = A.in[I_LRU_WA] + ((size_t)l * 8 + j) * 4096; const float* wx = A.in[I_LRU_WX] + ((size_t)l * 8 + j) * 4096;
    for (int i = tid; i < 4096; i += NTHREADS) { was[i] = wa[i]; wxs[i] = wx[i]; }
    const float* cw = A.in[I_LRU_CW] + (size_t)l * 4 * GW; const float* cb = A.in[I_LRU_CB] + l * GW;
    const float* ba = A.in[I_LRU_BA] + l * GW + j * 64; const float* bx = A.in[I_LRU_BX] + l * GW + j * 64; const float* lam = A.in[I_LRU_LAM] + l * GW + j * 64;
    float hstate = 0.f;
#pragma unroll 1
    for (int n = 0; n < NCHK; ++n) {
        const size_t r0 = (size_t)b * SEQ + n * CHK;
        { const int cc = tid & 63, c0 = (tid >> 6) * 8, ch = j * 64 + cc, pc = PC_LRU_X + ch; const long t0 = (long)n * CHK + c0;
            const float w0 = cw[ch], w1 = cw[GW + ch], w2 = cw[2 * GW + ch], w3 = cw[3 * GW + ch], bias = cb[ch];
            float xm3 = (t0 - 3 >= 0) ? bf2f(P[(r0 + c0 - 3) * PBW + pc]) : 0.f, xm2 = (t0 - 2 >= 0) ? bf2f(P[(r0 + c0 - 2) * PBW + pc]) : 0.f, xm1 = (t0 - 1 >= 0) ? bf2f(P[(r0 + c0 - 1) * PBW + pc]) : 0.f;
#pragma unroll
            for (int i = 0; i < 8; ++i) { const float x0 = bf2f(P[(r0 + c0 + i) * PBW + pc]); xc[(c0 + i) * 65 + cc] = w0 * xm3 + w1 * xm2 + w2 * xm1 + w3 * x0 + bias; xm3 = xm2; xm2 = xm1; xm1 = x0; } }
        __syncthreads();
        { const int tok = tid >> 3, cg = tid & 7; float ra[8], ri[8];
#pragma unroll
            for (int q = 0; q < 8; ++q) { ra[q] = ba[cg * 8 + q]; ri[q] = bx[cg * 8 + q]; }
#pragma unroll 4
            for (int i = 0; i < 64; ++i) { const float xv = xc[tok * 65 + i];
                const f32x4 a0 = *(const LAS f32x4*)(was + i * 64 + cg * 8), a1 = *(const LAS f32x4*)(was + i * 64 + cg * 8 + 4);
                const f32x4 x0 = *(const LAS f32x4*)(wxs + i * 64 + cg * 8), x1 = *(const LAS f32x4*)(wxs + i * 64 + cg * 8 + 4);
#pragma unroll
                for (int q = 0; q < 4; ++q) { ra[q] += xv * a0[q]; ra[4 + q] += xv * a1[q]; ri[q] += xv * x0[q]; ri[4 + q] += xv * x1[q]; } }
#pragma unroll
            for (int q = 0; q < 8; ++q) { const int jj = cg * 8 + q; const float r = sigmoidf_(ra[q]), ig = sigmoidf_(ri[q]);
                const float log_a = -8.0f * r * softplusf_(-lam[jj]); const float a = __expf(log_a), u = sqrtf(-expm1f(2.0f * log_a)) * (ig * xc[tok * 65 + jj]);
                aa[tok * 64 + jj] = a; uu[tok * 64 + jj] = u; } }
        __syncthreads();
        if (tid < 64) { const int ch = j * 64 + tid;
#pragma unroll 4
            for (int c = 0; c < CHK; ++c) { hstate = aa[c * 64 + tid] * hstate + uu[c * 64 + tid];
                const float y = bf2f(P[(r0 + c) * PBW + PC_LRU_Y + ch]); mix[(r0 + c) * DM + 512 + ch] = (bf16)f2bf(gelu_tanh(y) * hstate); } }
        __syncthreads();
    }
}

__device__ __forceinline__ void nm_phase(ArgsR A, int l, LAS unsigned char* lds, int G, int tid) {
    for (int it = blockIdx.x; it < 80; it += G) {
        if (it < 16) nm_gla(A, l, it >> 2, it & 3, lds, tid);
        else if (it < 32) nm_mlstm(A, l, (it - 16) >> 2, (it - 16) & 3, lds, tid);
        else if (it < 48) nm_gdn(A, l, (it - 32) >> 2, (it - 32) & 3, lds, tid);
        else nm_lru(A, l, (it - 48) >> 3, (it - 48) & 7, lds, tid);
        __syncthreads();
    }
}

constexpr size_t WS_GLA_INC = 562 * MiB;
constexpr size_t WS_GLA_DEC = 594 * MiB;
constexpr size_t WS_GLA_ST = 595 * MiB;
constexpr size_t WS_ML_INC = 611 * MiB;
constexpr size_t WS_ML_N = 643 * MiB;
constexpr size_t WS_ML_SC = 643 * MiB + 512 * 1024;
constexpr size_t WS_ML_ST = 644 * MiB;
constexpr size_t WS_ML_NP = 660 * MiB;
constexpr size_t WS_ML_MP = 660 * MiB + 512 * 1024;
constexpr size_t WS_GDN_U0 = 661 * MiB, WS_GDN_W = 669 * MiB, WS_GDN_QD = 677 * MiB, WS_GDN_KE = 685 * MiB;
constexpr size_t WS_GDN_QK = 693 * MiB;
constexpr size_t WS_GDN_DE = 697 * MiB;
constexpr size_t WS_GDN_O = 698 * MiB;
constexpr size_t WS_LRU_HL = 714 * MiB, WS_LRU_AP = 730 * MiB;
constexpr size_t WS_LRU_CARRY = 746 * MiB;
static_assert(WS_LRU_CARRY + 4 * 32 * 512 * 4 <= WS_END, "ws map");

constexpr int CW_PBAR = 2048;
typedef short v4i16_t __attribute__((ext_vector_type(4)));
constexpr int LD128 = 136, LD64 = 72;

__device__ __forceinline__ bf16x8 frag_rd(const LAS bf16* t, int ld, int row0, int k0, int lane) { return *(const LAS bf16x8*)(t + (row0 + (lane & 15)) * ld + k0 + 8 * (lane >> 4)); }
__device__ __forceinline__ bf16x8 frag_rd_perm(const LAS bf16* t, int ld, int row0, int k0, int lane) {
    const LAS bf16* p = t + (row0 + (lane & 15)) * ld + k0 + 4 * (lane >> 4);
    const bf16x4 a = *(const LAS bf16x4*)p, b = *(const LAS bf16x4*)(p + 16);
    return (bf16x8){a[0], a[1], a[2], a[3], b[0], b[1], b[2], b[3]};
}
__device__ __forceinline__ bf16x8 frag_tr(const LAS bf16* t, int ld, int k0, int n0, int lane) {
    const int i = lane & 15, g = lane >> 4; const LAS bf16* p = t + (k0 + 8 * g + (i >> 2)) * ld + n0 + 4 * (i & 3);
    const v4i16_t a = __builtin_amdgcn_ds_read_tr16_b64_v4i16((LAS v4i16_t*)p), b = __builtin_amdgcn_ds_read_tr16_b64_v4i16((LAS v4i16_t*)(p + 4 * ld));
    return (bf16x8){a[0], a[1], a[2], a[3], b[0], b[1], b[2], b[3]};
}
__device__ __forceinline__ bf16x8 frag_tr_perm(const LAS bf16* t, int ld, int k0, int n0, int lane) {
    const int i = lane & 15, g = lane >> 4; const LAS bf16* p = t + (k0 + 4 * g + (i >> 2)) * ld + n0 + 4 * (i & 3);
    const v4i16_t a = __builtin_amdgcn_ds_read_tr16_b64_v4i16((LAS v4i16_t*)p), b = __builtin_amdgcn_ds_read_tr16_b64_v4i16((LAS v4i16_t*)(p + 16 * ld));
    return (bf16x8){a[0], a[1], a[2], a[3], b[0], b[1], b[2], b[3]};
}
__device__ __forceinline__ bf16x8 pack_acc(const f32x4& lo, const f32x4& hi) {
    v4u w; w.x = pg8::cvt_pk_bf16(lo[0], lo[1]); w.y = pg8::cvt_pk_bf16(lo[2], lo[3]); w.z = pg8::cvt_pk_bf16(hi[0], hi[1]); w.w = pg8::cvt_pk_bf16(hi[2], hi[3]);
    return __builtin_bit_cast(bf16x8, w);
}
#define MFMA16(a, b, c) __builtin_amdgcn_mfma_f32_16x16x32_bf16((a), (b), (c), 0, 0, 0)

template <int ROWS>
__device__ __forceinline__ void tile_g2l_128(const bf16* g, size_t gld, LAS bf16* t, int tid) {
#pragma unroll
    for (int i = 0; i < ROWS * 16 / NTHREADS; ++i) { const int idx = tid + i * NTHREADS, r = idx >> 4, c8 = (idx & 15) * 8;
        *(LAS v4u*)(t + r * LD128 + c8) = *(const GAS v4u*)(g + (size_t)r * gld + c8); }
}
__device__ __forceinline__ float wave_scan_add(float v, int lane) {
#pragma unroll
    for (int o = 1; o < 64; o <<= 1) { const float t = __shfl_up(v, o); if (lane >= o) v += t; }
    return v;
}
__device__ __forceinline__ float wave_scan_max(float v, int lane) {
#pragma unroll
    for (int o = 1; o < 64; o <<= 1) { const float t = __shfl_up(v, o); if (lane >= o) v = fmaxf(v, t); }
    return v;
}
__device__ __forceinline__ float wave_max(float v) {
#pragma unroll
    for (int o = 1; o < 64; o <<= 1) v = fmaxf(v, __shfl_xor(v, o));
    return v;
}

__device__ __forceinline__ void f_lru_p2(ArgsR A, int l, int item, LAS unsigned char* lds, int tid) {
    const int j = item & 7, n = (item >> 3) & 31, b = item >> 8;
    const bf16* P = (const bf16*)(A.ws + WS_P); float* HLg = (float*)(A.ws + WS_LRU_HL); float* APg = (float*)(A.ws + WS_LRU_AP);
    LAS float* xc = (LAS float*)(lds); LAS float* was = (LAS float*)(lds + 20480); LAS float* wxs = (LAS float*)(lds + 36864);
    LAS float* aa = (LAS float*)(lds + 53248); LAS float* uu = (LAS float*)(lds + 69632); LAS float* segA = (LAS float*)(lds + 86016); LAS float* segH = (LAS float*)(lds + 88064);
    const float* wa = A.in[I_LRU_WA] + ((size_t)l * 8 + j) * 4096; const float* wx = A.in[I_LRU_WX] + ((size_t)l * 8 + j) * 4096;
    for (int i = tid; i < 4096; i += NTHREADS) { was[i] = wa[i]; wxs[i] = wx[i]; }
    const float* cw = A.in[I_LRU_CW] + (size_t)l * 4 * GW; const float* cb = A.in[I_LRU_CB] + l * GW;
    const float* ba = A.in[I_LRU_BA] + l * GW + j * 64; const float* bx = A.in[I_LRU_BX] + l * GW + j * 64; const float* lam = A.in[I_LRU_LAM] + l * GW + j * 64;
    const size_t r0 = (size_t)b * SEQ + n * CHK;
    float ba8[8], bx8[8], lam8[8];
#pragma unroll
    for (int q = 0; q < 8; ++q) { ba8[q] = ba[(tid & 7) * 8 + q]; bx8[q] = bx[(tid & 7) * 8 + q]; lam8[q] = lam[(tid & 7) * 8 + q]; }
    { const int cc = tid & 63, c0 = (tid >> 6) * 8, ch = j * 64 + cc, pc = PC_LRU_X + ch; const long t0 = (long)n * CHK + c0;
        const float w0 = cw[ch], w1 = cw[GW + ch], w2 = cw[2 * GW + ch], w3 = cw[3 * GW + ch], bias = cb[ch];
        float xm3 = (t0 - 3 >= 0) ? bf2f(P[(r0 + c0 - 3) * PBW + pc]) : 0.f, xm2 = (t0 - 2 >= 0) ? bf2f(P[(r0 + c0 - 2) * PBW + pc]) : 0.f, xm1 = (t0 - 1 >= 0) ? bf2f(P[(r0 + c0 - 1) * PBW + pc]) : 0.f;
#pragma unroll
        for (int i = 0; i < 8; ++i) { const float x0 = bf2f(P[(r0 + c0 + i) * PBW + pc]); xc[(c0 + i) * 65 + cc] = w0 * xm3 + w1 * xm2 + w2 * xm1 + w3 * x0 + bias; xm3 = xm2; xm2 = xm1; xm1 = x0; } }
    __syncthreads();
    { const int tok = tid >> 3, cg = tid & 7; float ra[8], ri[8], spl[8];
#pragma unroll
        for (int q = 0; q < 8; ++q) { ra[q] = ba8[q]; ri[q] = bx8[q]; spl[q] = softplusf_(-lam8[q]); }
#pragma unroll 4
        for (int i = 0; i < 64; ++i) { const float xv = xc[tok * 65 + i];
            const f32x4 a0 = *(const LAS f32x4*)(was + i * 64 + cg * 8), a1 = *(const LAS f32x4*)(was + i * 64 + cg * 8 + 4);
            const f32x4 x0 = *(const LAS f32x4*)(wxs + i * 64 + cg * 8), x1 = *(const LAS f32x4*)(wxs + i * 64 + cg * 8 + 4);
#pragma unroll
            for (int q = 0; q < 4; ++q) { ra[q] += xv * a0[q]; ra[4 + q] += xv * a1[q]; ri[q] += xv * x0[q]; ri[4 + q] += xv * x1[q]; } }
#pragma unroll
        for (int q = 0; q < 8; ++q) { const int jj = cg * 8 + q; const float r = sigmoidf_(ra[q]), ig = sigmoidf_(ri[q]);
            const float log_a = -8.0f * r * spl[q]; const float a = __expf(log_a), u = sqrtf(fmaxf(1.0f - a * a, 0.f)) * (ig * xc[tok * 65 + jj]);
            aa[tok * 64 + jj] = a; uu[tok * 64 + jj] = u; } }
    __syncthreads();
    const int cc = tid & 63, seg = tid >> 6;
    { float Ap = 1.f, Hl = 0.f;
#pragma unroll
        for (int i = 0; i < 8; ++i) { const int c = seg * 8 + i; const float a = aa[c * 64 + cc], u = uu[c * 64 + cc]; Hl = a * Hl + u; Ap *= a; aa[c * 64 + cc] = Ap; uu[c * 64 + cc] = Hl; }
        segA[seg * 64 + cc] = Ap; segH[seg * 64 + cc] = Hl; }
    __syncthreads();
    { float Ac = 1.f, Hc = 0.f;
#pragma unroll 1
        for (int s = 0; s < seg; ++s) { const float sa = segA[s * 64 + cc]; Hc = sa * Hc + segH[s * 64 + cc]; Ac *= sa; }
#pragma unroll
        for (int i = 0; i < 8; ++i) { const int c = seg * 8 + i; const float ap = aa[c * 64 + cc], hl = uu[c * 64 + cc];
            HLg[(r0 + c) * GW + j * 64 + cc] = ap * Hc + hl; APg[(r0 + c) * GW + j * 64 + cc] = ap * Ac; } }
    __syncthreads();
}
__device__ __forceinline__ void f_lru_p3(ArgsR A, int b, int tid) {
    const float* HLg = (const float*)(A.ws + WS_LRU_HL); const float* APg = (const float*)(A.ws + WS_LRU_AP); float* carry = (float*)(A.ws + WS_LRU_CARRY);
    float c = 0.f;
#pragma unroll 8
    for (int n = 0; n < NCHK; ++n) { carry[((size_t)b * NCHK + n) * GW + tid] = c; const size_t t = (size_t)b * SEQ + n * CHK + 63; c = APg[t * GW + tid] * c + HLg[t * GW + tid]; }
}
__device__ __forceinline__ void f_lru_p4(ArgsR A, int item, int tid) {
    const bf16* P = (const bf16*)(A.ws + WS_P); bf16* mix = (bf16*)(A.ws + WS_MIX);
    const float* HLg = (const float*)(A.ws + WS_LRU_HL); const float* APg = (const float*)(A.ws + WS_LRU_AP); const float* carry = (const float*)(A.ws + WS_LRU_CARRY);
    const float cr = carry[(size_t)item * GW + tid]; const size_t r0 = (size_t)item * CHK;
#pragma unroll 8
    for (int c = 0; c < CHK; ++c) { const float h = APg[(r0 + c) * GW + tid] * cr + HLg[(r0 + c) * GW + tid]; const float y = bf2f(P[(r0 + c) * PBW + PC_LRU_Y + tid]);
        mix[(r0 + c) * DM + 512 + tid] = (bf16)f2bf(gelu_tanh(y) * h); }
}

constexpr int FL_Q = 0, FL_K = 17408, FL_V = 34816, FL_ST = 52224, FL_SC = 87040, FL_BC = 96256, FL_LR = 129024, FL_SEG = 133120, FL_RS = 135168;
struct GlaW2 { float w[16]; float b2; };
__device__ __forceinline__ void gla_w2_load(ArgsR A, int l, int h, int tid, GlaW2& W) {
    const int d = tid & 127; const float* w2 = A.in[I_GLA_W2] + (size_t)l * 16 * GW + h * HD + d;
#pragma unroll
    for (int r = 0; r < 16; ++r) W.w[r] = w2[r * GW];
    W.b2 = A.in[I_GLA_B2][l * GW + h * HD + d];
}
__device__ __forceinline__ void gla_bcum(const GlaW2& W, LAS float* bc, LAS float* segt, const LAS float* lrs, int tid) {
    const int d = tid & 127, seg = tid >> 7; float run = 0.f;
#pragma unroll 4
    for (int i = 0; i < 16; ++i) { const int c = seg * 16 + i; float z = W.b2;
#pragma unroll
        for (int r = 0; r < 16; ++r) z += lrs[c * 16 + r] * W.w[r];
        run += logsigmoidf_(z) * (1.0f / 16.0f); bc[c * 128 + d] = run; }
    segt[seg * 128 + d] = run;
}
__device__ __forceinline__ void f_gla_p2(ArgsR A, int l, int item, LAS unsigned char* lds, int tid) {
    const int n = item & 31, h = (item >> 5) & 3, b = item >> 7; const int lane = tid & 63, wave = __builtin_amdgcn_readfirstlane(tid >> 6);
    const bf16* P = (const bf16*)(A.ws + WS_P); const float* Ps = (const float*)(A.ws + WS_PS);
    float* inc = (float*)(A.ws + WS_GLA_INC) + (size_t)item * 16384; float* dec = (float*)(A.ws + WS_GLA_DEC) + (size_t)item * 128;
    LAS bf16* ks = (LAS bf16*)(lds + FL_K); LAS bf16* vs = (LAS bf16*)(lds + FL_V); LAS float* bc = (LAS float*)(lds + FL_BC); LAS float* lrs = (LAS float*)(lds + FL_LR); LAS float* segt = (LAS float*)(lds + FL_SEG);
    const size_t r0 = (size_t)b * SEQ + n * CHK;
    GlaW2 W2; gla_w2_load(A, l, h, tid, W2);
    tile_g2l_128<64>(P + r0 * PBW + PC_GLA_K + h * HD, PBW, ks, tid);
    tile_g2l_128<64>(P + r0 * PBW + PC_GLA_V + h * HD, PBW, vs, tid);
    for (int i = tid; i < 64 * 16; i += NTHREADS) lrs[i] = Ps[(r0 + (i >> 4)) * 32 + PS_LR + (i & 15)];
    __syncthreads();
    gla_bcum(W2, bc, segt, lrs, tid);
    __syncthreads();
    { const int d = tid & 127, seg = tid >> 7; float pre = 0.f, tot = 0.f;
#pragma unroll
        for (int s = 0; s < 4; ++s) { const float v = segt[s * 128 + d]; if (s < seg) pre += v; tot += v; }
#pragma unroll 4
        for (int i = 0; i < 16; ++i) { const int c = seg * 16 + i; const float bcm = bc[c * 128 + d] + pre; ks[c * LD128 + d] = (bf16)f2bf(bf2f(ks[c * LD128 + d]) * __expf(tot - bcm)); }
        if (seg == 0) dec[d] = __expf(tot); }
    __syncthreads();
    { f32x4 acc[8];
#pragma unroll
        for (int nt = 0; nt < 8; ++nt) acc[nt] = (f32x4){0.f, 0.f, 0.f, 0.f};
#pragma unroll
        for (int kk = 0; kk < 2; ++kk) { const bf16x8 af = frag_tr(vs, LD128, 32 * kk, 16 * wave, lane);
#pragma unroll
            for (int nt = 0; nt < 8; ++nt) acc[nt] = MFMA16(af, frag_tr(ks, LD128, 32 * kk, 16 * nt, lane), acc[nt]); }
        const int fr = lane & 15, fq = lane >> 4;
#pragma unroll
        for (int nt = 0; nt < 8; ++nt)
#pragma unroll
            for (int r = 0; r < 4; ++r) inc[(16 * wave + 4 * fq + r) * 128 + 16 * nt + fr] = acc[nt][r]; }
    __syncthreads();
}
__device__ __forceinline__ void f_gla_p3(ArgsR A, int item, int tid) {
    const int bh = item >> 4, sl = item & 15; const int e = sl * 1024 + tid * 2, d = e & 127;
    const float* inc = (const float*)(A.ws + WS_GLA_INC) + (size_t)bh * 32 * 16384 + e; const float* dec = (const float*)(A.ws + WS_GLA_DEC) + (size_t)bh * 32 * 128 + d;
    bf16* st = (bf16*)(A.ws + WS_GLA_ST) + (size_t)bh * 32 * 16384 + e;
    float s0 = 0.f, s1 = 0.f;
#pragma unroll 8
    for (int n = 0; n < NCHK; ++n) { *(GAS unsigned*)(st + (size_t)n * 16384) = pk2(s0, s1);
        const f32x2 iv = *(const GAS f32x2*)(inc + (size_t)n * 16384), dv = *(const GAS f32x2*)(dec + (size_t)n * 128); s0 = dv[0] * s0 + iv[0]; s1 = dv[1] * s1 + iv[1]; }
}
__device__ __forceinline__ void f_gla_p4(ArgsR A, int l, int item, LAS unsigned char* lds, int tid) {
    const int n = item & 31, h = (item >> 5) & 3, b = item >> 7; const int lane = tid & 63, wave = __builtin_amdgcn_readfirstlane(tid >> 6), fr = lane & 15, fq = lane >> 4;
    const bf16* P = (const bf16*)(A.ws + WS_P); const float* Ps = (const float*)(A.ws + WS_PS); bf16* mix = (bf16*)(A.ws + WS_MIX);
    const bf16* stg = (const bf16*)(A.ws + WS_GLA_ST) + (size_t)item * 16384;
    LAS bf16* qs = (LAS bf16*)(lds + FL_Q); LAS bf16* ks = (LAS bf16*)(lds + FL_K); LAS bf16* vs = (LAS bf16*)(lds + FL_V); LAS bf16* sts = (LAS bf16*)(lds + FL_ST); LAS bf16* scs = (LAS bf16*)(lds + FL_SC);
    LAS float* bc = (LAS float*)(lds + FL_BC); LAS float* lrs = (LAS float*)(lds + FL_LR); LAS float* segt = (LAS float*)(lds + FL_SEG); LAS float* rsp = (LAS float*)(lds + FL_RS);
    const size_t r0 = (size_t)b * SEQ + n * CHK;
    GlaW2 W2; gla_w2_load(A, l, h, tid, W2);
    const float gn = A.in[I_GLA_NG][l * GW + h * HD + 16 * wave + fr];
    float gt[4][4];
#pragma unroll
    for (int mt = 0; mt < 4; ++mt)
#pragma unroll
        for (int r = 0; r < 4; ++r) gt[mt][r] = bf2f(P[(r0 + 16 * mt + 4 * fq + r) * PBW + PC_GLA_G + h * HD + 16 * wave + fr]);
    tile_g2l_128<64>(P + r0 * PBW + PC_GLA_Q + h * HD, PBW, qs, tid);
    tile_g2l_128<64>(P + r0 * PBW + PC_GLA_K + h * HD, PBW, ks, tid);
    tile_g2l_128<64>(P + r0 * PBW + PC_GLA_V + h * HD, PBW, vs, tid);
    tile_g2l_128<128>(stg, 128, sts, tid);
    for (int i = tid; i < 64 * 16; i += NTHREADS) lrs[i] = Ps[(r0 + (i >> 4)) * 32 + PS_LR + (i & 15)];
    __syncthreads();
    gla_bcum(W2, bc, segt, lrs, tid);
    __syncthreads();
    { const int d = tid & 127, seg = tid >> 7; float pre = 0.f;
#pragma unroll
        for (int s = 0; s < 4; ++s) { const float v = segt[s * 128 + d]; if (s < seg) pre += v; }
#pragma unroll 4
        for (int i = 0; i < 16; ++i) { const int c = seg * 16 + i; const float bcm = bc[c * 128 + d] + pre;
            qs[c * LD128 + d] = (bf16)f2bf(bf2f(qs[c * LD128 + d]) * __expf(bcm) * 0.08838834764831845f); ks[c * LD128 + d] = (bf16)f2bf(bf2f(ks[c * LD128 + d]) * __expf(-bcm)); } }
    __syncthreads();
    { const int mt = wave >> 1; f32x4 acc[2] = {{0.f, 0.f, 0.f, 0.f}, {0.f, 0.f, 0.f, 0.f}};
#pragma unroll
        for (int kk = 0; kk < 4; ++kk) { const bf16x8 af = frag_rd(qs, LD128, 16 * mt, 32 * kk, lane);
#pragma unroll
            for (int q = 0; q < 2; ++q) acc[q] = MFMA16(af, frag_rd(ks, LD128, 16 * (2 * (wave & 1) + q), 32 * kk, lane), acc[q]); }
#pragma unroll
        for (int q = 0; q < 2; ++q) { const int s = 16 * (2 * (wave & 1) + q) + fr;
#pragma unroll
            for (int r = 0; r < 4; ++r) { const int c = 16 * mt + 4 * fq + r; scs[c * LD64 + s] = (bf16)f2bf(s <= c ? acc[q][r] : 0.f); } } }
    __syncthreads();
    f32x4 o[4];
#pragma unroll
    for (int mt = 0; mt < 4; ++mt) o[mt] = (f32x4){0.f, 0.f, 0.f, 0.f};
#pragma unroll
    for (int kk = 0; kk < 2; ++kk) { const bf16x8 bfv = frag_tr(vs, LD128, 32 * kk, 16 * wave, lane);
#pragma unroll
        for (int mt = 0; mt < 4; ++mt) o[mt] = MFMA16(frag_rd(scs, LD64, 16 * mt, 32 * kk, lane), bfv, o[mt]); }
#pragma unroll
    for (int kk = 0; kk < 4; ++kk) { const bf16x8 bfs = frag_rd(sts, LD128, 16 * wave, 32 * kk, lane);
#pragma unroll
        for (int mt = 0; mt < 4; ++mt) o[mt] = MFMA16(frag_rd(qs, LD128, 16 * mt, 32 * kk, lane), bfs, o[mt]); }
#pragma unroll
    for (int mt = 0; mt < 4; ++mt)
#pragma unroll
        for (int r = 0; r < 4; ++r) { float s = o[mt][r] * o[mt][r]; s += __shfl_xor(s, 1); s += __shfl_xor(s, 2); s += __shfl_xor(s, 4); s += __shfl_xor(s, 8);
            if (fr == 0) rsp[wave * 64 + 16 * mt + 4 * fq + r] = s; }
    __syncthreads();
#pragma unroll
    for (int mt = 0; mt < 4; ++mt)
#pragma unroll
        for (int r = 0; r < 4; ++r) { const int c = 16 * mt + 4 * fq + r; float ss = 0.f;
#pragma unroll
            for (int w = 0; w < 8; ++w) ss += rsp[w * 64 + c];
            const float rs = rsqrtf(ss * (1.0f / 128.0f) + RMS_EPS);
            mix[(r0 + c) * DM + h * HD + 16 * wave + fr] = (bf16)f2bf(o[mt][r] * rs * gn * siluf_(gt[mt][r])); }
    __syncthreads();
}

constexpr int FM_Q2 = 96256, FM_S = 129024;
__device__ __forceinline__ void f_ml_p2(ArgsR A, int l, int item, LAS unsigned char* lds, int tid) {
    const int n = item & 31, h = (item >> 5) & 3, b = item >> 7; const int lane = tid & 63, wave = __builtin_amdgcn_readfirstlane(tid >> 6);
    const bf16* P = (const bf16*)(A.ws + WS_P); const float* Ps = (const float*)(A.ws + WS_PS);
    float* inc = (float*)(A.ws + WS_ML_INC) + (size_t)item * 16384; float* incn = (float*)(A.ws + WS_ML_N) + (size_t)item * 128; float* scg = (float*)(A.ws + WS_ML_SC) + (size_t)item * 2;
    LAS bf16* ks = (LAS bf16*)(lds + FL_K); LAS bf16* vs = (LAS bf16*)(lds + FL_V); LAS float* sc = (LAS float*)(lds + FM_S);
    const size_t r0 = (size_t)b * SEQ + n * CHK;
    tile_g2l_128<64>(P + r0 * PBW + PC_ML_K + h * HD, PBW, ks, tid);
    tile_g2l_128<64>(P + r0 * PBW + PC_ML_V + h * HD, PBW, vs, tid);
    if (wave == 0) { const float lf = logsigmoidf_(Ps[(r0 + lane) * 32 + PS_MF + h] + A.in[I_ML_FB][l * NH + h]), ig = Ps[(r0 + lane) * 32 + PS_MI + h] + A.in[I_ML_IB][l * NH + h];
        const float bcum = wave_scan_add(lf, lane), blast = __shfl(bcum, 63), le = blast - bcum + ig, mloc = wave_max(le);
        sc[lane] = __expf(le - mloc) * 0.08838834764831845f; if (lane == 0) { scg[0] = mloc; scg[1] = blast; } }
    __syncthreads();
#pragma unroll
    for (int i = 0; i < 2; ++i) { const int idx = tid + i * NTHREADS, r = idx >> 4, c8 = (idx & 15) * 8; const float w = sc[r];
        v4u x = *(LAS v4u*)(ks + r * LD128 + c8);
        x.x = pk2(bflo(x.x) * w, bfhi(x.x) * w); x.y = pk2(bflo(x.y) * w, bfhi(x.y) * w); x.z = pk2(bflo(x.z) * w, bfhi(x.z) * w); x.w = pk2(bflo(x.w) * w, bfhi(x.w) * w);
        *(LAS v4u*)(ks + r * LD128 + c8) = x; }
    __syncthreads();
    if (tid < 128) { float s = 0.f;
#pragma unroll 8
        for (int c = 0; c < 64; ++c) s += bf2f(ks[c * LD128 + tid]);
        incn[tid] = s; }
    { f32x4 acc[8];
#pragma unroll
        for (int nt = 0; nt < 8; ++nt) acc[nt] = (f32x4){0.f, 0.f, 0.f, 0.f};
#pragma unroll
        for (int kk = 0; kk < 2; ++kk) { const bf16x8 af = frag_tr(vs, LD128, 32 * kk, 16 * wave, lane);
#pragma unroll
            for (int nt = 0; nt < 8; ++nt) acc[nt] = MFMA16(af, frag_tr(ks, LD128, 32 * kk, 16 * nt, lane), acc[nt]); }
        const int fr = lane & 15, fq = lane >> 4;
#pragma unroll
        for (int nt = 0; nt < 8; ++nt)
#pragma unroll
            for (int r = 0; r < 4; ++r) inc[(16 * wave + 4 * fq + r) * 128 + 16 * nt + fr] = acc[nt][r]; }
    __syncthreads();
}
__device__ __forceinline__ void f_ml_p3(ArgsR A, int item, int tid) {
    const int bh = item >> 4, sl = item & 15; const int e = sl * 1024 + tid * 2;
    const float* inc = (const float*)(A.ws + WS_ML_INC) + (size_t)bh * 32 * 16384 + e; const float* incn = (const float*)(A.ws + WS_ML_N) + (size_t)bh * 32 * 128;
    const float* scg = (const float*)(A.ws + WS_ML_SC) + (size_t)bh * 32 * 2;
    bf16* st = (bf16*)(A.ws + WS_ML_ST) + (size_t)bh * 32 * 16384 + e; float* np = (float*)(A.ws + WS_ML_NP) + (size_t)bh * 32 * 128; float* mp = (float*)(A.ws + WS_ML_MP) + (size_t)bh * 32;
    float c0 = 0.f, c1 = 0.f, nv = 0.f, m = 0.f; const int dn = sl * 8 + tid;
#pragma unroll 4
    for (int n = 0; n < NCHK; ++n) {
        *(GAS unsigned*)(st + (size_t)n * 16384) = pk2(c0, c1);
        if (tid < 8) np[n * 128 + dn] = nv;
        if (sl == 0 && tid == 0) mp[n] = m;
        const float ml = scg[2 * n], bl = scg[2 * n + 1]; const float mn = fmaxf(bl + m, ml), ao = __expf(bl + m - mn), ai = __expf(ml - mn);
        const f32x2 iv = *(const GAS f32x2*)(inc + (size_t)n * 16384); c0 = ao * c0 + ai * iv[0]; c1 = ao * c1 + ai * iv[1];
        if (tid < 8) nv = ao * nv + ai * incn[n * 128 + dn];
        m = mn; }
}
__device__ __forceinline__ void f_ml_p4(ArgsR A, int l, int item, LAS unsigned char* lds, int tid) {
    const int n = item & 31, h = (item >> 5) & 3, b = item >> 7; const int lane = tid & 63, wave = __builtin_amdgcn_readfirstlane(tid >> 6), fr = lane & 15, fq = lane >> 4;
    const bf16* P = (const bf16*)(A.ws + WS_P); const float* Ps = (const float*)(A.ws + WS_PS); bf16* mix = (bf16*)(A.ws + WS_MIX);
    const bf16* stg = (const bf16*)(A.ws + WS_ML_ST) + (size_t)item * 16384; const float* npg = (const float*)(A.ws + WS_ML_NP) + (size_t)item * 128; const float mprev = ((const float*)(A.ws + WS_ML_MP))[item];
    LAS bf16* qs = (LAS bf16*)(lds + FL_Q); LAS bf16* ks = (LAS bf16*)(lds + FL_K); LAS bf16* vs = (LAS bf16*)(lds + FL_V); LAS bf16* sts = (LAS bf16*)(lds + FL_ST); LAS bf16* scs = (LAS bf16*)(lds + FL_SC);
    LAS bf16* q2 = (LAS bf16*)(lds + FM_Q2); LAS float* sc = (LAS float*)(lds + FM_S); LAS float* rsp = (LAS float*)(lds + FL_RS + 4096);
    const size_t r0 = (size_t)b * SEQ + n * CHK;
    const float gn = A.in[I_ML_NG][l * GW + h * HD + 16 * wave + fr];
    float ogt[4][4];
#pragma unroll
    for (int mt = 0; mt < 4; ++mt)
#pragma unroll
        for (int r = 0; r < 4; ++r) ogt[mt][r] = bf2f(P[(r0 + 16 * mt + 4 * fq + r) * PBW + PC_ML_O + h * HD + 16 * wave + fr]);
    tile_g2l_128<64>(P + r0 * PBW + PC_ML_Q + h * HD, PBW, qs, tid);
    tile_g2l_128<64>(P + r0 * PBW + PC_ML_K + h * HD, PBW, ks, tid);
    tile_g2l_128<64>(P + r0 * PBW + PC_ML_V + h * HD, PBW, vs, tid);
    tile_g2l_128<128>(stg, 128, sts, tid);
    if (wave == 0) { const float lf = logsigmoidf_(Ps[(r0 + lane) * 32 + PS_MF + h] + A.in[I_ML_FB][l * NH + h]), ig = Ps[(r0 + lane) * 32 + PS_MI + h] + A.in[I_ML_IB][l * NH + h];
        const float bcum = wave_scan_add(lf, lane), as = ig - bcum, pm = wave_scan_max(as, lane);
        const float mintra = bcum + pm, minter = bcum + mprev, mt = fmaxf(mintra, minter);
        sc[lane] = bcum - mt; sc[64 + lane] = as; sc[128 + lane] = __expf(minter - mt); sc[192 + lane] = __expf(-mt); }
    if (wave == 1) { sc[320 + lane] = npg[lane]; sc[384 + lane] = npg[64 + lane]; }
    __syncthreads();
#pragma unroll
    for (int i = 0; i < 2; ++i) { const int idx = tid + i * NTHREADS, r = idx >> 4, c8 = (idx & 15) * 8; const float w = sc[128 + r];
        v4u x = *(LAS v4u*)(qs + r * LD128 + c8);
        x.x = pk2(bflo(x.x) * w, bfhi(x.x) * w); x.y = pk2(bflo(x.y) * w, bfhi(x.y) * w); x.z = pk2(bflo(x.z) * w, bfhi(x.z) * w); x.w = pk2(bflo(x.w) * w, bfhi(x.w) * w);
        *(LAS v4u*)(q2 + r * LD128 + c8) = x; }
    { const int mt = wave >> 1; f32x4 acc[2] = {{0.f, 0.f, 0.f, 0.f}, {0.f, 0.f, 0.f, 0.f}};
#pragma unroll
        for (int kk = 0; kk < 4; ++kk) { const bf16x8 af = frag_rd(qs, LD128, 16 * mt, 32 * kk, lane);
#pragma unroll
            for (int q = 0; q < 2; ++q) acc[q] = MFMA16(af, frag_rd(ks, LD128, 16 * (2 * (wave & 1) + q), 32 * kk, lane), acc[q]); }
#pragma unroll
        for (int q = 0; q < 2; ++q) { const int s = 16 * (2 * (wave & 1) + q) + fr; const float asv = sc[64 + s];
#pragma unroll
            for (int r = 0; r < 4; ++r) { const int c = 16 * mt + 4 * fq + r; scs[c * LD64 + s] = (bf16)f2bf(s <= c ? acc[q][r] * 0.08838834764831845f * __expf(sc[c] + asv) : 0.f); } } }
    __syncthreads();
    { const int c = tid >> 3, part = tid & 7; float s = 0.f;
#pragma unroll
        for (int i = 0; i < 8; ++i) s += bf2f(scs[c * LD64 + part * 8 + i]);
#pragma unroll
        for (int i = 0; i < 16; ++i) s += bf2f(q2[c * LD128 + part * 16 + i]) * sc[320 + part * 16 + i];
        s += __shfl_xor(s, 1); s += __shfl_xor(s, 2); s += __shfl_xor(s, 4);
        if (part == 0) sc[256 + c] = fmaxf(fabsf(s), sc[192 + c]); }
    f32x4 o[4];
#pragma unroll
    for (int mt = 0; mt < 4; ++mt) o[mt] = (f32x4){0.f, 0.f, 0.f, 0.f};
#pragma unroll
    for (int kk = 0; kk < 2; ++kk) { const bf16x8 bfv = frag_tr(vs, LD128, 32 * kk, 16 * wave, lane);
#pragma unroll
        for (int mt = 0; mt < 4; ++mt) o[mt] = MFMA16(frag_rd(scs, LD64, 16 * mt, 32 * kk, lane), bfv, o[mt]); }
#pragma unroll
    for (int kk = 0; kk < 4; ++kk) { const bf16x8 bfs = frag_rd(sts, LD128, 16 * wave, 32 * kk, lane);
#pragma unroll
        for (int mt = 0; mt < 4; ++mt) o[mt] = MFMA16(frag_rd(q2, LD128, 16 * mt, 32 * kk, lane), bfs, o[mt]); }
    __syncthreads();
#pragma unroll
    for (int mt = 0; mt < 4; ++mt)
#pragma unroll
        for (int r = 0; r < 4; ++r) { const int c = 16 * mt + 4 * fq + r;
            const float hv = o[mt][r] * rcpf_(sc[256 + c]) * sigmoidf_(ogt[mt][r]); o[mt][r] = hv;
            float s = hv * hv; s += __shfl_xor(s, 1); s += __shfl_xor(s, 2); s += __shfl_xor(s, 4); s += __shfl_xor(s, 8);
            if (fr == 0) rsp[wave * 64 + c] = s; }
    __syncthreads();
#pragma unroll
    for (int mt = 0; mt < 4; ++mt)
#pragma unroll
        for (int r = 0; r < 4; ++r) { const int c = 16 * mt + 4 * fq + r; float ss = 0.f;
#pragma unroll
            for (int w = 0; w < 8; ++w) ss += rsp[w * 64 + c];
            mix[(r0 + c) * DM + 1024 + h * HD + 16 * wave + fr] = (bf16)f2bf(o[mt][r] * rsqrtf(ss * (1.0f / 128.0f) + RMS_EPS) * gn); }
    __syncthreads();
}

constexpr int FG_LM = 52224, FG_S = 129024, FG_RAW = 68608, FG_RAWT = 9216  ;
template <int C> struct GdnSolve {
    static __device__ __forceinline__ void run(float (&sol)[64], const LAS float* Lm) {
        if constexpr (C < 64) {
            float a0 = sol[C], a1 = 0.f, a2 = 0.f, a3 = 0.f;
#pragma unroll
            for (int s = 0; s < C; ++s) { const float t = Lm[C * 64 + s] * sol[s]; if ((s & 3) == 0) a0 -= t; else if ((s & 3) == 1) a1 -= t; else if ((s & 3) == 2) a2 -= t; else a3 -= t; }
            sol[C] = (a0 + a1) + (a2 + a3);
            GdnSolve<C + 1>::run(sol, Lm);
        }
    }
};
__device__ __forceinline__ void f_gdn_p2(ArgsR A, int l, int item, LAS unsigned char* lds, int tid) {
    const int n = item & 31, h = (item >> 5) & 3, b = item >> 7; const int lane = tid & 63, wave = __builtin_amdgcn_readfirstlane(tid >> 6), fr = lane & 15, fq = lane >> 4;
    const bf16* P = (const bf16*)(A.ws + WS_P); const float* Ps = (const float*)(A.ws + WS_PS);
    bf16* U0 = (bf16*)(A.ws + WS_GDN_U0) + (size_t)item * 8192; bf16* Wg = (bf16*)(A.ws + WS_GDN_W) + (size_t)item * 8192; bf16* QD = (bf16*)(A.ws + WS_GDN_QD) + (size_t)item * 8192;
    bf16* KE = (bf16*)(A.ws + WS_GDN_KE) + (size_t)item * 8192; bf16* QK = (bf16*)(A.ws + WS_GDN_QK) + (size_t)item * 4096; float* DE = (float*)(A.ws + WS_GDN_DE);
    LAS bf16* qs = (LAS bf16*)(lds + FL_Q); LAS bf16* ks = (LAS bf16*)(lds + FL_K); LAS bf16* vs = (LAS bf16*)(lds + FL_V); LAS float* Lm = (LAS float*)(lds + FG_LM); LAS float* sc = (LAS float*)(lds + FG_S);
    const float* cw = A.in[I_GDN_CW] + (size_t)l * 4 * 1536;
    const size_t r0 = (size_t)b * SEQ + n * CHK;
    float cwv[3][4];
#pragma unroll
    for (int part = 0; part < 3; ++part)
#pragma unroll
        for (int k = 0; k < 4; ++k) cwv[part][k] = cw[k * 1536 + part * 512 + h * HD + (tid & 127)];
    if (wave == 0) { const float bt = sigmoidf_(Ps[(r0 + lane) * 32 + PS_GB + h]);
        const float g = -__expf(A.in[I_GDN_ALOG][l * NH + h]) * softplusf_(Ps[(r0 + lane) * 32 + PS_GA + h] + A.in[I_GDN_DTB][l * NH + h]);
        const float gam = wave_scan_add(g, lane); sc[lane] = bt; sc[64 + lane] = gam; if (lane == 63) DE[item] = __expf(gam); }
    { LAS bf16* raw = (LAS bf16*)(lds + FG_RAW);
#pragma unroll
        for (int i = 0; i < 7; ++i) { const int idx = tid + i * NTHREADS; if (idx < 3 * 67 * 16) { const int part = idx / (67 * 16), pi = idx % (67 * 16), rr = pi >> 4, c8 = (pi & 15) * 8;
            const int pc = (part == 0 ? PC_GDN_Q : part == 1 ? PC_GDN_K : PC_GDN_V) + h * HD + c8; v4u w = {0u, 0u, 0u, 0u};
            if (n > 0 || rr >= 3) w = *(const GAS v4u*)(P + (r0 + rr - 3) * PBW + pc);
            *(LAS v4u*)(raw + part * FG_RAWT + rr * LD128 + c8) = w; } }
        __syncthreads();
        const int v = tid & 127, dq = tid >> 7;
#pragma unroll
        for (int part = 0; part < 3; ++part) {
            const float w0 = cwv[part][0], w1 = cwv[part][1], w2 = cwv[part][2], w3 = cwv[part][3];
            LAS bf16* dst = part == 0 ? qs : part == 1 ? ks : vs; const LAS bf16* src = raw + part * FG_RAWT + v;
            const int c0 = dq * 16;
            float xm3 = bf2f(src[(c0 + 0) * LD128]), xm2 = bf2f(src[(c0 + 1) * LD128]), xm1 = bf2f(src[(c0 + 2) * LD128]);
#pragma unroll
            for (int i = 0; i < 16; ++i) { const float x0 = bf2f(src[(c0 + i + 3) * LD128]); const float y = w0 * xm3 + w1 * xm2 + w2 * xm1 + w3 * x0;
                dst[(c0 + i) * LD128 + v] = (bf16)f2bf(siluf_(y)); xm3 = xm2; xm2 = xm1; xm1 = x0; } } }
    __syncthreads();
#pragma unroll 1
    for (int rr = 0; rr < 8; ++rr) { const int c = wave * 8 + rr;
        const float q1 = bf2f(qs[c * LD128 + lane]), q2 = bf2f(qs[c * LD128 + 64 + lane]), k1 = bf2f(ks[c * LD128 + lane]), k2 = bf2f(ks[c * LD128 + 64 + lane]);
        const float sq = wave_sum(q1 * q1 + q2 * q2), sk = wave_sum(k1 * k1 + k2 * k2);
        if (lane == 0) { sc[128 + c] = rsqrtf(sq + 1e-6f) * 0.08838834764831845f; sc[192 + c] = rsqrtf(sk + 1e-6f); } }
    __syncthreads();
    { const int mt = wave >> 1; f32x4 akk[2] = {{0.f, 0.f, 0.f, 0.f}, {0.f, 0.f, 0.f, 0.f}}, aqk[2] = {{0.f, 0.f, 0.f, 0.f}, {0.f, 0.f, 0.f, 0.f}};
#pragma unroll
        for (int kk = 0; kk < 4; ++kk) { const bf16x8 ak = frag_rd(ks, LD128, 16 * mt, 32 * kk, lane), aq = frag_rd(qs, LD128, 16 * mt, 32 * kk, lane);
#pragma unroll
            for (int q = 0; q < 2; ++q) { const bf16x8 bk = frag_rd(ks, LD128, 16 * (2 * (wave & 1) + q), 32 * kk, lane); akk[q] = MFMA16(ak, bk, akk[q]); aqk[q] = MFMA16(aq, bk, aqk[q]); } }
#pragma unroll
        for (int q = 0; q < 2; ++q) { const int s = 16 * (2 * (wave & 1) + q) + fr; const float rks = sc[192 + s], gs = sc[64 + s];
#pragma unroll
            for (int r = 0; r < 4; ++r) { const int c = 16 * mt + 4 * fq + r; const float dcy = __expf(sc[64 + c] - gs);
                Lm[c * 64 + s] = (s < c) ? sc[c] * akk[q][r] * sc[192 + c] * rks * dcy : 0.f;
                QK[c * 64 + s] = (bf16)f2bf((s <= c) ? aqk[q][r] * sc[128 + c] * rks * dcy : 0.f); } } }
    __syncthreads();
    if (tid < 256) {
        float sol[64]; const bool isw = tid >= 128; const int j = tid & 127;
        const LAS float* LmO = Lm; asm volatile("" : "+v"(LmO));
#pragma unroll
        for (int c = 0; c < 64; ++c) { const float bt = sc[c]; sol[c] = isw ? bf2f(ks[c * LD128 + j]) * sc[192 + c] * bt * __expf(sc[64 + c]) : bf2f(vs[c * LD128 + j]) * bt; }
        GdnSolve<1>::run(sol, LmO);
        bf16* dst = isw ? Wg : U0;
#pragma unroll
        for (int c = 0; c < 64; ++c) dst[c * 128 + j] = (bf16)f2bf(sol[c]);
    } else {
        const int t2 = tid - 256; const float glast = sc[64 + 63];
#pragma unroll
        for (int i = 0; i < 8; ++i) { const int idx = t2 + i * 256, which = idx >> 10, pi = idx & 1023, r = pi >> 4, c8 = (pi & 15) * 8;
            const float w = which == 0 ? sc[128 + r] * __expf(sc[64 + r]) : sc[192 + r] * __expf(glast - sc[64 + r]);
            v4u x = *(LAS v4u*)((which == 0 ? qs : ks) + r * LD128 + c8);
            x.x = pk2(bflo(x.x) * w, bfhi(x.x) * w); x.y = pk2(bflo(x.y) * w, bfhi(x.y) * w); x.z = pk2(bflo(x.z) * w, bfhi(x.z) * w); x.w = pk2(bflo(x.w) * w, bfhi(x.w) * w);
            *(GAS v4u*)((which == 0 ? QD : KE) + r * 128 + c8) = x; }
    }
    __syncthreads();
}

constexpr int FC_W = 0, FC_QD = 17408, FC_KE = 34816, FC_U0 = 52224, FC_QK = 69632, FC_RS = 78848  ;
__device__ __forceinline__ void f_gdn_p3(ArgsR A, int l, int bh, LAS unsigned char* lds, int tid) {
    const int lane = tid & 63, wave = __builtin_amdgcn_readfirstlane(tid >> 6), fr = lane & 15, fq = lane >> 4; const int b = bh >> 2, h = bh & 3;
    const bf16* U0 = (const bf16*)(A.ws + WS_GDN_U0) + (size_t)bh * 32 * 8192; const bf16* Wg = (const bf16*)(A.ws + WS_GDN_W) + (size_t)bh * 32 * 8192; const bf16* QD = (const bf16*)(A.ws + WS_GDN_QD) + (size_t)bh * 32 * 8192;
    const bf16* KE = (const bf16*)(A.ws + WS_GDN_KE) + (size_t)bh * 32 * 8192; const bf16* QK = (const bf16*)(A.ws + WS_GDN_QK) + (size_t)bh * 32 * 4096; const float* DE = (const float*)(A.ws + WS_GDN_DE) + bh * 32;
    const bf16* P = (const bf16*)(A.ws + WS_P); bf16* mix = (bf16*)(A.ws + WS_MIX); LAS float* rsp = (LAS float*)(lds + FC_RS);
    const float gn = A.in[I_GDN_NG][l * GW + h * HD + 16 * wave + fr];
    LAS bf16* ws_ = (LAS bf16*)(lds + FC_W); LAS bf16* qds = (LAS bf16*)(lds + FC_QD); LAS bf16* kes = (LAS bf16*)(lds + FC_KE); LAS bf16* u0s = (LAS bf16*)(lds + FC_U0); LAS bf16* qks = (LAS bf16*)(lds + FC_QK);
    f32x4 S[8];
#pragma unroll
    for (int i = 0; i < 8; ++i) S[i] = (f32x4){0.f, 0.f, 0.f, 0.f};
    v4u st[9];
    auto issue = [&](int n) {
#pragma unroll
        for (int i = 0; i < 8; ++i) { const int idx = tid + i * NTHREADS, which = idx >> 10, pi = idx & 1023;
            const bf16* src = (which == 0 ? Wg : which == 1 ? QD : which == 2 ? KE : U0) + (size_t)n * 8192; st[i] = *(const GAS v4u*)(src + pi * 8); }
        st[8] = *(const GAS v4u*)(QK + (size_t)n * 4096 + tid * 8);
    };
    auto commit = [&]() {
#pragma unroll
        for (int i = 0; i < 8; ++i) { const int idx = tid + i * NTHREADS, which = idx >> 10, pi = idx & 1023, r = pi >> 4, c8 = (pi & 15) * 8;
            *(LAS v4u*)((LAS bf16*)(lds + which * 17408) + r * LD128 + c8) = st[i]; }
        { const int r = tid >> 3, c8 = (tid & 7) * 8; *(LAS v4u*)(qks + r * LD64 + c8) = st[8]; }
    };
    const float dev = DE[lane & 31];
    issue(0);
#pragma unroll 1
    for (int n = 0; n < NCHK; ++n) {
        __syncthreads();
        commit();
        __syncthreads();
        if (n + 1 < NCHK) issue(n + 1);
        const float de = __shfl(dev, n);
        const size_t r0 = (size_t)b * SEQ + n * CHK;
        float gt[4][4];
#pragma unroll
        for (int mt = 0; mt < 4; ++mt)
#pragma unroll
            for (int r = 0; r < 4; ++r) gt[mt][r] = bf2f(P[(r0 + 16 * mt + 4 * fq + r) * PBW + PC_GDN_G + h * HD + 16 * wave + fr]);
        bf16x8 SB[4];
#pragma unroll
        for (int kb = 0; kb < 4; ++kb) SB[kb] = pack_acc(S[2 * kb], S[2 * kb + 1]);
        f32x4 u[4], o[4];
#pragma unroll
        for (int mt = 0; mt < 4; ++mt) { f32x4 ws2 = {0.f, 0.f, 0.f, 0.f}; o[mt] = (f32x4){0.f, 0.f, 0.f, 0.f};
#pragma unroll
            for (int kb = 0; kb < 4; ++kb) { ws2 = MFMA16(frag_rd_perm(ws_, LD128, 16 * mt, 32 * kb, lane), SB[kb], ws2); o[mt] = MFMA16(frag_rd_perm(qds, LD128, 16 * mt, 32 * kb, lane), SB[kb], o[mt]); }
#pragma unroll
            for (int r = 0; r < 4; ++r) u[mt][r] = bf2f(u0s[(16 * mt + 4 * fq + r) * LD128 + 16 * wave + fr]) - ws2[r]; }
        const bf16x8 UB0 = pack_acc(u[0], u[1]), UB1 = pack_acc(u[2], u[3]);
#pragma unroll
        for (int mt = 0; mt < 4; ++mt) { o[mt] = MFMA16(frag_rd_perm(qks, LD64, 16 * mt, 0, lane), UB0, o[mt]); o[mt] = MFMA16(frag_rd_perm(qks, LD64, 16 * mt, 32, lane), UB1, o[mt]); }
#pragma unroll
        for (int dt = 0; dt < 8; ++dt) { f32x4 sn = S[dt] * de;
            sn = MFMA16(frag_tr_perm(kes, LD128, 0, 16 * dt, lane), UB0, sn); sn = MFMA16(frag_tr_perm(kes, LD128, 32, 16 * dt, lane), UB1, sn); S[dt] = sn; }
        LAS float* rs_ = rsp + (n & 1) * 512;
#pragma unroll
        for (int mt = 0; mt < 4; ++mt)
#pragma unroll
            for (int r = 0; r < 4; ++r) { float s = o[mt][r] * o[mt][r]; s += __shfl_xor(s, 1); s += __shfl_xor(s, 2); s += __shfl_xor(s, 4); s += __shfl_xor(s, 8);
                if (fr == 0) rs_[wave * 64 + 16 * mt + 4 * fq + r] = s; }
        __syncthreads();
#pragma unroll
        for (int mt = 0; mt < 4; ++mt)
#pragma unroll
            for (int r = 0; r < 4; ++r) { const int c = 16 * mt + 4 * fq + r; float ss = 0.f;
#pragma unroll
                for (int w = 0; w < 8; ++w) ss += rs_[w * 64 + c];
                mix[(r0 + c) * DM + 1536 + h * HD + 16 * wave + fr] = (bf16)f2bf(o[mt][r] * rsqrtf(ss * (1.0f / 128.0f) + RMS_EPS) * gn * siluf_(gt[mt][r])); }
    }
    __syncthreads();
}

#ifndef TAB_FP8
#define TAB_FP8 1
#endif
constexpr size_t WS_TSC = 93 * MiB + 256 * 1024;
constexpr int NSLICE = 16;
constexpr int PE_KEYS = 0, PE_CAB = 16384, PE_ENT = 17408, PE_OFFS = 50176, PE_SHQ = 52352, PE_H2Q = 53248;

__device__ __forceinline__ void tab_convert(ArgsR A, int l, int gw, int NGW, int lane) {
    unsigned char* ws = A.ws; float* tsc = (float*)(ws + WS_TSC);
#pragma unroll 1
    for (int q = gw; q < 2 * NEXP; q += NGW) {
        const int t = q / NEXP, rr = l * NEXP + q % NEXP, r = t * DEPTH * NEXP + rr;
        const float* src = A.in[t ? I_PV : I_PU] + (size_t)rr * DM;
        f32x4 v[8];
#pragma unroll
        for (int i = 0; i < 8; ++i) v[i] = *(const GAS f32x4*)(src + 4 * (lane + 64 * i));
        unsigned char* dst = ws + (t ? WS_VB : WS_UB) + (size_t)(rr / NEXP) * TAB_L + (size_t)(rr % NEXP) * DM;
        float am = 0.f;
#pragma unroll
        for (int i = 0; i < 8; ++i) am = fmaxf(fmaxf(am, fmaxf(fabsf(v[i][0]), fabsf(v[i][1]))), fmaxf(fabsf(v[i][2]), fabsf(v[i][3])));
        am = wave_max(am); const float sc = am > 0.f ? 127.0f / am : 1.0f; const int off = t ? 128 : 0;
#pragma unroll
        for (int i = 0; i < 8; ++i) { const int q0 = __float2int_rn(v[i][0] * sc) + off, q1 = __float2int_rn(v[i][1] * sc) + off, q2 = __float2int_rn(v[i][2] * sc) + off, q3 = __float2int_rn(v[i][3] * sc) + off;
            *(GAS unsigned*)(dst + 4 * (lane + 64 * i)) = (unsigned)(q0 & 255) | ((unsigned)(q1 & 255) << 8) | ((unsigned)(q2 & 255) << 16) | ((unsigned)(q3 & 255) << 24); }
        if (lane == 0) tsc[r] = am > 0.f ? am * (1.0f / 127.0f) : 1.0f;
    }
}
__device__ __forceinline__ float ubf0(unsigned w) { float r; asm volatile("v_cvt_f32_ubyte0 %0, %1" : "=v"(r) : "v"(w)); return r; }
__device__ __forceinline__ float ubf1(unsigned w) { float r; asm volatile("v_cvt_f32_ubyte1 %0, %1" : "=v"(r) : "v"(w)); return r; }
__device__ __forceinline__ float ubf2(unsigned w) { float r; asm volatile("v_cvt_f32_ubyte2 %0, %1" : "=v"(r) : "v"(w)); return r; }
__device__ __forceinline__ float ubf3(unsigned w) { float r; asm volatile("v_cvt_f32_ubyte3 %0, %1" : "=v"(r) : "v"(w)); return r; }
#define TOUCH16(a, o) asm volatile("" : "+v"(a[(o)+0]), "+v"(a[(o)+1]), "+v"(a[(o)+2]), "+v"(a[(o)+3]), "+v"(a[(o)+4]), "+v"(a[(o)+5]), "+v"(a[(o)+6]), "+v"(a[(o)+7]), "+v"(a[(o)+8]), "+v"(a[(o)+9]), "+v"(a[(o)+10]), "+v"(a[(o)+11]), "+v"(a[(o)+12]), "+v"(a[(o)+13]), "+v"(a[(o)+14]), "+v"(a[(o)+15]))
__device__ __forceinline__ unsigned f2sortable(float f) { const unsigned u = __builtin_bit_cast(unsigned, f); return (u & 0x80000000u) ? ~u : (u | 0x80000000u); }
__device__ __forceinline__ float unsortable(unsigned k) { const unsigned u = (k & 0x80000000u) ? (k & 0x7fffffffu) : ~k; return __builtin_bit_cast(float, u); }
template <int CTRL> __device__ __forceinline__ unsigned dpp_rot_u(unsigned v) { return (unsigned)__builtin_amdgcn_update_dpp(0, (int)v, CTRL, 0xf, 0xf, false); }
__device__ __forceinline__ unsigned row_max_u(unsigned v) { v = max(v, dpp_rot_u<0x121>(v)); v = max(v, dpp_rot_u<0x122>(v)); v = max(v, dpp_rot_u<0x124>(v)); v = max(v, dpp_rot_u<0x128>(v)); return v; }
template <int CTRL> __device__ __forceinline__ float dpp_rotf(float v) { const unsigned u = __builtin_bit_cast(unsigned, v); return __builtin_bit_cast(float, dpp_rot_u<CTRL>(u)); }
__device__ __forceinline__ float row_max_f(float v) { v = fmaxf(v, dpp_rotf<0x121>(v)); v = fmaxf(v, dpp_rotf<0x122>(v)); v = fmaxf(v, dpp_rotf<0x124>(v)); v = fmaxf(v, dpp_rotf<0x128>(v)); return v; }
__device__ __forceinline__ float row_sum_f(float v) { v += dpp_rotf<0x121>(v); v += dpp_rotf<0x122>(v); v += dpp_rotf<0x124>(v); v += dpp_rotf<0x128>(v); return v; }

template <bool DRY>
__device__ __forceinline__ void peer_phase(ArgsR A, int l, bool last, LAS unsigned char* lds, int G, int tid) {
    const int wave = __builtin_amdgcn_readfirstlane(tid >> 6), lane = tid & 63;
    unsigned char* ws = A.ws;
    const bf16* Q = (const bf16*)(ws + WS_Q);
    const bf16* K1 = (const bf16*)(ws + WS_K1) + (size_t)l * 8 * 128 * 128; const bf16* K2 = (const bf16*)(ws + WS_K2) + (size_t)l * 8 * 128 * 128;
    const unsigned char* Ub = ws + WS_UB + (size_t)l * TAB_L; const unsigned char* Vb = ws + WS_VB + (size_t)l * TAB_L;
    const float* tscU = (const float*)(ws + WS_TSC) + (size_t)l * NEXP; const float* tscV = tscU + (size_t)DEPTH * NEXP;
    const float* ssp = (const float*)(ws + WS_SSP); float* X = A.out; bf16* xb = (bf16*)(ws + WS_XB); float* rstd1 = (float*)(ws + WS_RSTD1);
    const float* g2 = A.in[I_N2G] + l * DM; const float* gf = A.in[I_FNG];
    LAS unsigned* keysL = (LAS unsigned*)(lds + PE_KEYS); LAS unsigned* cab = (LAS unsigned*)(lds + PE_CAB); LAS v2u* ent = (LAS v2u*)(lds + PE_ENT); LAS unsigned* offs = (LAS unsigned*)(lds + PE_OFFS);
    LAS float* shqL = (LAS float*)(lds + PE_SHQ); LAS v4u* h2qL = (LAS v4u*)(lds + PE_H2Q);
    if (tid < 64) { int a = 0, b = tid, found = 0;
        for (int aa = 0, base = 0; aa < 16; ++aa) { const int nbb = 16 / (aa + 1); if (!found && tid < base + nbb) { a = aa; b = tid - base; found = 1; } base += nbb; }
        cab[tid] = found ? (unsigned)(a * 16 + b) : 0xffu; }
    __syncthreads();
#pragma unroll 1
    for (int item = blockIdx.x; item < NT / 32; item += G) {
        const int tok0 = item * 32;
#pragma unroll 1
        for (int tt = 0; tt < 4; ++tt) { const int tl = wave * 4 + tt; const size_t t = (size_t)tok0 + tl;
            float s2 = (lane < 32) ? ssp[t * 32 + lane] : 0.f; s2 = wave_sum(s2);
            const float rstd2 = rsqrtf(s2 * (1.0f / DM) + RMS_EPS);
            float hf[32]; float am = 0.f;
#pragma unroll
            for (int j = 0; j < 2; ++j)
#pragma unroll
                for (int q = 0; q < 4; ++q) { const size_t e0 = 16 * (size_t)(lane + 64 * j) + 4 * q;
                    const f32x4 xa = *(const GAS f32x4*)(X + t * DM + e0), ga = *(const GAS f32x4*)(g2 + e0);
#pragma unroll
                    for (int k = 0; k < 4; ++k) { const float hv = xa[k] * rstd2 * ga[k]; hf[j * 16 + q * 4 + k] = hv; am = fmaxf(am, fabsf(hv)); } }
            am = wave_max(am); const float sc = am > 0.f ? 127.0f / am : 1.0f;
#pragma unroll
            for (int j = 0; j < 2; ++j) { unsigned wd[4];
#pragma unroll
                for (int q = 0; q < 4; ++q) wd[q] = (unsigned)((__float2int_rn(hf[j * 16 + q * 4 + 0] * sc) & 255) | ((__float2int_rn(hf[j * 16 + q * 4 + 1] * sc) & 255) << 8) | ((__float2int_rn(hf[j * 16 + q * 4 + 2] * sc) & 255) << 16) | ((__float2int_rn(hf[j * 16 + q * 4 + 3] * sc) & 255) << 24));
                v4u w; w.x = wd[0]; w.y = wd[1]; w.z = wd[2]; w.w = wd[3]; h2qL[(tl * 2 + j) * 64 + lane] = w; }
            if (lane == 0) shqL[tl] = am > 0.f ? am * (1.0f / 127.0f) : 1.0f; }
#pragma unroll 1
        for (int pass = 0; pass < 4; ++pass) {
            LAS unsigned* kl = keysL + (pass & 1) * 2048;
            { const int hh = wave >> 2, side = (wave >> 1) & 1, mt = wave & 1, h = 2 * pass + hh, fr = lane & 15, fq = lane >> 4;
                const bf16* qa = Q + (size_t)(tok0 + 16 * mt + fr) * DM + h * 256 + side * 128 + 8 * fq;
                const bf16* kb = (side ? K2 : K1) + (size_t)h * 128 * 128 + (size_t)fr * 128 + 8 * fq;
                bf16x8 af[4];
#pragma unroll
                for (int ks = 0; ks < 4; ++ks) af[ks] = *(const GAS bf16x8*)(qa + 32 * ks);
                unsigned key[8][4];
#pragma unroll
                for (int nt = 0; nt < 8; ++nt) { f32x4 acc = {0.f, 0.f, 0.f, 0.f};
#pragma unroll
                    for (int ks = 0; ks < 4; ++ks) { const bf16x8 bfr = *(const GAS bf16x8*)(kb + (size_t)nt * 16 * 128 + 32 * ks); acc = __builtin_amdgcn_mfma_f32_16x16x32_bf16(af[ks], bfr, acc, 0, 0, 0); }
#pragma unroll
                    for (int r = 0; r < 4; ++r) key[nt][r] = (f2sortable(acc[r]) & ~127u) | (unsigned)(nt * 16 + fr);
                    if (nt & 1) __builtin_amdgcn_sched_barrier(0); }
                unsigned res[4] = {0u, 0u, 0u, 0u};
#pragma unroll 1
                for (int j = 0; j < 16; ++j) {
#pragma unroll
                    for (int r = 0; r < 4; ++r) {
                        unsigned m = max(max(max(key[0][r], key[1][r]), max(key[2][r], key[3][r])), max(max(key[4][r], key[5][r]), max(key[6][r], key[7][r])));
                        const unsigned w = row_max_u(m);
#pragma unroll
                        for (int nt = 0; nt < 8; ++nt) key[nt][r] = (key[nt][r] == w) ? 0u : key[nt][r];
                        res[r] = (fr == j) ? w : res[r]; } }
                const int rowb = (hh * 2 + side) * 32 + 16 * mt + 4 * fq;
#pragma unroll
                for (int r = 0; r < 4; ++r) kl[(rowb + r) * 16 + fr] = res[r]; }
            __syncthreads();
#pragma unroll 1
            for (int rnd = 0; rnd < 2; ++rnd) { const int fr = lane & 15, fq = lane >> 4, pidx = rnd * 32 + wave * 4 + fq, hh = pidx >> 5, tk = pidx & 31, h = 2 * pass + hh;
                const LAS unsigned* k1 = kl + ((hh * 2) * 32 + tk) * 16; const LAS unsigned* k2 = k1 + 32 * 16;
                unsigned ck[4];
#pragma unroll
                for (int sl = 0; sl < 4; ++sl) { const int ci = fr + 16 * sl; const unsigned ab = cab[ci];
                    const float v = unsortable(k1[(ab >> 4) & 15] & ~127u) + unsortable(k2[ab & 15] & ~127u);
                    ck[sl] = (ab == 0xffu) ? 0u : ((f2sortable(v) & ~63u) | (unsigned)ci); }
                unsigned rk = 0u;
#pragma unroll 1
                for (int j = 0; j < 16; ++j) { const unsigned w = row_max_u(max(max(ck[0], ck[1]), max(ck[2], ck[3])));
#pragma unroll
                    for (int sl = 0; sl < 4; ++sl) ck[sl] = (ck[sl] == w) ? 0u : ck[sl];
                    rk = (fr == j) ? w : rk; }
                const unsigned ab = cab[rk & 63u]; const float v = unsortable(rk & ~63u);
                const float vmax = row_max_f(v), e = __expf(v - vmax), den = row_sum_f(e);
                const unsigned eid = (k1[(ab >> 4) & 15] & 127u) * 128u + (k2[ab & 15] & 127u);
                const float gsv = e * rcpf_(den) * tscV[eid];
                v2u wv; wv.x = eid; wv.y = __builtin_bit_cast(unsigned, gsv);
                ent[tk * 128 + h * 16 + fr] = wv; }
        }
        __syncthreads();
#pragma unroll 1
        for (int tt = 0; tt < 4; ++tt) { const int tl = wave * 4 + tt;
            const v2u e0 = ent[tl * 128 + lane], e1 = ent[tl * 128 + 64 + lane];
            const unsigned id0 = e0.x, id1 = e1.x; const unsigned s0 = id0 >> 10, s1 = id1 >> 10; const unsigned long long lt = (1ull << lane) - 1ull;
            unsigned base = 0, p0 = 0, p1 = 0;
#pragma unroll 1
            for (unsigned s = 0; s < NSLICE; ++s) { const unsigned long long m0 = __ballot(s0 == s), m1 = __ballot(s1 == s); const unsigned c0 = __popcll(m0), c1 = __popcll(m1);
                if (s0 == s) p0 = base + __popcll(m0 & lt);
                if (s1 == s) p1 = base + c0 + __popcll(m1 & lt);
                if (lane == 0) offs[tl * 17 + s] = base;
                base += c0 + c1; }
            if (lane == 0) offs[tl * 17 + NSLICE] = base;
            ent[tl * 128 + p0] = e0; ent[tl * 128 + p1] = e1; }
        const unsigned lo16 = (unsigned)lane * 16u;
#pragma unroll 1
        for (int s = 0; s < NSLICE; ++s) {
#pragma unroll 1
            for (int tt = 0; tt < 4; ++tt) { const int tl = wave * 4 + tt;
                const int b0 = (int)offs[tl * 17 + s], b1 = (int)offs[tl * 17 + s + 1];
                if (b0 == b1) continue;
                const v4u hq0 = h2qL[(tl * 2 + 0) * 64 + lane], hq1 = h2qL[(tl * 2 + 1) * 64 + lane]; const float shq = shqL[tl];
#pragma unroll 1
                for (int p = b0; p < b1; p += 4) {
                    int ids[4]; float cfs[4], sus[4];
#pragma unroll
                    for (int e = 0; e < 4; ++e) { const int pp = min(p + e, b1 - 1); const v2u w_ = ent[tl * 128 + pp]; const unsigned ex = w_.x, ey = w_.y;
                        ids[e] = __builtin_amdgcn_readfirstlane((int)ex); cfs[e] = __builtin_bit_cast(float, __builtin_amdgcn_readfirstlane((int)ey)); sus[e] = tscU[ids[e]]; }
                    v4u uu[4][2];
#pragma unroll
                    for (int e = 0; e < 4; ++e) { const GAS unsigned char* rb = (const GAS unsigned char*)Ub + (size_t)ids[e] * 2048; uu[e][0] = *(const GAS v4u*)(rb + lo16); uu[e][1] = *(const GAS v4u*)(rb + lo16 + 1024); }
                    float dd[4];
#pragma unroll
                    for (int e = 0; e < 4; ++e) { int a0 = 0, a1 = 0;
                        a0 = __builtin_amdgcn_sdot4((int)uu[e][0][0], (int)hq0[0], a0, false); a1 = __builtin_amdgcn_sdot4((int)uu[e][0][1], (int)hq0[1], a1, false);
                        a0 = __builtin_amdgcn_sdot4((int)uu[e][0][2], (int)hq0[2], a0, false); a1 = __builtin_amdgcn_sdot4((int)uu[e][0][3], (int)hq0[3], a1, false);
                        a0 = __builtin_amdgcn_sdot4((int)uu[e][1][0], (int)hq1[0], a0, false); a1 = __builtin_amdgcn_sdot4((int)uu[e][1][1], (int)hq1[1], a1, false);
                        a0 = __builtin_amdgcn_sdot4((int)uu[e][1][2], (int)hq1[2], a0, false); a1 = __builtin_amdgcn_sdot4((int)uu[e][1][3], (int)hq1[3], a1, false);
                        dd[e] = (float)(a0 + a1); }
#pragma unroll
                    for (int o_ = 1; o_ < 64; o_ <<= 1) {
#pragma unroll
                        for (int e = 0; e < 4; ++e) dd[e] += __shfl_xor(dd[e], o_); }
#pragma unroll
                    for (int e = 0; e < 4; ++e) { const float cf = cfs[e] * gelu_tanh(dd[e] * sus[e] * shq);
                        if (lane == 0 && p + e < b1) { v2u w2; w2.x = (unsigned)ids[e]; w2.y = __builtin_bit_cast(unsigned, cf); ent[tl * 128 + p + e] = w2; } }
                }
            }
        }
#pragma unroll 1
        for (int half = 0; half < 2; ++half) {
            float y0[32], y1[32]; float cs0 = 0.f, cs1 = 0.f;
            const int tla = wave * 4 + half * 2, tlb = tla + 1; const size_t ta = (size_t)tok0 + tla, tb = ta + 1;
#pragma unroll
            for (int j = 0; j < 2; ++j)
#pragma unroll
                for (int q = 0; q < 4; ++q) { const size_t e0 = 16 * (size_t)(lane + 64 * j) + 4 * q;
                    const f32x4 xa = *(const GAS f32x4*)(X + ta * DM + e0), xc = *(const GAS f32x4*)(X + tb * DM + e0);
#pragma unroll
                    for (int k = 0; k < 4; ++k) { y0[j * 16 + q * 4 + k] = xa[k]; y1[j * 16 + q * 4 + k] = xc[k]; } }
#define PV_ACC(YY, CS, TL) { const int b0 = (int)offs[(TL) * 17 + s], b1 = (int)offs[(TL) * 17 + s + 1]; \
                _Pragma("unroll 1") for (int p = b0; p < b1; p += 4) { int ids[4]; float cfs[4]; \
                    _Pragma("unroll") for (int e = 0; e < 4; ++e) { const bool ok = p + e < b1; const v2u w_ = ent[(TL) * 128 + min(p + e, b1 - 1)]; const unsigned ex = w_.x, ey = w_.y; \
                        ids[e] = __builtin_amdgcn_readfirstlane((int)ex); cfs[e] = ok ? __builtin_bit_cast(float, __builtin_amdgcn_readfirstlane((int)ey)) : 0.f; } \
                    v4u vv[4][2]; \
                    _Pragma("unroll") for (int e = 0; e < 4; ++e) { const GAS unsigned char* rb = (const GAS unsigned char*)Vb + (size_t)ids[e] * 2048; vv[e][0] = *(const GAS v4u*)(rb + lo16); vv[e][1] = *(const GAS v4u*)(rb + lo16 + 1024); } \
                    _Pragma("unroll") for (int e = 0; e < 4; ++e) { const float c = cfs[e]; CS += c; \
                        _Pragma("unroll") for (int j = 0; j < 2; ++j) _Pragma("unroll") for (int w = 0; w < 4; ++w) { const unsigned dw = vv[e][j][w]; \
                            YY[j * 16 + w * 4 + 0] += c * ubf0(dw); YY[j * 16 + w * 4 + 1] += c * ubf1(dw); YY[j * 16 + w * 4 + 2] += c * ubf2(dw); YY[j * 16 + w * 4 + 3] += c * ubf3(dw); } \
                        TOUCH16(YY, 0); TOUCH16(YY, 16); } } }
#pragma unroll 1
            for (int s = 0; s < NSLICE; ++s) { PV_ACC(y0, cs0, tla); PV_ACC(y1, cs1, tlb); }
#undef PV_ACC
#define PV_EPI(YY, CS, T) { float ss = 0.f; const float corr = 128.0f * CS; \
                _Pragma("unroll") for (int i = 0; i < 32; ++i) { YY[i] -= corr; ss += YY[i] * YY[i]; } \
                ss = wave_sum(ss); const float rs = rsqrtf(ss * (1.0f / DM) + RMS_EPS); \
                if (last) { _Pragma("unroll") for (int j = 0; j < 2; ++j) _Pragma("unroll") for (int q = 0; q < 4; ++q) { const size_t e0 = 16 * (size_t)(lane + 64 * j) + 4 * q; const f32x4 ga = *(const GAS f32x4*)(gf + e0); \
                        f32x4 oa = {YY[j * 16 + q * 4 + 0] * rs * ga[0], YY[j * 16 + q * 4 + 1] * rs * ga[1], YY[j * 16 + q * 4 + 2] * rs * ga[2], YY[j * 16 + q * 4 + 3] * rs * ga[3]}; *(GAS f32x4*)(X + (T) * DM + e0) = oa; } } \
                else { _Pragma("unroll") for (int j = 0; j < 2; ++j) { \
                        _Pragma("unroll") for (int q = 0; q < 4; ++q) { const size_t e0 = 16 * (size_t)(lane + 64 * j) + 4 * q; f32x4 oa = {YY[j * 16 + q * 4 + 0], YY[j * 16 + q * 4 + 1], YY[j * 16 + q * 4 + 2], YY[j * 16 + q * 4 + 3]}; *(GAS f32x4*)(X + (T) * DM + e0) = oa; } \
                        const size_t e0 = 16 * (size_t)(lane + 64 * j); v4u w0, w1; \
                        w0.x = pk2(YY[j * 16 + 0], YY[j * 16 + 1]); w0.y = pk2(YY[j * 16 + 2], YY[j * 16 + 3]); w0.z = pk2(YY[j * 16 + 4], YY[j * 16 + 5]); w0.w = pk2(YY[j * 16 + 6], YY[j * 16 + 7]); \
                        w1.x = pk2(YY[j * 16 + 8], YY[j * 16 + 9]); w1.y = pk2(YY[j * 16 + 10], YY[j * 16 + 11]); w1.z = pk2(YY[j * 16 + 12], YY[j * 16 + 13]); w1.w = pk2(YY[j * 16 + 14], YY[j * 16 + 15]); \
                        *(GAS v4u*)(xb + (T) * DM + e0) = w0; *(GAS v4u*)(xb + (T) * DM + e0 + 8) = w1; } \
                    if (lane == 0) rstd1[(T)] = rs; } }
            PV_EPI(y0, cs0, ta); PV_EPI(y1, cs1, tb);
#undef PV_EPI
        }
        __syncthreads();
    }
}

#ifndef PROBE_ITEM
#define PROBE_ITEM -1
#endif
#define IREP(k) for (int irep = (PROBE_ITEM == (k)) ? 0 : 1; irep < 2; ++irep)
#ifndef FAST_MASK
#define FAST_MASK 15
#endif
__device__ __forceinline__ void mix_p2(ArgsR A, int l, LAS unsigned char* lds, int G, int tid) {
    const int bx = blockIdx.x;
    if (FAST_MASK & 2) IREP(1) for (int it = bx; it < 512; it += G) f_gla_p2(A, l, it, lds, pg8::fresh_tid());
    if (FAST_MASK & 4) IREP(2) for (int it = bx; it < 512; it += G) f_ml_p2(A, l, it, lds, pg8::fresh_tid());
    if (FAST_MASK & 8) IREP(3) for (int it = bx; it < 512; it += G) f_gdn_p2(A, l, it, lds, pg8::fresh_tid());
    if (FAST_MASK & 1) IREP(4) for (int it = bx; it < 1024; it += G) f_lru_p2(A, l, it, lds, pg8::fresh_tid());
    if ((FAST_MASK & 15) != 15) {
        for (int it = bx; it < 80; it += G) {
            if (it < 16) { if (!(FAST_MASK & 2)) nm_gla(A, l, it >> 2, it & 3, lds, pg8::fresh_tid()); }
            else if (it < 32) { if (!(FAST_MASK & 4)) nm_mlstm(A, l, (it - 16) >> 2, (it - 16) & 3, lds, pg8::fresh_tid()); }
            else if (it < 48) { if (!(FAST_MASK & 8)) nm_gdn(A, l, (it - 32) >> 2, (it - 32) & 3, lds, pg8::fresh_tid()); }
            else { if (!(FAST_MASK & 1)) nm_lru(A, l, (it - 48) >> 3, (it - 48) & 7, lds, pg8::fresh_tid()); }
            __syncthreads();
        }
    }
}
__device__ __forceinline__ void part_barrier(unsigned* word, unsigned nb, int tid) {
    asm volatile("s_waitcnt vmcnt(0)" ::: "memory");
    __syncthreads();
    if (tid == 0) {
        __builtin_amdgcn_fence(__ATOMIC_RELEASE, "agent");
        asm volatile("s_waitcnt vmcnt(0)" ::: "memory");
        __hip_atomic_fetch_add(word, 1u, __ATOMIC_RELAXED, __HIP_MEMORY_SCOPE_AGENT);
        unsigned sp = 0;
        while (__hip_atomic_load(word, __ATOMIC_RELAXED, __HIP_MEMORY_SCOPE_AGENT) < nb) { __builtin_amdgcn_s_sleep(2); if (++sp > (1u << 22)) break; }
        __builtin_amdgcn_fence(__ATOMIC_ACQUIRE, "agent");
        asm volatile("s_waitcnt vmcnt(0)" ::: "memory");
    }
    __syncthreads();
}
__device__ __forceinline__ void mix_p3(ArgsR A, int l, LAS unsigned char* lds, int G) {
    const int bx = blockIdx.x;
    const bool split = G > 32;
    int first = 0, nb = G;
    if (split) { if (bx < 16) { f_gdn_p3(A, l, bx, lds, pg8::fresh_tid()); return; } first = 16; nb = G - 16; }
    else { for (int it = bx; it < 16; it += G) f_gdn_p3(A, l, it, lds, pg8::fresh_tid()); }
    for (int it = bx - first; it < 516; it += nb) {
        if (it < 256) f_gla_p3(A, it, pg8::fresh_tid());
        else if (it < 512) f_ml_p3(A, it - 256, pg8::fresh_tid());
        else f_lru_p3(A, it - 512, pg8::fresh_tid());
    }
    IREP(7) { const int t2 = pg8::fresh_tid(); tab_convert(A, l, (bx - first) * NWAVES + __builtin_amdgcn_readfirstlane(t2 >> 6), nb * NWAVES, t2 & 63); }
    part_barrier((unsigned*)(A.ws + WS_CTL) + CW_PBAR + 64 * l, (unsigned)nb, pg8::fresh_tid());
    IREP(5) for (int it = bx - first; it < 512; it += nb) f_gla_p4(A, l, it, lds, pg8::fresh_tid());
    IREP(6) for (int it = nb - 1 - (bx - first); it < 512; it += nb) f_ml_p4(       A, l, it, lds, pg8::fresh_tid());
    for (int it = bx - first; it < 128; it += nb) f_lru_p4(A, it, pg8::fresh_tid());
}

#ifndef PROBE_PHASE
#define PROBE_PHASE -1
#endif
#ifndef MK_PER_PHASE
#define MK_PER_PHASE 0
#endif
#if defined(PROBE_PHASE) && PROBE_PHASE == 7
constexpr int PPL = 7;
#else
constexpr int PPL = 6;
#endif
constexpr int NPHASE = 1 + PPL * DEPTH;
constexpr int CW_BAR = 4096;

__global__ void __launch_bounds__(NTHREADS, 2) mk_fwd(Args args) {
    extern __shared__ __attribute__((aligned(16))) unsigned char lds_raw[];
    LAS unsigned char* lds = (LAS unsigned char*)lds_raw;
    volatile LAS unsigned* MISC = (volatile LAS unsigned*)(lds + MISC_OFF);
    const int G = gridDim.x; const int bx = blockIdx.x;
    unsigned char* ws = args.ws;
    if (threadIdx.x < 64) MISC[threadIdx.x] = 0u;
    __syncthreads();
    XcdBarrier bar; bar.bar = (unsigned*)(ws + WS_CTL) + CW_BAR; bar.x = 0; bar.st = nullptr;
    if (!MK_PER_PHASE) bar = xcd_barrier_post((unsigned*)(ws + WS_CTL) + CW_BAR, MISC + 8);
    const int lo = args.ph_lo, hi = args.ph_hi;
#pragma unroll 1
    for (int ph = lo; ph < hi; ++ph) {
        const int l = ph > 0 ? (ph - 1) / PPL : 0, k = ph > 0 ? (ph - 1) % PPL : -1;
        if (k < 0) { const int t0 = pg8::fresh_tid(); const int vcu = (G % 8 == 0) ? (bx % 8) * (G / 8) + bx / 8 : bx; p0_prologue(*kargs(), lds, vcu, G, __builtin_amdgcn_readfirstlane(t0 >> 6), t0 & 63); }
        else if (k == 0) {
            pg8::Gemm g{(const pg8::bf16_t*)(ws + WS_XB), (const pg8::bf16_t*)(ws + WS_WIN + l * WIN_L), NT, NINP, DM}; pg8::StaticOrder S; S.init(NT, NINP, G, bx);
            pg8::EpiP E{(pg8::bf16_t*)(ws + WS_P), (float*)(ws + WS_PS), (const float*)(ws + WS_RSTD1)};
            pg8::gemm_phase<pg8::EpiP, pg8::StaticOrder, true, true>(lds, g, S, E); }
        else if (k == 1) mix_p2(*kargs(), l, lds, G, pg8::fresh_tid());
        else if (k == 2) mix_p3(*kargs(), l, lds, G);
        else if (k == 3) {
            pg8::Gemm g{(const pg8::bf16_t*)(ws + WS_MIX), (const pg8::bf16_t*)(ws + WS_WOUT + l * WSQ_L), NT, DM, DM}; pg8::StaticOrder S; S.init(NT, DM, G, bx);
            pg8::EpiX E{l == 0 ? args.in[I_X] : (const float*)args.out, args.out, (pg8::bf16_t*)(ws + WS_XB), (float*)(ws + WS_SSP)};
            pg8::gemm_phase<pg8::EpiX, pg8::StaticOrder, true, true>(lds, g, S, E); }
        else if (k == 4) {
            pg8::Gemm g{(const pg8::bf16_t*)(ws + WS_XB), (const pg8::bf16_t*)(ws + WS_WQ + l * WSQ_L), NT, DM, DM}; pg8::StaticOrder S; S.init(NT, DM, G, bx);
            pg8::EpiQ E{(pg8::bf16_t*)(ws + WS_Q), (const float*)(ws + WS_SSP)};
            pg8::gemm_phase<pg8::EpiQ, pg8::StaticOrder, true, true>(lds, g, S, E); }
#if defined(PROBE_PHASE) && PROBE_PHASE == 7
        else if (k == 5) peer_phase<true>(*kargs(), l, l == DEPTH - 1, lds, G, pg8::fresh_tid());
#endif
        else peer_phase<false>(*kargs(), l, l == DEPTH - 1, lds, G, pg8::fresh_tid());
        if (!MK_PER_PHASE && ph + 1 < hi) xcd_barrier(bar);
    }
}

extern "C" void kernel_launch(void* const* d_in, const int* in_sizes, int n_in, void* d_out, int out_size, void* d_ws, size_t ws_size, hipStream_t stream) {
    static int grid = 0;
    if (grid == 0) {
        if (n_in != N_IN || out_size != NT * DM || ws_size < WS_END) { fprintf(stderr, "kernel_launch: unexpected shapes: n_in %d out %d ws %zu (need %zu)\n", n_in, out_size, ws_size, (size_t)WS_END); grid = -1; return; }
        int dev = 0, cus = 0, per_cu = 0;
        if (hipGetDevice(&dev) != hipSuccess || hipDeviceGetAttribute(&cus, hipDeviceAttributeMultiprocessorCount, dev) != hipSuccess) { grid = -1; return; }
        if (hipFuncSetAttribute((const void*)mk_fwd, hipFuncAttributeMaxDynamicSharedMemorySize, LDS_BYTES) != hipSuccess) { fprintf(stderr, "kernel_launch: hipFuncSetAttribute failed\n"); grid = -1; return; }
        if (hipOccupancyMaxActiveBlocksPerMultiprocessor(&per_cu, (const void*)mk_fwd, NTHREADS, LDS_BYTES) != hipSuccess || per_cu < 1) { fprintf(stderr, "kernel_launch: occupancy query says %d blocks per CU\n", per_cu); (void)hipGetLastError(); grid = -1; return; }
        grid = cus;
    }
    if (grid < 0) return;
    if (hipMemsetAsync((char*)d_ws + WS_CTL, 0, CTL_ZERO_BYTES, stream) != hipSuccess) return;
    Args a{};
    for (int i = 0; i < N_IN; ++i) a.in[i] = (const float*)d_in[i];
    a.out = (float*)d_out; a.ws = (unsigned char*)d_ws;
#if MK_PER_PHASE
    for (int p = 0; p < NPHASE; ++p) { a.ph_lo = p; a.ph_hi = p + 1; a.li = 0; hipLaunchKernelGGL(mk_fwd, dim3(grid), dim3(NTHREADS), LDS_BYTES, stream, a); }
#else
    a.ph_lo = 0; a.ph_hi = NPHASE; a.li = 0;
    hipLaunchKernelGGL(mk_fwd, dim3(grid), dim3(NTHREADS), LDS_BYTES, stream, a);
#endif
}
```

```cpp
#include <hip/hip_runtime.h>
#include <cstdio>
#include <cstdint>
#define TAB_FP8 1
namespace pg8 {
__device__ __forceinline__ int fresh_tid() { int t = threadIdx.x; asm volatile("" : "+v"(t)); return t; }
#define PG8_LAS __attribute__((address_space(3)))
typedef unsigned short bf16_t;
typedef short bf16x8 __attribute__((ext_vector_type(8)));
typedef float f32x4 __attribute__((ext_vector_type(4)));
typedef unsigned u32x4 __attribute__((ext_vector_type(4)));
constexpr int BM = 256, BK = 64, HALF = 128, HTB = HALF * BK * 2  , STAGE_BYTES = 8 * HTB, NXCD = 8, WGM = 8;

__host__ __device__ __forceinline__ int lds_byte(int r, int c) { const int st = (r >> 4) * 2 + (c >> 5), rr = r & 15, cc = c & 31, ob = rr * 64 + cc * 2; return st * 1024 + (ob ^ (((ob >> 9) & 1) << 5)); }
__host__ __device__ __forceinline__ void stage_rc(int b, int& R, int& C) { const int st = b / 1024, sb = b % 1024, swz = sb ^ (((sb >> 9) & 1) << 5); R = (st >> 1) * 16 + swz / 64; C = (st & 1) * 32 + (swz % 64) / 2; }
__host__ __device__ __forceinline__ int perm32(int rho) { const int n = rho >> 4, i = rho & 15; return 8 * (i >> 2) + 4 * n + (i & 3); }

struct Unit { int pm, pn; };
struct Gemm { const bf16_t* A; const bf16_t* Bt; int M, N, K; };

struct StaticOrder {
    int nM, nN, nwg, G, c;
    __host__ __device__ void init(int M, int N, int G_, int c_) { nM = M / BM; nN = N / BM; nwg = nM * nN; G = G_; c = c_; }
    __host__ __device__ bool next(int i, Unit& u) const {
        const long L = (long)i * G + c; if (L >= nwg) return false;
        int wgid = (int)L; { const int q = nwg / NXCD, r = nwg % NXCD, xcd = wgid % NXCD, off = wgid / NXCD; wgid = (xcd < r ? xcd * (q + 1) : r * (q + 1) + (xcd - r) * q) + off; }
        const int nig = WGM * nN, gid = wgid / nig, fm = gid * WGM, gsz = (nM - fm) < WGM ? (nM - fm) : WGM;
        u.pm = fm + ((wgid % nig) % gsz); u.pn = (wgid % nig) / gsz; return true;
    }
    __device__ __forceinline__ void a_ready(const Unit&) const {}
    __device__ __forceinline__ void done(const Unit&) const {}
};


__device__ __forceinline__ unsigned cvt_pk_bf16(float lo, float hi) { unsigned r; asm volatile("v_cvt_pk_bf16_f32 %0, %1, %2" : "=v"(r) : "v"(lo), "v"(hi)); return r; }

struct EpiP {
    static constexpr bool PERM = true, AFTER_DRAIN = false;
    bf16_t* P; float* Ps; const float* rstd;
    __device__ __forceinline__ void operator()(const f32x4 (&acc)[2][2][4][2], const Unit& u, int wr, int wc, int fr, int fq) const {
        const int row0 = u.pm * BM + wr * 64 + fr;
        if (u.pn < 28) {
            const int col0 = u.pn * BM + wc * 32 + 8 * fq;
#pragma unroll
            for (int ai = 0; ai < 2; ++ai)
#pragma unroll
                for (int m = 0; m < 4; ++m) { const int row = row0 + ai * HALF + m * 16; const float r = rstd[row]; bf16_t* rowp = P + (size_t)row * 7168 + col0;
#pragma unroll
                    for (int bj = 0; bj < 2; ++bj) { const f32x4 v0 = acc[ai][bj][m][0] * r, v1 = acc[ai][bj][m][1] * r;
                        u32x4 w; w.x = cvt_pk_bf16(v0[0], v0[1]); w.y = cvt_pk_bf16(v0[2], v0[3]); w.z = cvt_pk_bf16(v1[0], v1[1]); w.w = cvt_pk_bf16(v1[2], v1[3]);
                        *(u32x4*)(rowp + bj * HALF) = w; } }
        } else if (wc == 0) {
#pragma unroll
            for (int ai = 0; ai < 2; ++ai)
#pragma unroll
                for (int m = 0; m < 4; ++m) { const int row = row0 + ai * HALF + m * 16; const float r = rstd[row]; float* p = Ps + (size_t)row * 32 + 8 * fq;
                    *(f32x4*)p = acc[ai][0][m][0] * r; *(f32x4*)(p + 4) = acc[ai][0][m][1] * r; }
        }
    }
};
struct EpiX {
    static constexpr bool PERM = true, AFTER_DRAIN = false;
    const float* xres; float* xout; bf16_t* xb; float* ssp;
    __device__ __forceinline__ void operator()(const f32x4 (&acc)[2][2][4][2], const Unit& u, int wr, int wc, int fr, int fq) const {
        const int row0 = u.pm * BM + wr * 64 + fr, col0 = u.pn * BM + wc * 32 + 8 * fq;
#pragma unroll
        for (int ai = 0; ai < 2; ++ai)
#pragma unroll
            for (int m = 0; m < 4; ++m) { const int row = row0 + ai * HALF + m * 16; float ss = 0.f;
#pragma unroll
                for (int bj = 0; bj < 2; ++bj) { const size_t off = (size_t)row * 2048 + col0 + bj * HALF;
                    const f32x4 r0 = *(const f32x4*)(xres + off), r1 = *(const f32x4*)(xres + off + 4);
                    const f32x4 v0 = acc[ai][bj][m][0] + r0, v1 = acc[ai][bj][m][1] + r1;
                    *(f32x4*)(xout + off) = v0; *(f32x4*)(xout + off + 4) = v1;
                    u32x4 w; w.x = cvt_pk_bf16(v0[0], v0[1]); w.y = cvt_pk_bf16(v0[2], v0[3]); w.z = cvt_pk_bf16(v1[0], v1[1]); w.w = cvt_pk_bf16(v1[2], v1[3]);
                    *(u32x4*)(xb + off) = w;
                    ss += (v0[0] * v0[0] + v0[1] * v0[1]) + (v0[2] * v0[2] + v0[3] * v0[3]) + (v1[0] * v1[0] + v1[1] * v1[1]) + (v1[2] * v1[2] + v1[3] * v1[3]); }
                ss += __shfl_xor(ss, 16); ss += __shfl_xor(ss, 32);
                if (fq == 0) ssp[(size_t)row * 32 + u.pn * 4 + wc] = ss; }
    }
};
struct EpiQ {
    static constexpr bool PERM = true, AFTER_DRAIN = false;
    bf16_t* Q; const float* ssp;
    __device__ __forceinline__ void operator()(const f32x4 (&acc)[2][2][4][2], const Unit& u, int wr, int wc, int fr, int fq) const {
        const int row0 = u.pm * BM + wr * 64 + fr, col0 = u.pn * BM + wc * 32 + 8 * fq;
#pragma unroll
        for (int ai = 0; ai < 2; ++ai)
#pragma unroll
            for (int m = 0; m < 4; ++m) { const int row = row0 + ai * HALF + m * 16;
                const f32x4* sp = (const f32x4*)(ssp + (size_t)row * 32 + 8 * fq); const f32x4 a = sp[0], b = sp[1];
                float s = ((a[0] + a[1]) + (a[2] + a[3])) + ((b[0] + b[1]) + (b[2] + b[3]));
                s += __shfl_xor(s, 16); s += __shfl_xor(s, 32);
                const float r = rsqrtf(s * (1.0f / 2048.0f) + 1e-6f); bf16_t* rowp = Q + (size_t)row * 2048 + col0;
#pragma unroll
                for (int bj = 0; bj < 2; ++bj) { const f32x4 v0 = acc[ai][bj][m][0] * r, v1 = acc[ai][bj][m][1] * r;
                    u32x4 w; w.x = cvt_pk_bf16(v0[0], v0[1]); w.y = cvt_pk_bf16(v0[2], v0[3]); w.z = cvt_pk_bf16(v1[0], v1[1]); w.w = cvt_pk_bf16(v1[2], v1[3]);
                    *(u32x4*)(rowp + bj * HALF) = w; } }
    }
};

template <class Epi, class Sched, bool ALIGN_EPI = false, bool SP2 = false>
__device__ __forceinline__ void gemm_phase(PG8_LAS unsigned char* lds, const Gemm g, const Sched& S, const Epi& E) {
    const int tid = fresh_tid(), wid = __builtin_amdgcn_readfirstlane(tid >> 6), lane = tid & 63, wr = wid >> 2, wc = wid & 3, fr = lane & 15, fq = lane >> 4;
    const int K = g.K, nt = K / BK;
    unsigned voffA[2], voffB[2];
#pragma unroll
    for (int i = 0; i < 2; ++i) { int R, C; stage_rc(tid * 16 + i * 8192, R, C); const int Rb = Epi::PERM ? ((R & ~31) + perm32(R & 31)) : R;
        voffA[i] = (unsigned)(R * K + C) * 2u; voffB[i] = (unsigned)(Rb * K + C) * 2u; }
    const size_t kstep = (size_t)(BK * 2);
    const size_t hstep = (size_t)HALF * K * 2;
    const size_t tstep = 2 * hstep;
    const unsigned ldsw = (unsigned)wid * 1024u;
    const int aoff = lds_byte(wr * 64 + fr, fq * 8), boff = lds_byte(wc * 32 + fr, fq * 8);
#define PG8_SA(b, h) (((b) * 2 + (h)) * HTB)
#define PG8_SB(b, h) ((4 + (b) * 2 + (h)) * HTB)
#define PG8_STAGE(bufoff, gbase, voff) do { _Pragma("unroll") for (int _i = 0; _i < 2; ++_i) \
        __builtin_amdgcn_global_load_lds((const unsigned*)((const char*)(gbase) + (voff)[_i]), (PG8_LAS unsigned*)(lds + (bufoff) + ldsw + _i * 8192), 16, 0, 0); } while (0)
#define PG8_LDA(dst, b, h) do { _Pragma("unroll") for (int m = 0; m < 4; ++m) _Pragma("unroll") for (int k = 0; k < 2; ++k) dst[m][k] = *(const PG8_LAS bf16x8*)(lds + PG8_SA(b, h) + aoff + m * 2048 + k * 1024); } while (0)
#define PG8_LDB(dst, b, h) do { _Pragma("unroll") for (int n = 0; n < 2; ++n) _Pragma("unroll") for (int k = 0; k < 2; ++k) dst[n][k] = *(const PG8_LAS bf16x8*)(lds + PG8_SB(b, h) + boff + n * 2048 + k * 1024); } while (0)
#define PG8_MMA(ai, bj, At, Bt) do { __builtin_amdgcn_s_setprio(1); _Pragma("unroll") for (int m = 0; m < 4; ++m) _Pragma("unroll") for (int n = 0; n < 2; ++n) _Pragma("unroll") for (int k = 0; k < 2; ++k) \
        acc[ai][bj][m][n] = __builtin_amdgcn_mfma_f32_16x16x32_bf16(Bt[n][k], At[m][k], acc[ai][bj][m][n], 0, 0, 0); __builtin_amdgcn_s_setprio(0); } while (0)
#define PG8_WAIT_V(n) asm volatile("s_waitcnt vmcnt(" #n ")" ::: "memory")
#define PG8_WAIT_L(n) asm volatile("s_waitcnt lgkmcnt(" #n ")" ::: "memory")
#define PG8_BAR __builtin_amdgcn_s_barrier()
#define PG8_SCHED __builtin_amdgcn_sched_barrier(0)
    Unit cur, nxt; int ui = 0;
    if (!S.next(0, cur)) return;
    f32x4 acc[2][2][4][2];
#pragma unroll
    for (int a = 0; a < 2; ++a)
#pragma unroll
        for (int b = 0; b < 2; ++b)
#pragma unroll
            for (int m = 0; m < 4; ++m)
#pragma unroll
                for (int n = 0; n < 2; ++n) acc[a][b][m][n] = (f32x4){0.f, 0.f, 0.f, 0.f};
    bf16x8 At[4][2], B0[2][2], B1[2][2];
    const char* cA = (const char*)g.A + (size_t)cur.pm * tstep; const char* cB = (const char*)g.Bt + (size_t)cur.pn * tstep;
    S.a_ready(cur);
    if constexpr (SP2) {
        PG8_STAGE(PG8_SB(0, 0), cB, voffB); PG8_STAGE(PG8_SB(0, 1), cB + hstep, voffB); PG8_STAGE(PG8_SA(0, 0), cA, voffA); PG8_STAGE(PG8_SA(0, 1), cA + hstep, voffA);
        if (wr == 1) PG8_BAR;
        PG8_WAIT_V(2); PG8_BAR;
        PG8_STAGE(PG8_SB(1, 0), cB + kstep, voffB); PG8_STAGE(PG8_SA(1, 0), cA + kstep, voffA); PG8_STAGE(PG8_SB(1, 1), cB + hstep + kstep, voffB);
        PG8_WAIT_V(6); PG8_BAR;
    } else {
        PG8_STAGE(PG8_SB(0, 0), cB, voffB); PG8_STAGE(PG8_SA(0, 0), cA, voffA); PG8_STAGE(PG8_SB(0, 1), cB + hstep, voffB); PG8_STAGE(PG8_SA(0, 1), cA + hstep, voffA);
        if (wr == 1) PG8_BAR;
        PG8_WAIT_V(4); PG8_BAR;
        PG8_STAGE(PG8_SB(1, 0), cB + kstep, voffB); PG8_STAGE(PG8_SA(1, 0), cA + kstep, voffA); PG8_STAGE(PG8_SB(1, 1), cB + hstep + kstep, voffB);
        PG8_WAIT_V(6); PG8_BAR;
    }
    for (;;) {
        const bool has_next = S.next(ui + 1, nxt);
        const char* nA = has_next ? (const char*)g.A + (size_t)nxt.pm * tstep : cA; const char* nB = has_next ? (const char*)g.Bt + (size_t)nxt.pn * tstep : cB;
        for (int t = 0; t < nt; t += 2) {
            const bool last = (t == nt - 2);
            const char* a1 = cA + (size_t)(t + 1) * kstep;
            const char* a2 = last ? nA : cA + (size_t)(t + 2) * kstep; const char* b2 = last ? nB : cB + (size_t)(t + 2) * kstep;
            const char* a3 = a2 + kstep; const char* b3 = b2 + kstep;
            if (last && has_next) S.a_ready(nxt);
            if constexpr (SP2) {
            PG8_LDB(B0, 0, 0); PG8_LDB(B1, 0, 1); PG8_SCHED; PG8_LDA(At, 0, 0); PG8_STAGE(PG8_SA(1, 1), a1 + hstep, voffA);
            PG8_WAIT_V(8); PG8_WAIT_L(0); PG8_BAR; PG8_MMA(0, 0, At, B0); PG8_MMA(0, 1, At, B1); PG8_BAR; PG8_SCHED;
            PG8_LDA(At, 0, 1); PG8_STAGE(PG8_SB(0, 0), b2, voffB); PG8_STAGE(PG8_SB(0, 1), b2 + hstep, voffB); PG8_STAGE(PG8_SA(0, 0), a2, voffA);
            PG8_WAIT_V(8); PG8_WAIT_L(0); PG8_BAR; PG8_MMA(1, 0, At, B0); PG8_MMA(1, 1, At, B1); PG8_BAR; PG8_SCHED;
            PG8_LDB(B0, 1, 0); PG8_LDB(B1, 1, 1); PG8_SCHED; PG8_LDA(At, 1, 0); PG8_STAGE(PG8_SA(0, 1), a2 + hstep, voffA);
            PG8_WAIT_V(8); PG8_WAIT_L(0); PG8_BAR; PG8_MMA(0, 0, At, B0); PG8_MMA(0, 1, At, B1); PG8_BAR; PG8_SCHED;
            PG8_LDA(At, 1, 1); PG8_STAGE(PG8_SB(1, 0), b3, voffB); PG8_STAGE(PG8_SB(1, 1), b3 + hstep, voffB); PG8_STAGE(PG8_SA(1, 0), a3, voffA);
            PG8_WAIT_V(8); PG8_WAIT_L(0); PG8_BAR; PG8_MMA(1, 0, At, B0); PG8_MMA(1, 1, At, B1); PG8_BAR; PG8_SCHED;
            } else {
            PG8_LDB(B0, 0, 0); PG8_SCHED; PG8_LDA(At, 0, 0); PG8_STAGE(PG8_SA(1, 1), a1 + hstep, voffA);
            PG8_WAIT_L(8); PG8_BAR; PG8_WAIT_L(0); PG8_MMA(0, 0, At, B0); PG8_BAR; PG8_SCHED;
            PG8_LDB(B1, 0, 1); PG8_STAGE(PG8_SB(0, 0), b2, voffB);
            PG8_BAR; PG8_WAIT_L(0); PG8_MMA(0, 1, At, B1); PG8_BAR;
            PG8_LDA(At, 0, 1); PG8_STAGE(PG8_SA(0, 0), a2, voffA);
            PG8_BAR; PG8_WAIT_L(0); PG8_MMA(1, 0, At, B0); PG8_BAR; PG8_SCHED;
            PG8_STAGE(PG8_SB(0, 1), b2 + hstep, voffB);
            PG8_WAIT_V(6); PG8_BAR; PG8_MMA(1, 1, At, B1); PG8_BAR;
            PG8_LDB(B0, 1, 0); PG8_SCHED; PG8_LDA(At, 1, 0); PG8_STAGE(PG8_SA(0, 1), a2 + hstep, voffA);
            PG8_WAIT_L(8); PG8_BAR; PG8_WAIT_L(0); PG8_MMA(0, 0, At, B0); PG8_BAR; PG8_SCHED;
            PG8_LDB(B1, 1, 1); PG8_STAGE(PG8_SB(1, 0), b3, voffB);
            PG8_BAR; PG8_WAIT_L(0); PG8_MMA(0, 1, At, B1); PG8_BAR;
            PG8_LDA(At, 1, 1); PG8_STAGE(PG8_SA(1, 0), a3, voffA);
            PG8_BAR; PG8_WAIT_L(0); PG8_MMA(1, 0, At, B0); PG8_BAR; PG8_SCHED;
            PG8_STAGE(PG8_SB(1, 1), b3 + hstep, voffB);
            PG8_WAIT_V(6); PG8_BAR; PG8_MMA(1, 1, At, B1); PG8_BAR;
            }
        }
        if constexpr (ALIGN_EPI) { if (wr == 0) PG8_BAR; }
        if constexpr (!Epi::AFTER_DRAIN) { E(acc, cur, wr, wc, fr, fq); S.done(cur); }
        if (!has_next) break;
#pragma unroll
        for (int a = 0; a < 2; ++a)
#pragma unroll
            for (int b = 0; b < 2; ++b)
#pragma unroll
                for (int m = 0; m < 4; ++m)
#pragma unroll
                    for (int n = 0; n < 2; ++n) acc[a][b][m][n] = (f32x4){0.f, 0.f, 0.f, 0.f};
        cur = nxt; cA = nA; cB = nB; ++ui;
        if constexpr (ALIGN_EPI) { if (wr == 1) PG8_BAR; }
    }
    PG8_WAIT_V(0);
    if constexpr (!ALIGN_EPI) { if (wr == 0) PG8_BAR; }
    PG8_BAR;
    if constexpr (Epi::AFTER_DRAIN) { E.fused(acc, cur, wr, wc, fr, fq, lds, wid, lane); S.done(cur); }
#undef PG8_SA
#undef PG8_SB
#undef PG8_STAGE
#undef PG8_LDA
#undef PG8_LDB
#undef PG8_MMA
#undef PG8_WAIT_V
#undef PG8_WAIT_L
#undef PG8_BAR
#undef PG8_SCHED
}
}

constexpr int NWAVES = 8, NTHREADS = 512;
constexpr int NT = 8192, DM = 2048, SEQ = 2048, NBATCH = 4, DEPTH = 2, CHK = 64, NCHK = 32, GW = 512, NH = 4, HD = 128;
constexpr int DIN = 7200, NINP = 7424, PBW = 7168;
constexpr int NEXP = 16384;
constexpr int PC_GLA_Q = 0, PC_GLA_K = 512, PC_GLA_V = 1024, PC_GLA_G = 1536, PC_LRU_X = 2048, PC_LRU_Y = 2560, PC_ML_Q = 3072, PC_ML_K = 3584, PC_ML_V = 4096, PC_ML_O = 4608,
              PC_GDN_Q = 5120, PC_GDN_K = 5632, PC_GDN_V = 6144, PC_GDN_G = 6656;
constexpr int PS_LR = 0, PS_MI = 16, PS_MF = 20, PS_GB = 24, PS_GA = 28;
constexpr float RMS_EPS = 1e-6f;
enum { I_X = 0, I_N1G, I_WIN, I_WOUT, I_GLA_W2, I_GLA_B2, I_GLA_NG, I_LRU_CW, I_LRU_CB, I_LRU_WA, I_LRU_BA, I_LRU_WX, I_LRU_BX, I_LRU_LAM, I_ML_IB, I_ML_FB, I_ML_NG,
       I_GDN_CW, I_GDN_ALOG, I_GDN_DTB, I_GDN_NG, I_N2G, I_PWQ, I_PK1, I_PK2, I_PU, I_PV, I_FNG, N_IN };

constexpr size_t MiB = 1u << 20;
constexpr size_t WS_CTL = 0, CTL_ZERO_BYTES = 1 * MiB;
constexpr size_t WS_WIN = 2 * MiB;
constexpr size_t WIN_L = (size_t)NINP * DM * 2;
constexpr size_t WS_WOUT = 60 * MiB;
constexpr size_t WS_WQ = 76 * MiB;
constexpr size_t WSQ_L = (size_t)DM * DM * 2;
constexpr size_t WS_K1 = 92 * MiB, WS_K2 = 92 * MiB + 512 * 1024;
constexpr size_t WS_RSTD1 = 93 * MiB;
constexpr size_t WS_SSP = 94 * MiB;
constexpr size_t WS_XB = 96 * MiB;
constexpr size_t WS_P = 128 * MiB;
constexpr size_t WS_PS = 240 * MiB;
constexpr size_t WS_MIX = 242 * MiB;
constexpr size_t WS_Q = 274 * MiB;
constexpr size_t WS_UB = 306 * MiB;
constexpr size_t WS_VB = 434 * MiB;
constexpr size_t TAB_L = (size_t)NEXP * DM * 2;
constexpr size_t WS_SCR = 562 * MiB;
constexpr size_t WS_END = 900 * MiB;

constexpr int LDS_BYTES = 155648;
constexpr int MISC_OFF = LDS_BYTES - 256;

#define GAS __attribute__((address_space(1)))
#define LAS __attribute__((address_space(3)))
typedef unsigned short bf16;
typedef unsigned v4u __attribute__((ext_vector_type(4)));
typedef unsigned v2u __attribute__((ext_vector_type(2)));
typedef float f32x4 __attribute__((ext_vector_type(4)));
typedef float f32x2 __attribute__((ext_vector_type(2)));
typedef short bf16x8 __attribute__((ext_vector_type(8)));
typedef short bf16x4 __attribute__((ext_vector_type(4)));
typedef __bf16 bf2_t __attribute__((ext_vector_type(2)));
typedef GAS unsigned gu32;
#define RLX_AGENT __ATOMIC_RELAXED, __HIP_MEMORY_SCOPE_AGENT
__device__ __forceinline__ unsigned f2bf(float f) { unsigned u = __builtin_bit_cast(unsigned, f); return (u + 0x7fffu + ((u >> 16) & 1u)) >> 16; }
__device__ __forceinline__ unsigned pk2(float lo, float hi) { return f2bf(lo) | (f2bf(hi) << 16); }
__device__ __forceinline__ float bf2f(unsigned b) { return __builtin_bit_cast(float, b << 16); }
__device__ __forceinline__ float bflo(unsigned w) { return __builtin_bit_cast(float, w << 16); }
__device__ __forceinline__ float bfhi(unsigned w) { return __builtin_bit_cast(float, w & 0xffff0000u); }
template <int CTRL> __device__ __forceinline__ unsigned dpp_rot_u(unsigned v) { return (unsigned)__builtin_amdgcn_update_dpp(0, (int)v, CTRL, 0xf, 0xf, false); }
__device__ __forceinline__ unsigned row_max_u(unsigned v) { v = max(v, dpp_rot_u<0x121>(v)); v = max(v, dpp_rot_u<0x122>(v)); v = max(v, dpp_rot_u<0x124>(v)); v = max(v, dpp_rot_u<0x128>(v)); return v; }
template <int CTRL> __device__ __forceinline__ float dpp_rotf(float v) { const unsigned u = __builtin_bit_cast(unsigned, v); return __builtin_bit_cast(float, dpp_rot_u<CTRL>(u)); }
__device__ __forceinline__ float row_max_f(float v) { v = fmaxf(v, dpp_rotf<0x121>(v)); v = fmaxf(v, dpp_rotf<0x122>(v)); v = fmaxf(v, dpp_rotf<0x124>(v)); v = fmaxf(v, dpp_rotf<0x128>(v)); return v; }
__device__ __forceinline__ float row_sum_f(float v) { v += dpp_rotf<0x121>(v); v += dpp_rotf<0x122>(v); v += dpp_rotf<0x124>(v); v += dpp_rotf<0x128>(v); return v; }

__device__ __forceinline__ float oct_sum_f(float v) { v += dpp_rotf<0xB1>(v); v += dpp_rotf<0x4E>(v); v += dpp_rotf<0x141>(v); return v; }
__device__ __forceinline__ float lane_bcast(float v, int l) { return __builtin_bit_cast(float, __builtin_amdgcn_readlane(__builtin_bit_cast(int, v), l)); }
__device__ __forceinline__ float wave_sum(float v) { const float r = row_sum_f(v); return (lane_bcast(r, 0) + lane_bcast(r, 16)) + (lane_bcast(r, 32) + lane_bcast(r, 48)); }
__device__ __forceinline__ float wave_max(float v) { const float r = row_max_f(v); return fmaxf(fmaxf(lane_bcast(r, 0), lane_bcast(r, 16)), fmaxf(lane_bcast(r, 32), lane_bcast(r, 48))); }
__device__ __forceinline__ float rcpf_(float x) { return __builtin_amdgcn_rcpf(x); }
__device__ __forceinline__ float sigmoidf_(float x) { return rcpf_(1.0f + __expf(-x)); }
__device__ __forceinline__ float siluf_(float x) { return x * rcpf_(1.0f + __expf(-x)); }
__device__ __forceinline__ float softplusf_(float x) { return fmaxf(x, 0.f) + __logf(1.0f + __expf(-fabsf(x))); }
__device__ __forceinline__ float logsigmoidf_(float x) { return fminf(x, 0.f) - __logf(1.0f + __expf(-fabsf(x))); }
__device__ __forceinline__ float gelu_tanh(float x) { const float u = 1.5957691216057308f * (x + 0.044715f * x * x * x); return x * rcpf_(1.0f + __expf(-u)); }

#define XB_TMO      128
#define XB_XCNT(j)  (256  + 64 * (j))
#define XB_XSUB(j)  (1280 + 64 * (j))
#define XB_XGEN(j)  (2304 + 64 * (j))
#define XB_TOP      3328
#define XB_TOPGEN   3392
#define XCD_BAR_WORDS 3456
#define XB_SPIN_CAP (1u << 18)

__device__ __forceinline__ unsigned xb_ld(unsigned* p)              { return __hip_atomic_load(p, __ATOMIC_RELAXED, __HIP_MEMORY_SCOPE_AGENT); }
__device__ __forceinline__ unsigned xb_add(unsigned* p, unsigned v) { return __hip_atomic_fetch_add(p, v, __ATOMIC_RELAXED, __HIP_MEMORY_SCOPE_AGENT); }
__device__ __forceinline__ unsigned xb_xcc_id() { return (unsigned)__builtin_amdgcn_s_getreg((3 << 11) | 20) & 0xFu; }
#define XB_SPIN(cond, bar) do { unsigned _sp = 0; while (cond) { __builtin_amdgcn_s_sleep(1); \
    if ((++_sp & 255u) == 0u) { if (xb_ld(&(bar)[XB_TMO])) break; if (_sp > XB_SPIN_CAP) { atomicAdd(&(bar)[XB_TMO], 1u); break; } } } } while (0)

struct XcdBarrier {
    unsigned* bar; unsigned x;
    volatile LAS unsigned* st;
};

__device__ __forceinline__ XcdBarrier xcd_barrier_post(unsigned* bar, volatile LAS unsigned* st) {
    XcdBarrier b; b.bar = bar; b.x = xb_xcc_id(); b.st = st;
    if (threadIdx.x == 0) (void)xb_add(&bar[XB_XCNT(b.x)], 1u);
    return b;
}
__device__ __forceinline__ void xcd_barrier_complete(unsigned* bar, unsigned x, unsigned& nloc, unsigned& nx) {
    const unsigned G = gridDim.x * gridDim.y * gridDim.z;
    unsigned sum, cnt, mine, sp = 0u;
    for (;;) {
        sum = 0u; cnt = 0u; mine = 0u;
#pragma unroll
        for (unsigned j = 0; j < 16; ++j) { const unsigned c = xb_ld(&bar[XB_XCNT(j)]); sum += c; cnt += (c > 0u) ? 1u : 0u; mine = (j == x) ? c : mine; }
        if (sum == G) break;
        __builtin_amdgcn_s_sleep(1);
        if ((++sp & 255u) == 0u) { if (xb_ld(&bar[XB_TMO])) break; if (sp > XB_SPIN_CAP) { atomicAdd(&bar[XB_TMO], 1u); break; } }
    }
    nloc = mine > 0u ? mine : 1u; nx = cnt > 0u ? cnt : 1u;
}

__device__ __forceinline__ void xcd_barrier(const XcdBarrier& b) {
    asm volatile("s_waitcnt vmcnt(0)" ::: "memory");
    __syncthreads();
    if (threadIdx.x == 0) {
        unsigned* bar = b.bar; asm volatile("" : "+s"(bar));
        __builtin_amdgcn_s_waitcnt(0);
        unsigned nloc = b.st[0], nx = b.st[1];
        if (nloc == 0u) { xcd_barrier_complete(bar, b.x, nloc, nx); b.st[0] = nloc; b.st[1] = nx; }
        const unsigned old = xb_add(&bar[XB_XSUB(b.x)], 1u);
        const unsigned gen = old / nloc;
        if (old + 1u == (gen + 1u) * nloc) {
            __builtin_amdgcn_fence(__ATOMIC_RELEASE, "agent");
            asm volatile("s_waitcnt vmcnt(0)" ::: "memory");
            const unsigned og = xb_add(&bar[XB_TOP], 1u);
            const unsigned tg = og / nx;
            if (og + 1u == (tg + 1u) * nx) xb_add(&bar[XB_TOPGEN], 1u);
            else XB_SPIN(xb_ld(&bar[XB_TOPGEN]) == tg, bar);
            __builtin_amdgcn_fence(__ATOMIC_ACQUIRE, "agent");
            xb_add(&bar[XB_XGEN(b.x)], 1u);
            asm volatile("s_waitcnt vmcnt(0)" ::: "memory");
        } else {
            XB_SPIN(xb_ld(&bar[XB_XGEN(b.x)]) == gen, bar);
            __builtin_amdgcn_fence(__ATOMIC_ACQUIRE, "agent");
            asm volatile("s_waitcnt vmcnt(0)" ::: "memory");
        }
    }
    __syncthreads();
}


struct Args { const float* in[N_IN]; float* out; unsigned char* ws; int ph_lo, ph_hi, li, pad; };
typedef const __attribute__((address_space(4))) Args& ArgsR;
__device__ __forceinline__ const __attribute__((address_space(4))) Args* kargs() { unsigned long long p = (unsigned long long)__builtin_amdgcn_kernarg_segment_ptr(); asm volatile("" : "+s"(p)); return (const __attribute__((address_space(4))) Args*)p; }

__device__ __forceinline__ int win_src_col(int n) {
    if (n < 2048) return n;
    if (n < 3072) return 2064 + (n - 2048);
    if (n < 5120) return 3088 + (n - 3072);
    if (n < 7168) return 5144 + (n - 5120);
    if (n < 7184) return 2048 + (n - 7168);
    if (n < 7192) return 5136 + (n - 7184);
    if (n < 7200) return n;
    return -1;
}
template <bool MAP>
__device__ __forceinline__ void p0_transpose_item(const float* W, int K, int Nsrc, int Ndst, const float* gain, bf16* WT, LAS float* scr, int item, int lane) {
    const int nblk = Ndst / 32, kb = item / nblk, nb = item % nblk, k0 = 64 * kb, n0 = 32 * nb;
    const int nn = n0 + (lane & 31); const int src = MAP ? win_src_col(nn) : nn;
    float tv[32];
#pragma unroll
    for (int i = 0; i < 32; ++i) { const int kk = 2 * i + (lane >> 5); tv[i] = (src >= 0) ? W[(size_t)(k0 + kk) * Nsrc + src] : 0.f; }
#pragma unroll
    for (int i = 0; i < 32; ++i) { const int kk = 2 * i + (lane >> 5); float v = tv[i]; if (gain) v *= gain[k0 + kk]; scr[kk * 33 + (lane & 31)] = v; }
    asm volatile("s_waitcnt lgkmcnt(0)" ::: "memory");
    const int c = lane & 7;
#pragma unroll
    for (int j = 0; j < 4; ++j) { const int n = (lane >> 3) + 8 * j; const LAS float* s = scr + (8 * c) * 33 + n;
        v4u o; o.x = pk2(s[0 * 33], s[1 * 33]); o.y = pk2(s[2 * 33], s[3 * 33]); o.z = pk2(s[4 * 33], s[5 * 33]); o.w = pk2(s[6 * 33], s[7 * 33]);
        *(GAS v4u*)(WT + (size_t)(n0 + n) * K + k0 + 8 * c) = o; }
    asm volatile("s_waitcnt lgkmcnt(0)" ::: "memory");
}
__device__ __forceinline__ void p0_convert(const float* src, bf16* dst, size_t n, size_t gtid, size_t gthreads) {
    for (size_t i = gtid * 8; i < n; i += gthreads * 8) {
        const f32x4 a = *(const GAS f32x4*)(src + i), b = *(const GAS f32x4*)(src + i + 4);
        v4u o; o.x = pk2(a[0], a[1]); o.y = pk2(a[2], a[3]); o.z = pk2(b[0], b[1]); o.w = pk2(b[2], b[3]);
        *(GAS v4u*)(dst + i) = o; }
}
__device__ __forceinline__ void p0_prologue(ArgsR A, LAS unsigned char* lds, int vcu, int G, int wave, int lane) {
    unsigned char* ws = A.ws;
    LAS float* scr = (LAS float*)(lds + wave * 16384);
    const int gw = vcu * NWAVES + wave, NGW = G * NWAVES;
    constexpr int I_IN = (DM / 64) * (NINP / 32), I_SQ = (DM / 64) * (DM / 32), I_LAYER = I_IN + 2 * I_SQ, NITEMS = DEPTH * I_LAYER;
    for (int it = gw; it < NITEMS; it += NGW) {
        const int l = it / I_LAYER; int r = it % I_LAYER;
        if (r < I_IN) { p0_transpose_item<true>(A.in[I_WIN] + (size_t)l * DM * DIN, DM, DIN, NINP, A.in[I_N1G] + l * DM, (bf16*)(ws + WS_WIN + l * WIN_L), scr, r, lane); continue; } r -= I_IN;
        if (r < I_SQ) { p0_transpose_item<false>(A.in[I_WOUT] + (size_t)l * DM * DM, DM, DM, DM, nullptr, (bf16*)(ws + WS_WOUT + l * WSQ_L), scr, r, lane); continue; } r -= I_SQ;
        p0_transpose_item<false>(A.in[I_PWQ] + (size_t)l * DM * DM, DM, DM, DM, A.in[I_N2G] + l * DM, (bf16*)(ws + WS_WQ + l * WSQ_L), scr, r, lane);
    }
    const size_t gtid = (size_t)gw * 64 + lane, gthreads = (size_t)NGW * 64;
    p0_convert(A.in[I_PK1], (bf16*)(ws + WS_K1), (size_t)DEPTH * 8 * 128 * 128, gtid, gthreads);
    p0_convert(A.in[I_PK2], (bf16*)(ws + WS_K2), (size_t)DEPTH * 8 * 128 * 128, gtid, gthreads);
    const float* x = A.in[I_X]; bf16* xb = (bf16*)(ws + WS_XB); float* rstd1 = (float*)(ws + WS_RSTD1);
    for (int m = gw; m < NT; m += NGW) {
        const GAS f32x4* xr = (const GAS f32x4*)(x + (size_t)m * DM) + lane;
        f32x4 v[8]; float s = 0.f;
#pragma unroll
        for (int j = 0; j < 8; ++j) { v[j] = xr[64 * j]; s += (v[j][0] * v[j][0] + v[j][1] * v[j][1]) + (v[j][2] * v[j][2] + v[j][3] * v[j][3]); }
        s = wave_sum(s);
        GAS v2u* o = (GAS v2u*)(xb + (size_t)m * DM) + lane;
#pragma unroll
        for (int j = 0; j < 8; ++j) { v2u w; w.x = pk2(v[j][0], v[j][1]); w.y = pk2(v[j][2], v[j][3]); o[64 * j] = w; }
        if (lane == 0) rstd1[m] = rsqrtf(s * (1.0f / DM) + RMS_EPS);
    }
}

constexpr int NM_Q = 0, NM_K = 32768, NM_A = 65536, NM_V = 98304, NM_PARTS = 131072  , NM_SC = 135168  ;

__device__ __forceinline__ void nm_load_tile(const bf16* g, size_t ld, LAS float* dst, int tid) {
#pragma unroll
    for (int i = 0; i < 2; ++i) { const int idx = tid + i * NTHREADS, r = idx >> 4, c8 = (idx & 15) * 8;
        const v4u w = *(const GAS v4u*)(g + (size_t)r * ld + c8);
        f32x4 a = {bflo(w.x), bfhi(w.x), bflo(w.y), bfhi(w.y)}, b = {bflo(w.z), bfhi(w.z), bflo(w.w), bfhi(w.w)};
        *(LAS f32x4*)(dst + r * 128 + c8) = a; *(LAS f32x4*)(dst + r * 128 + c8 + 4) = b; }
}
template <int GATE>
__device__ __forceinline__ void nm_finalize(const LAS float* vs, const float* ng, const bf16* gate, size_t gld, bf16* mixp, int wave, int lane) {
#pragma unroll 1
    for (int rr = 0; rr < 8; ++rr) { const int c = wave * 8 + rr;
        const float o1 = vs[c * 128 + lane], o2 = vs[c * 128 + 64 + lane];
        const float ss = wave_sum(o1 * o1 + o2 * o2), rs = rsqrtf(ss * (1.0f / 128.0f) + RMS_EPS);
        float r1 = o1 * rs * ng[lane], r2 = o2 * rs * ng[64 + lane];
        if (GATE == 1) { r1 *= siluf_(bf2f(gate[(size_t)c * gld + lane])); r2 *= siluf_(bf2f(gate[(size_t)c * gld + 64 + lane])); }
        mixp[(size_t)c * DM + lane] = (bf16)f2bf(r1); mixp[(size_t)c * DM + 64 + lane] = (bf16)f2bf(r2); }
}

__device__ __forceinline__ void nm_gla(ArgsR A, int l, int b, int h, LAS unsigned char* lds, int tid) {
    const bf16* P = (const bf16*)(A.ws + WS_P); const float* Ps = (const float*)(A.ws + WS_PS); bf16* mix = (bf16*)(A.ws + WS_MIX);
    LAS float* qs = (LAS float*)(lds + NM_Q); LAS float* ks = (LAS float*)(lds + NM_K); LAS float* as = (LAS float*)(lds + NM_A); LAS float* vs = (LAS float*)(lds + NM_V);
    LAS float* parts = (LAS float*)(lds + NM_PARTS); LAS float* lrs = (LAS float*)(lds + NM_SC);
    const int v = tid & 127, dq = tid >> 7, wave = tid >> 6, lane = tid & 63;
    const float* w2 = A.in[I_GLA_W2] + (size_t)l * 16 * GW + h * HD + v;
    float w2c[16];
#pragma unroll
    for (int r = 0; r < 16; ++r) w2c[r] = w2[r * GW];
    const float b2 = A.in[I_GLA_B2][l * GW + h * HD + v];
    const float* ng = A.in[I_GLA_NG] + l * GW + h * HD;
    float S[32];
#pragma unroll
    for (int i = 0; i < 32; ++i) S[i] = 0.f;
#pragma unroll 1
    for (int n = 0; n < NCHK; ++n) {
        const size_t r0 = (size_t)b * SEQ + n * CHK;
        nm_load_tile(P + r0 * PBW + PC_GLA_Q + h * HD, PBW, qs, tid);
        nm_load_tile(P + r0 * PBW + PC_GLA_K + h * HD, PBW, ks, tid);
        nm_load_tile(P + r0 * PBW + PC_GLA_V + h * HD, PBW, vs, tid);
        for (int i = tid; i < 64 * 16; i += NTHREADS) lrs[i] = Ps[(r0 + (i >> 4)) * 32 + PS_LR + (i & 15)];
        __syncthreads();
#pragma unroll 1
        for (int i = 0; i < 16; ++i) { const int c = dq * 16 + i; float z = b2;
#pragma unroll
            for (int r = 0; r < 16; ++r) z += lrs[c * 16 + r] * w2c[r];
            as[c * 128 + v] = __expf(logsigmoidf_(z) * (1.0f / 16.0f)); }
        __syncthreads();
#pragma unroll 1
        for (int c = 0; c < CHK; ++c) {
            const float vt = vs[c * 128 + v]; float part = 0.f;
            const LAS f32x4* q4 = (const LAS f32x4*)(qs + c * 128 + dq * 32); const LAS f32x4* k4 = (const LAS f32x4*)(ks + c * 128 + dq * 32); const LAS f32x4* a4 = (const LAS f32x4*)(as + c * 128 + dq * 32);
#pragma unroll
            for (int i4 = 0; i4 < 8; ++i4) { const f32x4 qv = q4[i4], kv = k4[i4], av = a4[i4];
#pragma unroll
                for (int j = 0; j < 4; ++j) { S[i4 * 4 + j] = av[j] * S[i4 * 4 + j] + kv[j] * vt; part += qv[j] * S[i4 * 4 + j]; } }
            parts[((c & 1) * 4 + dq) * 128 + v] = part;
            __syncthreads();
            if (dq == 0) { const LAS float* pp = parts + (c & 1) * 512 + v; vs[c * 128 + v] = ((pp[0] + pp[128]) + (pp[256] + pp[384])) * 0.08838834764831845f; }
        }
        __syncthreads();
        nm_finalize<1>(vs, ng, P + r0 * PBW + PC_GLA_G + h * HD, PBW, mix + r0 * DM + 0 + h * HD, wave, lane);
        __syncthreads();
    }
}

__device__ __forceinline__ void nm_mlstm(ArgsR A, int l, int b, int h, LAS unsigned char* lds, int tid) {
    const bf16* P = (const bf16*)(A.ws + WS_P); const float* Ps = (const float*)(A.ws + WS_PS); bf16* mix = (bf16*)(A.ws + WS_MIX);
    LAS float* qs = (LAS float*)(lds + NM_Q); LAS float* ks = (LAS float*)(lds + NM_K); LAS float* vs = (LAS float*)(lds + NM_V);
    LAS float* parts = (LAS float*)(lds + NM_PARTS); LAS float* dparts = (LAS float*)(lds + NM_A);
    LAS float* fs = (LAS float*)(lds + NM_SC); LAS float* es = fs + 64;
    const int v = tid & 127, dq = tid >> 7, wave = tid >> 6, lane = tid & 63;
    const float ib = A.in[I_ML_IB][l * NH + h], fb = A.in[I_ML_FB][l * NH + h];
    const float* ng = A.in[I_ML_NG] + l * GW + h * HD;
    float C[32], nn[32];
#pragma unroll
    for (int i = 0; i < 32; ++i) { C[i] = 0.f; nn[i] = 0.f; }
#pragma unroll 1
    for (int n = 0; n < NCHK; ++n) {
        const size_t r0 = (size_t)b * SEQ + n * CHK;
        nm_load_tile(P + r0 * PBW + PC_ML_Q + h * HD, PBW, qs, tid);
        nm_load_tile(P + r0 * PBW + PC_ML_K + h * HD, PBW, ks, tid);
        nm_load_tile(P + r0 * PBW + PC_ML_V + h * HD, PBW, vs, tid);
        if (tid < 64) { fs[tid] = sigmoidf_(Ps[(r0 + tid) * 32 + PS_MF + h] + fb); es[tid] = __expf(Ps[(r0 + tid) * 32 + PS_MI + h] + ib) * 0.08838834764831845f; }
        __syncthreads();
#pragma unroll 1
        for (int c = 0; c < CHK; ++c) {
            const float vt = vs[c * 128 + v], f = fs[c], ei = es[c]; float part = 0.f, dpart = 0.f;
            const LAS f32x4* q4 = (const LAS f32x4*)(qs + c * 128 + dq * 32); const LAS f32x4* k4 = (const LAS f32x4*)(ks + c * 128 + dq * 32);
#pragma unroll
            for (int i4 = 0; i4 < 8; ++i4) { const f32x4 qv = q4[i4], kv = k4[i4];
#pragma unroll
                for (int j = 0; j < 4; ++j) { const float kd = kv[j] * ei; C[i4 * 4 + j] = f * C[i4 * 4 + j] + kd * vt; nn[i4 * 4 + j] = f * nn[i4 * 4 + j] + kd;
                    part += qv[j] * C[i4 * 4 + j]; dpart += qv[j] * nn[i4 * 4 + j]; } }
            parts[((c & 1) * 4 + dq) * 128 + v] = part; if (v == 0) dparts[(c & 1) * 4 + dq] = dpart;
            __syncthreads();
            if (dq == 0) { const LAS float* pp = parts + (c & 1) * 512 + v; const LAS float* dp = dparts + (c & 1) * 4;
                const float num = (pp[0] + pp[128]) + (pp[256] + pp[384]), dot = (dp[0] + dp[1]) + (dp[2] + dp[3]);
                const float og = bf2f(P[(r0 + c) * PBW + PC_ML_O + h * HD + v]);
                vs[c * 128 + v] = num / fmaxf(fabsf(dot), 1.0f) * sigmoidf_(og); }
        }
        __syncthreads();
        nm_finalize<0>(vs, ng, nullptr, 0, mix + r0 * DM + 1024 + h * HD, wave, lane);
        __syncthreads();
    }
}

__device__ __forceinline__ void nm_gdn(ArgsR A, int l, int b, int h, LAS unsigned char* lds, int tid) {
    const bf16* P = (const bf16*)(A.ws + WS_P); const float* Ps = (const float*)(A.ws + WS_PS); bf16* mix = (bf16*)(A.ws + WS_MIX);
    LAS float* qs = (LAS float*)(lds + NM_Q); LAS float* ks = (LAS float*)(lds + NM_K); LAS float* vs = (LAS float*)(lds + NM_V);
    LAS float* parts = (LAS float*)(lds + NM_PARTS);
    LAS float* egs = (LAS float*)(lds + NM_SC); LAS float* bts = egs + 64; LAS float* rq = egs + 128; LAS float* rk = egs + 192;
    const int v = tid & 127, dq = tid >> 7, wave = tid >> 6, lane = tid & 63;
    const float* cw = A.in[I_GDN_CW] + (size_t)l * 4 * 1536;
    const float nalog = -__expf(A.in[I_GDN_ALOG][l * NH + h]), dtb = A.in[I_GDN_DTB][l * NH + h];
    const float* ng = A.in[I_GDN_NG] + l * GW + h * HD;
    float S[32];
#pragma unroll
    for (int i = 0; i < 32; ++i) S[i] = 0.f;
#pragma unroll 1
    for (int n = 0; n < NCHK; ++n) {
        const size_t r0 = (size_t)b * SEQ + n * CHK;
#pragma unroll 1
        for (int part = 0; part < 3; ++part) {
            const int pc = (part == 0 ? PC_GDN_Q : part == 1 ? PC_GDN_K : PC_GDN_V) + h * HD + v, wc = part * 512 + h * HD + v;
            const float w0 = cw[wc], w1 = cw[1536 + wc], w2 = cw[2 * 1536 + wc], w3 = cw[3 * 1536 + wc];
            LAS float* dst = part == 0 ? qs : part == 1 ? ks : vs;
            const int c0 = dq * 16; const long t0 = (long)n * CHK + c0;
            float xm3 = (t0 - 3 >= 0) ? bf2f(P[(r0 + c0 - 3) * PBW + pc]) : 0.f, xm2 = (t0 - 2 >= 0) ? bf2f(P[(r0 + c0 - 2) * PBW + pc]) : 0.f, xm1 = (t0 - 1 >= 0) ? bf2f(P[(r0 + c0 - 1) * PBW + pc]) : 0.f;
#pragma unroll 4
            for (int i = 0; i < 16; ++i) { const float x0 = bf2f(P[(r0 + c0 + i) * PBW + pc]); const float y = w0 * xm3 + w1 * xm2 + w2 * xm1 + w3 * x0;
                dst[(c0 + i) * 128 + v] = siluf_(y); xm3 = xm2; xm2 = xm1; xm1 = x0; }
        }
        if (tid < 64) { bts[tid] = sigmoidf_(Ps[(r0 + tid) * 32 + PS_GB + h]); egs[tid] = __expf(nalog * softplusf_(Ps[(r0 + tid) * 32 + PS_GA + h] + dtb)); }
        __syncthreads();
#pragma unroll 1
        for (int rr = 0; rr < 8; ++rr) { const int c = wave * 8 + rr;
            const float q1 = qs[c * 128 + lane], q2 = qs[c * 128 + 64 + lane], k1 = ks[c * 128 + lane], k2 = ks[c * 128 + 64 + lane];
            const float sq = wave_sum(q1 * q1 + q2 * q2), sk = wave_sum(k1 * k1 + k2 * k2);
            if (lane == 0) { rq[c] = rsqrtf(sq + 1e-6f) * 0.08838834764831845f; rk[c] = rsqrtf(sk + 1e-6f); } }
        __syncthreads();
#pragma unroll 1
        for (int c = 0; c < CHK; ++c) {
            const float vt = vs[c * 128 + v], e = egs[c], bt = bts[c], sq = rq[c], sk = rk[c]; float part = 0.f;
            const LAS f32x4* q4 = (const LAS f32x4*)(qs + c * 128 + dq * 32); const LAS f32x4* k4 = (const LAS f32x4*)(ks + c * 128 + dq * 32);
            f32x4 kv[8];
#pragma unroll
            for (int i4 = 0; i4 < 8; ++i4) { kv[i4] = k4[i4] * sk;
#pragma unroll
                for (int j = 0; j < 4; ++j) { S[i4 * 4 + j] *= e; part += kv[i4][j] * S[i4 * 4 + j]; } }
            parts[dq * 128 + v] = part;
            __syncthreads();
            const float kS = (parts[v] + parts[128 + v]) + (parts[256 + v] + parts[384 + v]);
            const float u = bt * (vt - kS); float part2 = 0.f;
#pragma unroll
            for (int i4 = 0; i4 < 8; ++i4) { const f32x4 qv = q4[i4] * sq;
#pragma unroll
                for (int j = 0; j < 4; ++j) { S[i4 * 4 + j] += kv[i4][j] * u; part2 += qv[j] * S[i4 * 4 + j]; } }
            parts[512 + dq * 128 + v] = part2;
            __syncthreads();
            if (dq == 0) vs[c * 128 + v] = (parts[512 + v] + parts[640 + v]) + (parts[768 + v] + parts[896 + v]);
        }
        __syncthreads();
        nm_finalize<1>(vs, ng, P + r0 * PBW + PC_GDN_G + h * HD, PBW, mix + r0 * DM + 1536 + h * HD, wave, lane);
        __syncthreads();
    }
}

__device__ __forceinline__ void nm_lru(ArgsR A, int l, int b, int j, LAS unsigned char* lds, int tid) {
    const bf16* P = (const bf16*)(A.ws + WS_P); bf16* mix = (bf16*)(A.ws + WS_MIX);
    LAS float* xc = (LAS float*)(lds);
    LAS float* was = (LAS float*)(lds + 20480);
    LAS float* wxs = (LAS float*)(lds + 36864);
    LAS float* aa = (LAS float*)(lds + 53248);
    LAS float* uu = (LAS float*)(lds + 69632);
    const float* wa = A.in[I_LRU_WA] + ((size_t)l * 8 + j) * 4096; const float* wx = A.in[I_LRU_WX] + ((size_t)l * 8 + j) * 4096;
    for (int i = tid; i < 4096; i += NTHREADS) { was[i] = wa[i]; wxs[i] = wx[i]; }
    const float* cw = A.in[I_LRU_CW] + (size_t)l * 4 * GW; const float* cb = A.in[I_LRU_CB] + l * GW;
    const float* ba = A.in[I_LRU_BA] + l * GW + j * 64; const float* bx = A.in[I_LRU_BX] + l * GW + j * 64; const float* lam = A.in[I_LRU_LAM] + l * GW + j * 64;
    float hstate = 0.f;
#pragma unroll 1
    for (int n = 0; n < NCHK; ++n) {
        const size_t r0 = (size_t)b * SEQ + n * CHK;
        { const int cc = tid & 63, c0 = (tid >> 6) * 8, ch = j * 64 + cc, pc = PC_LRU_X + ch; const long t0 = (long)n * CHK + c0;
            const float w0 = cw[ch], w1 = cw[GW + ch], w2 = cw[2 * GW + ch], w3 = cw[3 * GW + ch], bias = cb[ch];
            float xm3 = (t0 - 3 >= 0) ? bf2f(P[(r0 + c0 - 3) * PBW + pc]) : 0.f, xm2 = (t0 - 2 >= 0) ? bf2f(P[(r0 + c0 - 2) * PBW + pc]) : 0.f, xm1 = (t0 - 1 >= 0) ? bf2f(P[(r0 + c0 - 1) * PBW + pc]) : 0.f;
#pragma unroll
            for (int i = 0; i < 8; ++i) { const float x0 = bf2f(P[(r0 + c0 + i) * PBW + pc]); xc[(c0 + i) * 65 + cc] = w0 * xm3 + w1 * xm2 + w2 * xm1 + w3 * x0 + bias; xm3 = xm2; xm2 = xm1; xm1 = x0; } }
        __syncthreads();
        { const int tok = tid >> 3, cg = tid & 7; float ra[8], ri[8];
#pragma unroll
            for (int q = 0; q < 8; ++q) { ra[q] = ba[cg * 8 + q]; ri[q] = bx[cg * 8 + q]; }
#pragma unroll 4
            for (int i = 0; i < 64; ++i) { const float xv = xc[tok * 65 + i];
                const f32x4 a0 = *(const LAS f32x4*)(was + i * 64 + cg * 8), a1 = *(const LAS f32x4*)(was + i * 64 + cg * 8 + 4);
                const f32x4 x0 = *(const LAS f32x4*)(wxs + i * 64 + cg * 8), x1 = *(const LAS f32x4*)(wxs + i * 64 + cg * 8 + 4);
#pragma unroll
                for (int q = 0; q < 4; ++q) { ra[q] += xv * a0[q]; ra[4 + q] += xv * a1[q]; ri[q] += xv * x0[q]; ri[4 + q] += xv * x1[q]; } }
#pragma unroll
            for (int q = 0; q < 8; ++q) { const int jj = cg * 8 + q; const float r = sigmoidf_(ra[q]), ig = sigmoidf_(ri[q]);
                const float log_a = -8.0f * r * softplusf_(-lam[jj]); const float a = __expf(log_a), u = sqrtf(-expm1f(2.0f * log_a)) * (ig * xc[tok * 65 + jj]);
                aa[tok * 64 + jj] = a; uu[tok * 64 + jj] = u; } }
        __syncthreads();
        if (tid < 64) { const int ch = j * 64 + tid;
#pragma unroll 4
            for (int c = 0; c < CHK; ++c) { hstate = aa[c * 64 + tid] * hstate + uu[c * 64 + tid];
                const float y = bf2f(P[(r0 + c) * PBW + PC_LRU_Y + ch]); mix[(r0 + c) * DM + 512 + ch] = (bf16)f2bf(gelu_tanh(y) * hstate); } }
        __syncthreads();
    }
}

__device__ __forceinline__ void nm_phase(ArgsR A, int l, LAS unsigned char* lds, int G, int tid) {
    for (int it = blockIdx.x; it < 80; it += G) {
        if (it < 16) nm_gla(A, l, it >> 2, it & 3, lds, tid);
        else if (it < 32) nm_mlstm(A, l, (it - 16) >> 2, (it - 16) & 3, lds, tid);
        else if (it < 48) nm_gdn(A, l, (it - 32) >> 2, (it - 32) & 3, lds, tid);
        else nm_lru(A, l, (it - 48) >> 3, (it - 48) & 7, lds, tid);
        __syncthreads();
    }
}

constexpr size_t WS_GLA_INC = 562 * MiB;
constexpr size_t WS_GLA_DEC = 594 * MiB;
constexpr size_t WS_GLA_ST = 595 * MiB;
constexpr size_t WS_ML_INC = 611 * MiB;
constexpr size_t WS_ML_N = 643 * MiB;
constexpr size_t WS_ML_SC = 643 * MiB + 512 * 1024;
constexpr size_t WS_ML_ST = 644 * MiB;
constexpr size_t WS_ML_NP = 660 * MiB;
constexpr size_t WS_ML_MP = 660 * MiB + 512 * 1024;
constexpr size_t WS_GDN_U0 = 661 * MiB, WS_GDN_W = 669 * MiB, WS_GDN_QD = 677 * MiB, WS_GDN_KE = 685 * MiB;
constexpr size_t WS_GDN_QK = 693 * MiB;
constexpr size_t WS_GDN_DE = 697 * MiB;
constexpr size_t WS_GDN_O = 698 * MiB;
constexpr size_t WS_LRU_HL = 714 * MiB, WS_LRU_AP = 730 * MiB;
constexpr size_t WS_LRU_CARRY = 746 * MiB;
static_assert(WS_LRU_CARRY + 4 * 32 * 512 * 4 <= WS_END, "ws map");

constexpr int CW_PBAR = 2048;
typedef short v4i16_t __attribute__((ext_vector_type(4)));
constexpr int LD128 = 136, LD64 = 72;

__device__ __forceinline__ bf16x8 frag_rd(const LAS bf16* t, int ld, int row0, int k0, int lane) { return *(const LAS bf16x8*)(t + (row0 + (lane & 15)) * ld + k0 + 8 * (lane >> 4)); }
__device__ __forceinline__ bf16x8 frag_rd_perm(const LAS bf16* t, int ld, int row0, int k0, int lane) {
    const LAS bf16* p = t + (row0 + (lane & 15)) * ld + k0 + 4 * (lane >> 4);
    const bf16x4 a = *(const LAS bf16x4*)p, b = *(const LAS bf16x4*)(p + 16);
    return (bf16x8){a[0], a[1], a[2], a[3], b[0], b[1], b[2], b[3]};
}
__device__ __forceinline__ bf16x8 frag_tr(const LAS bf16* t, int ld, int k0, int n0, int lane) {
    const int i = lane & 15, g = lane >> 4; const LAS bf16* p = t + (k0 + 8 * g + (i >> 2)) * ld + n0 + 4 * (i & 3);
    const v4i16_t a = __builtin_amdgcn_ds_read_tr16_b64_v4i16((LAS v4i16_t*)p), b = __builtin_amdgcn_ds_read_tr16_b64_v4i16((LAS v4i16_t*)(p + 4 * ld));
    return (bf16x8){a[0], a[1], a[2], a[3], b[0], b[1], b[2], b[3]};
}
__device__ __forceinline__ bf16x8 frag_tr_perm(const LAS bf16* t, int ld, int k0, int n0, int lane) {
    const int i = lane & 15, g = lane >> 4; const LAS bf16* p = t + (k0 + 4 * g + (i >> 2)) * ld + n0 + 4 * (i & 3);
    const v4i16_t a = __builtin_amdgcn_ds_read_tr16_b64_v4i16((LAS v4i16_t*)p), b = __builtin_amdgcn_ds_read_tr16_b64_v4i16((LAS v4i16_t*)(p + 16 * ld));
    return (bf16x8){a[0], a[1], a[2], a[3], b[0], b[1], b[2], b[3]};
}
__device__ __forceinline__ bf16x8 pack_acc(const f32x4& lo, const f32x4& hi) {
    v4u w; w.x = pg8::cvt_pk_bf16(lo[0], lo[1]); w.y = pg8::cvt_pk_bf16(lo[2], lo[3]); w.z = pg8::cvt_pk_bf16(hi[0], hi[1]); w.w = pg8::cvt_pk_bf16(hi[2], hi[3]);
    return __builtin_bit_cast(bf16x8, w);
}
#define MFMA16(a, b, c) __builtin_amdgcn_mfma_f32_16x16x32_bf16((a), (b), (c), 0, 0, 0)

template <int ROWS>
__device__ __forceinline__ void tile_g2l_128(const bf16* g, size_t gld, LAS bf16* t, int tid) {
#pragma unroll
    for (int i = 0; i < ROWS * 16 / NTHREADS; ++i) { const int idx = tid + i * NTHREADS, r = idx >> 4, c8 = (idx & 15) * 8;
        *(LAS v4u*)(t + r * LD128 + c8) = *(const GAS v4u*)(g + (size_t)r * gld + c8); }
}
template <int CTRL> __device__ __forceinline__ float dpp_shr_f(float v, float ident) { return __builtin_bit_cast(float, __builtin_amdgcn_update_dpp(__builtin_bit_cast(int, ident), __builtin_bit_cast(int, v), CTRL, 0xf, 0xf, false)); }
__device__ __forceinline__ float wave_scan_add(float v, int lane) {
    v += dpp_shr_f<0x111>(v, 0.f); v += dpp_shr_f<0x112>(v, 0.f); v += dpp_shr_f<0x114>(v, 0.f); v += dpp_shr_f<0x118>(v, 0.f);
    const float t0 = lane_bcast(v, 15), t1 = lane_bcast(v, 31), t2 = lane_bcast(v, 47); const int row = lane >> 4;
    return v + (row == 0 ? 0.f : row == 1 ? t0 : row == 2 ? t0 + t1 : (t0 + t1) + t2);
}
__device__ __forceinline__ float wave_scan_max(float v, int lane) {
    const float ninf = -__builtin_inff();
    v = fmaxf(v, dpp_shr_f<0x111>(v, ninf)); v = fmaxf(v, dpp_shr_f<0x112>(v, ninf)); v = fmaxf(v, dpp_shr_f<0x114>(v, ninf)); v = fmaxf(v, dpp_shr_f<0x118>(v, ninf));
    const float t0 = lane_bcast(v, 15), t1 = lane_bcast(v, 31), t2 = lane_bcast(v, 47); const int row = lane >> 4;
    return fmaxf(v, row == 0 ? ninf : row == 1 ? t0 : row == 2 ? fmaxf(t0, t1) : fmaxf(fmaxf(t0, t1), t2));
}

__device__ __forceinline__ void f_lru_p2(ArgsR A, int l, int item, LAS unsigned char* lds, int tid) {
    const int j = item & 7, n = (item >> 3) & 31, b = item >> 8;
    const bf16* P = (const bf16*)(A.ws + WS_P); float* HLg = (float*)(A.ws + WS_LRU_HL); float* APg = (float*)(A.ws + WS_LRU_AP);
    LAS float* xc = (LAS float*)(lds); LAS float* was = (LAS float*)(lds + 20480); LAS float* wxs = (LAS float*)(lds + 36864);
    LAS float* aa = (LAS float*)(lds + 53248); LAS float* uu = (LAS float*)(lds + 69632); LAS float* segA = (LAS float*)(lds + 86016); LAS float* segH = (LAS float*)(lds + 88064);
    const float* wa = A.in[I_LRU_WA] + ((size_t)l * 8 + j) * 4096; const float* wx = A.in[I_LRU_WX] + ((size_t)l * 8 + j) * 4096;
    for (int i = tid; i < 4096; i += NTHREADS) { was[i] = wa[i]; wxs[i] = wx[i]; }
    const float* cw = A.in[I_LRU_CW] + (size_t)l * 4 * GW; const float* cb = A.in[I_LRU_CB] + l * GW;
    const float* ba = A.in[I_LRU_BA] + l * GW + j * 64; const float* bx = A.in[I_LRU_BX] + l * GW + j * 64; const float* lam = A.in[I_LRU_LAM] + l * GW + j * 64;
    const size_t r0 = (size_t)b * SEQ + n * CHK;
    float ba8[8], bx8[8], lam8[8];
#pragma unroll
    for (int q = 0; q < 8; ++q) { ba8[q] = ba[(tid & 7) * 8 + q]; bx8[q] = bx[(tid & 7) * 8 + q]; lam8[q] = lam[(tid & 7) * 8 + q]; }
    { const int cc = tid & 63, c0 = (tid >> 6) * 8, ch = j * 64 + cc, pc = PC_LRU_X + ch; const long t0 = (long)n * CHK + c0;
        const float w0 = cw[ch], w1 = cw[GW + ch], w2 = cw[2 * GW + ch], w3 = cw[3 * GW + ch], bias = cb[ch];
        float xm3 = (t0 - 3 >= 0) ? bf2f(P[(r0 + c0 - 3) * PBW + pc]) : 0.f, xm2 = (t0 - 2 >= 0) ? bf2f(P[(r0 + c0 - 2) * PBW + pc]) : 0.f, xm1 = (t0 - 1 >= 0) ? bf2f(P[(r0 + c0 - 1) * PBW + pc]) : 0.f;
#pragma unroll
        for (int i = 0; i < 8; ++i) { const float x0 = bf2f(P[(r0 + c0 + i) * PBW + pc]); xc[(c0 + i) * 65 + cc] = w0 * xm3 + w1 * xm2 + w2 * xm1 + w3 * x0 + bias; xm3 = xm2; xm2 = xm1; xm1 = x0; } }
    __syncthreads();
    { const int tok = tid >> 3, cg = tid & 7; float ra[8], ri[8], spl[8];
#pragma unroll
        for (int q = 0; q < 8; ++q) { ra[q] = ba8[q]; ri[q] = bx8[q]; spl[q] = softplusf_(-lam8[q]); }
#pragma unroll 4
        for (int i = 0; i < 64; ++i) { const float xv = xc[tok * 65 + i];
            const f32x4 a0 = *(const LAS f32x4*)(was + i * 64 + cg * 8), a1 = *(const LAS f32x4*)(was + i * 64 + cg * 8 + 4);
            const f32x4 x0 = *(const LAS f32x4*)(wxs + i * 64 + cg * 8), x1 = *(const LAS f32x4*)(wxs + i * 64 + cg * 8 + 4);
#pragma unroll
            for (int q = 0; q < 4; ++q) { ra[q] += xv * a0[q]; ra[4 + q] += xv * a1[q]; ri[q] += xv * x0[q]; ri[4 + q] += xv * x1[q]; } }
#pragma unroll
        for (int q = 0; q < 8; ++q) { const int jj = cg * 8 + q; const float r = sigmoidf_(ra[q]), ig = sigmoidf_(ri[q]);
            const float log_a = -8.0f * r * spl[q]; const float a = __expf(log_a), u = sqrtf(fmaxf(1.0f - a * a, 0.f)) * (ig * xc[tok * 65 + jj]);
            aa[tok * 64 + jj] = a; uu[tok * 64 + jj] = u; } }
    __syncthreads();
    const int cc = tid & 63, seg = tid >> 6;
    { float Ap = 1.f, Hl = 0.f;
#pragma unroll
        for (int i = 0; i < 8; ++i) { const int c = seg * 8 + i; const float a = aa[c * 64 + cc], u = uu[c * 64 + cc]; Hl = a * Hl + u; Ap *= a; aa[c * 64 + cc] = Ap; uu[c * 64 + cc] = Hl; }
        segA[seg * 64 + cc] = Ap; segH[seg * 64 + cc] = Hl; }
    __syncthreads();
    { float Ac = 1.f, Hc = 0.f;
#pragma unroll 1
        for (int s = 0; s < seg; ++s) { const float sa = segA[s * 64 + cc]; Hc = sa * Hc + segH[s * 64 + cc]; Ac *= sa; }
#pragma unroll
        for (int i = 0; i < 8; ++i) { const int c = seg * 8 + i; const float ap = aa[c * 64 + cc], hl = uu[c * 64 + cc];
            HLg[(r0 + c) * GW + j * 64 + cc] = ap * Hc + hl; APg[(r0 + c) * GW + j * 64 + cc] = ap * Ac; } }
    __syncthreads();
}
__device__ __forceinline__ void f_lru_p3(ArgsR A, int b, int tid) {
    const float* HLg = (const float*)(A.ws + WS_LRU_HL); const float* APg = (const float*)(A.ws + WS_LRU_AP); float* carry = (float*)(A.ws + WS_LRU_CARRY);
    float c = 0.f;
#pragma unroll 8
    for (int n = 0; n < NCHK; ++n) { carry[((size_t)b * NCHK + n) * GW + tid] = c; const size_t t = (size_t)b * SEQ + n * CHK + 63; c = APg[t * GW + tid] * c + HLg[t * GW + tid]; }
}
__device__ __forceinline__ void f_lru_p4(ArgsR A, int item, int tid) {
    const bf16* P = (const bf16*)(A.ws + WS_P); bf16* mix = (bf16*)(A.ws + WS_MIX);
    const float* HLg = (const float*)(A.ws + WS_LRU_HL); const float* APg = (const float*)(A.ws + WS_LRU_AP); const float* carry = (const float*)(A.ws + WS_LRU_CARRY);
    const float cr = carry[(size_t)item * GW + tid]; const size_t r0 = (size_t)item * CHK;
#pragma unroll 8
    for (int c = 0; c < CHK; ++c) { const float h = APg[(r0 + c) * GW + tid] * cr + HLg[(r0 + c) * GW + tid]; const float y = bf2f(P[(r0 + c) * PBW + PC_LRU_Y + tid]);
        mix[(r0 + c) * DM + 512 + tid] = (bf16)f2bf(gelu_tanh(y) * h); }
}

constexpr int FL_Q = 0, FL_K = 17408, FL_V = 34816, FL_ST = 52224, FL_SC = 87040, FL_BC = 96256, FL_LR = 129024, FL_SEG = 133120, FL_RS = 135168;
struct GlaW2 { float w[16]; float b2; };
__device__ __forceinline__ void gla_w2_load(ArgsR A, int l, int h, int tid, GlaW2& W) {
    const int d = tid & 127; const float* w2 = A.in[I_GLA_W2] + (size_t)l * 16 * GW + h * HD + d;
#pragma unroll
    for (int r = 0; r < 16; ++r) W.w[r] = w2[r * GW];
    W.b2 = A.in[I_GLA_B2][l * GW + h * HD + d];
}
__device__ __forceinline__ void gla_bcum(const GlaW2& W, LAS float* bc, LAS float* segt, const LAS float* lrs, int tid) {
    const int d = tid & 127, seg = tid >> 7; float run = 0.f;
#pragma unroll 4
    for (int i = 0; i < 16; ++i) { const int c = seg * 16 + i; float z = W.b2;
#pragma unroll
        for (int r = 0; r < 16; ++r) z += lrs[c * 16 + r] * W.w[r];
        run += logsigmoidf_(z) * (1.0f / 16.0f); bc[c * 128 + d] = run; }
    segt[seg * 128 + d] = run;
}
__device__ __forceinline__ void f_gla_p2(ArgsR A, int l, int item, LAS unsigned char* lds, int tid) {
    const int n = item & 31, h = (item >> 5) & 3, b = item >> 7; const int lane = tid & 63, wave = __builtin_amdgcn_readfirstlane(tid >> 6);
    const bf16* P = (const bf16*)(A.ws + WS_P); const float* Ps = (const float*)(A.ws + WS_PS);
    float* inc = (float*)(A.ws + WS_GLA_INC) + (size_t)item * 16384; float* dec = (float*)(A.ws + WS_GLA_DEC) + (size_t)item * 128;
    LAS bf16* ks = (LAS bf16*)(lds + FL_K); LAS bf16* vs = (LAS bf16*)(lds + FL_V); LAS float* bc = (LAS float*)(lds + FL_BC); LAS float* lrs = (LAS float*)(lds + FL_LR); LAS float* segt = (LAS float*)(lds + FL_SEG);
    const size_t r0 = (size_t)b * SEQ + n * CHK;
    GlaW2 W2; gla_w2_load(A, l, h, tid, W2);
    tile_g2l_128<64>(P + r0 * PBW + PC_GLA_K + h * HD, PBW, ks, tid);
    tile_g2l_128<64>(P + r0 * PBW + PC_GLA_V + h * HD, PBW, vs, tid);
    for (int i = tid; i < 64 * 16; i += NTHREADS) lrs[i] = Ps[(r0 + (i >> 4)) * 32 + PS_LR + (i & 15)];
    __syncthreads();
    gla_bcum(W2, bc, segt, lrs, tid);
    __syncthreads();
    { const int d = tid & 127, seg = tid >> 7; float pre = 0.f, tot = 0.f;
#pragma unroll
        for (int s = 0; s < 4; ++s) { const float v = segt[s * 128 + d]; if (s < seg) pre += v; tot += v; }
#pragma unroll 4
        for (int i = 0; i < 16; ++i) { const int c = seg * 16 + i; const float bcm = bc[c * 128 + d] + pre; ks[c * LD128 + d] = (bf16)f2bf(bf2f(ks[c * LD128 + d]) * __expf(tot - bcm)); }
        if (seg == 0) dec[d] = __expf(tot); }
    __syncthreads();
    { f32x4 acc[8];
#pragma unroll
        for (int nt = 0; nt < 8; ++nt) acc[nt] = (f32x4){0.f, 0.f, 0.f, 0.f};
#pragma unroll
        for (int kk = 0; kk < 2; ++kk) { const bf16x8 af = frag_tr(vs, LD128, 32 * kk, 16 * wave, lane);
#pragma unroll
            for (int nt = 0; nt < 8; ++nt) acc[nt] = MFMA16(af, frag_tr(ks, LD128, 32 * kk, 16 * nt, lane), acc[nt]); }
        const int fr = lane & 15, fq = lane >> 4;
#pragma unroll
        for (int nt = 0; nt < 8; ++nt)
#pragma unroll
            for (int r = 0; r < 4; ++r) inc[(16 * wave + 4 * fq + r) * 128 + 16 * nt + fr] = acc[nt][r]; }
    __syncthreads();
}
__device__ __forceinline__ void f_gla_p3(ArgsR A, int item, int tid) {
    const int bh = item >> 4, sl = item & 15; const int e = sl * 1024 + tid * 2, d = e & 127;
    const float* inc = (const float*)(A.ws + WS_GLA_INC) + (size_t)bh * 32 * 16384 + e; const float* dec = (const float*)(A.ws + WS_GLA_DEC) + (size_t)bh * 32 * 128 + d;
    bf16* st = (bf16*)(A.ws + WS_GLA_ST) + (size_t)bh * 32 * 16384 + e;
    float s0 = 0.f, s1 = 0.f;
#pragma unroll 8
    for (int n = 0; n < NCHK; ++n) { *(GAS unsigned*)(st + (size_t)n * 16384) = pk2(s0, s1);
        const f32x2 iv = *(const GAS f32x2*)(inc + (size_t)n * 16384), dv = *(const GAS f32x2*)(dec + (size_t)n * 128); s0 = dv[0] * s0 + iv[0]; s1 = dv[1] * s1 + iv[1]; }
}
__device__ __forceinline__ void f_gla_p4(ArgsR A, int l, int item, LAS unsigned char* lds, int tid) {
    const int n = item & 31, h = (item >> 5) & 3, b = item >> 7; const int lane = tid & 63, wave = __builtin_amdgcn_readfirstlane(tid >> 6), fr = lane & 15, fq = lane >> 4;
    const bf16* P = (const bf16*)(A.ws + WS_P); const float* Ps = (const float*)(A.ws + WS_PS); bf16* mix = (bf16*)(A.ws + WS_MIX);
    const bf16* stg = (const bf16*)(A.ws + WS_GLA_ST) + (size_t)item * 16384;
    LAS bf16* qs = (LAS bf16*)(lds + FL_Q); LAS bf16* ks = (LAS bf16*)(lds + FL_K); LAS bf16* vs = (LAS bf16*)(lds + FL_V); LAS bf16* sts = (LAS bf16*)(lds + FL_ST); LAS bf16* scs = (LAS bf16*)(lds + FL_SC);
    LAS float* bc = (LAS float*)(lds + FL_BC); LAS float* lrs = (LAS float*)(lds + FL_LR); LAS float* segt = (LAS float*)(lds + FL_SEG); LAS float* rsp = (LAS float*)(lds + FL_RS);
    const size_t r0 = (size_t)b * SEQ + n * CHK;
    GlaW2 W2; gla_w2_load(A, l, h, tid, W2);
    const float gn = A.in[I_GLA_NG][l * GW + h * HD + 16 * wave + fr];
    float gt[4][4];
#pragma unroll
    for (int mt = 0; mt < 4; ++mt)
#pragma unroll
        for (int r = 0; r < 4; ++r) gt[mt][r] = bf2f(P[(r0 + 16 * mt + 4 * fq + r) * PBW + PC_GLA_G + h * HD + 16 * wave + fr]);
    tile_g2l_128<64>(P + r0 * PBW + PC_GLA_Q + h * HD, PBW, qs, tid);
    tile_g2l_128<64>(P + r0 * PBW + PC_GLA_K + h * HD, PBW, ks, tid);
    tile_g2l_128<64>(P + r0 * PBW + PC_GLA_V + h * HD, PBW, vs, tid);
    tile_g2l_128<128>(stg, 128, sts, tid);
    for (int i = tid; i < 64 * 16; i += NTHREADS) lrs[i] = Ps[(r0 + (i >> 4)) * 32 + PS_LR + (i & 15)];
    __syncthreads();
    gla_bcum(W2, bc, segt, lrs, tid);
    __syncthreads();
    { const int d = tid & 127, seg = tid >> 7; float pre = 0.f;
#pragma unroll
        for (int s = 0; s < 4; ++s) { const float v = segt[s * 128 + d]; if (s < seg) pre += v; }
#pragma unroll 4
        for (int i = 0; i < 16; ++i) { const int c = seg * 16 + i; const float bcm = bc[c * 128 + d] + pre;
            qs[c * LD128 + d] = (bf16)f2bf(bf2f(qs[c * LD128 + d]) * __expf(bcm) * 0.08838834764831845f); ks[c * LD128 + d] = (bf16)f2bf(bf2f(ks[c * LD128 + d]) * __expf(-bcm)); } }
    __syncthreads();
    { const int mt = wave >> 1; f32x4 acc[2] = {{0.f, 0.f, 0.f, 0.f}, {0.f, 0.f, 0.f, 0.f}};
#pragma unroll
        for (int kk = 0; kk < 4; ++kk) { const bf16x8 af = frag_rd(qs, LD128, 16 * mt, 32 * kk, lane);
#pragma unroll
            for (int q = 0; q < 2; ++q) acc[q] = MFMA16(af, frag_rd(ks, LD128, 16 * (2 * (wave & 1) + q), 32 * kk, lane), acc[q]); }
#pragma unroll
        for (int q = 0; q < 2; ++q) { const int s = 16 * (2 * (wave & 1) + q) + fr;
#pragma unroll
            for (int r = 0; r < 4; ++r) { const int c = 16 * mt + 4 * fq + r; scs[c * LD64 + s] = (bf16)f2bf(s <= c ? acc[q][r] : 0.f); } } }
    __syncthreads();
    f32x4 o[4];
#pragma unroll
    for (int mt = 0; mt < 4; ++mt) o[mt] = (f32x4){0.f, 0.f, 0.f, 0.f};
#pragma unroll
    for (int kk = 0; kk < 2; ++kk) { const bf16x8 bfv = frag_tr(vs, LD128, 32 * kk, 16 * wave, lane);
#pragma unroll
        for (int mt = 0; mt < 4; ++mt) o[mt] = MFMA16(frag_rd(scs, LD64, 16 * mt, 32 * kk, lane), bfv, o[mt]); }
#pragma unroll
    for (int kk = 0; kk < 4; ++kk) { const bf16x8 bfs = frag_rd(sts, LD128, 16 * wave, 32 * kk, lane);
#pragma unroll
        for (int mt = 0; mt < 4; ++mt) o[mt] = MFMA16(frag_rd(qs, LD128, 16 * mt, 32 * kk, lane), bfs, o[mt]); }
#pragma unroll
    for (int mt = 0; mt < 4; ++mt)
#pragma unroll
        for (int r = 0; r < 4; ++r) { float s = o[mt][r] * o[mt][r]; s = row_sum_f(s);
            if (fr == 0) rsp[wave * 64 + 16 * mt + 4 * fq + r] = s; }
    __syncthreads();
#pragma unroll
    for (int mt = 0; mt < 4; ++mt)
#pragma unroll
        for (int r = 0; r < 4; ++r) { const int c = 16 * mt + 4 * fq + r; float ss = 0.f;
#pragma unroll
            for (int w = 0; w < 8; ++w) ss += rsp[w * 64 + c];
            const float rs = rsqrtf(ss * (1.0f / 128.0f) + RMS_EPS);
            mix[(r0 + c) * DM + h * HD + 16 * wave + fr] = (bf16)f2bf(o[mt][r] * rs * gn * siluf_(gt[mt][r])); }
    __syncthreads();
}

constexpr int FM_Q2 = 96256, FM_S = 129024;
__device__ __forceinline__ void f_ml_p2(ArgsR A, int l, int item, LAS unsigned char* lds, int tid) {
    const int n = item & 31, h = (item >> 5) & 3, b = item >> 7; const int lane = tid & 63, wave = __builtin_amdgcn_readfirstlane(tid >> 6);
    const bf16* P = (const bf16*)(A.ws + WS_P); const float* Ps = (const float*)(A.ws + WS_PS);
    float* inc = (float*)(A.ws + WS_ML_INC) + (size_t)item * 16384; float* incn = (float*)(A.ws + WS_ML_N) + (size_t)item * 128; float* scg = (float*)(A.ws + WS_ML_SC) + (size_t)item * 2;
    LAS bf16* ks = (LAS bf16*)(lds + FL_K); LAS bf16* vs = (LAS bf16*)(lds + FL_V); LAS float* sc = (LAS float*)(lds + FM_S);
    const size_t r0 = (size_t)b * SEQ + n * CHK;
    tile_g2l_128<64>(P + r0 * PBW + PC_ML_K + h * HD, PBW, ks, tid);
    tile_g2l_128<64>(P + r0 * PBW + PC_ML_V + h * HD, PBW, vs, tid);
    if (wave == 0) { const float lf = logsigmoidf_(Ps[(r0 + lane) * 32 + PS_MF + h] + A.in[I_ML_FB][l * NH + h]), ig = Ps[(r0 + lane) * 32 + PS_MI + h] + A.in[I_ML_IB][l * NH + h];
        const float bcum = wave_scan_add(lf, lane), blast = lane_bcast(bcum, 63), le = blast - bcum + ig, mloc = wave_max(le);
        sc[lane] = __expf(le - mloc) * 0.08838834764831845f; if (lane == 0) { scg[0] = mloc; scg[1] = blast; } }
    __syncthreads();
#pragma unroll
    for (int i = 0; i < 2; ++i) { const int idx = tid + i * NTHREADS, r = idx >> 4, c8 = (idx & 15) * 8; const float w = sc[r];
        v4u x = *(LAS v4u*)(ks + r * LD128 + c8);
        x.x = pk2(bflo(x.x) * w, bfhi(x.x) * w); x.y = pk2(bflo(x.y) * w, bfhi(x.y) * w); x.z = pk2(bflo(x.z) * w, bfhi(x.z) * w); x.w = pk2(bflo(x.w) * w, bfhi(x.w) * w);
        *(LAS v4u*)(ks + r * LD128 + c8) = x; }
    __syncthreads();
    if (tid < 128) { float s = 0.f;
#pragma unroll 8
        for (int c = 0; c < 64; ++c) s += bf2f(ks[c * LD128 + tid]);
        incn[tid] = s; }
    { f32x4 acc[8];
#pragma unroll
        for (int nt = 0; nt < 8; ++nt) acc[nt] = (f32x4){0.f, 0.f, 0.f, 0.f};
#pragma unroll
        for (int kk = 0; kk < 2; ++kk) { const bf16x8 af = frag_tr(vs, LD128, 32 * kk, 16 * wave, lane);
#pragma unroll
            for (int nt = 0; nt < 8; ++nt) acc[nt] = MFMA16(af, frag_tr(ks, LD128, 32 * kk, 16 * nt, lane), acc[nt]); }
        const int fr = lane & 15, fq = lane >> 4;
#pragma unroll
        for (int nt = 0; nt < 8; ++nt)
#pragma unroll
            for (int r = 0; r < 4; ++r) inc[(16 * wave + 4 * fq + r) * 128 + 16 * nt + fr] = acc[nt][r]; }
    __syncthreads();
}
__device__ __forceinline__ void f_ml_p3(ArgsR A, int item, int tid) {
    const int bh = item >> 4, sl = item & 15; const int e = sl * 1024 + tid * 2;
    const float* inc = (const float*)(A.ws + WS_ML_INC) + (size_t)bh * 32 * 16384 + e; const float* incn = (const float*)(A.ws + WS_ML_N) + (size_t)bh * 32 * 128;
    const float* scg = (const float*)(A.ws + WS_ML_SC) + (size_t)bh * 32 * 2;
    bf16* st = (bf16*)(A.ws + WS_ML_ST) + (size_t)bh * 32 * 16384 + e; float* np = (float*)(A.ws + WS_ML_NP) + (size_t)bh * 32 * 128; float* mp = (float*)(A.ws + WS_ML_MP) + (size_t)bh * 32;
    float c0 = 0.f, c1 = 0.f, nv = 0.f, m = 0.f; const int dn = sl * 8 + tid;
#pragma unroll 4
    for (int n = 0; n < NCHK; ++n) {
        *(GAS unsigned*)(st + (size_t)n * 16384) = pk2(c0, c1);
        if (tid < 8) np[n * 128 + dn] = nv;
        if (sl == 0 && tid == 0) mp[n] = m;
        const float ml = scg[2 * n], bl = scg[2 * n + 1]; const float mn = fmaxf(bl + m, ml), ao = __expf(bl + m - mn), ai = __expf(ml - mn);
        const f32x2 iv = *(const GAS f32x2*)(inc + (size_t)n * 16384); c0 = ao * c0 + ai * iv[0]; c1 = ao * c1 + ai * iv[1];
        if (tid < 8) nv = ao * nv + ai * incn[n * 128 + dn];
        m = mn; }
}
__device__ __forceinline__ void f_ml_p4(ArgsR A, int l, int item, LAS unsigned char* lds, int tid) {
    const int n = item & 31, h = (item >> 5) & 3, b = item >> 7; const int lane = tid & 63, wave = __builtin_amdgcn_readfirstlane(tid >> 6), fr = lane & 15, fq = lane >> 4;
    const bf16* P = (const bf16*)(A.ws + WS_P); const float* Ps = (const float*)(A.ws + WS_PS); bf16* mix = (bf16*)(A.ws + WS_MIX);
    const bf16* stg = (const bf16*)(A.ws + WS_ML_ST) + (size_t)item * 16384; const float* npg = (const float*)(A.ws + WS_ML_NP) + (size_t)item * 128; const float mprev = ((const float*)(A.ws + WS_ML_MP))[item];
    LAS bf16* qs = (LAS bf16*)(lds + FL_Q); LAS bf16* ks = (LAS bf16*)(lds + FL_K); LAS bf16* vs = (LAS bf16*)(lds + FL_V); LAS bf16* sts = (LAS bf16*)(lds + FL_ST); LAS bf16* scs = (LAS bf16*)(lds + FL_SC);
    LAS bf16* q2 = (LAS bf16*)(lds + FM_Q2); LAS float* sc = (LAS float*)(lds + FM_S); LAS float* rsp = (LAS float*)(lds + FL_RS + 4096);
    const size_t r0 = (size_t)b * SEQ + n * CHK;
    const float gn = A.in[I_ML_NG][l * GW + h * HD + 16 * wave + fr];
    float ogt[4][4];
#pragma unroll
    for (int mt = 0; mt < 4; ++mt)
#pragma unroll
        for (int r = 0; r < 4; ++r) ogt[mt][r] = bf2f(P[(r0 + 16 * mt + 4 * fq + r) * PBW + PC_ML_O + h * HD + 16 * wave + fr]);
    tile_g2l_128<64>(P + r0 * PBW + PC_ML_Q + h * HD, PBW, qs, tid);
    tile_g2l_128<64>(P + r0 * PBW + PC_ML_K + h * HD, PBW, ks, tid);
    tile_g2l_128<64>(P + r0 * PBW + PC_ML_V + h * HD, PBW, vs, tid);
    tile_g2l_128<128>(stg, 128, sts, tid);
    if (wave == 0) { const float lf = logsigmoidf_(Ps[(r0 + lane) * 32 + PS_MF + h] + A.in[I_ML_FB][l * NH + h]), ig = Ps[(r0 + lane) * 32 + PS_MI + h] + A.in[I_ML_IB][l * NH + h];
        const float bcum = wave_scan_add(lf, lane), as = ig - bcum, pm = wave_scan_max(as, lane);
        const float mintra = bcum + pm, minter = bcum + mprev, mt = fmaxf(mintra, minter);
        sc[lane] = bcum - mt; sc[64 + lane] = as; sc[128 + lane] = __expf(minter - mt); sc[192 + lane] = __expf(-mt); }
    if (wave == 1) { sc[320 + lane] = npg[lane]; sc[384 + lane] = npg[64 + lane]; }
    __syncthreads();
#pragma unroll
    for (int i = 0; i < 2; ++i) { const int idx = tid + i * NTHREADS, r = idx >> 4, c8 = (idx & 15) * 8; const float w = sc[128 + r];
        v4u x = *(LAS v4u*)(qs + r * LD128 + c8);
        x.x = pk2(bflo(x.x) * w, bfhi(x.x) * w); x.y = pk2(bflo(x.y) * w, bfhi(x.y) * w); x.z = pk2(bflo(x.z) * w, bfhi(x.z) * w); x.w = pk2(bflo(x.w) * w, bfhi(x.w) * w);
        *(LAS v4u*)(q2 + r * LD128 + c8) = x; }
    { const int mt = wave >> 1; f32x4 acc[2] = {{0.f, 0.f, 0.f, 0.f}, {0.f, 0.f, 0.f, 0.f}};
#pragma unroll
        for (int kk = 0; kk < 4; ++kk) { const bf16x8 af = frag_rd(qs, LD128, 16 * mt, 32 * kk, lane);
#pragma unroll
            for (int q = 0; q < 2; ++q) acc[q] = MFMA16(af, frag_rd(ks, LD128, 16 * (2 * (wave & 1) + q), 32 * kk, lane), acc[q]); }
#pragma unroll
        for (int q = 0; q < 2; ++q) { const int s = 16 * (2 * (wave & 1) + q) + fr; const float asv = sc[64 + s];
#pragma unroll
            for (int r = 0; r < 4; ++r) { const int c = 16 * mt + 4 * fq + r; scs[c * LD64 + s] = (bf16)f2bf(s <= c ? acc[q][r] * 0.08838834764831845f * __expf(sc[c] + asv) : 0.f); } } }
    __syncthreads();
    { const int c = tid >> 3, part = tid & 7; float s = 0.f;
#pragma unroll
        for (int i = 0; i < 8; ++i) s += bf2f(scs[c * LD64 + part * 8 + i]);
#pragma unroll
        for (int i = 0; i < 16; ++i) s += bf2f(q2[c * LD128 + part * 16 + i]) * sc[320 + part * 16 + i];
        s = oct_sum_f(s);
        if (part == 0) sc[256 + c] = fmaxf(fabsf(s), sc[192 + c]); }
    f32x4 o[4];
#pragma unroll
    for (int mt = 0; mt < 4; ++mt) o[mt] = (f32x4){0.f, 0.f, 0.f, 0.f};
#pragma unroll
    for (int kk = 0; kk < 2; ++kk) { const bf16x8 bfv = frag_tr(vs, LD128, 32 * kk, 16 * wave, lane);
#pragma unroll
        for (int mt = 0; mt < 4; ++mt) o[mt] = MFMA16(frag_rd(scs, LD64, 16 * mt, 32 * kk, lane), bfv, o[mt]); }
#pragma unroll
    for (int kk = 0; kk < 4; ++kk) { const bf16x8 bfs = frag_rd(sts, LD128, 16 * wave, 32 * kk, lane);
#pragma unroll
        for (int mt = 0; mt < 4; ++mt) o[mt] = MFMA16(frag_rd(q2, LD128, 16 * mt, 32 * kk, lane), bfs, o[mt]); }
    __syncthreads();
#pragma unroll
    for (int mt = 0; mt < 4; ++mt)
#pragma unroll
        for (int r = 0; r < 4; ++r) { const int c = 16 * mt + 4 * fq + r;
            const float hv = o[mt][r] * rcpf_(sc[256 + c]) * sigmoidf_(ogt[mt][r]); o[mt][r] = hv;
            float s = hv * hv; s = row_sum_f(s);
            if (fr == 0) rsp[wave * 64 + c] = s; }
    __syncthreads();
#pragma unroll
    for (int mt = 0; mt < 4; ++mt)
#pragma unroll
        for (int r = 0; r < 4; ++r) { const int c = 16 * mt + 4 * fq + r; float ss = 0.f;
#pragma unroll
            for (int w = 0; w < 8; ++w) ss += rsp[w * 64 + c];
            mix[(r0 + c) * DM + 1024 + h * HD + 16 * wave + fr] = (bf16)f2bf(o[mt][r] * rsqrtf(ss * (1.0f / 128.0f) + RMS_EPS) * gn); }
    __syncthreads();
}

constexpr int FG_LM = 52224, FG_S = 129024, FG_RAW = 68608, FG_RAWT = 9216  ;
template <int C> struct GdnSolve {
    static __device__ __forceinline__ void run(float (&sol)[64], const LAS float* Lm) {
        if constexpr (C < 64) {
            float a0 = sol[C], a1 = 0.f, a2 = 0.f, a3 = 0.f;
#pragma unroll
            for (int s = 0; s < C; ++s) { const float t = Lm[C * 64 + s] * sol[s]; if ((s & 3) == 0) a0 -= t; else if ((s & 3) == 1) a1 -= t; else if ((s & 3) == 2) a2 -= t; else a3 -= t; }
            sol[C] = (a0 + a1) + (a2 + a3);
            GdnSolve<C + 1>::run(sol, Lm);
        }
    }
};
__device__ __forceinline__ void f_gdn_p2(ArgsR A, int l, int item, LAS unsigned char* lds, int tid) {
    const int n = item & 31, h = (item >> 5) & 3, b = item >> 7; const int lane = tid & 63, wave = __builtin_amdgcn_readfirstlane(tid >> 6), fr = lane & 15, fq = lane >> 4;
    const bf16* P = (const bf16*)(A.ws + WS_P); const float* Ps = (const float*)(A.ws + WS_PS);
    bf16* U0 = (bf16*)(A.ws + WS_GDN_U0) + (size_t)item * 8192; bf16* Wg = (bf16*)(A.ws + WS_GDN_W) + (size_t)item * 8192; bf16* QD = (bf16*)(A.ws + WS_GDN_QD) + (size_t)item * 8192;
    bf16* KE = (bf16*)(A.ws + WS_GDN_KE) + (size_t)item * 8192; bf16* QK = (bf16*)(A.ws + WS_GDN_QK) + (size_t)item * 4096; float* DE = (float*)(A.ws + WS_GDN_DE);
    LAS bf16* qs = (LAS bf16*)(lds + FL_Q); LAS bf16* ks = (LAS bf16*)(lds + FL_K); LAS bf16* vs = (LAS bf16*)(lds + FL_V); LAS float* Lm = (LAS float*)(lds + FG_LM); LAS float* sc = (LAS float*)(lds + FG_S);
    const float* cw = A.in[I_GDN_CW] + (size_t)l * 4 * 1536;
    const size_t r0 = (size_t)b * SEQ + n * CHK;
    float cwv[3][4];
#pragma unroll
    for (int part = 0; part < 3; ++part)
#pragma unroll
        for (int k = 0; k < 4; ++k) cwv[part][k] = cw[k * 1536 + part * 512 + h * HD + (tid & 127)];
    if (wave == 0) { const float bt = sigmoidf_(Ps[(r0 + lane) * 32 + PS_GB + h]);
        const float g = -__expf(A.in[I_GDN_ALOG][l * NH + h]) * softplusf_(Ps[(r0 + lane) * 32 + PS_GA + h] + A.in[I_GDN_DTB][l * NH + h]);
        const float gam = wave_scan_add(g, lane); sc[lane] = bt; sc[64 + lane] = gam; if (lane == 63) DE[item] = __expf(gam); }
    { LAS bf16* raw = (LAS bf16*)(lds + FG_RAW);
#pragma unroll
        for (int i = 0; i < 7; ++i) { const int idx = tid + i * NTHREADS; if (idx < 3 * 67 * 16) { const int part = idx / (67 * 16), pi = idx % (67 * 16), rr = pi >> 4, c8 = (pi & 15) * 8;
            const int pc = (part == 0 ? PC_GDN_Q : part == 1 ? PC_GDN_K : PC_GDN_V) + h * HD + c8; v4u w = {0u, 0u, 0u, 0u};
            if (n > 0 || rr >= 3) w = *(const GAS v4u*)(P + (r0 + rr - 3) * PBW + pc);
            *(LAS v4u*)(raw + part * FG_RAWT + rr * LD128 + c8) = w; } }
        __syncthreads();
        const int v = tid & 127, dq = tid >> 7;
#pragma unroll
        for (int part = 0; part < 3; ++part) {
            const float w0 = cwv[part][0], w1 = cwv[part][1], w2 = cwv[part][2], w3 = cwv[part][3];
            LAS bf16* dst = part == 0 ? qs : part == 1 ? ks : vs; const LAS bf16* src = raw + part * FG_RAWT + v;
            const int c0 = dq * 16;
            float xm3 = bf2f(src[(c0 + 0) * LD128]), xm2 = bf2f(src[(c0 + 1) * LD128]), xm1 = bf2f(src[(c0 + 2) * LD128]);
#pragma unroll
            for (int i = 0; i < 16; ++i) { const float x0 = bf2f(src[(c0 + i + 3) * LD128]); const float y = w0 * xm3 + w1 * xm2 + w2 * xm1 + w3 * x0;
                dst[(c0 + i) * LD128 + v] = (bf16)f2bf(siluf_(y)); xm3 = xm2; xm2 = xm1; xm1 = x0; } } }
    __syncthreads();
#pragma unroll 1
    for (int rr = 0; rr < 8; ++rr) { const int c = wave * 8 + rr;
        const float q1 = bf2f(qs[c * LD128 + lane]), q2 = bf2f(qs[c * LD128 + 64 + lane]), k1 = bf2f(ks[c * LD128 + lane]), k2 = bf2f(ks[c * LD128 + 64 + lane]);
        const float sq = wave_sum(q1 * q1 + q2 * q2), sk = wave_sum(k1 * k1 + k2 * k2);
        if (lane == 0) { sc[128 + c] = rsqrtf(sq + 1e-6f) * 0.08838834764831845f; sc[192 + c] = rsqrtf(sk + 1e-6f); } }
    __syncthreads();
    { const int mt = wave >> 1; f32x4 akk[2] = {{0.f, 0.f, 0.f, 0.f}, {0.f, 0.f, 0.f, 0.f}}, aqk[2] = {{0.f, 0.f, 0.f, 0.f}, {0.f, 0.f, 0.f, 0.f}};
#pragma unroll
        for (int kk = 0; kk < 4; ++kk) { const bf16x8 ak = frag_rd(ks, LD128, 16 * mt, 32 * kk, lane), aq = frag_rd(qs, LD128, 16 * mt, 32 * kk, lane);
#pragma unroll
            for (int q = 0; q < 2; ++q) { const bf16x8 bk = frag_rd(ks, LD128, 16 * (2 * (wave & 1) + q), 32 * kk, lane); akk[q] = MFMA16(ak, bk, akk[q]); aqk[q] = MFMA16(aq, bk, aqk[q]); } }
#pragma unroll
        for (int q = 0; q < 2; ++q) { const int s = 16 * (2 * (wave & 1) + q) + fr; const float rks = sc[192 + s], gs = sc[64 + s];
#pragma unroll
            for (int r = 0; r < 4; ++r) { const int c = 16 * mt + 4 * fq + r; const float dcy = __expf(sc[64 + c] - gs);
                Lm[c * 64 + s] = (s < c) ? sc[c] * akk[q][r] * sc[192 + c] * rks * dcy : 0.f;
                QK[c * 64 + s] = (bf16)f2bf((s <= c) ? aqk[q][r] * sc[128 + c] * rks * dcy : 0.f); } } }
    __syncthreads();
    if (tid < 256) {
        float sol[64]; const bool isw = tid >= 128; const int j = tid & 127;
        const LAS float* LmO = Lm; asm volatile("" : "+v"(LmO));
#pragma unroll
        for (int c = 0; c < 64; ++c) { const float bt = sc[c]; sol[c] = isw ? bf2f(ks[c * LD128 + j]) * sc[192 + c] * bt * __expf(sc[64 + c]) : bf2f(vs[c * LD128 + j]) * bt; }
        GdnSolve<1>::run(sol, LmO);
        bf16* dst = isw ? Wg : U0;
#pragma unroll
        for (int c = 0; c < 64; ++c) dst[c * 128 + j] = (bf16)f2bf(sol[c]);
    } else {
        const int t2 = tid - 256; const float glast = sc[64 + 63];
#pragma unroll
        for (int i = 0; i < 8; ++i) { const int idx = t2 + i * 256, which = idx >> 10, pi = idx & 1023, r = pi >> 4, c8 = (pi & 15) * 8;
            const float w = which == 0 ? sc[128 + r] * __expf(sc[64 + r]) : sc[192 + r] * __expf(glast - sc[64 + r]);
            v4u x = *(LAS v4u*)((which == 0 ? qs : ks) + r * LD128 + c8);
            x.x = pk2(bflo(x.x) * w, bfhi(x.x) * w); x.y = pk2(bflo(x.y) * w, bfhi(x.y) * w); x.z = pk2(bflo(x.z) * w, bfhi(x.z) * w); x.w = pk2(bflo(x.w) * w, bfhi(x.w) * w);
            *(GAS v4u*)((which == 0 ? QD : KE) + r * 128 + c8) = x; }
    }
    __syncthreads();
}

constexpr int FC_W = 0, FC_QD = 17408, FC_KE = 34816, FC_U0 = 52224, FC_QK = 69632, FC_RS = 78848  ;
__device__ __forceinline__ void f_gdn_p3(ArgsR A, int l, int bh, LAS unsigned char* lds, int tid) {
    const int lane = tid & 63, wave = __builtin_amdgcn_readfirstlane(tid >> 6), fr = lane & 15, fq = lane >> 4; const int b = bh >> 2, h = bh & 3;
    const bf16* U0 = (const bf16*)(A.ws + WS_GDN_U0) + (size_t)bh * 32 * 8192; const bf16* Wg = (const bf16*)(A.ws + WS_GDN_W) + (size_t)bh * 32 * 8192; const bf16* QD = (const bf16*)(A.ws + WS_GDN_QD) + (size_t)bh * 32 * 8192;
    const bf16* KE = (const bf16*)(A.ws + WS_GDN_KE) + (size_t)bh * 32 * 8192; const bf16* QK = (const bf16*)(A.ws + WS_GDN_QK) + (size_t)bh * 32 * 4096; const float* DE = (const float*)(A.ws + WS_GDN_DE) + bh * 32;
    const bf16* P = (const bf16*)(A.ws + WS_P); bf16* mix = (bf16*)(A.ws + WS_MIX); LAS float* rsp = (LAS float*)(lds + FC_RS);
    const float gn = A.in[I_GDN_NG][l * GW + h * HD + 16 * wave + fr];
    LAS bf16* ws_ = (LAS bf16*)(lds + FC_W); LAS bf16* qds = (LAS bf16*)(lds + FC_QD); LAS bf16* kes = (LAS bf16*)(lds + FC_KE); LAS bf16* u0s = (LAS bf16*)(lds + FC_U0); LAS bf16* qks = (LAS bf16*)(lds + FC_QK);
    f32x4 S[8];
#pragma unroll
    for (int i = 0; i < 8; ++i) S[i] = (f32x4){0.f, 0.f, 0.f, 0.f};
    v4u st[9];
    auto issue = [&](int n) {
#pragma unroll
        for (int i = 0; i < 8; ++i) { const int idx = tid + i * NTHREADS, which = idx >> 10, pi = idx & 1023;
            const bf16* src = (which == 0 ? Wg : which == 1 ? QD : which == 2 ? KE : U0) + (size_t)n * 8192; st[i] = *(const GAS v4u*)(src + pi * 8); }
        st[8] = *(const GAS v4u*)(QK + (size_t)n * 4096 + tid * 8);
    };
    auto commit = [&]() {
#pragma unroll
        for (int i = 0; i < 8; ++i) { const int idx = tid + i * NTHREADS, which = idx >> 10, pi = idx & 1023, r = pi >> 4, c8 = (pi & 15) * 8;
            *(LAS v4u*)((LAS bf16*)(lds + which * 17408) + r * LD128 + c8) = st[i]; }
        { const int r = tid >> 3, c8 = (tid & 7) * 8; *(LAS v4u*)(qks + r * LD64 + c8) = st[8]; }
    };
    const float dev = DE[lane & 31];
    issue(0);
#pragma unroll 1
    for (int n = 0; n < NCHK; ++n) {
        __syncthreads();
        commit();
        __syncthreads();
        if (n + 1 < NCHK) issue(n + 1);
        const float de = lane_bcast(dev, n);
        const size_t r0 = (size_t)b * SEQ + n * CHK;
        float gt[4][4];
#pragma unroll
        for (int mt = 0; mt < 4; ++mt)
#pragma unroll
            for (int r = 0; r < 4; ++r) gt[mt][r] = bf2f(P[(r0 + 16 * mt + 4 * fq + r) * PBW + PC_GDN_G + h * HD + 16 * wave + fr]);
        bf16x8 SB[4];
#pragma unroll
        for (int kb = 0; kb < 4; ++kb) SB[kb] = pack_acc(S[2 * kb], S[2 * kb + 1]);
        f32x4 u[4], o[4];
#pragma unroll
        for (int mt = 0; mt < 4; ++mt) { f32x4 ws2 = {0.f, 0.f, 0.f, 0.f}; o[mt] = (f32x4){0.f, 0.f, 0.f, 0.f};
#pragma unroll
            for (int kb = 0; kb < 4; ++kb) { ws2 = MFMA16(frag_rd_perm(ws_, LD128, 16 * mt, 32 * kb, lane), SB[kb], ws2); o[mt] = MFMA16(frag_rd_perm(qds, LD128, 16 * mt, 32 * kb, lane), SB[kb], o[mt]); }
#pragma unroll
            for (int r = 0; r < 4; ++r) u[mt][r] = bf2f(u0s[(16 * mt + 4 * fq + r) * LD128 + 16 * wave + fr]) - ws2[r]; }
        const bf16x8 UB0 = pack_acc(u[0], u[1]), UB1 = pack_acc(u[2], u[3]);
#pragma unroll
        for (int mt = 0; mt < 4; ++mt) { o[mt] = MFMA16(frag_rd_perm(qks, LD64, 16 * mt, 0, lane), UB0, o[mt]); o[mt] = MFMA16(frag_rd_perm(qks, LD64, 16 * mt, 32, lane), UB1, o[mt]); }
#pragma unroll
        for (int dt = 0; dt < 8; ++dt) { f32x4 sn = S[dt] * de;
            sn = MFMA16(frag_tr_perm(kes, LD128, 0, 16 * dt, lane), UB0, sn); sn = MFMA16(frag_tr_perm(kes, LD128, 32, 16 * dt, lane), UB1, sn); S[dt] = sn; }
        LAS float* rs_ = rsp + (n & 1) * 512;
#pragma unroll
        for (int mt = 0; mt < 4; ++mt)
#pragma unroll
            for (int r = 0; r < 4; ++r) { float s = o[mt][r] * o[mt][r]; s = row_sum_f(s);
                if (fr == 0) rs_[wave * 64 + 16 * mt + 4 * fq + r] = s; }
        __syncthreads();
#pragma unroll
        for (int mt = 0; mt < 4; ++mt)
#pragma unroll
            for (int r = 0; r < 4; ++r) { const int c = 16 * mt + 4 * fq + r; float ss = 0.f;
#pragma unroll
                for (int w = 0; w < 8; ++w) ss += rs_[w * 64 + c];
                mix[(r0 + c) * DM + 1536 + h * HD + 16 * wave + fr] = (bf16)f2bf(o[mt][r] * rsqrtf(ss * (1.0f / 128.0f) + RMS_EPS) * gn * siluf_(gt[mt][r])); }
    }
    __syncthreads();
}

#ifndef TAB_FP8
#define TAB_FP8 1
#endif
constexpr size_t WS_TSC = 93 * MiB + 256 * 1024;
constexpr int NSLICE = 16;
constexpr int PE_KEYS = 0, PE_CAB = 16384, PE_ENT = 17408, PE_OFFS = 50176, PE_SHQ = 52352, PE_H2Q = 53248;

__device__ __forceinline__ void tab_convert(ArgsR A, int l, int gw, int NGW, int lane) {
    unsigned char* ws = A.ws; float* tsc = (float*)(ws + WS_TSC);
#pragma unroll 1
    for (int q = gw; q < 2 * NEXP; q += NGW) {
        const int t = q / NEXP, rr = l * NEXP + q % NEXP, r = t * DEPTH * NEXP + rr;
        const float* src = A.in[t ? I_PV : I_PU] + (size_t)rr * DM;
        f32x4 v[8];
#pragma unroll
        for (int i = 0; i < 8; ++i) v[i] = *(const GAS f32x4*)(src + 4 * (lane + 64 * i));
        unsigned char* dst = ws + (t ? WS_VB : WS_UB) + (size_t)(rr / NEXP) * TAB_L + (size_t)(rr % NEXP) * DM;
        float am = 0.f;
#pragma unroll
        for (int i = 0; i < 8; ++i) am = fmaxf(fmaxf(am, fmaxf(fabsf(v[i][0]), fabsf(v[i][1]))), fmaxf(fabsf(v[i][2]), fabsf(v[i][3])));
        am = wave_max(am); const float sc = am > 0.f ? 127.0f / am : 1.0f; const int off = t ? 128 : 0;
#pragma unroll
        for (int i = 0; i < 8; ++i) { const int q0 = __float2int_rn(v[i][0] * sc) + off, q1 = __float2int_rn(v[i][1] * sc) + off, q2 = __float2int_rn(v[i][2] * sc) + off, q3 = __float2int_rn(v[i][3] * sc) + off;
            *(GAS unsigned*)(dst + 4 * (lane + 64 * i)) = (unsigned)(q0 & 255) | ((unsigned)(q1 & 255) << 8) | ((unsigned)(q2 & 255) << 16) | ((unsigned)(q3 & 255) << 24); }
        if (lane == 0) tsc[r] = am > 0.f ? am * (1.0f / 127.0f) : 1.0f;
    }
}
__device__ __forceinline__ float ubf0(unsigned w) { float r; asm volatile("v_cvt_f32_ubyte0 %0, %1" : "=v"(r) : "v"(w)); return r; }
__device__ __forceinline__ float ubf1(unsigned w) { float r; asm volatile("v_cvt_f32_ubyte1 %0, %1" : "=v"(r) : "v"(w)); return r; }
__device__ __forceinline__ float ubf2(unsigned w) { float r; asm volatile("v_cvt_f32_ubyte2 %0, %1" : "=v"(r) : "v"(w)); return r; }
__device__ __forceinline__ float ubf3(unsigned w) { float r; asm volatile("v_cvt_f32_ubyte3 %0, %1" : "=v"(r) : "v"(w)); return r; }
#define TOUCH16(a, o) asm volatile("" : "+v"(a[(o)+0]), "+v"(a[(o)+1]), "+v"(a[(o)+2]), "+v"(a[(o)+3]), "+v"(a[(o)+4]), "+v"(a[(o)+5]), "+v"(a[(o)+6]), "+v"(a[(o)+7]), "+v"(a[(o)+8]), "+v"(a[(o)+9]), "+v"(a[(o)+10]), "+v"(a[(o)+11]), "+v"(a[(o)+12]), "+v"(a[(o)+13]), "+v"(a[(o)+14]), "+v"(a[(o)+15]))
__device__ __forceinline__ unsigned f2sortable(float f) { const unsigned u = __builtin_bit_cast(unsigned, f); return (u & 0x80000000u) ? ~u : (u | 0x80000000u); }
__device__ __forceinline__ float unsortable(unsigned k) { const unsigned u = (k & 0x80000000u) ? (k & 0x7fffffffu) : ~k; return __builtin_bit_cast(float, u); }
template <bool DRY>
__device__ __forceinline__ void peer_phase(ArgsR A, int l, bool last, LAS unsigned char* lds, int G, int tid) {
    const int wave = __builtin_amdgcn_readfirstlane(tid >> 6), lane = tid & 63;
    unsigned char* ws = A.ws;
    const bf16* Q = (const bf16*)(ws + WS_Q);
    const bf16* K1 = (const bf16*)(ws + WS_K1) + (size_t)l * 8 * 128 * 128; const bf16* K2 = (const bf16*)(ws + WS_K2) + (size_t)l * 8 * 128 * 128;
    const unsigned char* Ub = ws + WS_UB + (size_t)l * TAB_L; const unsigned char* Vb = ws + WS_VB + (size_t)l * TAB_L;
    const float* tscU = (const float*)(ws + WS_TSC) + (size_t)l * NEXP; const float* tscV = tscU + (size_t)DEPTH * NEXP;
    const float* ssp = (const float*)(ws + WS_SSP); float* X = A.out; bf16* xb = (bf16*)(ws + WS_XB); float* rstd1 = (float*)(ws + WS_RSTD1);
    const float* g2 = A.in[I_N2G] + l * DM; const float* gf = A.in[I_FNG];
    LAS unsigned* keysL = (LAS unsigned*)(lds + PE_KEYS); LAS unsigned* cab = (LAS unsigned*)(lds + PE_CAB); LAS v2u* ent = (LAS v2u*)(lds + PE_ENT); LAS unsigned* offs = (LAS unsigned*)(lds + PE_OFFS);
    LAS float* shqL = (LAS float*)(lds + PE_SHQ); LAS unsigned* ngt = (LAS unsigned*)(lds + PE_SHQ + 128); LAS v4u* h2qL = (LAS v4u*)(lds + PE_H2Q);
    if (tid < 64) { int a = 0, b = tid, found = 0;
        for (int aa = 0, base = 0; aa < 16; ++aa) { const int nbb = 16 / (aa + 1); if (!found && tid < base + nbb) { a = aa; b = tid - base; found = 1; } base += nbb; }
        cab[tid] = found ? (unsigned)(a * 16 + b) : 0xffu; }
    __syncthreads();
#pragma unroll 1
    for (int item = blockIdx.x; item < NT / 32; item += G) {
        const int tok0 = item * 32;
#pragma unroll 1
        for (int tt = 0; tt < 4; ++tt) { const int tl = wave * 4 + tt; const size_t t = (size_t)tok0 + tl;
            float s2 = (lane < 32) ? ssp[t * 32 + lane] : 0.f; s2 = wave_sum(s2);
            const float rstd2 = rsqrtf(s2 * (1.0f / DM) + RMS_EPS);
            float hf[32]; float am = 0.f;
#pragma unroll
            for (int j = 0; j < 2; ++j)
#pragma unroll
                for (int q = 0; q < 4; ++q) { const size_t e0 = 16 * (size_t)(lane + 64 * j) + 4 * q;
                    const f32x4 xa = *(const GAS f32x4*)(X + t * DM + e0), ga = *(const GAS f32x4*)(g2 + e0);
#pragma unroll
                    for (int k = 0; k < 4; ++k) { const float hv = xa[k] * rstd2 * ga[k]; hf[j * 16 + q * 4 + k] = hv; am = fmaxf(am, fabsf(hv)); } }
            am = wave_max(am); const float sc = am > 0.f ? 127.0f / am : 1.0f;
#pragma unroll
            for (int j = 0; j < 2; ++j) { unsigned wd[4];
#pragma unroll
                for (int q = 0; q < 4; ++q) wd[q] = (unsigned)((__float2int_rn(hf[j * 16 + q * 4 + 0] * sc) & 255) | ((__float2int_rn(hf[j * 16 + q * 4 + 1] * sc) & 255) << 8) | ((__float2int_rn(hf[j * 16 + q * 4 + 2] * sc) & 255) << 16) | ((__float2int_rn(hf[j * 16 + q * 4 + 3] * sc) & 255) << 24));
                v4u w; w.x = wd[0]; w.y = wd[1]; w.z = wd[2]; w.w = wd[3]; h2qL[(tl * 2 + j) * 64 + lane] = w; }
            if (lane == 0) shqL[tl] = am > 0.f ? am * (1.0f / 127.0f) : 1.0f; }
#pragma unroll 1
        for (int pass = 0; pass < 4; ++pass) {
            LAS unsigned* kl = keysL + (pass & 1) * 2048;
            { const int hh = wave >> 2, side = (wave >> 1) & 1, mt = wave & 1, h = 2 * pass + hh, fr = lane & 15, fq = lane >> 4;
                const bf16* qa = Q + (size_t)(tok0 + 16 * mt + fr) * DM + h * 256 + side * 128 + 8 * fq;
                const bf16* kb = (side ? K2 : K1) + (size_t)h * 128 * 128 + (size_t)fr * 128 + 8 * fq;
                bf16x8 af[4];
#pragma unroll
                for (int ks = 0; ks < 4; ++ks) af[ks] = *(const GAS bf16x8*)(qa + 32 * ks);
                unsigned key[8][4];
#pragma unroll
                for (int nt = 0; nt < 8; ++nt) { f32x4 acc = {0.f, 0.f, 0.f, 0.f};
#pragma unroll
                    for (int ks = 0; ks < 4; ++ks) { const bf16x8 bfr = *(const GAS bf16x8*)(kb + (size_t)nt * 16 * 128 + 32 * ks); acc = __builtin_amdgcn_mfma_f32_16x16x32_bf16(af[ks], bfr, acc, 0, 0, 0); }
#pragma unroll
                    for (int r = 0; r < 4; ++r) key[nt][r] = (f2sortable(acc[r]) & ~127u) | (unsigned)(nt * 16 + fr);
                    if (nt & 1) __builtin_amdgcn_sched_barrier(0); }
                unsigned res[4] = {0u, 0u, 0u, 0u};
#pragma unroll 1
                for (int j = 0; j < 16; ++j) {
#pragma unroll
                    for (int r = 0; r < 4; ++r) {
                        unsigned m = max(max(max(key[0][r], key[1][r]), max(key[2][r], key[3][r])), max(max(key[4][r], key[5][r]), max(key[6][r], key[7][r])));
                        const unsigned w = row_max_u(m);
#pragma unroll
                        for (int nt = 0; nt < 8; ++nt) key[nt][r] = (key[nt][r] == w) ? 0u : key[nt][r];
                        res[r] = (fr == j) ? w : res[r]; } }
                const int rowb = (hh * 2 + side) * 32 + 16 * mt + 4 * fq;
#pragma unroll
                for (int r = 0; r < 4; ++r) kl[(rowb + r) * 16 + fr] = res[r]; }
            __syncthreads();
#pragma unroll 1
            for (int rnd = 0; rnd < 2; ++rnd) { const int fr = lane & 15, fq = lane >> 4, pidx = rnd * 32 + wave * 4 + fq, hh = pidx >> 5, tk = pidx & 31, h = 2 * pass + hh;
                const LAS unsigned* k1 = kl + ((hh * 2) * 32 + tk) * 16; const LAS unsigned* k2 = k1 + 32 * 16;
                unsigned ck[4];
#pragma unroll
                for (int sl = 0; sl < 4; ++sl) { const int ci = fr + 16 * sl; const unsigned ab = cab[ci];
                    const float v = unsortable(k1[(ab >> 4) & 15] & ~127u) + unsortable(k2[ab & 15] & ~127u);
                    ck[sl] = (ab == 0xffu) ? 0u : ((f2sortable(v) & ~63u) | (unsigned)ci); }
                unsigned rk = 0u;
#pragma unroll 1
                for (int j = 0; j < 16; ++j) { const unsigned w = row_max_u(max(max(ck[0], ck[1]), max(ck[2], ck[3])));
#pragma unroll
                    for (int sl = 0; sl < 4; ++sl) ck[sl] = (ck[sl] == w) ? 0u : ck[sl];
                    rk = (fr == j) ? w : rk; }
                const unsigned ab = cab[rk & 63u]; const float v = unsortable(rk & ~63u);
                const float vmax = row_max_f(v), e = __expf(v - vmax), den = row_sum_f(e);
                const unsigned eid = (k1[(ab >> 4) & 15] & 127u) * 128u + (k2[ab & 15] & 127u);
                const float gsv = e * rcpf_(den) * tscV[eid];
                v2u wv; wv.x = eid; wv.y = __builtin_bit_cast(unsigned, gsv);
                ent[tk * 128 + h * 16 + fr] = wv; }
        }
        __syncthreads();
#pragma unroll 1
        for (int tt = 0; tt < 4; ++tt) { const int tl = wave * 4 + tt;
            const v2u e0 = ent[tl * 128 + lane], e1 = ent[tl * 128 + 64 + lane];
            const unsigned id0 = e0.x, id1 = e1.x; const unsigned s0 = id0 >> 10, s1 = id1 >> 10; const unsigned long long lt = (1ull << lane) - 1ull;
            unsigned base = 0, p0 = 0, p1 = 0, ngr = 0;
#pragma unroll 1
            for (unsigned s = 0; s < NSLICE; ++s) { const unsigned long long m0 = __ballot(s0 == s), m1 = __ballot(s1 == s); const unsigned c0 = __popcll(m0), c1 = __popcll(m1); ngr += (c0 + c1 + 3u) >> 2;
                if (s0 == s) p0 = base + __popcll(m0 & lt);
                if (s1 == s) p1 = base + c0 + __popcll(m1 & lt);
                if (lane == 0) offs[tl * 17 + s] = base;
                base += c0 + c1; }
            if (lane == 0) { offs[tl * 17 + NSLICE] = base; ngt[tl] = ngr; }
            ent[tl * 128 + p0] = e0; ent[tl * 128 + p1] = e1; }
        const unsigned lo16 = (unsigned)lane * 16u;
#define E_ADV(S, T, P, B1, NTOK, TLBASE) { P += 4; while (P >= B1 && S < NSLICE) { ++T; if (T == (NTOK)) { T = 0; ++S; } \
            if (S < NSLICE) { P = __builtin_amdgcn_readfirstlane((int)offs[((TLBASE) + T) * 17 + S]); B1 = __builtin_amdgcn_readfirstlane((int)offs[((TLBASE) + T) * 17 + S + 1]); } } \
            if (S >= NSLICE) { T = 0; P = 128; B1 = 128; } }
#define E_FETCH(X, T, P, B1, TLBASE, WITHSU) { X##tl = (TLBASE) + T; X##w = T; X##p = P; X##b1 = B1; \
            _Pragma("unroll") for (int e = 0; e < 4; ++e) { const v2u w_ = ent[X##tl * 128 + min(P + e, B1 - 1)]; const unsigned ex = w_.x, ey = w_.y; \
                X##id[e] = __builtin_amdgcn_readfirstlane((int)ex); X##cf[e] = __builtin_bit_cast(float, __builtin_amdgcn_readfirstlane((int)ey)); if (WITHSU) X##su[e] = tscU[X##id[e]]; } }
#define E_LOAD(REG, TAB, X) { _Pragma("unroll") for (int e = 0; e < 4; ++e) { const GAS unsigned char* rb = (const GAS unsigned char*)(TAB) + (size_t)X##id[e] * 2048; REG[e][0] = *(const GAS v4u*)(rb + lo16); REG[e][1] = *(const GAS v4u*)(rb + lo16 + 1024); } }
        {
            int Atl = 0, Aw = 0, Ap = 0, Ab1 = 0, Aid[4]; float Acf[4], Asu[4]; int Btl = 0, Bw = 0, Bp = 0, Bb1 = 0, Bid[4]; float Bcf[4], Bsu[4]; v4u RA[4][2], RB[4][2];
            (void)Aw; (void)Bw;
#define U_COMP(X, REG) { const v4u hq0 = h2qL[(X##tl * 2 + 0) * 64 + lane], hq1 = h2qL[(X##tl * 2 + 1) * 64 + lane]; const float shq = shqL[X##tl]; float dd[4]; \
                _Pragma("unroll") for (int e = 0; e < 4; ++e) { int a0 = 0, a1 = 0; \
                    a0 = __builtin_amdgcn_sdot4((int)REG[e][0][0], (int)hq0[0], a0, false); a1 = __builtin_amdgcn_sdot4((int)REG[e][0][1], (int)hq0[1], a1, false); \
                    a0 = __builtin_amdgcn_sdot4((int)REG[e][0][2], (int)hq0[2], a0, false); a1 = __builtin_amdgcn_sdot4((int)REG[e][0][3], (int)hq0[3], a1, false); \
                    a0 = __builtin_amdgcn_sdot4((int)REG[e][1][0], (int)hq1[0], a0, false); a1 = __builtin_amdgcn_sdot4((int)REG[e][1][1], (int)hq1[1], a1, false); \
                    a0 = __builtin_amdgcn_sdot4((int)REG[e][1][2], (int)hq1[2], a0, false); a1 = __builtin_amdgcn_sdot4((int)REG[e][1][3], (int)hq1[3], a1, false); \
                    dd[e] = (float)(a0 + a1); } \
                _Pragma("unroll") for (int e = 0; e < 4; ++e) { const float r_ = row_sum_f(dd[e]); const int ri_ = __builtin_bit_cast(int, r_); \
                    dd[e] = (__builtin_bit_cast(float, __builtin_amdgcn_readlane(ri_, 0)) + __builtin_bit_cast(float, __builtin_amdgcn_readlane(ri_, 16))) + (__builtin_bit_cast(float, __builtin_amdgcn_readlane(ri_, 32)) + __builtin_bit_cast(float, __builtin_amdgcn_readlane(ri_, 48))); } \
                _Pragma("unroll") for (int e = 0; e < 4; ++e) { const float cf = X##cf[e] * gelu_tanh(dd[e] * X##su[e] * shq); \
                    if (lane == 0 && X##p + e < X##b1) { v2u w2; w2.x = (unsigned)X##id[e]; w2.y = __builtin_bit_cast(unsigned, cf); ent[X##tl * 128 + X##p + e] = w2; } } }
            int us = 0, ut = -1, up = 0, ub1 = 0;
            const int ngU = __builtin_amdgcn_readfirstlane((int)(ngt[wave * 4] + ngt[wave * 4 + 1] + ngt[wave * 4 + 2] + ngt[wave * 4 + 3]));
            E_ADV(us, ut, up, ub1, 4, wave * 4);
            E_FETCH(A, ut, up, ub1, wave * 4, 1); E_LOAD(RA, Ub, A);
#pragma unroll 1
            for (int gi = 0; gi < ngU; gi += 2) {
                E_ADV(us, ut, up, ub1, 4, wave * 4); E_FETCH(B, ut, up, ub1, wave * 4, 1); E_LOAD(RB, Ub, B);
                U_COMP(A, RA);
                E_ADV(us, ut, up, ub1, 4, wave * 4); E_FETCH(A, ut, up, ub1, wave * 4, 1); E_LOAD(RA, Ub, A);
                U_COMP(B, RB);
            }
#undef U_COMP
        }
#pragma unroll 1
        for (int tq = 0; tq < 4; ++tq) {
            float y0[32]; float cs0 = 0.f;
            const int tla = wave * 4 + tq; const size_t ta = (size_t)tok0 + tla;
#pragma unroll
            for (int j = 0; j < 2; ++j)
#pragma unroll
                for (int q = 0; q < 4; ++q) { const size_t e0 = 16 * (size_t)(lane + 64 * j) + 4 * q; const f32x4 xa = *(const GAS f32x4*)(X + ta * DM + e0);
#pragma unroll
                    for (int k = 0; k < 4; ++k) y0[j * 16 + q * 4 + k] = xa[k]; }
            {
                int Atl = 0, Aw = 0, Ap = 0, Ab1 = 0, Aid[4]; float Acf[4], Asu[4]; int Btl = 0, Bw = 0, Bp = 0, Bb1 = 0, Bid[4]; float Bcf[4], Bsu[4]; v4u RA[4][2], RB[4][2];
                (void)Asu; (void)Bsu; (void)Atl; (void)Btl; (void)Aw; (void)Bw;
#define V_COMP(X, REG) { _Pragma("unroll") for (int e = 0; e < 4; ++e) { const float c = (X##p + e < X##b1) ? X##cf[e] : 0.f; cs0 += c; \
                    _Pragma("unroll") for (int j = 0; j < 2; ++j) _Pragma("unroll") for (int w = 0; w < 4; ++w) { const unsigned dw = REG[e][j][w]; \
                        y0[j * 16 + w * 4 + 0] += c * ubf0(dw); y0[j * 16 + w * 4 + 1] += c * ubf1(dw); y0[j * 16 + w * 4 + 2] += c * ubf2(dw); y0[j * 16 + w * 4 + 3] += c * ubf3(dw); } \
                    TOUCH16(y0, 0); TOUCH16(y0, 16); } }
                int us = 0, ut = -1, up = 0, ub1 = 0;
                const int ngV = __builtin_amdgcn_readfirstlane((int)ngt[tla]);
                E_ADV(us, ut, up, ub1, 1, tla);
                E_FETCH(A, ut, up, ub1, tla, 0); E_LOAD(RA, Vb, A);
#pragma unroll 1
                for (int gi = 0; gi < ngV; gi += 2) {
                    E_ADV(us, ut, up, ub1, 1, tla); E_FETCH(B, ut, up, ub1, tla, 0); E_LOAD(RB, Vb, B);
                    V_COMP(A, RA);
                    E_ADV(us, ut, up, ub1, 1, tla); E_FETCH(A, ut, up, ub1, tla, 0); E_LOAD(RA, Vb, A);
                    V_COMP(B, RB);
                }
#undef V_COMP
            }
#define PV_EPI(YY, CS, T) { float ss = 0.f; const float corr = 128.0f * CS; \
                _Pragma("unroll") for (int i = 0; i < 32; ++i) { YY[i] -= corr; ss += YY[i] * YY[i]; } \
                ss = wave_sum(ss); const float rs = rsqrtf(ss * (1.0f / DM) + RMS_EPS); \
                if (last) { _Pragma("unroll") for (int j = 0; j < 2; ++j) _Pragma("unroll") for (int q = 0; q < 4; ++q) { const size_t e0 = 16 * (size_t)(lane + 64 * j) + 4 * q; const f32x4 ga = *(const GAS f32x4*)(gf + e0); \
                        f32x4 oa = {YY[j * 16 + q * 4 + 0] * rs * ga[0], YY[j * 16 + q * 4 + 1] * rs * ga[1], YY[j * 16 + q * 4 + 2] * rs * ga[2], YY[j * 16 + q * 4 + 3] * rs * ga[3]}; *(GAS f32x4*)(X + (T) * DM + e0) = oa; } } \
                else { _Pragma("unroll") for (int j = 0; j < 2; ++j) { \
                        _Pragma("unroll") for (int q = 0; q < 4; ++q) { const size_t e0 = 16 * (size_t)(lane + 64 * j) + 4 * q; f32x4 oa = {YY[j * 16 + q * 4 + 0], YY[j * 16 + q * 4 + 1], YY[j * 16 + q * 4 + 2], YY[j * 16 + q * 4 + 3]}; *(GAS f32x4*)(X + (T) * DM + e0) = oa; } \
                        const size_t e0 = 16 * (size_t)(lane + 64 * j); v4u w0, w1; \
                        w0.x = pk2(YY[j * 16 + 0], YY[j * 16 + 1]); w0.y = pk2(YY[j * 16 + 2], YY[j * 16 + 3]); w0.z = pk2(YY[j * 16 + 4], YY[j * 16 + 5]); w0.w = pk2(YY[j * 16 + 6], YY[j * 16 + 7]); \
                        w1.x = pk2(YY[j * 16 + 8], YY[j * 16 + 9]); w1.y = pk2(YY[j * 16 + 10], YY[j * 16 + 11]); w1.z = pk2(YY[j * 16 + 12], YY[j * 16 + 13]); w1.w = pk2(YY[j * 16 + 14], YY[j * 16 + 15]); \
                        *(GAS v4u*)(xb + (T) * DM + e0) = w0; *(GAS v4u*)(xb + (T) * DM + e0 + 8) = w1; } \
                    if (lane == 0) rstd1[(T)] = rs; } }
            PV_EPI(y0, cs0, ta);
#undef PV_EPI
#undef E_ADV
#undef E_FETCH
#undef E_LOAD
        }
        __syncthreads();
    }
}

#ifndef PROBE_ITEM
#define PROBE_ITEM -1
#endif
#define IREP(k) for (int irep = (PROBE_ITEM == (k)) ? 0 : 1; irep < 2; ++irep)
#ifndef FAST_MASK
#define FAST_MASK 15
#endif
__device__ __forceinline__ void mix_p2(ArgsR A, int l, LAS unsigned char* lds, int G, int tid) {
    const int bx = blockIdx.x;
    if (FAST_MASK & 2) IREP(1) for (int it = bx; it < 512; it += G) f_gla_p2(A, l, it, lds, pg8::fresh_tid());
    if (FAST_MASK & 4) IREP(2) for (int it = bx; it < 512; it += G) f_ml_p2(A, l, it, lds, pg8::fresh_tid());
    if (FAST_MASK & 8) IREP(3) for (int it = bx; it < 512; it += G) f_gdn_p2(A, l, it, lds, pg8::fresh_tid());
    if (FAST_MASK & 1) IREP(4) for (int it = bx; it < 1024; it += G) f_lru_p2(A, l, it, lds, pg8::fresh_tid());
    if ((FAST_MASK & 15) != 15) {
        for (int it = bx; it < 80; it += G) {
            if (it < 16) { if (!(FAST_MASK & 2)) nm_gla(A, l, it >> 2, it & 3, lds, pg8::fresh_tid()); }
            else if (it < 32) { if (!(FAST_MASK & 4)) nm_mlstm(A, l, (it - 16) >> 2, (it - 16) & 3, lds, pg8::fresh_tid()); }
            else if (it < 48) { if (!(FAST_MASK & 8)) nm_gdn(A, l, (it - 32) >> 2, (it - 32) & 3, lds, pg8::fresh_tid()); }
            else { if (!(FAST_MASK & 1)) nm_lru(A, l, (it - 48) >> 3, (it - 48) & 7, lds, pg8::fresh_tid()); }
            __syncthreads();
        }
    }
}
__device__ __forceinline__ void part_barrier(unsigned* word, unsigned nb, int tid) {
    asm volatile("s_waitcnt vmcnt(0)" ::: "memory");
    __syncthreads();
    if (tid == 0) {
        __builtin_amdgcn_fence(__ATOMIC_RELEASE, "agent");
        asm volatile("s_waitcnt vmcnt(0)" ::: "memory");
        __hip_atomic_fetch_add(word, 1u, __ATOMIC_RELAXED, __HIP_MEMORY_SCOPE_AGENT);
        unsigned sp = 0;
        while (__hip_atomic_load(word, __ATOMIC_RELAXED, __HIP_MEMORY_SCOPE_AGENT) < nb) { __builtin_amdgcn_s_sleep(2); if (++sp > (1u << 22)) break; }
        __builtin_amdgcn_fence(__ATOMIC_ACQUIRE, "agent");
        asm volatile("s_waitcnt vmcnt(0)" ::: "memory");
    }
    __syncthreads();
}
__device__ __forceinline__ void mix_p3(ArgsR A, int l, LAS unsigned char* lds, int G) {
    const int bx = blockIdx.x;
    const bool split = G > 32;
    int first = 0, nb = G;
    if (split) { if (bx < 16) { f_gdn_p3(A, l, bx, lds, pg8::fresh_tid()); return; } first = 16; nb = G - 16; }
    else { for (int it = bx; it < 16; it += G) f_gdn_p3(A, l, it, lds, pg8::fresh_tid()); }
    for (int it = bx - first; it < 516; it += nb) {
        if (it < 256) f_gla_p3(A, it, pg8::fresh_tid());
        else if (it < 512) f_ml_p3(A, it - 256, pg8::fresh_tid());
        else f_lru_p3(A, it - 512, pg8::fresh_tid());
    }
    IREP(7) { const int t2 = pg8::fresh_tid(); tab_convert(A, l, (bx - first) * NWAVES + __builtin_amdgcn_readfirstlane(t2 >> 6), nb * NWAVES, t2 & 63); }
    part_barrier((unsigned*)(A.ws + WS_CTL) + CW_PBAR + 64 * l, (unsigned)nb, pg8::fresh_tid());
    IREP(5) for (int it = bx - first; it < 512; it += nb) f_gla_p4(A, l, it, lds, pg8::fresh_tid());
    IREP(6) for (int it = nb - 1 - (bx - first); it < 512; it += nb) f_ml_p4(       A, l, it, lds, pg8::fresh_tid());
    for (int it = bx - first; it < 128; it += nb) f_lru_p4(A, it, pg8::fresh_tid());
}

#ifndef PROBE_PHASE
#define PROBE_PHASE -1
#endif
#ifndef MK_PER_PHASE
#define MK_PER_PHASE 0
#endif
#if defined(PROBE_PHASE) && PROBE_PHASE == 7
constexpr int PPL = 7;
#else
constexpr int PPL = 6;
#endif
constexpr int NPHASE = 1 + PPL * DEPTH;
constexpr int CW_BAR = 4096;

__global__ void __launch_bounds__(NTHREADS, 2) mk_fwd(Args args) {
    extern __shared__ __attribute__((aligned(16))) unsigned char lds_raw[];
    LAS unsigned char* lds = (LAS unsigned char*)lds_raw;
    volatile LAS unsigned* MISC = (volatile LAS unsigned*)(lds + MISC_OFF);
    const int G = gridDim.x; const int bx = blockIdx.x;
    unsigned char* ws = args.ws;
    if (threadIdx.x < 64) MISC[threadIdx.x] = 0u;
    __syncthreads();
    XcdBarrier bar; bar.bar = (unsigned*)(ws + WS_CTL) + CW_BAR; bar.x = 0; bar.st = nullptr;
    if (!MK_PER_PHASE) bar = xcd_barrier_post((unsigned*)(ws + WS_CTL) + CW_BAR, MISC + 8);
    const int lo = args.ph_lo, hi = args.ph_hi;
#pragma unroll 1
    for (int ph = lo; ph < hi; ++ph) {
        const int l = ph > 0 ? (ph - 1) / PPL : 0, k = ph > 0 ? (ph - 1) % PPL : -1;
        if (k < 0) { const int t0 = pg8::fresh_tid(); const int vcu = (G % 8 == 0) ? (bx % 8) * (G / 8) + bx / 8 : bx; p0_prologue(*kargs(), lds, vcu, G, __builtin_amdgcn_readfirstlane(t0 >> 6), t0 & 63); }
        else if (k == 0) {
            pg8::Gemm g{(const pg8::bf16_t*)(ws + WS_XB), (const pg8::bf16_t*)(ws + WS_WIN + l * WIN_L), NT, NINP, DM}; pg8::StaticOrder S; S.init(NT, NINP, G, bx);
            pg8::EpiP E{(pg8::bf16_t*)(ws + WS_P), (float*)(ws + WS_PS), (const float*)(ws + WS_RSTD1)};
            pg8::gemm_phase<pg8::EpiP, pg8::StaticOrder, true, true>(lds, g, S, E); }
        else if (k == 1) mix_p2(*kargs(), l, lds, G, pg8::fresh_tid());
        else if (k == 2) mix_p3(*kargs(), l, lds, G);
        else if (k == 3) {
            pg8::Gemm g{(const pg8::bf16_t*)(ws + WS_MIX), (const pg8::bf16_t*)(ws + WS_WOUT + l * WSQ_L), NT, DM, DM}; pg8::StaticOrder S; S.init(NT, DM, G, bx);
            pg8::EpiX E{l == 0 ? args.in[I_X] : (const float*)args.out, args.out, (pg8::bf16_t*)(ws + WS_XB), (float*)(ws + WS_SSP)};
            pg8::gemm_phase<pg8::EpiX, pg8::StaticOrder, true, true>(lds, g, S, E); }
        else if (k == 4) {
            pg8::Gemm g{(const pg8::bf16_t*)(ws + WS_XB), (const pg8::bf16_t*)(ws + WS_WQ + l * WSQ_L), NT, DM, DM}; pg8::StaticOrder S; S.init(NT, DM, G, bx);
            pg8::EpiQ E{(pg8::bf16_t*)(ws + WS_Q), (const float*)(ws + WS_SSP)};
            pg8::gemm_phase<pg8::EpiQ, pg8::StaticOrder, true, true>(lds, g, S, E); }
#if defined(PROBE_PHASE) && PROBE_PHASE == 7
        else if (k == 5) peer_phase<true>(*kargs(), l, l == DEPTH - 1, lds, G, pg8::fresh_tid());
#endif
        else peer_phase<false>(*kargs(), l, l == DEPTH - 1, lds, G, pg8::fresh_tid());
        if (!MK_PER_PHASE && ph + 1 < hi) xcd_barrier(bar);
    }
}

extern "C" void kernel_launch(void* const* d_in, const int* in_sizes, int n_in, void* d_out, int out_size, void* d_ws, size_t ws_size, hipStream_t stream) {
    static int grid = 0;
    if (grid == 0) {
        if (n_in != N_IN || out_size != NT * DM || ws_size < WS_END) { fprintf(stderr, "kernel_launch: unexpected shapes: n_in %d out %d ws %zu (need %zu)\n", n_in, out_size, ws_size, (size_t)WS_END); grid = -1; return; }
        int dev = 0, cus = 0, per_cu = 0;
        if (hipGetDevice(&dev) != hipSuccess || hipDeviceGetAttribute(&cus, hipDeviceAttributeMultiprocessorCount, dev) != hipSuccess) { grid = -1; return; }
        if (hipFuncSetAttribute((const void*)mk_fwd, hipFuncAttributeMaxDynamicSharedMemorySize, LDS_BYTES) != hipSuccess) { fprintf(stderr, "kernel_launch: hipFuncSetAttribute failed\n"); grid = -1; return; }
        if (hipOccupancyMaxActiveBlocksPerMultiprocessor(&per_cu, (const void*)mk_fwd, NTHREADS, LDS_BYTES) != hipSuccess || per_cu < 1) { fprintf(stderr, "kernel_launch: occupancy query says %d blocks per CU\n", per_cu); (void)hipGetLastError(); grid = -1; return; }
        grid = cus;
    }
    if (grid < 0) return;
    if (hipMemsetAsync((char*)d_ws + WS_CTL, 0, CTL_ZERO_BYTES, stream) != hipSuccess) return;
    Args a{};
    for (int i = 0; i < N_IN; ++i) a.in[i] = (const float*)d_in[i];
    a.out = (float*)d_out; a.ws = (unsigned char*)d_ws;
#if MK_PER_PHASE
    for (int p = 0; p < NPHASE; ++p) { a.ph_lo = p; a.ph_hi = p + 1; a.li = 0; hipLaunchKernelGGL(mk_fwd, dim3(grid), dim3(NTHREADS), LDS_BYTES, stream, a); }
#else
    a.ph_lo = 0; a.ph_hi = NPHASE; a.li = 0;
    hipLaunchKernelGGL(mk_fwd, dim3(grid), dim3(NTHREADS), LDS_BYTES, stream, a);
#endif
}
```

```cpp
#include <hip/hip_runtime.h>
#include <cstdio>
#include <cstdint>
namespace pg8 {
__device__ __forceinline__ int fresh_tid() { int t = threadIdx.x; asm volatile("" : "+v"(t)); return t; }
#define PG8_LAS __attribute__((address_space(3)))
typedef unsigned short bf16_t;
typedef short bf16x8 __attribute__((ext_vector_type(8)));
typedef float f32x4 __attribute__((ext_vector_type(4)));
typedef unsigned u32x4 __attribute__((ext_vector_type(4)));
constexpr int BM = 256, BK = 64, HALF = 128, HTB = HALF * BK * 2  , STAGE_BYTES = 8 * HTB, NXCD = 8, WGM = 8;

__host__ __device__ __forceinline__ int lds_byte(int r, int c) { const int st = (r >> 4) * 2 + (c >> 5), rr = r & 15, cc = c & 31, ob = rr * 64 + cc * 2; return st * 1024 + (ob ^ (((ob >> 9) & 1) << 5)); }
__host__ __device__ __forceinline__ void stage_rc(int b, int& R, int& C) { const int st = b / 1024, sb = b % 1024, swz = sb ^ (((sb >> 9) & 1) << 5); R = (st >> 1) * 16 + swz / 64; C = (st & 1) * 32 + (swz % 64) / 2; }
__host__ __device__ __forceinline__ int perm32(int rho) { const int n = rho >> 4, i = rho & 15; return 8 * (i >> 2) + 4 * n + (i & 3); }

struct Unit { int pm, pn; };
struct Gemm { const bf16_t* A; const bf16_t* Bt; int M, N, K; };

struct StaticOrder {
    int nM, nN, nwg, G, c;
    __host__ __device__ void init(int M, int N, int G_, int c_) { nM = M / BM; nN = N / BM; nwg = nM * nN; G = G_; c = c_; }
    __host__ __device__ bool next(int i, Unit& u) const {
        const long L = (long)i * G + c; if (L >= nwg) return false;
        int wgid = (int)L; { const int q = nwg / NXCD, r = nwg % NXCD, xcd = wgid % NXCD, off = wgid / NXCD; wgid = (xcd < r ? xcd * (q + 1) : r * (q + 1) + (xcd - r) * q) + off; }
        const int nig = WGM * nN, gid = wgid / nig, fm = gid * WGM, gsz = (nM - fm) < WGM ? (nM - fm) : WGM;
        u.pm = fm + ((wgid % nig) % gsz); u.pn = (wgid % nig) / gsz; return true;
    }
    __device__ __forceinline__ void a_ready(const Unit&) const {}
    __device__ __forceinline__ void done(const Unit&) const {}
};


__device__ __forceinline__ unsigned cvt_pk_bf16(float lo, float hi) { unsigned r; asm volatile("v_cvt_pk_bf16_f32 %0, %1, %2" : "=v"(r) : "v"(lo), "v"(hi)); return r; }

struct EpiP {
    static constexpr bool PERM = true, AFTER_DRAIN = false;
    bf16_t* P; float* Ps; const float* rstd;
    __device__ __forceinline__ void operator()(const f32x4 (&acc)[2][2][4][2], const Unit& u, int wr, int wc, int fr, int fq) const {
        const int row0 = u.pm * BM + wr * 64 + fr;
        if (u.pn < 28) {
            const int col0 = u.pn * BM + wc * 32 + 8 * fq;
#pragma unroll
            for (int ai = 0; ai < 2; ++ai)
#pragma unroll
                for (int m = 0; m < 4; ++m) { const int row = row0 + ai * HALF + m * 16; const float r = rstd[row]; bf16_t* rowp = P + (size_t)row * 7168 + col0;
#pragma unroll
                    for (int bj = 0; bj < 2; ++bj) { const f32x4 v0 = acc[ai][bj][m][0] * r, v1 = acc[ai][bj][m][1] * r;
                        u32x4 w; w.x = cvt_pk_bf16(v0[0], v0[1]); w.y = cvt_pk_bf16(v0[2], v0[3]); w.z = cvt_pk_bf16(v1[0], v1[1]); w.w = cvt_pk_bf16(v1[2], v1[3]);
                        *(u32x4*)(rowp + bj * HALF) = w; } }
        } else if (wc == 0) {
#pragma unroll
            for (int ai = 0; ai < 2; ++ai)
#pragma unroll
                for (int m = 0; m < 4; ++m) { const int row = row0 + ai * HALF + m * 16; const float r = rstd[row]; float* p = Ps + (size_t)row * 32 + 8 * fq;
                    *(f32x4*)p = acc[ai][0][m][0] * r; *(f32x4*)(p + 4) = acc[ai][0][m][1] * r; }
        }
    }
};
struct EpiX {
    static constexpr bool PERM = true, AFTER_DRAIN = false;
    const float* xres; float* xout; bf16_t* xb; float* ssp;
    __device__ __forceinline__ void operator()(const f32x4 (&acc)[2][2][4][2], const Unit& u, int wr, int wc, int fr, int fq) const {
        const int row0 = u.pm * BM + wr * 64 + fr, col0 = u.pn * BM + wc * 32 + 8 * fq;
#pragma unroll
        for (int ai = 0; ai < 2; ++ai)
#pragma unroll
            for (int m = 0; m < 4; ++m) { const int row = row0 + ai * HALF + m * 16; float ss = 0.f;
#pragma unroll
                for (int bj = 0; bj < 2; ++bj) { const size_t off = (size_t)row * 2048 + col0 + bj * HALF;
                    const f32x4 r0 = *(const f32x4*)(xres + off), r1 = *(const f32x4*)(xres + off + 4);
                    const f32x4 v0 = acc[ai][bj][m][0] + r0, v1 = acc[ai][bj][m][1] + r1;
                    *(f32x4*)(xout + off) = v0; *(f32x4*)(xout + off + 4) = v1;
                    u32x4 w; w.x = cvt_pk_bf16(v0[0], v0[1]); w.y = cvt_pk_bf16(v0[2], v0[3]); w.z = cvt_pk_bf16(v1[0], v1[1]); w.w = cvt_pk_bf16(v1[2], v1[3]);
                    *(u32x4*)(xb + off) = w;
                    ss += (v0[0] * v0[0] + v0[1] * v0[1]) + (v0[2] * v0[2] + v0[3] * v0[3]) + (v1[0] * v1[0] + v1[1] * v1[1]) + (v1[2] * v1[2] + v1[3] * v1[3]); }
                ss += __shfl_xor(ss, 16); ss += __shfl_xor(ss, 32);
                if (fq == 0) ssp[(size_t)row * 32 + u.pn * 4 + wc] = ss; }
    }
};
struct EpiQ {
    static constexpr bool PERM = true, AFTER_DRAIN = false;
    bf16_t* Q; const float* ssp;
    __device__ __forceinline__ void operator()(const f32x4 (&acc)[2][2][4][2], const Unit& u, int wr, int wc, int fr, int fq) const {
        const int row0 = u.pm * BM + wr * 64 + fr, col0 = u.pn * BM + wc * 32 + 8 * fq;
#pragma unroll
        for (int ai = 0; ai < 2; ++ai)
#pragma unroll
            for (int m = 0; m < 4; ++m) { const int row = row0 + ai * HALF + m * 16;
                const f32x4* sp = (const f32x4*)(ssp + (size_t)row * 32 + 8 * fq); const f32x4 a = sp[0], b = sp[1];
                float s = ((a[0] + a[1]) + (a[2] + a[3])) + ((b[0] + b[1]) + (b[2] + b[3]));
                s += __shfl_xor(s, 16); s += __shfl_xor(s, 32);
                const float r = rsqrtf(s * (1.0f / 2048.0f) + 1e-6f); bf16_t* rowp = Q + (size_t)row * 2048 + col0;
#pragma unroll
                for (int bj = 0; bj < 2; ++bj) { const f32x4 v0 = acc[ai][bj][m][0] * r, v1 = acc[ai][bj][m][1] * r;
                    u32x4 w; w.x = cvt_pk_bf16(v0[0], v0[1]); w.y = cvt_pk_bf16(v0[2], v0[3]); w.z = cvt_pk_bf16(v1[0], v1[1]); w.w = cvt_pk_bf16(v1[2], v1[3]);
                    *(u32x4*)(rowp + bj * HALF) = w; } }
    }
};

template <class Epi, class Sched, bool ALIGN_EPI = false, bool SP2 = false>
__device__ __forceinline__ void gemm_phase(PG8_LAS unsigned char* lds, const Gemm g, const Sched& S, const Epi& E) {
    const int tid = fresh_tid(), wid = __builtin_amdgcn_readfirstlane(tid >> 6), lane = tid & 63, wr = wid >> 2, wc = wid & 3, fr = lane & 15, fq = lane >> 4;
    const int K = g.K, nt = K / BK;
    unsigned voffA[2], voffB[2];
#pragma unroll
    for (int i = 0; i < 2; ++i) { int R, C; stage_rc(tid * 16 + i * 8192, R, C); const int Rb = Epi::PERM ? ((R & ~31) + perm32(R & 31)) : R;
        voffA[i] = (unsigned)(R * K + C) * 2u; voffB[i] = (unsigned)(Rb * K + C) * 2u; }
    const size_t kstep = (size_t)(BK * 2);
    const size_t hstep = (size_t)HALF * K * 2;
    const size_t tstep = 2 * hstep;
    const unsigned ldsw = (unsigned)wid * 1024u;
    const int aoff = lds_byte(wr * 64 + fr, fq * 8), boff = lds_byte(wc * 32 + fr, fq * 8);
#define PG8_SA(b, h) (((b) * 2 + (h)) * HTB)
#define PG8_SB(b, h) ((4 + (b) * 2 + (h)) * HTB)
#define PG8_STAGE(bufoff, gbase, voff) do { _Pragma("unroll") for (int _i = 0; _i < 2; ++_i) \
        __builtin_amdgcn_global_load_lds((const unsigned*)((const char*)(gbase) + (voff)[_i]), (PG8_LAS unsigned*)(lds + (bufoff) + ldsw + _i * 8192), 16, 0, 0); } while (0)
#define PG8_LDA(dst, b, h) do { _Pragma("unroll") for (int m = 0; m < 4; ++m) _Pragma("unroll") for (int k = 0; k < 2; ++k) dst[m][k] = *(const PG8_LAS bf16x8*)(lds + PG8_SA(b, h) + aoff + m * 2048 + k * 1024); } while (0)
#define PG8_LDB(dst, b, h) do { _Pragma("unroll") for (int n = 0; n < 2; ++n) _Pragma("unroll") for (int k = 0; k < 2; ++k) dst[n][k] = *(const PG8_LAS bf16x8*)(lds + PG8_SB(b, h) + boff + n * 2048 + k * 1024); } while (0)
#define PG8_MMA(ai, bj, At, Bt) do { __builtin_amdgcn_s_setprio(1); _Pragma("unroll") for (int m = 0; m < 4; ++m) _Pragma("unroll") for (int n = 0; n < 2; ++n) _Pragma("unroll") for (int k = 0; k < 2; ++k) \
        acc[ai][bj][m][n] = __builtin_amdgcn_mfma_f32_16x16x32_bf16(Bt[n][k], At[m][k], acc[ai][bj][m][n], 0, 0, 0); __builtin_amdgcn_s_setprio(0); } while (0)
#define PG8_WAIT_V(n) asm volatile("s_waitcnt vmcnt(" #n ")" ::: "memory")
#define PG8_WAIT_L(n) asm volatile("s_waitcnt lgkmcnt(" #n ")" ::: "memory")
#define PG8_BAR __builtin_amdgcn_s_barrier()
#define PG8_SCHED __builtin_amdgcn_sched_barrier(0)
    Unit cur, nxt; int ui = 0;
    if (!S.next(0, cur)) return;
    f32x4 acc[2][2][4][2];
#pragma unroll
    for (int a = 0; a < 2; ++a)
#pragma unroll
        for (int b = 0; b < 2; ++b)
#pragma unroll
            for (int m = 0; m < 4; ++m)
#pragma unroll
                for (int n = 0; n < 2; ++n) acc[a][b][m][n] = (f32x4){0.f, 0.f, 0.f, 0.f};
    bf16x8 At[4][2], B0[2][2], B1[2][2];
    const char* cA = (const char*)g.A + (size_t)cur.pm * tstep; const char* cB = (const char*)g.Bt + (size_t)cur.pn * tstep;
    S.a_ready(cur);
    if constexpr (SP2) {
        PG8_STAGE(PG8_SB(0, 0), cB, voffB); PG8_STAGE(PG8_SB(0, 1), cB + hstep, voffB); PG8_STAGE(PG8_SA(0, 0), cA, voffA); PG8_STAGE(PG8_SA(0, 1), cA + hstep, voffA);
        if (wr == 1) PG8_BAR;
        PG8_WAIT_V(2); PG8_BAR;
        PG8_STAGE(PG8_SB(1, 0), cB + kstep, voffB); PG8_STAGE(PG8_SA(1, 0), cA + kstep, voffA); PG8_STAGE(PG8_SB(1, 1), cB + hstep + kstep, voffB);
        PG8_WAIT_V(6); PG8_BAR;
    } else {
        PG8_STAGE(PG8_SB(0, 0), cB, voffB); PG8_STAGE(PG8_SA(0, 0), cA, voffA); PG8_STAGE(PG8_SB(0, 1), cB + hstep, voffB); PG8_STAGE(PG8_SA(0, 1), cA + hstep, voffA);
        if (wr == 1) PG8_BAR;
        PG8_WAIT_V(4); PG8_BAR;
        PG8_STAGE(PG8_SB(1, 0), cB + kstep, voffB); PG8_STAGE(PG8_SA(1, 0), cA + kstep, voffA); PG8_STAGE(PG8_SB(1, 1), cB + hstep + kstep, voffB);
        PG8_WAIT_V(6); PG8_BAR;
    }
    for (;;) {
        const bool has_next = S.next(ui + 1, nxt);
        const char* nA = has_next ? (const char*)g.A + (size_t)nxt.pm * tstep : cA; const char* nB = has_next ? (const char*)g.Bt + (size_t)nxt.pn * tstep : cB;
        for (int t = 0; t < nt; t += 2) {
            const bool last = (t == nt - 2);
            const char* a1 = cA + (size_t)(t + 1) * kstep;
            const char* a2 = last ? nA : cA + (size_t)(t + 2) * kstep; const char* b2 = last ? nB : cB + (size_t)(t + 2) * kstep;
            const char* a3 = a2 + kstep; const char* b3 = b2 + kstep;
            if (last && has_next) S.a_ready(nxt);
            if constexpr (SP2) {
            PG8_LDB(B0, 0, 0); PG8_LDB(B1, 0, 1); PG8_SCHED; PG8_LDA(At, 0, 0); PG8_STAGE(PG8_SA(1, 1), a1 + hstep, voffA);
            PG8_WAIT_V(8); PG8_WAIT_L(0); PG8_BAR; PG8_MMA(0, 0, At, B0); PG8_MMA(0, 1, At, B1); PG8_BAR; PG8_SCHED;
            PG8_LDA(At, 0, 1); PG8_STAGE(PG8_SB(0, 0), b2, voffB); PG8_STAGE(PG8_SB(0, 1), b2 + hstep, voffB); PG8_STAGE(PG8_SA(0, 0), a2, voffA);
            PG8_WAIT_V(8); PG8_WAIT_L(0); PG8_BAR; PG8_MMA(1, 0, At, B0); PG8_MMA(1, 1, At, B1); PG8_BAR; PG8_SCHED;
            PG8_LDB(B0, 1, 0); PG8_LDB(B1, 1, 1); PG8_SCHED; PG8_LDA(At, 1, 0); PG8_STAGE(PG8_SA(0, 1), a2 + hstep, voffA);
            PG8_WAIT_V(8); PG8_WAIT_L(0); PG8_BAR; PG8_MMA(0, 0, At, B0); PG8_MMA(0, 1, At, B1); PG8_BAR; PG8_SCHED;
            PG8_LDA(At, 1, 1); PG8_STAGE(PG8_SB(1, 0), b3, voffB); PG8_STAGE(PG8_SB(1, 1), b3 + hstep, voffB); PG8_STAGE(PG8_SA(1, 0), a3, voffA);
            PG8_WAIT_V(8); PG8_WAIT_L(0); PG8_BAR; PG8_MMA(1, 0, At, B0); PG8_MMA(1, 1, At, B1); PG8_BAR; PG8_SCHED;
            } else {
            PG8_LDB(B0, 0, 0); PG8_SCHED; PG8_LDA(At, 0, 0); PG8_STAGE(PG8_SA(1, 1), a1 + hstep, voffA);
            PG8_WAIT_L(8); PG8_BAR; PG8_WAIT_L(0); PG8_MMA(0, 0, At, B0); PG8_BAR; PG8_SCHED;
            PG8_LDB(B1, 0, 1); PG8_STAGE(PG8_SB(0, 0), b2, voffB);
            PG8_BAR; PG8_WAIT_L(0); PG8_MMA(0, 1, At, B1); PG8_BAR;
            PG8_LDA(At, 0, 1); PG8_STAGE(PG8_SA(0, 0), a2, voffA);
            PG8_BAR; PG8_WAIT_L(0); PG8_MMA(1, 0, At, B0); PG8_BAR; PG8_SCHED;
            PG8_STAGE(PG8_SB(0, 1), b2 + hstep, voffB);
            PG8_WAIT_V(6); PG8_BAR; PG8_MMA(1, 1, At, B1); PG8_BAR;
            PG8_LDB(B0, 1, 0); PG8_SCHED; PG8_LDA(At, 1, 0); PG8_STAGE(PG8_SA(0, 1), a2 + hstep, voffA);
            PG8_WAIT_L(8); PG8_BAR; PG8_WAIT_L(0); PG8_MMA(0, 0, At, B0); PG8_BAR; PG8_SCHED;
            PG8_LDB(B1, 1, 1); PG8_STAGE(PG8_SB(1, 0), b3, voffB);
            PG8_BAR; PG8_WAIT_L(0); PG8_MMA(0, 1, At, B1); PG8_BAR;
            PG8_LDA(At, 1, 1); PG8_STAGE(PG8_SA(1, 0), a3, voffA);
            PG8_BAR; PG8_WAIT_L(0); PG8_MMA(1, 0, At, B0); PG8_BAR; PG8_SCHED;
            PG8_STAGE(PG8_SB(1, 1), b3 + hstep, voffB);
            PG8_WAIT_V(6); PG8_BAR; PG8_MMA(1, 1, At, B1); PG8_BAR;
            }
        }
        if constexpr (ALIGN_EPI) { if (wr == 0) PG8_BAR; }
        if constexpr (!Epi::AFTER_DRAIN) { E(acc, cur, wr, wc, fr, fq); S.done(cur); }
        if (!has_next) break;
#pragma unroll
        for (int a = 0; a < 2; ++a)
#pragma unroll
            for (int b = 0; b < 2; ++b)
#pragma unroll
                for (int m = 0; m < 4; ++m)
#pragma unroll
                    for (int n = 0; n < 2; ++n) acc[a][b][m][n] = (f32x4){0.f, 0.f, 0.f, 0.f};
        cur = nxt; cA = nA; cB = nB; ++ui;
        if constexpr (ALIGN_EPI) { if (wr == 1) PG8_BAR; }
    }
    PG8_WAIT_V(0);
    if constexpr (!ALIGN_EPI) { if (wr == 0) PG8_BAR; }
    PG8_BAR;
    if constexpr (Epi::AFTER_DRAIN) { E.fused(acc, cur, wr, wc, fr, fq, lds, wid, lane); S.done(cur); }
#undef PG8_SA
#undef PG8_SB
#undef PG8_STAGE
#undef PG8_LDA
#undef PG8_LDB
#undef PG8_MMA
#undef PG8_WAIT_V
#undef PG8_WAIT_L
#undef PG8_BAR
#undef PG8_SCHED
}
}

constexpr int NWAVES = 8, NTHREADS = 512;
constexpr int NT = 8192, DM = 2048, SEQ = 2048, NBATCH = 4, DEPTH = 2, CHK = 64, NCHK = 32, GW = 512, NH = 4, HD = 128;
constexpr int DIN = 7200, NINP = 7424, PBW = 7168;
constexpr int NEXP = 16384;
constexpr int PC_GLA_Q = 0, PC_GLA_K = 512, PC_GLA_V = 1024, PC_GLA_G = 1536, PC_LRU_X = 2048, PC_LRU_Y = 2560, PC_ML_Q = 3072, PC_ML_K = 3584, PC_ML_V = 4096, PC_ML_O = 4608,
              PC_GDN_Q = 5120, PC_GDN_K = 5632, PC_GDN_V = 6144, PC_GDN_G = 6656;
constexpr int PS_LR = 0, PS_MI = 16, PS_MF = 20, PS_GB = 24, PS_GA = 28;
constexpr float RMS_EPS = 1e-6f;
enum { I_X = 0, I_N1G, I_WIN, I_WOUT, I_GLA_W2, I_GLA_B2, I_GLA_NG, I_LRU_CW, I_LRU_CB, I_LRU_WA, I_LRU_BA, I_LRU_WX, I_LRU_BX, I_LRU_LAM, I_ML_IB, I_ML_FB, I_ML_NG,
       I_GDN_CW, I_GDN_ALOG, I_GDN_DTB, I_GDN_NG, I_N2G, I_PWQ, I_PK1, I_PK2, I_PU, I_PV, I_FNG, N_IN };

constexpr size_t MiB = 1u << 20;
constexpr size_t WS_CTL = 0, CTL_ZERO_BYTES = 1 * MiB;
constexpr size_t WS_WIN = 2 * MiB;
constexpr size_t WIN_L = (size_t)NINP * DM * 2;
constexpr size_t WS_WOUT = 60 * MiB;
constexpr size_t WS_WQ = 76 * MiB;
constexpr size_t WSQ_L = (size_t)DM * DM * 2;
constexpr size_t WS_K1 = 92 * MiB, WS_K2 = 92 * MiB + 512 * 1024;
constexpr size_t WS_RSTD1 = 93 * MiB;
constexpr size_t WS_SSP = 94 * MiB;
constexpr size_t WS_XB = 96 * MiB;
constexpr size_t WS_P = 128 * MiB;
constexpr size_t WS_PS = 240 * MiB;
constexpr size_t WS_MIX = 242 * MiB;
constexpr size_t WS_Q = 274 * MiB;
constexpr size_t WS_UB = 306 * MiB;
constexpr size_t WS_VB = 434 * MiB;
constexpr size_t TAB_L = (size_t)NEXP * DM * 2;
constexpr size_t WS_SCR = 562 * MiB;
constexpr size_t WS_END = 900 * MiB;

constexpr int LDS_BYTES = 155648;
constexpr int MISC_OFF = LDS_BYTES - 256;

#define GAS __attribute__((address_space(1)))
#define LAS __attribute__((address_space(3)))
typedef unsigned short bf16;
typedef unsigned v4u __attribute__((ext_vector_type(4)));
typedef unsigned v2u __attribute__((ext_vector_type(2)));
typedef float f32x4 __attribute__((ext_vector_type(4)));
typedef float f32x2 __attribute__((ext_vector_type(2)));
typedef short bf16x8 __attribute__((ext_vector_type(8)));
typedef short bf16x4 __attribute__((ext_vector_type(4)));
typedef __bf16 bf2_t __attribute__((ext_vector_type(2)));
typedef GAS unsigned gu32;
#define RLX_AGENT __ATOMIC_RELAXED, __HIP_MEMORY_SCOPE_AGENT
__device__ __forceinline__ unsigned f2bf(float f) { unsigned u = __builtin_bit_cast(unsigned, f); return (u + 0x7fffu + ((u >> 16) & 1u)) >> 16; }
__device__ __forceinline__ unsigned pk2(float lo, float hi) { return f2bf(lo) | (f2bf(hi) << 16); }
__device__ __forceinline__ float bf2f(unsigned b) { return __builtin_bit_cast(float, b << 16); }
__device__ __forceinline__ float bflo(unsigned w) { return __builtin_bit_cast(float, w << 16); }
__device__ __forceinline__ float bfhi(unsigned w) { return __builtin_bit_cast(float, w & 0xffff0000u); }
template <int CTRL> __device__ __forceinline__ unsigned dpp_rot_u(unsigned v) { return (unsigned)__builtin_amdgcn_update_dpp(0, (int)v, CTRL, 0xf, 0xf, false); }
__device__ __forceinline__ unsigned row_max_u(unsigned v) { v = max(v, dpp_rot_u<0x121>(v)); v = max(v, dpp_rot_u<0x122>(v)); v = max(v, dpp_rot_u<0x124>(v)); v = max(v, dpp_rot_u<0x128>(v)); return v; }
template <int CTRL> __device__ __forceinline__ float dpp_rotf(float v) { const unsigned u = __builtin_bit_cast(unsigned, v); return __builtin_bit_cast(float, dpp_rot_u<CTRL>(u)); }
__device__ __forceinline__ float row_max_f(float v) { v = fmaxf(v, dpp_rotf<0x121>(v)); v = fmaxf(v, dpp_rotf<0x122>(v)); v = fmaxf(v, dpp_rotf<0x124>(v)); v = fmaxf(v, dpp_rotf<0x128>(v)); return v; }
__device__ __forceinline__ float row_sum_f(float v) { v += dpp_rotf<0x121>(v); v += dpp_rotf<0x122>(v); v += dpp_rotf<0x124>(v); v += dpp_rotf<0x128>(v); return v; }

__device__ __forceinline__ float oct_sum_f(float v) { v += dpp_rotf<0xB1>(v); v += dpp_rotf<0x4E>(v); v += dpp_rotf<0x141>(v); return v; }
__device__ __forceinline__ float lane_bcast(float v, int l) { return __builtin_bit_cast(float, __builtin_amdgcn_readlane(__builtin_bit_cast(int, v), l)); }
__device__ __forceinline__ float wave_sum(float v) { const float r = row_sum_f(v); return (lane_bcast(r, 0) + lane_bcast(r, 16)) + (lane_bcast(r, 32) + lane_bcast(r, 48)); }
__device__ __forceinline__ float wave_max(float v) { const float r = row_max_f(v); return fmaxf(fmaxf(lane_bcast(r, 0), lane_bcast(r, 16)), fmaxf(lane_bcast(r, 32), lane_bcast(r, 48))); }
__device__ __forceinline__ float rcpf_(float x) { return __builtin_amdgcn_rcpf(x); }
__device__ __forceinline__ float sigmoidf_(float x) { return rcpf_(1.0f + __expf(-x)); }
__device__ __forceinline__ float siluf_(float x) { return x * rcpf_(1.0f + __expf(-x)); }
__device__ __forceinline__ float softplusf_(float x) { return fmaxf(x, 0.f) + __logf(1.0f + __expf(-fabsf(x))); }
__device__ __forceinline__ float logsigmoidf_(float x) { return fminf(x, 0.f) - __logf(1.0f + __expf(-fabsf(x))); }
__device__ __forceinline__ float gelu_tanh(float x) { const float u = 1.5957691216057308f * (x + 0.044715f * x * x * x); return x * rcpf_(1.0f + __expf(-u)); }

#define XB_TMO      128
#define XB_XCNT(j)  (256  + 64 * (j))
#define XB_XSUB(j)  (1280 + 64 * (j))
#define XB_XGEN(j)  (2304 + 64 * (j))
#define XB_TOP      3328
#define XB_TOPGEN   3392
#define XCD_BAR_WORDS 3456
#define XB_SPIN_CAP (1u << 18)

__device__ __forceinline__ unsigned xb_ld(unsigned* p)              { return __hip_atomic_load(p, __ATOMIC_RELAXED, __HIP_MEMORY_SCOPE_AGENT); }
__device__ __forceinline__ unsigned xb_add(unsigned* p, unsigned v) { return __hip_atomic_fetch_add(p, v, __ATOMIC_RELAXED, __HIP_MEMORY_SCOPE_AGENT); }
__device__ __forceinline__ unsigned xb_xcc_id() { return (unsigned)__builtin_amdgcn_s_getreg((3 << 11) | 20) & 0xFu; }
#define XB_SPIN(cond, bar) do { unsigned _sp = 0; while (cond) { __builtin_amdgcn_s_sleep(1); \
    if ((++_sp & 255u) == 0u) { if (xb_ld(&(bar)[XB_TMO])) break; if (_sp > XB_SPIN_CAP) { atomicAdd(&(bar)[XB_TMO], 1u); break; } } } } while (0)

struct XcdBarrier {
    unsigned* bar; unsigned x;
    volatile LAS unsigned* st;
};

__device__ __forceinline__ XcdBarrier xcd_barrier_post(unsigned* bar, volatile LAS unsigned* st) {
    XcdBarrier b; b.bar = bar; b.x = xb_xcc_id(); b.st = st;
    if (threadIdx.x == 0) (void)xb_add(&bar[XB_XCNT(b.x)], 1u);
    return b;
}
__device__ __forceinline__ void xcd_barrier_complete(unsigned* bar, unsigned x, unsigned& nloc, unsigned& nx) {
    const unsigned G = gridDim.x * gridDim.y * gridDim.z;
    unsigned sum, cnt, mine, sp = 0u;
    for (;;) {
        sum = 0u; cnt = 0u; mine = 0u;
#pragma unroll
        for (unsigned j = 0; j < 16; ++j) { const unsigned c = xb_ld(&bar[XB_XCNT(j)]); sum += c; cnt += (c > 0u) ? 1u : 0u; mine = (j == x) ? c : mine; }
        if (sum == G) break;
        __builtin_amdgcn_s_sleep(1);
        if ((++sp & 255u) == 0u) { if (xb_ld(&bar[XB_TMO])) break; if (sp > XB_SPIN_CAP) { atomicAdd(&bar[XB_TMO], 1u); break; } }
    }
    nloc = mine > 0u ? mine : 1u; nx = cnt > 0u ? cnt : 1u;
}

__device__ __forceinline__ void xcd_barrier(const XcdBarrier& b) {
    asm volatile("s_waitcnt vmcnt(0)" ::: "memory");
    __syncthreads();
    if (threadIdx.x == 0) {
        unsigned* bar = b.bar; asm volatile("" : "+s"(bar));
        __builtin_amdgcn_s_waitcnt(0);
        unsigned nloc = b.st[0], nx = b.st[1];
        if (nloc == 0u) { xcd_barrier_complete(bar, b.x, nloc, nx); b.st[0] = nloc; b.st[1] = nx; }
        const unsigned old = xb_add(&bar[XB_XSUB(b.x)], 1u);
        const unsigned gen = old / nloc;
        if (old + 1u == (gen + 1u) * nloc) {
            __builtin_amdgcn_fence(__ATOMIC_RELEASE, "agent");
            asm volatile("s_waitcnt vmcnt(0)" ::: "memory");
            const unsigned og = xb_add(&bar[XB_TOP], 1u);
            const unsigned tg = og / nx;
            if (og + 1u == (tg + 1u) * nx) xb_add(&bar[XB_TOPGEN], 1u);
            else XB_SPIN(xb_ld(&bar[XB_TOPGEN]) == tg, bar);
            __builtin_amdgcn_fence(__ATOMIC_ACQUIRE, "agent");
            xb_add(&bar[XB_XGEN(b.x)], 1u);
            asm volatile("s_waitcnt vmcnt(0)" ::: "memory");
        } else {
            XB_SPIN(xb_ld(&bar[XB_XGEN(b.x)]) == gen, bar);
            __builtin_amdgcn_fence(__ATOMIC_ACQUIRE, "agent");
            asm volatile("s_waitcnt vmcnt(0)" ::: "memory");
        }
    }
    __syncthreads();
}


struct Args { const float* in[N_IN]; float* out; unsigned char* ws; int ph_lo, ph_hi, li, pad; };
typedef const __attribute__((address_space(4))) Args& ArgsR;
__device__ __forceinline__ const __attribute__((address_space(4))) Args* kargs() { unsigned long long p = (unsigned long long)__builtin_amdgcn_kernarg_segment_ptr(); asm volatile("" : "+s"(p)); return (const __attribute__((address_space(4))) Args*)p; }

__device__ __forceinline__ int win_src_col(int n) {
    if (n < 2048) return n;
    if (n < 3072) return 2064 + (n - 2048);
    if (n < 5120) return 3088 + (n - 3072);
    if (n < 7168) return 5144 + (n - 5120);
    if (n < 7184) return 2048 + (n - 7168);
    if (n < 7192) return 5136 + (n - 7184);
    if (n < 7200) return n;
    return -1;
}
template <bool MAP>
__device__ __forceinline__ void p0_transpose_item(const float* W, int K, int Nsrc, int Ndst, const float* gain, bf16* WT, LAS float* scr, int item, int lane) {
    const int nblk = Ndst / 32, kb = item / nblk, nb = item % nblk, k0 = 64 * kb, n0 = 32 * nb;
    const int nn = n0 + (lane & 31); const int src = MAP ? win_src_col(nn) : nn;
    float tv[32];
#pragma unroll
    for (int i = 0; i < 32; ++i) { const int kk = 2 * i + (lane >> 5); tv[i] = (src >= 0) ? W[(size_t)(k0 + kk) * Nsrc + src] : 0.f; }
#pragma unroll
    for (int i = 0; i < 32; ++i) { const int kk = 2 * i + (lane >> 5); float v = tv[i]; if (gain) v *= gain[k0 + kk]; scr[kk * 33 + (lane & 31)] = v; }
    asm volatile("s_waitcnt lgkmcnt(0)" ::: "memory");
    const int c = lane & 7;
#pragma unroll
    for (int j = 0; j < 4; ++j) { const int n = (lane >> 3) + 8 * j; const LAS float* s = scr + (8 * c) * 33 + n;
        v4u o; o.x = pk2(s[0 * 33], s[1 * 33]); o.y = pk2(s[2 * 33], s[3 * 33]); o.z = pk2(s[4 * 33], s[5 * 33]); o.w = pk2(s[6 * 33], s[7 * 33]);
        *(GAS v4u*)(WT + (size_t)(n0 + n) * K + k0 + 8 * c) = o; }
    asm volatile("s_waitcnt lgkmcnt(0)" ::: "memory");
}
__device__ __forceinline__ void p0_convert(const float* src, bf16* dst, size_t n, size_t gtid, size_t gthreads) {
    for (size_t i = gtid * 8; i < n; i += gthreads * 8) {
        const f32x4 a = *(const GAS f32x4*)(src + i), b = *(const GAS f32x4*)(src + i + 4);
        v4u o; o.x = pk2(a[0], a[1]); o.y = pk2(a[2], a[3]); o.z = pk2(b[0], b[1]); o.w = pk2(b[2], b[3]);
        *(GAS v4u*)(dst + i) = o; }
}
__device__ __forceinline__ void p0_prologue(ArgsR A, LAS unsigned char* lds, int vcu, int G, int wave, int lane) {
    unsigned char* ws = A.ws;
    LAS float* scr = (LAS float*)(lds + wave * 16384);
    const int gw = vcu * NWAVES + wave, NGW = G * NWAVES;
    constexpr int I_IN = (DM / 64) * (NINP / 32), I_SQ = (DM / 64) * (DM / 32), I_LAYER = I_IN + 2 * I_SQ, NITEMS = DEPTH * I_LAYER;
    for (int it = gw; it < NITEMS; it += NGW) {
        const int l = it / I_LAYER; int r = it % I_LAYER;
        if (r < I_IN) { p0_transpose_item<true>(A.in[I_WIN] + (size_t)l * DM * DIN, DM, DIN, NINP, A.in[I_N1G] + l * DM, (bf16*)(ws + WS_WIN + l * WIN_L), scr, r, lane); continue; } r -= I_IN;
        if (r < I_SQ) { p0_transpose_item<false>(A.in[I_WOUT] + (size_t)l * DM * DM, DM, DM, DM, nullptr, (bf16*)(ws + WS_WOUT + l * WSQ_L), scr, r, lane); continue; } r -= I_SQ;
        p0_transpose_item<false>(A.in[I_PWQ] + (size_t)l * DM * DM, DM, DM, DM, A.in[I_N2G] + l * DM, (bf16*)(ws + WS_WQ + l * WSQ_L), scr, r, lane);
    }
    const size_t gtid = (size_t)gw * 64 + lane, gthreads = (size_t)NGW * 64;
    p0_convert(A.in[I_PK1], (bf16*)(ws + WS_K1), (size_t)DEPTH * 8 * 128 * 128, gtid, gthreads);
    p0_convert(A.in[I_PK2], (bf16*)(ws + WS_K2), (size_t)DEPTH * 8 * 128 * 128, gtid, gthreads);
    const float* x = A.in[I_X]; bf16* xb = (bf16*)(ws + WS_XB); float* rstd1 = (float*)(ws + WS_RSTD1);
    for (int m = gw; m < NT; m += NGW) {
        const GAS f32x4* xr = (const GAS f32x4*)(x + (size_t)m * DM) + lane;
        f32x4 v[8]; float s = 0.f;
#pragma unroll
        for (int j = 0; j < 8; ++j) { v[j] = xr[64 * j]; s += (v[j][0] * v[j][0] + v[j][1] * v[j][1]) + (v[j][2] * v[j][2] + v[j][3] * v[j][3]); }
        s = wave_sum(s);
        GAS v2u* o = (GAS v2u*)(xb + (size_t)m * DM) + lane;
#pragma unroll
        for (int j = 0; j < 8; ++j) { v2u w; w.x = pk2(v[j][0], v[j][1]); w.y = pk2(v[j][2], v[j][3]); o[64 * j] = w; }
        if (lane == 0) rstd1[m] = rsqrtf(s * (1.0f / DM) + RMS_EPS);
    }
}

constexpr size_t WS_GLA_INC = 562 * MiB;
constexpr size_t WS_GLA_DEC = 594 * MiB;
constexpr size_t WS_GLA_ST = 595 * MiB;
constexpr size_t WS_ML_INC = 611 * MiB;
constexpr size_t WS_ML_N = 643 * MiB;
constexpr size_t WS_ML_SC = 643 * MiB + 512 * 1024;
constexpr size_t WS_ML_ST = 644 * MiB;
constexpr size_t WS_ML_NP = 660 * MiB;
constexpr size_t WS_ML_MP = 660 * MiB + 512 * 1024;
constexpr size_t WS_GDN_U0 = 661 * MiB, WS_GDN_W = 669 * MiB, WS_GDN_QD = 677 * MiB, WS_GDN_KE = 685 * MiB;
constexpr size_t WS_GDN_QK = 693 * MiB;
constexpr size_t WS_GDN_DE = 697 * MiB;
constexpr size_t WS_GDN_O = 698 * MiB;
constexpr size_t WS_LRU_HL = 714 * MiB, WS_LRU_AP = 730 * MiB;
constexpr size_t WS_LRU_CARRY = 746 * MiB;
static_assert(WS_LRU_CARRY + 4 * 32 * 512 * 4 <= WS_END, "ws map");

constexpr int CW_PBAR = 2048;
typedef short v4i16_t __attribute__((ext_vector_type(4)));
constexpr int LD128 = 136, LD64 = 72;

__device__ __forceinline__ bf16x8 frag_rd(const LAS bf16* t, int ld, int row0, int k0, int lane) { return *(const LAS bf16x8*)(t + (row0 + (lane & 15)) * ld + k0 + 8 * (lane >> 4)); }
__device__ __forceinline__ bf16x8 frag_rd_perm(const LAS bf16* t, int ld, int row0, int k0, int lane) {
    const LAS bf16* p = t + (row0 + (lane & 15)) * ld + k0 + 4 * (lane >> 4);
    const bf16x4 a = *(const LAS bf16x4*)p, b = *(const LAS bf16x4*)(p + 16);
    return (bf16x8){a[0], a[1], a[2], a[3], b[0], b[1], b[2], b[3]};
}
__device__ __forceinline__ bf16x8 frag_tr(const LAS bf16* t, int ld, int k0, int n0, int lane) {
    const int i = lane & 15, g = lane >> 4; const LAS bf16* p = t + (k0 + 8 * g + (i >> 2)) * ld + n0 + 4 * (i & 3);
    const v4i16_t a = __builtin_amdgcn_ds_read_tr16_b64_v4i16((LAS v4i16_t*)p), b = __builtin_amdgcn_ds_read_tr16_b64_v4i16((LAS v4i16_t*)(p + 4 * ld));
    return (bf16x8){a[0], a[1], a[2], a[3], b[0], b[1], b[2], b[3]};
}
__device__ __forceinline__ bf16x8 frag_tr_perm(const LAS bf16* t, int ld, int k0, int n0, int lane) {
    const int i = lane & 15, g = lane >> 4; const LAS bf16* p = t + (k0 + 4 * g + (i >> 2)) * ld + n0 + 4 * (i & 3);
    const v4i16_t a = __builtin_amdgcn_ds_read_tr16_b64_v4i16((LAS v4i16_t*)p), b = __builtin_amdgcn_ds_read_tr16_b64_v4i16((LAS v4i16_t*)(p + 16 * ld));
    return (bf16x8){a[0], a[1], a[2], a[3], b[0], b[1], b[2], b[3]};
}
__device__ __forceinline__ bf16x8 pack_acc(const f32x4& lo, const f32x4& hi) {
    v4u w; w.x = pg8::cvt_pk_bf16(lo[0], lo[1]); w.y = pg8::cvt_pk_bf16(lo[2], lo[3]); w.z = pg8::cvt_pk_bf16(hi[0], hi[1]); w.w = pg8::cvt_pk_bf16(hi[2], hi[3]);
    return __builtin_bit_cast(bf16x8, w);
}
#define MFMA16(a, b, c) __builtin_amdgcn_mfma_f32_16x16x32_bf16((a), (b), (c), 0, 0, 0)

template <int ROWS>
__device__ __forceinline__ void tile_g2l_128(const bf16* g, size_t gld, LAS bf16* t, int tid) {
#pragma unroll
    for (int i = 0; i < ROWS * 16 / NTHREADS; ++i) { const int idx = tid + i * NTHREADS, r = idx >> 4, c8 = (idx & 15) * 8;
        *(LAS v4u*)(t + r * LD128 + c8) = *(const GAS v4u*)(g + (size_t)r * gld + c8); }
}
template <int CTRL> __device__ __forceinline__ float dpp_shr_f(float v, float ident) { return __builtin_bit_cast(float, __builtin_amdgcn_update_dpp(__builtin_bit_cast(int, ident), __builtin_bit_cast(int, v), CTRL, 0xf, 0xf, false)); }
__device__ __forceinline__ float wave_scan_add(float v, int lane) {
    v += dpp_shr_f<0x111>(v, 0.f); v += dpp_shr_f<0x112>(v, 0.f); v += dpp_shr_f<0x114>(v, 0.f); v += dpp_shr_f<0x118>(v, 0.f);
    const float t0 = lane_bcast(v, 15), t1 = lane_bcast(v, 31), t2 = lane_bcast(v, 47); const int row = lane >> 4;
    return v + (row == 0 ? 0.f : row == 1 ? t0 : row == 2 ? t0 + t1 : (t0 + t1) + t2);
}
__device__ __forceinline__ float wave_scan_max(float v, int lane) {
    const float ninf = -__builtin_inff();
    v = fmaxf(v, dpp_shr_f<0x111>(v, ninf)); v = fmaxf(v, dpp_shr_f<0x112>(v, ninf)); v = fmaxf(v, dpp_shr_f<0x114>(v, ninf)); v = fmaxf(v, dpp_shr_f<0x118>(v, ninf));
    const float t0 = lane_bcast(v, 15), t1 = lane_bcast(v, 31), t2 = lane_bcast(v, 47); const int row = lane >> 4;
    return fmaxf(v, row == 0 ? ninf : row == 1 ? t0 : row == 2 ? fmaxf(t0, t1) : fmaxf(fmaxf(t0, t1), t2));
}

__device__ __forceinline__ void f_lru_p2(ArgsR A, int l, int item, LAS unsigned char* lds, int tid) {
    const int j = item & 7, n = (item >> 3) & 31, b = item >> 8;
    const bf16* P = (const bf16*)(A.ws + WS_P); float* HLg = (float*)(A.ws + WS_LRU_HL); float* APg = (float*)(A.ws + WS_LRU_AP);
    LAS float* xc = (LAS float*)(lds); LAS float* was = (LAS float*)(lds + 20480); LAS float* wxs = (LAS float*)(lds + 36864);
    LAS float* aa = (LAS float*)(lds + 53248); LAS float* uu = (LAS float*)(lds + 69632); LAS float* segA = (LAS float*)(lds + 86016); LAS float* segH = (LAS float*)(lds + 88064);
    const float* wa = A.in[I_LRU_WA] + ((size_t)l * 8 + j) * 4096; const float* wx = A.in[I_LRU_WX] + ((size_t)l * 8 + j) * 4096;
    for (int i = tid; i < 4096; i += NTHREADS) { was[i] = wa[i]; wxs[i] = wx[i]; }
    const float* cw = A.in[I_LRU_CW] + (size_t)l * 4 * GW; const float* cb = A.in[I_LRU_CB] + l * GW;
    const float* ba = A.in[I_LRU_BA] + l * GW + j * 64; const float* bx = A.in[I_LRU_BX] + l * GW + j * 64; const float* lam = A.in[I_LRU_LAM] + l * GW + j * 64;
    const size_t r0 = (size_t)b * SEQ + n * CHK;
    float ba8[8], bx8[8], lam8[8];
#pragma unroll
    for (int q = 0; q < 8; ++q) { ba8[q] = ba[(tid & 7) * 8 + q]; bx8[q] = bx[(tid & 7) * 8 + q]; lam8[q] = lam[(tid & 7) * 8 + q]; }
    { const int cc = tid & 63, c0 = (tid >> 6) * 8, ch = j * 64 + cc, pc = PC_LRU_X + ch; const long t0 = (long)n * CHK + c0;
        const float w0 = cw[ch], w1 = cw[GW + ch], w2 = cw[2 * GW + ch], w3 = cw[3 * GW + ch], bias = cb[ch];
        float xm3 = (t0 - 3 >= 0) ? bf2f(P[(r0 + c0 - 3) * PBW + pc]) : 0.f, xm2 = (t0 - 2 >= 0) ? bf2f(P[(r0 + c0 - 2) * PBW + pc]) : 0.f, xm1 = (t0 - 1 >= 0) ? bf2f(P[(r0 + c0 - 1) * PBW + pc]) : 0.f;
#pragma unroll
        for (int i = 0; i < 8; ++i) { const float x0 = bf2f(P[(r0 + c0 + i) * PBW + pc]); xc[(c0 + i) * 65 + cc] = w0 * xm3 + w1 * xm2 + w2 * xm1 + w3 * x0 + bias; xm3 = xm2; xm2 = xm1; xm1 = x0; } }
    __syncthreads();
    { const int tok = tid >> 3, cg = tid & 7; float ra[8], ri[8], spl[8];
#pragma unroll
        for (int q = 0; q < 8; ++q) { ra[q] = ba8[q]; ri[q] = bx8[q]; spl[q] = softplusf_(-lam8[q]); }
#pragma unroll 4
        for (int i = 0; i < 64; ++i) { const float xv = xc[tok * 65 + i];
            const f32x4 a0 = *(const LAS f32x4*)(was + i * 64 + cg * 8), a1 = *(const LAS f32x4*)(was + i * 64 + cg * 8 + 4);
            const f32x4 x0 = *(const LAS f32x4*)(wxs + i * 64 + cg * 8), x1 = *(const LAS f32x4*)(wxs + i * 64 + cg * 8 + 4);
#pragma unroll
            for (int q = 0; q < 4; ++q) { ra[q] += xv * a0[q]; ra[4 + q] += xv * a1[q]; ri[q] += xv * x0[q]; ri[4 + q] += xv * x1[q]; } }
#pragma unroll
        for (int q = 0; q < 8; ++q) { const int jj = cg * 8 + q; const float r = sigmoidf_(ra[q]), ig = sigmoidf_(ri[q]);
            const float log_a = -8.0f * r * spl[q]; const float a = __expf(log_a), u = sqrtf(fmaxf(1.0f - a * a, 0.f)) * (ig * xc[tok * 65 + jj]);
            aa[tok * 64 + jj] = a; uu[tok * 64 + jj] = u; } }
    __syncthreads();
    const int cc = tid & 63, seg = tid >> 6;
    { float Ap = 1.f, Hl = 0.f;
#pragma unroll
        for (int i = 0; i < 8; ++i) { const int c = seg * 8 + i; const float a = aa[c * 64 + cc], u = uu[c * 64 + cc]; Hl = a * Hl + u; Ap *= a; aa[c * 64 + cc] = Ap; uu[c * 64 + cc] = Hl; }
        segA[seg * 64 + cc] = Ap; segH[seg * 64 + cc] = Hl; }
    __syncthreads();
    { float Ac = 1.f, Hc = 0.f;
#pragma unroll 1
        for (int s = 0; s < seg; ++s) { const float sa = segA[s * 64 + cc]; Hc = sa * Hc + segH[s * 64 + cc]; Ac *= sa; }
#pragma unroll
        for (int i = 0; i < 8; ++i) { const int c = seg * 8 + i; const float ap = aa[c * 64 + cc], hl = uu[c * 64 + cc];
            HLg[(r0 + c) * GW + j * 64 + cc] = ap * Hc + hl; APg[(r0 + c) * GW + j * 64 + cc] = ap * Ac; } }
    __syncthreads();
}
__device__ __forceinline__ void f_lru_p3(ArgsR A, int b, int tid) {
    const float* HLg = (const float*)(A.ws + WS_LRU_HL); const float* APg = (const float*)(A.ws + WS_LRU_AP); float* carry = (float*)(A.ws + WS_LRU_CARRY);
    float c = 0.f;
#pragma unroll 8
    for (int n = 0; n < NCHK; ++n) { carry[((size_t)b * NCHK + n) * GW + tid] = c; const size_t t = (size_t)b * SEQ + n * CHK + 63; c = APg[t * GW + tid] * c + HLg[t * GW + tid]; }
}
__device__ __forceinline__ void f_lru_p4(ArgsR A, int item, int tid) {
    const bf16* P = (const bf16*)(A.ws + WS_P); bf16* mix = (bf16*)(A.ws + WS_MIX);
    const float* HLg = (const float*)(A.ws + WS_LRU_HL); const float* APg = (const float*)(A.ws + WS_LRU_AP); const float* carry = (const float*)(A.ws + WS_LRU_CARRY);
    const float cr = carry[(size_t)item * GW + tid]; const size_t r0 = (size_t)item * CHK;
#pragma unroll 8
    for (int c = 0; c < CHK; ++c) { const float h = APg[(r0 + c) * GW + tid] * cr + HLg[(r0 + c) * GW + tid]; const float y = bf2f(P[(r0 + c) * PBW + PC_LRU_Y + tid]);
        mix[(r0 + c) * DM + 512 + tid] = (bf16)f2bf(gelu_tanh(y) * h); }
}

constexpr int FL_Q = 0, FL_K = 17408, FL_V = 34816, FL_ST = 52224, FL_SC = 87040, FL_BC = 96256, FL_LR = 129024, FL_SEG = 133120, FL_RS = 135168;
struct GlaW2 { float w[16]; float b2; };
__device__ __forceinline__ void gla_w2_load(ArgsR A, int l, int h, int tid, GlaW2& W) {
    const int d = tid & 127; const float* w2 = A.in[I_GLA_W2] + (size_t)l * 16 * GW + h * HD + d;
#pragma unroll
    for (int r = 0; r < 16; ++r) W.w[r] = w2[r * GW];
    W.b2 = A.in[I_GLA_B2][l * GW + h * HD + d];
}
__device__ __forceinline__ void gla_bcum(const GlaW2& W, LAS float* bc, LAS float* segt, const LAS float* lrs, int tid) {
    const int d = tid & 127, seg = tid >> 7; float run = 0.f;
#pragma unroll 4
    for (int i = 0; i < 16; ++i) { const int c = seg * 16 + i; float z = W.b2;
#pragma unroll
        for (int r = 0; r < 16; ++r) z += lrs[c * 16 + r] * W.w[r];
        run += logsigmoidf_(z) * (1.0f / 16.0f); bc[c * 128 + d] = run; }
    segt[seg * 128 + d] = run;
}
__device__ __forceinline__ void f_gla_p2(ArgsR A, int l, int item, LAS unsigned char* lds, int tid) {
    const int n = item & 31, h = (item >> 5) & 3, b = item >> 7; const int lane = tid & 63, wave = __builtin_amdgcn_readfirstlane(tid >> 6);
    const bf16* P = (const bf16*)(A.ws + WS_P); const float* Ps = (const float*)(A.ws + WS_PS);
    float* inc = (float*)(A.ws + WS_GLA_INC) + (size_t)item * 16384; float* dec = (float*)(A.ws + WS_GLA_DEC) + (size_t)item * 128;
    LAS bf16* ks = (LAS bf16*)(lds + FL_K); LAS bf16* vs = (LAS bf16*)(lds + FL_V); LAS float* bc = (LAS float*)(lds + FL_BC); LAS float* lrs = (LAS float*)(lds + FL_LR); LAS float* segt = (LAS float*)(lds + FL_SEG);
    const size_t r0 = (size_t)b * SEQ + n * CHK;
    GlaW2 W2; gla_w2_load(A, l, h, tid, W2);
    tile_g2l_128<64>(P + r0 * PBW + PC_GLA_K + h * HD, PBW, ks, tid);
    tile_g2l_128<64>(P + r0 * PBW + PC_GLA_V + h * HD, PBW, vs, tid);
    for (int i = tid; i < 64 * 16; i += NTHREADS) lrs[i] = Ps[(r0 + (i >> 4)) * 32 + PS_LR + (i & 15)];
    __syncthreads();
    gla_bcum(W2, bc, segt, lrs, tid);
    __syncthreads();
    { const int d = tid & 127, seg = tid >> 7; float pre = 0.f, tot = 0.f;
#pragma unroll
        for (int s = 0; s < 4; ++s) { const float v = segt[s * 128 + d]; if (s < seg) pre += v; tot += v; }
#pragma unroll 4
        for (int i = 0; i < 16; ++i) { const int c = seg * 16 + i; const float bcm = bc[c * 128 + d] + pre; ks[c * LD128 + d] = (bf16)f2bf(bf2f(ks[c * LD128 + d]) * __expf(tot - bcm)); }
        if (seg == 0) dec[d] = __expf(tot); }
    __syncthreads();
    { f32x4 acc[8];
#pragma unroll
        for (int nt = 0; nt < 8; ++nt) acc[nt] = (f32x4){0.f, 0.f, 0.f, 0.f};
#pragma unroll
        for (int kk = 0; kk < 2; ++kk) { const bf16x8 af = frag_tr(vs, LD128, 32 * kk, 16 * wave, lane);
#pragma unroll
            for (int nt = 0; nt < 8; ++nt) acc[nt] = MFMA16(af, frag_tr(ks, LD128, 32 * kk, 16 * nt, lane), acc[nt]); }
        const int fr = lane & 15, fq = lane >> 4;
#pragma unroll
        for (int nt = 0; nt < 8; ++nt)
#pragma unroll
            for (int r = 0; r < 4; ++r) inc[(16 * wave + 4 * fq + r) * 128 + 16 * nt + fr] = acc[nt][r]; }
    __syncthreads();
}
__device__ __forceinline__ void f_gla_p3(ArgsR A, int item, int tid) {
    const int bh = item >> 4, sl = item & 15; const int e = sl * 1024 + tid * 2, d = e & 127;
    const float* inc = (const float*)(A.ws + WS_GLA_INC) + (size_t)bh * 32 * 16384 + e; const float* dec = (const float*)(A.ws + WS_GLA_DEC) + (size_t)bh * 32 * 128 + d;
    bf16* st = (bf16*)(A.ws + WS_GLA_ST) + (size_t)bh * 32 * 16384 + e;
    float s0 = 0.f, s1 = 0.f;
#pragma unroll 8
    for (int n = 0; n < NCHK; ++n) { *(GAS unsigned*)(st + (size_t)n * 16384) = pk2(s0, s1);
        const f32x2 iv = *(const GAS f32x2*)(inc + (size_t)n * 16384), dv = *(const GAS f32x2*)(dec + (size_t)n * 128); s0 = dv[0] * s0 + iv[0]; s1 = dv[1] * s1 + iv[1]; }
}
__device__ __forceinline__ void f_gla_p4(ArgsR A, int l, int item, LAS unsigned char* lds, int tid) {
    const int n = item & 31, h = (item >> 5) & 3, b = item >> 7; const int lane = tid & 63, wave = __builtin_amdgcn_readfirstlane(tid >> 6), fr = lane & 15, fq = lane >> 4;
    const bf16* P = (const bf16*)(A.ws + WS_P); const float* Ps = (const float*)(A.ws + WS_PS); bf16* mix = (bf16*)(A.ws + WS_MIX);
    const bf16* stg = (const bf16*)(A.ws + WS_GLA_ST) + (size_t)item * 16384;
    LAS bf16* qs = (LAS bf16*)(lds + FL_Q); LAS bf16* ks = (LAS bf16*)(lds + FL_K); LAS bf16* vs = (LAS bf16*)(lds + FL_V); LAS bf16* sts = (LAS bf16*)(lds + FL_ST); LAS bf16* scs = (LAS bf16*)(lds + FL_SC);
    LAS float* bc = (LAS float*)(lds + FL_BC); LAS float* lrs = (LAS float*)(lds + FL_LR); LAS float* segt = (LAS float*)(lds + FL_SEG); LAS float* rsp = (LAS float*)(lds + FL_RS);
    const size_t r0 = (size_t)b * SEQ + n * CHK;
    GlaW2 W2; gla_w2_load(A, l, h, tid, W2);
    const float gn = A.in[I_GLA_NG][l * GW + h * HD + 16 * wave + fr];
    float gt[4][4];
#pragma unroll
    for (int mt = 0; mt < 4; ++mt)
#pragma unroll
        for (int r = 0; r < 4; ++r) gt[mt][r] = bf2f(P[(r0 + 16 * mt + 4 * fq + r) * PBW + PC_GLA_G + h * HD + 16 * wave + fr]);
    tile_g2l_128<64>(P + r0 * PBW + PC_GLA_Q + h * HD, PBW, qs, tid);
    tile_g2l_128<64>(P + r0 * PBW + PC_GLA_K + h * HD, PBW, ks, tid);
    tile_g2l_128<64>(P + r0 * PBW + PC_GLA_V + h * HD, PBW, vs, tid);
    tile_g2l_128<128>(stg, 128, sts, tid);
    for (int i = tid; i < 64 * 16; i += NTHREADS) lrs[i] = Ps[(r0 + (i >> 4)) * 32 + PS_LR + (i & 15)];
    __syncthreads();
    gla_bcum(W2, bc, segt, lrs, tid);
    __syncthreads();
    { const int d = tid & 127, seg = tid >> 7; float pre = 0.f;
#pragma unroll
        for (int s = 0; s < 4; ++s) { const float v = segt[s * 128 + d]; if (s < seg) pre += v; }
#pragma unroll 4
        for (int i = 0; i < 16; ++i) { const int c = seg * 16 + i; const float bcm = bc[c * 128 + d] + pre;
            qs[c * LD128 + d] = (bf16)f2bf(bf2f(qs[c * LD128 + d]) * __expf(bcm) * 0.08838834764831845f); ks[c * LD128 + d] = (bf16)f2bf(bf2f(ks[c * LD128 + d]) * __expf(-bcm)); } }
    __syncthreads();
    { const int mt = wave >> 1; f32x4 acc[2] = {{0.f, 0.f, 0.f, 0.f}, {0.f, 0.f, 0.f, 0.f}};
#pragma unroll
        for (int kk = 0; kk < 4; ++kk) { const bf16x8 af = frag_rd(qs, LD128, 16 * mt, 32 * kk, lane);
#pragma unroll
            for (int q = 0; q < 2; ++q) acc[q] = MFMA16(af, frag_rd(ks, LD128, 16 * (2 * (wave & 1) + q), 32 * kk, lane), acc[q]); }
#pragma unroll
        for (int q = 0; q < 2; ++q) { const int s = 16 * (2 * (wave & 1) + q) + fr;
#pragma unroll
            for (int r = 0; r < 4; ++r) { const int c = 16 * mt + 4 * fq + r; scs[c * LD64 + s] = (bf16)f2bf(s <= c ? acc[q][r] : 0.f); } } }
    __syncthreads();
    f32x4 o[4];
#pragma unroll
    for (int mt = 0; mt < 4; ++mt) o[mt] = (f32x4){0.f, 0.f, 0.f, 0.f};
#pragma unroll
    for (int kk = 0; kk < 2; ++kk) { const bf16x8 bfv = frag_tr(vs, LD128, 32 * kk, 16 * wave, lane);
#pragma unroll
        for (int mt = 0; mt < 4; ++mt) o[mt] = MFMA16(frag_rd(scs, LD64, 16 * mt, 32 * kk, lane), bfv, o[mt]); }
#pragma unroll
    for (int kk = 0; kk < 4; ++kk) { const bf16x8 bfs = frag_rd(sts, LD128, 16 * wave, 32 * kk, lane);
#pragma unroll
        for (int mt = 0; mt < 4; ++mt) o[mt] = MFMA16(frag_rd(qs, LD128, 16 * mt, 32 * kk, lane), bfs, o[mt]); }
#pragma unroll
    for (int mt = 0; mt < 4; ++mt)
#pragma unroll
        for (int r = 0; r < 4; ++r) { float s = o[mt][r] * o[mt][r]; s = row_sum_f(s);
            if (fr == 0) rsp[wave * 64 + 16 * mt + 4 * fq + r] = s; }
    __syncthreads();
#pragma unroll
    for (int mt = 0; mt < 4; ++mt)
#pragma unroll
        for (int r = 0; r < 4; ++r) { const int c = 16 * mt + 4 * fq + r; float ss = 0.f;
#pragma unroll
            for (int w = 0; w < 8; ++w) ss += rsp[w * 64 + c];
            const float rs = rsqrtf(ss * (1.0f / 128.0f) + RMS_EPS);
            mix[(r0 + c) * DM + h * HD + 16 * wave + fr] = (bf16)f2bf(o[mt][r] * rs * gn * siluf_(gt[mt][r])); }
    __syncthreads();
}

constexpr int FM_Q2 = 96256, FM_S = 129024;
__device__ __forceinline__ void f_ml_p2(ArgsR A, int l, int item, LAS unsigned char* lds, int tid) {
    const int n = item & 31, h = (item >> 5) & 3, b = item >> 7; const int lane = tid & 63, wave = __builtin_amdgcn_readfirstlane(tid >> 6);
    const bf16* P = (const bf16*)(A.ws + WS_P); const float* Ps = (const float*)(A.ws + WS_PS);
    float* inc = (float*)(A.ws + WS_ML_INC) + (size_t)item * 16384; float* incn = (float*)(A.ws + WS_ML_N) + (size_t)item * 128; float* scg = (float*)(A.ws + WS_ML_SC) + (size_t)item * 2;
    LAS bf16* ks = (LAS bf16*)(lds + FL_K); LAS bf16* vs = (LAS bf16*)(lds + FL_V); LAS float* sc = (LAS float*)(lds + FM_S);
    const size_t r0 = (size_t)b * SEQ + n * CHK;
    tile_g2l_128<64>(P + r0 * PBW + PC_ML_K + h * HD, PBW, ks, tid);
    tile_g2l_128<64>(P + r0 * PBW + PC_ML_V + h * HD, PBW, vs, tid);
    if (wave == 0) { const float lf = logsigmoidf_(Ps[(r0 + lane) * 32 + PS_MF + h] + A.in[I_ML_FB][l * NH + h]), ig = Ps[(r0 + lane) * 32 + PS_MI + h] + A.in[I_ML_IB][l * NH + h];
        const float bcum = wave_scan_add(lf, lane), blast = lane_bcast(bcum, 63), le = blast - bcum + ig, mloc = wave_max(le);
        sc[lane] = __expf(le - mloc) * 0.08838834764831845f; if (lane == 0) { scg[0] = mloc; scg[1] = blast; } }
    __syncthreads();
#pragma unroll
    for (int i = 0; i < 2; ++i) { const int idx = tid + i * NTHREADS, r = idx >> 4, c8 = (idx & 15) * 8; const float w = sc[r];
        v4u x = *(LAS v4u*)(ks + r * LD128 + c8);
        x.x = pk2(bflo(x.x) * w, bfhi(x.x) * w); x.y = pk2(bflo(x.y) * w, bfhi(x.y) * w); x.z = pk2(bflo(x.z) * w, bfhi(x.z) * w); x.w = pk2(bflo(x.w) * w, bfhi(x.w) * w);
        *(LAS v4u*)(ks + r * LD128 + c8) = x; }
    __syncthreads();
    if (tid < 128) { float s = 0.f;
#pragma unroll 8
        for (int c = 0; c < 64; ++c) s += bf2f(ks[c * LD128 + tid]);
        incn[tid] = s; }
    { f32x4 acc[8];
#pragma unroll
        for (int nt = 0; nt < 8; ++nt) acc[nt] = (f32x4){0.f, 0.f, 0.f, 0.f};
#pragma unroll
        for (int kk = 0; kk < 2; ++kk) { const bf16x8 af = frag_tr(vs, LD128, 32 * kk, 16 * wave, lane);
#pragma unroll
            for (int nt = 0; nt < 8; ++nt) acc[nt] = MFMA16(af, frag_tr(ks, LD128, 32 * kk, 16 * nt, lane), acc[nt]); }
        const int fr = lane & 15, fq = lane >> 4;
#pragma unroll
        for (int nt = 0; nt < 8; ++nt)
#pragma unroll
            for (int r = 0; r < 4; ++r) inc[(16 * wave + 4 * fq + r) * 128 + 16 * nt + fr] = acc[nt][r]; }
    __syncthreads();
}
__device__ __forceinline__ void f_ml_p3(ArgsR A, int item, int tid) {
    const int bh = item >> 4, sl = item & 15; const int e = sl * 1024 + tid * 2;
    const float* inc = (const float*)(A.ws + WS_ML_INC) + (size_t)bh * 32 * 16384 + e; const float* incn = (const float*)(A.ws + WS_ML_N) + (size_t)bh * 32 * 128;
    const float* scg = (const float*)(A.ws + WS_ML_SC) + (size_t)bh * 32 * 2;
    bf16* st = (bf16*)(A.ws + WS_ML_ST) + (size_t)bh * 32 * 16384 + e; float* np = (float*)(A.ws + WS_ML_NP) + (size_t)bh * 32 * 128; float* mp = (float*)(A.ws + WS_ML_MP) + (size_t)bh * 32;
    float c0 = 0.f, c1 = 0.f, nv = 0.f, m = 0.f; const int dn = sl * 8 + tid;
#pragma unroll 4
    for (int n = 0; n < NCHK; ++n) {
        *(GAS unsigned*)(st + (size_t)n * 16384) = pk2(c0, c1);
        if (tid < 8) np[n * 128 + dn] = nv;
        if (sl == 0 && tid == 0) mp[n] = m;
        const float ml = scg[2 * n], bl = scg[2 * n + 1]; const float mn = fmaxf(bl + m, ml), ao = __expf(bl + m - mn), ai = __expf(ml - mn);
        const f32x2 iv = *(const GAS f32x2*)(inc + (size_t)n * 16384); c0 = ao * c0 + ai * iv[0]; c1 = ao * c1 + ai * iv[1];
        if (tid < 8) nv = ao * nv + ai * incn[n * 128 + dn];
        m = mn; }
}
__device__ __forceinline__ void f_ml_p4(ArgsR A, int l, int item, LAS unsigned char* lds, int tid) {
    const int n = item & 31, h = (item >> 5) & 3, b = item >> 7; const int lane = tid & 63, wave = __builtin_amdgcn_readfirstlane(tid >> 6), fr = lane & 15, fq = lane >> 4;
    const bf16* P = (const bf16*)(A.ws + WS_P); const float* Ps = (const float*)(A.ws + WS_PS); bf16* mix = (bf16*)(A.ws + WS_MIX);
    const bf16* stg = (const bf16*)(A.ws + WS_ML_ST) + (size_t)item * 16384; const float* npg = (const float*)(A.ws + WS_ML_NP) + (size_t)item * 128; const float mprev = ((const float*)(A.ws + WS_ML_MP))[item];
    LAS bf16* qs = (LAS bf16*)(lds + FL_Q); LAS bf16* ks = (LAS bf16*)(lds + FL_K); LAS bf16* vs = (LAS bf16*)(lds + FL_V); LAS bf16* sts = (LAS bf16*)(lds + FL_ST); LAS bf16* scs = (LAS bf16*)(lds + FL_SC);
    LAS bf16* q2 = (LAS bf16*)(lds + FM_Q2); LAS float* sc = (LAS float*)(lds + FM_S); LAS float* rsp = (LAS float*)(lds + FL_RS + 4096);
    const size_t r0 = (size_t)b * SEQ + n * CHK;
    const float gn = A.in[I_ML_NG][l * GW + h * HD + 16 * wave + fr];
    float ogt[4][4];
#pragma unroll
    for (int mt = 0; mt < 4; ++mt)
#pragma unroll
        for (int r = 0; r < 4; ++r) ogt[mt][r] = bf2f(P[(r0 + 16 * mt + 4 * fq + r) * PBW + PC_ML_O + h * HD + 16 * wave + fr]);
    tile_g2l_128<64>(P + r0 * PBW + PC_ML_Q + h * HD, PBW, qs, tid);
    tile_g2l_128<64>(P + r0 * PBW + PC_ML_K + h * HD, PBW, ks, tid);
    tile_g2l_128<64>(P + r0 * PBW + PC_ML_V + h * HD, PBW, vs, tid);
    tile_g2l_128<128>(stg, 128, sts, tid);
    if (wave == 0) { const float lf = logsigmoidf_(Ps[(r0 + lane) * 32 + PS_MF + h] + A.in[I_ML_FB][l * NH + h]), ig = Ps[(r0 + lane) * 32 + PS_MI + h] + A.in[I_ML_IB][l * NH + h];
        const float bcum = wave_scan_add(lf, lane), as = ig - bcum, pm = wave_scan_max(as, lane);
        const float mintra = bcum + pm, minter = bcum + mprev, mt = fmaxf(mintra, minter);
        sc[lane] = bcum - mt; sc[64 + lane] = as; sc[128 + lane] = __expf(minter - mt); sc[192 + lane] = __expf(-mt); }
    if (wave == 1) { sc[320 + lane] = npg[lane]; sc[384 + lane] = npg[64 + lane]; }
    __syncthreads();
#pragma unroll
    for (int i = 0; i < 2; ++i) { const int idx = tid + i * NTHREADS, r = idx >> 4, c8 = (idx & 15) * 8; const float w = sc[128 + r];
        v4u x = *(LAS v4u*)(qs + r * LD128 + c8);
        x.x = pk2(bflo(x.x) * w, bfhi(x.x) * w); x.y = pk2(bflo(x.y) * w, bfhi(x.y) * w); x.z = pk2(bflo(x.z) * w, bfhi(x.z) * w); x.w = pk2(bflo(x.w) * w, bfhi(x.w) * w);
        *(LAS v4u*)(q2 + r * LD128 + c8) = x; }
    { const int mt = wave >> 1; f32x4 acc[2] = {{0.f, 0.f, 0.f, 0.f}, {0.f, 0.f, 0.f, 0.f}};
#pragma unroll
        for (int kk = 0; kk < 4; ++kk) { const bf16x8 af = frag_rd(qs, LD128, 16 * mt, 32 * kk, lane);
#pragma unroll
            for (int q = 0; q < 2; ++q) acc[q] = MFMA16(af, frag_rd(ks, LD128, 16 * (2 * (wave & 1) + q), 32 * kk, lane), acc[q]); }
#pragma unroll
        for (int q = 0; q < 2; ++q) { const int s = 16 * (2 * (wave & 1) + q) + fr; const float asv = sc[64 + s];
#pragma unroll
            for (int r = 0; r < 4; ++r) { const int c = 16 * mt + 4 * fq + r; scs[c * LD64 + s] = (bf16)f2bf(s <= c ? acc[q][r] * 0.08838834764831845f * __expf(sc[c] + asv) : 0.f); } } }
    __syncthreads();
    { const int c = tid >> 3, part = tid & 7; float s = 0.f;
#pragma unroll
        for (int i = 0; i < 8; ++i) s += bf2f(scs[c * LD64 + part * 8 + i]);
#pragma unroll
        for (int i = 0; i < 16; ++i) s += bf2f(q2[c * LD128 + part * 16 + i]) * sc[320 + part * 16 + i];
        s = oct_sum_f(s);
        if (part == 0) sc[256 + c] = fmaxf(fabsf(s), sc[192 + c]); }
    f32x4 o[4];
#pragma unroll
    for (int mt = 0; mt < 4; ++mt) o[mt] = (f32x4){0.f, 0.f, 0.f, 0.f};
#pragma unroll
    for (int kk = 0; kk < 2; ++kk) { const bf16x8 bfv = frag_tr(vs, LD128, 32 * kk, 16 * wave, lane);
#pragma unroll
        for (int mt = 0; mt < 4; ++mt) o[mt] = MFMA16(frag_rd(scs, LD64, 16 * mt, 32 * kk, lane), bfv, o[mt]); }
#pragma unroll
    for (int kk = 0; kk < 4; ++kk) { const bf16x8 bfs = frag_rd(sts, LD128, 16 * wave, 32 * kk, lane);
#pragma unroll
        for (int mt = 0; mt < 4; ++mt) o[mt] = MFMA16(frag_rd(q2, LD128, 16 * mt, 32 * kk, lane), bfs, o[mt]); }
    __syncthreads();
#pragma unroll
    for (int mt = 0; mt < 4; ++mt)
#pragma unroll
        for (int r = 0; r < 4; ++r) { const int c = 16 * mt + 4 * fq + r;
            const float hv = o[mt][r] * rcpf_(sc[256 + c]) * sigmoidf_(ogt[mt][r]); o[mt][r] = hv;
            float s = hv * hv; s = row_sum_f(s);
            if (fr == 0) rsp[wave * 64 + c] = s; }
    __syncthreads();
#pragma unroll
    for (int mt = 0; mt < 4; ++mt)
#pragma unroll
        for (int r = 0; r < 4; ++r) { const int c = 16 * mt + 4 * fq + r; float ss = 0.f;
#pragma unroll
            for (int w = 0; w < 8; ++w) ss += rsp[w * 64 + c];
            mix[(r0 + c) * DM + 1024 + h * HD + 16 * wave + fr] = (bf16)f2bf(o[mt][r] * rsqrtf(ss * (1.0f / 128.0f) + RMS_EPS) * gn); }
    __syncthreads();
}

constexpr int FG_LM = 52224, FG_S = 129024, FG_RAW = 68608, FG_RAWT = 9216  ;
template <int C> struct GdnSolve {
    static __device__ __forceinline__ void run(float (&sol)[64], const LAS float* Lm) {
        if constexpr (C < 64) {
            float a0 = sol[C], a1 = 0.f, a2 = 0.f, a3 = 0.f;
#pragma unroll
            for (int s = 0; s < C; ++s) { const float t = Lm[C * 64 + s] * sol[s]; if ((s & 3) == 0) a0 -= t; else if ((s & 3) == 1) a1 -= t; else if ((s & 3) == 2) a2 -= t; else a3 -= t; }
            sol[C] = (a0 + a1) + (a2 + a3);
            GdnSolve<C + 1>::run(sol, Lm);
        }
    }
};
__device__ __forceinline__ void f_gdn_p2(ArgsR A, int l, int item, LAS unsigned char* lds, int tid) {
    const int n = item & 31, h = (item >> 5) & 3, b = item >> 7; const int lane = tid & 63, wave = __builtin_amdgcn_readfirstlane(tid >> 6), fr = lane & 15, fq = lane >> 4;
    const bf16* P = (const bf16*)(A.ws + WS_P); const float* Ps = (const float*)(A.ws + WS_PS);
    bf16* U0 = (bf16*)(A.ws + WS_GDN_U0) + (size_t)item * 8192; bf16* Wg = (bf16*)(A.ws + WS_GDN_W) + (size_t)item * 8192; bf16* QD = (bf16*)(A.ws + WS_GDN_QD) + (size_t)item * 8192;
    bf16* KE = (bf16*)(A.ws + WS_GDN_KE) + (size_t)item * 8192; bf16* QK = (bf16*)(A.ws + WS_GDN_QK) + (size_t)item * 4096; float* DE = (float*)(A.ws + WS_GDN_DE);
    LAS bf16* qs = (LAS bf16*)(lds + FL_Q); LAS bf16* ks = (LAS bf16*)(lds + FL_K); LAS bf16* vs = (LAS bf16*)(lds + FL_V); LAS float* Lm = (LAS float*)(lds + FG_LM); LAS float* sc = (LAS float*)(lds + FG_S);
    const float* cw = A.in[I_GDN_CW] + (size_t)l * 4 * 1536;
    const size_t r0 = (size_t)b * SEQ + n * CHK;
    float cwv[3][4];
#pragma unroll
    for (int part = 0; part < 3; ++part)
#pragma unroll
        for (int k = 0; k < 4; ++k) cwv[part][k] = cw[k * 1536 + part * 512 + h * HD + (tid & 127)];
    if (wave == 0) { const float bt = sigmoidf_(Ps[(r0 + lane) * 32 + PS_GB + h]);
        const float g = -__expf(A.in[I_GDN_ALOG][l * NH + h]) * softplusf_(Ps[(r0 + lane) * 32 + PS_GA + h] + A.in[I_GDN_DTB][l * NH + h]);
        const float gam = wave_scan_add(g, lane); sc[lane] = bt; sc[64 + lane] = gam; if (lane == 63) DE[item] = __expf(gam); }
    { LAS bf16* raw = (LAS bf16*)(lds + FG_RAW);
#pragma unroll
        for (int i = 0; i < 7; ++i) { const int idx = tid + i * NTHREADS; if (idx < 3 * 67 * 16) { const int part = idx / (67 * 16), pi = idx % (67 * 16), rr = pi >> 4, c8 = (pi & 15) * 8;
            const int pc = (part == 0 ? PC_GDN_Q : part == 1 ? PC_GDN_K : PC_GDN_V) + h * HD + c8; v4u w = {0u, 0u, 0u, 0u};
            if (n > 0 || rr >= 3) w = *(const GAS v4u*)(P + (r0 + rr - 3) * PBW + pc);
            *(LAS v4u*)(raw + part * FG_RAWT + rr * LD128 + c8) = w; } }
        __syncthreads();
        const int v = tid & 127, dq = tid >> 7;
#pragma unroll
        for (int part = 0; part < 3; ++part) {
            const float w0 = cwv[part][0], w1 = cwv[part][1], w2 = cwv[part][2], w3 = cwv[part][3];
            LAS bf16* dst = part == 0 ? qs : part == 1 ? ks : vs; const LAS bf16* src = raw + part * FG_RAWT + v;
            const int c0 = dq * 16;
            float xm3 = bf2f(src[(c0 + 0) * LD128]), xm2 = bf2f(src[(c0 + 1) * LD128]), xm1 = bf2f(src[(c0 + 2) * LD128]);
#pragma unroll
            for (int i = 0; i < 16; ++i) { const float x0 = bf2f(src[(c0 + i + 3) * LD128]); const float y = w0 * xm3 + w1 * xm2 + w2 * xm1 + w3 * x0;
                dst[(c0 + i) * LD128 + v] = (bf16)f2bf(siluf_(y)); xm3 = xm2; xm2 = xm1; xm1 = x0; } } }
    __syncthreads();
#pragma unroll 1
    for (int rr = 0; rr < 8; ++rr) { const int c = wave * 8 + rr;
        const float q1 = bf2f(qs[c * LD128 + lane]), q2 = bf2f(qs[c * LD128 + 64 + lane]), k1 = bf2f(ks[c * LD128 + lane]), k2 = bf2f(ks[c * LD128 + 64 + lane]);
        const float sq = wave_sum(q1 * q1 + q2 * q2), sk = wave_sum(k1 * k1 + k2 * k2);
        if (lane == 0) { sc[128 + c] = rsqrtf(sq + 1e-6f) * 0.08838834764831845f; sc[192 + c] = rsqrtf(sk + 1e-6f); } }
    __syncthreads();
    { const int mt = wave >> 1; f32x4 akk[2] = {{0.f, 0.f, 0.f, 0.f}, {0.f, 0.f, 0.f, 0.f}}, aqk[2] = {{0.f, 0.f, 0.f, 0.f}, {0.f, 0.f, 0.f, 0.f}};
#pragma unroll
        for (int kk = 0; kk < 4; ++kk) { const bf16x8 ak = frag_rd(ks, LD128, 16 * mt, 32 * kk, lane), aq = frag_rd(qs, LD128, 16 * mt, 32 * kk, lane);
#pragma unroll
            for (int q = 0; q < 2; ++q) { const bf16x8 bk = frag_rd(ks, LD128, 16 * (2 * (wave & 1) + q), 32 * kk, lane); akk[q] = MFMA16(ak, bk, akk[q]); aqk[q] = MFMA16(aq, bk, aqk[q]); } }
#pragma unroll
        for (int q = 0; q < 2; ++q) { const int s = 16 * (2 * (wave & 1) + q) + fr; const float rks = sc[192 + s], gs = sc[64 + s];
#pragma unroll
            for (int r = 0; r < 4; ++r) { const int c = 16 * mt + 4 * fq + r; const float dcy = __expf(sc[64 + c] - gs);
                Lm[c * 64 + s] = (s < c) ? sc[c] * akk[q][r] * sc[192 + c] * rks * dcy : 0.f;
                QK[c * 64 + s] = (bf16)f2bf((s <= c) ? aqk[q][r] * sc[128 + c] * rks * dcy : 0.f); } } }
    __syncthreads();
    if (tid < 256) {
        float sol[64]; const bool isw = tid >= 128; const int j = tid & 127;
        const LAS float* LmO = Lm; asm volatile("" : "+v"(LmO));
#pragma unroll
        for (int c = 0; c < 64; ++c) { const float bt = sc[c]; sol[c] = isw ? bf2f(ks[c * LD128 + j]) * sc[192 + c] * bt * __expf(sc[64 + c]) : bf2f(vs[c * LD128 + j]) * bt; }
        GdnSolve<1>::run(sol, LmO);
        bf16* dst = isw ? Wg : U0;
#pragma unroll
        for (int c = 0; c < 64; ++c) dst[c * 128 + j] = (bf16)f2bf(sol[c]);
    } else {
        const int t2 = tid - 256; const float glast = sc[64 + 63];
#pragma unroll
        for (int i = 0; i < 8; ++i) { const int idx = t2 + i * 256, which = idx >> 10, pi = idx & 1023, r = pi >> 4, c8 = (pi & 15) * 8;
            const float w = which == 0 ? sc[128 + r] * __expf(sc[64 + r]) : sc[192 + r] * __expf(glast - sc[64 + r]);
            v4u x = *(LAS v4u*)((which == 0 ? qs : ks) + r * LD128 + c8);
            x.x = pk2(bflo(x.x) * w, bfhi(x.x) * w); x.y = pk2(bflo(x.y) * w, bfhi(x.y) * w); x.z = pk2(bflo(x.z) * w, bfhi(x.z) * w); x.w = pk2(bflo(x.w) * w, bfhi(x.w) * w);
            *(GAS v4u*)((which == 0 ? QD : KE) + r * 128 + c8) = x; }
    }
    __syncthreads();
}

constexpr int FC_W = 0, FC_QD = 17408, FC_KE = 34816, FC_U0 = 52224, FC_QK = 69632, FC_RS = 78848  ;
__device__ __forceinline__ void f_gdn_p3(ArgsR A, int l, int bh, LAS unsigned char* lds, int tid) {
    const int lane = tid & 63, wave = __builtin_amdgcn_readfirstlane(tid >> 6), fr = lane & 15, fq = lane >> 4; const int b = bh >> 2, h = bh & 3;
    const bf16* U0 = (const bf16*)(A.ws + WS_GDN_U0) + (size_t)bh * 32 * 8192; const bf16* Wg = (const bf16*)(A.ws + WS_GDN_W) + (size_t)bh * 32 * 8192; const bf16* QD = (const bf16*)(A.ws + WS_GDN_QD) + (size_t)bh * 32 * 8192;
    const bf16* KE = (const bf16*)(A.ws + WS_GDN_KE) + (size_t)bh * 32 * 8192; const bf16* QK = (const bf16*)(A.ws + WS_GDN_QK) + (size_t)bh * 32 * 4096; const float* DE = (const float*)(A.ws + WS_GDN_DE) + bh * 32;
    const bf16* P = (const bf16*)(A.ws + WS_P); bf16* mix = (bf16*)(A.ws + WS_MIX); LAS float* rsp = (LAS float*)(lds + FC_RS);
    const float gn = A.in[I_GDN_NG][l * GW + h * HD + 16 * wave + fr];
    LAS bf16* ws_ = (LAS bf16*)(lds + FC_W); LAS bf16* qds = (LAS bf16*)(lds + FC_QD); LAS bf16* kes = (LAS bf16*)(lds + FC_KE); LAS bf16* u0s = (LAS bf16*)(lds + FC_U0); LAS bf16* qks = (LAS bf16*)(lds + FC_QK);
    f32x4 S[8];
#pragma unroll
    for (int i = 0; i < 8; ++i) S[i] = (f32x4){0.f, 0.f, 0.f, 0.f};
    v4u st[9];
    auto issue = [&](int n) {
#pragma unroll
        for (int i = 0; i < 8; ++i) { const int idx = tid + i * NTHREADS, which = idx >> 10, pi = idx & 1023;
            const bf16* src = (which == 0 ? Wg : which == 1 ? QD : which == 2 ? KE : U0) + (size_t)n * 8192; st[i] = *(const GAS v4u*)(src + pi * 8); }
        st[8] = *(const GAS v4u*)(QK + (size_t)n * 4096 + tid * 8);
    };
    auto commit = [&]() {
#pragma unroll
        for (int i = 0; i < 8; ++i) { const int idx = tid + i * NTHREADS, which = idx >> 10, pi = idx & 1023, r = pi >> 4, c8 = (pi & 15) * 8;
            *(LAS v4u*)((LAS bf16*)(lds + which * 17408) + r * LD128 + c8) = st[i]; }
        { const int r = tid >> 3, c8 = (tid & 7) * 8; *(LAS v4u*)(qks + r * LD64 + c8) = st[8]; }
    };
    const float dev = DE[lane & 31];
    issue(0);
    f32x4 op[4]; float gp[4][4];
#pragma unroll
    for (int mt = 0; mt < 4; ++mt) { op[mt] = (f32x4){0.f, 0.f, 0.f, 0.f};
#pragma unroll
        for (int r = 0; r < 4; ++r) gp[mt][r] = 0.f; }
#define CH_FINAL(nn) { LAS float* rs_ = rsp + ((nn) & 1) * 512; const size_t rp_ = (size_t)b * SEQ + (nn) * CHK; \
        _Pragma("unroll") for (int mt = 0; mt < 4; ++mt) _Pragma("unroll") for (int r = 0; r < 4; ++r) { const int c = 16 * mt + 4 * fq + r; float ss = 0.f; \
            _Pragma("unroll") for (int w = 0; w < 8; ++w) ss += rs_[w * 64 + c]; \
            mix[(rp_ + c) * DM + 1536 + h * HD + 16 * wave + fr] = (bf16)f2bf(op[mt][r] * rsqrtf(ss * (1.0f / 128.0f) + RMS_EPS) * gn * siluf_(gp[mt][r])); } }
#pragma unroll 1
    for (int n = 0; n < NCHK; ++n) {
        __syncthreads();
        if (n > 0) CH_FINAL(n - 1);
        commit();
        __syncthreads();
        if (n + 1 < NCHK) issue(n + 1);
        const float de = lane_bcast(dev, n);
        const size_t r0 = (size_t)b * SEQ + n * CHK;
#pragma unroll
        for (int mt = 0; mt < 4; ++mt)
#pragma unroll
            for (int r = 0; r < 4; ++r) gp[mt][r] = bf2f(P[(r0 + 16 * mt + 4 * fq + r) * PBW + PC_GDN_G + h * HD + 16 * wave + fr]);
        bf16x8 SB[4];
#pragma unroll
        for (int kb = 0; kb < 4; ++kb) SB[kb] = pack_acc(S[2 * kb], S[2 * kb + 1]);
        f32x4 u[4];
#pragma unroll
        for (int mt = 0; mt < 4; ++mt) { f32x4 ws2 = {0.f, 0.f, 0.f, 0.f}; op[mt] = (f32x4){0.f, 0.f, 0.f, 0.f};
#pragma unroll
            for (int kb = 0; kb < 4; ++kb) { ws2 = MFMA16(frag_rd_perm(ws_, LD128, 16 * mt, 32 * kb, lane), SB[kb], ws2); op[mt] = MFMA16(frag_rd_perm(qds, LD128, 16 * mt, 32 * kb, lane), SB[kb], op[mt]); }
#pragma unroll
            for (int r = 0; r < 4; ++r) u[mt][r] = bf2f(u0s[(16 * mt + 4 * fq + r) * LD128 + 16 * wave + fr]) - ws2[r]; }
        const bf16x8 UB0 = pack_acc(u[0], u[1]), UB1 = pack_acc(u[2], u[3]);
#pragma unroll
        for (int mt = 0; mt < 4; ++mt) { op[mt] = MFMA16(frag_rd_perm(qks, LD64, 16 * mt, 0, lane), UB0, op[mt]); op[mt] = MFMA16(frag_rd_perm(qks, LD64, 16 * mt, 32, lane), UB1, op[mt]); }
#pragma unroll
        for (int dt = 0; dt < 8; ++dt) { f32x4 sn = S[dt] * de;
            sn = MFMA16(frag_tr_perm(kes, LD128, 0, 16 * dt, lane), UB0, sn); sn = MFMA16(frag_tr_perm(kes, LD128, 32, 16 * dt, lane), UB1, sn); S[dt] = sn; }
        LAS float* rs_ = rsp + (n & 1) * 512;
#pragma unroll
        for (int mt = 0; mt < 4; ++mt)
#pragma unroll
            for (int r = 0; r < 4; ++r) { float s = op[mt][r] * op[mt][r]; s = row_sum_f(s);
                if (fr == 0) rs_[wave * 64 + 16 * mt + 4 * fq + r] = s; }
    }
    __syncthreads();
    CH_FINAL(NCHK - 1);
#undef CH_FINAL
    __syncthreads();
}

#ifndef TAB_FP8
#define TAB_FP8 1
#endif
constexpr size_t WS_TSC = 93 * MiB + 256 * 1024;
constexpr int NSLICE = 16;
constexpr int PE_KEYS = 0, PE_CAB = 16384, PE_ENT = 17408, PE_OFFS = 50176, PE_SHQ = 52352, PE_H2Q = 53248;

__device__ __forceinline__ void tab_convert(ArgsR A, int l, int gw, int NGW, int lane) {
    unsigned char* ws = A.ws; float* tsc = (float*)(ws + WS_TSC);
#pragma unroll 1
    for (int q = gw; q < 2 * NEXP; q += NGW) {
        const int t = q / NEXP, rr = l * NEXP + q % NEXP, r = t * DEPTH * NEXP + rr;
        const float* src = A.in[t ? I_PV : I_PU] + (size_t)rr * DM;
        f32x4 v[8];
#pragma unroll
        for (int i = 0; i < 8; ++i) v[i] = *(const GAS f32x4*)(src + 4 * (lane + 64 * i));
        unsigned char* dst = ws + (t ? WS_VB : WS_UB) + (size_t)(rr / NEXP) * TAB_L + (size_t)(rr % NEXP) * DM;
        float am = 0.f;
#pragma unroll
        for (int i = 0; i < 8; ++i) am = fmaxf(fmaxf(am, fmaxf(fabsf(v[i][0]), fabsf(v[i][1]))), fmaxf(fabsf(v[i][2]), fabsf(v[i][3])));
        am = wave_max(am); const float sc = am > 0.f ? 127.0f / am : 1.0f; const int off = t ? 128 : 0;
#pragma unroll
        for (int i = 0; i < 8; ++i) { const int q0 = __float2int_rn(v[i][0] * sc) + off, q1 = __float2int_rn(v[i][1] * sc) + off, q2 = __float2int_rn(v[i][2] * sc) + off, q3 = __float2int_rn(v[i][3] * sc) + off;
            *(GAS unsigned*)(dst + 4 * (lane + 64 * i)) = (unsigned)(q0 & 255) | ((unsigned)(q1 & 255) << 8) | ((unsigned)(q2 & 255) << 16) | ((unsigned)(q3 & 255) << 24); }
        if (lane == 0) tsc[r] = am > 0.f ? am * (1.0f / 127.0f) : 1.0f;
    }
}
__device__ __forceinline__ float ubf0(unsigned w) { float r; asm volatile("v_cvt_f32_ubyte0 %0, %1" : "=v"(r) : "v"(w)); return r; }
__device__ __forceinline__ float ubf1(unsigned w) { float r; asm volatile("v_cvt_f32_ubyte1 %0, %1" : "=v"(r) : "v"(w)); return r; }
__device__ __forceinline__ float ubf2(unsigned w) { float r; asm volatile("v_cvt_f32_ubyte2 %0, %1" : "=v"(r) : "v"(w)); return r; }
__device__ __forceinline__ float ubf3(unsigned w) { float r; asm volatile("v_cvt_f32_ubyte3 %0, %1" : "=v"(r) : "v"(w)); return r; }
#define TOUCH16(a, o) asm volatile("" : "+v"(a[(o)+0]), "+v"(a[(o)+1]), "+v"(a[(o)+2]), "+v"(a[(o)+3]), "+v"(a[(o)+4]), "+v"(a[(o)+5]), "+v"(a[(o)+6]), "+v"(a[(o)+7]), "+v"(a[(o)+8]), "+v"(a[(o)+9]), "+v"(a[(o)+10]), "+v"(a[(o)+11]), "+v"(a[(o)+12]), "+v"(a[(o)+13]), "+v"(a[(o)+14]), "+v"(a[(o)+15]))
__device__ __forceinline__ unsigned f2sortable(float f) { const unsigned u = __builtin_bit_cast(unsigned, f); return (u & 0x80000000u) ? ~u : (u | 0x80000000u); }
__device__ __forceinline__ float unsortable(unsigned k) { const unsigned u = (k & 0x80000000u) ? (k & 0x7fffffffu) : ~k; return __builtin_bit_cast(float, u); }
__device__ __forceinline__ void peer_phase(ArgsR A, int l, bool last, bool dry, LAS unsigned char* lds, int G, int tid) {
    const int wave = __builtin_amdgcn_readfirstlane(tid >> 6), lane = tid & 63;
    unsigned char* ws = A.ws;
    const bf16* Q = (const bf16*)(ws + WS_Q);
    const bf16* K1 = (const bf16*)(ws + WS_K1) + (size_t)l * 8 * 128 * 128; const bf16* K2 = (const bf16*)(ws + WS_K2) + (size_t)l * 8 * 128 * 128;
    const unsigned char* Ub = ws + WS_UB + (size_t)l * TAB_L; const unsigned char* Vb = ws + WS_VB + (size_t)l * TAB_L;
    const float* tscU = (const float*)(ws + WS_TSC) + (size_t)l * NEXP; const float* tscV = tscU + (size_t)DEPTH * NEXP;
    const float* ssp = (const float*)(ws + WS_SSP); const float* X = A.out; float* XO = dry ? (float*)(ws + WS_P) : A.out; bf16* xb = (bf16*)(ws + (dry ? WS_MIX : WS_XB)); float* rstd1 = (float*)(ws + (dry ? WS_PS : WS_RSTD1));
    const float* g2 = A.in[I_N2G] + l * DM; const float* gf = A.in[I_FNG];
    LAS unsigned* keysL = (LAS unsigned*)(lds + PE_KEYS); LAS unsigned* cab = (LAS unsigned*)(lds + PE_CAB); LAS v2u* ent = (LAS v2u*)(lds + PE_ENT); LAS unsigned* offs = (LAS unsigned*)(lds + PE_OFFS);
    LAS float* shqL = (LAS float*)(lds + PE_SHQ); LAS unsigned* ngt = (LAS unsigned*)(lds + PE_SHQ + 128); LAS v4u* h2qL = (LAS v4u*)(lds + PE_H2Q);
    if (tid < 64) { int a = 0, b = tid, found = 0;
        for (int aa = 0, base = 0; aa < 16; ++aa) { const int nbb = 16 / (aa + 1); if (!found && tid < base + nbb) { a = aa; b = tid - base; found = 1; } base += nbb; }
        cab[tid] = found ? (unsigned)(a * 16 + b) : 0xffu; }
    __syncthreads();
#pragma unroll 1
    for (int item = blockIdx.x; item < NT / 32; item += G) {
        const int tok0 = item * 32;
#pragma unroll 1
        for (int tt = 0; tt < 4; ++tt) { const int tl = wave * 4 + tt; const size_t t = (size_t)tok0 + tl;
            float s2 = (lane < 32) ? ssp[t * 32 + lane] : 0.f; s2 = wave_sum(s2);
            const float rstd2 = rsqrtf(s2 * (1.0f / DM) + RMS_EPS);
            float hf[32]; float am = 0.f;
#pragma unroll
            for (int j = 0; j < 2; ++j)
#pragma unroll
                for (int q = 0; q < 4; ++q) { const size_t e0 = 16 * (size_t)(lane + 64 * j) + 4 * q;
                    const f32x4 xa = *(const GAS f32x4*)(X + t * DM + e0), ga = *(const GAS f32x4*)(g2 + e0);
#pragma unroll
                    for (int k = 0; k < 4; ++k) { const float hv = xa[k] * rstd2 * ga[k]; hf[j * 16 + q * 4 + k] = hv; am = fmaxf(am, fabsf(hv)); } }
            am = wave_max(am); const float sc = am > 0.f ? 127.0f / am : 1.0f;
#pragma unroll
            for (int j = 0; j < 2; ++j) { unsigned wd[4];
#pragma unroll
                for (int q = 0; q < 4; ++q) wd[q] = (unsigned)((__float2int_rn(hf[j * 16 + q * 4 + 0] * sc) & 255) | ((__float2int_rn(hf[j * 16 + q * 4 + 1] * sc) & 255) << 8) | ((__float2int_rn(hf[j * 16 + q * 4 + 2] * sc) & 255) << 16) | ((__float2int_rn(hf[j * 16 + q * 4 + 3] * sc) & 255) << 24));
                v4u w; w.x = wd[0]; w.y = wd[1]; w.z = wd[2]; w.w = wd[3]; h2qL[(tl * 2 + j) * 64 + lane] = w; }
            if (lane == 0) shqL[tl] = am > 0.f ? am * (1.0f / 127.0f) : 1.0f; }
#pragma unroll 1
        for (int pass = 0; pass < 4; ++pass) {
            LAS unsigned* kl = keysL + (pass & 1) * 2048;
            { const int hh = wave >> 2, side = (wave >> 1) & 1, mt = wave & 1, h = 2 * pass + hh, fr = lane & 15, fq = lane >> 4;
                const bf16* qa = Q + (size_t)(tok0 + 16 * mt + fr) * DM + h * 256 + side * 128 + 8 * fq;
                const bf16* kb = (side ? K2 : K1) + (size_t)h * 128 * 128 + (size_t)fr * 128 + 8 * fq;
                bf16x8 af[4];
#pragma unroll
                for (int ks = 0; ks < 4; ++ks) af[ks] = *(const GAS bf16x8*)(qa + 32 * ks);
                unsigned key[8][4];
#pragma unroll
                for (int nt = 0; nt < 8; ++nt) { f32x4 acc = {0.f, 0.f, 0.f, 0.f};
#pragma unroll
                    for (int ks = 0; ks < 4; ++ks) { const bf16x8 bfr = *(const GAS bf16x8*)(kb + (size_t)nt * 16 * 128 + 32 * ks); acc = __builtin_amdgcn_mfma_f32_16x16x32_bf16(af[ks], bfr, acc, 0, 0, 0); }
#pragma unroll
                    for (int r = 0; r < 4; ++r) key[nt][r] = (f2sortable(acc[r]) & ~127u) | (unsigned)(nt * 16 + fr);
                    if (nt & 1) __builtin_amdgcn_sched_barrier(0); }
                unsigned res[4] = {0u, 0u, 0u, 0u};
#pragma unroll 1
                for (int j = 0; j < 16; ++j) {
#pragma unroll
                    for (int r = 0; r < 4; ++r) {
                        unsigned m = max(max(max(key[0][r], key[1][r]), max(key[2][r], key[3][r])), max(max(key[4][r], key[5][r]), max(key[6][r], key[7][r])));
                        const unsigned w = row_max_u(m);
#pragma unroll
                        for (int nt = 0; nt < 8; ++nt) key[nt][r] = (key[nt][r] == w) ? 0u : key[nt][r];
                        res[r] = (fr == j) ? w : res[r]; } }
                const int rowb = (hh * 2 + side) * 32 + 16 * mt + 4 * fq;
#pragma unroll
                for (int r = 0; r < 4; ++r) kl[(rowb + r) * 16 + fr] = res[r]; }
            __syncthreads();
#pragma unroll 1
            for (int rnd = 0; rnd < 2; ++rnd) { const int fr = lane & 15, fq = lane >> 4, pidx = rnd * 32 + wave * 4 + fq, hh = pidx >> 5, tk = pidx & 31, h = 2 * pass + hh;
                const LAS unsigned* k1 = kl + ((hh * 2) * 32 + tk) * 16; const LAS unsigned* k2 = k1 + 32 * 16;
                unsigned ck[4];
#pragma unroll
                for (int sl = 0; sl < 4; ++sl) { const int ci = fr + 16 * sl; const unsigned ab = cab[ci];
                    const float v = unsortable(k1[(ab >> 4) & 15] & ~127u) + unsortable(k2[ab & 15] & ~127u);
                    ck[sl] = (ab == 0xffu) ? 0u : ((f2sortable(v) & ~63u) | (unsigned)ci); }
                unsigned rk = 0u;
#pragma unroll 1
                for (int j = 0; j < 16; ++j) { const unsigned w = row_max_u(max(max(ck[0], ck[1]), max(ck[2], ck[3])));
#pragma unroll
                    for (int sl = 0; sl < 4; ++sl) ck[sl] = (ck[sl] == w) ? 0u : ck[sl];
                    rk = (fr == j) ? w : rk; }
                const unsigned ab = cab[rk & 63u]; const float v = unsortable(rk & ~63u);
                const float vmax = row_max_f(v), e = __expf(v - vmax), den = row_sum_f(e);
                const unsigned eid = (k1[(ab >> 4) & 15] & 127u) * 128u + (k2[ab & 15] & 127u);
                const float gsv = e * rcpf_(den) * tscV[eid];
                v2u wv; wv.x = eid; wv.y = __builtin_bit_cast(unsigned, gsv);
                ent[tk * 128 + h * 16 + fr] = wv; }
        }
        __syncthreads();
#pragma unroll 1
        for (int tt = 0; tt < 4; ++tt) { const int tl = wave * 4 + tt;
            const v2u e0 = ent[tl * 128 + lane], e1 = ent[tl * 128 + 64 + lane];
            const unsigned id0 = e0.x, id1 = e1.x; const unsigned s0 = id0 >> 10, s1 = id1 >> 10; const unsigned long long lt = (1ull << lane) - 1ull;
            unsigned base = 0, p0 = 0, p1 = 0, ngr = 0;
#pragma unroll 1
            for (unsigned s = 0; s < NSLICE; ++s) { const unsigned long long m0 = __ballot(s0 == s), m1 = __ballot(s1 == s); const unsigned c0 = __popcll(m0), c1 = __popcll(m1); ngr += (c0 + c1 + 3u) >> 2;
                if (s0 == s) p0 = base + __popcll(m0 & lt);
                if (s1 == s) p1 = base + c0 + __popcll(m1 & lt);
                if (lane == 0) offs[tl * 17 + s] = base;
                base += c0 + c1; }
            if (lane == 0) { offs[tl * 17 + NSLICE] = base; ngt[tl] = ngr; }
            ent[tl * 128 + p0] = e0; ent[tl * 128 + p1] = e1; }
        const unsigned lo16 = (unsigned)lane * 16u;
#define E_ADV(S, T, P, B1, NTOK, TLBASE) { P += 4; while (P >= B1 && S < NSLICE) { ++T; if (T == (NTOK)) { T = 0; ++S; } \
            if (S < NSLICE) { P = __builtin_amdgcn_readfirstlane((int)offs[((TLBASE) + T) * 17 + S]); B1 = __builtin_amdgcn_readfirstlane((int)offs[((TLBASE) + T) * 17 + S + 1]); } } \
            if (S >= NSLICE) { T = 0; P = 128; B1 = 128; } }
#define E_FETCH(X, T, P, B1, TLBASE, WITHSU) { X##tl = (TLBASE) + T; X##w = T; X##p = P; X##b1 = B1; \
            _Pragma("unroll") for (int e = 0; e < 4; ++e) { const v2u w_ = ent[X##tl * 128 + min(P + e, B1 - 1)]; const unsigned ex = w_.x, ey = w_.y; \
                X##id[e] = __builtin_amdgcn_readfirstlane((int)ex); X##cf[e] = __builtin_bit_cast(float, __builtin_amdgcn_readfirstlane((int)ey)); if (WITHSU) X##su[e] = tscU[X##id[e]]; } }
#define E_LOAD(REG, TAB, X) { _Pragma("unroll") for (int e = 0; e < 4; ++e) { const GAS unsigned char* rb = (const GAS unsigned char*)(TAB) + (size_t)X##id[e] * 2048; REG[e][0] = *(const GAS v4u*)(rb + lo16); REG[e][1] = *(const GAS v4u*)(rb + lo16 + 1024); } }
        {
            int Atl = 0, Aw = 0, Ap = 0, Ab1 = 0, Aid[4]; float Acf[4], Asu[4]; int Btl = 0, Bw = 0, Bp = 0, Bb1 = 0, Bid[4]; float Bcf[4], Bsu[4]; v4u RA[4][2], RB[4][2];
            (void)Aw; (void)Bw;
#define U_COMP(X, REG) { const v4u hq0 = h2qL[(X##tl * 2 + 0) * 64 + lane], hq1 = h2qL[(X##tl * 2 + 1) * 64 + lane]; const float shq = shqL[X##tl]; float dd[4]; \
                _Pragma("unroll") for (int e = 0; e < 4; ++e) { int a0 = 0, a1 = 0; \
                    a0 = __builtin_amdgcn_sdot4((int)REG[e][0][0], (int)hq0[0], a0, false); a1 = __builtin_amdgcn_sdot4((int)REG[e][0][1], (int)hq0[1], a1, false); \
                    a0 = __builtin_amdgcn_sdot4((int)REG[e][0][2], (int)hq0[2], a0, false); a1 = __builtin_amdgcn_sdot4((int)REG[e][0][3], (int)hq0[3], a1, false); \
                    a0 = __builtin_amdgcn_sdot4((int)REG[e][1][0], (int)hq1[0], a0, false); a1 = __builtin_amdgcn_sdot4((int)REG[e][1][1], (int)hq1[1], a1, false); \
                    a0 = __builtin_amdgcn_sdot4((int)REG[e][1][2], (int)hq1[2], a0, false); a1 = __builtin_amdgcn_sdot4((int)REG[e][1][3], (int)hq1[3], a1, false); \
                    dd[e] = (float)(a0 + a1); } \
                _Pragma("unroll") for (int e = 0; e < 4; ++e) { const float r_ = row_sum_f(dd[e]); const int ri_ = __builtin_bit_cast(int, r_); \
                    dd[e] = (__builtin_bit_cast(float, __builtin_amdgcn_readlane(ri_, 0)) + __builtin_bit_cast(float, __builtin_amdgcn_readlane(ri_, 16))) + (__builtin_bit_cast(float, __builtin_amdgcn_readlane(ri_, 32)) + __builtin_bit_cast(float, __builtin_amdgcn_readlane(ri_, 48))); } \
                _Pragma("unroll") for (int e = 0; e < 4; ++e) { const float cf = X##cf[e] * gelu_tanh(dd[e] * X##su[e] * shq); \
                    if (lane == 0 && X##p + e < X##b1) { v2u w2; w2.x = (unsigned)X##id[e]; w2.y = __builtin_bit_cast(unsigned, cf); ent[X##tl * 128 + X##p + e] = w2; } } }
            int us = 0, ut = -1, up = 0, ub1 = 0;
            const int ngU = __builtin_amdgcn_readfirstlane((int)(ngt[wave * 4] + ngt[wave * 4 + 1] + ngt[wave * 4 + 2] + ngt[wave * 4 + 3]));
            E_ADV(us, ut, up, ub1, 4, wave * 4);
            E_FETCH(A, ut, up, ub1, wave * 4, 1); E_LOAD(RA, Ub, A);
#pragma unroll 1
            for (int gi = 0; gi < ngU; gi += 2) {
                E_ADV(us, ut, up, ub1, 4, wave * 4); E_FETCH(B, ut, up, ub1, wave * 4, 1); E_LOAD(RB, Ub, B);
                U_COMP(A, RA);
                E_ADV(us, ut, up, ub1, 4, wave * 4); E_FETCH(A, ut, up, ub1, wave * 4, 1); E_LOAD(RA, Ub, A);
                U_COMP(B, RB);
            }
#undef U_COMP
        }
#pragma unroll 1
        for (int tq = 0; tq < 4; ++tq) {
            float y0[32]; float cs0 = 0.f;
            const int tla = wave * 4 + tq; const size_t ta = (size_t)tok0 + tla;
#pragma unroll
            for (int j = 0; j < 2; ++j)
#pragma unroll
                for (int q = 0; q < 4; ++q) { const size_t e0 = 16 * (size_t)(lane + 64 * j) + 4 * q; const f32x4 xa = *(const GAS f32x4*)(X + ta * DM + e0);
#pragma unroll
                    for (int k = 0; k < 4; ++k) y0[j * 16 + q * 4 + k] = xa[k]; }
            {
                int Atl = 0, Aw = 0, Ap = 0, Ab1 = 0, Aid[4]; float Acf[4], Asu[4]; int Btl = 0, Bw = 0, Bp = 0, Bb1 = 0, Bid[4]; float Bcf[4], Bsu[4]; v4u RA[4][2], RB[4][2];
                (void)Asu; (void)Bsu; (void)Atl; (void)Btl; (void)Aw; (void)Bw;
#define V_COMP(X, REG) { _Pragma("unroll") for (int e = 0; e < 4; ++e) { const float c = (X##p + e < X##b1) ? X##cf[e] : 0.f; cs0 += c; \
                    _Pragma("unroll") for (int j = 0; j < 2; ++j) _Pragma("unroll") for (int w = 0; w < 4; w += 2) { const unsigned dw = REG[e][j][w], dx = REG[e][j][w + 1]; \
                        const float f0 = ubf0(dw), f1 = ubf1(dw), f2 = ubf2(dw), f3 = ubf3(dw), f4 = ubf0(dx), f5 = ubf1(dx), f6 = ubf2(dx), f7 = ubf3(dx);        \
                        y0[j * 16 + w * 4 + 0] += c * f0; y0[j * 16 + w * 4 + 1] += c * f1; y0[j * 16 + w * 4 + 2] += c * f2; y0[j * 16 + w * 4 + 3] += c * f3; \
                        y0[j * 16 + w * 4 + 4] += c * f4; y0[j * 16 + w * 4 + 5] += c * f5; y0[j * 16 + w * 4 + 6] += c * f6; y0[j * 16 + w * 4 + 7] += c * f7; } \
                    TOUCH16(y0, 0); TOUCH16(y0, 16); } }
                int us = 0, ut = -1, up = 0, ub1 = 0;
                const int ngV = __builtin_amdgcn_readfirstlane((int)ngt[tla]);
                E_ADV(us, ut, up, ub1, 1, tla);
                E_FETCH(A, ut, up, ub1, tla, 0); E_LOAD(RA, Vb, A);
#pragma unroll 1
                for (int gi = 0; gi < ngV; gi += 2) {
                    E_ADV(us, ut, up, ub1, 1, tla); E_FETCH(B, ut, up, ub1, tla, 0); E_LOAD(RB, Vb, B);
                    V_COMP(A, RA);
                    E_ADV(us, ut, up, ub1, 1, tla); E_FETCH(A, ut, up, ub1, tla, 0); E_LOAD(RA, Vb, A);
                    V_COMP(B, RB);
                }
#undef V_COMP
            }
#define PV_EPI(YY, CS, T) { float ss = 0.f; const float corr = 128.0f * CS; \
                _Pragma("unroll") for (int i = 0; i < 32; ++i) { YY[i] -= corr; ss += YY[i] * YY[i]; } \
                ss = wave_sum(ss); const float rs = rsqrtf(ss * (1.0f / DM) + RMS_EPS); \
                if (last) { _Pragma("unroll") for (int j = 0; j < 2; ++j) _Pragma("unroll") for (int q = 0; q < 4; ++q) { const size_t e0 = 16 * (size_t)(lane + 64 * j) + 4 * q; const f32x4 ga = *(const GAS f32x4*)(gf + e0); \
                        f32x4 oa = {YY[j * 16 + q * 4 + 0] * rs * ga[0], YY[j * 16 + q * 4 + 1] * rs * ga[1], YY[j * 16 + q * 4 + 2] * rs * ga[2], YY[j * 16 + q * 4 + 3] * rs * ga[3]}; *(GAS f32x4*)(XO + (T) * DM + e0) = oa; } } \
                else { _Pragma("unroll") for (int j = 0; j < 2; ++j) { \
                        _Pragma("unroll") for (int q = 0; q < 4; ++q) { const size_t e0 = 16 * (size_t)(lane + 64 * j) + 4 * q; f32x4 oa = {YY[j * 16 + q * 4 + 0], YY[j * 16 + q * 4 + 1], YY[j * 16 + q * 4 + 2], YY[j * 16 + q * 4 + 3]}; *(GAS f32x4*)(XO + (T) * DM + e0) = oa; } \
                        const size_t e0 = 16 * (size_t)(lane + 64 * j); v4u w0, w1; \
                        w0.x = pk2(YY[j * 16 + 0], YY[j * 16 + 1]); w0.y = pk2(YY[j * 16 + 2], YY[j * 16 + 3]); w0.z = pk2(YY[j * 16 + 4], YY[j * 16 + 5]); w0.w = pk2(YY[j * 16 + 6], YY[j * 16 + 7]); \
                        w1.x = pk2(YY[j * 16 + 8], YY[j * 16 + 9]); w1.y = pk2(YY[j * 16 + 10], YY[j * 16 + 11]); w1.z = pk2(YY[j * 16 + 12], YY[j * 16 + 13]); w1.w = pk2(YY[j * 16 + 14], YY[j * 16 + 15]); \
                        *(GAS v4u*)(xb + (T) * DM + e0) = w0; *(GAS v4u*)(xb + (T) * DM + e0 + 8) = w1; } \
                    if (lane == 0) rstd1[(T)] = rs; } }
            PV_EPI(y0, cs0, ta);
#undef PV_EPI
#undef E_ADV
#undef E_FETCH
#undef E_LOAD
        }
        __syncthreads();
    }
}

#ifndef PROBE_ITEM
#define PROBE_ITEM -1
#endif
#define IREP(k) for (int irep = (PROBE_ITEM == (k)) ? 0 : 1; irep < 2; ++irep)
__device__ __forceinline__ void mix_p2(ArgsR A, int l, LAS unsigned char* lds, int G, int tid) {
    const int bx = blockIdx.x; (void)tid;
    IREP(1) for (int it = bx; it < 512; it += G) f_gla_p2(A, l, it, lds, pg8::fresh_tid());
    IREP(2) for (int it = bx; it < 512; it += G) f_ml_p2(A, l, it, lds, pg8::fresh_tid());
    IREP(3) for (int it = bx; it < 512; it += G) f_gdn_p2(A, l, it, lds, pg8::fresh_tid());
    IREP(4) for (int it = bx; it < 1024; it += G) f_lru_p2(A, l, it, lds, pg8::fresh_tid());
}
__device__ __forceinline__ void part_barrier(unsigned* word, unsigned nb, int tid) {
    asm volatile("s_waitcnt vmcnt(0)" ::: "memory");
    __syncthreads();
    if (tid == 0) {
        __builtin_amdgcn_fence(__ATOMIC_RELEASE, "agent");
        asm volatile("s_waitcnt vmcnt(0)" ::: "memory");
        __hip_atomic_fetch_add(word, 1u, __ATOMIC_RELAXED, __HIP_MEMORY_SCOPE_AGENT);
        unsigned sp = 0;
        while (__hip_atomic_load(word, __ATOMIC_RELAXED, __HIP_MEMORY_SCOPE_AGENT) < nb) { __builtin_amdgcn_s_sleep(2); if (++sp > (1u << 22)) break; }
        __builtin_amdgcn_fence(__ATOMIC_ACQUIRE, "agent");
        asm volatile("s_waitcnt vmcnt(0)" ::: "memory");
    }
    __syncthreads();
}
__device__ __forceinline__ void mix_p3(ArgsR A, int l, LAS unsigned char* lds, int G) {
    const int bx = blockIdx.x;
    const bool split = G > 32;
    int first = 0, nb = G;
    if (split) { if (bx < 16) { IREP(8) f_gdn_p3(A, l, bx, lds, pg8::fresh_tid()); return; } first = 16; nb = G - 16; }
    else { for (int it = bx; it < 16; it += G) f_gdn_p3(A, l, it, lds, pg8::fresh_tid()); }
    for (int it = bx - first; it < 516; it += nb) {
        if (it < 256) f_gla_p3(A, it, pg8::fresh_tid());
        else if (it < 512) f_ml_p3(A, it - 256, pg8::fresh_tid());
        else f_lru_p3(A, it - 512, pg8::fresh_tid());
    }
    IREP(7) { const int t2 = pg8::fresh_tid(); tab_convert(A, l, (bx - first) * NWAVES + __builtin_amdgcn_readfirstlane(t2 >> 6), nb * NWAVES, t2 & 63); }
    part_barrier((unsigned*)(A.ws + WS_CTL) + CW_PBAR + 64 * l, (unsigned)nb, pg8::fresh_tid());
    IREP(5) for (int it = bx - first; it < 512; it += nb) f_gla_p4(A, l, it, lds, pg8::fresh_tid());
    IREP(6) for (int it = nb - 1 - (bx - first); it < 512; it += nb) f_ml_p4(       A, l, it, lds, pg8::fresh_tid());
    for (int it = bx - first; it < 128; it += nb) f_lru_p4(A, it, pg8::fresh_tid());
}

#ifndef PROBE_PHASE
#define PROBE_PHASE -1
#endif
#ifndef MK_PER_PHASE
#define MK_PER_PHASE 0
#endif
#ifdef PROBE_DUP
constexpr int PPL = 7;
#else
constexpr int PPL = 6;
#endif
constexpr int NPHASE = 1 + PPL * DEPTH;
constexpr int CW_BAR = 4096;

__global__ void __launch_bounds__(NTHREADS, 2) mk_fwd(Args args) {
    extern __shared__ __attribute__((aligned(16))) unsigned char lds_raw[];
    LAS unsigned char* lds = (LAS unsigned char*)lds_raw;
    volatile LAS unsigned* MISC = (volatile LAS unsigned*)(lds + MISC_OFF);
    const int G = gridDim.x; const int bx = blockIdx.x;
    unsigned char* ws = args.ws;
    if (threadIdx.x < 64) MISC[threadIdx.x] = 0u;
    __syncthreads();
    XcdBarrier bar; bar.bar = (unsigned*)(ws + WS_CTL) + CW_BAR; bar.x = 0; bar.st = nullptr;
    if (!MK_PER_PHASE) bar = xcd_barrier_post((unsigned*)(ws + WS_CTL) + CW_BAR, MISC + 8);
    const int lo = args.ph_lo, hi = args.ph_hi;
#pragma unroll 1
    for (int ph = lo; ph < hi; ++ph) {
#ifdef PROBE_DUP
        const int l = ph > 0 ? (ph - 1) / PPL : 0, kx = ph > 0 ? (ph - 1) % PPL : -1, k = kx > PROBE_DUP ? kx - 1 : kx; const bool dry = (kx == PROBE_DUP);
#else
        const int l = ph > 0 ? (ph - 1) / PPL : 0, k = ph > 0 ? (ph - 1) % PPL : -1; const bool dry = false;
#endif
        if (k < 0) { const int t0 = pg8::fresh_tid(); const int vcu = (G % 8 == 0) ? (bx % 8) * (G / 8) + bx / 8 : bx; p0_prologue(*kargs(), lds, vcu, G, __builtin_amdgcn_readfirstlane(t0 >> 6), t0 & 63); }
        else if (k == 0) {
            pg8::Gemm g{(const pg8::bf16_t*)(ws + WS_XB), (const pg8::bf16_t*)(ws + WS_WIN + l * WIN_L), NT, NINP, DM}; pg8::StaticOrder S; S.init(NT, NINP, G, bx);
            pg8::EpiP E{(pg8::bf16_t*)(ws + WS_P), (float*)(ws + WS_PS), (const float*)(ws + WS_RSTD1)};
            pg8::gemm_phase<pg8::EpiP, pg8::StaticOrder, true, true>(lds, g, S, E); }
        else if (k == 1) mix_p2(*kargs(), l, lds, G, pg8::fresh_tid());
        else if (k == 2) mix_p3(*kargs(), l, lds, G);
        else if (k == 3) {
            pg8::Gemm g{(const pg8::bf16_t*)(ws + WS_MIX), (const pg8::bf16_t*)(ws + WS_WOUT + l * WSQ_L), NT, DM, DM}; pg8::StaticOrder S; S.init(NT, DM, G, bx);
            pg8::EpiX E{l == 0 ? args.in[I_X] : (const float*)args.out, dry ? (float*)(ws + WS_P) : args.out, (pg8::bf16_t*)(ws + (dry ? WS_Q : WS_XB)), (float*)(ws + (dry ? WS_PS : WS_SSP))};
            pg8::gemm_phase<pg8::EpiX, pg8::StaticOrder, true, true>(lds, g, S, E); }
        else if (k == 4) {
            pg8::Gemm g{(const pg8::bf16_t*)(ws + WS_XB), (const pg8::bf16_t*)(ws + WS_WQ + l * WSQ_L), NT, DM, DM}; pg8::StaticOrder S; S.init(NT, DM, G, bx);
            pg8::EpiQ E{(pg8::bf16_t*)(ws + WS_Q), (const float*)(ws + WS_SSP)};
            pg8::gemm_phase<pg8::EpiQ, pg8::StaticOrder, true, true>(lds, g, S, E); }
        else peer_phase(*kargs(), l, l == DEPTH - 1, dry, lds, G, pg8::fresh_tid());
        if (!MK_PER_PHASE && ph + 1 < hi) xcd_barrier(bar);
    }
}

extern "C" void kernel_launch(void* const* d_in, const int* in_sizes, int n_in, void* d_out, int out_size, void* d_ws, size_t ws_size, hipStream_t stream) {
    static int grid = 0;
    if (grid == 0) {
        if (n_in != N_IN || out_size != NT * DM || ws_size < WS_END) { fprintf(stderr, "kernel_launch: unexpected shapes: n_in %d out %d ws %zu (need %zu)\n", n_in, out_size, ws_size, (size_t)WS_END); grid = -1; return; }
        int dev = 0, cus = 0, per_cu = 0;
        if (hipGetDevice(&dev) != hipSuccess || hipDeviceGetAttribute(&cus, hipDeviceAttributeMultiprocessorCount, dev) != hipSuccess) { grid = -1; return; }
        if (hipFuncSetAttribute((const void*)mk_fwd, hipFuncAttributeMaxDynamicSharedMemorySize, LDS_BYTES) != hipSuccess) { fprintf(stderr, "kernel_launch: hipFuncSetAttribute failed\n"); grid = -1; return; }
        if (hipOccupancyMaxActiveBlocksPerMultiprocessor(&per_cu, (const void*)mk_fwd, NTHREADS, LDS_BYTES) != hipSuccess || per_cu < 1) { fprintf(stderr, "kernel_launch: occupancy query says %d blocks per CU\n", per_cu); (void)hipGetLastError(); grid = -1; return; }
        grid = cus;
    }
    if (grid < 0) return;
    if (hipMemsetAsync((char*)d_ws + WS_CTL, 0, CTL_ZERO_BYTES, stream) != hipSuccess) return;
    Args a{};
    for (int i = 0; i < N_IN; ++i) a.in[i] = (const float*)d_in[i];
    a.out = (float*)d_out; a.ws = (unsigned char*)d_ws;
#if MK_PER_PHASE
    for (int p = 0; p < NPHASE; ++p) { a.ph_lo = p; a.ph_hi = p + 1; a.li = 0; hipLaunchKernelGGL(mk_fwd, dim3(grid), dim3(NTHREADS), LDS_BYTES, stream, a); }
#else
    a.ph_lo = 0; a.ph_hi = NPHASE; a.li = 0;
    hipLaunchKernelGGL(mk_fwd, dim3(grid), dim3(NTHREADS), LDS_BYTES, stream, a);
#endif
}
```

```cpp
#include <hip/hip_runtime.h>
#include <cstdio>
#include <cstdint>
namespace pg8 {
__device__ __forceinline__ int fresh_tid() { int t = threadIdx.x; asm volatile("" : "+v"(t)); return t; }
#define PG8_LAS __attribute__((address_space(3)))
typedef unsigned short bf16_t;
typedef short bf16x8 __attribute__((ext_vector_type(8)));
typedef float f32x4 __attribute__((ext_vector_type(4)));
typedef unsigned u32x4 __attribute__((ext_vector_type(4)));
constexpr int BM = 256, BK = 64, HALF = 128, HTB = HALF * BK * 2  , STAGE_BYTES = 8 * HTB, NXCD = 8, WGM = 8;

__host__ __device__ __forceinline__ int lds_byte(int r, int c) { const int st = (r >> 4) * 2 + (c >> 5), rr = r & 15, cc = c & 31, ob = rr * 64 + cc * 2; return st * 1024 + (ob ^ (((ob >> 9) & 1) << 5)); }
__host__ __device__ __forceinline__ void stage_rc(int b, int& R, int& C) { const int st = b / 1024, sb = b % 1024, swz = sb ^ (((sb >> 9) & 1) << 5); R = (st >> 1) * 16 + swz / 64; C = (st & 1) * 32 + (swz % 64) / 2; }
__host__ __device__ __forceinline__ int perm32(int rho) { const int n = rho >> 4, i = rho & 15; return 8 * (i >> 2) + 4 * n + (i & 3); }

struct Unit { int pm, pn; };
struct Gemm { const bf16_t* A; const bf16_t* Bt; int M, N, K; };

struct StaticOrder {
    int nM, nN, nwg, G, c;
    __host__ __device__ void init(int M, int N, int G_, int c_) { nM = M / BM; nN = N / BM; nwg = nM * nN; G = G_; c = c_; }
    __host__ __device__ bool next(int i, Unit& u) const {
        const long L = (long)i * G + c; if (L >= nwg) return false;
        int wgid = (int)L; { const int q = nwg / NXCD, r = nwg % NXCD, xcd = wgid % NXCD, off = wgid / NXCD; wgid = (xcd < r ? xcd * (q + 1) : r * (q + 1) + (xcd - r) * q) + off; }
        const int nig = WGM * nN, gid = wgid / nig, fm = gid * WGM, gsz = (nM - fm) < WGM ? (nM - fm) : WGM;
        u.pm = fm + ((wgid % nig) % gsz); u.pn = (wgid % nig) / gsz; return true;
    }
    __device__ __forceinline__ void a_ready(const Unit&) const {}
    __device__ __forceinline__ void done(const Unit&) const {}
};


__device__ __forceinline__ unsigned cvt_pk_bf16(float lo, float hi) { unsigned r; asm volatile("v_cvt_pk_bf16_f32 %0, %1, %2" : "=v"(r) : "v"(lo), "v"(hi)); return r; }

struct EpiP {
    static constexpr bool PERM = true, AFTER_DRAIN = false;
    bf16_t* P; float* Ps; const float* rstd;
    __device__ __forceinline__ void operator()(const f32x4 (&acc)[2][2][4][2], const Unit& u, int wr, int wc, int fr, int fq) const {
        const int row0 = u.pm * BM + wr * 64 + fr;
        if (u.pn < 28) {
            const int col0 = u.pn * BM + wc * 32 + 8 * fq;
#pragma unroll
            for (int ai = 0; ai < 2; ++ai)
#pragma unroll
                for (int m = 0; m < 4; ++m) { const int row = row0 + ai * HALF + m * 16; const float r = rstd[row]; bf16_t* rowp = P + (size_t)row * 7168 + col0;
#pragma unroll
                    for (int bj = 0; bj < 2; ++bj) { const f32x4 v0 = acc[ai][bj][m][0] * r, v1 = acc[ai][bj][m][1] * r;
                        u32x4 w; w.x = cvt_pk_bf16(v0[0], v0[1]); w.y = cvt_pk_bf16(v0[2], v0[3]); w.z = cvt_pk_bf16(v1[0], v1[1]); w.w = cvt_pk_bf16(v1[2], v1[3]);
                        *(u32x4*)(rowp + bj * HALF) = w; } }
        } else if (wc == 0) {
#pragma unroll
            for (int ai = 0; ai < 2; ++ai)
#pragma unroll
                for (int m = 0; m < 4; ++m) { const int row = row0 + ai * HALF + m * 16; const float r = rstd[row]; float* p = Ps + (size_t)row * 32 + 8 * fq;
                    *(f32x4*)p = acc[ai][0][m][0] * r; *(f32x4*)(p + 4) = acc[ai][0][m][1] * r; }
        }
    }
};
struct EpiX {
    static constexpr bool PERM = true, AFTER_DRAIN = false;
    const float* xres; float* xout; bf16_t* xb; float* ssp;
    __device__ __forceinline__ void operator()(const f32x4 (&acc)[2][2][4][2], const Unit& u, int wr, int wc, int fr, int fq) const {
        const int row0 = u.pm * BM + wr * 64 + fr, col0 = u.pn * BM + wc * 32 + 8 * fq;
#pragma unroll
        for (int ai = 0; ai < 2; ++ai)
#pragma unroll
            for (int m = 0; m < 4; ++m) { const int row = row0 + ai * HALF + m * 16; float ss = 0.f;
#pragma unroll
                for (int bj = 0; bj < 2; ++bj) { const size_t off = (size_t)row * 2048 + col0 + bj * HALF;
                    const f32x4 r0 = *(const f32x4*)(xres + off), r1 = *(const f32x4*)(xres + off + 4);
                    const f32x4 v0 = acc[ai][bj][m][0] + r0, v1 = acc[ai][bj][m][1] + r1;
                    *(f32x4*)(xout + off) = v0; *(f32x4*)(xout + off + 4) = v1;
                    u32x4 w; w.x = cvt_pk_bf16(v0[0], v0[1]); w.y = cvt_pk_bf16(v0[2], v0[3]); w.z = cvt_pk_bf16(v1[0], v1[1]); w.w = cvt_pk_bf16(v1[2], v1[3]);
                    *(u32x4*)(xb + off) = w;
                    ss += (v0[0] * v0[0] + v0[1] * v0[1]) + (v0[2] * v0[2] + v0[3] * v0[3]) + (v1[0] * v1[0] + v1[1] * v1[1]) + (v1[2] * v1[2] + v1[3] * v1[3]); }
                ss += __shfl_xor(ss, 16); ss += __shfl_xor(ss, 32);
                if (fq == 0) ssp[(size_t)row * 32 + u.pn * 4 + wc] = ss; }
    }
};
struct EpiQ {
    static constexpr bool PERM = true, AFTER_DRAIN = false;
    bf16_t* Q; const float* ssp;
    __device__ __forceinline__ void operator()(const f32x4 (&acc)[2][2][4][2], const Unit& u, int wr, int wc, int fr, int fq) const {
        const int row0 = u.pm * BM + wr * 64 + fr, col0 = u.pn * BM + wc * 32 + 8 * fq;
#pragma unroll
        for (int ai = 0; ai < 2; ++ai)
#pragma unroll
            for (int m = 0; m < 4; ++m) { const int row = row0 + ai * HALF + m * 16;
                const f32x4* sp = (const f32x4*)(ssp + (size_t)row * 32 + 8 * fq); const f32x4 a = sp[0], b = sp[1];
                float s = ((a[0] + a[1]) + (a[2] + a[3])) + ((b[0] + b[1]) + (b[2] + b[3]));
                s += __shfl_xor(s, 16); s += __shfl_xor(s, 32);
                const float r = rsqrtf(s * (1.0f / 2048.0f) + 1e-6f); bf16_t* rowp = Q + (size_t)row * 2048 + col0;
#pragma unroll
                for (int bj = 0; bj < 2; ++bj) { const f32x4 v0 = acc[ai][bj][m][0] * r, v1 = acc[ai][bj][m][1] * r;
                    u32x4 w; w.x = cvt_pk_bf16(v0[0], v0[1]); w.y = cvt_pk_bf16(v0[2], v0[3]); w.z = cvt_pk_bf16(v1[0], v1[1]); w.w = cvt_pk_bf16(v1[2], v1[3]);
                    *(u32x4*)(rowp + bj * HALF) = w; } }
    }
};

template <class Epi, class Sched, bool ALIGN_EPI = false, bool SP2 = false>
__device__ __forceinline__ void gemm_phase(PG8_LAS unsigned char* lds, const Gemm g, const Sched& S, const Epi& E) {
    const int tid = fresh_tid(), wid = __builtin_amdgcn_readfirstlane(tid >> 6), lane = tid & 63, wr = wid >> 2, wc = wid & 3, fr = lane & 15, fq = lane >> 4;
    const int K = g.K, nt = K / BK;
    unsigned voffA[2], voffB[2];
#pragma unroll
    for (int i = 0; i < 2; ++i) { int R, C; stage_rc(tid * 16 + i * 8192, R, C); const int Rb = Epi::PERM ? ((R & ~31) + perm32(R & 31)) : R;
        voffA[i] = (unsigned)(R * K + C) * 2u; voffB[i] = (unsigned)(Rb * K + C) * 2u; }
    const size_t kstep = (size_t)(BK * 2);
    const size_t hstep = (size_t)HALF * K * 2;
    const size_t tstep = 2 * hstep;
    const unsigned ldsw = (unsigned)wid * 1024u;
    const int aoff = lds_byte(wr * 64 + fr, fq * 8), boff = lds_byte(wc * 32 + fr, fq * 8);
#define PG8_SA(b, h) (((b) * 2 + (h)) * HTB)
#define PG8_SB(b, h) ((4 + (b) * 2 + (h)) * HTB)
#define PG8_STAGE(bufoff, gbase, voff) do { _Pragma("unroll") for (int _i = 0; _i < 2; ++_i) \
        __builtin_amdgcn_global_load_lds((const unsigned*)((const char*)(gbase) + (voff)[_i]), (PG8_LAS unsigned*)(lds + (bufoff) + ldsw + _i * 8192), 16, 0, 0); } while (0)
#define PG8_LDA(dst, b, h) do { _Pragma("unroll") for (int m = 0; m < 4; ++m) _Pragma("unroll") for (int k = 0; k < 2; ++k) dst[m][k] = *(const PG8_LAS bf16x8*)(lds + PG8_SA(b, h) + aoff + m * 2048 + k * 1024); } while (0)
#define PG8_LDB(dst, b, h) do { _Pragma("unroll") for (int n = 0; n < 2; ++n) _Pragma("unroll") for (int k = 0; k < 2; ++k) dst[n][k] = *(const PG8_LAS bf16x8*)(lds + PG8_SB(b, h) + boff + n * 2048 + k * 1024); } while (0)
#define PG8_MMA(ai, bj, At, Bt) do { __builtin_amdgcn_s_setprio(1); _Pragma("unroll") for (int m = 0; m < 4; ++m) _Pragma("unroll") for (int n = 0; n < 2; ++n) _Pragma("unroll") for (int k = 0; k < 2; ++k) \
        acc[ai][bj][m][n] = __builtin_amdgcn_mfma_f32_16x16x32_bf16(Bt[n][k], At[m][k], acc[ai][bj][m][n], 0, 0, 0); __builtin_amdgcn_s_setprio(0); } while (0)
#define PG8_WAIT_V(n) asm volatile("s_waitcnt vmcnt(" #n ")" ::: "memory")
#define PG8_WAIT_L(n) asm volatile("s_waitcnt lgkmcnt(" #n ")" ::: "memory")
#define PG8_BAR __builtin_amdgcn_s_barrier()
#define PG8_SCHED __builtin_amdgcn_sched_barrier(0)
    Unit cur, nxt; int ui = 0;
    if (!S.next(0, cur)) return;
    f32x4 acc[2][2][4][2];
#pragma unroll
    for (int a = 0; a < 2; ++a)
#pragma unroll
        for (int b = 0; b < 2; ++b)
#pragma unroll
            for (int m = 0; m < 4; ++m)
#pragma unroll
                for (int n = 0; n < 2; ++n) acc[a][b][m][n] = (f32x4){0.f, 0.f, 0.f, 0.f};
    bf16x8 At[4][2], B0[2][2], B1[2][2];
    const char* cA = (const char*)g.A + (size_t)cur.pm * tstep; const char* cB = (const char*)g.Bt + (size_t)cur.pn * tstep;
    S.a_ready(cur);
    if constexpr (SP2) {
        PG8_STAGE(PG8_SB(0, 0), cB, voffB); PG8_STAGE(PG8_SB(0, 1), cB + hstep, voffB); PG8_STAGE(PG8_SA(0, 0), cA, voffA); PG8_STAGE(PG8_SA(0, 1), cA + hstep, voffA);
        if (wr == 1) PG8_BAR;
        PG8_WAIT_V(2); PG8_BAR;
        PG8_STAGE(PG8_SB(1, 0), cB + kstep, voffB); PG8_STAGE(PG8_SA(1, 0), cA + kstep, voffA); PG8_STAGE(PG8_SB(1, 1), cB + hstep + kstep, voffB);
        PG8_WAIT_V(6); PG8_BAR;
    } else {
        PG8_STAGE(PG8_SB(0, 0), cB, voffB); PG8_STAGE(PG8_SA(0, 0), cA, voffA); PG8_STAGE(PG8_SB(0, 1), cB + hstep, voffB); PG8_STAGE(PG8_SA(0, 1), cA + hstep, voffA);
        if (wr == 1) PG8_BAR;
        PG8_WAIT_V(4); PG8_BAR;
        PG8_STAGE(PG8_SB(1, 0), cB + kstep, voffB); PG8_STAGE(PG8_SA(1, 0), cA + kstep, voffA); PG8_STAGE(PG8_SB(1, 1), cB + hstep + kstep, voffB);
        PG8_WAIT_V(6); PG8_BAR;
    }
    for (;;) {
        const bool has_next = S.next(ui + 1, nxt);
        const char* nA = has_next ? (const char*)g.A + (size_t)nxt.pm * tstep : cA; const char* nB = has_next ? (const char*)g.Bt + (size_t)nxt.pn * tstep : cB;
        for (int t = 0; t < nt; t += 2) {
            const bool last = (t == nt - 2);
            const char* a1 = cA + (size_t)(t + 1) * kstep;
            const char* a2 = last ? nA : cA + (size_t)(t + 2) * kstep; const char* b2 = last ? nB : cB + (size_t)(t + 2) * kstep;
            const char* a3 = a2 + kstep; const char* b3 = b2 + kstep;
            if (last && has_next) S.a_ready(nxt);
            if constexpr (SP2) {
            PG8_LDB(B0, 0, 0); PG8_LDB(B1, 0, 1); PG8_SCHED; PG8_LDA(At, 0, 0); PG8_STAGE(PG8_SA(1, 1), a1 + hstep, voffA);
            PG8_WAIT_V(8); PG8_WAIT_L(0); PG8_BAR; PG8_MMA(0, 0, At, B0); PG8_MMA(0, 1, At, B1); PG8_BAR; PG8_SCHED;
            PG8_LDA(At, 0, 1); PG8_STAGE(PG8_SB(0, 0), b2, voffB); PG8_STAGE(PG8_SB(0, 1), b2 + hstep, voffB); PG8_STAGE(PG8_SA(0, 0), a2, voffA);
            PG8_WAIT_V(8); PG8_WAIT_L(0); PG8_BAR; PG8_MMA(1, 0, At, B0); PG8_MMA(1, 1, At, B1); PG8_BAR; PG8_SCHED;
            PG8_LDB(B0, 1, 0); PG8_LDB(B1, 1, 1); PG8_SCHED; PG8_LDA(At, 1, 0); PG8_STAGE(PG8_SA(0, 1), a2 + hstep, voffA);
            PG8_WAIT_V(8); PG8_WAIT_L(0); PG8_BAR; PG8_MMA(0, 0, At, B0); PG8_MMA(0, 1, At, B1); PG8_BAR; PG8_SCHED;
            PG8_LDA(At, 1, 1); PG8_STAGE(PG8_SB(1, 0), b3, voffB); PG8_STAGE(PG8_SB(1, 1), b3 + hstep, voffB); PG8_STAGE(PG8_SA(1, 0), a3, voffA);
            PG8_WAIT_V(8); PG8_WAIT_L(0); PG8_BAR; PG8_MMA(1, 0, At, B0); PG8_MMA(1, 1, At, B1); PG8_BAR; PG8_SCHED;
            } else {
            PG8_LDB(B0, 0, 0); PG8_SCHED; PG8_LDA(At, 0, 0); PG8_STAGE(PG8_SA(1, 1), a1 + hstep, voffA);
            PG8_WAIT_L(8); PG8_BAR; PG8_WAIT_L(0); PG8_MMA(0, 0, At, B0); PG8_BAR; PG8_SCHED;
            PG8_LDB(B1, 0, 1); PG8_STAGE(PG8_SB(0, 0), b2, voffB);
            PG8_BAR; PG8_WAIT_L(0); PG8_MMA(0, 1, At, B1); PG8_BAR;
            PG8_LDA(At, 0, 1); PG8_STAGE(PG8_SA(0, 0), a2, voffA);
            PG8_BAR; PG8_WAIT_L(0); PG8_MMA(1, 0, At, B0); PG8_BAR; PG8_SCHED;
            PG8_STAGE(PG8_SB(0, 1), b2 + hstep, voffB);
            PG8_WAIT_V(6); PG8_BAR; PG8_MMA(1, 1, At, B1); PG8_BAR;
            PG8_LDB(B0, 1, 0); PG8_SCHED; PG8_LDA(At, 1, 0); PG8_STAGE(PG8_SA(0, 1), a2 + hstep, voffA);
            PG8_WAIT_L(8); PG8_BAR; PG8_WAIT_L(0); PG8_MMA(0, 0, At, B0); PG8_BAR; PG8_SCHED;
            PG8_LDB(B1, 1, 1); PG8_STAGE(PG8_SB(1, 0), b3, voffB);
            PG8_BAR; PG8_WAIT_L(0); PG8_MMA(0, 1, At, B1); PG8_BAR;
            PG8_LDA(At, 1, 1); PG8_STAGE(PG8_SA(1, 0), a3, voffA);
            PG8_BAR; PG8_WAIT_L(0); PG8_MMA(1, 0, At, B0); PG8_BAR; PG8_SCHED;
            PG8_STAGE(PG8_SB(1, 1), b3 + hstep, voffB);
            PG8_WAIT_V(6); PG8_BAR; PG8_MMA(1, 1, At, B1); PG8_BAR;
            }
        }
        if constexpr (ALIGN_EPI) { if (wr == 0) PG8_BAR; }
        if constexpr (!Epi::AFTER_DRAIN) { E(acc, cur, wr, wc, fr, fq); S.done(cur); }
        if (!has_next) break;
#pragma unroll
        for (int a = 0; a < 2; ++a)
#pragma unroll
            for (int b = 0; b < 2; ++b)
#pragma unroll
                for (int m = 0; m < 4; ++m)
#pragma unroll
                    for (int n = 0; n < 2; ++n) acc[a][b][m][n] = (f32x4){0.f, 0.f, 0.f, 0.f};
        cur = nxt; cA = nA; cB = nB; ++ui;
        if constexpr (ALIGN_EPI) { if (wr == 1) PG8_BAR; }
    }
    PG8_WAIT_V(0);
    if constexpr (!ALIGN_EPI) { if (wr == 0) PG8_BAR; }
    PG8_BAR;
    if constexpr (Epi::AFTER_DRAIN) { E.fused(acc, cur, wr, wc, fr, fq, lds, wid, lane); S.done(cur); }
#undef PG8_SA
#undef PG8_SB
#undef PG8_STAGE
#undef PG8_LDA
#undef PG8_LDB
#undef PG8_MMA
#undef PG8_WAIT_V
#undef PG8_WAIT_L
#undef PG8_BAR
#undef PG8_SCHED
}
}

constexpr int NWAVES = 8, NTHREADS = 512;
constexpr int NT = 8192, DM = 2048, SEQ = 2048, NBATCH = 4, DEPTH = 2, CHK = 64, NCHK = 32, GW = 512, NH = 4, HD = 128;
constexpr int DIN = 7200, NINP = 7424, PBW = 7168;
constexpr int NEXP = 16384;
constexpr int PC_GLA_Q = 0, PC_GLA_K = 512, PC_GLA_V = 1024, PC_GLA_G = 1536, PC_LRU_X = 2048, PC_LRU_Y = 2560, PC_ML_Q = 3072, PC_ML_K = 3584, PC_ML_V = 4096, PC_ML_O = 4608,
              PC_GDN_Q = 5120, PC_GDN_K = 5632, PC_GDN_V = 6144, PC_GDN_G = 6656;
constexpr int PS_LR = 0, PS_MI = 16, PS_MF = 20, PS_GB = 24, PS_GA = 28;
constexpr float RMS_EPS = 1e-6f;
enum { I_X = 0, I_N1G, I_WIN, I_WOUT, I_GLA_W2, I_GLA_B2, I_GLA_NG, I_LRU_CW, I_LRU_CB, I_LRU_WA, I_LRU_BA, I_LRU_WX, I_LRU_BX, I_LRU_LAM, I_ML_IB, I_ML_FB, I_ML_NG,
       I_GDN_CW, I_GDN_ALOG, I_GDN_DTB, I_GDN_NG, I_N2G, I_PWQ, I_PK1, I_PK2, I_PU, I_PV, I_FNG, N_IN };

constexpr size_t MiB = 1u << 20;
constexpr size_t WS_CTL = 0, CTL_ZERO_BYTES = 1 * MiB;
constexpr size_t WS_WIN = 2 * MiB;
constexpr size_t WIN_L = (size_t)NINP * DM * 2;
constexpr size_t WS_WOUT = 60 * MiB;
constexpr size_t WS_WQ = 76 * MiB;
constexpr size_t WSQ_L = (size_t)DM * DM * 2;
constexpr size_t WS_K1 = 92 * MiB, WS_K2 = 92 * MiB + 512 * 1024;
constexpr size_t WS_RSTD1 = 93 * MiB;
constexpr size_t WS_SSP = 94 * MiB;
constexpr size_t WS_XB = 96 * MiB;
constexpr size_t WS_P = 128 * MiB;
constexpr size_t WS_PS = 240 * MiB;
constexpr size_t WS_MIX = 242 * MiB;
constexpr size_t WS_Q = 274 * MiB;
constexpr size_t WS_UB = 306 * MiB;
constexpr size_t WS_VB = 434 * MiB;
constexpr size_t TAB_L = (size_t)NEXP * DM * 2;
constexpr size_t WS_SCR = 562 * MiB;
constexpr size_t WS_END = 900 * MiB;

constexpr int LDS_BYTES = 155648;
constexpr int MISC_OFF = LDS_BYTES - 256;

#define GAS __attribute__((address_space(1)))
#define LAS __attribute__((address_space(3)))
typedef unsigned short bf16;
typedef unsigned v4u __attribute__((ext_vector_type(4)));
typedef unsigned v2u __attribute__((ext_vector_type(2)));
typedef float f32x4 __attribute__((ext_vector_type(4)));
typedef float f32x2 __attribute__((ext_vector_type(2)));
typedef short bf16x8 __attribute__((ext_vector_type(8)));
typedef short bf16x4 __attribute__((ext_vector_type(4)));
typedef __bf16 bf2_t __attribute__((ext_vector_type(2)));
typedef GAS unsigned gu32;
#define RLX_AGENT __ATOMIC_RELAXED, __HIP_MEMORY_SCOPE_AGENT
__device__ __forceinline__ unsigned f2bf(float f) { unsigned u = __builtin_bit_cast(unsigned, f); return (u + 0x7fffu + ((u >> 16) & 1u)) >> 16; }
__device__ __forceinline__ unsigned pk2(float lo, float hi) { return f2bf(lo) | (f2bf(hi) << 16); }
__device__ __forceinline__ float bf2f(unsigned b) { return __builtin_bit_cast(float, b << 16); }
__device__ __forceinline__ float bflo(unsigned w) { return __builtin_bit_cast(float, w << 16); }
__device__ __forceinline__ float bfhi(unsigned w) { return __builtin_bit_cast(float, w & 0xffff0000u); }
template <int CTRL> __device__ __forceinline__ unsigned dpp_rot_u(unsigned v) { return (unsigned)__builtin_amdgcn_update_dpp(0, (int)v, CTRL, 0xf, 0xf, false); }
__device__ __forceinline__ unsigned row_max_u(unsigned v) { v = max(v, dpp_rot_u<0x121>(v)); v = max(v, dpp_rot_u<0x122>(v)); v = max(v, dpp_rot_u<0x124>(v)); v = max(v, dpp_rot_u<0x128>(v)); return v; }
template <int CTRL> __device__ __forceinline__ float dpp_rotf(float v) { const unsigned u = __builtin_bit_cast(unsigned, v); return __builtin_bit_cast(float, dpp_rot_u<CTRL>(u)); }
__device__ __forceinline__ float row_max_f(float v) { v = fmaxf(v, dpp_rotf<0x121>(v)); v = fmaxf(v, dpp_rotf<0x122>(v)); v = fmaxf(v, dpp_rotf<0x124>(v)); v = fmaxf(v, dpp_rotf<0x128>(v)); return v; }
__device__ __forceinline__ float row_sum_f(float v) { v += dpp_rotf<0x121>(v); v += dpp_rotf<0x122>(v); v += dpp_rotf<0x124>(v); v += dpp_rotf<0x128>(v); return v; }

__device__ __forceinline__ float oct_sum_f(float v) { v += dpp_rotf<0xB1>(v); v += dpp_rotf<0x4E>(v); v += dpp_rotf<0x141>(v); return v; }
__device__ __forceinline__ float lane_bcast(float v, int l) { return __builtin_bit_cast(float, __builtin_amdgcn_readlane(__builtin_bit_cast(int, v), l)); }
__device__ __forceinline__ float wave_sum(float v) { const float r = row_sum_f(v); return (lane_bcast(r, 0) + lane_bcast(r, 16)) + (lane_bcast(r, 32) + lane_bcast(r, 48)); }
__device__ __forceinline__ float wave_max(float v) { const float r = row_max_f(v); return fmaxf(fmaxf(lane_bcast(r, 0), lane_bcast(r, 16)), fmaxf(lane_bcast(r, 32), lane_bcast(r, 48))); }
__device__ __forceinline__ float rcpf_(float x) { return __builtin_amdgcn_rcpf(x); }
__device__ __forceinline__ float sigmoidf_(float x) { return rcpf_(1.0f + __expf(-x)); }
__device__ __forceinline__ float siluf_(float x) { return x * rcpf_(1.0f + __expf(-x)); }
__device__ __forceinline__ float softplusf_(float x) { return fmaxf(x, 0.f) + __logf(1.0f + __expf(-fabsf(x))); }
__device__ __forceinline__ float logsigmoidf_(float x) { return fminf(x, 0.f) - __logf(1.0f + __expf(-fabsf(x))); }
__device__ __forceinline__ float gelu_tanh(float x) { const float u = 1.5957691216057308f * (x + 0.044715f * x * x * x); return x * rcpf_(1.0f + __expf(-u)); }

#define XB_TMO      128
#define XB_XCNT(j)  (256  + 64 * (j))
#define XB_XSUB(j)  (1280 + 64 * (j))
#define XB_XGEN(j)  (2304 + 64 * (j))
#define XB_TOP      3328
#define XB_TOPGEN   3392
#define XCD_BAR_WORDS 3456
#define XB_SPIN_CAP (1u << 18)

__device__ __forceinline__ unsigned xb_ld(unsigned* p)              { return __hip_atomic_load(p, __ATOMIC_RELAXED, __HIP_MEMORY_SCOPE_AGENT); }
__device__ __forceinline__ unsigned xb_add(unsigned* p, unsigned v) { return __hip_atomic_fetch_add(p, v, __ATOMIC_RELAXED, __HIP_MEMORY_SCOPE_AGENT); }
__device__ __forceinline__ unsigned xb_xcc_id() { return (unsigned)__builtin_amdgcn_s_getreg((3 << 11) | 20) & 0xFu; }
#define XB_SPIN(cond, bar) do { unsigned _sp = 0; while (cond) { __builtin_amdgcn_s_sleep(1); \
    if ((++_sp & 255u) == 0u) { if (xb_ld(&(bar)[XB_TMO])) break; if (_sp > XB_SPIN_CAP) { atomicAdd(&(bar)[XB_TMO], 1u); break; } } } } while (0)

struct XcdBarrier {
    unsigned* bar; unsigned x;
    volatile LAS unsigned* st;
};

__device__ __forceinline__ XcdBarrier xcd_barrier_post(unsigned* bar, volatile LAS unsigned* st) {
    XcdBarrier b; b.bar = bar; b.x = xb_xcc_id(); b.st = st;
    if (threadIdx.x == 0) (void)xb_add(&bar[XB_XCNT(b.x)], 1u);
    return b;
}
__device__ __forceinline__ void xcd_barrier_complete(unsigned* bar, unsigned x, unsigned& nloc, unsigned& nx) {
    const unsigned G = gridDim.x * gridDim.y * gridDim.z;
    unsigned sum, cnt, mine, sp = 0u;
    for (;;) {
        sum = 0u; cnt = 0u; mine = 0u;
#pragma unroll
        for (unsigned j = 0; j < 16; ++j) { const unsigned c = xb_ld(&bar[XB_XCNT(j)]); sum += c; cnt += (c > 0u) ? 1u : 0u; mine = (j == x) ? c : mine; }
        if (sum == G) break;
        __builtin_amdgcn_s_sleep(1);
        if ((++sp & 255u) == 0u) { if (xb_ld(&bar[XB_TMO])) break; if (sp > XB_SPIN_CAP) { atomicAdd(&bar[XB_TMO], 1u); break; } }
    }
    nloc = mine > 0u ? mine : 1u; nx = cnt > 0u ? cnt : 1u;
}

__device__ __forceinline__ void xcd_barrier(const XcdBarrier& b) {
    asm volatile("s_waitcnt vmcnt(0)" ::: "memory");
    __syncthreads();
    if (threadIdx.x == 0) {
        unsigned* bar = b.bar; asm volatile("" : "+s"(bar));
        __builtin_amdgcn_s_waitcnt(0);
        unsigned nloc = b.st[0], nx = b.st[1];
        if (nloc == 0u) { xcd_barrier_complete(bar, b.x, nloc, nx); b.st[0] = nloc; b.st[1] = nx; }
        const unsigned old = xb_add(&bar[XB_XSUB(b.x)], 1u);
        const unsigned gen = old / nloc;
        if (old + 1u == (gen + 1u) * nloc) {
            __builtin_amdgcn_fence(__ATOMIC_RELEASE, "agent");
            asm volatile("s_waitcnt vmcnt(0)" ::: "memory");
            const unsigned og = xb_add(&bar[XB_TOP], 1u);
            const unsigned tg = og / nx;
            if (og + 1u == (tg + 1u) * nx) xb_add(&bar[XB_TOPGEN], 1u);
            else XB_SPIN(xb_ld(&bar[XB_TOPGEN]) == tg, bar);
            __builtin_amdgcn_fence(__ATOMIC_ACQUIRE, "agent");
            xb_add(&bar[XB_XGEN(b.x)], 1u);
            asm volatile("s_waitcnt vmcnt(0)" ::: "memory");
        } else {
            XB_SPIN(xb_ld(&bar[XB_XGEN(b.x)]) == gen, bar);
            __builtin_amdgcn_fence(__ATOMIC_ACQUIRE, "agent");
            asm volatile("s_waitcnt vmcnt(0)" ::: "memory");
        }
    }
    __syncthreads();
}


struct Args { const float* in[N_IN]; float* out; unsigned char* ws; int ph_lo, ph_hi, li, pad; };
typedef const __attribute__((address_space(4))) Args& ArgsR;
__device__ __forceinline__ const __attribute__((address_space(4))) Args* kargs() { unsigned long long p = (unsigned long long)__builtin_amdgcn_kernarg_segment_ptr(); asm volatile("" : "+s"(p)); return (const __attribute__((address_space(4))) Args*)p; }

__device__ __forceinline__ int win_src_col(int n) {
    if (n < 2048) return n;
    if (n < 3072) return 2064 + (n - 2048);
    if (n < 5120) return 3088 + (n - 3072);
    if (n < 7168) return 5144 + (n - 5120);
    if (n < 7184) return 2048 + (n - 7168);
    if (n < 7192) return 5136 + (n - 7184);
    if (n < 7200) return n;
    return -1;
}
template <bool MAP>
__device__ __forceinline__ void p0_transpose_item(const float* W, int K, int Nsrc, int Ndst, const float* gain, bf16* WT, LAS float* scr, int item, int lane) {
    const int nblk = Ndst / 32, kb = item / nblk, nb = item % nblk, k0 = 64 * kb, n0 = 32 * nb;
    const int nn = n0 + (lane & 31); const int src = MAP ? win_src_col(nn) : nn;
    float tv[32];
#pragma unroll
    for (int i = 0; i < 32; ++i) { const int kk = 2 * i + (lane >> 5); tv[i] = (src >= 0) ? W[(size_t)(k0 + kk) * Nsrc + src] : 0.f; }
#pragma unroll
    for (int i = 0; i < 32; ++i) { const int kk = 2 * i + (lane >> 5); float v = tv[i]; if (gain) v *= gain[k0 + kk]; scr[kk * 33 + (lane & 31)] = v; }
    asm volatile("s_waitcnt lgkmcnt(0)" ::: "memory");
    const int c = lane & 7;
#pragma unroll
    for (int j = 0; j < 4; ++j) { const int n = (lane >> 3) + 8 * j; const LAS float* s = scr + (8 * c) * 33 + n;
        v4u o; o.x = pk2(s[0 * 33], s[1 * 33]); o.y = pk2(s[2 * 33], s[3 * 33]); o.z = pk2(s[4 * 33], s[5 * 33]); o.w = pk2(s[6 * 33], s[7 * 33]);
        *(GAS v4u*)(WT + (size_t)(n0 + n) * K + k0 + 8 * c) = o; }
    asm volatile("s_waitcnt lgkmcnt(0)" ::: "memory");
}
__device__ __forceinline__ void p0_convert(const float* src, bf16* dst, size_t n, size_t gtid, size_t gthreads) {
    for (size_t i = gtid * 8; i < n; i += gthreads * 8) {
        const f32x4 a = *(const GAS f32x4*)(src + i), b = *(const GAS f32x4*)(src + i + 4);
        v4u o; o.x = pk2(a[0], a[1]); o.y = pk2(a[2], a[3]); o.z = pk2(b[0], b[1]); o.w = pk2(b[2], b[3]);
        *(GAS v4u*)(dst + i) = o; }
}
__device__ __forceinline__ void p0_prologue(ArgsR A, LAS unsigned char* lds, int vcu, int G, int wave, int lane) {
    unsigned char* ws = A.ws;
    LAS float* scr = (LAS float*)(lds + wave * 16384);
    const int gw = vcu * NWAVES + wave, NGW = G * NWAVES;
    constexpr int I_IN = (DM / 64) * (NINP / 32), I_SQ = (DM / 64) * (DM / 32), I_LAYER = I_IN + 2 * I_SQ, NITEMS = DEPTH * I_LAYER;
    for (int it = gw; it < NITEMS; it += NGW) {
        const int l = it / I_LAYER; int r = it % I_LAYER;
        if (r < I_IN) { p0_transpose_item<true>(A.in[I_WIN] + (size_t)l * DM * DIN, DM, DIN, NINP, A.in[I_N1G] + l * DM, (bf16*)(ws + WS_WIN + l * WIN_L), scr, r, lane); continue; } r -= I_IN;
        if (r < I_SQ) { p0_transpose_item<false>(A.in[I_WOUT] + (size_t)l * DM * DM, DM, DM, DM, nullptr, (bf16*)(ws + WS_WOUT + l * WSQ_L), scr, r, lane); continue; } r -= I_SQ;
        p0_transpose_item<false>(A.in[I_PWQ] + (size_t)l * DM * DM, DM, DM, DM, A.in[I_N2G] + l * DM, (bf16*)(ws + WS_WQ + l * WSQ_L), scr, r, lane);
    }
    const size_t gtid = (size_t)gw * 64 + lane, gthreads = (size_t)NGW * 64;
    p0_convert(A.in[I_PK1], (bf16*)(ws + WS_K1), (size_t)DEPTH * 8 * 128 * 128, gtid, gthreads);
    p0_convert(A.in[I_PK2], (bf16*)(ws + WS_K2), (size_t)DEPTH * 8 * 128 * 128, gtid, gthreads);
    const float* x = A.in[I_X]; bf16* xb = (bf16*)(ws + WS_XB); float* rstd1 = (float*)(ws + WS_RSTD1);
    for (int m = gw; m < NT; m += NGW) {
        const GAS f32x4* xr = (const GAS f32x4*)(x + (size_t)m * DM) + lane;
        f32x4 v[8]; float s = 0.f;
#pragma unroll
        for (int j = 0; j < 8; ++j) { v[j] = xr[64 * j]; s += (v[j][0] * v[j][0] + v[j][1] * v[j][1]) + (v[j][2] * v[j][2] + v[j][3] * v[j][3]); }
        s = wave_sum(s);
        GAS v2u* o = (GAS v2u*)(xb + (size_t)m * DM) + lane;
#pragma unroll
        for (int j = 0; j < 8; ++j) { v2u w; w.x = pk2(v[j][0], v[j][1]); w.y = pk2(v[j][2], v[j][3]); o[64 * j] = w; }
        if (lane == 0) rstd1[m] = rsqrtf(s * (1.0f / DM) + RMS_EPS);
    }
}

constexpr size_t WS_GLA_INC = 562 * MiB;
constexpr size_t WS_GLA_DEC = 594 * MiB;
constexpr size_t WS_GLA_ST = 595 * MiB;
constexpr size_t WS_ML_INC = 611 * MiB;
constexpr size_t WS_ML_N = 643 * MiB;
constexpr size_t WS_ML_SC = 643 * MiB + 512 * 1024;
constexpr size_t WS_ML_ST = 644 * MiB;
constexpr size_t WS_ML_NP = 660 * MiB;
constexpr size_t WS_ML_MP = 660 * MiB + 512 * 1024;
constexpr size_t WS_GDN_U0 = 661 * MiB, WS_GDN_W = 669 * MiB, WS_GDN_QD = 677 * MiB, WS_GDN_KE = 685 * MiB;
constexpr size_t WS_GDN_QK = 693 * MiB;
constexpr size_t WS_GDN_DE = 697 * MiB;
constexpr size_t WS_GDN_O = 698 * MiB;
constexpr size_t WS_LRU_HL = 714 * MiB, WS_LRU_AP = 730 * MiB;
constexpr size_t WS_LRU_CARRY = 746 * MiB;
static_assert(WS_LRU_CARRY + 4 * 32 * 512 * 4 <= WS_END, "ws map");

constexpr int CW_PBAR = 2048;
typedef short v4i16_t __attribute__((ext_vector_type(4)));
constexpr int LD128 = 136, LD64 = 72;

__device__ __forceinline__ bf16x8 frag_rd(const LAS bf16* t, int ld, int row0, int k0, int lane) { return *(const LAS bf16x8*)(t + (row0 + (lane & 15)) * ld + k0 + 8 * (lane >> 4)); }
__device__ __forceinline__ bf16x8 frag_rd_perm(const LAS bf16* t, int ld, int row0, int k0, int lane) {
    const LAS bf16* p = t + (row0 + (lane & 15)) * ld + k0 + 4 * (lane >> 4);
    const bf16x4 a = *(const LAS bf16x4*)p, b = *(const LAS bf16x4*)(p + 16);
    return (bf16x8){a[0], a[1], a[2], a[3], b[0], b[1], b[2], b[3]};
}
__device__ __forceinline__ bf16x8 frag_tr(const LAS bf16* t, int ld, int k0, int n0, int lane) {
    const int i = lane & 15, g = lane >> 4; const LAS bf16* p = t + (k0 + 8 * g + (i >> 2)) * ld + n0 + 4 * (i & 3);
    const v4i16_t a = __builtin_amdgcn_ds_read_tr16_b64_v4i16((LAS v4i16_t*)p), b = __builtin_amdgcn_ds_read_tr16_b64_v4i16((LAS v4i16_t*)(p + 4 * ld));
    return (bf16x8){a[0], a[1], a[2], a[3], b[0], b[1], b[2], b[3]};
}
__device__ __forceinline__ bf16x8 frag_tr_perm(const LAS bf16* t, int ld, int k0, int n0, int lane) {
    const int i = lane & 15, g = lane >> 4; const LAS bf16* p = t + (k0 + 4 * g + (i >> 2)) * ld + n0 + 4 * (i & 3);
    const v4i16_t a = __builtin_amdgcn_ds_read_tr16_b64_v4i16((LAS v4i16_t*)p), b = __builtin_amdgcn_ds_read_tr16_b64_v4i16((LAS v4i16_t*)(p + 16 * ld));
    return (bf16x8){a[0], a[1], a[2], a[3], b[0], b[1], b[2], b[3]};
}
__device__ __forceinline__ bf16x8 pack_acc(const f32x4& lo, const f32x4& hi) {
    v4u w; w.x = pg8::cvt_pk_bf16(lo[0], lo[1]); w.y = pg8::cvt_pk_bf16(lo[2], lo[3]); w.z = pg8::cvt_pk_bf16(hi[0], hi[1]); w.w = pg8::cvt_pk_bf16(hi[2], hi[3]);
    return __builtin_bit_cast(bf16x8, w);
}
#define MFMA16(a, b, c) __builtin_amdgcn_mfma_f32_16x16x32_bf16((a), (b), (c), 0, 0, 0)

template <int ROWS>
__device__ __forceinline__ void tile_g2l_128(const bf16* g, size_t gld, LAS bf16* t, int tid) {
#pragma unroll
    for (int i = 0; i < ROWS * 16 / NTHREADS; ++i) { const int idx = tid + i * NTHREADS, r = idx >> 4, c8 = (idx & 15) * 8;
        *(LAS v4u*)(t + r * LD128 + c8) = *(const GAS v4u*)(g + (size_t)r * gld + c8); }
}
template <int CTRL> __device__ __forceinline__ float dpp_shr_f(float v, float ident) { return __builtin_bit_cast(float, __builtin_amdgcn_update_dpp(__builtin_bit_cast(int, ident), __builtin_bit_cast(int, v), CTRL, 0xf, 0xf, false)); }
__device__ __forceinline__ float wave_scan_add(float v, int lane) {
    v += dpp_shr_f<0x111>(v, 0.f); v += dpp_shr_f<0x112>(v, 0.f); v += dpp_shr_f<0x114>(v, 0.f); v += dpp_shr_f<0x118>(v, 0.f);
    const float t0 = lane_bcast(v, 15), t1 = lane_bcast(v, 31), t2 = lane_bcast(v, 47); const int row = lane >> 4;
    return v + (row == 0 ? 0.f : row == 1 ? t0 : row == 2 ? t0 + t1 : (t0 + t1) + t2);
}
__device__ __forceinline__ float wave_scan_max(float v, int lane) {
    const float ninf = -__builtin_inff();
    v = fmaxf(v, dpp_shr_f<0x111>(v, ninf)); v = fmaxf(v, dpp_shr_f<0x112>(v, ninf)); v = fmaxf(v, dpp_shr_f<0x114>(v, ninf)); v = fmaxf(v, dpp_shr_f<0x118>(v, ninf));
    const float t0 = lane_bcast(v, 15), t1 = lane_bcast(v, 31), t2 = lane_bcast(v, 47); const int row = lane >> 4;
    return fmaxf(v, row == 0 ? ninf : row == 1 ? t0 : row == 2 ? fmaxf(t0, t1) : fmaxf(fmaxf(t0, t1), t2));
}

__device__ __forceinline__ void f_lru_p2(ArgsR A, int l, int item, LAS unsigned char* lds, int tid) {
    const int j = item & 7, n = (item >> 3) & 31, b = item >> 8;
    const bf16* P = (const bf16*)(A.ws + WS_P); float* HLg = (float*)(A.ws + WS_LRU_HL); float* APg = (float*)(A.ws + WS_LRU_AP);
    LAS float* xc = (LAS float*)(lds); LAS float* was = (LAS float*)(lds + 20480); LAS float* wxs = (LAS float*)(lds + 36864);
    LAS float* aa = (LAS float*)(lds + 53248); LAS float* uu = (LAS float*)(lds + 69632); LAS float* segA = (LAS float*)(lds + 86016); LAS float* segH = (LAS float*)(lds + 88064);
    const float* wa = A.in[I_LRU_WA] + ((size_t)l * 8 + j) * 4096; const float* wx = A.in[I_LRU_WX] + ((size_t)l * 8 + j) * 4096;
    for (int i = tid; i < 4096; i += NTHREADS) { was[i] = wa[i]; wxs[i] = wx[i]; }
    const float* cw = A.in[I_LRU_CW] + (size_t)l * 4 * GW; const float* cb = A.in[I_LRU_CB] + l * GW;
    const float* ba = A.in[I_LRU_BA] + l * GW + j * 64; const float* bx = A.in[I_LRU_BX] + l * GW + j * 64; const float* lam = A.in[I_LRU_LAM] + l * GW + j * 64;
    const size_t r0 = (size_t)b * SEQ + n * CHK;
    float ba8[8], bx8[8], lam8[8];
#pragma unroll
    for (int q = 0; q < 8; ++q) { ba8[q] = ba[(tid & 7) * 8 + q]; bx8[q] = bx[(tid & 7) * 8 + q]; lam8[q] = lam[(tid & 7) * 8 + q]; }
    { const int cc = tid & 63, c0 = (tid >> 6) * 8, ch = j * 64 + cc, pc = PC_LRU_X + ch; const long t0 = (long)n * CHK + c0;
        const float w0 = cw[ch], w1 = cw[GW + ch], w2 = cw[2 * GW + ch], w3 = cw[3 * GW + ch], bias = cb[ch];
        float xm3 = (t0 - 3 >= 0) ? bf2f(P[(r0 + c0 - 3) * PBW + pc]) : 0.f, xm2 = (t0 - 2 >= 0) ? bf2f(P[(r0 + c0 - 2) * PBW + pc]) : 0.f, xm1 = (t0 - 1 >= 0) ? bf2f(P[(r0 + c0 - 1) * PBW + pc]) : 0.f;
#pragma unroll
        for (int i = 0; i < 8; ++i) { const float x0 = bf2f(P[(r0 + c0 + i) * PBW + pc]); xc[(c0 + i) * 65 + cc] = w0 * xm3 + w1 * xm2 + w2 * xm1 + w3 * x0 + bias; xm3 = xm2; xm2 = xm1; xm1 = x0; } }
    __syncthreads();
    { const int tok = tid >> 3, cg = tid & 7; float ra[8], ri[8], spl[8];
#pragma unroll
        for (int q = 0; q < 8; ++q) { ra[q] = ba8[q]; ri[q] = bx8[q]; spl[q] = softplusf_(-lam8[q]); }
#pragma unroll 4
        for (int i = 0; i < 64; ++i) { const float xv = xc[tok * 65 + i];
            const f32x4 a0 = *(const LAS f32x4*)(was + i * 64 + cg * 8), a1 = *(const LAS f32x4*)(was + i * 64 + cg * 8 + 4);
            const f32x4 x0 = *(const LAS f32x4*)(wxs + i * 64 + cg * 8), x1 = *(const LAS f32x4*)(wxs + i * 64 + cg * 8 + 4);
#pragma unroll
            for (int q = 0; q < 4; ++q) { ra[q] += xv * a0[q]; ra[4 + q] += xv * a1[q]; ri[q] += xv * x0[q]; ri[4 + q] += xv * x1[q]; } }
#pragma unroll
        for (int q = 0; q < 8; ++q) { const int jj = cg * 8 + q; const float r = sigmoidf_(ra[q]), ig = sigmoidf_(ri[q]);
            const float log_a = -8.0f * r * spl[q]; const float a = __expf(log_a), u = sqrtf(fmaxf(1.0f - a * a, 0.f)) * (ig * xc[tok * 65 + jj]);
            aa[tok * 64 + jj] = a; uu[tok * 64 + jj] = u; } }
    __syncthreads();
    const int cc = tid & 63, seg = tid >> 6;
    { float Ap = 1.f, Hl = 0.f;
#pragma unroll
        for (int i = 0; i < 8; ++i) { const int c = seg * 8 + i; const float a = aa[c * 64 + cc], u = uu[c * 64 + cc]; Hl = a * Hl + u; Ap *= a; aa[c * 64 + cc] = Ap; uu[c * 64 + cc] = Hl; }
        segA[seg * 64 + cc] = Ap; segH[seg * 64 + cc] = Hl; }
    __syncthreads();
    { float Ac = 1.f, Hc = 0.f;
#pragma unroll 1
        for (int s = 0; s < seg; ++s) { const float sa = segA[s * 64 + cc]; Hc = sa * Hc + segH[s * 64 + cc]; Ac *= sa; }
#pragma unroll
        for (int i = 0; i < 8; ++i) { const int c = seg * 8 + i; const float ap = aa[c * 64 + cc], hl = uu[c * 64 + cc];
            HLg[(r0 + c) * GW + j * 64 + cc] = ap * Hc + hl; APg[(r0 + c) * GW + j * 64 + cc] = ap * Ac; } }
    __syncthreads();
}
__device__ __forceinline__ void f_lru_p3(ArgsR A, int b, int tid) {
    const float* HLg = (const float*)(A.ws + WS_LRU_HL); const float* APg = (const float*)(A.ws + WS_LRU_AP); float* carry = (float*)(A.ws + WS_LRU_CARRY);
    float c = 0.f;
#pragma unroll 8
    for (int n = 0; n < NCHK; ++n) { carry[((size_t)b * NCHK + n) * GW + tid] = c; const size_t t = (size_t)b * SEQ + n * CHK + 63; c = APg[t * GW + tid] * c + HLg[t * GW + tid]; }
}
__device__ __forceinline__ void f_lru_p4(ArgsR A, int item, int tid) {
    const bf16* P = (const bf16*)(A.ws + WS_P); bf16* mix = (bf16*)(A.ws + WS_MIX);
    const float* HLg = (const float*)(A.ws + WS_LRU_HL); const float* APg = (const float*)(A.ws + WS_LRU_AP); const float* carry = (const float*)(A.ws + WS_LRU_CARRY);
    const float cr = carry[(size_t)item * GW + tid]; const size_t r0 = (size_t)item * CHK;
#pragma unroll 8
    for (int c = 0; c < CHK; ++c) { const float h = APg[(r0 + c) * GW + tid] * cr + HLg[(r0 + c) * GW + tid]; const float y = bf2f(P[(r0 + c) * PBW + PC_LRU_Y + tid]);
        mix[(r0 + c) * DM + 512 + tid] = (bf16)f2bf(gelu_tanh(y) * h); }
}

constexpr int FL_Q = 0, FL_K = 17408, FL_V = 34816, FL_ST = 52224, FL_SC = 87040, FL_BC = 96256, FL_LR = 129024, FL_SEG = 133120, FL_RS = 135168;
struct GlaW2 { float w[16]; float b2; };
__device__ __forceinline__ void gla_w2_load(ArgsR A, int l, int h, int tid, GlaW2& W) {
    const int d = tid & 127; const float* w2 = A.in[I_GLA_W2] + (size_t)l * 16 * GW + h * HD + d;
#pragma unroll
    for (int r = 0; r < 16; ++r) W.w[r] = w2[r * GW];
    W.b2 = A.in[I_GLA_B2][l * GW + h * HD + d];
}
__device__ __forceinline__ void gla_bcum(const GlaW2& W, LAS float* bc, LAS float* segt, const LAS float* lrs, int tid) {
    const int d = tid & 127, seg = tid >> 7; float run = 0.f;
#pragma unroll 4
    for (int i = 0; i < 16; ++i) { const int c = seg * 16 + i; float z = W.b2;
#pragma unroll
        for (int r = 0; r < 16; ++r) z += lrs[c * 16 + r] * W.w[r];
        run += logsigmoidf_(z) * (1.0f / 16.0f); bc[c * 128 + d] = run; }
    segt[seg * 128 + d] = run;
}
__device__ __forceinline__ void f_gla_p2(ArgsR A, int l, int item, LAS unsigned char* lds, int tid) {
    const int n = item & 31, h = (item >> 5) & 3, b = item >> 7; const int lane = tid & 63, wave = __builtin_amdgcn_readfirstlane(tid >> 6);
    const bf16* P = (const bf16*)(A.ws + WS_P); const float* Ps = (const float*)(A.ws + WS_PS);
    float* inc = (float*)(A.ws + WS_GLA_INC) + (size_t)item * 16384; float* dec = (float*)(A.ws + WS_GLA_DEC) + (size_t)item * 128;
    LAS bf16* ks = (LAS bf16*)(lds + FL_K); LAS bf16* vs = (LAS bf16*)(lds + FL_V); LAS float* bc = (LAS float*)(lds + FL_BC); LAS float* lrs = (LAS float*)(lds + FL_LR); LAS float* segt = (LAS float*)(lds + FL_SEG);
    const size_t r0 = (size_t)b * SEQ + n * CHK;
    GlaW2 W2; gla_w2_load(A, l, h, tid, W2);
    tile_g2l_128<64>(P + r0 * PBW + PC_GLA_K + h * HD, PBW, ks, tid);
    tile_g2l_128<64>(P + r0 * PBW + PC_GLA_V + h * HD, PBW, vs, tid);
    for (int i = tid; i < 64 * 16; i += NTHREADS) lrs[i] = Ps[(r0 + (i >> 4)) * 32 + PS_LR + (i & 15)];
    __syncthreads();
    gla_bcum(W2, bc, segt, lrs, tid);
    __syncthreads();
    { const int d = tid & 127, seg = tid >> 7; float pre = 0.f, tot = 0.f;
#pragma unroll
        for (int s = 0; s < 4; ++s) { const float v = segt[s * 128 + d]; if (s < seg) pre += v; tot += v; }
#pragma unroll 4
        for (int i = 0; i < 16; ++i) { const int c = seg * 16 + i; const float bcm = bc[c * 128 + d] + pre; ks[c * LD128 + d] = (bf16)f2bf(bf2f(ks[c * LD128 + d]) * __expf(tot - bcm)); }
        if (seg == 0) dec[d] = __expf(tot); }
    __syncthreads();
    { f32x4 acc[8];
#pragma unroll
        for (int nt = 0; nt < 8; ++nt) acc[nt] = (f32x4){0.f, 0.f, 0.f, 0.f};
#pragma unroll
        for (int kk = 0; kk < 2; ++kk) { const bf16x8 af = frag_tr(vs, LD128, 32 * kk, 16 * wave, lane);
#pragma unroll
            for (int nt = 0; nt < 8; ++nt) acc[nt] = MFMA16(af, frag_tr(ks, LD128, 32 * kk, 16 * nt, lane), acc[nt]); }
        const int fr = lane & 15, fq = lane >> 4;
#pragma unroll
        for (int nt = 0; nt < 8; ++nt)
#pragma unroll
            for (int r = 0; r < 4; ++r) inc[(16 * wave + 4 * fq + r) * 128 + 16 * nt + fr] = acc[nt][r]; }
    __syncthreads();
}
__device__ __forceinline__ void f_gla_p3(ArgsR A, int item, int tid) {
    const int bh = item >> 4, sl = item & 15; const int e = sl * 1024 + tid * 2, d = e & 127;
    const float* inc = (const float*)(A.ws + WS_GLA_INC) + (size_t)bh * 32 * 16384 + e; const float* dec = (const float*)(A.ws + WS_GLA_DEC) + (size_t)bh * 32 * 128 + d;
    bf16* st = (bf16*)(A.ws + WS_GLA_ST) + (size_t)bh * 32 * 16384 + e;
    float s0 = 0.f, s1 = 0.f;
#pragma unroll 8
    for (int n = 0; n < NCHK; ++n) { *(GAS unsigned*)(st + (size_t)n * 16384) = pk2(s0, s1);
        const f32x2 iv = *(const GAS f32x2*)(inc + (size_t)n * 16384), dv = *(const GAS f32x2*)(dec + (size_t)n * 128); s0 = dv[0] * s0 + iv[0]; s1 = dv[1] * s1 + iv[1]; }
}
__device__ __forceinline__ void f_gla_p4(ArgsR A, int l, int item, LAS unsigned char* lds, int tid) {
    const int n = item & 31, h = (item >> 5) & 3, b = item >> 7; const int lane = tid & 63, wave = __builtin_amdgcn_readfirstlane(tid >> 6), fr = lane & 15, fq = lane >> 4;
    const bf16* P = (const bf16*)(A.ws + WS_P); const float* Ps = (const float*)(A.ws + WS_PS); bf16* mix = (bf16*)(A.ws + WS_MIX);
    const bf16* stg = (const bf16*)(A.ws + WS_GLA_ST) + (size_t)item * 16384;
    LAS bf16* qs = (LAS bf16*)(lds + FL_Q); LAS bf16* ks = (LAS bf16*)(lds + FL_K); LAS bf16* vs = (LAS bf16*)(lds + FL_V); LAS bf16* sts = (LAS bf16*)(lds + FL_ST); LAS bf16* scs = (LAS bf16*)(lds + FL_SC);
    LAS float* bc = (LAS float*)(lds + FL_BC); LAS float* lrs = (LAS float*)(lds + FL_LR); LAS float* segt = (LAS float*)(lds + FL_SEG); LAS float* rsp = (LAS float*)(lds + FL_RS);
    const size_t r0 = (size_t)b * SEQ + n * CHK;
    GlaW2 W2; gla_w2_load(A, l, h, tid, W2);
    const float gn = A.in[I_GLA_NG][l * GW + h * HD + 16 * wave + fr];
    float gt[4][4];
#pragma unroll
    for (int mt = 0; mt < 4; ++mt)
#pragma unroll
        for (int r = 0; r < 4; ++r) gt[mt][r] = bf2f(P[(r0 + 16 * mt + 4 * fq + r) * PBW + PC_GLA_G + h * HD + 16 * wave + fr]);
    tile_g2l_128<64>(P + r0 * PBW + PC_GLA_Q + h * HD, PBW, qs, tid);
    tile_g2l_128<64>(P + r0 * PBW + PC_GLA_K + h * HD, PBW, ks, tid);
    tile_g2l_128<64>(P + r0 * PBW + PC_GLA_V + h * HD, PBW, vs, tid);
    tile_g2l_128<128>(stg, 128, sts, tid);
    for (int i = tid; i < 64 * 16; i += NTHREADS) lrs[i] = Ps[(r0 + (i >> 4)) * 32 + PS_LR + (i & 15)];
    __syncthreads();
    gla_bcum(W2, bc, segt, lrs, tid);
    __syncthreads();
    { const int d = tid & 127, seg = tid >> 7; float pre = 0.f;
#pragma unroll
        for (int s = 0; s < 4; ++s) { const float v = segt[s * 128 + d]; if (s < seg) pre += v; }
#pragma unroll 4
        for (int i = 0; i < 16; ++i) { const int c = seg * 16 + i; const float bcm = bc[c * 128 + d] + pre;
            qs[c * LD128 + d] = (bf16)f2bf(bf2f(qs[c * LD128 + d]) * __expf(bcm) * 0.08838834764831845f); ks[c * LD128 + d] = (bf16)f2bf(bf2f(ks[c * LD128 + d]) * __expf(-bcm)); } }
    __syncthreads();
    { const int mt = wave >> 1; f32x4 acc[2] = {{0.f, 0.f, 0.f, 0.f}, {0.f, 0.f, 0.f, 0.f}};
#pragma unroll
        for (int kk = 0; kk < 4; ++kk) { const bf16x8 af = frag_rd(qs, LD128, 16 * mt, 32 * kk, lane);
#pragma unroll
            for (int q = 0; q < 2; ++q) acc[q] = MFMA16(af, frag_rd(ks, LD128, 16 * (2 * (wave & 1) + q), 32 * kk, lane), acc[q]); }
#pragma unroll
        for (int q = 0; q < 2; ++q) { const int s = 16 * (2 * (wave & 1) + q) + fr;
#pragma unroll
            for (int r = 0; r < 4; ++r) { const int c = 16 * mt + 4 * fq + r; scs[c * LD64 + s] = (bf16)f2bf(s <= c ? acc[q][r] : 0.f); } } }
    __syncthreads();
    f32x4 o[4];
#pragma unroll
    for (int mt = 0; mt < 4; ++mt) o[mt] = (f32x4){0.f, 0.f, 0.f, 0.f};
#pragma unroll
    for (int kk = 0; kk < 2; ++kk) { const bf16x8 bfv = frag_tr(vs, LD128, 32 * kk, 16 * wave, lane);
#pragma unroll
        for (int mt = 0; mt < 4; ++mt) o[mt] = MFMA16(frag_rd(scs, LD64, 16 * mt, 32 * kk, lane), bfv, o[mt]); }
#pragma unroll
    for (int kk = 0; kk < 4; ++kk) { const bf16x8 bfs = frag_rd(sts, LD128, 16 * wave, 32 * kk, lane);
#pragma unroll
        for (int mt = 0; mt < 4; ++mt) o[mt] = MFMA16(frag_rd(qs, LD128, 16 * mt, 32 * kk, lane), bfs, o[mt]); }
#pragma unroll
    for (int mt = 0; mt < 4; ++mt)
#pragma unroll
        for (int r = 0; r < 4; ++r) { float s = o[mt][r] * o[mt][r]; s = row_sum_f(s);
            if (fr == 0) rsp[wave * 64 + 16 * mt + 4 * fq + r] = s; }
    __syncthreads();
#pragma unroll
    for (int mt = 0; mt < 4; ++mt)
#pragma unroll
        for (int r = 0; r < 4; ++r) { const int c = 16 * mt + 4 * fq + r; float ss = 0.f;
#pragma unroll
            for (int w = 0; w < 8; ++w) ss += rsp[w * 64 + c];
            const float rs = rsqrtf(ss * (1.0f / 128.0f) + RMS_EPS);
            mix[(r0 + c) * DM + h * HD + 16 * wave + fr] = (bf16)f2bf(o[mt][r] * rs * gn * siluf_(gt[mt][r])); }
    __syncthreads();
}

constexpr int FM_Q2 = 96256, FM_S = 129024;
__device__ __forceinline__ void f_ml_p2(ArgsR A, int l, int item, LAS unsigned char* lds, int tid) {
    const int n = item & 31, h = (item >> 5) & 3, b = item >> 7; const int lane = tid & 63, wave = __builtin_amdgcn_readfirstlane(tid >> 6);
    const bf16* P = (const bf16*)(A.ws + WS_P); const float* Ps = (const float*)(A.ws + WS_PS);
    float* inc = (float*)(A.ws + WS_ML_INC) + (size_t)item * 16384; float* incn = (float*)(A.ws + WS_ML_N) + (size_t)item * 128; float* scg = (float*)(A.ws + WS_ML_SC) + (size_t)item * 2;
    LAS bf16* ks = (LAS bf16*)(lds + FL_K); LAS bf16* vs = (LAS bf16*)(lds + FL_V); LAS float* sc = (LAS float*)(lds + FM_S);
    const size_t r0 = (size_t)b * SEQ + n * CHK;
    tile_g2l_128<64>(P + r0 * PBW + PC_ML_K + h * HD, PBW, ks, tid);
    tile_g2l_128<64>(P + r0 * PBW + PC_ML_V + h * HD, PBW, vs, tid);
    if (wave == 0) { const float lf = logsigmoidf_(Ps[(r0 + lane) * 32 + PS_MF + h] + A.in[I_ML_FB][l * NH + h]), ig = Ps[(r0 + lane) * 32 + PS_MI + h] + A.in[I_ML_IB][l * NH + h];
        const float bcum = wave_scan_add(lf, lane), blast = lane_bcast(bcum, 63), le = blast - bcum + ig, mloc = wave_max(le);
        sc[lane] = __expf(le - mloc) * 0.08838834764831845f; if (lane == 0) { scg[0] = mloc; scg[1] = blast; } }
    __syncthreads();
#pragma unroll
    for (int i = 0; i < 2; ++i) { const int idx = tid + i * NTHREADS, r = idx >> 4, c8 = (idx & 15) * 8; const float w = sc[r];
        v4u x = *(LAS v4u*)(ks + r * LD128 + c8);
        x.x = pk2(bflo(x.x) * w, bfhi(x.x) * w); x.y = pk2(bflo(x.y) * w, bfhi(x.y) * w); x.z = pk2(bflo(x.z) * w, bfhi(x.z) * w); x.w = pk2(bflo(x.w) * w, bfhi(x.w) * w);
        *(LAS v4u*)(ks + r * LD128 + c8) = x; }
    __syncthreads();
    if (tid < 128) { float s = 0.f;
#pragma unroll 8
        for (int c = 0; c < 64; ++c) s += bf2f(ks[c * LD128 + tid]);
        incn[tid] = s; }
    { f32x4 acc[8];
#pragma unroll
        for (int nt = 0; nt < 8; ++nt) acc[nt] = (f32x4){0.f, 0.f, 0.f, 0.f};
#pragma unroll
        for (int kk = 0; kk < 2; ++kk) { const bf16x8 af = frag_tr(vs, LD128, 32 * kk, 16 * wave, lane);
#pragma unroll
            for (int nt = 0; nt < 8; ++nt) acc[nt] = MFMA16(af, frag_tr(ks, LD128, 32 * kk, 16 * nt, lane), acc[nt]); }
        const int fr = lane & 15, fq = lane >> 4;
#pragma unroll
        for (int nt = 0; nt < 8; ++nt)
#pragma unroll
            for (int r = 0; r < 4; ++r) inc[(16 * wave + 4 * fq + r) * 128 + 16 * nt + fr] = acc[nt][r]; }
    __syncthreads();
}
__device__ __forceinline__ void f_ml_p3(ArgsR A, int item, int tid) {
    const int bh = item >> 4, sl = item & 15; const int e = sl * 1024 + tid * 2;
    const float* inc = (const float*)(A.ws + WS_ML_INC) + (size_t)bh * 32 * 16384 + e; const float* incn = (const float*)(A.ws + WS_ML_N) + (size_t)bh * 32 * 128;
    const float* scg = (const float*)(A.ws + WS_ML_SC) + (size_t)bh * 32 * 2;
    bf16* st = (bf16*)(A.ws + WS_ML_ST) + (size_t)bh * 32 * 16384 + e; float* np = (float*)(A.ws + WS_ML_NP) + (size_t)bh * 32 * 128; float* mp = (float*)(A.ws + WS_ML_MP) + (size_t)bh * 32;
    float c0 = 0.f, c1 = 0.f, nv = 0.f, m = 0.f; const int dn = sl * 8 + tid;
#pragma unroll 4
    for (int n = 0; n < NCHK; ++n) {
        *(GAS unsigned*)(st + (size_t)n * 16384) = pk2(c0, c1);
        if (tid < 8) np[n * 128 + dn] = nv;
        if (sl == 0 && tid == 0) mp[n] = m;
        const float ml = scg[2 * n], bl = scg[2 * n + 1]; const float mn = fmaxf(bl + m, ml), ao = __expf(bl + m - mn), ai = __expf(ml - mn);
        const f32x2 iv = *(const GAS f32x2*)(inc + (size_t)n * 16384); c0 = ao * c0 + ai * iv[0]; c1 = ao * c1 + ai * iv[1];
        if (tid < 8) nv = ao * nv + ai * incn[n * 128 + dn];
        m = mn; }
}
__device__ __forceinline__ void f_ml_p4(ArgsR A, int l, int item, LAS unsigned char* lds, int tid) {
    const int n = item & 31, h = (item >> 5) & 3, b = item >> 7; const int lane = tid & 63, wave = __builtin_amdgcn_readfirstlane(tid >> 6), fr = lane & 15, fq = lane >> 4;
    const bf16* P = (const bf16*)(A.ws + WS_P); const float* Ps = (const float*)(A.ws + WS_PS); bf16* mix = (bf16*)(A.ws + WS_MIX);
    const bf16* stg = (const bf16*)(A.ws + WS_ML_ST) + (size_t)item * 16384; const float* npg = (const float*)(A.ws + WS_ML_NP) + (size_t)item * 128; const float mprev = ((const float*)(A.ws + WS_ML_MP))[item];
    LAS bf16* qs = (LAS bf16*)(lds + FL_Q); LAS bf16* ks = (LAS bf16*)(lds + FL_K); LAS bf16* vs = (LAS bf16*)(lds + FL_V); LAS bf16* sts = (LAS bf16*)(lds + FL_ST); LAS bf16* scs = (LAS bf16*)(lds + FL_SC);
    LAS bf16* q2 = (LAS bf16*)(lds + FM_Q2); LAS float* sc = (LAS float*)(lds + FM_S); LAS float* rsp = (LAS float*)(lds + FL_RS + 4096);
    const size_t r0 = (size_t)b * SEQ + n * CHK;
    const float gn = A.in[I_ML_NG][l * GW + h * HD + 16 * wave + fr];
    float ogt[4][4];
#pragma unroll
    for (int mt = 0; mt < 4; ++mt)
#pragma unroll
        for (int r = 0; r < 4; ++r) ogt[mt][r] = bf2f(P[(r0 + 16 * mt + 4 * fq + r) * PBW + PC_ML_O + h * HD + 16 * wave + fr]);
    tile_g2l_128<64>(P + r0 * PBW + PC_ML_Q + h * HD, PBW, qs, tid);
    tile_g2l_128<64>(P + r0 * PBW + PC_ML_K + h * HD, PBW, ks, tid);
    tile_g2l_128<64>(P + r0 * PBW + PC_ML_V + h * HD, PBW, vs, tid);
    tile_g2l_128<128>(stg, 128, sts, tid);
    if (wave == 0) { const float lf = logsigmoidf_(Ps[(r0 + lane) * 32 + PS_MF + h] + A.in[I_ML_FB][l * NH + h]), ig = Ps[(r0 + lane) * 32 + PS_MI + h] + A.in[I_ML_IB][l * NH + h];
        const float bcum = wave_scan_add(lf, lane), as = ig - bcum, pm = wave_scan_max(as, lane);
        const float mintra = bcum + pm, minter = bcum + mprev, mt = fmaxf(mintra, minter);
        sc[lane] = bcum - mt; sc[64 + lane] = as; sc[128 + lane] = __expf(minter - mt); sc[192 + lane] = __expf(-mt); }
    if (wave == 1) { sc[320 + lane] = npg[lane]; sc[384 + lane] = npg[64 + lane]; }
    __syncthreads();
#pragma unroll
    for (int i = 0; i < 2; ++i) { const int idx = tid + i * NTHREADS, r = idx >> 4, c8 = (idx & 15) * 8; const float w = sc[128 + r];
        v4u x = *(LAS v4u*)(qs + r * LD128 + c8);
        x.x = pk2(bflo(x.x) * w, bfhi(x.x) * w); x.y = pk2(bflo(x.y) * w, bfhi(x.y) * w); x.z = pk2(bflo(x.z) * w, bfhi(x.z) * w); x.w = pk2(bflo(x.w) * w, bfhi(x.w) * w);
        *(LAS v4u*)(q2 + r * LD128 + c8) = x; }
    { const int mt = wave >> 1; f32x4 acc[2] = {{0.f, 0.f, 0.f, 0.f}, {0.f, 0.f, 0.f, 0.f}};
#pragma unroll
        for (int kk = 0; kk < 4; ++kk) { const bf16x8 af = frag_rd(qs, LD128, 16 * mt, 32 * kk, lane);
#pragma unroll
            for (int q = 0; q < 2; ++q) acc[q] = MFMA16(af, frag_rd(ks, LD128, 16 * (2 * (wave & 1) + q), 32 * kk, lane), acc[q]); }
#pragma unroll
        for (int q = 0; q < 2; ++q) { const int s = 16 * (2 * (wave & 1) + q) + fr; const float asv = sc[64 + s];
#pragma unroll
            for (int r = 0; r < 4; ++r) { const int c = 16 * mt + 4 * fq + r; scs[c * LD64 + s] = (bf16)f2bf(s <= c ? acc[q][r] * 0.08838834764831845f * __expf(sc[c] + asv) : 0.f); } } }
    __syncthreads();
    { const int c = tid >> 3, part = tid & 7; float s = 0.f;
#pragma unroll
        for (int i = 0; i < 8; ++i) s += bf2f(scs[c * LD64 + part * 8 + i]);
#pragma unroll
        for (int i = 0; i < 16; ++i) s += bf2f(q2[c * LD128 + part * 16 + i]) * sc[320 + part * 16 + i];
        s = oct_sum_f(s);
        if (part == 0) sc[256 + c] = fmaxf(fabsf(s), sc[192 + c]); }
    f32x4 o[4];
#pragma unroll
    for (int mt = 0; mt < 4; ++mt) o[mt] = (f32x4){0.f, 0.f, 0.f, 0.f};
#pragma unroll
    for (int kk = 0; kk < 2; ++kk) { const bf16x8 bfv = frag_tr(vs, LD128, 32 * kk, 16 * wave, lane);
#pragma unroll
        for (int mt = 0; mt < 4; ++mt) o[mt] = MFMA16(frag_rd(scs, LD64, 16 * mt, 32 * kk, lane), bfv, o[mt]); }
#pragma unroll
    for (int kk = 0; kk < 4; ++kk) { const bf16x8 bfs = frag_rd(sts, LD128, 16 * wave, 32 * kk, lane);
#pragma unroll
        for (int mt = 0; mt < 4; ++mt) o[mt] = MFMA16(frag_rd(q2, LD128, 16 * mt, 32 * kk, lane), bfs, o[mt]); }
    __syncthreads();
#pragma unroll
    for (int mt = 0; mt < 4; ++mt)
#pragma unroll
        for (int r = 0; r < 4; ++r) { const int c = 16 * mt + 4 * fq + r;
            const float hv = o[mt][r] * rcpf_(sc[256 + c]) * sigmoidf_(ogt[mt][r]); o[mt][r] = hv;
            float s = hv * hv; s = row_sum_f(s);
            if (fr == 0) rsp[wave * 64 + c] = s; }
    __syncthreads();
#pragma unroll
    for (int mt = 0; mt < 4; ++mt)
#pragma unroll
        for (int r = 0; r < 4; ++r) { const int c = 16 * mt + 4 * fq + r; float ss = 0.f;
#pragma unroll
            for (int w = 0; w < 8; ++w) ss += rsp[w * 64 + c];
            mix[(r0 + c) * DM + 1024 + h * HD + 16 * wave + fr] = (bf16)f2bf(o[mt][r] * rsqrtf(ss * (1.0f / 128.0f) + RMS_EPS) * gn); }
    __syncthreads();
}

constexpr int FG_LM = 52224, FG_S = 129024, FG_RAW = 68608, FG_RAWT = 9216  ;
template <int C> struct GdnSolve {
    static __device__ __forceinline__ void run(float (&sol)[64], const LAS float* Lm) {
        if constexpr (C < 64) {
            float a0 = sol[C], a1 = 0.f, a2 = 0.f, a3 = 0.f;
#pragma unroll
            for (int s = 0; s < C; ++s) { const float t = Lm[C * 64 + s] * sol[s]; if ((s & 3) == 0) a0 -= t; else if ((s & 3) == 1) a1 -= t; else if ((s & 3) == 2) a2 -= t; else a3 -= t; }
            sol[C] = (a0 + a1) + (a2 + a3);
            GdnSolve<C + 1>::run(sol, Lm);
        }
    }
};
__device__ __forceinline__ void f_gdn_p2(ArgsR A, int l, int item, LAS unsigned char* lds, int tid) {
    const int n = item & 31, h = (item >> 5) & 3, b = item >> 7; const int lane = tid & 63, wave = __builtin_amdgcn_readfirstlane(tid >> 6), fr = lane & 15, fq = lane >> 4;
    const bf16* P = (const bf16*)(A.ws + WS_P); const float* Ps = (const float*)(A.ws + WS_PS);
    bf16* U0 = (bf16*)(A.ws + WS_GDN_U0) + (size_t)item * 8192; bf16* Wg = (bf16*)(A.ws + WS_GDN_W) + (size_t)item * 8192; bf16* QD = (bf16*)(A.ws + WS_GDN_QD) + (size_t)item * 8192;
    bf16* KE = (bf16*)(A.ws + WS_GDN_KE) + (size_t)item * 8192; bf16* QK = (bf16*)(A.ws + WS_GDN_QK) + (size_t)item * 4096; float* DE = (float*)(A.ws + WS_GDN_DE);
    LAS bf16* qs = (LAS bf16*)(lds + FL_Q); LAS bf16* ks = (LAS bf16*)(lds + FL_K); LAS bf16* vs = (LAS bf16*)(lds + FL_V); LAS float* Lm = (LAS float*)(lds + FG_LM); LAS float* sc = (LAS float*)(lds + FG_S);
    const float* cw = A.in[I_GDN_CW] + (size_t)l * 4 * 1536;
    const size_t r0 = (size_t)b * SEQ + n * CHK;
    float cwv[3][4];
#pragma unroll
    for (int part = 0; part < 3; ++part)
#pragma unroll
        for (int k = 0; k < 4; ++k) cwv[part][k] = cw[k * 1536 + part * 512 + h * HD + (tid & 127)];
    if (wave == 0) { const float bt = sigmoidf_(Ps[(r0 + lane) * 32 + PS_GB + h]);
        const float g = -__expf(A.in[I_GDN_ALOG][l * NH + h]) * softplusf_(Ps[(r0 + lane) * 32 + PS_GA + h] + A.in[I_GDN_DTB][l * NH + h]);
        const float gam = wave_scan_add(g, lane); sc[lane] = bt; sc[64 + lane] = gam; if (lane == 63) DE[item] = __expf(gam); }
    { LAS bf16* raw = (LAS bf16*)(lds + FG_RAW);
#pragma unroll
        for (int i = 0; i < 7; ++i) { const int idx = tid + i * NTHREADS; if (idx < 3 * 67 * 16) { const int part = idx / (67 * 16), pi = idx % (67 * 16), rr = pi >> 4, c8 = (pi & 15) * 8;
            const int pc = (part == 0 ? PC_GDN_Q : part == 1 ? PC_GDN_K : PC_GDN_V) + h * HD + c8; v4u w = {0u, 0u, 0u, 0u};
            if (n > 0 || rr >= 3) w = *(const GAS v4u*)(P + (r0 + rr - 3) * PBW + pc);
            *(LAS v4u*)(raw + part * FG_RAWT + rr * LD128 + c8) = w; } }
        __syncthreads();
        const int v = tid & 127, dq = tid >> 7;
#pragma unroll
        for (int part = 0; part < 3; ++part) {
            const float w0 = cwv[part][0], w1 = cwv[part][1], w2 = cwv[part][2], w3 = cwv[part][3];
            LAS bf16* dst = part == 0 ? qs : part == 1 ? ks : vs; const LAS bf16* src = raw + part * FG_RAWT + v;
            const int c0 = dq * 16;
            float xm3 = bf2f(src[(c0 + 0) * LD128]), xm2 = bf2f(src[(c0 + 1) * LD128]), xm1 = bf2f(src[(c0 + 2) * LD128]);
#pragma unroll
            for (int i = 0; i < 16; ++i) { const float x0 = bf2f(src[(c0 + i + 3) * LD128]); const float y = w0 * xm3 + w1 * xm2 + w2 * xm1 + w3 * x0;
                dst[(c0 + i) * LD128 + v] = (bf16)f2bf(siluf_(y)); xm3 = xm2; xm2 = xm1; xm1 = x0; } } }
    __syncthreads();
#pragma unroll 1
    for (int rr = 0; rr < 8; ++rr) { const int c = wave * 8 + rr;
        const float q1 = bf2f(qs[c * LD128 + lane]), q2 = bf2f(qs[c * LD128 + 64 + lane]), k1 = bf2f(ks[c * LD128 + lane]), k2 = bf2f(ks[c * LD128 + 64 + lane]);
        const float sq = wave_sum(q1 * q1 + q2 * q2), sk = wave_sum(k1 * k1 + k2 * k2);
        if (lane == 0) { sc[128 + c] = rsqrtf(sq + 1e-6f) * 0.08838834764831845f; sc[192 + c] = rsqrtf(sk + 1e-6f); } }
    __syncthreads();
    { const int mt = wave >> 1; f32x4 akk[2] = {{0.f, 0.f, 0.f, 0.f}, {0.f, 0.f, 0.f, 0.f}}, aqk[2] = {{0.f, 0.f, 0.f, 0.f}, {0.f, 0.f, 0.f, 0.f}};
#pragma unroll
        for (int kk = 0; kk < 4; ++kk) { const bf16x8 ak = frag_rd(ks, LD128, 16 * mt, 32 * kk, lane), aq = frag_rd(qs, LD128, 16 * mt, 32 * kk, lane);
#pragma unroll
            for (int q = 0; q < 2; ++q) { const bf16x8 bk = frag_rd(ks, LD128, 16 * (2 * (wave & 1) + q), 32 * kk, lane); akk[q] = MFMA16(ak, bk, akk[q]); aqk[q] = MFMA16(aq, bk, aqk[q]); } }
#pragma unroll
        for (int q = 0; q < 2; ++q) { const int s = 16 * (2 * (wave & 1) + q) + fr; const float rks = sc[192 + s], gs = sc[64 + s];
#pragma unroll
            for (int r = 0; r < 4; ++r) { const int c = 16 * mt + 4 * fq + r; const float dcy = __expf(sc[64 + c] - gs);
                Lm[c * 64 + s] = (s < c) ? sc[c] * akk[q][r] * sc[192 + c] * rks * dcy : 0.f;
                QK[c * 64 + s] = (bf16)f2bf((s <= c) ? aqk[q][r] * sc[128 + c] * rks * dcy : 0.f); } } }
    __syncthreads();
    if (tid < 256) {
        float sol[64]; const bool isw = tid >= 128; const int j = tid & 127;
        const LAS float* LmO = Lm; asm volatile("" : "+v"(LmO));
#pragma unroll
        for (int c = 0; c < 64; ++c) { const float bt = sc[c]; sol[c] = isw ? bf2f(ks[c * LD128 + j]) * sc[192 + c] * bt * __expf(sc[64 + c]) : bf2f(vs[c * LD128 + j]) * bt; }
        GdnSolve<1>::run(sol, LmO);
        bf16* dst = isw ? Wg : U0;
#pragma unroll
        for (int c = 0; c < 64; ++c) dst[c * 128 + j] = (bf16)f2bf(sol[c]);
    } else {
        const int t2 = tid - 256; const float glast = sc[64 + 63];
#pragma unroll
        for (int i = 0; i < 8; ++i) { const int idx = t2 + i * 256, which = idx >> 10, pi = idx & 1023, r = pi >> 4, c8 = (pi & 15) * 8;
            const float w = which == 0 ? sc[128 + r] * __expf(sc[64 + r]) : sc[192 + r] * __expf(glast - sc[64 + r]);
            v4u x = *(LAS v4u*)((which == 0 ? qs : ks) + r * LD128 + c8);
            x.x = pk2(bflo(x.x) * w, bfhi(x.x) * w); x.y = pk2(bflo(x.y) * w, bfhi(x.y) * w); x.z = pk2(bflo(x.z) * w, bfhi(x.z) * w); x.w = pk2(bflo(x.w) * w, bfhi(x.w) * w);
            *(GAS v4u*)((which == 0 ? QD : KE) + r * 128 + c8) = x; }
    }
    __syncthreads();
}

constexpr int FC_W = 0, FC_QD = 17408, FC_KE = 34816, FC_U0 = 52224, FC_QK = 69632, FC_RS = 78848  ;
__device__ __forceinline__ void f_gdn_p3(ArgsR A, int l, int bh, LAS unsigned char* lds, int tid) {
    const int lane = tid & 63, wave = __builtin_amdgcn_readfirstlane(tid >> 6), fr = lane & 15, fq = lane >> 4; const int b = bh >> 2, h = bh & 3;
    const bf16* U0 = (const bf16*)(A.ws + WS_GDN_U0) + (size_t)bh * 32 * 8192; const bf16* Wg = (const bf16*)(A.ws + WS_GDN_W) + (size_t)bh * 32 * 8192; const bf16* QD = (const bf16*)(A.ws + WS_GDN_QD) + (size_t)bh * 32 * 8192;
    const bf16* KE = (const bf16*)(A.ws + WS_GDN_KE) + (size_t)bh * 32 * 8192; const bf16* QK = (const bf16*)(A.ws + WS_GDN_QK) + (size_t)bh * 32 * 4096; const float* DE = (const float*)(A.ws + WS_GDN_DE) + bh * 32;
    const bf16* P = (const bf16*)(A.ws + WS_P); bf16* mix = (bf16*)(A.ws + WS_MIX); LAS float* rsp = (LAS float*)(lds + FC_RS);
    const float gn = A.in[I_GDN_NG][l * GW + h * HD + 16 * wave + fr];
    LAS bf16* ws_ = (LAS bf16*)(lds + FC_W); LAS bf16* qds = (LAS bf16*)(lds + FC_QD); LAS bf16* kes = (LAS bf16*)(lds + FC_KE); LAS bf16* u0s = (LAS bf16*)(lds + FC_U0); LAS bf16* qks = (LAS bf16*)(lds + FC_QK);
    f32x4 S[8];
#pragma unroll
    for (int i = 0; i < 8; ++i) S[i] = (f32x4){0.f, 0.f, 0.f, 0.f};
    v4u st[9];
    auto issue = [&](int n) {
#pragma unroll
        for (int i = 0; i < 8; ++i) { const int idx = tid + i * NTHREADS, which = idx >> 10, pi = idx & 1023;
            const bf16* src = (which == 0 ? Wg : which == 1 ? QD : which == 2 ? KE : U0) + (size_t)n * 8192; st[i] = *(const GAS v4u*)(src + pi * 8); }
        st[8] = *(const GAS v4u*)(QK + (size_t)n * 4096 + tid * 8);
    };
    auto commit = [&]() {
#pragma unroll
        for (int i = 0; i < 8; ++i) { const int idx = tid + i * NTHREADS, which = idx >> 10, pi = idx & 1023, r = pi >> 4, c8 = (pi & 15) * 8;
            *(LAS v4u*)((LAS bf16*)(lds + which * 17408) + r * LD128 + c8) = st[i]; }
        { const int r = tid >> 3, c8 = (tid & 7) * 8; *(LAS v4u*)(qks + r * LD64 + c8) = st[8]; }
    };
    const float dev = DE[lane & 31];
    issue(0);
    f32x4 op[4]; float gp[4][4];
#pragma unroll
    for (int mt = 0; mt < 4; ++mt) { op[mt] = (f32x4){0.f, 0.f, 0.f, 0.f};
#pragma unroll
        for (int r = 0; r < 4; ++r) gp[mt][r] = 0.f; }
#define CH_FINAL(nn) { LAS float* rs_ = rsp + ((nn) & 1) * 512; const size_t rp_ = (size_t)b * SEQ + (nn) * CHK; \
        _Pragma("unroll") for (int mt = 0; mt < 4; ++mt) _Pragma("unroll") for (int r = 0; r < 4; ++r) { const int c = 16 * mt + 4 * fq + r; float ss = 0.f; \
            _Pragma("unroll") for (int w = 0; w < 8; ++w) ss += rs_[w * 64 + c]; \
            mix[(rp_ + c) * DM + 1536 + h * HD + 16 * wave + fr] = (bf16)f2bf(op[mt][r] * rsqrtf(ss * (1.0f / 128.0f) + RMS_EPS) * gn * siluf_(gp[mt][r])); } }
#pragma unroll 1
    for (int n = 0; n < NCHK; ++n) {
        __syncthreads();
        if (n > 0) CH_FINAL(n - 1);
        commit();
        __syncthreads();
        if (n + 1 < NCHK) issue(n + 1);
        const float de = lane_bcast(dev, n);
        const size_t r0 = (size_t)b * SEQ + n * CHK;
#pragma unroll
        for (int mt = 0; mt < 4; ++mt)
#pragma unroll
            for (int r = 0; r < 4; ++r) gp[mt][r] = bf2f(P[(r0 + 16 * mt + 4 * fq + r) * PBW + PC_GDN_G + h * HD + 16 * wave + fr]);
        bf16x8 SB[4];
#pragma unroll
        for (int kb = 0; kb < 4; ++kb) SB[kb] = pack_acc(S[2 * kb], S[2 * kb + 1]);
        f32x4 u[4];
#pragma unroll
        for (int mt = 0; mt < 4; ++mt) { f32x4 ws2 = {0.f, 0.f, 0.f, 0.f}; op[mt] = (f32x4){0.f, 0.f, 0.f, 0.f};
#pragma unroll
            for (int kb = 0; kb < 4; ++kb) { ws2 = MFMA16(frag_rd_perm(ws_, LD128, 16 * mt, 32 * kb, lane), SB[kb], ws2); op[mt] = MFMA16(frag_rd_perm(qds, LD128, 16 * mt, 32 * kb, lane), SB[kb], op[mt]); }
#pragma unroll
            for (int r = 0; r < 4; ++r) u[mt][r] = bf2f(u0s[(16 * mt + 4 * fq + r) * LD128 + 16 * wave + fr]) - ws2[r]; }
        const bf16x8 UB0 = pack_acc(u[0], u[1]), UB1 = pack_acc(u[2], u[3]);
#pragma unroll
        for (int mt = 0; mt < 4; ++mt) { op[mt] = MFMA16(frag_rd_perm(qks, LD64, 16 * mt, 0, lane), UB0, op[mt]); op[mt] = MFMA16(frag_rd_perm(qks, LD64, 16 * mt, 32, lane), UB1, op[mt]); }
#pragma unroll
        for (int dt = 0; dt < 8; ++dt) { f32x4 sn = S[dt] * de;
            sn = MFMA16(frag_tr_perm(kes, LD128, 0, 16 * dt, lane), UB0, sn); sn = MFMA16(frag_tr_perm(kes, LD128, 32, 16 * dt, lane), UB1, sn); S[dt] = sn; }
        LAS float* rs_ = rsp + (n & 1) * 512;
#pragma unroll
        for (int mt = 0; mt < 4; ++mt)
#pragma unroll
            for (int r = 0; r < 4; ++r) { float s = op[mt][r] * op[mt][r]; s = row_sum_f(s);
                if (fr == 0) rs_[wave * 64 + 16 * mt + 4 * fq + r] = s; }
    }
    __syncthreads();
    CH_FINAL(NCHK - 1);
#undef CH_FINAL
    __syncthreads();
}

#ifndef TAB_FP8
#define TAB_FP8 1
#endif
constexpr size_t WS_TSC = 93 * MiB + 256 * 1024;
constexpr int NSLICE = 16;
constexpr int PE_KEYS = 0, PE_CAB = 16384, PE_ENT = 17408, PE_OFFS = 50176, PE_SHQ = 52352, PE_H2Q = 53248;

__device__ __forceinline__ void tab_convert(ArgsR A, int l, int gw, int NGW, int lane) {
    unsigned char* ws = A.ws; float* tsc = (float*)(ws + WS_TSC);
#pragma unroll 1
    for (int q = gw; q < 2 * NEXP; q += NGW) {
        const int t = q / NEXP, rr = l * NEXP + q % NEXP, r = t * DEPTH * NEXP + rr;
        const float* src = A.in[t ? I_PV : I_PU] + (size_t)rr * DM;
        f32x4 v[8];
#pragma unroll
        for (int i = 0; i < 8; ++i) v[i] = *(const GAS f32x4*)(src + 4 * (lane + 64 * i));
        unsigned char* dst = ws + (t ? WS_VB : WS_UB) + (size_t)(rr / NEXP) * TAB_L + (size_t)(rr % NEXP) * DM;
        float am = 0.f;
#pragma unroll
        for (int i = 0; i < 8; ++i) am = fmaxf(fmaxf(am, fmaxf(fabsf(v[i][0]), fabsf(v[i][1]))), fmaxf(fabsf(v[i][2]), fabsf(v[i][3])));
        am = wave_max(am); const float sc = am > 0.f ? 127.0f / am : 1.0f; const int off = 0;
#pragma unroll
        for (int i = 0; i < 8; ++i) { const int q0 = __float2int_rn(v[i][0] * sc) + off, q1 = __float2int_rn(v[i][1] * sc) + off, q2 = __float2int_rn(v[i][2] * sc) + off, q3 = __float2int_rn(v[i][3] * sc) + off;
            *(GAS unsigned*)(dst + 4 * (lane + 64 * i)) = (unsigned)(q0 & 255) | ((unsigned)(q1 & 255) << 8) | ((unsigned)(q2 & 255) << 16) | ((unsigned)(q3 & 255) << 24); }
        if (lane == 0) tsc[r] = am > 0.f ? am * (1.0f / 127.0f) : 1.0f;
    }
}
__device__ __forceinline__ float ubf0(unsigned w) { float r; asm volatile("v_cvt_f32_ubyte0 %0, %1" : "=v"(r) : "v"(w)); return r; }
__device__ __forceinline__ float ubf1(unsigned w) { float r; asm volatile("v_cvt_f32_ubyte1 %0, %1" : "=v"(r) : "v"(w)); return r; }
__device__ __forceinline__ float ubf2(unsigned w) { float r; asm volatile("v_cvt_f32_ubyte2 %0, %1" : "=v"(r) : "v"(w)); return r; }
__device__ __forceinline__ float ubf3(unsigned w) { float r; asm volatile("v_cvt_f32_ubyte3 %0, %1" : "=v"(r) : "v"(w)); return r; }
#define TOUCH16(a, o) asm volatile("" : "+v"(a[(o)+0]), "+v"(a[(o)+1]), "+v"(a[(o)+2]), "+v"(a[(o)+3]), "+v"(a[(o)+4]), "+v"(a[(o)+5]), "+v"(a[(o)+6]), "+v"(a[(o)+7]), "+v"(a[(o)+8]), "+v"(a[(o)+9]), "+v"(a[(o)+10]), "+v"(a[(o)+11]), "+v"(a[(o)+12]), "+v"(a[(o)+13]), "+v"(a[(o)+14]), "+v"(a[(o)+15]))
__device__ __forceinline__ unsigned f2sortable(float f) { const unsigned u = __builtin_bit_cast(unsigned, f); return (u & 0x80000000u) ? ~u : (u | 0x80000000u); }
__device__ __forceinline__ float unsortable(unsigned k) { const unsigned u = (k & 0x80000000u) ? (k & 0x7fffffffu) : ~k; return __builtin_bit_cast(float, u); }
__device__ __forceinline__ void peer_phase(ArgsR A, int l, bool last, bool dry, LAS unsigned char* lds, int G, int tid) {
    const int wave = __builtin_amdgcn_readfirstlane(tid >> 6), lane = tid & 63;
    unsigned char* ws = A.ws;
    const bf16* Q = (const bf16*)(ws + WS_Q);
    const bf16* K1 = (const bf16*)(ws + WS_K1) + (size_t)l * 8 * 128 * 128; const bf16* K2 = (const bf16*)(ws + WS_K2) + (size_t)l * 8 * 128 * 128;
    const unsigned char* Ub = ws + WS_UB + (size_t)l * TAB_L; const unsigned char* Vb = ws + WS_VB + (size_t)l * TAB_L;
    const float* tscU = (const float*)(ws + WS_TSC) + (size_t)l * NEXP; const float* tscV = tscU + (size_t)DEPTH * NEXP;
    const float* ssp = (const float*)(ws + WS_SSP); const float* X = A.out; float* XO = dry ? (float*)(ws + WS_P) : A.out; bf16* xb = (bf16*)(ws + (dry ? WS_MIX : WS_XB)); float* rstd1 = (float*)(ws + (dry ? WS_PS : WS_RSTD1));
    const float* g2 = A.in[I_N2G] + l * DM; const float* gf = A.in[I_FNG];
    LAS unsigned* keysL = (LAS unsigned*)(lds + PE_KEYS); LAS unsigned* cab = (LAS unsigned*)(lds + PE_CAB); LAS v2u* ent = (LAS v2u*)(lds + PE_ENT); LAS unsigned* offs = (LAS unsigned*)(lds + PE_OFFS);
    LAS float* shqL = (LAS float*)(lds + PE_SHQ); LAS unsigned* ngt = (LAS unsigned*)(lds + PE_SHQ + 128); LAS float* cqs = (LAS float*)(lds + PE_SHQ + 256); LAS v4u* h2qL = (LAS v4u*)(lds + PE_H2Q);
    if (tid < 64) { int a = 0, b = tid, found = 0;
        for (int aa = 0, base = 0; aa < 16; ++aa) { const int nbb = 16 / (aa + 1); if (!found && tid < base + nbb) { a = aa; b = tid - base; found = 1; } base += nbb; }
        cab[tid] = found ? (unsigned)(a * 16 + b) : 0xffu; }
    __syncthreads();
#pragma unroll 1
    for (int item = blockIdx.x; item < NT / 32; item += G) {
        const int tok0 = item * 32;
#pragma unroll 1
        for (int tt = 0; tt < 4; ++tt) { const int tl = wave * 4 + tt; const size_t t = (size_t)tok0 + tl;
            float s2 = (lane < 32) ? ssp[t * 32 + lane] : 0.f; s2 = wave_sum(s2);
            const float rstd2 = rsqrtf(s2 * (1.0f / DM) + RMS_EPS);
            float hf[32]; float am = 0.f;
#pragma unroll
            for (int j = 0; j < 2; ++j)
#pragma unroll
                for (int q = 0; q < 4; ++q) { const size_t e0 = 16 * (size_t)(lane + 64 * j) + 4 * q;
                    const f32x4 xa = *(const GAS f32x4*)(X + t * DM + e0), ga = *(const GAS f32x4*)(g2 + e0);
#pragma unroll
                    for (int k = 0; k < 4; ++k) { const float hv = xa[k] * rstd2 * ga[k]; hf[j * 16 + q * 4 + k] = hv; am = fmaxf(am, fabsf(hv)); } }
            am = wave_max(am); const float sc = am > 0.f ? 127.0f / am : 1.0f;
#pragma unroll
            for (int j = 0; j < 2; ++j) { unsigned wd[4];
#pragma unroll
                for (int q = 0; q < 4; ++q) wd[q] = (unsigned)((__float2int_rn(hf[j * 16 + q * 4 + 0] * sc) & 255) | ((__float2int_rn(hf[j * 16 + q * 4 + 1] * sc) & 255) << 8) | ((__float2int_rn(hf[j * 16 + q * 4 + 2] * sc) & 255) << 16) | ((__float2int_rn(hf[j * 16 + q * 4 + 3] * sc) & 255) << 24));
                v4u w; w.x = wd[0]; w.y = wd[1]; w.z = wd[2]; w.w = wd[3]; h2qL[(tl * 2 + j) * 64 + lane] = w; }
            if (lane == 0) shqL[tl] = am > 0.f ? am * (1.0f / 127.0f) : 1.0f; }
#pragma unroll 1
        for (int pass = 0; pass < 4; ++pass) {
            LAS unsigned* kl = keysL + (pass & 1) * 2048;
            { const int hh = wave >> 2, side = (wave >> 1) & 1, mt = wave & 1, h = 2 * pass + hh, fr = lane & 15, fq = lane >> 4;
                const bf16* qa = Q + (size_t)(tok0 + 16 * mt + fr) * DM + h * 256 + side * 128 + 8 * fq;
                const bf16* kb = (side ? K2 : K1) + (size_t)h * 128 * 128 + (size_t)fr * 128 + 8 * fq;
                bf16x8 af[4];
#pragma unroll
                for (int ks = 0; ks < 4; ++ks) af[ks] = *(const GAS bf16x8*)(qa + 32 * ks);
                unsigned key[8][4];
#pragma unroll
                for (int nt = 0; nt < 8; ++nt) { f32x4 acc = {0.f, 0.f, 0.f, 0.f};
#pragma unroll
                    for (int ks = 0; ks < 4; ++ks) { const bf16x8 bfr = *(const GAS bf16x8*)(kb + (size_t)nt * 16 * 128 + 32 * ks); acc = __builtin_amdgcn_mfma_f32_16x16x32_bf16(af[ks], bfr, acc, 0, 0, 0); }
#pragma unroll
                    for (int r = 0; r < 4; ++r) key[nt][r] = (f2sortable(acc[r]) & ~127u) | (unsigned)(nt * 16 + fr);
                    if (nt & 1) __builtin_amdgcn_sched_barrier(0); }
#define CE8(a, b) { const unsigned hi_ = max(key[a][r], key[b][r]), lo_ = min(key[a][r], key[b][r]); key[a][r] = hi_; key[b][r] = lo_; }
#pragma unroll
                for (int r = 0; r < 4; ++r) { CE8(0, 1) CE8(2, 3) CE8(4, 5) CE8(6, 7) CE8(0, 2) CE8(1, 3) CE8(4, 6) CE8(5, 7) CE8(1, 2) CE8(5, 6) CE8(0, 4) CE8(1, 5) CE8(2, 6) CE8(3, 7) CE8(2, 4) CE8(3, 5) CE8(1, 2) CE8(3, 4) CE8(5, 6) }
#undef CE8
                unsigned res[4] = {0u, 0u, 0u, 0u};
#pragma unroll 1
                for (int j = 0; j < 16; ++j) {
#pragma unroll
                    for (int r = 0; r < 4; ++r) {
                        const unsigned w = row_max_u(key[0][r]); const bool own = key[0][r] == w;
#pragma unroll
                        for (int nt = 0; nt < 7; ++nt) key[nt][r] = own ? key[nt + 1][r] : key[nt][r];
                        key[7][r] = own ? 0u : key[7][r];
                        res[r] = (fr == j) ? w : res[r]; } }
                const int rowb = (hh * 2 + side) * 32 + 16 * mt + 4 * fq;
#pragma unroll
                for (int r = 0; r < 4; ++r) kl[(rowb + r) * 16 + fr] = res[r]; }
            __syncthreads();
#pragma unroll 1
            for (int rnd = 0; rnd < 2; ++rnd) { const int fr = lane & 15, fq = lane >> 4, pidx = rnd * 32 + wave * 4 + fq, hh = pidx >> 5, tk = pidx & 31, h = 2 * pass + hh;
                const LAS unsigned* k1 = kl + ((hh * 2) * 32 + tk) * 16; const LAS unsigned* k2 = k1 + 32 * 16;
                unsigned ck[4];
#pragma unroll
                for (int sl = 0; sl < 4; ++sl) { const int ci = fr + 16 * sl; const unsigned ab = cab[ci];
                    const float v = unsortable(k1[(ab >> 4) & 15] & ~127u) + unsortable(k2[ab & 15] & ~127u);
                    ck[sl] = (ab == 0xffu) ? 0u : ((f2sortable(v) & ~63u) | (unsigned)ci); }
#define CE4(a, b) { const unsigned hi_ = max(ck[a], ck[b]), lo_ = min(ck[a], ck[b]); ck[a] = hi_; ck[b] = lo_; }
                CE4(0, 1) CE4(2, 3) CE4(0, 2) CE4(1, 3) CE4(1, 2)
#undef CE4
                unsigned rk = 0u;
#pragma unroll 1
                for (int j = 0; j < 16; ++j) { const unsigned w = row_max_u(ck[0]); const bool own = ck[0] == w;
                    ck[0] = own ? ck[1] : ck[0]; ck[1] = own ? ck[2] : ck[1]; ck[2] = own ? ck[3] : ck[2]; ck[3] = own ? 0u : ck[3];
                    rk = (fr == j) ? w : rk; }
                const unsigned ab = cab[rk & 63u]; const float v = unsortable(rk & ~63u);
                const float vmax = row_max_f(v), e = __expf(v - vmax), den = row_sum_f(e);
                const unsigned eid = (k1[(ab >> 4) & 15] & 127u) * 128u + (k2[ab & 15] & 127u);
                const float gsv = e * rcpf_(den) * tscV[eid];
                v2u wv; wv.x = eid; wv.y = __builtin_bit_cast(unsigned, gsv);
                ent[tk * 128 + h * 16 + fr] = wv; }
        }
        __syncthreads();
#pragma unroll 1
        for (int tt = 0; tt < 4; ++tt) { const int tl = wave * 4 + tt;
            const v2u e0 = ent[tl * 128 + lane], e1 = ent[tl * 128 + 64 + lane];
            const unsigned id0 = e0.x, id1 = e1.x; const unsigned s0 = id0 >> 10, s1 = id1 >> 10; const unsigned long long lt = (1ull << lane) - 1ull;
            unsigned base = 0, p0 = 0, p1 = 0, ngr = 0;
#pragma unroll 1
            for (unsigned s = 0; s < NSLICE; ++s) { const unsigned long long m0 = __ballot(s0 == s), m1 = __ballot(s1 == s); const unsigned c0 = __popcll(m0), c1 = __popcll(m1); ngr += (c0 + c1 + 3u) >> 2;
                if (s0 == s) p0 = base + __popcll(m0 & lt);
                if (s1 == s) p1 = base + c0 + __popcll(m1 & lt);
                if (lane == 0) offs[tl * 17 + s] = base;
                base += c0 + c1; }
            if (lane == 0) { offs[tl * 17 + NSLICE] = base; ngt[tl] = ngr; }
            ent[tl * 128 + p0] = e0; ent[tl * 128 + p1] = e1; }
        const unsigned lo16 = (unsigned)lane * 16u;
#define E_ADV(S, T, P, B1, NTOK, TLBASE) { P += 4; while (P >= B1 && S < NSLICE) { ++T; if (T == (NTOK)) { T = 0; ++S; } \
            if (S < NSLICE) { P = __builtin_amdgcn_readfirstlane((int)offs[((TLBASE) + T) * 17 + S]); B1 = __builtin_amdgcn_readfirstlane((int)offs[((TLBASE) + T) * 17 + S + 1]); } } \
            if (S >= NSLICE) { T = 0; P = 128; B1 = 128; } }
#define E_FETCH(X, T, P, B1, TLBASE, WITHSU) { X##tl = (TLBASE) + T; X##w = T; X##p = P; X##b1 = B1; \
            _Pragma("unroll") for (int e = 0; e < 4; ++e) { const v2u w_ = ent[X##tl * 128 + min(P + e, B1 - 1)]; const unsigned ex = w_.x, ey = w_.y; \
                X##id[e] = __builtin_amdgcn_readfirstlane((int)ex); X##cf[e] = __builtin_bit_cast(float, __builtin_amdgcn_readfirstlane((int)ey)); if (WITHSU) X##su[e] = tscU[X##id[e]]; } }
#define E_LOAD(REG, TAB, X) { _Pragma("unroll") for (int e = 0; e < 4; ++e) { const GAS unsigned char* rb = (const GAS unsigned char*)(TAB) + (size_t)X##id[e] * 2048; REG[e][0] = *(const GAS v4u*)(rb + lo16); REG[e][1] = *(const GAS v4u*)(rb + lo16 + 1024); } }
        {
            int Atl = 0, Aw = 0, Ap = 0, Ab1 = 0, Aid[4]; float Acf[4], Asu[4]; int Btl = 0, Bw = 0, Bp = 0, Bb1 = 0, Bid[4]; float Bcf[4], Bsu[4]; v4u RA[4][2], RB[4][2];
            (void)Aw; (void)Bw;
#define U_COMP(X, REG) { const v4u hq0 = h2qL[(X##tl * 2 + 0) * 64 + lane], hq1 = h2qL[(X##tl * 2 + 1) * 64 + lane]; const float shq = shqL[X##tl]; float dd[4]; \
                _Pragma("unroll") for (int e = 0; e < 4; ++e) { int a0 = 0, a1 = 0; \
                    a0 = __builtin_amdgcn_sdot4((int)REG[e][0][0], (int)hq0[0], a0, false); a1 = __builtin_amdgcn_sdot4((int)REG[e][0][1], (int)hq0[1], a1, false); \
                    a0 = __builtin_amdgcn_sdot4((int)REG[e][0][2], (int)hq0[2], a0, false); a1 = __builtin_amdgcn_sdot4((int)REG[e][0][3], (int)hq0[3], a1, false); \
                    a0 = __builtin_amdgcn_sdot4((int)REG[e][1][0], (int)hq1[0], a0, false); a1 = __builtin_amdgcn_sdot4((int)REG[e][1][1], (int)hq1[1], a1, false); \
                    a0 = __builtin_amdgcn_sdot4((int)REG[e][1][2], (int)hq1[2], a0, false); a1 = __builtin_amdgcn_sdot4((int)REG[e][1][3], (int)hq1[3], a1, false); \
                    dd[e] = (float)(a0 + a1); } \
                _Pragma("unroll") for (int e = 0; e < 4; ++e) { const float r_ = row_sum_f(dd[e]); const int ri_ = __builtin_bit_cast(int, r_); \
                    dd[e] = (__builtin_bit_cast(float, __builtin_amdgcn_readlane(ri_, 0)) + __builtin_bit_cast(float, __builtin_amdgcn_readlane(ri_, 16))) + (__builtin_bit_cast(float, __builtin_amdgcn_readlane(ri_, 32)) + __builtin_bit_cast(float, __builtin_amdgcn_readlane(ri_, 48))); } \
                _Pragma("unroll") for (int e = 0; e < 4; ++e) { const float cf = X##cf[e] * gelu_tanh(dd[e] * X##su[e] * shq); \
                    if (lane == 0 && X##p + e < X##b1) { v2u w2; w2.x = (unsigned)X##id[e]; w2.y = __builtin_bit_cast(unsigned, cf); ent[X##tl * 128 + X##p + e] = w2; } } }
            int us = 0, ut = -1, up = 0, ub1 = 0;
            const int ngU = __builtin_amdgcn_readfirstlane((int)(ngt[wave * 4] + ngt[wave * 4 + 1] + ngt[wave * 4 + 2] + ngt[wave * 4 + 3]));
            E_ADV(us, ut, up, ub1, 4, wave * 4);
            E_FETCH(A, ut, up, ub1, wave * 4, 1); E_LOAD(RA, Ub, A);
#pragma unroll 1
            for (int gi = 0; gi < ngU; gi += 2) {
                E_ADV(us, ut, up, ub1, 4, wave * 4); E_FETCH(B, ut, up, ub1, wave * 4, 1); E_LOAD(RB, Ub, B);
                U_COMP(A, RA);
                E_ADV(us, ut, up, ub1, 4, wave * 4); E_FETCH(A, ut, up, ub1, wave * 4, 1); E_LOAD(RA, Ub, A);
                U_COMP(B, RB);
            }
#undef U_COMP
        }
#pragma unroll 1
        for (int tt = 0; tt < 4; ++tt) { const int tl = wave * 4 + tt;
            const v2u e0 = ent[tl * 128 + lane], e1 = ent[tl * 128 + 64 + lane]; const unsigned b0_ = e0.y, b1_ = e1.y;
            const float c0 = __builtin_bit_cast(float, b0_), c1 = __builtin_bit_cast(float, b1_);
            const float am = wave_max(fmaxf(fabsf(c0), fabsf(c1))); const float sc = am > 0.f ? 127.0f / am : 0.f;
            v2u w0 = e0, w1 = e1; w0.y = (unsigned)__float2int_rn(c0 * sc); w1.y = (unsigned)__float2int_rn(c1 * sc);
            ent[tl * 128 + lane] = w0; ent[tl * 128 + 64 + lane] = w1;
            if (lane == 0) cqs[tl] = am * (1.0f / 127.0f); }
#pragma unroll 1
        for (int tq = 0; tq < 4; ++tq) {
            int yi[32];
#pragma unroll
            for (int i = 0; i < 32; ++i) yi[i] = 0;
            const int tla = wave * 4 + tq; const size_t ta = (size_t)tok0 + tla;
            {
                int Atl = 0, Aw = 0, Ap = 0, Ab1 = 0, Aid[4]; float Acf[4], Asu[4]; int Btl = 0, Bw = 0, Bp = 0, Bb1 = 0, Bid[4]; float Bcf[4], Bsu[4]; v4u RA[4][2], RB[4][2];
                (void)Asu; (void)Bsu; (void)Atl; (void)Btl; (void)Aw; (void)Bw;
#define V_COMP(X, REG) { int cq_[4]; _Pragma("unroll") for (int e = 0; e < 4; ++e) cq_[e] = (X##p + e < X##b1) ? __builtin_bit_cast(int, X##cf[e]) : 0; \
                    const int cpk = (cq_[0] & 255) | ((cq_[1] & 255) << 8) | ((cq_[2] & 255) << 16) | ((cq_[3] & 255) << 24); \
                    _Pragma("unroll") for (int j = 0; j < 2; ++j) _Pragma("unroll") for (int w = 0; w < 4; ++w) { \
                        const unsigned ab_lo = __builtin_amdgcn_perm(REG[1][j][w], REG[0][j][w], 0x05010400u), ab_hi = __builtin_amdgcn_perm(REG[1][j][w], REG[0][j][w], 0x07030602u); \
                        const unsigned cd_lo = __builtin_amdgcn_perm(REG[3][j][w], REG[2][j][w], 0x05010400u), cd_hi = __builtin_amdgcn_perm(REG[3][j][w], REG[2][j][w], 0x07030602u); \
                        yi[j * 16 + w * 4 + 0] = __builtin_amdgcn_sdot4((int)__builtin_amdgcn_perm(cd_lo, ab_lo, 0x05040100u), cpk, yi[j * 16 + w * 4 + 0], false); \
                        yi[j * 16 + w * 4 + 1] = __builtin_amdgcn_sdot4((int)__builtin_amdgcn_perm(cd_lo, ab_lo, 0x07060302u), cpk, yi[j * 16 + w * 4 + 1], false); \
                        yi[j * 16 + w * 4 + 2] = __builtin_amdgcn_sdot4((int)__builtin_amdgcn_perm(cd_hi, ab_hi, 0x05040100u), cpk, yi[j * 16 + w * 4 + 2], false); \
                        yi[j * 16 + w * 4 + 3] = __builtin_amdgcn_sdot4((int)__builtin_amdgcn_perm(cd_hi, ab_hi, 0x07060302u), cpk, yi[j * 16 + w * 4 + 3], false); } }
                int us = 0, ut = -1, up = 0, ub1 = 0;
                const int ngV = __builtin_amdgcn_readfirstlane((int)ngt[tla]);
                E_ADV(us, ut, up, ub1, 1, tla);
                E_FETCH(A, ut, up, ub1, tla, 0); E_LOAD(RA, Vb, A);
#pragma unroll 1
                for (int gi = 0; gi < ngV; gi += 2) {
                    E_ADV(us, ut, up, ub1, 1, tla); E_FETCH(B, ut, up, ub1, tla, 0); E_LOAD(RB, Vb, B);
                    V_COMP(A, RA);
                    E_ADV(us, ut, up, ub1, 1, tla); E_FETCH(A, ut, up, ub1, tla, 0); E_LOAD(RA, Vb, A);
                    V_COMP(B, RB);
                }
#undef V_COMP
            }
            float y0[32]; const float cs0 = cqs[tla];
#pragma unroll
            for (int j = 0; j < 2; ++j)
#pragma unroll
                for (int q = 0; q < 4; ++q) { const size_t e0 = 16 * (size_t)(lane + 64 * j) + 4 * q; const f32x4 xa = *(const GAS f32x4*)(X + ta * DM + e0);
#pragma unroll
                    for (int k = 0; k < 4; ++k) y0[j * 16 + q * 4 + k] = xa[k] + cs0 * (float)yi[j * 16 + q * 4 + k]; }
#define PV_EPI(YY, CS, T) { float ss = 0.f; \
                _Pragma("unroll") for (int i = 0; i < 32; ++i) ss += YY[i] * YY[i]; \
                ss = wave_sum(ss); const float rs = rsqrtf(ss * (1.0f / DM) + RMS_EPS); \
                if (last) { _Pragma("unroll") for (int j = 0; j < 2; ++j) _Pragma("unroll") for (int q = 0; q < 4; ++q) { const size_t e0 = 16 * (size_t)(lane + 64 * j) + 4 * q; const f32x4 ga = *(const GAS f32x4*)(gf + e0); \
                        f32x4 oa = {YY[j * 16 + q * 4 + 0] * rs * ga[0], YY[j * 16 + q * 4 + 1] * rs * ga[1], YY[j * 16 + q * 4 + 2] * rs * ga[2], YY[j * 16 + q * 4 + 3] * rs * ga[3]}; *(GAS f32x4*)(XO + (T) * DM + e0) = oa; } } \
                else { _Pragma("unroll") for (int j = 0; j < 2; ++j) { \
                        _Pragma("unroll") for (int q = 0; q < 4; ++q) { const size_t e0 = 16 * (size_t)(lane + 64 * j) + 4 * q; f32x4 oa = {YY[j * 16 + q * 4 + 0], YY[j * 16 + q * 4 + 1], YY[j * 16 + q * 4 + 2], YY[j * 16 + q * 4 + 3]}; *(GAS f32x4*)(XO + (T) * DM + e0) = oa; } \
                        const size_t e0 = 16 * (size_t)(lane + 64 * j); v4u w0, w1; \
                        w0.x = pk2(YY[j * 16 + 0], YY[j * 16 + 1]); w0.y = pk2(YY[j * 16 + 2], YY[j * 16 + 3]); w0.z = pk2(YY[j * 16 + 4], YY[j * 16 + 5]); w0.w = pk2(YY[j * 16 + 6], YY[j * 16 + 7]); \
                        w1.x = pk2(YY[j * 16 + 8], YY[j * 16 + 9]); w1.y = pk2(YY[j * 16 + 10], YY[j * 16 + 11]); w1.z = pk2(YY[j * 16 + 12], YY[j * 16 + 13]); w1.w = pk2(YY[j * 16 + 14], YY[j * 16 + 15]); \
                        *(GAS v4u*)(xb + (T) * DM + e0) = w0; *(GAS v4u*)(xb + (T) * DM + e0 + 8) = w1; } \
                    if (lane == 0) rstd1[(T)] = rs; } }
            PV_EPI(y0, cs0, ta);
#undef PV_EPI
#undef E_ADV
#undef E_FETCH
#undef E_LOAD
        }
        __syncthreads();
    }
}

#ifndef PROBE_ITEM
#define PROBE_ITEM -1
#endif
#define IREP(k) for (int irep = (PROBE_ITEM == (k)) ? 0 : 1; irep < 2; ++irep)
__device__ __forceinline__ void mix_p2(ArgsR A, int l, LAS unsigned char* lds, int G, int tid) {
    const int bx = blockIdx.x; (void)tid;
    IREP(1) for (int it = bx; it < 512; it += G) f_gla_p2(A, l, it, lds, pg8::fresh_tid());
    IREP(2) for (int it = bx; it < 512; it += G) f_ml_p2(A, l, it, lds, pg8::fresh_tid());
    IREP(3) for (int it = bx; it < 512; it += G) f_gdn_p2(A, l, it, lds, pg8::fresh_tid());
    IREP(4) for (int it = bx; it < 1024; it += G) f_lru_p2(A, l, it, lds, pg8::fresh_tid());
}
__device__ __forceinline__ void part_barrier(unsigned* word, unsigned nb, int tid) {
    asm volatile("s_waitcnt vmcnt(0)" ::: "memory");
    __syncthreads();
    if (tid == 0) {
        __builtin_amdgcn_fence(__ATOMIC_RELEASE, "agent");
        asm volatile("s_waitcnt vmcnt(0)" ::: "memory");
        __hip_atomic_fetch_add(word, 1u, __ATOMIC_RELAXED, __HIP_MEMORY_SCOPE_AGENT);
        unsigned sp = 0;
        while (__hip_atomic_load(word, __ATOMIC_RELAXED, __HIP_MEMORY_SCOPE_AGENT) < nb) { __builtin_amdgcn_s_sleep(2); if (++sp > (1u << 22)) break; }
        __builtin_amdgcn_fence(__ATOMIC_ACQUIRE, "agent");
        asm volatile("s_waitcnt vmcnt(0)" ::: "memory");
    }
    __syncthreads();
}
__device__ __forceinline__ void mix_p3(ArgsR A, int l, LAS unsigned char* lds, int G) {
    const int bx = blockIdx.x;
    const bool split = G > 32;
    int first = 0, nb = G;
    if (split) { if (bx < 16) { IREP(8) f_gdn_p3(A, l, bx, lds, pg8::fresh_tid()); return; } first = 16; nb = G - 16; }
    else { for (int it = bx; it < 16; it += G) f_gdn_p3(A, l, it, lds, pg8::fresh_tid()); }
    for (int it = bx - first; it < 516; it += nb) {
        if (it < 256) f_gla_p3(A, it, pg8::fresh_tid());
        else if (it < 512) f_ml_p3(A, it - 256, pg8::fresh_tid());
        else f_lru_p3(A, it - 512, pg8::fresh_tid());
    }
    IREP(7) { const int t2 = pg8::fresh_tid(); tab_convert(A, l, (bx - first) * NWAVES + __builtin_amdgcn_readfirstlane(t2 >> 6), nb * NWAVES, t2 & 63); }
    part_barrier((unsigned*)(A.ws + WS_CTL) + CW_PBAR + 64 * l, (unsigned)nb, pg8::fresh_tid());
    IREP(5) for (int it = bx - first; it < 512; it += nb) f_gla_p4(A, l, it, lds, pg8::fresh_tid());
    IREP(6) for (int it = nb - 1 - (bx - first); it < 512; it += nb) f_ml_p4(       A, l, it, lds, pg8::fresh_tid());
    for (int it = bx - first; it < 128; it += nb) f_lru_p4(A, it, pg8::fresh_tid());
}

#ifndef PROBE_PHASE
#define PROBE_PHASE -1
#endif
#ifndef MK_PER_PHASE
#define MK_PER_PHASE 0
#endif
#ifdef PROBE_DUP
constexpr int PPL = 7;
#else
constexpr int PPL = 6;
#endif
constexpr int NPHASE = 1 + PPL * DEPTH;
constexpr int CW_BAR = 4096;

__global__ void __launch_bounds__(NTHREADS, 2) mk_fwd(Args args) {
    extern __shared__ __attribute__((aligned(16))) unsigned char lds_raw[];
    LAS unsigned char* lds = (LAS unsigned char*)lds_raw;
    volatile LAS unsigned* MISC = (volatile LAS unsigned*)(lds + MISC_OFF);
    const int G = gridDim.x; const int bx = blockIdx.x;
    unsigned char* ws = args.ws;
    if (threadIdx.x < 64) MISC[threadIdx.x] = 0u;
    __syncthreads();
    XcdBarrier bar; bar.bar = (unsigned*)(ws + WS_CTL) + CW_BAR; bar.x = 0; bar.st = nullptr;
    if (!MK_PER_PHASE) bar = xcd_barrier_post((unsigned*)(ws + WS_CTL) + CW_BAR, MISC + 8);
    const int lo = args.ph_lo, hi = args.ph_hi;
#pragma unroll 1
    for (int ph = lo; ph < hi; ++ph) {
#ifdef PROBE_DUP
        const int l = ph > 0 ? (ph - 1) / PPL : 0, kx = ph > 0 ? (ph - 1) % PPL : -1, k = kx > PROBE_DUP ? kx - 1 : kx; const bool dry = (kx == PROBE_DUP);
#else
        const int l = ph > 0 ? (ph - 1) / PPL : 0, k = ph > 0 ? (ph - 1) % PPL : -1; const bool dry = false;
#endif
        if (k < 0) { const int t0 = pg8::fresh_tid(); const int vcu = (G % 8 == 0) ? (bx % 8) * (G / 8) + bx / 8 : bx; p0_prologue(*kargs(), lds, vcu, G, __builtin_amdgcn_readfirstlane(t0 >> 6), t0 & 63); }
        else if (k == 0) {
            pg8::Gemm g{(const pg8::bf16_t*)(ws + WS_XB), (const pg8::bf16_t*)(ws + WS_WIN + l * WIN_L), NT, NINP, DM}; pg8::StaticOrder S; S.init(NT, NINP, G, bx);
            pg8::EpiP E{(pg8::bf16_t*)(ws + WS_P), (float*)(ws + WS_PS), (const float*)(ws + WS_RSTD1)};
            pg8::gemm_phase<pg8::EpiP, pg8::StaticOrder, true, true>(lds, g, S, E); }
        else if (k == 1) mix_p2(*kargs(), l, lds, G, pg8::fresh_tid());
        else if (k == 2) mix_p3(*kargs(), l, lds, G);
        else if (k == 3) {
            pg8::Gemm g{(const pg8::bf16_t*)(ws + WS_MIX), (const pg8::bf16_t*)(ws + WS_WOUT + l * WSQ_L), NT, DM, DM}; pg8::StaticOrder S; S.init(NT, DM, G, bx);
            pg8::EpiX E{l == 0 ? args.in[I_X] : (const float*)args.out, dry ? (float*)(ws + WS_P) : args.out, (pg8::bf16_t*)(ws + (dry ? WS_Q : WS_XB)), (float*)(ws + (dry ? WS_PS : WS_SSP))};
            pg8::gemm_phase<pg8::EpiX, pg8::StaticOrder, true, true>(lds, g, S, E); }
        else if (k == 4) {
            pg8::Gemm g{(const pg8::bf16_t*)(ws + WS_XB), (const pg8::bf16_t*)(ws + WS_WQ + l * WSQ_L), NT, DM, DM}; pg8::StaticOrder S; S.init(NT, DM, G, bx);
            pg8::EpiQ E{(pg8::bf16_t*)(ws + WS_Q), (const float*)(ws + WS_SSP)};
            pg8::gemm_phase<pg8::EpiQ, pg8::StaticOrder, true, true>(lds, g, S, E); }
        else peer_phase(*kargs(), l, l == DEPTH - 1, dry, lds, G, pg8::fresh_tid());
        if (!MK_PER_PHASE && ph + 1 < hi) xcd_barrier(bar);
    }
}

extern "C" void kernel_launch(void* const* d_in, const int* in_sizes, int n_in, void* d_out, int out_size, void* d_ws, size_t ws_size, hipStream_t stream) {
    static int grid = 0;
    if (grid == 0) {
        if (n_in != N_IN || out_size != NT * DM || ws_size < WS_END) { fprintf(stderr, "kernel_launch: unexpected shapes: n_in %d out %d ws %zu (need %zu)\n", n_in, out_size, ws_size, (size_t)WS_END); grid = -1; return; }
        int dev = 0, cus = 0, per_cu = 0;
        if (hipGetDevice(&dev) != hipSuccess || hipDeviceGetAttribute(&cus, hipDeviceAttributeMultiprocessorCount, dev) != hipSuccess) { grid = -1; return; }
        if (hipFuncSetAttribute((const void*)mk_fwd, hipFuncAttributeMaxDynamicSharedMemorySize, LDS_BYTES) != hipSuccess) { fprintf(stderr, "kernel_launch: hipFuncSetAttribute failed\n"); grid = -1; return; }
        if (hipOccupancyMaxActiveBlocksPerMultiprocessor(&per_cu, (const void*)mk_fwd, NTHREADS, LDS_BYTES) != hipSuccess || per_cu < 1) { fprintf(stderr, "kernel_launch: occupancy query says %d blocks per CU\n", per_cu); (void)hipGetLastError(); grid = -1; return; }
        grid = cus;
    }
    if (grid < 0) return;
    if (hipMemsetAsync((char*)d_ws + WS_CTL, 0, CTL_ZERO_BYTES, stream) != hipSuccess) return;
    Args a{};
    for (int i = 0; i < N_IN; ++i) a.in[i] = (const float*)d_in[i];
    a.out = (float*)d_out; a.ws = (unsigned char*)d_ws;
#if MK_PER_PHASE
    for (int p = 0; p < NPHASE; ++p) { a.ph_lo = p; a.ph_hi = p + 1; a.li = 0; hipLaunchKernelGGL(mk_fwd, dim3(grid), dim3(NTHREADS), LDS_BYTES, stream, a); }
#else
    a.ph_lo = 0; a.ph_hi = NPHASE; a.li = 0;
    hipLaunchKernelGGL(mk_fwd, dim3(grid), dim3(NTHREADS), LDS_BYTES, stream, a);
#endif
}
```

```cpp
#include <hip/hip_runtime.h>
#include <cstdio>
#include <cstdint>
namespace pg8 {
__device__ __forceinline__ int fresh_tid() { int t = threadIdx.x; asm volatile("" : "+v"(t)); return t; }
#define PG8_LAS __attribute__((address_space(3)))
typedef unsigned short bf16_t;
typedef short bf16x8 __attribute__((ext_vector_type(8)));
typedef float f32x4 __attribute__((ext_vector_type(4)));
typedef unsigned u32x4 __attribute__((ext_vector_type(4)));
constexpr int BM = 256, BK = 64, HALF = 128, HTB = HALF * BK * 2  , STAGE_BYTES = 8 * HTB, NXCD = 8, WGM = 8;

__host__ __device__ __forceinline__ int lds_byte(int r, int c) { const int st = (r >> 4) * 2 + (c >> 5), rr = r & 15, cc = c & 31, ob = rr * 64 + cc * 2; return st * 1024 + (ob ^ (((ob >> 9) & 1) << 5)); }
__host__ __device__ __forceinline__ void stage_rc(int b, int& R, int& C) { const int st = b / 1024, sb = b % 1024, swz = sb ^ (((sb >> 9) & 1) << 5); R = (st >> 1) * 16 + swz / 64; C = (st & 1) * 32 + (swz % 64) / 2; }
__host__ __device__ __forceinline__ int perm32(int rho) { const int n = rho >> 4, i = rho & 15; return 8 * (i >> 2) + 4 * n + (i & 3); }

struct Unit { int pm, pn; };
struct Gemm { const bf16_t* A; const bf16_t* Bt; int M, N, K; };

struct StaticOrder {
    int nM, nN, nwg, G, c;
    __host__ __device__ void init(int M, int N, int G_, int c_) { nM = M / BM; nN = N / BM; nwg = nM * nN; G = G_; c = c_; }
    __host__ __device__ bool next(int i, Unit& u) const {
        const long L = (long)i * G + c; if (L >= nwg) return false;
        int wgid = (int)L; { const int q = nwg / NXCD, r = nwg % NXCD, xcd = wgid % NXCD, off = wgid / NXCD; wgid = (xcd < r ? xcd * (q + 1) : r * (q + 1) + (xcd - r) * q) + off; }
        const int nig = WGM * nN, gid = wgid / nig, fm = gid * WGM, gsz = (nM - fm) < WGM ? (nM - fm) : WGM;
        u.pm = fm + ((wgid % nig) % gsz); u.pn = (wgid % nig) / gsz; return true;
    }
    __device__ __forceinline__ void a_ready(const Unit&) const {}
    __device__ __forceinline__ void done(const Unit&) const {}
};


__device__ __forceinline__ unsigned cvt_pk_bf16(float lo, float hi) { unsigned r; asm volatile("v_cvt_pk_bf16_f32 %0, %1, %2" : "=v"(r) : "v"(lo), "v"(hi)); return r; }

struct EpiP {
    static constexpr bool PERM = true, AFTER_DRAIN = false;
    bf16_t* P; float* Ps; const float* rstd;
    __device__ __forceinline__ void operator()(const f32x4 (&acc)[2][2][4][2], const Unit& u, int wr, int wc, int fr, int fq) const {
        const int row0 = u.pm * BM + wr * 64 + fr;
        if (u.pn < 28) {
            const int col0 = u.pn * BM + wc * 32 + 8 * fq;
#pragma unroll
            for (int ai = 0; ai < 2; ++ai)
#pragma unroll
                for (int m = 0; m < 4; ++m) { const int row = row0 + ai * HALF + m * 16; const float r = rstd[row]; bf16_t* rowp = P + (size_t)row * 7168 + col0;
#pragma unroll
                    for (int bj = 0; bj < 2; ++bj) { const f32x4 v0 = acc[ai][bj][m][0] * r, v1 = acc[ai][bj][m][1] * r;
                        u32x4 w; w.x = cvt_pk_bf16(v0[0], v0[1]); w.y = cvt_pk_bf16(v0[2], v0[3]); w.z = cvt_pk_bf16(v1[0], v1[1]); w.w = cvt_pk_bf16(v1[2], v1[3]);
                        *(u32x4*)(rowp + bj * HALF) = w; } }
        } else if (wc == 0) {
#pragma unroll
            for (int ai = 0; ai < 2; ++ai)
#pragma unroll
                for (int m = 0; m < 4; ++m) { const int row = row0 + ai * HALF + m * 16; const float r = rstd[row]; float* p = Ps + (size_t)row * 32 + 8 * fq;
                    *(f32x4*)p = acc[ai][0][m][0] * r; *(f32x4*)(p + 4) = acc[ai][0][m][1] * r; }
        }
    }
};
struct EpiX {
    static constexpr bool PERM = true, AFTER_DRAIN = false;
    const float* xres; float* xout; bf16_t* xb; float* ssp;
    __device__ __forceinline__ void operator()(const f32x4 (&acc)[2][2][4][2], const Unit& u, int wr, int wc, int fr, int fq) const {
        const int row0 = u.pm * BM + wr * 64 + fr, col0 = u.pn * BM + wc * 32 + 8 * fq;
#pragma unroll
        for (int ai = 0; ai < 2; ++ai)
#pragma unroll
            for (int m = 0; m < 4; ++m) { const int row = row0 + ai * HALF + m * 16; float ss = 0.f;
#pragma unroll
                for (int bj = 0; bj < 2; ++bj) { const size_t off = (size_t)row * 2048 + col0 + bj * HALF;
                    const f32x4 r0 = *(const f32x4*)(xres + off), r1 = *(const f32x4*)(xres + off + 4);
                    const f32x4 v0 = acc[ai][bj][m][0] + r0, v1 = acc[ai][bj][m][1] + r1;
                    *(f32x4*)(xout + off) = v0; *(f32x4*)(xout + off + 4) = v1;
                    u32x4 w; w.x = cvt_pk_bf16(v0[0], v0[1]); w.y = cvt_pk_bf16(v0[2], v0[3]); w.z = cvt_pk_bf16(v1[0], v1[1]); w.w = cvt_pk_bf16(v1[2], v1[3]);
                    *(u32x4*)(xb + off) = w;
                    ss += (v0[0] * v0[0] + v0[1] * v0[1]) + (v0[2] * v0[2] + v0[3] * v0[3]) + (v1[0] * v1[0] + v1[1] * v1[1]) + (v1[2] * v1[2] + v1[3] * v1[3]); }
                ss += __shfl_xor(ss, 16); ss += __shfl_xor(ss, 32);
                if (fq == 0) ssp[(size_t)row * 32 + u.pn * 4 + wc] = ss; }
    }
};
struct EpiQ {
    static constexpr bool PERM = true, AFTER_DRAIN = false;
    bf16_t* Q; const float* ssp;
    __device__ __forceinline__ void operator()(const f32x4 (&acc)[2][2][4][2], const Unit& u, int wr, int wc, int fr, int fq) const {
        const int row0 = u.pm * BM + wr * 64 + fr, col0 = u.pn * BM + wc * 32 + 8 * fq;
#pragma unroll
        for (int ai = 0; ai < 2; ++ai)
#pragma unroll
            for (int m = 0; m < 4; ++m) { const int row = row0 + ai * HALF + m * 16;
                const f32x4* sp = (const f32x4*)(ssp + (size_t)row * 32 + 8 * fq); const f32x4 a = sp[0], b = sp[1];
                float s = ((a[0] + a[1]) + (a[2] + a[3])) + ((b[0] + b[1]) + (b[2] + b[3]));
                s += __shfl_xor(s, 16); s += __shfl_xor(s, 32);
                const float r = rsqrtf(s * (1.0f / 2048.0f) + 1e-6f); bf16_t* rowp = Q + (size_t)row * 2048 + col0;
#pragma unroll
                for (int bj = 0; bj < 2; ++bj) { const f32x4 v0 = acc[ai][bj][m][0] * r, v1 = acc[ai][bj][m][1] * r;
                    u32x4 w; w.x = cvt_pk_bf16(v0[0], v0[1]); w.y = cvt_pk_bf16(v0[2], v0[3]); w.z = cvt_pk_bf16(v1[0], v1[1]); w.w = cvt_pk_bf16(v1[2], v1[3]);
                    *(u32x4*)(rowp + bj * HALF) = w; } }
    }
};

template <class Epi, class Sched, bool ALIGN_EPI = false, bool SP2 = false>
__device__ __forceinline__ void gemm_phase(PG8_LAS unsigned char* lds, const Gemm g, const Sched& S, const Epi& E) {
    const int tid = fresh_tid(), wid = __builtin_amdgcn_readfirstlane(tid >> 6), lane = tid & 63, wr = wid >> 2, wc = wid & 3, fr = lane & 15, fq = lane >> 4;
    const int K = g.K, nt = K / BK;
    unsigned voffA[2], voffB[2];
#pragma unroll
    for (int i = 0; i < 2; ++i) { int R, C; stage_rc(tid * 16 + i * 8192, R, C); const int Rb = Epi::PERM ? ((R & ~31) + perm32(R & 31)) : R;
        voffA[i] = (unsigned)(R * K + C) * 2u; voffB[i] = (unsigned)(Rb * K + C) * 2u; }
    const size_t kstep = (size_t)(BK * 2);
    const size_t hstep = (size_t)HALF * K * 2;
    const size_t tstep = 2 * hstep;
    const unsigned ldsw = (unsigned)wid * 1024u;
    const int aoff = lds_byte(wr * 64 + fr, fq * 8), boff = lds_byte(wc * 32 + fr, fq * 8);
#define PG8_SA(b, h) (((b) * 2 + (h)) * HTB)
#define PG8_SB(b, h) ((4 + (b) * 2 + (h)) * HTB)
#define PG8_STAGE(bufoff, gbase, voff) do { _Pragma("unroll") for (int _i = 0; _i < 2; ++_i) \
        __builtin_amdgcn_global_load_lds((const unsigned*)((const char*)(gbase) + (voff)[_i]), (PG8_LAS unsigned*)(lds + (bufoff) + ldsw + _i * 8192), 16, 0, 0); } while (0)
#define PG8_LDA(dst, b, h) do { _Pragma("unroll") for (int m = 0; m < 4; ++m) _Pragma("unroll") for (int k = 0; k < 2; ++k) dst[m][k] = *(const PG8_LAS bf16x8*)(lds + PG8_SA(b, h) + aoff + m * 2048 + k * 1024); } while (0)
#define PG8_LDB(dst, b, h) do { _Pragma("unroll") for (int n = 0; n < 2; ++n) _Pragma("unroll") for (int k = 0; k < 2; ++k) dst[n][k] = *(const PG8_LAS bf16x8*)(lds + PG8_SB(b, h) + boff + n * 2048 + k * 1024); } while (0)
#define PG8_MMA(ai, bj, At, Bt) do { __builtin_amdgcn_s_setprio(1); _Pragma("unroll") for (int m = 0; m < 4; ++m) _Pragma("unroll") for (int n = 0; n < 2; ++n) _Pragma("unroll") for (int k = 0; k < 2; ++k) \
        acc[ai][bj][m][n] = __builtin_amdgcn_mfma_f32_16x16x32_bf16(Bt[n][k], At[m][k], acc[ai][bj][m][n], 0, 0, 0); __builtin_amdgcn_s_setprio(0); } while (0)
#define PG8_WAIT_V(n) asm volatile("s_waitcnt vmcnt(" #n ")" ::: "memory")
#define PG8_WAIT_L(n) asm volatile("s_waitcnt lgkmcnt(" #n ")" ::: "memory")
#define PG8_BAR __builtin_amdgcn_s_barrier()
#define PG8_SCHED __builtin_amdgcn_sched_barrier(0)
    Unit cur, nxt; int ui = 0;
    if (!S.next(0, cur)) return;
    f32x4 acc[2][2][4][2];
#pragma unroll
    for (int a = 0; a < 2; ++a)
#pragma unroll
        for (int b = 0; b < 2; ++b)
#pragma unroll
            for (int m = 0; m < 4; ++m)
#pragma unroll
                for (int n = 0; n < 2; ++n) acc[a][b][m][n] = (f32x4){0.f, 0.f, 0.f, 0.f};
    bf16x8 At[4][2], B0[2][2], B1[2][2];
    const char* cA = (const char*)g.A + (size_t)cur.pm * tstep; const char* cB = (const char*)g.Bt + (size_t)cur.pn * tstep;
    S.a_ready(cur);
    if constexpr (SP2) {
        PG8_STAGE(PG8_SB(0, 0), cB, voffB); PG8_STAGE(PG8_SB(0, 1), cB + hstep, voffB); PG8_STAGE(PG8_SA(0, 0), cA, voffA); PG8_STAGE(PG8_SA(0, 1), cA + hstep, voffA);
        if (wr == 1) PG8_BAR;
        PG8_WAIT_V(2); PG8_BAR;
        PG8_STAGE(PG8_SB(1, 0), cB + kstep, voffB); PG8_STAGE(PG8_SA(1, 0), cA + kstep, voffA); PG8_STAGE(PG8_SB(1, 1), cB + hstep + kstep, voffB);
        PG8_WAIT_V(6); PG8_BAR;
    } else {
        PG8_STAGE(PG8_SB(0, 0), cB, voffB); PG8_STAGE(PG8_SA(0, 0), cA, voffA); PG8_STAGE(PG8_SB(0, 1), cB + hstep, voffB); PG8_STAGE(PG8_SA(0, 1), cA + hstep, voffA);
        if (wr == 1) PG8_BAR;
        PG8_WAIT_V(4); PG8_BAR;
        PG8_STAGE(PG8_SB(1, 0), cB + kstep, voffB); PG8_STAGE(PG8_SA(1, 0), cA + kstep, voffA); PG8_STAGE(PG8_SB(1, 1), cB + hstep + kstep, voffB);
        PG8_WAIT_V(6); PG8_BAR;
    }
    for (;;) {
        const bool has_next = S.next(ui + 1, nxt);
        const char* nA = has_next ? (const char*)g.A + (size_t)nxt.pm * tstep : cA; const char* nB = has_next ? (const char*)g.Bt + (size_t)nxt.pn * tstep : cB;
        for (int t = 0; t < nt; t += 2) {
            const bool last = (t == nt - 2);
            const char* a1 = cA + (size_t)(t + 1) * kstep;
            const char* a2 = last ? nA : cA + (size_t)(t + 2) * kstep; const char* b2 = last ? nB : cB + (size_t)(t + 2) * kstep;
            const char* a3 = a2 + kstep; const char* b3 = b2 + kstep;
            if (last && has_next) S.a_ready(nxt);
            if constexpr (SP2) {
            PG8_LDB(B0, 0, 0); PG8_LDB(B1, 0, 1); PG8_SCHED; PG8_LDA(At, 0, 0); PG8_STAGE(PG8_SA(1, 1), a1 + hstep, voffA);
            PG8_WAIT_V(8); PG8_WAIT_L(0); PG8_BAR; PG8_MMA(0, 0, At, B0); PG8_MMA(0, 1, At, B1); PG8_BAR; PG8_SCHED;
            PG8_LDA(At, 0, 1); PG8_STAGE(PG8_SB(0, 0), b2, voffB); PG8_STAGE(PG8_SB(0, 1), b2 + hstep, voffB); PG8_STAGE(PG8_SA(0, 0), a2, voffA);
            PG8_WAIT_V(8); PG8_WAIT_L(0); PG8_BAR; PG8_MMA(1, 0, At, B0); PG8_MMA(1, 1, At, B1); PG8_BAR; PG8_SCHED;
            PG8_LDB(B0, 1, 0); PG8_LDB(B1, 1, 1); PG8_SCHED; PG8_LDA(At, 1, 0); PG8_STAGE(PG8_SA(0, 1), a2 + hstep, voffA);
            PG8_WAIT_V(8); PG8_WAIT_L(0); PG8_BAR; PG8_MMA(0, 0, At, B0); PG8_MMA(0, 1, At, B1); PG8_BAR; PG8_SCHED;
            PG8_LDA(At, 1, 1); PG8_STAGE(PG8_SB(1, 0), b3, voffB); PG8_STAGE(PG8_SB(1, 1), b3 + hstep, voffB); PG8_STAGE(PG8_SA(1, 0), a3, voffA);
            PG8_WAIT_V(8); PG8_WAIT_L(0); PG8_BAR; PG8_MMA(1, 0, At, B0); PG8_MMA(1, 1, At, B1); PG8_BAR; PG8_SCHED;
            } else {
            PG8_LDB(B0, 0, 0); PG8_SCHED; PG8_LDA(At, 0, 0); PG8_STAGE(PG8_SA(1, 1), a1 + hstep, voffA);
            PG8_WAIT_L(8); PG8_BAR; PG8_WAIT_L(0); PG8_MMA(0, 0, At, B0); PG8_BAR; PG8_SCHED;
            PG8_LDB(B1, 0, 1); PG8_STAGE(PG8_SB(0, 0), b2, voffB);
            PG8_BAR; PG8_WAIT_L(0); PG8_MMA(0, 1, At, B1); PG8_BAR;
            PG8_LDA(At, 0, 1); PG8_STAGE(PG8_SA(0, 0), a2, voffA);
            PG8_BAR; PG8_WAIT_L(0); PG8_MMA(1, 0, At, B0); PG8_BAR; PG8_SCHED;
            PG8_STAGE(PG8_SB(0, 1), b2 + hstep, voffB);
            PG8_WAIT_V(6); PG8_BAR; PG8_MMA(1, 1, At, B1); PG8_BAR;
            PG8_LDB(B0, 1, 0); PG8_SCHED; PG8_LDA(At, 1, 0); PG8_STAGE(PG8_SA(0, 1), a2 + hstep, voffA);
            PG8_WAIT_L(8); PG8_BAR; PG8_WAIT_L(0); PG8_MMA(0, 0, At, B0); PG8_BAR; PG8_SCHED;
            PG8_LDB(B1, 1, 1); PG8_STAGE(PG8_SB(1, 0), b3, voffB);
            PG8_BAR; PG8_WAIT_L(0); PG8_MMA(0, 1, At, B1); PG8_BAR;
            PG8_LDA(At, 1, 1); PG8_STAGE(PG8_SA(1, 0), a3, voffA);
            PG8_BAR; PG8_WAIT_L(0); PG8_MMA(1, 0, At, B0); PG8_BAR; PG8_SCHED;
            PG8_STAGE(PG8_SB(1, 1), b3 + hstep, voffB);
            PG8_WAIT_V(6); PG8_BAR; PG8_MMA(1, 1, At, B1); PG8_BAR;
            }
        }
        if constexpr (ALIGN_EPI) { if (wr == 0) PG8_BAR; }
        if constexpr (!Epi::AFTER_DRAIN) { E(acc, cur, wr, wc, fr, fq); S.done(cur); }
        if (!has_next) break;
#pragma unroll
        for (int a = 0; a < 2; ++a)
#pragma unroll
            for (int b = 0; b < 2; ++b)
#pragma unroll
                for (int m = 0; m < 4; ++m)
#pragma unroll
                    for (int n = 0; n < 2; ++n) acc[a][b][m][n] = (f32x4){0.f, 0.f, 0.f, 0.f};
        cur = nxt; cA = nA; cB = nB; ++ui;
        if constexpr (ALIGN_EPI) { if (wr == 1) PG8_BAR; }
    }
    PG8_WAIT_V(0);
    if constexpr (!ALIGN_EPI) { if (wr == 0) PG8_BAR; }
    PG8_BAR;
    if constexpr (Epi::AFTER_DRAIN) { E.fused(acc, cur, wr, wc, fr, fq, lds, wid, lane); S.done(cur); }
#undef PG8_SA
#undef PG8_SB
#undef PG8_STAGE
#undef PG8_LDA
#undef PG8_LDB
#undef PG8_MMA
#undef PG8_WAIT_V
#undef PG8_WAIT_L
#undef PG8_BAR
#undef PG8_SCHED
}
}

constexpr int NWAVES = 8, NTHREADS = 512;
constexpr int NT = 8192, DM = 2048, SEQ = 2048, NBATCH = 4, DEPTH = 2, CHK = 64, NCHK = 32, GW = 512, NH = 4, HD = 128;
constexpr int DIN = 7200, NINP = 7424, PBW = 7168;
constexpr int NEXP = 16384;
constexpr int PC_GLA_Q = 0, PC_GLA_K = 512, PC_GLA_V = 1024, PC_GLA_G = 1536, PC_LRU_X = 2048, PC_LRU_Y = 2560, PC_ML_Q = 3072, PC_ML_K = 3584, PC_ML_V = 4096, PC_ML_O = 4608,
              PC_GDN_Q = 5120, PC_GDN_K = 5632, PC_GDN_V = 6144, PC_GDN_G = 6656;
constexpr int PS_LR = 0, PS_MI = 16, PS_MF = 20, PS_GB = 24, PS_GA = 28;
constexpr float RMS_EPS = 1e-6f;
enum { I_X = 0, I_N1G, I_WIN, I_WOUT, I_GLA_W2, I_GLA_B2, I_GLA_NG, I_LRU_CW, I_LRU_CB, I_LRU_WA, I_LRU_BA, I_LRU_WX, I_LRU_BX, I_LRU_LAM, I_ML_IB, I_ML_FB, I_ML_NG,
       I_GDN_CW, I_GDN_ALOG, I_GDN_DTB, I_GDN_NG, I_N2G, I_PWQ, I_PK1, I_PK2, I_PU, I_PV, I_FNG, N_IN };

constexpr size_t MiB = 1u << 20;
constexpr size_t WS_CTL = 0, CTL_ZERO_BYTES = 1 * MiB;
constexpr size_t WS_WIN = 2 * MiB;
constexpr size_t WIN_L = (size_t)NINP * DM * 2;
constexpr size_t WS_WOUT = 60 * MiB;
constexpr size_t WS_WQ = 76 * MiB;
constexpr size_t WSQ_L = (size_t)DM * DM * 2;
constexpr size_t WS_K1 = 92 * MiB, WS_K2 = 92 * MiB + 512 * 1024;
constexpr size_t WS_RSTD1 = 93 * MiB;
constexpr size_t WS_SSP = 94 * MiB;
constexpr size_t WS_XB = 96 * MiB;
constexpr size_t WS_P = 128 * MiB;
constexpr size_t WS_PS = 240 * MiB;
constexpr size_t WS_MIX = 242 * MiB;
constexpr size_t WS_Q = 274 * MiB;
constexpr size_t WS_UB = 306 * MiB;
constexpr size_t WS_VB = 434 * MiB;
constexpr size_t TAB_L = (size_t)NEXP * DM * 2;
constexpr size_t WS_SCR = 562 * MiB;
constexpr size_t WS_END = 900 * MiB;

constexpr int LDS_BYTES = 155648;
constexpr int MISC_OFF = LDS_BYTES - 256;

#define GAS __attribute__((address_space(1)))
#define LAS __attribute__((address_space(3)))
typedef unsigned short bf16;
typedef unsigned v4u __attribute__((ext_vector_type(4)));
typedef unsigned v2u __attribute__((ext_vector_type(2)));
typedef float f32x4 __attribute__((ext_vector_type(4)));
typedef float f32x2 __attribute__((ext_vector_type(2)));
typedef short bf16x8 __attribute__((ext_vector_type(8)));
typedef short bf16x4 __attribute__((ext_vector_type(4)));
typedef __bf16 bf2_t __attribute__((ext_vector_type(2)));
typedef GAS unsigned gu32;
#define RLX_AGENT __ATOMIC_RELAXED, __HIP_MEMORY_SCOPE_AGENT
__device__ __forceinline__ unsigned f2bf(float f) { unsigned u = __builtin_bit_cast(unsigned, f); return (u + 0x7fffu + ((u >> 16) & 1u)) >> 16; }
__device__ __forceinline__ unsigned pk2(float lo, float hi) { return f2bf(lo) | (f2bf(hi) << 16); }
__device__ __forceinline__ float bf2f(unsigned b) { return __builtin_bit_cast(float, b << 16); }
__device__ __forceinline__ float bflo(unsigned w) { return __builtin_bit_cast(float, w << 16); }
__device__ __forceinline__ float bfhi(unsigned w) { return __builtin_bit_cast(float, w & 0xffff0000u); }
template <int CTRL> __device__ __forceinline__ unsigned dpp_rot_u(unsigned v) { return (unsigned)__builtin_amdgcn_update_dpp(0, (int)v, CTRL, 0xf, 0xf, false); }
__device__ __forceinline__ unsigned row_max_u(unsigned v) { v = max(v, dpp_rot_u<0x121>(v)); v = max(v, dpp_rot_u<0x122>(v)); v = max(v, dpp_rot_u<0x124>(v)); v = max(v, dpp_rot_u<0x128>(v)); return v; }
template <int CTRL> __device__ __forceinline__ float dpp_rotf(float v) { const unsigned u = __builtin_bit_cast(unsigned, v); return __builtin_bit_cast(float, dpp_rot_u<CTRL>(u)); }
__device__ __forceinline__ float row_max_f(float v) { v = fmaxf(v, dpp_rotf<0x121>(v)); v = fmaxf(v, dpp_rotf<0x122>(v)); v = fmaxf(v, dpp_rotf<0x124>(v)); v = fmaxf(v, dpp_rotf<0x128>(v)); return v; }
__device__ __forceinline__ float row_sum_f(float v) { v += dpp_rotf<0x121>(v); v += dpp_rotf<0x122>(v); v += dpp_rotf<0x124>(v); v += dpp_rotf<0x128>(v); return v; }

__device__ __forceinline__ float oct_sum_f(float v) { v += dpp_rotf<0xB1>(v); v += dpp_rotf<0x4E>(v); v += dpp_rotf<0x141>(v); return v; }
__device__ __forceinline__ float lane_bcast(float v, int l) { return __builtin_bit_cast(float, __builtin_amdgcn_readlane(__builtin_bit_cast(int, v), l)); }
__device__ __forceinline__ float wave_sum(float v) { const float r = row_sum_f(v); return (lane_bcast(r, 0) + lane_bcast(r, 16)) + (lane_bcast(r, 32) + lane_bcast(r, 48)); }
__device__ __forceinline__ float wave_max(float v) { const float r = row_max_f(v); return fmaxf(fmaxf(lane_bcast(r, 0), lane_bcast(r, 16)), fmaxf(lane_bcast(r, 32), lane_bcast(r, 48))); }
__device__ __forceinline__ float rcpf_(float x) { return __builtin_amdgcn_rcpf(x); }
__device__ __forceinline__ float sigmoidf_(float x) { return rcpf_(1.0f + __expf(-x)); }
__device__ __forceinline__ float siluf_(float x) { return x * rcpf_(1.0f + __expf(-x)); }
__device__ __forceinline__ float softplusf_(float x) { return fmaxf(x, 0.f) + __logf(1.0f + __expf(-fabsf(x))); }
__device__ __forceinline__ float logsigmoidf_(float x) { return fminf(x, 0.f) - __logf(1.0f + __expf(-fabsf(x))); }
__device__ __forceinline__ float gelu_tanh(float x) { const float u = 1.5957691216057308f * (x + 0.044715f * x * x * x); return x * rcpf_(1.0f + __expf(-u)); }

#define XB_TMO      128
#define XB_XCNT(j)  (256  + 64 * (j))
#define XB_XSUB(j)  (1280 + 64 * (j))
#define XB_XGEN(j)  (2304 + 64 * (j))
#define XB_TOP      3328
#define XB_TOPGEN   3392
#define XCD_BAR_WORDS 3456
#define XB_SPIN_CAP (1u << 18)

__device__ __forceinline__ unsigned xb_ld(unsigned* p)              { return __hip_atomic_load(p, __ATOMIC_RELAXED, __HIP_MEMORY_SCOPE_AGENT); }
__device__ __forceinline__ unsigned xb_add(unsigned* p, unsigned v) { return __hip_atomic_fetch_add(p, v, __ATOMIC_RELAXED, __HIP_MEMORY_SCOPE_AGENT); }
__device__ __forceinline__ unsigned xb_xcc_id() { return (unsigned)__builtin_amdgcn_s_getreg((3 << 11) | 20) & 0xFu; }
#define XB_SPIN(cond, bar) do { unsigned _sp = 0; while (cond) { __builtin_amdgcn_s_sleep(1); \
    if ((++_sp & 255u) == 0u) { if (xb_ld(&(bar)[XB_TMO])) break; if (_sp > XB_SPIN_CAP) { atomicAdd(&(bar)[XB_TMO], 1u); break; } } } } while (0)

struct XcdBarrier {
    unsigned* bar; unsigned x;
    volatile LAS unsigned* st;
};

__device__ __forceinline__ XcdBarrier xcd_barrier_post(unsigned* bar, volatile LAS unsigned* st) {
    XcdBarrier b; b.bar = bar; b.x = xb_xcc_id(); b.st = st;
    if (threadIdx.x == 0) (void)xb_add(&bar[XB_XCNT(b.x)], 1u);
    return b;
}
__device__ __forceinline__ void xcd_barrier_complete(unsigned* bar, unsigned x, unsigned& nloc, unsigned& nx) {
    const unsigned G = gridDim.x * gridDim.y * gridDim.z;
    unsigned sum, cnt, mine, sp = 0u;
    for (;;) {
        sum = 0u; cnt = 0u; mine = 0u;
#pragma unroll
        for (unsigned j = 0; j < 16; ++j) { const unsigned c = xb_ld(&bar[XB_XCNT(j)]); sum += c; cnt += (c > 0u) ? 1u : 0u; mine = (j == x) ? c : mine; }
        if (sum == G) break;
        __builtin_amdgcn_s_sleep(1);
        if ((++sp & 255u) == 0u) { if (xb_ld(&bar[XB_TMO])) break; if (sp > XB_SPIN_CAP) { atomicAdd(&bar[XB_TMO], 1u); break; } }
    }
    nloc = mine > 0u ? mine : 1u; nx = cnt > 0u ? cnt : 1u;
}

__device__ __forceinline__ void xcd_barrier(const XcdBarrier& b) {
    asm volatile("s_waitcnt vmcnt(0)" ::: "memory");
    __syncthreads();
    if (threadIdx.x == 0) {
        unsigned* bar = b.bar; asm volatile("" : "+s"(bar));
        __builtin_amdgcn_s_waitcnt(0);
        unsigned nloc = b.st[0], nx = b.st[1];
        if (nloc == 0u) { xcd_barrier_complete(bar, b.x, nloc, nx); b.st[0] = nloc; b.st[1] = nx; }
        const unsigned old = xb_add(&bar[XB_XSUB(b.x)], 1u);
        const unsigned gen = old / nloc;
        if (old + 1u == (gen + 1u) * nloc) {
            __builtin_amdgcn_fence(__ATOMIC_RELEASE, "agent");
            asm volatile("s_waitcnt vmcnt(0)" ::: "memory");
            const unsigned og = xb_add(&bar[XB_TOP], 1u);
            const unsigned tg = og / nx;
            if (og + 1u == (tg + 1u) * nx) xb_add(&bar[XB_TOPGEN], 1u);
            else XB_SPIN(xb_ld(&bar[XB_TOPGEN]) == tg, bar);
            __builtin_amdgcn_fence(__ATOMIC_ACQUIRE, "agent");
            xb_add(&bar[XB_XGEN(b.x)], 1u);
            asm volatile("s_waitcnt vmcnt(0)" ::: "memory");
        } else {
            XB_SPIN(xb_ld(&bar[XB_XGEN(b.x)]) == gen, bar);
            __builtin_amdgcn_fence(__ATOMIC_ACQUIRE, "agent");
            asm volatile("s_waitcnt vmcnt(0)" ::: "memory");
        }
    }
    __syncthreads();
}


struct Args { const float* in[N_IN]; float* out; unsigned char* ws; int ph_lo, ph_hi, li, pad; };
typedef const __attribute__((address_space(4))) Args& ArgsR;
__device__ __forceinline__ const __attribute__((address_space(4))) Args* kargs() { unsigned long long p = (unsigned long long)__builtin_amdgcn_kernarg_segment_ptr(); asm volatile("" : "+s"(p)); return (const __attribute__((address_space(4))) Args*)p; }

__device__ __forceinline__ int win_src_col(int n) {
    if (n < 2048) return n;
    if (n < 3072) return 2064 + (n - 2048);
    if (n < 5120) return 3088 + (n - 3072);
    if (n < 7168) return 5144 + (n - 5120);
    if (n < 7184) return 2048 + (n - 7168);
    if (n < 7192) return 5136 + (n - 7184);
    if (n < 7200) return n;
    return -1;
}
template <bool MAP>
__device__ __forceinline__ void p0_transpose_item(const float* W, int K, int Nsrc, int Ndst, const float* gain, bf16* WT, LAS float* scr, int item, int lane) {
    const int nblk = Ndst / 32, kb = item / nblk, nb = item % nblk, k0 = 64 * kb, n0 = 32 * nb;
    const int nn = n0 + (lane & 31); const int src = MAP ? win_src_col(nn) : nn;
    float tv[32];
#pragma unroll
    for (int i = 0; i < 32; ++i) { const int kk = 2 * i + (lane >> 5); tv[i] = (src >= 0) ? W[(size_t)(k0 + kk) * Nsrc + src] : 0.f; }
#pragma unroll
    for (int i = 0; i < 32; ++i) { const int kk = 2 * i + (lane >> 5); float v = tv[i]; if (gain) v *= gain[k0 + kk]; scr[kk * 33 + (lane & 31)] = v; }
    asm volatile("s_waitcnt lgkmcnt(0)" ::: "memory");
    const int c = lane & 7;
#pragma unroll
    for (int j = 0; j < 4; ++j) { const int n = (lane >> 3) + 8 * j; const LAS float* s = scr + (8 * c) * 33 + n;
        v4u o; o.x = pk2(s[0 * 33], s[1 * 33]); o.y = pk2(s[2 * 33], s[3 * 33]); o.z = pk2(s[4 * 33], s[5 * 33]); o.w = pk2(s[6 * 33], s[7 * 33]);
        *(GAS v4u*)(WT + (size_t)(n0 + n) * K + k0 + 8 * c) = o; }
    asm volatile("s_waitcnt lgkmcnt(0)" ::: "memory");
}
__device__ __forceinline__ void p0_convert(const float* src, bf16* dst, size_t n, size_t gtid, size_t gthreads) {
    for (size_t i = gtid * 8; i < n; i += gthreads * 8) {
        const f32x4 a = *(const GAS f32x4*)(src + i), b = *(const GAS f32x4*)(src + i + 4);
        v4u o; o.x = pk2(a[0], a[1]); o.y = pk2(a[2], a[3]); o.z = pk2(b[0], b[1]); o.w = pk2(b[2], b[3]);
        *(GAS v4u*)(dst + i) = o; }
}
__device__ __forceinline__ void p0_prologue(ArgsR A, LAS unsigned char* lds, int vcu, int G, int wave, int lane) {
    unsigned char* ws = A.ws;
    LAS float* scr = (LAS float*)(lds + wave * 16384);
    const int gw = vcu * NWAVES + wave, NGW = G * NWAVES;
    constexpr int I_IN = (DM / 64) * (NINP / 32), I_SQ = (DM / 64) * (DM / 32), I_LAYER = I_IN + 2 * I_SQ, NITEMS = DEPTH * I_LAYER;
    for (int it = gw; it < NITEMS; it += NGW) {
        const int l = it / I_LAYER; int r = it % I_LAYER;
        if (r < I_IN) { p0_transpose_item<true>(A.in[I_WIN] + (size_t)l * DM * DIN, DM, DIN, NINP, A.in[I_N1G] + l * DM, (bf16*)(ws + WS_WIN + l * WIN_L), scr, r, lane); continue; } r -= I_IN;
        if (r < I_SQ) { p0_transpose_item<false>(A.in[I_WOUT] + (size_t)l * DM * DM, DM, DM, DM, nullptr, (bf16*)(ws + WS_WOUT + l * WSQ_L), scr, r, lane); continue; } r -= I_SQ;
        p0_transpose_item<false>(A.in[I_PWQ] + (size_t)l * DM * DM, DM, DM, DM, A.in[I_N2G] + l * DM, (bf16*)(ws + WS_WQ + l * WSQ_L), scr, r, lane);
    }
    const size_t gtid = (size_t)gw * 64 + lane, gthreads = (size_t)NGW * 64;
    p0_convert(A.in[I_PK1], (bf16*)(ws + WS_K1), (size_t)DEPTH * 8 * 128 * 128, gtid, gthreads);
    p0_convert(A.in[I_PK2], (bf16*)(ws + WS_K2), (size_t)DEPTH * 8 * 128 * 128, gtid, gthreads);
    const float* x = A.in[I_X]; bf16* xb = (bf16*)(ws + WS_XB); float* rstd1 = (float*)(ws + WS_RSTD1);
    for (int m = gw; m < NT; m += NGW) {
        const GAS f32x4* xr = (const GAS f32x4*)(x + (size_t)m * DM) + lane;
        f32x4 v[8]; float s = 0.f;
#pragma unroll
        for (int j = 0; j < 8; ++j) { v[j] = xr[64 * j]; s += (v[j][0] * v[j][0] + v[j][1] * v[j][1]) + (v[j][2] * v[j][2] + v[j][3] * v[j][3]); }
        s = wave_sum(s);
        GAS v2u* o = (GAS v2u*)(xb + (size_t)m * DM) + lane;
#pragma unroll
        for (int j = 0; j < 8; ++j) { v2u w; w.x = pk2(v[j][0], v[j][1]); w.y = pk2(v[j][2], v[j][3]); o[64 * j] = w; }
        if (lane == 0) rstd1[m] = rsqrtf(s * (1.0f / DM) + RMS_EPS);
    }
}

constexpr size_t WS_GLA_INC = 562 * MiB;
constexpr size_t WS_GLA_DEC = 594 * MiB;
constexpr size_t WS_GLA_ST = 595 * MiB;
constexpr size_t WS_ML_INC = 611 * MiB;
constexpr size_t WS_ML_N = 643 * MiB;
constexpr size_t WS_ML_SC = 643 * MiB + 512 * 1024;
constexpr size_t WS_ML_ST = 644 * MiB;
constexpr size_t WS_ML_NP = 660 * MiB;
constexpr size_t WS_ML_MP = 660 * MiB + 512 * 1024;
constexpr size_t WS_GDN_U0 = 661 * MiB, WS_GDN_W = 669 * MiB, WS_GDN_QD = 677 * MiB, WS_GDN_KE = 685 * MiB;
constexpr size_t WS_GDN_QK = 693 * MiB;
constexpr size_t WS_GDN_DE = 697 * MiB;
constexpr size_t WS_GDN_O = 698 * MiB;
constexpr size_t WS_LRU_HL = 714 * MiB, WS_LRU_AP = 730 * MiB;
constexpr size_t WS_LRU_CARRY = 746 * MiB;
static_assert(WS_LRU_CARRY + 4 * 32 * 512 * 4 <= WS_END, "ws map");

constexpr int CW_PBAR = 2048;
typedef short v4i16_t __attribute__((ext_vector_type(4)));
constexpr int LD128 = 136, LD64 = 72;

__device__ __forceinline__ bf16x8 frag_rd(const LAS bf16* t, int ld, int row0, int k0, int lane) { return *(const LAS bf16x8*)(t + (row0 + (lane & 15)) * ld + k0 + 8 * (lane >> 4)); }
__device__ __forceinline__ bf16x8 frag_rd_perm(const LAS bf16* t, int ld, int row0, int k0, int lane) {
    const LAS bf16* p = t + (row0 + (lane & 15)) * ld + k0 + 4 * (lane >> 4);
    const bf16x4 a = *(const LAS bf16x4*)p, b = *(const LAS bf16x4*)(p + 16);
    return (bf16x8){a[0], a[1], a[2], a[3], b[0], b[1], b[2], b[3]};
}
__device__ __forceinline__ bf16x8 frag_tr(const LAS bf16* t, int ld, int k0, int n0, int lane) {
    const int i = lane & 15, g = lane >> 4; const LAS bf16* p = t + (k0 + 8 * g + (i >> 2)) * ld + n0 + 4 * (i & 3);
    const v4i16_t a = __builtin_amdgcn_ds_read_tr16_b64_v4i16((LAS v4i16_t*)p), b = __builtin_amdgcn_ds_read_tr16_b64_v4i16((LAS v4i16_t*)(p + 4 * ld));
    return (bf16x8){a[0], a[1], a[2], a[3], b[0], b[1], b[2], b[3]};
}
__device__ __forceinline__ bf16x8 frag_tr_perm(const LAS bf16* t, int ld, int k0, int n0, int lane) {
    const int i = lane & 15, g = lane >> 4; const LAS bf16* p = t + (k0 + 4 * g + (i >> 2)) * ld + n0 + 4 * (i & 3);
    const v4i16_t a = __builtin_amdgcn_ds_read_tr16_b64_v4i16((LAS v4i16_t*)p), b = __builtin_amdgcn_ds_read_tr16_b64_v4i16((LAS v4i16_t*)(p + 16 * ld));
    return (bf16x8){a[0], a[1], a[2], a[3], b[0], b[1], b[2], b[3]};
}
__device__ __forceinline__ bf16x8 pack_acc(const f32x4& lo, const f32x4& hi) {
    v4u w; w.x = pg8::cvt_pk_bf16(lo[0], lo[1]); w.y = pg8::cvt_pk_bf16(lo[2], lo[3]); w.z = pg8::cvt_pk_bf16(hi[0], hi[1]); w.w = pg8::cvt_pk_bf16(hi[2], hi[3]);
    return __builtin_bit_cast(bf16x8, w);
}
#define MFMA16(a, b, c) __builtin_amdgcn_mfma_f32_16x16x32_bf16((a), (b), (c), 0, 0, 0)

template <int ROWS>
__device__ __forceinline__ void tile_g2l_128(const bf16* g, size_t gld, LAS bf16* t, int tid) {
#pragma unroll
    for (int i = 0; i < ROWS * 16 / NTHREADS; ++i) { const int idx = tid + i * NTHREADS, r = idx >> 4, c8 = (idx & 15) * 8;
        *(LAS v4u*)(t + r * LD128 + c8) = *(const GAS v4u*)(g + (size_t)r * gld + c8); }
}
template <int CTRL> __device__ __forceinline__ float dpp_shr_f(float v, float ident) { return __builtin_bit_cast(float, __builtin_amdgcn_update_dpp(__builtin_bit_cast(int, ident), __builtin_bit_cast(int, v), CTRL, 0xf, 0xf, false)); }
__device__ __forceinline__ float wave_scan_add(float v, int lane) {
    v += dpp_shr_f<0x111>(v, 0.f); v += dpp_shr_f<0x112>(v, 0.f); v += dpp_shr_f<0x114>(v, 0.f); v += dpp_shr_f<0x118>(v, 0.f);
    const float t0 = lane_bcast(v, 15), t1 = lane_bcast(v, 31), t2 = lane_bcast(v, 47); const int row = lane >> 4;
    return v + (row == 0 ? 0.f : row == 1 ? t0 : row == 2 ? t0 + t1 : (t0 + t1) + t2);
}
__device__ __forceinline__ float wave_scan_max(float v, int lane) {
    const float ninf = -__builtin_inff();
    v = fmaxf(v, dpp_shr_f<0x111>(v, ninf)); v = fmaxf(v, dpp_shr_f<0x112>(v, ninf)); v = fmaxf(v, dpp_shr_f<0x114>(v, ninf)); v = fmaxf(v, dpp_shr_f<0x118>(v, ninf));
    const float t0 = lane_bcast(v, 15), t1 = lane_bcast(v, 31), t2 = lane_bcast(v, 47); const int row = lane >> 4;
    return fmaxf(v, row == 0 ? ninf : row == 1 ? t0 : row == 2 ? fmaxf(t0, t1) : fmaxf(fmaxf(t0, t1), t2));
}

__device__ __forceinline__ void f_lru_p2(ArgsR A, int l, int item, LAS unsigned char* lds, int tid) {
    const int j = item & 7, n = (item >> 3) & 31, b = item >> 8;
    const bf16* P = (const bf16*)(A.ws + WS_P); float* HLg = (float*)(A.ws + WS_LRU_HL); float* APg = (float*)(A.ws + WS_LRU_AP);
    LAS float* xc = (LAS float*)(lds); LAS float* was = (LAS float*)(lds + 20480); LAS float* wxs = (LAS float*)(lds + 36864);
    LAS float* aa = (LAS float*)(lds + 53248); LAS float* uu = (LAS float*)(lds + 69632); LAS float* segA = (LAS float*)(lds + 86016); LAS float* segH = (LAS float*)(lds + 88064);
    const float* wa = A.in[I_LRU_WA] + ((size_t)l * 8 + j) * 4096; const float* wx = A.in[I_LRU_WX] + ((size_t)l * 8 + j) * 4096;
    for (int i = tid; i < 4096; i += NTHREADS) { was[i] = wa[i]; wxs[i] = wx[i]; }
    const float* cw = A.in[I_LRU_CW] + (size_t)l * 4 * GW; const float* cb = A.in[I_LRU_CB] + l * GW;
    const float* ba = A.in[I_LRU_BA] + l * GW + j * 64; const float* bx = A.in[I_LRU_BX] + l * GW + j * 64; const float* lam = A.in[I_LRU_LAM] + l * GW + j * 64;
    const size_t r0 = (size_t)b * SEQ + n * CHK;
    float ba8[8], bx8[8], lam8[8];
#pragma unroll
    for (int q = 0; q < 8; ++q) { ba8[q] = ba[(tid & 7) * 8 + q]; bx8[q] = bx[(tid & 7) * 8 + q]; lam8[q] = lam[(tid & 7) * 8 + q]; }
    { const int cc = tid & 63, c0 = (tid >> 6) * 8, ch = j * 64 + cc, pc = PC_LRU_X + ch; const long t0 = (long)n * CHK + c0;
        const float w0 = cw[ch], w1 = cw[GW + ch], w2 = cw[2 * GW + ch], w3 = cw[3 * GW + ch], bias = cb[ch];
        float xm3 = (t0 - 3 >= 0) ? bf2f(P[(r0 + c0 - 3) * PBW + pc]) : 0.f, xm2 = (t0 - 2 >= 0) ? bf2f(P[(r0 + c0 - 2) * PBW + pc]) : 0.f, xm1 = (t0 - 1 >= 0) ? bf2f(P[(r0 + c0 - 1) * PBW + pc]) : 0.f;
#pragma unroll
        for (int i = 0; i < 8; ++i) { const float x0 = bf2f(P[(r0 + c0 + i) * PBW + pc]); xc[(c0 + i) * 65 + cc] = w0 * xm3 + w1 * xm2 + w2 * xm1 + w3 * x0 + bias; xm3 = xm2; xm2 = xm1; xm1 = x0; } }
    __syncthreads();
    { const int tok = tid >> 3, cg = tid & 7; float ra[8], ri[8], spl[8];
#pragma unroll
        for (int q = 0; q < 8; ++q) { ra[q] = ba8[q]; ri[q] = bx8[q]; spl[q] = softplusf_(-lam8[q]); }
#pragma unroll 4
        for (int i = 0; i < 64; ++i) { const float xv = xc[tok * 65 + i];
            const f32x4 a0 = *(const LAS f32x4*)(was + i * 64 + cg * 8), a1 = *(const LAS f32x4*)(was + i * 64 + cg * 8 + 4);
            const f32x4 x0 = *(const LAS f32x4*)(wxs + i * 64 + cg * 8), x1 = *(const LAS f32x4*)(wxs + i * 64 + cg * 8 + 4);
#pragma unroll
            for (int q = 0; q < 4; ++q) { ra[q] += xv * a0[q]; ra[4 + q] += xv * a1[q]; ri[q] += xv * x0[q]; ri[4 + q] += xv * x1[q]; } }
#pragma unroll
        for (int q = 0; q < 8; ++q) { const int jj = cg * 8 + q; const float r = sigmoidf_(ra[q]), ig = sigmoidf_(ri[q]);
            const float log_a = -8.0f * r * spl[q]; const float a = __expf(log_a), u = sqrtf(fmaxf(1.0f - a * a, 0.f)) * (ig * xc[tok * 65 + jj]);
            aa[tok * 64 + jj] = a; uu[tok * 64 + jj] = u; } }
    __syncthreads();
    const int cc = tid & 63, seg = tid >> 6;
    { float Ap = 1.f, Hl = 0.f;
#pragma unroll
        for (int i = 0; i < 8; ++i) { const int c = seg * 8 + i; const float a = aa[c * 64 + cc], u = uu[c * 64 + cc]; Hl = a * Hl + u; Ap *= a; aa[c * 64 + cc] = Ap; uu[c * 64 + cc] = Hl; }
        segA[seg * 64 + cc] = Ap; segH[seg * 64 + cc] = Hl; }
    __syncthreads();
    { float Ac = 1.f, Hc = 0.f;
#pragma unroll 1
        for (int s = 0; s < seg; ++s) { const float sa = segA[s * 64 + cc]; Hc = sa * Hc + segH[s * 64 + cc]; Ac *= sa; }
#pragma unroll
        for (int i = 0; i < 8; ++i) { const int c = seg * 8 + i; const float ap = aa[c * 64 + cc], hl = uu[c * 64 + cc];
            HLg[(r0 + c) * GW + j * 64 + cc] = ap * Hc + hl; APg[(r0 + c) * GW + j * 64 + cc] = ap * Ac; } }
    __syncthreads();
}
__device__ __forceinline__ void f_lru_p3(ArgsR A, int b, int tid) {
    const float* HLg = (const float*)(A.ws + WS_LRU_HL); const float* APg = (const float*)(A.ws + WS_LRU_AP); float* carry = (float*)(A.ws + WS_LRU_CARRY);
    float c = 0.f;
#pragma unroll 8
    for (int n = 0; n < NCHK; ++n) { carry[((size_t)b * NCHK + n) * GW + tid] = c; const size_t t = (size_t)b * SEQ + n * CHK + 63; c = APg[t * GW + tid] * c + HLg[t * GW + tid]; }
}
__device__ __forceinline__ void f_lru_p4(ArgsR A, int item, int tid) {
    const bf16* P = (const bf16*)(A.ws + WS_P); bf16* mix = (bf16*)(A.ws + WS_MIX);
    const float* HLg = (const float*)(A.ws + WS_LRU_HL); const float* APg = (const float*)(A.ws + WS_LRU_AP); const float* carry = (const float*)(A.ws + WS_LRU_CARRY);
    const float cr = carry[(size_t)item * GW + tid]; const size_t r0 = (size_t)item * CHK;
#pragma unroll 8
    for (int c = 0; c < CHK; ++c) { const float h = APg[(r0 + c) * GW + tid] * cr + HLg[(r0 + c) * GW + tid]; const float y = bf2f(P[(r0 + c) * PBW + PC_LRU_Y + tid]);
        mix[(r0 + c) * DM + 512 + tid] = (bf16)f2bf(gelu_tanh(y) * h); }
}

constexpr int FL_Q = 0, FL_K = 17408, FL_V = 34816, FL_ST = 52224, FL_SC = 87040, FL_BC = 96256, FL_LR = 129024, FL_SEG = 133120, FL_RS = 135168;
struct GlaW2 { float w[16]; float b2; };
__device__ __forceinline__ void gla_w2_load(ArgsR A, int l, int h, int tid, GlaW2& W) {
    const int d = tid & 127; const float* w2 = A.in[I_GLA_W2] + (size_t)l * 16 * GW + h * HD + d;
#pragma unroll
    for (int r = 0; r < 16; ++r) W.w[r] = w2[r * GW];
    W.b2 = A.in[I_GLA_B2][l * GW + h * HD + d];
}
__device__ __forceinline__ void gla_bcum(const GlaW2& W, LAS float* bc, LAS float* segt, const LAS float* lrs, int tid) {
    const int d = tid & 127, seg = tid >> 7; float run = 0.f;
#pragma unroll 4
    for (int i = 0; i < 16; ++i) { const int c = seg * 16 + i; float z = W.b2;
#pragma unroll
        for (int r = 0; r < 16; ++r) z += lrs[c * 16 + r] * W.w[r];
        run += logsigmoidf_(z) * (1.0f / 16.0f); bc[c * 128 + d] = run; }
    segt[seg * 128 + d] = run;
}
__device__ __forceinline__ void f_gla_p2(ArgsR A, int l, int item, LAS unsigned char* lds, int tid) {
    const int n = item & 31, h = (item >> 5) & 3, b = item >> 7; const int lane = tid & 63, wave = __builtin_amdgcn_readfirstlane(tid >> 6);
    const bf16* P = (const bf16*)(A.ws + WS_P); const float* Ps = (const float*)(A.ws + WS_PS);
    float* inc = (float*)(A.ws + WS_GLA_INC) + (size_t)item * 16384; float* dec = (float*)(A.ws + WS_GLA_DEC) + (size_t)item * 128;
    LAS bf16* ks = (LAS bf16*)(lds + FL_K); LAS bf16* vs = (LAS bf16*)(lds + FL_V); LAS float* bc = (LAS float*)(lds + FL_BC); LAS float* lrs = (LAS float*)(lds + FL_LR); LAS float* segt = (LAS float*)(lds + FL_SEG);
    const size_t r0 = (size_t)b * SEQ + n * CHK;
    GlaW2 W2; gla_w2_load(A, l, h, tid, W2);
    tile_g2l_128<64>(P + r0 * PBW + PC_GLA_K + h * HD, PBW, ks, tid);
    tile_g2l_128<64>(P + r0 * PBW + PC_GLA_V + h * HD, PBW, vs, tid);
    for (int i = tid; i < 64 * 16; i += NTHREADS) lrs[i] = Ps[(r0 + (i >> 4)) * 32 + PS_LR + (i & 15)];
    __syncthreads();
    gla_bcum(W2, bc, segt, lrs, tid);
    __syncthreads();
    { const int d = tid & 127, seg = tid >> 7; float pre = 0.f, tot = 0.f;
#pragma unroll
        for (int s = 0; s < 4; ++s) { const float v = segt[s * 128 + d]; if (s < seg) pre += v; tot += v; }
#pragma unroll 4
        for (int i = 0; i < 16; ++i) { const int c = seg * 16 + i; const float bcm = bc[c * 128 + d] + pre; ks[c * LD128 + d] = (bf16)f2bf(bf2f(ks[c * LD128 + d]) * __expf(tot - bcm)); }
        if (seg == 0) dec[d] = __expf(tot); }
    __syncthreads();
    { f32x4 acc[8];
#pragma unroll
        for (int nt = 0; nt < 8; ++nt) acc[nt] = (f32x4){0.f, 0.f, 0.f, 0.f};
#pragma unroll
        for (int kk = 0; kk < 2; ++kk) { const bf16x8 af = frag_tr(vs, LD128, 32 * kk, 16 * wave, lane);
#pragma unroll
            for (int nt = 0; nt < 8; ++nt) acc[nt] = MFMA16(af, frag_tr(ks, LD128, 32 * kk, 16 * nt, lane), acc[nt]); }
        const int fr = lane & 15, fq = lane >> 4;
#pragma unroll
        for (int nt = 0; nt < 8; ++nt)
#pragma unroll
            for (int r = 0; r < 4; ++r) inc[(16 * wave + 4 * fq + r) * 128 + 16 * nt + fr] = acc[nt][r]; }
    __syncthreads();
}
__device__ __forceinline__ void f_gla_p3(ArgsR A, int item, int tid) {
    const int bh = item >> 4, sl = item & 15; const int e = sl * 1024 + tid * 2, d = e & 127;
    const float* inc = (const float*)(A.ws + WS_GLA_INC) + (size_t)bh * 32 * 16384 + e; const float* dec = (const float*)(A.ws + WS_GLA_DEC) + (size_t)bh * 32 * 128 + d;
    bf16* st = (bf16*)(A.ws + WS_GLA_ST) + (size_t)bh * 32 * 16384 + e;
    float s0 = 0.f, s1 = 0.f;
#pragma unroll 8
    for (int n = 0; n < NCHK; ++n) { *(GAS unsigned*)(st + (size_t)n * 16384) = pk2(s0, s1);
        const f32x2 iv = *(const GAS f32x2*)(inc + (size_t)n * 16384), dv = *(const GAS f32x2*)(dec + (size_t)n * 128); s0 = dv[0] * s0 + iv[0]; s1 = dv[1] * s1 + iv[1]; }
}
__device__ __forceinline__ void f_gla_p4(ArgsR A, int l, int item, LAS unsigned char* lds, int tid) {
    const int n = item & 31, h = (item >> 5) & 3, b = item >> 7; const int lane = tid & 63, wave = __builtin_amdgcn_readfirstlane(tid >> 6), fr = lane & 15, fq = lane >> 4;
    const bf16* P = (const bf16*)(A.ws + WS_P); const float* Ps = (const float*)(A.ws + WS_PS); bf16* mix = (bf16*)(A.ws + WS_MIX);
    const bf16* stg = (const bf16*)(A.ws + WS_GLA_ST) + (size_t)item * 16384;
    LAS bf16* qs = (LAS bf16*)(lds + FL_Q); LAS bf16* ks = (LAS bf16*)(lds + FL_K); LAS bf16* vs = (LAS bf16*)(lds + FL_V); LAS bf16* sts = (LAS bf16*)(lds + FL_ST); LAS bf16* scs = (LAS bf16*)(lds + FL_SC);
    LAS float* bc = (LAS float*)(lds + FL_BC); LAS float* lrs = (LAS float*)(lds + FL_LR); LAS float* segt = (LAS float*)(lds + FL_SEG); LAS float* rsp = (LAS float*)(lds + FL_RS);
    const size_t r0 = (size_t)b * SEQ + n * CHK;
    GlaW2 W2; gla_w2_load(A, l, h, tid, W2);
    const float gn = A.in[I_GLA_NG][l * GW + h * HD + 16 * wave + fr];
    float gt[4][4];
#pragma unroll
    for (int mt = 0; mt < 4; ++mt)
#pragma unroll
        for (int r = 0; r < 4; ++r) gt[mt][r] = bf2f(P[(r0 + 16 * mt + 4 * fq + r) * PBW + PC_GLA_G + h * HD + 16 * wave + fr]);
    tile_g2l_128<64>(P + r0 * PBW + PC_GLA_Q + h * HD, PBW, qs, tid);
    tile_g2l_128<64>(P + r0 * PBW + PC_GLA_K + h * HD, PBW, ks, tid);
    tile_g2l_128<64>(P + r0 * PBW + PC_GLA_V + h * HD, PBW, vs, tid);
    tile_g2l_128<128>(stg, 128, sts, tid);
    for (int i = tid; i < 64 * 16; i += NTHREADS) lrs[i] = Ps[(r0 + (i >> 4)) * 32 + PS_LR + (i & 15)];
    __syncthreads();
    gla_bcum(W2, bc, segt, lrs, tid);
    __syncthreads();
    { const int d = tid & 127, seg = tid >> 7; float pre = 0.f;
#pragma unroll
        for (int s = 0; s < 4; ++s) { const float v = segt[s * 128 + d]; if (s < seg) pre += v; }
#pragma unroll 4
        for (int i = 0; i < 16; ++i) { const int c = seg * 16 + i; const float bcm = bc[c * 128 + d] + pre;
            qs[c * LD128 + d] = (bf16)f2bf(bf2f(qs[c * LD128 + d]) * __expf(bcm) * 0.08838834764831845f); ks[c * LD128 + d] = (bf16)f2bf(bf2f(ks[c * LD128 + d]) * __expf(-bcm)); } }
    __syncthreads();
    { const int mt = wave >> 1; f32x4 acc[2] = {{0.f, 0.f, 0.f, 0.f}, {0.f, 0.f, 0.f, 0.f}};
#pragma unroll
        for (int kk = 0; kk < 4; ++kk) { const bf16x8 af = frag_rd(qs, LD128, 16 * mt, 32 * kk, lane);
#pragma unroll
            for (int q = 0; q < 2; ++q) acc[q] = MFMA16(af, frag_rd(ks, LD128, 16 * (2 * (wave & 1) + q), 32 * kk, lane), acc[q]); }
#pragma unroll
        for (int q = 0; q < 2; ++q) { const int s = 16 * (2 * (wave & 1) + q) + fr;
#pragma unroll
            for (int r = 0; r < 4; ++r) { const int c = 16 * mt + 4 * fq + r; scs[c * LD64 + s] = (bf16)f2bf(s <= c ? acc[q][r] : 0.f); } } }
    __syncthreads();
    f32x4 o[4];
#pragma unroll
    for (int mt = 0; mt < 4; ++mt) o[mt] = (f32x4){0.f, 0.f, 0.f, 0.f};
#pragma unroll
    for (int kk = 0; kk < 2; ++kk) { const bf16x8 bfv = frag_tr(vs, LD128, 32 * kk, 16 * wave, lane);
#pragma unroll
        for (int mt = 0; mt < 4; ++mt) o[mt] = MFMA16(frag_rd(scs, LD64, 16 * mt, 32 * kk, lane), bfv, o[mt]); }
#pragma unroll
    for (int kk = 0; kk < 4; ++kk) { const bf16x8 bfs = frag_rd(sts, LD128, 16 * wave, 32 * kk, lane);
#pragma unroll
        for (int mt = 0; mt < 4; ++mt) o[mt] = MFMA16(frag_rd(qs, LD128, 16 * mt, 32 * kk, lane), bfs, o[mt]); }
#pragma unroll
    for (int mt = 0; mt < 4; ++mt)
#pragma unroll
        for (int r = 0; r < 4; ++r) { float s = o[mt][r] * o[mt][r]; s = row_sum_f(s);
            if (fr == 0) rsp[wave * 64 + 16 * mt + 4 * fq + r] = s; }
    __syncthreads();
#pragma unroll
    for (int mt = 0; mt < 4; ++mt)
#pragma unroll
        for (int r = 0; r < 4; ++r) { const int c = 16 * mt + 4 * fq + r; float ss = 0.f;
#pragma unroll
            for (int w = 0; w < 8; ++w) ss += rsp[w * 64 + c];
            const float rs = rsqrtf(ss * (1.0f / 128.0f) + RMS_EPS);
            mix[(r0 + c) * DM + h * HD + 16 * wave + fr] = (bf16)f2bf(o[mt][r] * rs * gn * siluf_(gt[mt][r])); }
    __syncthreads();
}

constexpr int FM_Q2 = 96256, FM_S = 129024;
__device__ __forceinline__ void f_ml_p2(ArgsR A, int l, int item, LAS unsigned char* lds, int tid) {
    const int n = item & 31, h = (item >> 5) & 3, b = item >> 7; const int lane = tid & 63, wave = __builtin_amdgcn_readfirstlane(tid >> 6);
    const bf16* P = (const bf16*)(A.ws + WS_P); const float* Ps = (const float*)(A.ws + WS_PS);
    float* inc = (float*)(A.ws + WS_ML_INC) + (size_t)item * 16384; float* incn = (float*)(A.ws + WS_ML_N) + (size_t)item * 128; float* scg = (float*)(A.ws + WS_ML_SC) + (size_t)item * 2;
    LAS bf16* ks = (LAS bf16*)(lds + FL_K); LAS bf16* vs = (LAS bf16*)(lds + FL_V); LAS float* sc = (LAS float*)(lds + FM_S);
    const size_t r0 = (size_t)b * SEQ + n * CHK;
    tile_g2l_128<64>(P + r0 * PBW + PC_ML_K + h * HD, PBW, ks, tid);
    tile_g2l_128<64>(P + r0 * PBW + PC_ML_V + h * HD, PBW, vs, tid);
    if (wave == 0) { const float lf = logsigmoidf_(Ps[(r0 + lane) * 32 + PS_MF + h] + A.in[I_ML_FB][l * NH + h]), ig = Ps[(r0 + lane) * 32 + PS_MI + h] + A.in[I_ML_IB][l * NH + h];
        const float bcum = wave_scan_add(lf, lane), blast = lane_bcast(bcum, 63), le = blast - bcum + ig, mloc = wave_max(le);
        sc[lane] = __expf(le - mloc) * 0.08838834764831845f; if (lane == 0) { scg[0] = mloc; scg[1] = blast; } }
    __syncthreads();
#pragma unroll
    for (int i = 0; i < 2; ++i) { const int idx = tid + i * NTHREADS, r = idx >> 4, c8 = (idx & 15) * 8; const float w = sc[r];
        v4u x = *(LAS v4u*)(ks + r * LD128 + c8);
        x.x = pk2(bflo(x.x) * w, bfhi(x.x) * w); x.y = pk2(bflo(x.y) * w, bfhi(x.y) * w); x.z = pk2(bflo(x.z) * w, bfhi(x.z) * w); x.w = pk2(bflo(x.w) * w, bfhi(x.w) * w);
        *(LAS v4u*)(ks + r * LD128 + c8) = x; }
    __syncthreads();
    if (tid < 128) { float s = 0.f;
#pragma unroll 8
        for (int c = 0; c < 64; ++c) s += bf2f(ks[c * LD128 + tid]);
        incn[tid] = s; }
    { f32x4 acc[8];
#pragma unroll
        for (int nt = 0; nt < 8; ++nt) acc[nt] = (f32x4){0.f, 0.f, 0.f, 0.f};
#pragma unroll
        for (int kk = 0; kk < 2; ++kk) { const bf16x8 af = frag_tr(vs, LD128, 32 * kk, 16 * wave, lane);
#pragma unroll
            for (int nt = 0; nt < 8; ++nt) acc[nt] = MFMA16(af, frag_tr(ks, LD128, 32 * kk, 16 * nt, lane), acc[nt]); }
        const int fr = lane & 15, fq = lane >> 4;
#pragma unroll
        for (int nt = 0; nt < 8; ++nt)
#pragma unroll
            for (int r = 0; r < 4; ++r) inc[(16 * wave + 4 * fq + r) * 128 + 16 * nt + fr] = acc[nt][r]; }
    __syncthreads();
}
__device__ __forceinline__ void f_ml_p3(ArgsR A, int item, int tid) {
    const int bh = item >> 4, sl = item & 15; const int e = sl * 1024 + tid * 2;
    const float* inc = (const float*)(A.ws + WS_ML_INC) + (size_t)bh * 32 * 16384 + e; const float* incn = (const float*)(A.ws + WS_ML_N) + (size_t)bh * 32 * 128;
    const float* scg = (const float*)(A.ws + WS_ML_SC) + (size_t)bh * 32 * 2;
    bf16* st = (bf16*)(A.ws + WS_ML_ST) + (size_t)bh * 32 * 16384 + e; float* np = (float*)(A.ws + WS_ML_NP) + (size_t)bh * 32 * 128; float* mp = (float*)(A.ws + WS_ML_MP) + (size_t)bh * 32;
    float c0 = 0.f, c1 = 0.f, nv = 0.f, m = 0.f; const int dn = sl * 8 + tid;
#pragma unroll 4
    for (int n = 0; n < NCHK; ++n) {
        *(GAS unsigned*)(st + (size_t)n * 16384) = pk2(c0, c1);
        if (tid < 8) np[n * 128 + dn] = nv;
        if (sl == 0 && tid == 0) mp[n] = m;
        const float ml = scg[2 * n], bl = scg[2 * n + 1]; const float mn = fmaxf(bl + m, ml), ao = __expf(bl + m - mn), ai = __expf(ml - mn);
        const f32x2 iv = *(const GAS f32x2*)(inc + (size_t)n * 16384); c0 = ao * c0 + ai * iv[0]; c1 = ao * c1 + ai * iv[1];
        if (tid < 8) nv = ao * nv + ai * incn[n * 128 + dn];
        m = mn; }
}
__device__ __forceinline__ void f_ml_p4(ArgsR A, int l, int item, LAS unsigned char* lds, int tid) {
    const int n = item & 31, h = (item >> 5) & 3, b = item >> 7; const int lane = tid & 63, wave = __builtin_amdgcn_readfirstlane(tid >> 6), fr = lane & 15, fq = lane >> 4;
    const bf16* P = (const bf16*)(A.ws + WS_P); const float* Ps = (const float*)(A.ws + WS_PS); bf16* mix = (bf16*)(A.ws + WS_MIX);
    const bf16* stg = (const bf16*)(A.ws + WS_ML_ST) + (size_t)item * 16384; const float* npg = (const float*)(A.ws + WS_ML_NP) + (size_t)item * 128; const float mprev = ((const float*)(A.ws + WS_ML_MP))[item];
    LAS bf16* qs = (LAS bf16*)(lds + FL_Q); LAS bf16* ks = (LAS bf16*)(lds + FL_K); LAS bf16* vs = (LAS bf16*)(lds + FL_V); LAS bf16* sts = (LAS bf16*)(lds + FL_ST); LAS bf16* scs = (LAS bf16*)(lds + FL_SC);
    LAS bf16* q2 = (LAS bf16*)(lds + FM_Q2); LAS float* sc = (LAS float*)(lds + FM_S); LAS float* rsp = (LAS float*)(lds + FL_RS + 4096);
    const size_t r0 = (size_t)b * SEQ + n * CHK;
    const float gn = A.in[I_ML_NG][l * GW + h * HD + 16 * wave + fr];
    float ogt[4][4];
#pragma unroll
    for (int mt = 0; mt < 4; ++mt)
#pragma unroll
        for (int r = 0; r < 4; ++r) ogt[mt][r] = bf2f(P[(r0 + 16 * mt + 4 * fq + r) * PBW + PC_ML_O + h * HD + 16 * wave + fr]);
    tile_g2l_128<64>(P + r0 * PBW + PC_ML_Q + h * HD, PBW, qs, tid);
    tile_g2l_128<64>(P + r0 * PBW + PC_ML_K + h * HD, PBW, ks, tid);
    tile_g2l_128<64>(P + r0 * PBW + PC_ML_V + h * HD, PBW, vs, tid);
    tile_g2l_128<128>(stg, 128, sts, tid);
    if (wave == 0) { const float lf = logsigmoidf_(Ps[(r0 + lane) * 32 + PS_MF + h] + A.in[I_ML_FB][l * NH + h]), ig = Ps[(r0 + lane) * 32 + PS_MI + h] + A.in[I_ML_IB][l * NH + h];
        const float bcum = wave_scan_add(lf, lane), as = ig - bcum, pm = wave_scan_max(as, lane);
        const float mintra = bcum + pm, minter = bcum + mprev, mt = fmaxf(mintra, minter);
        sc[lane] = bcum - mt; sc[64 + lane] = as; sc[128 + lane] = __expf(minter - mt); sc[192 + lane] = __expf(-mt); }
    if (wave == 1) { sc[320 + lane] = npg[lane]; sc[384 + lane] = npg[64 + lane]; }
    __syncthreads();
#pragma unroll
    for (int i = 0; i < 2; ++i) { const int idx = tid + i * NTHREADS, r = idx >> 4, c8 = (idx & 15) * 8; const float w = sc[128 + r];
        v4u x = *(LAS v4u*)(qs + r * LD128 + c8);
        x.x = pk2(bflo(x.x) * w, bfhi(x.x) * w); x.y = pk2(bflo(x.y) * w, bfhi(x.y) * w); x.z = pk2(bflo(x.z) * w, bfhi(x.z) * w); x.w = pk2(bflo(x.w) * w, bfhi(x.w) * w);
        *(LAS v4u*)(q2 + r * LD128 + c8) = x; }
    { const int mt = wave >> 1; f32x4 acc[2] = {{0.f, 0.f, 0.f, 0.f}, {0.f, 0.f, 0.f, 0.f}};
#pragma unroll
        for (int kk = 0; kk < 4; ++kk) { const bf16x8 af = frag_rd(qs, LD128, 16 * mt, 32 * kk, lane);
#pragma unroll
            for (int q = 0; q < 2; ++q) acc[q] = MFMA16(af, frag_rd(ks, LD128, 16 * (2 * (wave & 1) + q), 32 * kk, lane), acc[q]); }
#pragma unroll
        for (int q = 0; q < 2; ++q) { const int s = 16 * (2 * (wave & 1) + q) + fr; const float asv = sc[64 + s];
#pragma unroll
            for (int r = 0; r < 4; ++r) { const int c = 16 * mt + 4 * fq + r; scs[c * LD64 + s] = (bf16)f2bf(s <= c ? acc[q][r] * 0.08838834764831845f * __expf(sc[c] + asv) : 0.f); } } }
    __syncthreads();
    { const int c = tid >> 3, part = tid & 7; float s = 0.f;
#pragma unroll
        for (int i = 0; i < 8; ++i) s += bf2f(scs[c * LD64 + part * 8 + i]);
#pragma unroll
        for (int i = 0; i < 16; ++i) s += bf2f(q2[c * LD128 + part * 16 + i]) * sc[320 + part * 16 + i];
        s = oct_sum_f(s);
        if (part == 0) sc[256 + c] = fmaxf(fabsf(s), sc[192 + c]); }
    f32x4 o[4];
#pragma unroll
    for (int mt = 0; mt < 4; ++mt) o[mt] = (f32x4){0.f, 0.f, 0.f, 0.f};
#pragma unroll
    for (int kk = 0; kk < 2; ++kk) { const bf16x8 bfv = frag_tr(vs, LD128, 32 * kk, 16 * wave, lane);
#pragma unroll
        for (int mt = 0; mt < 4; ++mt) o[mt] = MFMA16(frag_rd(scs, LD64, 16 * mt, 32 * kk, lane), bfv, o[mt]); }
#pragma unroll
    for (int kk = 0; kk < 4; ++kk) { const bf16x8 bfs = frag_rd(sts, LD128, 16 * wave, 32 * kk, lane);
#pragma unroll
        for (int mt = 0; mt < 4; ++mt) o[mt] = MFMA16(frag_rd(q2, LD128, 16 * mt, 32 * kk, lane), bfs, o[mt]); }
    __syncthreads();
#pragma unroll
    for (int mt = 0; mt < 4; ++mt)
#pragma unroll
        for (int r = 0; r < 4; ++r) { const int c = 16 * mt + 4 * fq + r;
            const float hv = o[mt][r] * rcpf_(sc[256 + c]) * sigmoidf_(ogt[mt][r]); o[mt][r] = hv;
            float s = hv * hv; s = row_sum_f(s);
            if (fr == 0) rsp[wave * 64 + c] = s; }
    __syncthreads();
#pragma unroll
    for (int mt = 0; mt < 4; ++mt)
#pragma unroll
        for (int r = 0; r < 4; ++r) { const int c = 16 * mt + 4 * fq + r; float ss = 0.f;
#pragma unroll
            for (int w = 0; w < 8; ++w) ss += rsp[w * 64 + c];
            mix[(r0 + c) * DM + 1024 + h * HD + 16 * wave + fr] = (bf16)f2bf(o[mt][r] * rsqrtf(ss * (1.0f / 128.0f) + RMS_EPS) * gn); }
    __syncthreads();
}

constexpr int FG_LM = 52224, FG_S = 129024, FG_RAW = 68608, FG_RAWT = 9216  ;
template <int C> struct GdnSolve {
    static __device__ __forceinline__ void run(float (&sol)[64], const LAS float* Lm) {
        if constexpr (C < 64) {
            float a0 = sol[C], a1 = 0.f, a2 = 0.f, a3 = 0.f;
#pragma unroll
            for (int s = 0; s < C; ++s) { const float t = Lm[C * 64 + s] * sol[s]; if ((s & 3) == 0) a0 -= t; else if ((s & 3) == 1) a1 -= t; else if ((s & 3) == 2) a2 -= t; else a3 -= t; }
            sol[C] = (a0 + a1) + (a2 + a3);
            GdnSolve<C + 1>::run(sol, Lm);
        }
    }
};
__device__ __forceinline__ void f_gdn_p2(ArgsR A, int l, int item, LAS unsigned char* lds, int tid) {
    const int n = item & 31, h = (item >> 5) & 3, b = item >> 7; const int lane = tid & 63, wave = __builtin_amdgcn_readfirstlane(tid >> 6), fr = lane & 15, fq = lane >> 4;
    const bf16* P = (const bf16*)(A.ws + WS_P); const float* Ps = (const float*)(A.ws + WS_PS);
    bf16* U0 = (bf16*)(A.ws + WS_GDN_U0) + (size_t)item * 8192; bf16* Wg = (bf16*)(A.ws + WS_GDN_W) + (size_t)item * 8192; bf16* QD = (bf16*)(A.ws + WS_GDN_QD) + (size_t)item * 8192;
    bf16* KE = (bf16*)(A.ws + WS_GDN_KE) + (size_t)item * 8192; bf16* QK = (bf16*)(A.ws + WS_GDN_QK) + (size_t)item * 4096; float* DE = (float*)(A.ws + WS_GDN_DE);
    LAS bf16* qs = (LAS bf16*)(lds + FL_Q); LAS bf16* ks = (LAS bf16*)(lds + FL_K); LAS bf16* vs = (LAS bf16*)(lds + FL_V); LAS float* Lm = (LAS float*)(lds + FG_LM); LAS float* sc = (LAS float*)(lds + FG_S);
    const float* cw = A.in[I_GDN_CW] + (size_t)l * 4 * 1536;
    const size_t r0 = (size_t)b * SEQ + n * CHK;
    float cwv[3][4];
#pragma unroll
    for (int part = 0; part < 3; ++part)
#pragma unroll
        for (int k = 0; k < 4; ++k) cwv[part][k] = cw[k * 1536 + part * 512 + h * HD + (tid & 127)];
    if (wave == 0) { const float bt = sigmoidf_(Ps[(r0 + lane) * 32 + PS_GB + h]);
        const float g = -__expf(A.in[I_GDN_ALOG][l * NH + h]) * softplusf_(Ps[(r0 + lane) * 32 + PS_GA + h] + A.in[I_GDN_DTB][l * NH + h]);
        const float gam = wave_scan_add(g, lane); sc[lane] = bt; sc[64 + lane] = gam; if (lane == 63) DE[item] = __expf(gam); }
    { LAS bf16* raw = (LAS bf16*)(lds + FG_RAW);
#pragma unroll
        for (int i = 0; i < 7; ++i) { const int idx = tid + i * NTHREADS; if (idx < 3 * 67 * 16) { const int part = idx / (67 * 16), pi = idx % (67 * 16), rr = pi >> 4, c8 = (pi & 15) * 8;
            const int pc = (part == 0 ? PC_GDN_Q : part == 1 ? PC_GDN_K : PC_GDN_V) + h * HD + c8; v4u w = {0u, 0u, 0u, 0u};
            if (n > 0 || rr >= 3) w = *(const GAS v4u*)(P + (r0 + rr - 3) * PBW + pc);
            *(LAS v4u*)(raw + part * FG_RAWT + rr * LD128 + c8) = w; } }
        __syncthreads();
        const int v = tid & 127, dq = tid >> 7;
#pragma unroll
        for (int part = 0; part < 3; ++part) {
            const float w0 = cwv[part][0], w1 = cwv[part][1], w2 = cwv[part][2], w3 = cwv[part][3];
            LAS bf16* dst = part == 0 ? qs : part == 1 ? ks : vs; const LAS bf16* src = raw + part * FG_RAWT + v;
            const int c0 = dq * 16;
            float xm3 = bf2f(src[(c0 + 0) * LD128]), xm2 = bf2f(src[(c0 + 1) * LD128]), xm1 = bf2f(src[(c0 + 2) * LD128]);
#pragma unroll
            for (int i = 0; i < 16; ++i) { const float x0 = bf2f(src[(c0 + i + 3) * LD128]); const float y = w0 * xm3 + w1 * xm2 + w2 * xm1 + w3 * x0;
                dst[(c0 + i) * LD128 + v] = (bf16)f2bf(siluf_(y)); xm3 = xm2; xm2 = xm1; xm1 = x0; } } }
    __syncthreads();
#pragma unroll 1
    for (int rr = 0; rr < 8; ++rr) { const int c = wave * 8 + rr;
        const float q1 = bf2f(qs[c * LD128 + lane]), q2 = bf2f(qs[c * LD128 + 64 + lane]), k1 = bf2f(ks[c * LD128 + lane]), k2 = bf2f(ks[c * LD128 + 64 + lane]);
        const float sq = wave_sum(q1 * q1 + q2 * q2), sk = wave_sum(k1 * k1 + k2 * k2);
        if (lane == 0) { sc[128 + c] = rsqrtf(sq + 1e-6f) * 0.08838834764831845f; sc[192 + c] = rsqrtf(sk + 1e-6f); } }
    __syncthreads();
    { const int mt = wave >> 1; f32x4 akk[2] = {{0.f, 0.f, 0.f, 0.f}, {0.f, 0.f, 0.f, 0.f}}, aqk[2] = {{0.f, 0.f, 0.f, 0.f}, {0.f, 0.f, 0.f, 0.f}};
#pragma unroll
        for (int kk = 0; kk < 4; ++kk) { const bf16x8 ak = frag_rd(ks, LD128, 16 * mt, 32 * kk, lane), aq = frag_rd(qs, LD128, 16 * mt, 32 * kk, lane);
#pragma unroll
            for (int q = 0; q < 2; ++q) { const bf16x8 bk = frag_rd(ks, LD128, 16 * (2 * (wave & 1) + q), 32 * kk, lane); akk[q] = MFMA16(ak, bk, akk[q]); aqk[q] = MFMA16(aq, bk, aqk[q]); } }
#pragma unroll
        for (int q = 0; q < 2; ++q) { const int s = 16 * (2 * (wave & 1) + q) + fr; const float rks = sc[192 + s], gs = sc[64 + s];
#pragma unroll
            for (int r = 0; r < 4; ++r) { const int c = 16 * mt + 4 * fq + r; const float dcy = __expf(sc[64 + c] - gs);
                Lm[c * 64 + s] = (s < c) ? sc[c] * akk[q][r] * sc[192 + c] * rks * dcy : 0.f;
                QK[c * 64 + s] = (bf16)f2bf((s <= c) ? aqk[q][r] * sc[128 + c] * rks * dcy : 0.f); } } }
    __syncthreads();
    if (tid < 256) {
        float sol[64]; const bool isw = tid >= 128; const int j = tid & 127;
        const LAS float* LmO = Lm; asm volatile("" : "+v"(LmO));
#pragma unroll
        for (int c = 0; c < 64; ++c) { const float bt = sc[c]; sol[c] = isw ? bf2f(ks[c * LD128 + j]) * sc[192 + c] * bt * __expf(sc[64 + c]) : bf2f(vs[c * LD128 + j]) * bt; }
        GdnSolve<1>::run(sol, LmO);
        bf16* dst = isw ? Wg : U0;
#pragma unroll
        for (int c = 0; c < 64; ++c) dst[c * 128 + j] = (bf16)f2bf(sol[c]);
    } else {
        const int t2 = tid - 256; const float glast = sc[64 + 63];
#pragma unroll
        for (int i = 0; i < 8; ++i) { const int idx = t2 + i * 256, which = idx >> 10, pi = idx & 1023, r = pi >> 4, c8 = (pi & 15) * 8;
            const float w = which == 0 ? sc[128 + r] * __expf(sc[64 + r]) : sc[192 + r] * __expf(glast - sc[64 + r]);
            v4u x = *(LAS v4u*)((which == 0 ? qs : ks) + r * LD128 + c8);
            x.x = pk2(bflo(x.x) * w, bfhi(x.x) * w); x.y = pk2(bflo(x.y) * w, bfhi(x.y) * w); x.z = pk2(bflo(x.z) * w, bfhi(x.z) * w); x.w = pk2(bflo(x.w) * w, bfhi(x.w) * w);
            *(GAS v4u*)((which == 0 ? QD : KE) + r * 128 + c8) = x; }
    }
    __syncthreads();
}

constexpr int FC_W = 0, FC_QD = 17408, FC_KE = 34816, FC_U0 = 52224, FC_QK = 69632, FC_RS = 78848  ;
__device__ __forceinline__ void f_gdn_p3(ArgsR A, int l, int bh, LAS unsigned char* lds, int tid) {
    const int lane = tid & 63, wave = __builtin_amdgcn_readfirstlane(tid >> 6), fr = lane & 15, fq = lane >> 4; const int b = bh >> 2, h = bh & 3;
    const bf16* U0 = (const bf16*)(A.ws + WS_GDN_U0) + (size_t)bh * 32 * 8192; const bf16* Wg = (const bf16*)(A.ws + WS_GDN_W) + (size_t)bh * 32 * 8192; const bf16* QD = (const bf16*)(A.ws + WS_GDN_QD) + (size_t)bh * 32 * 8192;
    const bf16* KE = (const bf16*)(A.ws + WS_GDN_KE) + (size_t)bh * 32 * 8192; const bf16* QK = (const bf16*)(A.ws + WS_GDN_QK) + (size_t)bh * 32 * 4096; const float* DE = (const float*)(A.ws + WS_GDN_DE) + bh * 32;
    const bf16* P = (const bf16*)(A.ws + WS_P); bf16* mix = (bf16*)(A.ws + WS_MIX); LAS float* rsp = (LAS float*)(lds + FC_RS);
    const float gn = A.in[I_GDN_NG][l * GW + h * HD + 16 * wave + fr];
    LAS bf16* ws_ = (LAS bf16*)(lds + FC_W); LAS bf16* qds = (LAS bf16*)(lds + FC_QD); LAS bf16* kes = (LAS bf16*)(lds + FC_KE); LAS bf16* u0s = (LAS bf16*)(lds + FC_U0); LAS bf16* qks = (LAS bf16*)(lds + FC_QK);
    f32x4 S[8];
#pragma unroll
    for (int i = 0; i < 8; ++i) S[i] = (f32x4){0.f, 0.f, 0.f, 0.f};
    v4u st[9];
    auto issue = [&](int n) {
#pragma unroll
        for (int i = 0; i < 8; ++i) { const int idx = tid + i * NTHREADS, which = idx >> 10, pi = idx & 1023;
            const bf16* src = (which == 0 ? Wg : which == 1 ? QD : which == 2 ? KE : U0) + (size_t)n * 8192; st[i] = *(const GAS v4u*)(src + pi * 8); }
        st[8] = *(const GAS v4u*)(QK + (size_t)n * 4096 + tid * 8);
    };
    auto commit = [&]() {
#pragma unroll
        for (int i = 0; i < 8; ++i) { const int idx = tid + i * NTHREADS, which = idx >> 10, pi = idx & 1023, r = pi >> 4, c8 = (pi & 15) * 8;
            *(LAS v4u*)((LAS bf16*)(lds + which * 17408) + r * LD128 + c8) = st[i]; }
        { const int r = tid >> 3, c8 = (tid & 7) * 8; *(LAS v4u*)(qks + r * LD64 + c8) = st[8]; }
    };
    const float dev = DE[lane & 31];
    issue(0);
    f32x4 op[4]; float gp[4][4];
#pragma unroll
    for (int mt = 0; mt < 4; ++mt) { op[mt] = (f32x4){0.f, 0.f, 0.f, 0.f};
#pragma unroll
        for (int r = 0; r < 4; ++r) gp[mt][r] = 0.f; }
#define CH_FINAL(nn) { LAS float* rs_ = rsp + ((nn) & 1) * 512; const size_t rp_ = (size_t)b * SEQ + (nn) * CHK; \
        _Pragma("unroll") for (int mt = 0; mt < 4; ++mt) _Pragma("unroll") for (int r = 0; r < 4; ++r) { const int c = 16 * mt + 4 * fq + r; float ss = 0.f; \
            _Pragma("unroll") for (int w = 0; w < 8; ++w) ss += rs_[w * 64 + c]; \
            mix[(rp_ + c) * DM + 1536 + h * HD + 16 * wave + fr] = (bf16)f2bf(op[mt][r] * rsqrtf(ss * (1.0f / 128.0f) + RMS_EPS) * gn * siluf_(gp[mt][r])); } }
#pragma unroll 1
    for (int n = 0; n < NCHK; ++n) {
        __syncthreads();
        if (n > 0) CH_FINAL(n - 1);
        commit();
        __syncthreads();
        if (n + 1 < NCHK) issue(n + 1);
        const float de = lane_bcast(dev, n);
        const size_t r0 = (size_t)b * SEQ + n * CHK;
#pragma unroll
        for (int mt = 0; mt < 4; ++mt)
#pragma unroll
            for (int r = 0; r < 4; ++r) gp[mt][r] = bf2f(P[(r0 + 16 * mt + 4 * fq + r) * PBW + PC_GDN_G + h * HD + 16 * wave + fr]);
        bf16x8 SB[4];
#pragma unroll
        for (int kb = 0; kb < 4; ++kb) SB[kb] = pack_acc(S[2 * kb], S[2 * kb + 1]);
        f32x4 u[4];
#pragma unroll
        for (int mt = 0; mt < 4; ++mt) { f32x4 ws2 = {0.f, 0.f, 0.f, 0.f}; op[mt] = (f32x4){0.f, 0.f, 0.f, 0.f};
#pragma unroll
            for (int kb = 0; kb < 4; ++kb) { ws2 = MFMA16(frag_rd_perm(ws_, LD128, 16 * mt, 32 * kb, lane), SB[kb], ws2); op[mt] = MFMA16(frag_rd_perm(qds, LD128, 16 * mt, 32 * kb, lane), SB[kb], op[mt]); }
#pragma unroll
            for (int r = 0; r < 4; ++r) u[mt][r] = bf2f(u0s[(16 * mt + 4 * fq + r) * LD128 + 16 * wave + fr]) - ws2[r]; }
        const bf16x8 UB0 = pack_acc(u[0], u[1]), UB1 = pack_acc(u[2], u[3]);
#pragma unroll
        for (int mt = 0; mt < 4; ++mt) { op[mt] = MFMA16(frag_rd_perm(qks, LD64, 16 * mt, 0, lane), UB0, op[mt]); op[mt] = MFMA16(frag_rd_perm(qks, LD64, 16 * mt, 32, lane), UB1, op[mt]); }
#pragma unroll
        for (int dt = 0; dt < 8; ++dt) { f32x4 sn = S[dt] * de;
            sn = MFMA16(frag_tr_perm(kes, LD128, 0, 16 * dt, lane), UB0, sn); sn = MFMA16(frag_tr_perm(kes, LD128, 32, 16 * dt, lane), UB1, sn); S[dt] = sn; }
        LAS float* rs_ = rsp + (n & 1) * 512;
#pragma unroll
        for (int mt = 0; mt < 4; ++mt)
#pragma unroll
            for (int r = 0; r < 4; ++r) { float s = op[mt][r] * op[mt][r]; s = row_sum_f(s);
                if (fr == 0) rs_[wave * 64 + 16 * mt + 4 * fq + r] = s; }
    }
    __syncthreads();
    CH_FINAL(NCHK - 1);
#undef CH_FINAL
    __syncthreads();
}

#ifndef TAB_FP8
#define TAB_FP8 1
#endif
constexpr size_t WS_TSC = 93 * MiB + 256 * 1024;
constexpr int NSLICE = 16;
constexpr int PE_KEYS = 0, PE_CAB = 16384, PE_ENT = 17408, PE_OFFS = 50176, PE_SHQ = 52352, PE_H2Q = 53248;

__device__ __forceinline__ void tab_convert(ArgsR A, int l, int gw, int NGW, int lane) {
    unsigned char* ws = A.ws; float* tsc = (float*)(ws + WS_TSC);
#pragma unroll 1
    for (int q = gw; q < 2 * NEXP; q += NGW) {
        const int t = q / NEXP, rr = l * NEXP + q % NEXP, r = t * DEPTH * NEXP + rr;
        const float* src = A.in[t ? I_PV : I_PU] + (size_t)rr * DM;
        f32x4 v[8];
#pragma unroll
        for (int i = 0; i < 8; ++i) v[i] = *(const GAS f32x4*)(src + 4 * (lane + 64 * i));
        unsigned char* dst = ws + (t ? WS_VB : WS_UB) + (size_t)(rr / NEXP) * TAB_L + (size_t)(rr % NEXP) * DM;
        float am = 0.f;
#pragma unroll
        for (int i = 0; i < 8; ++i) am = fmaxf(fmaxf(am, fmaxf(fabsf(v[i][0]), fabsf(v[i][1]))), fmaxf(fabsf(v[i][2]), fabsf(v[i][3])));
        am = wave_max(am); const float sc = am > 0.f ? 127.0f / am : 1.0f; const int off = 0;
#pragma unroll
        for (int i = 0; i < 8; ++i) { const int q0 = __float2int_rn(v[i][0] * sc) + off, q1 = __float2int_rn(v[i][1] * sc) + off, q2 = __float2int_rn(v[i][2] * sc) + off, q3 = __float2int_rn(v[i][3] * sc) + off;
            *(GAS unsigned*)(dst + 4 * (lane + 64 * i)) = (unsigned)(q0 & 255) | ((unsigned)(q1 & 255) << 8) | ((unsigned)(q2 & 255) << 16) | ((unsigned)(q3 & 255) << 24); }
        if (lane == 0) tsc[r] = am > 0.f ? am * (1.0f / 127.0f) : 1.0f;
    }
}
__device__ __forceinline__ float ubf0(unsigned w) { float r; asm volatile("v_cvt_f32_ubyte0 %0, %1" : "=v"(r) : "v"(w)); return r; }
__device__ __forceinline__ float ubf1(unsigned w) { float r; asm volatile("v_cvt_f32_ubyte1 %0, %1" : "=v"(r) : "v"(w)); return r; }
__device__ __forceinline__ float ubf2(unsigned w) { float r; asm volatile("v_cvt_f32_ubyte2 %0, %1" : "=v"(r) : "v"(w)); return r; }
__device__ __forceinline__ float ubf3(unsigned w) { float r; asm volatile("v_cvt_f32_ubyte3 %0, %1" : "=v"(r) : "v"(w)); return r; }
#define TOUCH16(a, o) asm volatile("" : "+v"(a[(o)+0]), "+v"(a[(o)+1]), "+v"(a[(o)+2]), "+v"(a[(o)+3]), "+v"(a[(o)+4]), "+v"(a[(o)+5]), "+v"(a[(o)+6]), "+v"(a[(o)+7]), "+v"(a[(o)+8]), "+v"(a[(o)+9]), "+v"(a[(o)+10]), "+v"(a[(o)+11]), "+v"(a[(o)+12]), "+v"(a[(o)+13]), "+v"(a[(o)+14]), "+v"(a[(o)+15]))
__device__ __forceinline__ unsigned f2sortable(float f) { const unsigned u = __builtin_bit_cast(unsigned, f); return (u & 0x80000000u) ? ~u : (u | 0x80000000u); }
__device__ __forceinline__ float unsortable(unsigned k) { const unsigned u = (k & 0x80000000u) ? (k & 0x7fffffffu) : ~k; return __builtin_bit_cast(float, u); }
__device__ __forceinline__ void peer_phase(ArgsR A, int l, bool last, bool dry, LAS unsigned char* lds, int G, int tid) {
    const int wave = __builtin_amdgcn_readfirstlane(tid >> 6), lane = tid & 63;
    unsigned char* ws = A.ws;
    const bf16* Q = (const bf16*)(ws + WS_Q);
    const bf16* K1 = (const bf16*)(ws + WS_K1) + (size_t)l * 8 * 128 * 128; const bf16* K2 = (const bf16*)(ws + WS_K2) + (size_t)l * 8 * 128 * 128;
    const unsigned char* Ub = ws + WS_UB + (size_t)l * TAB_L; const unsigned char* Vb = ws + WS_VB + (size_t)l * TAB_L;
    const float* tscU = (const float*)(ws + WS_TSC) + (size_t)l * NEXP; const float* tscV = tscU + (size_t)DEPTH * NEXP;
    const float* ssp = (const float*)(ws + WS_SSP); const float* X = A.out; float* XO = dry ? (float*)(ws + WS_P) : A.out; bf16* xb = (bf16*)(ws + (dry ? WS_MIX : WS_XB)); float* rstd1 = (float*)(ws + (dry ? WS_PS : WS_RSTD1));
    const float* g2 = A.in[I_N2G] + l * DM; const float* gf = A.in[I_FNG];
    LAS unsigned* keysL = (LAS unsigned*)(lds + PE_KEYS); LAS unsigned* cab = (LAS unsigned*)(lds + PE_CAB); LAS v2u* ent = (LAS v2u*)(lds + PE_ENT); LAS unsigned* offs = (LAS unsigned*)(lds + PE_OFFS);
    LAS float* shqL = (LAS float*)(lds + PE_SHQ); LAS unsigned* ngt = (LAS unsigned*)(lds + PE_SHQ + 128); LAS float* cqs = (LAS float*)(lds + PE_SHQ + 256); LAS unsigned* ngt8 = (LAS unsigned*)(lds + PE_SHQ + 384); LAS v4u* h2qL = (LAS v4u*)(lds + PE_H2Q);
    if (tid < 64) { int a = 0, b = tid, found = 0;
        for (int aa = 0, base = 0; aa < 16; ++aa) { const int nbb = 16 / (aa + 1); if (!found && tid < base + nbb) { a = aa; b = tid - base; found = 1; } base += nbb; }
        cab[tid] = found ? (unsigned)(a * 16 + b) : 0xffu; }
    __syncthreads();
#pragma unroll 1
    for (int item = blockIdx.x; item < NT / 32; item += G) {
        const int tok0 = item * 32;
#pragma unroll 1
        for (int tt = 0; tt < 4; ++tt) { const int tl = wave * 4 + tt; const size_t t = (size_t)tok0 + tl;
            float s2 = (lane < 32) ? ssp[t * 32 + lane] : 0.f; s2 = wave_sum(s2);
            const float rstd2 = rsqrtf(s2 * (1.0f / DM) + RMS_EPS);
            float hf[32]; float am = 0.f;
#pragma unroll
            for (int j = 0; j < 2; ++j)
#pragma unroll
                for (int q = 0; q < 4; ++q) { const size_t e0 = 16 * (size_t)(lane + 64 * j) + 4 * q;
                    const f32x4 xa = *(const GAS f32x4*)(X + t * DM + e0), ga = *(const GAS f32x4*)(g2 + e0);
#pragma unroll
                    for (int k = 0; k < 4; ++k) { const float hv = xa[k] * rstd2 * ga[k]; hf[j * 16 + q * 4 + k] = hv; am = fmaxf(am, fabsf(hv)); } }
            am = wave_max(am); const float sc = am > 0.f ? 127.0f / am : 1.0f;
#pragma unroll
            for (int j = 0; j < 2; ++j) { unsigned wd[4];
#pragma unroll
                for (int q = 0; q < 4; ++q) wd[q] = (unsigned)((__float2int_rn(hf[j * 16 + q * 4 + 0] * sc) & 255) | ((__float2int_rn(hf[j * 16 + q * 4 + 1] * sc) & 255) << 8) | ((__float2int_rn(hf[j * 16 + q * 4 + 2] * sc) & 255) << 16) | ((__float2int_rn(hf[j * 16 + q * 4 + 3] * sc) & 255) << 24));
                v4u w; w.x = wd[0]; w.y = wd[1]; w.z = wd[2]; w.w = wd[3]; h2qL[(tl * 2 + j) * 64 + lane] = w; }
            if (lane == 0) shqL[tl] = am > 0.f ? am * (1.0f / 127.0f) : 1.0f; }
#pragma unroll 1
        for (int pass = 0; pass < 4; ++pass) {
            LAS unsigned* kl = keysL + (pass & 1) * 2048;
            { const int hh = wave >> 2, side = (wave >> 1) & 1, mt = wave & 1, h = 2 * pass + hh, fr = lane & 15, fq = lane >> 4;
                const bf16* qa = Q + (size_t)(tok0 + 16 * mt + fr) * DM + h * 256 + side * 128 + 8 * fq;
                const bf16* kb = (side ? K2 : K1) + (size_t)h * 128 * 128 + (size_t)fr * 128 + 8 * fq;
                bf16x8 af[4];
#pragma unroll
                for (int ks = 0; ks < 4; ++ks) af[ks] = *(const GAS bf16x8*)(qa + 32 * ks);
                unsigned key[8][4];
#pragma unroll
                for (int nt = 0; nt < 8; ++nt) { f32x4 acc = {0.f, 0.f, 0.f, 0.f};
#pragma unroll
                    for (int ks = 0; ks < 4; ++ks) { const bf16x8 bfr = *(const GAS bf16x8*)(kb + (size_t)nt * 16 * 128 + 32 * ks); acc = __builtin_amdgcn_mfma_f32_16x16x32_bf16(af[ks], bfr, acc, 0, 0, 0); }
#pragma unroll
                    for (int r = 0; r < 4; ++r) key[nt][r] = (f2sortable(acc[r]) & ~127u) | (unsigned)(nt * 16 + fr);
                    if (nt & 1) __builtin_amdgcn_sched_barrier(0); }
#define CE8(a, b) { const unsigned hi_ = max(key[a][r], key[b][r]), lo_ = min(key[a][r], key[b][r]); key[a][r] = hi_; key[b][r] = lo_; }
#pragma unroll
                for (int r = 0; r < 4; ++r) { CE8(0, 1) CE8(2, 3) CE8(4, 5) CE8(6, 7) CE8(0, 2) CE8(1, 3) CE8(4, 6) CE8(5, 7) CE8(1, 2) CE8(5, 6) CE8(0, 4) CE8(1, 5) CE8(2, 6) CE8(3, 7) CE8(2, 4) CE8(3, 5) CE8(1, 2) CE8(3, 4) CE8(5, 6) }
#undef CE8
                unsigned res[4] = {0u, 0u, 0u, 0u};
#pragma unroll 1
                for (int j = 0; j < 16; ++j) {
#pragma unroll
                    for (int r = 0; r < 4; ++r) {
                        const unsigned w = row_max_u(key[0][r]); const bool own = key[0][r] == w;
#pragma unroll
                        for (int nt = 0; nt < 7; ++nt) key[nt][r] = own ? key[nt + 1][r] : key[nt][r];
                        key[7][r] = own ? 0u : key[7][r];
                        res[r] = (fr == j) ? w : res[r]; } }
                const int rowb = (hh * 2 + side) * 32 + 16 * mt + 4 * fq;
#pragma unroll
                for (int r = 0; r < 4; ++r) kl[(rowb + r) * 16 + fr] = res[r]; }
            __syncthreads();
#pragma unroll 1
            for (int rnd = 0; rnd < 2; ++rnd) { const int fr = lane & 15, fq = lane >> 4, pidx = rnd * 32 + wave * 4 + fq, hh = pidx >> 5, tk = pidx & 31, h = 2 * pass + hh;
                const LAS unsigned* k1 = kl + ((hh * 2) * 32 + tk) * 16; const LAS unsigned* k2 = k1 + 32 * 16;
                unsigned ck[4];
#pragma unroll
                for (int sl = 0; sl < 4; ++sl) { const int ci = fr + 16 * sl; const unsigned ab = cab[ci];
                    const float v = unsortable(k1[(ab >> 4) & 15] & ~127u) + unsortable(k2[ab & 15] & ~127u);
                    ck[sl] = (ab == 0xffu) ? 0u : ((f2sortable(v) & ~63u) | (unsigned)ci); }
#define CE4(a, b) { const unsigned hi_ = max(ck[a], ck[b]), lo_ = min(ck[a], ck[b]); ck[a] = hi_; ck[b] = lo_; }
                CE4(0, 1) CE4(2, 3) CE4(0, 2) CE4(1, 3) CE4(1, 2)
#undef CE4
                unsigned rk = 0u;
#pragma unroll 1
                for (int j = 0; j < 16; ++j) { const unsigned w = row_max_u(ck[0]); const bool own = ck[0] == w;
                    ck[0] = own ? ck[1] : ck[0]; ck[1] = own ? ck[2] : ck[1]; ck[2] = own ? ck[3] : ck[2]; ck[3] = own ? 0u : ck[3];
                    rk = (fr == j) ? w : rk; }
                const unsigned ab = cab[rk & 63u]; const float v = unsortable(rk & ~63u);
                const float vmax = row_max_f(v), e = __expf(v - vmax), den = row_sum_f(e);
                const unsigned eid = (k1[(ab >> 4) & 15] & 127u) * 128u + (k2[ab & 15] & 127u);
                const float gsv = e * rcpf_(den) * tscV[eid];
                v2u wv; wv.x = eid; wv.y = __builtin_bit_cast(unsigned, gsv);
                ent[tk * 128 + h * 16 + fr] = wv; }
        }
        __syncthreads();
#pragma unroll 1
        for (int tt = 0; tt < 4; ++tt) { const int tl = wave * 4 + tt;
            const v2u e0 = ent[tl * 128 + lane], e1 = ent[tl * 128 + 64 + lane];
            const unsigned id0 = e0.x, id1 = e1.x; const unsigned s0 = id0 >> 10, s1 = id1 >> 10; const unsigned long long lt = (1ull << lane) - 1ull;
            unsigned base = 0, p0 = 0, p1 = 0, ngr = 0, ng8 = 0, pc = 0;
#pragma unroll 1
            for (unsigned s = 0; s < NSLICE; ++s) { const unsigned long long m0 = __ballot(s0 == s), m1 = __ballot(s1 == s); const unsigned c0 = __popcll(m0), c1 = __popcll(m1); ngr += (c0 + c1 + 3u) >> 2; pc += c0 + c1; if (s & 1u) { ng8 += (pc + 7u) >> 3; pc = 0; }
                if (s0 == s) p0 = base + __popcll(m0 & lt);
                if (s1 == s) p1 = base + c0 + __popcll(m1 & lt);
                if (lane == 0) offs[tl * 17 + s] = base;
                base += c0 + c1; }
            if (lane == 0) { offs[tl * 17 + NSLICE] = base; ngt[tl] = ngr; ngt8[tl] = ng8; }
            ent[tl * 128 + p0] = e0; ent[tl * 128 + p1] = e1; }
        const unsigned lo16 = (unsigned)lane * 16u;
#if defined(PROBE_VMASK) || defined(PROBE_UMASK)
        int IDM_ = 0xffffff;
#else
        constexpr int IDM_ = 0xffffff;
#endif
#define E_ADV(S, T, P, B1, NTOK, TLBASE) { P += 4; while (P >= B1 && S < NSLICE) { ++T; if (T == (NTOK)) { T = 0; ++S; } \
            if (S < NSLICE) { P = __builtin_amdgcn_readfirstlane((int)offs[((TLBASE) + T) * 17 + S]); B1 = __builtin_amdgcn_readfirstlane((int)offs[((TLBASE) + T) * 17 + S + 1]); } } \
            if (S >= NSLICE) { T = 0; P = 128; B1 = 128; } }
#define E_FETCH(X, T, P, B1, TLBASE, WITHSU) { X##tl = (TLBASE) + T; X##w = T; X##p = P; X##b1 = B1; \
            _Pragma("unroll") for (int e = 0; e < 4; ++e) { const v2u w_ = ent[X##tl * 128 + min(P + e, B1 - 1)]; const unsigned ex = w_.x, ey = w_.y; \
                X##id[e] = __builtin_amdgcn_readfirstlane((int)ex); X##cf[e] = __builtin_bit_cast(float, __builtin_amdgcn_readfirstlane((int)ey)); if (WITHSU) X##su[e] = tscU[X##id[e]]; } }
#define E_LOAD(REG, TAB, X) { _Pragma("unroll") for (int e = 0; e < 4; ++e) { const GAS unsigned char* rb = (const GAS unsigned char*)(TAB) + (size_t)(X##id[e] & IDM_) * 2048; REG[e][0] = *(const GAS v4u*)(rb + lo16); REG[e][1] = *(const GAS v4u*)(rb + lo16 + 1024); } }
        {
#ifdef PROBE_UMASK
            IDM_ = dry ? 1023 : 0xffffff;
#endif
            int Atl = 0, Aw = 0, Ap = 0, Ab1 = 0, Aid[4]; float Acf[4], Asu[4]; int Btl = 0, Bw = 0, Bp = 0, Bb1 = 0, Bid[4]; float Bcf[4], Bsu[4]; v4u RA[4][2], RB[4][2];
            (void)Aw; (void)Bw;
#define U_COMP(X, REG) { const v4u hq0 = h2qL[(X##tl * 2 + 0) * 64 + lane], hq1 = h2qL[(X##tl * 2 + 1) * 64 + lane]; const float shq = shqL[X##tl]; float dd[4]; \
                _Pragma("unroll") for (int e = 0; e < 4; ++e) { int a0 = 0, a1 = 0; \
                    a0 = __builtin_amdgcn_sdot4((int)REG[e][0][0], (int)hq0[0], a0, false); a1 = __builtin_amdgcn_sdot4((int)REG[e][0][1], (int)hq0[1], a1, false); \
                    a0 = __builtin_amdgcn_sdot4((int)REG[e][0][2], (int)hq0[2], a0, false); a1 = __builtin_amdgcn_sdot4((int)REG[e][0][3], (int)hq0[3], a1, false); \
                    a0 = __builtin_amdgcn_sdot4((int)REG[e][1][0], (int)hq1[0], a0, false); a1 = __builtin_amdgcn_sdot4((int)REG[e][1][1], (int)hq1[1], a1, false); \
                    a0 = __builtin_amdgcn_sdot4((int)REG[e][1][2], (int)hq1[2], a0, false); a1 = __builtin_amdgcn_sdot4((int)REG[e][1][3], (int)hq1[3], a1, false); \
                    dd[e] = (float)(a0 + a1); } \
                _Pragma("unroll") for (int e = 0; e < 4; ++e) { const float r_ = row_sum_f(dd[e]); const int ri_ = __builtin_bit_cast(int, r_); \
                    dd[e] = (__builtin_bit_cast(float, __builtin_amdgcn_readlane(ri_, 0)) + __builtin_bit_cast(float, __builtin_amdgcn_readlane(ri_, 16))) + (__builtin_bit_cast(float, __builtin_amdgcn_readlane(ri_, 32)) + __builtin_bit_cast(float, __builtin_amdgcn_readlane(ri_, 48))); } \
                _Pragma("unroll") for (int e = 0; e < 4; ++e) { const float cf = X##cf[e] * gelu_tanh(dd[e] * X##su[e] * shq); \
                    if (lane == 0 && X##p + e < X##b1) { v2u w2; w2.x = (unsigned)X##id[e]; w2.y = __builtin_bit_cast(unsigned, cf); ent[X##tl * 128 + X##p + e] = w2; } } }
            int us = 0, ut = -1, up = 0, ub1 = 0;
            const int ngU = __builtin_amdgcn_readfirstlane((int)(ngt[wave * 4] + ngt[wave * 4 + 1] + ngt[wave * 4 + 2] + ngt[wave * 4 + 3]));
            E_ADV(us, ut, up, ub1, 4, wave * 4);
            E_FETCH(A, ut, up, ub1, wave * 4, 1); E_LOAD(RA, Ub, A);
#pragma unroll 1
            for (int gi = 0; gi < ngU; gi += 2) {
                E_ADV(us, ut, up, ub1, 4, wave * 4); E_FETCH(B, ut, up, ub1, wave * 4, 1); E_LOAD(RB, Ub, B);
                U_COMP(A, RA);
                E_ADV(us, ut, up, ub1, 4, wave * 4); E_FETCH(A, ut, up, ub1, wave * 4, 1); E_LOAD(RA, Ub, A);
                U_COMP(B, RB);
            }
#undef U_COMP
        }
#pragma unroll 1
        for (int tt = 0; tt < 4; ++tt) { const int tl = wave * 4 + tt;
            const v2u e0 = ent[tl * 128 + lane], e1 = ent[tl * 128 + 64 + lane]; const unsigned b0_ = e0.y, b1_ = e1.y;
            const float c0 = __builtin_bit_cast(float, b0_), c1 = __builtin_bit_cast(float, b1_);
            const float am = wave_max(fmaxf(fabsf(c0), fabsf(c1))); const float sc = am > 0.f ? 127.0f / am : 0.f;
            v2u w0 = e0, w1 = e1; w0.y = (unsigned)__float2int_rn(c0 * sc); w1.y = (unsigned)__float2int_rn(c1 * sc);
            ent[tl * 128 + lane] = w0; ent[tl * 128 + 64 + lane] = w1;
            if (lane == 0) cqs[tl] = am * (1.0f / 127.0f); }
        {
            LAS unsigned* accL = (LAS unsigned*)(lds + PE_H2Q) + wave * 2048;
            float ssq0 = 0.f, ssq1 = 0.f, ssq2 = 0.f, ssq3 = 0.f;
            const int ngV = __builtin_amdgcn_readfirstlane((int)(ngt8[wave * 4] + ngt8[wave * 4 + 1] + ngt8[wave * 4 + 2] + ngt8[wave * 4 + 3]));
#if defined(PROBE_VMASK)
            IDM_ = dry ? 2047 : 0xffffff;
#elif defined(PROBE_UMASK)
            IDM_ = 0xffffff;
#endif
#define V_ADV(S, T, P, B1) { P += 8; while (P >= B1 && S < NSLICE / 2) { ++T; if (T == 4) { T = 0; ++S; } \
                if (S < NSLICE / 2) { P = __builtin_amdgcn_readfirstlane((int)offs[(wave * 4 + T) * 17 + 2 * S]); B1 = __builtin_amdgcn_readfirstlane((int)offs[(wave * 4 + T) * 17 + 2 * S + 2]); } } \
                if (S >= NSLICE / 2) { T = 0; P = 128; B1 = 128; } }
#define V_FETCH(X, T, P, B1) { X##w = T; { const v2u w_ = ent[(wave * 4 + T) * 128 + min(P + (lane & 7), B1 - 1)]; const unsigned ex = w_.x, ey = w_.y; int cq_[8]; \
                _Pragma("unroll") for (int e = 0; e < 8; ++e) { X##id[e] = __builtin_amdgcn_readlane((int)ex, e); const int c_ = __builtin_amdgcn_readlane((int)ey, e); cq_[e] = (P + e < B1) ? (c_ & 255) : 0; } \
                X##c0 = cq_[0] | (cq_[1] << 8) | (cq_[2] << 16) | (cq_[3] << 24); X##c1 = cq_[4] | (cq_[5] << 8) | (cq_[6] << 16) | (cq_[7] << 24); } }
#define V_LOAD(REG, X) { _Pragma("unroll") for (int e = 0; e < 8; ++e) REG[e] = *(const GAS v4u*)(Vb + (size_t)(X##id[e] & IDM_) * 2048 + hoff); }
#define V_QUAD(Y, REG, O, CPK) { _Pragma("unroll") for (int w = 0; w < 4; ++w) { \
                const unsigned ab_lo = __builtin_amdgcn_perm(REG[O + 1][w], REG[O][w], 0x05010400u), ab_hi = __builtin_amdgcn_perm(REG[O + 1][w], REG[O][w], 0x07030602u); \
                const unsigned cd_lo = __builtin_amdgcn_perm(REG[O + 3][w], REG[O + 2][w], 0x05010400u), cd_hi = __builtin_amdgcn_perm(REG[O + 3][w], REG[O + 2][w], 0x07030602u); \
                Y[w * 4 + 0] = __builtin_amdgcn_sdot4((int)__builtin_amdgcn_perm(cd_lo, ab_lo, 0x05040100u), CPK, Y[w * 4 + 0], false); \
                Y[w * 4 + 1] = __builtin_amdgcn_sdot4((int)__builtin_amdgcn_perm(cd_lo, ab_lo, 0x07060302u), CPK, Y[w * 4 + 1], false); \
                Y[w * 4 + 2] = __builtin_amdgcn_sdot4((int)__builtin_amdgcn_perm(cd_hi, ab_hi, 0x05040100u), CPK, Y[w * 4 + 2], false); \
                Y[w * 4 + 3] = __builtin_amdgcn_sdot4((int)__builtin_amdgcn_perm(cd_hi, ab_hi, 0x07060302u), CPK, Y[w * 4 + 3], false); } }
#define V_COMP(X, REG) { if (X##w == 0) { V_QUAD(yA, REG, 0, X##c0) V_QUAD(yA, REG, 4, X##c1) } else if (X##w == 1) { V_QUAD(yB, REG, 0, X##c0) V_QUAD(yB, REG, 4, X##c1) } \
                else { int yt[16]; _Pragma("unroll") for (int i = 0; i < 16; ++i) yt[i] = 0; V_QUAD(yt, REG, 0, X##c0) V_QUAD(yt, REG, 4, X##c1) \
                    LAS unsigned* ap = accL + (X##w - 2) * 1024 + lane; _Pragma("unroll") for (int i = 0; i < 16; ++i) (void)__hip_atomic_fetch_add(ap + i * 64, (unsigned)yt[i], __ATOMIC_RELAXED, __HIP_MEMORY_SCOPE_WORKGROUP); } }
#define PV_EPI(TS, YI, SSQ) { const int tl_ = wave * 4 + (TS); const size_t t_ = (size_t)tok0 + tl_; const float cs_ = cqs[tl_]; float yv[16]; \
                _Pragma("unroll") for (int q = 0; q < 4; ++q) { const f32x4 xa = *(const GAS f32x4*)(X + t_ * DM + hoff + 4 * q); \
                    _Pragma("unroll") for (int k = 0; k < 4; ++k) { yv[q * 4 + k] = xa[k] + cs_ * (float)YI[q * 4 + k]; SSQ += yv[q * 4 + k] * yv[q * 4 + k]; } } \
                if (!last || half == 0) { _Pragma("unroll") for (int q = 0; q < 4; ++q) { f32x4 oa = {yv[q * 4 + 0], yv[q * 4 + 1], yv[q * 4 + 2], yv[q * 4 + 3]}; *(GAS f32x4*)(XO + t_ * DM + hoff + 4 * q) = oa; } } \
                if (!last) { v4u w0, w1; w0.x = pk2(yv[0], yv[1]); w0.y = pk2(yv[2], yv[3]); w0.z = pk2(yv[4], yv[5]); w0.w = pk2(yv[6], yv[7]); w1.x = pk2(yv[8], yv[9]); w1.y = pk2(yv[10], yv[11]); w1.z = pk2(yv[12], yv[13]); w1.w = pk2(yv[14], yv[15]); \
                    *(GAS v4u*)(xb + t_ * DM + hoff) = w0; *(GAS v4u*)(xb + t_ * DM + hoff + 8) = w1; } \
                if (half == 1) { const float rs = rsqrtf(wave_sum(SSQ) * (1.0f / DM) + RMS_EPS); \
                    if (!last) { if (lane == 0) rstd1[t_] = rs; } \
                    else { _Pragma("unroll") for (int q = 0; q < 4; ++q) { const f32x4 ga = *(const GAS f32x4*)(gf + hoff + 4 * q); \
                            f32x4 oa = {yv[q * 4 + 0] * rs * ga[0], yv[q * 4 + 1] * rs * ga[1], yv[q * 4 + 2] * rs * ga[2], yv[q * 4 + 3] * rs * ga[3]}; *(GAS f32x4*)(XO + t_ * DM + hoff + 4 * q) = oa; } \
                        _Pragma("unroll") for (int q = 0; q < 4; ++q) { const f32x4 ya = *(const GAS f32x4*)(XO + t_ * DM + lo16 + 4 * q), ga = *(const GAS f32x4*)(gf + lo16 + 4 * q);        \
                            f32x4 oa = {ya[0] * rs * ga[0], ya[1] * rs * ga[1], ya[2] * rs * ga[2], ya[3] * rs * ga[3]}; *(GAS f32x4*)(XO + t_ * DM + lo16 + 4 * q) = oa; } } } }
#pragma unroll 1
            for (int half = 0; half < 2; ++half) {
                const unsigned hoff = (unsigned)half * 1024u + lo16;
                int yA[16], yB[16];
#pragma unroll
                for (int i = 0; i < 16; ++i) { yA[i] = 0; yB[i] = 0; }
#pragma unroll
                for (int i = 0; i < 32; ++i) accL[i * 64 + lane] = 0u;
                {
                    int Aw = 0, Aid[8], Ac0 = 0, Ac1 = 0, Bw = 0, Bid[8], Bc0 = 0, Bc1 = 0; v4u RA[8], RB[8];
                    int us = 0, ut = -1, up = 0, ub1 = 0;
                    V_ADV(us, ut, up, ub1);
                    V_FETCH(A, ut, up, ub1); V_LOAD(RA, A);
#pragma unroll 1
                    for (int gi = 0; gi < ngV; gi += 2) {
                        V_ADV(us, ut, up, ub1); V_FETCH(B, ut, up, ub1); V_LOAD(RB, B);
                        V_COMP(A, RA);
                        V_ADV(us, ut, up, ub1); V_FETCH(A, ut, up, ub1); V_LOAD(RA, A);
                        V_COMP(B, RB);
                    }
                }
                PV_EPI(0, yA, ssq0);
                PV_EPI(1, yB, ssq1);
                { int yl[16];
#pragma unroll
                    for (int i = 0; i < 16; ++i) yl[i] = (int)accL[i * 64 + lane];
                    PV_EPI(2, yl, ssq2); }
                { int yl[16];
#pragma unroll
                    for (int i = 0; i < 16; ++i) yl[i] = (int)accL[1024 + i * 64 + lane];
                    PV_EPI(3, yl, ssq3); }
            }
#undef PV_EPI
#undef V_COMP
#undef V_QUAD
#undef V_LOAD
#undef V_FETCH
#undef V_ADV
#undef E_ADV
#undef E_FETCH
#undef E_LOAD
        }
        __syncthreads();
    }
}

#ifndef PROBE_ITEM
#define PROBE_ITEM -1
#endif
#define IREP(k) for (int irep = (PROBE_ITEM == (k)) ? 0 : 1; irep < 2; ++irep)
__device__ __forceinline__ void mix_p2(ArgsR A, int l, LAS unsigned char* lds, int G, int tid) {
    const int bx = blockIdx.x; (void)tid;
    IREP(1) for (int it = bx; it < 512; it += G) f_gla_p2(A, l, it, lds, pg8::fresh_tid());
    IREP(2) for (int it = bx; it < 512; it += G) f_ml_p2(A, l, it, lds, pg8::fresh_tid());
    IREP(3) for (int it = bx; it < 512; it += G) f_gdn_p2(A, l, it, lds, pg8::fresh_tid());
    IREP(4) for (int it = bx; it < 1024; it += G) f_lru_p2(A, l, it, lds, pg8::fresh_tid());
}
__device__ __forceinline__ void part_barrier(unsigned* word, unsigned nb, int tid) {
    asm volatile("s_waitcnt vmcnt(0)" ::: "memory");
    __syncthreads();
    if (tid == 0) {
        __builtin_amdgcn_fence(__ATOMIC_RELEASE, "agent");
        asm volatile("s_waitcnt vmcnt(0)" ::: "memory");
        __hip_atomic_fetch_add(word, 1u, __ATOMIC_RELAXED, __HIP_MEMORY_SCOPE_AGENT);
        unsigned sp = 0;
        while (__hip_atomic_load(word, __ATOMIC_RELAXED, __HIP_MEMORY_SCOPE_AGENT) < nb) { __builtin_amdgcn_s_sleep(2); if (++sp > (1u << 22)) break; }
        __builtin_amdgcn_fence(__ATOMIC_ACQUIRE, "agent");
        asm volatile("s_waitcnt vmcnt(0)" ::: "memory");
    }
    __syncthreads();
}
__device__ __forceinline__ void mix_p3(ArgsR A, int l, LAS unsigned char* lds, int G) {
    const int bx = blockIdx.x;
    const bool split = G > 32;
    int first = 0, nb = G;
    if (split) { if (bx < 16) { IREP(8) f_gdn_p3(A, l, bx, lds, pg8::fresh_tid()); return; } first = 16; nb = G - 16; }
    else { for (int it = bx; it < 16; it += G) f_gdn_p3(A, l, it, lds, pg8::fresh_tid()); }
    for (int it = bx - first; it < 516; it += nb) {
        if (it < 256) f_gla_p3(A, it, pg8::fresh_tid());
        else if (it < 512) f_ml_p3(A, it - 256, pg8::fresh_tid());
        else f_lru_p3(A, it - 512, pg8::fresh_tid());
    }
    IREP(7) { const int t2 = pg8::fresh_tid(); tab_convert(A, l, (bx - first) * NWAVES + __builtin_amdgcn_readfirstlane(t2 >> 6), nb * NWAVES, t2 & 63); }
    part_barrier((unsigned*)(A.ws + WS_CTL) + CW_PBAR + 64 * l, (unsigned)nb, pg8::fresh_tid());
    IREP(5) for (int it = bx - first; it < 512; it += nb) f_gla_p4(A, l, it, lds, pg8::fresh_tid());
    IREP(6) for (int it = nb - 1 - (bx - first); it < 512; it += nb) f_ml_p4(       A, l, it, lds, pg8::fresh_tid());
    for (int it = bx - first; it < 128; it += nb) f_lru_p4(A, it, pg8::fresh_tid());
}

#ifndef PROBE_PHASE
#define PROBE_PHASE -1
#endif
#ifndef MK_PER_PHASE
#define MK_PER_PHASE 0
#endif
#ifdef PROBE_DUP
constexpr int PPL = 7;
#else
constexpr int PPL = 6;
#endif
constexpr int NPHASE = 1 + PPL * DEPTH;
constexpr int CW_BAR = 4096;

__global__ void __launch_bounds__(NTHREADS, 2) mk_fwd(Args args) {
    extern __shared__ __attribute__((aligned(16))) unsigned char lds_raw[];
    LAS unsigned char* lds = (LAS unsigned char*)lds_raw;
    volatile LAS unsigned* MISC = (volatile LAS unsigned*)(lds + MISC_OFF);
    const int G = gridDim.x; const int bx = blockIdx.x;
    unsigned char* ws = args.ws;
    if (threadIdx.x < 64) MISC[threadIdx.x] = 0u;
    __syncthreads();
    XcdBarrier bar; bar.bar = (unsigned*)(ws + WS_CTL) + CW_BAR; bar.x = 0; bar.st = nullptr;
    if (!MK_PER_PHASE) bar = xcd_barrier_post((unsigned*)(ws + WS_CTL) + CW_BAR, MISC + 8);
    const int lo = args.ph_lo, hi = args.ph_hi;
#pragma unroll 1
    for (int ph = lo; ph < hi; ++ph) {
#ifdef PROBE_DUP
        const int l = ph > 0 ? (ph - 1) / PPL : 0, kx = ph > 0 ? (ph - 1) % PPL : -1, k = kx > PROBE_DUP ? kx - 1 : kx; const bool dry = (kx == PROBE_DUP);
#else
        const int l = ph > 0 ? (ph - 1) / PPL : 0, k = ph > 0 ? (ph - 1) % PPL : -1; const bool dry = false;
#endif
        if (k < 0) { const int t0 = pg8::fresh_tid(); const int vcu = (G % 8 == 0) ? (bx % 8) * (G / 8) + bx / 8 : bx; p0_prologue(*kargs(), lds, vcu, G, __builtin_amdgcn_readfirstlane(t0 >> 6), t0 & 63); }
        else if (k == 0) {
            pg8::Gemm g{(const pg8::bf16_t*)(ws + WS_XB), (const pg8::bf16_t*)(ws + WS_WIN + l * WIN_L), NT, NINP, DM}; pg8::StaticOrder S; S.init(NT, NINP, G, bx);
            pg8::EpiP E{(pg8::bf16_t*)(ws + WS_P), (float*)(ws + WS_PS), (const float*)(ws + WS_RSTD1)};
            pg8::gemm_phase<pg8::EpiP, pg8::StaticOrder, true, true>(lds, g, S, E); }
        else if (k == 1) mix_p2(*kargs(), l, lds, G, pg8::fresh_tid());
        else if (k == 2) mix_p3(*kargs(), l, lds, G);
        else if (k == 3) {
            pg8::Gemm g{(const pg8::bf16_t*)(ws + WS_MIX), (const pg8::bf16_t*)(ws + WS_WOUT + l * WSQ_L), NT, DM, DM}; pg8::StaticOrder S; S.init(NT, DM, G, bx);
            pg8::EpiX E{l == 0 ? args.in[I_X] : (const float*)args.out, dry ? (float*)(ws + WS_P) : args.out, (pg8::bf16_t*)(ws + (dry ? WS_Q : WS_XB)), (float*)(ws + (dry ? WS_PS : WS_SSP))};
            pg8::gemm_phase<pg8::EpiX, pg8::StaticOrder, true, true>(lds, g, S, E); }
        else if (k == 4) {
            pg8::Gemm g{(const pg8::bf16_t*)(ws + WS_XB), (const pg8::bf16_t*)(ws + WS_WQ + l * WSQ_L), NT, DM, DM}; pg8::StaticOrder S; S.init(NT, DM, G, bx);
            pg8::EpiQ E{(pg8::bf16_t*)(ws + WS_Q), (const float*)(ws + WS_SSP)};
            pg8::gemm_phase<pg8::EpiQ, pg8::StaticOrder, true, true>(lds, g, S, E); }
        else peer_phase(*kargs(), l, l == DEPTH - 1, dry, lds, G, pg8::fresh_tid());
        if (!MK_PER_PHASE && ph + 1 < hi) xcd_barrier(bar);
    }
}

extern "C" void kernel_launch(void* const* d_in, const int* in_sizes, int n_in, void* d_out, int out_size, void* d_ws, size_t ws_size, hipStream_t stream) {
    static int grid = 0;
    if (grid == 0) {
        if (n_in != N_IN || out_size != NT * DM || ws_size < WS_END) { fprintf(stderr, "kernel_launch: unexpected shapes: n_in %d out %d ws %zu (need %zu)\n", n_in, out_size, ws_size, (size_t)WS_END); grid = -1; return; }
        int dev = 0, cus = 0, per_cu = 0;
        if (hipGetDevice(&dev) != hipSuccess || hipDeviceGetAttribute(&cus, hipDeviceAttributeMultiprocessorCount, dev) != hipSuccess) { grid = -1; return; }
        if (hipFuncSetAttribute((const void*)mk_fwd, hipFuncAttributeMaxDynamicSharedMemorySize, LDS_BYTES) != hipSuccess) { fprintf(stderr, "kernel_launch: hipFuncSetAttribute failed\n"); grid = -1; return; }
        if (hipOccupancyMaxActiveBlocksPerMultiprocessor(&per_cu, (const void*)mk_fwd, NTHREADS, LDS_BYTES) != hipSuccess || per_cu < 1) { fprintf(stderr, "kernel_launch: occupancy query says %d blocks per CU\n", per_cu); (void)hipGetLastError(); grid = -1; return; }
        grid = cus;
    }
    if (grid < 0) return;
    if (hipMemsetAsync((char*)d_ws + WS_CTL, 0, CTL_ZERO_BYTES, stream) != hipSuccess) return;
    Args a{};
    for (int i = 0; i < N_IN; ++i) a.in[i] = (const float*)d_in[i];
    a.out = (float*)d_out; a.ws = (unsigned char*)d_ws;
#if MK_PER_PHASE
    for (int p = 0; p < NPHASE; ++p) { a.ph_lo = p; a.ph_hi = p + 1; a.li = 0; hipLaunchKernelGGL(mk_fwd, dim3(grid), dim3(NTHREADS), LDS_BYTES, stream, a); }
#else
    a.ph_lo = 0; a.ph_hi = NPHASE; a.li = 0;
    hipLaunchKernelGGL(mk_fwd, dim3(grid), dim3(NTHREADS), LDS_BYTES, stream, a);
#endif
}
```

```cpp
#include <hip/hip_runtime.h>
#include <cstdio>
#include <cstdint>
namespace pg8 {
__device__ __forceinline__ int fresh_tid() { int t = threadIdx.x; asm volatile("" : "+v"(t)); return t; }
#define PG8_LAS __attribute__((address_space(3)))
typedef unsigned short bf16_t;
typedef short bf16x8 __attribute__((ext_vector_type(8)));
typedef float f32x4 __attribute__((ext_vector_type(4)));
typedef unsigned u32x4 __attribute__((ext_vector_type(4)));
constexpr int BM = 256, BK = 64, HALF = 128, HTB = HALF * BK * 2  , STAGE_BYTES = 8 * HTB, NXCD = 8, WGM = 8;

__host__ __device__ __forceinline__ int lds_byte(int r, int c) { const int st = (r >> 4) * 2 + (c >> 5), rr = r & 15, cc = c & 31, ob = rr * 64 + cc * 2; return st * 1024 + (ob ^ (((ob >> 9) & 1) << 5)); }
__host__ __device__ __forceinline__ void stage_rc(int b, int& R, int& C) { const int st = b / 1024, sb = b % 1024, swz = sb ^ (((sb >> 9) & 1) << 5); R = (st >> 1) * 16 + swz / 64; C = (st & 1) * 32 + (swz % 64) / 2; }
__host__ __device__ __forceinline__ int perm32(int rho) { const int n = rho >> 4, i = rho & 15; return 8 * (i >> 2) + 4 * n + (i & 3); }

struct Unit { int pm, pn; };
struct Gemm { const bf16_t* A; const bf16_t* Bt; int M, N, K; };

struct StaticOrder {
    int nM, nN, nwg, G, c;
    __host__ __device__ void init(int M, int N, int G_, int c_) { nM = M / BM; nN = N / BM; nwg = nM * nN; G = G_; c = c_; }
    __host__ __device__ bool next(int i, Unit& u) const {
        const long L = (long)i * G + c; if (L >= nwg) return false;
        int wgid = (int)L; { const int q = nwg / NXCD, r = nwg % NXCD, xcd = wgid % NXCD, off = wgid / NXCD; wgid = (xcd < r ? xcd * (q + 1) : r * (q + 1) + (xcd - r) * q) + off; }
        const int nig = WGM * nN, gid = wgid / nig, fm = gid * WGM, gsz = (nM - fm) < WGM ? (nM - fm) : WGM;
        u.pm = fm + ((wgid % nig) % gsz); u.pn = (wgid % nig) / gsz; return true;
    }
    __device__ __forceinline__ void a_ready(const Unit&) const {}
    __device__ __forceinline__ void done(const Unit&) const {}
};


__device__ __forceinline__ unsigned cvt_pk_bf16(float lo, float hi) { unsigned r; asm volatile("v_cvt_pk_bf16_f32 %0, %1, %2" : "=v"(r) : "v"(lo), "v"(hi)); return r; }

struct EpiP {
    static constexpr bool PERM = true, AFTER_DRAIN = false;
    bf16_t* P; float* Ps; const float* rstd;
    __device__ __forceinline__ void operator()(const f32x4 (&acc)[2][2][4][2], const Unit& u, int wr, int wc, int fr, int fq) const {
        const int row0 = u.pm * BM + wr * 64 + fr;
        if (u.pn < 28) {
            const int col0 = u.pn * BM + wc * 32 + 8 * fq;
#pragma unroll
            for (int ai = 0; ai < 2; ++ai)
#pragma unroll
                for (int m = 0; m < 4; ++m) { const int row = row0 + ai * HALF + m * 16; const float r = rstd[row]; bf16_t* rowp = P + (size_t)row * 7168 + col0;
#pragma unroll
                    for (int bj = 0; bj < 2; ++bj) { const f32x4 v0 = acc[ai][bj][m][0] * r, v1 = acc[ai][bj][m][1] * r;
                        u32x4 w; w.x = cvt_pk_bf16(v0[0], v0[1]); w.y = cvt_pk_bf16(v0[2], v0[3]); w.z = cvt_pk_bf16(v1[0], v1[1]); w.w = cvt_pk_bf16(v1[2], v1[3]);
                        *(u32x4*)(rowp + bj * HALF) = w; } }
        } else if (wc == 0) {
#pragma unroll
            for (int ai = 0; ai < 2; ++ai)
#pragma unroll
                for (int m = 0; m < 4; ++m) { const int row = row0 + ai * HALF + m * 16; const float r = rstd[row]; float* p = Ps + (size_t)row * 32 + 8 * fq;
                    *(f32x4*)p = acc[ai][0][m][0] * r; *(f32x4*)(p + 4) = acc[ai][0][m][1] * r; }
        }
    }
};
struct EpiX {
    static constexpr bool PERM = true, AFTER_DRAIN = false;
    const float* xres; float* xout; bf16_t* xb; float* ssp;
    __device__ __forceinline__ void operator()(const f32x4 (&acc)[2][2][4][2], const Unit& u, int wr, int wc, int fr, int fq) const {
        const int row0 = u.pm * BM + wr * 64 + fr, col0 = u.pn * BM + wc * 32 + 8 * fq;
#pragma unroll
        for (int ai = 0; ai < 2; ++ai)
#pragma unroll
            for (int m = 0; m < 4; ++m) { const int row = row0 + ai * HALF + m * 16; float ss = 0.f;
#pragma unroll
                for (int bj = 0; bj < 2; ++bj) { const size_t off = (size_t)row * 2048 + col0 + bj * HALF;
                    const f32x4 r0 = *(const f32x4*)(xres + off), r1 = *(const f32x4*)(xres + off + 4);
                    const f32x4 v0 = acc[ai][bj][m][0] + r0, v1 = acc[ai][bj][m][1] + r1;
                    *(f32x4*)(xout + off) = v0; *(f32x4*)(xout + off + 4) = v1;
                    u32x4 w; w.x = cvt_pk_bf16(v0[0], v0[1]); w.y = cvt_pk_bf16(v0[2], v0[3]); w.z = cvt_pk_bf16(v1[0], v1[1]); w.w = cvt_pk_bf16(v1[2], v1[3]);
                    *(u32x4*)(xb + off) = w;
                    ss += (v0[0] * v0[0] + v0[1] * v0[1]) + (v0[2] * v0[2] + v0[3] * v0[3]) + (v1[0] * v1[0] + v1[1] * v1[1]) + (v1[2] * v1[2] + v1[3] * v1[3]); }
                ss += __shfl_xor(ss, 16); ss += __shfl_xor(ss, 32);
                if (fq == 0) ssp[(size_t)row * 32 + u.pn * 4 + wc] = ss; }
    }
};
struct EpiQ {
    static constexpr bool PERM = true, AFTER_DRAIN = false;
    bf16_t* Q; const float* ssp;
    __device__ __forceinline__ void operator()(const f32x4 (&acc)[2][2][4][2], const Unit& u, int wr, int wc, int fr, int fq) const {
        const int row0 = u.pm * BM + wr * 64 + fr, col0 = u.pn * BM + wc * 32 + 8 * fq;
#pragma unroll
        for (int ai = 0; ai < 2; ++ai)
#pragma unroll
            for (int m = 0; m < 4; ++m) { const int row = row0 + ai * HALF + m * 16;
                const f32x4* sp = (const f32x4*)(ssp + (size_t)row * 32 + 8 * fq); const f32x4 a = sp[0], b = sp[1];
                float s = ((a[0] + a[1]) + (a[2] + a[3])) + ((b[0] + b[1]) + (b[2] + b[3]));
                s += __shfl_xor(s, 16); s += __shfl_xor(s, 32);
                const float r = rsqrtf(s * (1.0f / 2048.0f) + 1e-6f); bf16_t* rowp = Q + (size_t)row * 2048 + col0;
#pragma unroll
                for (int bj = 0; bj < 2; ++bj) { const f32x4 v0 = acc[ai][bj][m][0] * r, v1 = acc[ai][bj][m][1] * r;
                    u32x4 w; w.x = cvt_pk_bf16(v0[0], v0[1]); w.y = cvt_pk_bf16(v0[2], v0[3]); w.z = cvt_pk_bf16(v1[0], v1[1]); w.w = cvt_pk_bf16(v1[2], v1[3]);
                    *(u32x4*)(rowp + bj * HALF) = w; } }
    }
};

template <class Epi, class Sched, bool ALIGN_EPI = false, bool SP2 = false>
__device__ __forceinline__ void gemm_phase(PG8_LAS unsigned char* lds, const Gemm g, const Sched& S, const Epi& E) {
    const int tid = fresh_tid(), wid = __builtin_amdgcn_readfirstlane(tid >> 6), lane = tid & 63, wr = wid >> 2, wc = wid & 3, fr = lane & 15, fq = lane >> 4;
    const int K = g.K, nt = K / BK;
    unsigned voffA[2], voffB[2];
#pragma unroll
    for (int i = 0; i < 2; ++i) { int R, C; stage_rc(tid * 16 + i * 8192, R, C); const int Rb = Epi::PERM ? ((R & ~31) + perm32(R & 31)) : R;
        voffA[i] = (unsigned)(R * K + C) * 2u; voffB[i] = (unsigned)(Rb * K + C) * 2u; }
    const size_t kstep = (size_t)(BK * 2);
    const size_t hstep = (size_t)HALF * K * 2;
    const size_t tstep = 2 * hstep;
    const unsigned ldsw = (unsigned)wid * 1024u;
    const int aoff = lds_byte(wr * 64 + fr, fq * 8), boff = lds_byte(wc * 32 + fr, fq * 8);
#define PG8_SA(b, h) (((b) * 2 + (h)) * HTB)
#define PG8_SB(b, h) ((4 + (b) * 2 + (h)) * HTB)
#define PG8_STAGE(bufoff, gbase, voff) do { _Pragma("unroll") for (int _i = 0; _i < 2; ++_i) \
        __builtin_amdgcn_global_load_lds((const unsigned*)((const char*)(gbase) + (voff)[_i]), (PG8_LAS unsigned*)(lds + (bufoff) + ldsw + _i * 8192), 16, 0, 0); } while (0)
#define PG8_LDA(dst, b, h) do { _Pragma("unroll") for (int m = 0; m < 4; ++m) _Pragma("unroll") for (int k = 0; k < 2; ++k) dst[m][k] = *(const PG8_LAS bf16x8*)(lds + PG8_SA(b, h) + aoff + m * 2048 + k * 1024); } while (0)
#define PG8_LDB(dst, b, h) do { _Pragma("unroll") for (int n = 0; n < 2; ++n) _Pragma("unroll") for (int k = 0; k < 2; ++k) dst[n][k] = *(const PG8_LAS bf16x8*)(lds + PG8_SB(b, h) + boff + n * 2048 + k * 1024); } while (0)
#define PG8_MMA(ai, bj, At, Bt) do { __builtin_amdgcn_s_setprio(1); _Pragma("unroll") for (int m = 0; m < 4; ++m) _Pragma("unroll") for (int n = 0; n < 2; ++n) _Pragma("unroll") for (int k = 0; k < 2; ++k) \
        acc[ai][bj][m][n] = __builtin_amdgcn_mfma_f32_16x16x32_bf16(Bt[n][k], At[m][k], acc[ai][bj][m][n], 0, 0, 0); __builtin_amdgcn_s_setprio(0); } while (0)
#define PG8_WAIT_V(n) asm volatile("s_waitcnt vmcnt(" #n ")" ::: "memory")
#define PG8_WAIT_L(n) asm volatile("s_waitcnt lgkmcnt(" #n ")" ::: "memory")
#define PG8_BAR __builtin_amdgcn_s_barrier()
#define PG8_SCHED __builtin_amdgcn_sched_barrier(0)
    Unit cur, nxt; int ui = 0;
    if (!S.next(0, cur)) return;
    f32x4 acc[2][2][4][2];
#pragma unroll
    for (int a = 0; a < 2; ++a)
#pragma unroll
        for (int b = 0; b < 2; ++b)
#pragma unroll
            for (int m = 0; m < 4; ++m)
#pragma unroll
                for (int n = 0; n < 2; ++n) acc[a][b][m][n] = (f32x4){0.f, 0.f, 0.f, 0.f};
    bf16x8 At[4][2], B0[2][2], B1[2][2];
    const char* cA = (const char*)g.A + (size_t)cur.pm * tstep; const char* cB = (const char*)g.Bt + (size_t)cur.pn * tstep;
    S.a_ready(cur);
    if constexpr (SP2) {
        PG8_STAGE(PG8_SB(0, 0), cB, voffB); PG8_STAGE(PG8_SB(0, 1), cB + hstep, voffB); PG8_STAGE(PG8_SA(0, 0), cA, voffA); PG8_STAGE(PG8_SA(0, 1), cA + hstep, voffA);
        if (wr == 1) PG8_BAR;
        PG8_WAIT_V(2); PG8_BAR;
        PG8_STAGE(PG8_SB(1, 0), cB + kstep, voffB); PG8_STAGE(PG8_SA(1, 0), cA + kstep, voffA); PG8_STAGE(PG8_SB(1, 1), cB + hstep + kstep, voffB);
        PG8_WAIT_V(6); PG8_BAR;
    } else {
        PG8_STAGE(PG8_SB(0, 0), cB, voffB); PG8_STAGE(PG8_SA(0, 0), cA, voffA); PG8_STAGE(PG8_SB(0, 1), cB + hstep, voffB); PG8_STAGE(PG8_SA(0, 1), cA + hstep, voffA);
        if (wr == 1) PG8_BAR;
        PG8_WAIT_V(4); PG8_BAR;
        PG8_STAGE(PG8_SB(1, 0), cB + kstep, voffB); PG8_STAGE(PG8_SA(1, 0), cA + kstep, voffA); PG8_STAGE(PG8_SB(1, 1), cB + hstep + kstep, voffB);
        PG8_WAIT_V(6); PG8_BAR;
    }
    for (;;) {
        const bool has_next = S.next(ui + 1, nxt);
        const char* nA = has_next ? (const char*)g.A + (size_t)nxt.pm * tstep : cA; const char* nB = has_next ? (const char*)g.Bt + (size_t)nxt.pn * tstep : cB;
        for (int t = 0; t < nt; t += 2) {
            const bool last = (t == nt - 2);
            const char* a1 = cA + (size_t)(t + 1) * kstep;
            const char* a2 = last ? nA : cA + (size_t)(t + 2) * kstep; const char* b2 = last ? nB : cB + (size_t)(t + 2) * kstep;
            const char* a3 = a2 + kstep; const char* b3 = b2 + kstep;
            if (last && has_next) S.a_ready(nxt);
            if constexpr (SP2) {
            PG8_LDB(B0, 0, 0); PG8_LDB(B1, 0, 1); PG8_SCHED; PG8_LDA(At, 0, 0); PG8_STAGE(PG8_SA(1, 1), a1 + hstep, voffA);
            PG8_WAIT_V(8); PG8_WAIT_L(0); PG8_BAR; PG8_MMA(0, 0, At, B0); PG8_MMA(0, 1, At, B1); PG8_BAR; PG8_SCHED;
            PG8_LDA(At, 0, 1); PG8_STAGE(PG8_SB(0, 0), b2, voffB); PG8_STAGE(PG8_SB(0, 1), b2 + hstep, voffB); PG8_STAGE(PG8_SA(0, 0), a2, voffA);
            PG8_WAIT_V(8); PG8_WAIT_L(0); PG8_BAR; PG8_MMA(1, 0, At, B0); PG8_MMA(1, 1, At, B1); PG8_BAR; PG8_SCHED;
            PG8_LDB(B0, 1, 0); PG8_LDB(B1, 1, 1); PG8_SCHED; PG8_LDA(At, 1, 0); PG8_STAGE(PG8_SA(0, 1), a2 + hstep, voffA);
            PG8_WAIT_V(8); PG8_WAIT_L(0); PG8_BAR; PG8_MMA(0, 0, At, B0); PG8_MMA(0, 1, At, B1); PG8_BAR; PG8_SCHED;
            PG8_LDA(At, 1, 1); PG8_STAGE(PG8_SB(1, 0), b3, voffB); PG8_STAGE(PG8_SB(1, 1), b3 + hstep, voffB); PG8_STAGE(PG8_SA(1, 0), a3, voffA);
            PG8_WAIT_V(8); PG8_WAIT_L(0); PG8_BAR; PG8_MMA(1, 0, At, B0); PG8_MMA(1, 1, At, B1); PG8_BAR; PG8_SCHED;
            } else {
            PG8_LDB(B0, 0, 0); PG8_SCHED; PG8_LDA(At, 0, 0); PG8_STAGE(PG8_SA(1, 1), a1 + hstep, voffA);
            PG8_WAIT_L(8); PG8_BAR; PG8_WAIT_L(0); PG8_MMA(0, 0, At, B0); PG8_BAR; PG8_SCHED;
            PG8_LDB(B1, 0, 1); PG8_STAGE(PG8_SB(0, 0), b2, voffB);
            PG8_BAR; PG8_WAIT_L(0); PG8_MMA(0, 1, At, B1); PG8_BAR;
            PG8_LDA(At, 0, 1); PG8_STAGE(PG8_SA(0, 0), a2, voffA);
            PG8_BAR; PG8_WAIT_L(0); PG8_MMA(1, 0, At, B0); PG8_BAR; PG8_SCHED;
            PG8_STAGE(PG8_SB(0, 1), b2 + hstep, voffB);
            PG8_WAIT_V(6); PG8_BAR; PG8_MMA(1, 1, At, B1); PG8_BAR;
            PG8_LDB(B0, 1, 0); PG8_SCHED; PG8_LDA(At, 1, 0); PG8_STAGE(PG8_SA(0, 1), a2 + hstep, voffA);
            PG8_WAIT_L(8); PG8_BAR; PG8_WAIT_L(0); PG8_MMA(0, 0, At, B0); PG8_BAR; PG8_SCHED;
            PG8_LDB(B1, 1, 1); PG8_STAGE(PG8_SB(1, 0), b3, voffB);
            PG8_BAR; PG8_WAIT_L(0); PG8_MMA(0, 1, At, B1); PG8_BAR;
            PG8_LDA(At, 1, 1); PG8_STAGE(PG8_SA(1, 0), a3, voffA);
            PG8_BAR; PG8_WAIT_L(0); PG8_MMA(1, 0, At, B0); PG8_BAR; PG8_SCHED;
            PG8_STAGE(PG8_SB(1, 1), b3 + hstep, voffB);
            PG8_WAIT_V(6); PG8_BAR; PG8_MMA(1, 1, At, B1); PG8_BAR;
            }
        }
        if constexpr (ALIGN_EPI) { if (wr == 0) PG8_BAR; }
        if constexpr (!Epi::AFTER_DRAIN) { E(acc, cur, wr, wc, fr, fq); S.done(cur); }
        if (!has_next) break;
#pragma unroll
        for (int a = 0; a < 2; ++a)
#pragma unroll
            for (int b = 0; b < 2; ++b)
#pragma unroll
                for (int m = 0; m < 4; ++m)
#pragma unroll
                    for (int n = 0; n < 2; ++n) acc[a][b][m][n] = (f32x4){0.f, 0.f, 0.f, 0.f};
        cur = nxt; cA = nA; cB = nB; ++ui;
        if constexpr (ALIGN_EPI) { if (wr == 1) PG8_BAR; }
    }
    PG8_WAIT_V(0);
    if constexpr (!ALIGN_EPI) { if (wr == 0) PG8_BAR; }
    PG8_BAR;
    if constexpr (Epi::AFTER_DRAIN) { E.fused(acc, cur, wr, wc, fr, fq, lds, wid, lane); S.done(cur); }
#undef PG8_SA
#undef PG8_SB
#undef PG8_STAGE
#undef PG8_LDA
#undef PG8_LDB
#undef PG8_MMA
#undef PG8_WAIT_V
#undef PG8_WAIT_L
#undef PG8_BAR
#undef PG8_SCHED
}
}

constexpr int NWAVES = 8, NTHREADS = 512;
constexpr int NT = 8192, DM = 2048, SEQ = 2048, NBATCH = 4, DEPTH = 2, CHK = 64, NCHK = 32, GW = 512, NH = 4, HD = 128;
constexpr int DIN = 7200, NINP = 7424, PBW = 7168;
constexpr int NEXP = 16384;
constexpr int PC_GLA_Q = 0, PC_GLA_K = 512, PC_GLA_V = 1024, PC_GLA_G = 1536, PC_LRU_X = 2048, PC_LRU_Y = 2560, PC_ML_Q = 3072, PC_ML_K = 3584, PC_ML_V = 4096, PC_ML_O = 4608,
              PC_GDN_Q = 5120, PC_GDN_K = 5632, PC_GDN_V = 6144, PC_GDN_G = 6656;
constexpr int PS_LR = 0, PS_MI = 16, PS_MF = 20, PS_GB = 24, PS_GA = 28;
constexpr float RMS_EPS = 1e-6f;
enum { I_X = 0, I_N1G, I_WIN, I_WOUT, I_GLA_W2, I_GLA_B2, I_GLA_NG, I_LRU_CW, I_LRU_CB, I_LRU_WA, I_LRU_BA, I_LRU_WX, I_LRU_BX, I_LRU_LAM, I_ML_IB, I_ML_FB, I_ML_NG,
       I_GDN_CW, I_GDN_ALOG, I_GDN_DTB, I_GDN_NG, I_N2G, I_PWQ, I_PK1, I_PK2, I_PU, I_PV, I_FNG, N_IN };

constexpr size_t MiB = 1u << 20;
constexpr size_t WS_CTL = 0, CTL_ZERO_BYTES = 1 * MiB;
constexpr size_t WS_WIN = 2 * MiB;
constexpr size_t WIN_L = (size_t)NINP * DM * 2;
constexpr size_t WS_WOUT = 60 * MiB;
constexpr size_t WS_WQ = 76 * MiB;
constexpr size_t WSQ_L = (size_t)DM * DM * 2;
constexpr size_t WS_K1 = 92 * MiB, WS_K2 = 92 * MiB + 512 * 1024;
constexpr size_t WS_RSTD1 = 93 * MiB;
constexpr size_t WS_SSP = 94 * MiB;
constexpr size_t WS_XB = 96 * MiB;
constexpr size_t WS_P = 128 * MiB;
constexpr size_t WS_PS = 240 * MiB;
constexpr size_t WS_MIX = 242 * MiB;
constexpr size_t WS_Q = 274 * MiB;
constexpr size_t WS_UB = 306 * MiB;
constexpr size_t WS_VB = 434 * MiB;
constexpr size_t TAB_L = (size_t)NEXP * DM * 2;
constexpr size_t WS_SCR = 562 * MiB;
constexpr size_t WS_END = 900 * MiB;

constexpr int LDS_BYTES = 155648;
constexpr int MISC_OFF = LDS_BYTES - 256;

#define GAS __attribute__((address_space(1)))
#define LAS __attribute__((address_space(3)))
typedef unsigned short bf16;
typedef unsigned v4u __attribute__((ext_vector_type(4)));
typedef unsigned v2u __attribute__((ext_vector_type(2)));
typedef float f32x4 __attribute__((ext_vector_type(4)));
typedef float f32x2 __attribute__((ext_vector_type(2)));
typedef short bf16x8 __attribute__((ext_vector_type(8)));
typedef short bf16x4 __attribute__((ext_vector_type(4)));
typedef __bf16 bf2_t __attribute__((ext_vector_type(2)));
typedef GAS unsigned gu32;
#define RLX_AGENT __ATOMIC_RELAXED, __HIP_MEMORY_SCOPE_AGENT
__device__ __forceinline__ unsigned f2bf(float f) { unsigned u = __builtin_bit_cast(unsigned, f); return (u + 0x7fffu + ((u >> 16) & 1u)) >> 16; }
__device__ __forceinline__ unsigned pk2(float lo, float hi) { return f2bf(lo) | (f2bf(hi) << 16); }
__device__ __forceinline__ float bf2f(unsigned b) { return __builtin_bit_cast(float, b << 16); }
__device__ __forceinline__ float bflo(unsigned w) { return __builtin_bit_cast(float, w << 16); }
__device__ __forceinline__ float bfhi(unsigned w) { return __builtin_bit_cast(float, w & 0xffff0000u); }
template <int CTRL> __device__ __forceinline__ unsigned dpp_rot_u(unsigned v) { return (unsigned)__builtin_amdgcn_update_dpp(0, (int)v, CTRL, 0xf, 0xf, false); }
__device__ __forceinline__ unsigned row_max_u(unsigned v) { v = max(v, dpp_rot_u<0x121>(v)); v = max(v, dpp_rot_u<0x122>(v)); v = max(v, dpp_rot_u<0x124>(v)); v = max(v, dpp_rot_u<0x128>(v)); return v; }
template <int CTRL> __device__ __forceinline__ float dpp_rotf(float v) { const unsigned u = __builtin_bit_cast(unsigned, v); return __builtin_bit_cast(float, dpp_rot_u<CTRL>(u)); }
__device__ __forceinline__ float row_max_f(float v) { v = fmaxf(v, dpp_rotf<0x121>(v)); v = fmaxf(v, dpp_rotf<0x122>(v)); v = fmaxf(v, dpp_rotf<0x124>(v)); v = fmaxf(v, dpp_rotf<0x128>(v)); return v; }
__device__ __forceinline__ float row_sum_f(float v) { v += dpp_rotf<0x121>(v); v += dpp_rotf<0x122>(v); v += dpp_rotf<0x124>(v); v += dpp_rotf<0x128>(v); return v; }

__device__ __forceinline__ float oct_sum_f(float v) { v += dpp_rotf<0xB1>(v); v += dpp_rotf<0x4E>(v); v += dpp_rotf<0x141>(v); return v; }
__device__ __forceinline__ float lane_bcast(float v, int l) { return __builtin_bit_cast(float, __builtin_amdgcn_readlane(__builtin_bit_cast(int, v), l)); }
__device__ __forceinline__ float wave_sum(float v) { const float r = row_sum_f(v); return (lane_bcast(r, 0) + lane_bcast(r, 16)) + (lane_bcast(r, 32) + lane_bcast(r, 48)); }
__device__ __forceinline__ float wave_max(float v) { const float r = row_max_f(v); return fmaxf(fmaxf(lane_bcast(r, 0), lane_bcast(r, 16)), fmaxf(lane_bcast(r, 32), lane_bcast(r, 48))); }
__device__ __forceinline__ float rcpf_(float x) { return __builtin_amdgcn_rcpf(x); }
__device__ __forceinline__ float sigmoidf_(float x) { return rcpf_(1.0f + __expf(-x)); }
__device__ __forceinline__ float siluf_(float x) { return x * rcpf_(1.0f + __expf(-x)); }
__device__ __forceinline__ float softplusf_(float x) { return fmaxf(x, 0.f) + __logf(1.0f + __expf(-fabsf(x))); }
__device__ __forceinline__ float logsigmoidf_(float x) { return fminf(x, 0.f) - __logf(1.0f + __expf(-fabsf(x))); }
__device__ __forceinline__ float gelu_tanh(float x) { const float u = 1.5957691216057308f * (x + 0.044715f * x * x * x); return x * rcpf_(1.0f + __expf(-u)); }

#define XB_TMO      128
#define XB_XCNT(j)  (256  + 64 * (j))
#define XB_XSUB(j)  (1280 + 64 * (j))
#define XB_XGEN(j)  (2304 + 64 * (j))
#define XB_TOP      3328
#define XB_TOPGEN   3392
#define XCD_BAR_WORDS 3456
#define XB_SPIN_CAP (1u << 18)

__device__ __forceinline__ unsigned xb_ld(unsigned* p)              { return __hip_atomic_load(p, __ATOMIC_RELAXED, __HIP_MEMORY_SCOPE_AGENT); }
__device__ __forceinline__ unsigned xb_add(unsigned* p, unsigned v) { return __hip_atomic_fetch_add(p, v, __ATOMIC_RELAXED, __HIP_MEMORY_SCOPE_AGENT); }
__device__ __forceinline__ unsigned xb_xcc_id() { return (unsigned)__builtin_amdgcn_s_getreg((3 << 11) | 20) & 0xFu; }
#define XB_SPIN(cond, bar) do { unsigned _sp = 0; while (cond) { __builtin_amdgcn_s_sleep(1); \
    if ((++_sp & 255u) == 0u) { if (xb_ld(&(bar)[XB_TMO])) break; if (_sp > XB_SPIN_CAP) { atomicAdd(&(bar)[XB_TMO], 1u); break; } } } } while (0)

struct XcdBarrier {
    unsigned* bar; unsigned x;
    volatile LAS unsigned* st;
};

__device__ __forceinline__ XcdBarrier xcd_barrier_post(unsigned* bar, volatile LAS unsigned* st) {
    XcdBarrier b; b.bar = bar; b.x = xb_xcc_id(); b.st = st;
    if (threadIdx.x == 0) (void)xb_add(&bar[XB_XCNT(b.x)], 1u);
    return b;
}
__device__ __forceinline__ void xcd_barrier_complete(unsigned* bar, unsigned x, unsigned& nloc, unsigned& nx) {
    const unsigned G = gridDim.x * gridDim.y * gridDim.z;
    unsigned sum, cnt, mine, sp = 0u;
    for (;;) {
        sum = 0u; cnt = 0u; mine = 0u;
#pragma unroll
        for (unsigned j = 0; j < 16; ++j) { const unsigned c = xb_ld(&bar[XB_XCNT(j)]); sum += c; cnt += (c > 0u) ? 1u : 0u; mine = (j == x) ? c : mine; }
        if (sum == G) break;
        __builtin_amdgcn_s_sleep(1);
        if ((++sp & 255u) == 0u) { if (xb_ld(&bar[XB_TMO])) break; if (sp > XB_SPIN_CAP) { atomicAdd(&bar[XB_TMO], 1u); break; } }
    }
    nloc = mine > 0u ? mine : 1u; nx = cnt > 0u ? cnt : 1u;
}

__device__ __forceinline__ void xcd_barrier(const XcdBarrier& b) {
    asm volatile("s_waitcnt vmcnt(0)" ::: "memory");
    __syncthreads();
    if (threadIdx.x == 0) {
        unsigned* bar = b.bar; asm volatile("" : "+s"(bar));
        __builtin_amdgcn_s_waitcnt(0);
        unsigned nloc = b.st[0], nx = b.st[1];
        if (nloc == 0u) { xcd_barrier_complete(bar, b.x, nloc, nx); b.st[0] = nloc; b.st[1] = nx; }
        const unsigned old = xb_add(&bar[XB_XSUB(b.x)], 1u);
        const unsigned gen = old / nloc;
        if (old + 1u == (gen + 1u) * nloc) {
            __builtin_amdgcn_fence(__ATOMIC_RELEASE, "agent");
            asm volatile("s_waitcnt vmcnt(0)" ::: "memory");
            const unsigned og = xb_add(&bar[XB_TOP], 1u);
            const unsigned tg = og / nx;
            if (og + 1u == (tg + 1u) * nx) xb_add(&bar[XB_TOPGEN], 1u);
            else XB_SPIN(xb_ld(&bar[XB_TOPGEN]) == tg, bar);
            __builtin_amdgcn_fence(__ATOMIC_ACQUIRE, "agent");
            xb_add(&bar[XB_XGEN(b.x)], 1u);
            asm volatile("s_waitcnt vmcnt(0)" ::: "memory");
        } else {
            XB_SPIN(xb_ld(&bar[XB_XGEN(b.x)]) == gen, bar);
            __builtin_amdgcn_fence(__ATOMIC_ACQUIRE, "agent");
            asm volatile("s_waitcnt vmcnt(0)" ::: "memory");
        }
    }
    __syncthreads();
}


struct Args { const float* in[N_IN]; float* out; unsigned char* ws; int ph_lo, ph_hi, li, pad; };
typedef const __attribute__((address_space(4))) Args& ArgsR;
__device__ __forceinline__ const __attribute__((address_space(4))) Args* kargs() { unsigned long long p = (unsigned long long)__builtin_amdgcn_kernarg_segment_ptr(); asm volatile("" : "+s"(p)); return (const __attribute__((address_space(4))) Args*)p; }

__device__ __forceinline__ int win_src_col(int n) {
    if (n < 2048) return n;
    if (n < 3072) return 2064 + (n - 2048);
    if (n < 5120) return 3088 + (n - 3072);
    if (n < 7168) return 5144 + (n - 5120);
    if (n < 7184) return 2048 + (n - 7168);
    if (n < 7192) return 5136 + (n - 7184);
    if (n < 7200) return n;
    return -1;
}
template <bool MAP>
__device__ __forceinline__ void p0_transpose_item(const float* W, int K, int Nsrc, int Ndst, const float* gain, bf16* WT, LAS float* scr, int item, int lane) {
    const int nblk = Ndst / 32, kb = item / nblk, nb = item % nblk, k0 = 64 * kb, n0 = 32 * nb;
    const int nn = n0 + (lane & 31); const int src = MAP ? win_src_col(nn) : nn;
    float tv[32];
#pragma unroll
    for (int i = 0; i < 32; ++i) { const int kk = 2 * i + (lane >> 5); tv[i] = (src >= 0) ? W[(size_t)(k0 + kk) * Nsrc + src] : 0.f; }
#pragma unroll
    for (int i = 0; i < 32; ++i) { const int kk = 2 * i + (lane >> 5); float v = tv[i]; if (gain) v *= gain[k0 + kk]; scr[kk * 33 + (lane & 31)] = v; }
    asm volatile("s_waitcnt lgkmcnt(0)" ::: "memory");
    const int c = lane & 7;
#pragma unroll
    for (int j = 0; j < 4; ++j) { const int n = (lane >> 3) + 8 * j; const LAS float* s = scr + (8 * c) * 33 + n;
        v4u o; o.x = pk2(s[0 * 33], s[1 * 33]); o.y = pk2(s[2 * 33], s[3 * 33]); o.z = pk2(s[4 * 33], s[5 * 33]); o.w = pk2(s[6 * 33], s[7 * 33]);
        *(GAS v4u*)(WT + (size_t)(n0 + n) * K + k0 + 8 * c) = o; }
    asm volatile("s_waitcnt lgkmcnt(0)" ::: "memory");
}
__device__ __forceinline__ void p0_convert(const float* src, bf16* dst, size_t n, size_t gtid, size_t gthreads) {
    for (size_t i = gtid * 8; i < n; i += gthreads * 8) {
        const f32x4 a = *(const GAS f32x4*)(src + i), b = *(const GAS f32x4*)(src + i + 4);
        v4u o; o.x = pk2(a[0], a[1]); o.y = pk2(a[2], a[3]); o.z = pk2(b[0], b[1]); o.w = pk2(b[2], b[3]);
        *(GAS v4u*)(dst + i) = o; }
}
__device__ __forceinline__ void p0_prologue(ArgsR A, LAS unsigned char* lds, int vcu, int G, int wave, int lane) {
    unsigned char* ws = A.ws;
    LAS float* scr = (LAS float*)(lds + wave * 16384);
    const int gw = vcu * NWAVES + wave, NGW = G * NWAVES;
    constexpr int I_IN = (DM / 64) * (NINP / 32), I_SQ = (DM / 64) * (DM / 32), I_LAYER = I_IN + 2 * I_SQ, NITEMS = DEPTH * I_LAYER;
    for (int it = gw; it < NITEMS; it += NGW) {
        const int l = it / I_LAYER; int r = it % I_LAYER;
        if (r < I_IN) { p0_transpose_item<true>(A.in[I_WIN] + (size_t)l * DM * DIN, DM, DIN, NINP, A.in[I_N1G] + l * DM, (bf16*)(ws + WS_WIN + l * WIN_L), scr, r, lane); continue; } r -= I_IN;
        if (r < I_SQ) { p0_transpose_item<false>(A.in[I_WOUT] + (size_t)l * DM * DM, DM, DM, DM, nullptr, (bf16*)(ws + WS_WOUT + l * WSQ_L), scr, r, lane); continue; } r -= I_SQ;
        p0_transpose_item<false>(A.in[I_PWQ] + (size_t)l * DM * DM, DM, DM, DM, A.in[I_N2G] + l * DM, (bf16*)(ws + WS_WQ + l * WSQ_L), scr, r, lane);
    }
    const size_t gtid = (size_t)gw * 64 + lane, gthreads = (size_t)NGW * 64;
    p0_convert(A.in[I_PK1], (bf16*)(ws + WS_K1), (size_t)DEPTH * 8 * 128 * 128, gtid, gthreads);
    p0_convert(A.in[I_PK2], (bf16*)(ws + WS_K2), (size_t)DEPTH * 8 * 128 * 128, gtid, gthreads);
    const float* x = A.in[I_X]; bf16* xb = (bf16*)(ws + WS_XB); float* rstd1 = (float*)(ws + WS_RSTD1);
    for (int m = gw; m < NT; m += NGW) {
        const GAS f32x4* xr = (const GAS f32x4*)(x + (size_t)m * DM) + lane;
        f32x4 v[8]; float s = 0.f;
#pragma unroll
        for (int j = 0; j < 8; ++j) { v[j] = xr[64 * j]; s += (v[j][0] * v[j][0] + v[j][1] * v[j][1]) + (v[j][2] * v[j][2] + v[j][3] * v[j][3]); }
        s = wave_sum(s);
        GAS v2u* o = (GAS v2u*)(xb + (size_t)m * DM) + lane;
#pragma unroll
        for (int j = 0; j < 8; ++j) { v2u w; w.x = pk2(v[j][0], v[j][1]); w.y = pk2(v[j][2], v[j][3]); o[64 * j] = w; }
        if (lane == 0) rstd1[m] = rsqrtf(s * (1.0f / DM) + RMS_EPS);
    }
}

constexpr size_t WS_GLA_INC = 562 * MiB;
constexpr size_t WS_GLA_DEC = 594 * MiB;
constexpr size_t WS_GLA_ST = 595 * MiB;
constexpr size_t WS_ML_INC = 611 * MiB;
constexpr size_t WS_ML_N = 643 * MiB;
constexpr size_t WS_ML_SC = 643 * MiB + 512 * 1024;
constexpr size_t WS_ML_ST = 644 * MiB;
constexpr size_t WS_ML_NP = 660 * MiB;
constexpr size_t WS_ML_MP = 660 * MiB + 512 * 1024;
constexpr size_t WS_GDN_U0 = 661 * MiB, WS_GDN_W = 669 * MiB, WS_GDN_QD = 677 * MiB, WS_GDN_KE = 685 * MiB;
constexpr size_t WS_GDN_QK = 693 * MiB;
constexpr size_t WS_GDN_DE = 697 * MiB;
constexpr size_t WS_GDN_O = 698 * MiB;
constexpr size_t WS_LRU_HL = 714 * MiB, WS_LRU_AP = 730 * MiB;
constexpr size_t WS_LRU_CARRY = 746 * MiB;
static_assert(WS_LRU_CARRY + 4 * 32 * 512 * 4 <= WS_END, "ws map");

constexpr int CW_PBAR = 2048;
typedef short v4i16_t __attribute__((ext_vector_type(4)));
constexpr int LD128 = 136, LD64 = 72;

__device__ __forceinline__ bf16x8 frag_rd(const LAS bf16* t, int ld, int row0, int k0, int lane) { return *(const LAS bf16x8*)(t + (row0 + (lane & 15)) * ld + k0 + 8 * (lane >> 4)); }
__device__ __forceinline__ bf16x8 frag_rd_perm(const LAS bf16* t, int ld, int row0, int k0, int lane) {
    const LAS bf16* p = t + (row0 + (lane & 15)) * ld + k0 + 4 * (lane >> 4);
    const bf16x4 a = *(const LAS bf16x4*)p, b = *(const LAS bf16x4*)(p + 16);
    return (bf16x8){a[0], a[1], a[2], a[3], b[0], b[1], b[2], b[3]};
}
__device__ __forceinline__ bf16x8 frag_tr(const LAS bf16* t, int ld, int k0, int n0, int lane) {
    const int i = lane & 15, g = lane >> 4; const LAS bf16* p = t + (k0 + 8 * g + (i >> 2)) * ld + n0 + 4 * (i & 3);
    const v4i16_t a = __builtin_amdgcn_ds_read_tr16_b64_v4i16((LAS v4i16_t*)p), b = __builtin_amdgcn_ds_read_tr16_b64_v4i16((LAS v4i16_t*)(p + 4 * ld));
    return (bf16x8){a[0], a[1], a[2], a[3], b[0], b[1], b[2], b[3]};
}
__device__ __forceinline__ bf16x8 frag_tr_perm(const LAS bf16* t, int ld, int k0, int n0, int lane) {
    const int i = lane & 15, g = lane >> 4; const LAS bf16* p = t + (k0 + 4 * g + (i >> 2)) * ld + n0 + 4 * (i & 3);
    const v4i16_t a = __builtin_amdgcn_ds_read_tr16_b64_v4i16((LAS v4i16_t*)p), b = __builtin_amdgcn_ds_read_tr16_b64_v4i16((LAS v4i16_t*)(p + 16 * ld));
    return (bf16x8){a[0], a[1], a[2], a[3], b[0], b[1], b[2], b[3]};
}
__device__ __forceinline__ bf16x8 pack_acc(const f32x4& lo, const f32x4& hi) {
    v4u w; w.x = pg8::cvt_pk_bf16(lo[0], lo[1]); w.y = pg8::cvt_pk_bf16(lo[2], lo[3]); w.z = pg8::cvt_pk_bf16(hi[0], hi[1]); w.w = pg8::cvt_pk_bf16(hi[2], hi[3]);
    return __builtin_bit_cast(bf16x8, w);
}
#define MFMA16(a, b, c) __builtin_amdgcn_mfma_f32_16x16x32_bf16((a), (b), (c), 0, 0, 0)

template <int ROWS>
__device__ __forceinline__ void tile_g2l_128(const bf16* g, size_t gld, LAS bf16* t, int tid) {
#pragma unroll
    for (int i = 0; i < ROWS * 16 / NTHREADS; ++i) { const int idx = tid + i * NTHREADS, r = idx >> 4, c8 = (idx & 15) * 8;
        *(LAS v4u*)(t + r * LD128 + c8) = *(const GAS v4u*)(g + (size_t)r * gld + c8); }
}
template <int CTRL> __device__ __forceinline__ float dpp_shr_f(float v, float ident) { return __builtin_bit_cast(float, __builtin_amdgcn_update_dpp(__builtin_bit_cast(int, ident), __builtin_bit_cast(int, v), CTRL, 0xf, 0xf, false)); }
__device__ __forceinline__ float wave_scan_add(float v, int lane) {
    v += dpp_shr_f<0x111>(v, 0.f); v += dpp_shr_f<0x112>(v, 0.f); v += dpp_shr_f<0x114>(v, 0.f); v += dpp_shr_f<0x118>(v, 0.f);
    const float t0 = lane_bcast(v, 15), t1 = lane_bcast(v, 31), t2 = lane_bcast(v, 47); const int row = lane >> 4;
    return v + (row == 0 ? 0.f : row == 1 ? t0 : row == 2 ? t0 + t1 : (t0 + t1) + t2);
}
__device__ __forceinline__ float wave_scan_max(float v, int lane) {
    const float ninf = -__builtin_inff();
    v = fmaxf(v, dpp_shr_f<0x111>(v, ninf)); v = fmaxf(v, dpp_shr_f<0x112>(v, ninf)); v = fmaxf(v, dpp_shr_f<0x114>(v, ninf)); v = fmaxf(v, dpp_shr_f<0x118>(v, ninf));
    const float t0 = lane_bcast(v, 15), t1 = lane_bcast(v, 31), t2 = lane_bcast(v, 47); const int row = lane >> 4;
    return fmaxf(v, row == 0 ? ninf : row == 1 ? t0 : row == 2 ? fmaxf(t0, t1) : fmaxf(fmaxf(t0, t1), t2));
}

__device__ __forceinline__ void f_lru_p2(ArgsR A, int l, int item, LAS unsigned char* lds, int tid) {
    const int j = item & 7, n = (item >> 3) & 31, b = item >> 8;
    const bf16* P = (const bf16*)(A.ws + WS_P); float* HLg = (float*)(A.ws + WS_LRU_HL); float* APg = (float*)(A.ws + WS_LRU_AP);
    LAS float* xc = (LAS float*)(lds); LAS float* was = (LAS float*)(lds + 20480); LAS float* wxs = (LAS float*)(lds + 36864);
    LAS float* aa = (LAS float*)(lds + 53248); LAS float* uu = (LAS float*)(lds + 69632); LAS float* segA = (LAS float*)(lds + 86016); LAS float* segH = (LAS float*)(lds + 88064);
    const float* wa = A.in[I_LRU_WA] + ((size_t)l * 8 + j) * 4096; const float* wx = A.in[I_LRU_WX] + ((size_t)l * 8 + j) * 4096;
    for (int i = tid; i < 4096; i += NTHREADS) { was[i] = wa[i]; wxs[i] = wx[i]; }
    const float* cw = A.in[I_LRU_CW] + (size_t)l * 4 * GW; const float* cb = A.in[I_LRU_CB] + l * GW;
    const float* ba = A.in[I_LRU_BA] + l * GW + j * 64; const float* bx = A.in[I_LRU_BX] + l * GW + j * 64; const float* lam = A.in[I_LRU_LAM] + l * GW + j * 64;
    const size_t r0 = (size_t)b * SEQ + n * CHK;
    float ba8[8], bx8[8], lam8[8];
#pragma unroll
    for (int q = 0; q < 8; ++q) { ba8[q] = ba[(tid & 7) * 8 + q]; bx8[q] = bx[(tid & 7) * 8 + q]; lam8[q] = lam[(tid & 7) * 8 + q]; }
    { const int cc = tid & 63, c0 = (tid >> 6) * 8, ch = j * 64 + cc, pc = PC_LRU_X + ch; const long t0 = (long)n * CHK + c0;
        const float w0 = cw[ch], w1 = cw[GW + ch], w2 = cw[2 * GW + ch], w3 = cw[3 * GW + ch], bias = cb[ch];
        float xm3 = (t0 - 3 >= 0) ? bf2f(P[(r0 + c0 - 3) * PBW + pc]) : 0.f, xm2 = (t0 - 2 >= 0) ? bf2f(P[(r0 + c0 - 2) * PBW + pc]) : 0.f, xm1 = (t0 - 1 >= 0) ? bf2f(P[(r0 + c0 - 1) * PBW + pc]) : 0.f;
#pragma unroll
        for (int i = 0; i < 8; ++i) { const float x0 = bf2f(P[(r0 + c0 + i) * PBW + pc]); xc[(c0 + i) * 65 + cc] = w0 * xm3 + w1 * xm2 + w2 * xm1 + w3 * x0 + bias; xm3 = xm2; xm2 = xm1; xm1 = x0; } }
    __syncthreads();
    { const int tok = tid >> 3, cg = tid & 7; float ra[8], ri[8], spl[8];
#pragma unroll
        for (int q = 0; q < 8; ++q) { ra[q] = ba8[q]; ri[q] = bx8[q]; spl[q] = softplusf_(-lam8[q]); }
#pragma unroll 4
        for (int i = 0; i < 64; ++i) { const float xv = xc[tok * 65 + i];
            const f32x4 a0 = *(const LAS f32x4*)(was + i * 64 + cg * 8), a1 = *(const LAS f32x4*)(was + i * 64 + cg * 8 + 4);
            const f32x4 x0 = *(const LAS f32x4*)(wxs + i * 64 + cg * 8), x1 = *(const LAS f32x4*)(wxs + i * 64 + cg * 8 + 4);
#pragma unroll
            for (int q = 0; q < 4; ++q) { ra[q] += xv * a0[q]; ra[4 + q] += xv * a1[q]; ri[q] += xv * x0[q]; ri[4 + q] += xv * x1[q]; } }
#pragma unroll
        for (int q = 0; q < 8; ++q) { const int jj = cg * 8 + q; const float r = sigmoidf_(ra[q]), ig = sigmoidf_(ri[q]);
            const float log_a = -8.0f * r * spl[q]; const float a = __expf(log_a), u = sqrtf(fmaxf(1.0f - a * a, 0.f)) * (ig * xc[tok * 65 + jj]);
            aa[tok * 64 + jj] = a; uu[tok * 64 + jj] = u; } }
    __syncthreads();
    const int cc = tid & 63, seg = tid >> 6;
    { float Ap = 1.f, Hl = 0.f;
#pragma unroll
        for (int i = 0; i < 8; ++i) { const int c = seg * 8 + i; const float a = aa[c * 64 + cc], u = uu[c * 64 + cc]; Hl = a * Hl + u; Ap *= a; aa[c * 64 + cc] = Ap; uu[c * 64 + cc] = Hl; }
        segA[seg * 64 + cc] = Ap; segH[seg * 64 + cc] = Hl; }
    __syncthreads();
    { float Ac = 1.f, Hc = 0.f;
#pragma unroll 1
        for (int s = 0; s < seg; ++s) { const float sa = segA[s * 64 + cc]; Hc = sa * Hc + segH[s * 64 + cc]; Ac *= sa; }
#pragma unroll
        for (int i = 0; i < 8; ++i) { const int c = seg * 8 + i; const float ap = aa[c * 64 + cc], hl = uu[c * 64 + cc];
            HLg[(r0 + c) * GW + j * 64 + cc] = ap * Hc + hl; APg[(r0 + c) * GW + j * 64 + cc] = ap * Ac; } }
    __syncthreads();
}
__device__ __forceinline__ void f_lru_p3(ArgsR A, int b, int tid) {
    const float* HLg = (const float*)(A.ws + WS_LRU_HL); const float* APg = (const float*)(A.ws + WS_LRU_AP); float* carry = (float*)(A.ws + WS_LRU_CARRY);
    float c = 0.f;
#pragma unroll 8
    for (int n = 0; n < NCHK; ++n) { carry[((size_t)b * NCHK + n) * GW + tid] = c; const size_t t = (size_t)b * SEQ + n * CHK + 63; c = APg[t * GW + tid] * c + HLg[t * GW + tid]; }
}
__device__ __forceinline__ void f_lru_p4(ArgsR A, int item, int tid) {
    const bf16* P = (const bf16*)(A.ws + WS_P); bf16* mix = (bf16*)(A.ws + WS_MIX);
    const float* HLg = (const float*)(A.ws + WS_LRU_HL); const float* APg = (const float*)(A.ws + WS_LRU_AP); const float* carry = (const float*)(A.ws + WS_LRU_CARRY);
    const float cr = carry[(size_t)item * GW + tid]; const size_t r0 = (size_t)item * CHK;
#pragma unroll 8
    for (int c = 0; c < CHK; ++c) { const float h = APg[(r0 + c) * GW + tid] * cr + HLg[(r0 + c) * GW + tid]; const float y = bf2f(P[(r0 + c) * PBW + PC_LRU_Y + tid]);
        mix[(r0 + c) * DM + 512 + tid] = (bf16)f2bf(gelu_tanh(y) * h); }
}

constexpr int FL_Q = 0, FL_K = 17408, FL_V = 34816, FL_ST = 52224, FL_SC = 87040, FL_BC = 96256, FL_LR = 129024, FL_SEG = 133120, FL_RS = 135168;
struct GlaW2 { float w[16]; float b2; };
__device__ __forceinline__ void gla_w2_load(ArgsR A, int l, int h, int tid, GlaW2& W) {
    const int d = tid & 127; const float* w2 = A.in[I_GLA_W2] + (size_t)l * 16 * GW + h * HD + d;
#pragma unroll
    for (int r = 0; r < 16; ++r) W.w[r] = w2[r * GW];
    W.b2 = A.in[I_GLA_B2][l * GW + h * HD + d];
}
__device__ __forceinline__ void gla_bcum(const GlaW2& W, LAS float* bc, LAS float* segt, const LAS float* lrs, int tid) {
    const int d = tid & 127, seg = tid >> 7; float run = 0.f;
#pragma unroll 4
    for (int i = 0; i < 16; ++i) { const int c = seg * 16 + i; float z = W.b2;
#pragma unroll
        for (int r = 0; r < 16; ++r) z += lrs[c * 16 + r] * W.w[r];
        run += logsigmoidf_(z) * (1.0f / 16.0f); bc[c * 128 + d] = run; }
    segt[seg * 128 + d] = run;
}
__device__ __forceinline__ void f_gla_p2(ArgsR A, int l, int item, LAS unsigned char* lds, int tid) {
    const int n = item & 31, h = (item >> 5) & 3, b = item >> 7; const int lane = tid & 63, wave = __builtin_amdgcn_readfirstlane(tid >> 6);
    const bf16* P = (const bf16*)(A.ws + WS_P); const float* Ps = (const float*)(A.ws + WS_PS);
    float* inc = (float*)(A.ws + WS_GLA_INC) + (size_t)item * 16384; float* dec = (float*)(A.ws + WS_GLA_DEC) + (size_t)item * 128;
    LAS bf16* ks = (LAS bf16*)(lds + FL_K); LAS bf16* vs = (LAS bf16*)(lds + FL_V); LAS float* bc = (LAS float*)(lds + FL_BC); LAS float* lrs = (LAS float*)(lds + FL_LR); LAS float* segt = (LAS float*)(lds + FL_SEG);
    const size_t r0 = (size_t)b * SEQ + n * CHK;
    GlaW2 W2; gla_w2_load(A, l, h, tid, W2);
    tile_g2l_128<64>(P + r0 * PBW + PC_GLA_K + h * HD, PBW, ks, tid);
    tile_g2l_128<64>(P + r0 * PBW + PC_GLA_V + h * HD, PBW, vs, tid);
    for (int i = tid; i < 64 * 16; i += NTHREADS) lrs[i] = Ps[(r0 + (i >> 4)) * 32 + PS_LR + (i & 15)];
    __syncthreads();
    gla_bcum(W2, bc, segt, lrs, tid);
    __syncthreads();
    { const int d = tid & 127, seg = tid >> 7; float pre = 0.f, tot = 0.f;
#pragma unroll
        for (int s = 0; s < 4; ++s) { const float v = segt[s * 128 + d]; if (s < seg) pre += v; tot += v; }
#pragma unroll 4
        for (int i = 0; i < 16; ++i) { const int c = seg * 16 + i; const float bcm = bc[c * 128 + d] + pre; ks[c * LD128 + d] = (bf16)f2bf(bf2f(ks[c * LD128 + d]) * __expf(tot - bcm)); }
        if (seg == 0) dec[d] = __expf(tot); }
    __syncthreads();
    { f32x4 acc[8];
#pragma unroll
        for (int nt = 0; nt < 8; ++nt) acc[nt] = (f32x4){0.f, 0.f, 0.f, 0.f};
#pragma unroll
        for (int kk = 0; kk < 2; ++kk) { const bf16x8 af = frag_tr(vs, LD128, 32 * kk, 16 * wave, lane);
#pragma unroll
            for (int nt = 0; nt < 8; ++nt) acc[nt] = MFMA16(af, frag_tr(ks, LD128, 32 * kk, 16 * nt, lane), acc[nt]); }
        const int fr = lane & 15, fq = lane >> 4;
#pragma unroll
        for (int nt = 0; nt < 8; ++nt)
#pragma unroll
            for (int r = 0; r < 4; ++r) inc[(16 * wave + 4 * fq + r) * 128 + 16 * nt + fr] = acc[nt][r]; }
    __syncthreads();
}
__device__ __forceinline__ void f_gla_p3(ArgsR A, int item, int tid) {
    const int bh = item >> 4, sl = item & 15; const int e = sl * 1024 + tid * 2, d = e & 127;
    const float* inc = (const float*)(A.ws + WS_GLA_INC) + (size_t)bh * 32 * 16384 + e; const float* dec = (const float*)(A.ws + WS_GLA_DEC) + (size_t)bh * 32 * 128 + d;
    bf16* st = (bf16*)(A.ws + WS_GLA_ST) + (size_t)bh * 32 * 16384 + e;
    float s0 = 0.f, s1 = 0.f;
#pragma unroll 8
    for (int n = 0; n < NCHK; ++n) { *(GAS unsigned*)(st + (size_t)n * 16384) = pk2(s0, s1);
        const f32x2 iv = *(const GAS f32x2*)(inc + (size_t)n * 16384), dv = *(const GAS f32x2*)(dec + (size_t)n * 128); s0 = dv[0] * s0 + iv[0]; s1 = dv[1] * s1 + iv[1]; }
}
__device__ __forceinline__ void f_gla_p4(ArgsR A, int l, int item, LAS unsigned char* lds, int tid) {
    const int n = item & 31, h = (item >> 5) & 3, b = item >> 7; const int lane = tid & 63, wave = __builtin_amdgcn_readfirstlane(tid >> 6), fr = lane & 15, fq = lane >> 4;
    const bf16* P = (const bf16*)(A.ws + WS_P); const float* Ps = (const float*)(A.ws + WS_PS); bf16* mix = (bf16*)(A.ws + WS_MIX);
    const bf16* stg = (const bf16*)(A.ws + WS_GLA_ST) + (size_t)item * 16384;
    LAS bf16* qs = (LAS bf16*)(lds + FL_Q); LAS bf16* ks = (LAS bf16*)(lds + FL_K); LAS bf16* vs = (LAS bf16*)(lds + FL_V); LAS bf16* sts = (LAS bf16*)(lds + FL_ST); LAS bf16* scs = (LAS bf16*)(lds + FL_SC);
    LAS float* bc = (LAS float*)(lds + FL_BC); LAS float* lrs = (LAS float*)(lds + FL_LR); LAS float* segt = (LAS float*)(lds + FL_SEG); LAS float* rsp = (LAS float*)(lds + FL_RS);
    const size_t r0 = (size_t)b * SEQ + n * CHK;
    GlaW2 W2; gla_w2_load(A, l, h, tid, W2);
    const float gn = A.in[I_GLA_NG][l * GW + h * HD + 16 * wave + fr];
    float gt[4][4];
#pragma unroll
    for (int mt = 0; mt < 4; ++mt)
#pragma unroll
        for (int r = 0; r < 4; ++r) gt[mt][r] = bf2f(P[(r0 + 16 * mt + 4 * fq + r) * PBW + PC_GLA_G + h * HD + 16 * wave + fr]);
    tile_g2l_128<64>(P + r0 * PBW + PC_GLA_Q + h * HD, PBW, qs, tid);
    tile_g2l_128<64>(P + r0 * PBW + PC_GLA_K + h * HD, PBW, ks, tid);
    tile_g2l_128<64>(P + r0 * PBW + PC_GLA_V + h * HD, PBW, vs, tid);
    tile_g2l_128<128>(stg, 128, sts, tid);
    for (int i = tid; i < 64 * 16; i += NTHREADS) lrs[i] = Ps[(r0 + (i >> 4)) * 32 + PS_LR + (i & 15)];
    __syncthreads();
    gla_bcum(W2, bc, segt, lrs, tid);
    __syncthreads();
    { const int d = tid & 127, seg = tid >> 7; float pre = 0.f;
#pragma unroll
        for (int s = 0; s < 4; ++s) { const float v = segt[s * 128 + d]; if (s < seg) pre += v; }
#pragma unroll 4
        for (int i = 0; i < 16; ++i) { const int c = seg * 16 + i; const float bcm = bc[c * 128 + d] + pre;
            qs[c * LD128 + d] = (bf16)f2bf(bf2f(qs[c * LD128 + d]) * __expf(bcm) * 0.08838834764831845f); ks[c * LD128 + d] = (bf16)f2bf(bf2f(ks[c * LD128 + d]) * __expf(-bcm)); } }
    __syncthreads();
    { const int mt = wave >> 1; f32x4 acc[2] = {{0.f, 0.f, 0.f, 0.f}, {0.f, 0.f, 0.f, 0.f}};
#pragma unroll
        for (int kk = 0; kk < 4; ++kk) { const bf16x8 af = frag_rd(qs, LD128, 16 * mt, 32 * kk, lane);
#pragma unroll
            for (int q = 0; q < 2; ++q) acc[q] = MFMA16(af, frag_rd(ks, LD128, 16 * (2 * (wave & 1) + q), 32 * kk, lane), acc[q]); }
#pragma unroll
        for (int q = 0; q < 2; ++q) { const int s = 16 * (2 * (wave & 1) + q) + fr;
#pragma unroll
            for (int r = 0; r < 4; ++r) { const int c = 16 * mt + 4 * fq + r; scs[c * LD64 + s] = (bf16)f2bf(s <= c ? acc[q][r] : 0.f); } } }
    __syncthreads();
    f32x4 o[4];
#pragma unroll
    for (int mt = 0; mt < 4; ++mt) o[mt] = (f32x4){0.f, 0.f, 0.f, 0.f};
#pragma unroll
    for (int kk = 0; kk < 2; ++kk) { const bf16x8 bfv = frag_tr(vs, LD128, 32 * kk, 16 * wave, lane);
#pragma unroll
        for (int mt = 0; mt < 4; ++mt) o[mt] = MFMA16(frag_rd(scs, LD64, 16 * mt, 32 * kk, lane), bfv, o[mt]); }
#pragma unroll
    for (int kk = 0; kk < 4; ++kk) { const bf16x8 bfs = frag_rd(sts, LD128, 16 * wave, 32 * kk, lane);
#pragma unroll
        for (int mt = 0; mt < 4; ++mt) o[mt] = MFMA16(frag_rd(qs, LD128, 16 * mt, 32 * kk, lane), bfs, o[mt]); }
#pragma unroll
    for (int mt = 0; mt < 4; ++mt)
#pragma unroll
        for (int r = 0; r < 4; ++r) { float s = o[mt][r] * o[mt][r]; s = row_sum_f(s);
            if (fr == 0) rsp[wave * 64 + 16 * mt + 4 * fq + r] = s; }
    __syncthreads();
#pragma unroll
    for (int mt = 0; mt < 4; ++mt)
#pragma unroll
        for (int r = 0; r < 4; ++r) { const int c = 16 * mt + 4 * fq + r; float ss = 0.f;
#pragma unroll
            for (int w = 0; w < 8; ++w) ss += rsp[w * 64 + c];
            const float rs = rsqrtf(ss * (1.0f / 128.0f) + RMS_EPS);
            mix[(r0 + c) * DM + h * HD + 16 * wave + fr] = (bf16)f2bf(o[mt][r] * rs * gn * siluf_(gt[mt][r])); }
    __syncthreads();
}

constexpr int FM_Q2 = 96256, FM_S = 129024;
__device__ __forceinline__ void f_ml_p2(ArgsR A, int l, int item, LAS unsigned char* lds, int tid) {
    const int n = item & 31, h = (item >> 5) & 3, b = item >> 7; const int lane = tid & 63, wave = __builtin_amdgcn_readfirstlane(tid >> 6);
    const bf16* P = (const bf16*)(A.ws + WS_P); const float* Ps = (const float*)(A.ws + WS_PS);
    float* inc = (float*)(A.ws + WS_ML_INC) + (size_t)item * 16384; float* incn = (float*)(A.ws + WS_ML_N) + (size_t)item * 128; float* scg = (float*)(A.ws + WS_ML_SC) + (size_t)item * 2;
    LAS bf16* ks = (LAS bf16*)(lds + FL_K); LAS bf16* vs = (LAS bf16*)(lds + FL_V); LAS float* sc = (LAS float*)(lds + FM_S);
    const size_t r0 = (size_t)b * SEQ + n * CHK;
    tile_g2l_128<64>(P + r0 * PBW + PC_ML_K + h * HD, PBW, ks, tid);
    tile_g2l_128<64>(P + r0 * PBW + PC_ML_V + h * HD, PBW, vs, tid);
    if (wave == 0) { const float lf = logsigmoidf_(Ps[(r0 + lane) * 32 + PS_MF + h] + A.in[I_ML_FB][l * NH + h]), ig = Ps[(r0 + lane) * 32 + PS_MI + h] + A.in[I_ML_IB][l * NH + h];
        const float bcum = wave_scan_add(lf, lane), blast = lane_bcast(bcum, 63), le = blast - bcum + ig, mloc = wave_max(le);
        sc[lane] = __expf(le - mloc) * 0.08838834764831845f; if (lane == 0) { scg[0] = mloc; scg[1] = blast; } }
    __syncthreads();
#pragma unroll
    for (int i = 0; i < 2; ++i) { const int idx = tid + i * NTHREADS, r = idx >> 4, c8 = (idx & 15) * 8; const float w = sc[r];
        v4u x = *(LAS v4u*)(ks + r * LD128 + c8);
        x.x = pk2(bflo(x.x) * w, bfhi(x.x) * w); x.y = pk2(bflo(x.y) * w, bfhi(x.y) * w); x.z = pk2(bflo(x.z) * w, bfhi(x.z) * w); x.w = pk2(bflo(x.w) * w, bfhi(x.w) * w);
        *(LAS v4u*)(ks + r * LD128 + c8) = x; }
    __syncthreads();
    if (tid < 128) { float s = 0.f;
#pragma unroll 8
        for (int c = 0; c < 64; ++c) s += bf2f(ks[c * LD128 + tid]);
        incn[tid] = s; }
    { f32x4 acc[8];
#pragma unroll
        for (int nt = 0; nt < 8; ++nt) acc[nt] = (f32x4){0.f, 0.f, 0.f, 0.f};
#pragma unroll
        for (int kk = 0; kk < 2; ++kk) { const bf16x8 af = frag_tr(vs, LD128, 32 * kk, 16 * wave, lane);
#pragma unroll
            for (int nt = 0; nt < 8; ++nt) acc[nt] = MFMA16(af, frag_tr(ks, LD128, 32 * kk, 16 * nt, lane), acc[nt]); }
        const int fr = lane & 15, fq = lane >> 4;
#pragma unroll
        for (int nt = 0; nt < 8; ++nt)
#pragma unroll
            for (int r = 0; r < 4; ++r) inc[(16 * wave + 4 * fq + r) * 128 + 16 * nt + fr] = acc[nt][r]; }
    __syncthreads();
}
__device__ __forceinline__ void f_ml_p3(ArgsR A, int item, int tid) {
    const int bh = item >> 4, sl = item & 15; const int e = sl * 1024 + tid * 2;
    const float* inc = (const float*)(A.ws + WS_ML_INC) + (size_t)bh * 32 * 16384 + e; const float* incn = (const float*)(A.ws + WS_ML_N) + (size_t)bh * 32 * 128;
    const float* scg = (const float*)(A.ws + WS_ML_SC) + (size_t)bh * 32 * 2;
    bf16* st = (bf16*)(A.ws + WS_ML_ST) + (size_t)bh * 32 * 16384 + e; float* np = (float*)(A.ws + WS_ML_NP) + (size_t)bh * 32 * 128; float* mp = (float*)(A.ws + WS_ML_MP) + (size_t)bh * 32;
    float c0 = 0.f, c1 = 0.f, nv = 0.f, m = 0.f; const int dn = sl * 8 + tid;
#pragma unroll 4
    for (int n = 0; n < NCHK; ++n) {
        *(GAS unsigned*)(st + (size_t)n * 16384) = pk2(c0, c1);
        if (tid < 8) np[n * 128 + dn] = nv;
        if (sl == 0 && tid == 0) mp[n] = m;
        const float ml = scg[2 * n], bl = scg[2 * n + 1]; const float mn = fmaxf(bl + m, ml), ao = __expf(bl + m - mn), ai = __expf(ml - mn);
        const f32x2 iv = *(const GAS f32x2*)(inc + (size_t)n * 16384); c0 = ao * c0 + ai * iv[0]; c1 = ao * c1 + ai * iv[1];
        if (tid < 8) nv = ao * nv + ai * incn[n * 128 + dn];
        m = mn; }
}
__device__ __forceinline__ void f_ml_p4(ArgsR A, int l, int item, LAS unsigned char* lds, int tid) {
    const int n = item & 31, h = (item >> 5) & 3, b = item >> 7; const int lane = tid & 63, wave = __builtin_amdgcn_readfirstlane(tid >> 6), fr = lane & 15, fq = lane >> 4;
    const bf16* P = (const bf16*)(A.ws + WS_P); const float* Ps = (const float*)(A.ws + WS_PS); bf16* mix = (bf16*)(A.ws + WS_MIX);
    const bf16* stg = (const bf16*)(A.ws + WS_ML_ST) + (size_t)item * 16384; const float* npg = (const float*)(A.ws + WS_ML_NP) + (size_t)item * 128; const float mprev = ((const float*)(A.ws + WS_ML_MP))[item];
    LAS bf16* qs = (LAS bf16*)(lds + FL_Q); LAS bf16* ks = (LAS bf16*)(lds + FL_K); LAS bf16* vs = (LAS bf16*)(lds + FL_V); LAS bf16* sts = (LAS bf16*)(lds + FL_ST); LAS bf16* scs = (LAS bf16*)(lds + FL_SC);
    LAS bf16* q2 = (LAS bf16*)(lds + FM_Q2); LAS float* sc = (LAS float*)(lds + FM_S); LAS float* rsp = (LAS float*)(lds + FL_RS + 4096);
    const size_t r0 = (size_t)b * SEQ + n * CHK;
    const float gn = A.in[I_ML_NG][l * GW + h * HD + 16 * wave + fr];
    float ogt[4][4];
#pragma unroll
    for (int mt = 0; mt < 4; ++mt)
#pragma unroll
        for (int r = 0; r < 4; ++r) ogt[mt][r] = bf2f(P[(r0 + 16 * mt + 4 * fq + r) * PBW + PC_ML_O + h * HD + 16 * wave + fr]);
    tile_g2l_128<64>(P + r0 * PBW + PC_ML_Q + h * HD, PBW, qs, tid);
    tile_g2l_128<64>(P + r0 * PBW + PC_ML_K + h * HD, PBW, ks, tid);
    tile_g2l_128<64>(P + r0 * PBW + PC_ML_V + h * HD, PBW, vs, tid);
    tile_g2l_128<128>(stg, 128, sts, tid);
    if (wave == 0) { const float lf = logsigmoidf_(Ps[(r0 + lane) * 32 + PS_MF + h] + A.in[I_ML_FB][l * NH + h]), ig = Ps[(r0 + lane) * 32 + PS_MI + h] + A.in[I_ML_IB][l * NH + h];
        const float bcum = wave_scan_add(lf, lane), as = ig - bcum, pm = wave_scan_max(as, lane);
        const float mintra = bcum + pm, minter = bcum + mprev, mt = fmaxf(mintra, minter);
        sc[lane] = bcum - mt; sc[64 + lane] = as; sc[128 + lane] = __expf(minter - mt); sc[192 + lane] = __expf(-mt); }
    if (wave == 1) { sc[320 + lane] = npg[lane]; sc[384 + lane] = npg[64 + lane]; }
    __syncthreads();
#pragma unroll
    for (int i = 0; i < 2; ++i) { const int idx = tid + i * NTHREADS, r = idx >> 4, c8 = (idx & 15) * 8; const float w = sc[128 + r];
        v4u x = *(LAS v4u*)(qs + r * LD128 + c8);
        x.x = pk2(bflo(x.x) * w, bfhi(x.x) * w); x.y = pk2(bflo(x.y) * w, bfhi(x.y) * w); x.z = pk2(bflo(x.z) * w, bfhi(x.z) * w); x.w = pk2(bflo(x.w) * w, bfhi(x.w) * w);
        *(LAS v4u*)(q2 + r * LD128 + c8) = x; }
    { const int mt = wave >> 1; f32x4 acc[2] = {{0.f, 0.f, 0.f, 0.f}, {0.f, 0.f, 0.f, 0.f}};
#pragma unroll
        for (int kk = 0; kk < 4; ++kk) { const bf16x8 af = frag_rd(qs, LD128, 16 * mt, 32 * kk, lane);
#pragma unroll
            for (int q = 0; q < 2; ++q) acc[q] = MFMA16(af, frag_rd(ks, LD128, 16 * (2 * (wave & 1) + q), 32 * kk, lane), acc[q]); }
#pragma unroll
        for (int q = 0; q < 2; ++q) { const int s = 16 * (2 * (wave & 1) + q) + fr; const float asv = sc[64 + s];
#pragma unroll
            for (int r = 0; r < 4; ++r) { const int c = 16 * mt + 4 * fq + r; scs[c * LD64 + s] = (bf16)f2bf(s <= c ? acc[q][r] * 0.08838834764831845f * __expf(sc[c] + asv) : 0.f); } } }
    __syncthreads();
    { const int c = tid >> 3, part = tid & 7; float s = 0.f;
#pragma unroll
        for (int i = 0; i < 8; ++i) s += bf2f(scs[c * LD64 + part * 8 + i]);
#pragma unroll
        for (int i = 0; i < 16; ++i) s += bf2f(q2[c * LD128 + part * 16 + i]) * sc[320 + part * 16 + i];
        s = oct_sum_f(s);
        if (part == 0) sc[256 + c] = fmaxf(fabsf(s), sc[192 + c]); }
    f32x4 o[4];
#pragma unroll
    for (int mt = 0; mt < 4; ++mt) o[mt] = (f32x4){0.f, 0.f, 0.f, 0.f};
#pragma unroll
    for (int kk = 0; kk < 2; ++kk) { const bf16x8 bfv = frag_tr(vs, LD128, 32 * kk, 16 * wave, lane);
#pragma unroll
        for (int mt = 0; mt < 4; ++mt) o[mt] = MFMA16(frag_rd(scs, LD64, 16 * mt, 32 * kk, lane), bfv, o[mt]); }
#pragma unroll
    for (int kk = 0; kk < 4; ++kk) { const bf16x8 bfs = frag_rd(sts, LD128, 16 * wave, 32 * kk, lane);
#pragma unroll
        for (int mt = 0; mt < 4; ++mt) o[mt] = MFMA16(frag_rd(q2, LD128, 16 * mt, 32 * kk, lane), bfs, o[mt]); }
    __syncthreads();
#pragma unroll
    for (int mt = 0; mt < 4; ++mt)
#pragma unroll
        for (int r = 0; r < 4; ++r) { const int c = 16 * mt + 4 * fq + r;
            const float hv = o[mt][r] * rcpf_(sc[256 + c]) * sigmoidf_(ogt[mt][r]); o[mt][r] = hv;
            float s = hv * hv; s = row_sum_f(s);
            if (fr == 0) rsp[wave * 64 + c] = s; }
    __syncthreads();
#pragma unroll
    for (int mt = 0; mt < 4; ++mt)
#pragma unroll
        for (int r = 0; r < 4; ++r) { const int c = 16 * mt + 4 * fq + r; float ss = 0.f;
#pragma unroll
            for (int w = 0; w < 8; ++w) ss += rsp[w * 64 + c];
            mix[(r0 + c) * DM + 1024 + h * HD + 16 * wave + fr] = (bf16)f2bf(o[mt][r] * rsqrtf(ss * (1.0f / 128.0f) + RMS_EPS) * gn); }
    __syncthreads();
}

constexpr int FG_LM = 52224, FG_S = 129024, FG_RAW = 68608, FG_RAWT = 9216  ;
template <int C> struct GdnSolve {
    static __device__ __forceinline__ void run(float (&sol)[64], const LAS float* Lm) {
        if constexpr (C < 64) {
            float a0 = sol[C], a1 = 0.f, a2 = 0.f, a3 = 0.f;
#pragma unroll
            for (int s = 0; s < C; ++s) { const float t = Lm[C * 64 + s] * sol[s]; if ((s & 3) == 0) a0 -= t; else if ((s & 3) == 1) a1 -= t; else if ((s & 3) == 2) a2 -= t; else a3 -= t; }
            sol[C] = (a0 + a1) + (a2 + a3);
            GdnSolve<C + 1>::run(sol, Lm);
        }
    }
};
__device__ __forceinline__ void f_gdn_p2(ArgsR A, int l, int item, LAS unsigned char* lds, int tid) {
    const int n = item & 31, h = (item >> 5) & 3, b = item >> 7; const int lane = tid & 63, wave = __builtin_amdgcn_readfirstlane(tid >> 6), fr = lane & 15, fq = lane >> 4;
    const bf16* P = (const bf16*)(A.ws + WS_P); const float* Ps = (const float*)(A.ws + WS_PS);
    bf16* U0 = (bf16*)(A.ws + WS_GDN_U0) + (size_t)item * 8192; bf16* Wg = (bf16*)(A.ws + WS_GDN_W) + (size_t)item * 8192; bf16* QD = (bf16*)(A.ws + WS_GDN_QD) + (size_t)item * 8192;
    bf16* KE = (bf16*)(A.ws + WS_GDN_KE) + (size_t)item * 8192; bf16* QK = (bf16*)(A.ws + WS_GDN_QK) + (size_t)item * 4096; float* DE = (float*)(A.ws + WS_GDN_DE);
    LAS bf16* qs = (LAS bf16*)(lds + FL_Q); LAS bf16* ks = (LAS bf16*)(lds + FL_K); LAS bf16* vs = (LAS bf16*)(lds + FL_V); LAS float* Lm = (LAS float*)(lds + FG_LM); LAS float* sc = (LAS float*)(lds + FG_S);
    const float* cw = A.in[I_GDN_CW] + (size_t)l * 4 * 1536;
    const size_t r0 = (size_t)b * SEQ + n * CHK;
    float cwv[3][4];
#pragma unroll
    for (int part = 0; part < 3; ++part)
#pragma unroll
        for (int k = 0; k < 4; ++k) cwv[part][k] = cw[k * 1536 + part * 512 + h * HD + (tid & 127)];
    if (wave == 0) { const float bt = sigmoidf_(Ps[(r0 + lane) * 32 + PS_GB + h]);
        const float g = -__expf(A.in[I_GDN_ALOG][l * NH + h]) * softplusf_(Ps[(r0 + lane) * 32 + PS_GA + h] + A.in[I_GDN_DTB][l * NH + h]);
        const float gam = wave_scan_add(g, lane); sc[lane] = bt; sc[64 + lane] = gam; if (lane == 63) DE[item] = __expf(gam); }
    { LAS bf16* raw = (LAS bf16*)(lds + FG_RAW);
#pragma unroll
        for (int i = 0; i < 7; ++i) { const int idx = tid + i * NTHREADS; if (idx < 3 * 67 * 16) { const int part = idx / (67 * 16), pi = idx % (67 * 16), rr = pi >> 4, c8 = (pi & 15) * 8;
            const int pc = (part == 0 ? PC_GDN_Q : part == 1 ? PC_GDN_K : PC_GDN_V) + h * HD + c8; v4u w = {0u, 0u, 0u, 0u};
            if (n > 0 || rr >= 3) w = *(const GAS v4u*)(P + (r0 + rr - 3) * PBW + pc);
            *(LAS v4u*)(raw + part * FG_RAWT + rr * LD128 + c8) = w; } }
        __syncthreads();
        const int v = tid & 127, dq = tid >> 7;
#pragma unroll
        for (int part = 0; part < 3; ++part) {
            const float w0 = cwv[part][0], w1 = cwv[part][1], w2 = cwv[part][2], w3 = cwv[part][3];
            LAS bf16* dst = part == 0 ? qs : part == 1 ? ks : vs; const LAS bf16* src = raw + part * FG_RAWT + v;
            const int c0 = dq * 16;
            float xm3 = bf2f(src[(c0 + 0) * LD128]), xm2 = bf2f(src[(c0 + 1) * LD128]), xm1 = bf2f(src[(c0 + 2) * LD128]);
#pragma unroll
            for (int i = 0; i < 16; ++i) { const float x0 = bf2f(src[(c0 + i + 3) * LD128]); const float y = w0 * xm3 + w1 * xm2 + w2 * xm1 + w3 * x0;
                dst[(c0 + i) * LD128 + v] = (bf16)f2bf(siluf_(y)); xm3 = xm2; xm2 = xm1; xm1 = x0; } } }
    __syncthreads();
#pragma unroll 1
    for (int rr = 0; rr < 8; ++rr) { const int c = wave * 8 + rr;
        const float q1 = bf2f(qs[c * LD128 + lane]), q2 = bf2f(qs[c * LD128 + 64 + lane]), k1 = bf2f(ks[c * LD128 + lane]), k2 = bf2f(ks[c * LD128 + 64 + lane]);
        const float sq = wave_sum(q1 * q1 + q2 * q2), sk = wave_sum(k1 * k1 + k2 * k2);
        if (lane == 0) { sc[128 + c] = rsqrtf(sq + 1e-6f) * 0.08838834764831845f; sc[192 + c] = rsqrtf(sk + 1e-6f); } }
    __syncthreads();
    { const int mt = wave >> 1; f32x4 akk[2] = {{0.f, 0.f, 0.f, 0.f}, {0.f, 0.f, 0.f, 0.f}}, aqk[2] = {{0.f, 0.f, 0.f, 0.f}, {0.f, 0.f, 0.f, 0.f}};
#pragma unroll
        for (int kk = 0; kk < 4; ++kk) { const bf16x8 ak = frag_rd(ks, LD128, 16 * mt, 32 * kk, lane), aq = frag_rd(qs, LD128, 16 * mt, 32 * kk, lane);
#pragma unroll
            for (int q = 0; q < 2; ++q) { const bf16x8 bk = frag_rd(ks, LD128, 16 * (2 * (wave & 1) + q), 32 * kk, lane); akk[q] = MFMA16(ak, bk, akk[q]); aqk[q] = MFMA16(aq, bk, aqk[q]); } }
#pragma unroll
        for (int q = 0; q < 2; ++q) { const int s = 16 * (2 * (wave & 1) + q) + fr; const float rks = sc[192 + s], gs = sc[64 + s];
#pragma unroll
            for (int r = 0; r < 4; ++r) { const int c = 16 * mt + 4 * fq + r; const float dcy = __expf(sc[64 + c] - gs);
                Lm[c * 64 + s] = (s < c) ? sc[c] * akk[q][r] * sc[192 + c] * rks * dcy : 0.f;
                QK[c * 64 + s] = (bf16)f2bf((s <= c) ? aqk[q][r] * sc[128 + c] * rks * dcy : 0.f); } } }
    __syncthreads();
    if (tid < 256) {
        float sol[64]; const bool isw = tid >= 128; const int j = tid & 127;
        const LAS float* LmO = Lm; asm volatile("" : "+v"(LmO));
#pragma unroll
        for (int c = 0; c < 64; ++c) { const float bt = sc[c]; sol[c] = isw ? bf2f(ks[c * LD128 + j]) * sc[192 + c] * bt * __expf(sc[64 + c]) : bf2f(vs[c * LD128 + j]) * bt; }
        GdnSolve<1>::run(sol, LmO);
        bf16* dst = isw ? Wg : U0;
#pragma unroll
        for (int c = 0; c < 64; ++c) dst[c * 128 + j] = (bf16)f2bf(sol[c]);
    } else {
        const int t2 = tid - 256; const float glast = sc[64 + 63];
#pragma unroll
        for (int i = 0; i < 8; ++i) { const int idx = t2 + i * 256, which = idx >> 10, pi = idx & 1023, r = pi >> 4, c8 = (pi & 15) * 8;
            const float w = which == 0 ? sc[128 + r] * __expf(sc[64 + r]) : sc[192 + r] * __expf(glast - sc[64 + r]);
            v4u x = *(LAS v4u*)((which == 0 ? qs : ks) + r * LD128 + c8);
            x.x = pk2(bflo(x.x) * w, bfhi(x.x) * w); x.y = pk2(bflo(x.y) * w, bfhi(x.y) * w); x.z = pk2(bflo(x.z) * w, bfhi(x.z) * w); x.w = pk2(bflo(x.w) * w, bfhi(x.w) * w);
            *(GAS v4u*)((which == 0 ? QD : KE) + r * 128 + c8) = x; }
    }
    __syncthreads();
}

constexpr int FC_W = 0, FC_QD = 17408, FC_KE = 34816, FC_U0 = 52224, FC_QK = 69632, FC_RS = 78848  ;
__device__ __forceinline__ void f_gdn_p3(ArgsR A, int l, int bh, LAS unsigned char* lds, int tid) {
    const int lane = tid & 63, wave = __builtin_amdgcn_readfirstlane(tid >> 6), fr = lane & 15, fq = lane >> 4; const int b = bh >> 2, h = bh & 3;
    const bf16* U0 = (const bf16*)(A.ws + WS_GDN_U0) + (size_t)bh * 32 * 8192; const bf16* Wg = (const bf16*)(A.ws + WS_GDN_W) + (size_t)bh * 32 * 8192; const bf16* QD = (const bf16*)(A.ws + WS_GDN_QD) + (size_t)bh * 32 * 8192;
    const bf16* KE = (const bf16*)(A.ws + WS_GDN_KE) + (size_t)bh * 32 * 8192; const bf16* QK = (const bf16*)(A.ws + WS_GDN_QK) + (size_t)bh * 32 * 4096; const float* DE = (const float*)(A.ws + WS_GDN_DE) + bh * 32;
    const bf16* P = (const bf16*)(A.ws + WS_P); bf16* mix = (bf16*)(A.ws + WS_MIX); LAS float* rsp = (LAS float*)(lds + FC_RS);
    const float gn = A.in[I_GDN_NG][l * GW + h * HD + 16 * wave + fr];
    LAS bf16* ws_ = (LAS bf16*)(lds + FC_W); LAS bf16* qds = (LAS bf16*)(lds + FC_QD); LAS bf16* kes = (LAS bf16*)(lds + FC_KE); LAS bf16* u0s = (LAS bf16*)(lds + FC_U0); LAS bf16* qks = (LAS bf16*)(lds + FC_QK);
    f32x4 S[8];
#pragma unroll
    for (int i = 0; i < 8; ++i) S[i] = (f32x4){0.f, 0.f, 0.f, 0.f};
    v4u st[9];
    auto issue = [&](int n) {
#pragma unroll
        for (int i = 0; i < 8; ++i) { const int idx = tid + i * NTHREADS, which = idx >> 10, pi = idx & 1023;
            const bf16* src = (which == 0 ? Wg : which == 1 ? QD : which == 2 ? KE : U0) + (size_t)n * 8192; st[i] = *(const GAS v4u*)(src + pi * 8); }
        st[8] = *(const GAS v4u*)(QK + (size_t)n * 4096 + tid * 8);
    };
    auto commit = [&]() {
#pragma unroll
        for (int i = 0; i < 8; ++i) { const int idx = tid + i * NTHREADS, which = idx >> 10, pi = idx & 1023, r = pi >> 4, c8 = (pi & 15) * 8;
            *(LAS v4u*)((LAS bf16*)(lds + which * 17408) + r * LD128 + c8) = st[i]; }
        { const int r = tid >> 3, c8 = (tid & 7) * 8; *(LAS v4u*)(qks + r * LD64 + c8) = st[8]; }
    };
    const float dev = DE[lane & 31];
    issue(0);
    f32x4 op[4]; float gp[4][4];
#pragma unroll
    for (int mt = 0; mt < 4; ++mt) { op[mt] = (f32x4){0.f, 0.f, 0.f, 0.f};
#pragma unroll
        for (int r = 0; r < 4; ++r) gp[mt][r] = 0.f; }
#define CH_FINAL(nn) { LAS float* rs_ = rsp + ((nn) & 1) * 512; const size_t rp_ = (size_t)b * SEQ + (nn) * CHK; \
        _Pragma("unroll") for (int mt = 0; mt < 4; ++mt) _Pragma("unroll") for (int r = 0; r < 4; ++r) { const int c = 16 * mt + 4 * fq + r; float ss = 0.f; \
            _Pragma("unroll") for (int w = 0; w < 8; ++w) ss += rs_[w * 64 + c]; \
            mix[(rp_ + c) * DM + 1536 + h * HD + 16 * wave + fr] = (bf16)f2bf(op[mt][r] * rsqrtf(ss * (1.0f / 128.0f) + RMS_EPS) * gn * siluf_(gp[mt][r])); } }
#pragma unroll 1
    for (int n = 0; n < NCHK; ++n) {
        __syncthreads();
        if (n > 0) CH_FINAL(n - 1);
        commit();
        __syncthreads();
        if (n + 1 < NCHK) issue(n + 1);
        const float de = lane_bcast(dev, n);
        const size_t r0 = (size_t)b * SEQ + n * CHK;
#pragma unroll
        for (int mt = 0; mt < 4; ++mt)
#pragma unroll
            for (int r = 0; r < 4; ++r) gp[mt][r] = bf2f(P[(r0 + 16 * mt + 4 * fq + r) * PBW + PC_GDN_G + h * HD + 16 * wave + fr]);
        bf16x8 SB[4];
#pragma unroll
        for (int kb = 0; kb < 4; ++kb) SB[kb] = pack_acc(S[2 * kb], S[2 * kb + 1]);
        f32x4 u[4];
#pragma unroll
        for (int mt = 0; mt < 4; ++mt) { f32x4 ws2 = {0.f, 0.f, 0.f, 0.f}; op[mt] = (f32x4){0.f, 0.f, 0.f, 0.f};
#pragma unroll
            for (int kb = 0; kb < 4; ++kb) { ws2 = MFMA16(frag_rd_perm(ws_, LD128, 16 * mt, 32 * kb, lane), SB[kb], ws2); op[mt] = MFMA16(frag_rd_perm(qds, LD128, 16 * mt, 32 * kb, lane), SB[kb], op[mt]); }
#pragma unroll
            for (int r = 0; r < 4; ++r) u[mt][r] = bf2f(u0s[(16 * mt + 4 * fq + r) * LD128 + 16 * wave + fr]) - ws2[r]; }
        const bf16x8 UB0 = pack_acc(u[0], u[1]), UB1 = pack_acc(u[2], u[3]);
#pragma unroll
        for (int mt = 0; mt < 4; ++mt) { op[mt] = MFMA16(frag_rd_perm(qks, LD64, 16 * mt, 0, lane), UB0, op[mt]); op[mt] = MFMA16(frag_rd_perm(qks, LD64, 16 * mt, 32, lane), UB1, op[mt]); }
#pragma unroll
        for (int dt = 0; dt < 8; ++dt) { f32x4 sn = S[dt] * de;
            sn = MFMA16(frag_tr_perm(kes, LD128, 0, 16 * dt, lane), UB0, sn); sn = MFMA16(frag_tr_perm(kes, LD128, 32, 16 * dt, lane), UB1, sn); S[dt] = sn; }
        LAS float* rs_ = rsp + (n & 1) * 512;
#pragma unroll
        for (int mt = 0; mt < 4; ++mt)
#pragma unroll
            for (int r = 0; r < 4; ++r) { float s = op[mt][r] * op[mt][r]; s = row_sum_f(s);
                if (fr == 0) rs_[wave * 64 + 16 * mt + 4 * fq + r] = s; }
    }
    __syncthreads();
    CH_FINAL(NCHK - 1);
#undef CH_FINAL
    __syncthreads();
}

#ifndef TAB_FP8
#define TAB_FP8 1
#endif
constexpr size_t WS_TSC = 93 * MiB + 256 * 1024;
constexpr int NSLICE = 16;
constexpr int PE_KEYS = 0, PE_CAB = 16384, PE_ENT = 17408, PE_OFFS = 50176, PE_SHQ = 52352, PE_H2Q = 53248;

__device__ __forceinline__ void tab_convert(ArgsR A, int l, int gw, int NGW, int lane) {
    unsigned char* ws = A.ws; float* tsc = (float*)(ws + WS_TSC);
#pragma unroll 1
    for (int q = gw; q < 2 * NEXP; q += NGW) {
        const int t = q / NEXP, rr = l * NEXP + q % NEXP, r = t * DEPTH * NEXP + rr;
        const float* src = A.in[t ? I_PV : I_PU] + (size_t)rr * DM;
        f32x4 v[8];
#pragma unroll
        for (int i = 0; i < 8; ++i) v[i] = *(const GAS f32x4*)(src + 4 * (lane + 64 * i));
        unsigned char* dst = ws + (t ? WS_VB : WS_UB) + (size_t)(rr / NEXP) * TAB_L + (size_t)(rr % NEXP) * DM;
        float am = 0.f;
#pragma unroll
        for (int i = 0; i < 8; ++i) am = fmaxf(fmaxf(am, fmaxf(fabsf(v[i][0]), fabsf(v[i][1]))), fmaxf(fabsf(v[i][2]), fabsf(v[i][3])));
        am = wave_max(am); const float sc = am > 0.f ? 127.0f / am : 1.0f; const int off = 0;
#pragma unroll
        for (int i = 0; i < 8; ++i) { const int q0 = __float2int_rn(v[i][0] * sc) + off, q1 = __float2int_rn(v[i][1] * sc) + off, q2 = __float2int_rn(v[i][2] * sc) + off, q3 = __float2int_rn(v[i][3] * sc) + off;
            *(GAS unsigned*)(dst + 4 * (lane + 64 * i)) = (unsigned)(q0 & 255) | ((unsigned)(q1 & 255) << 8) | ((unsigned)(q2 & 255) << 16) | ((unsigned)(q3 & 255) << 24); }
        if (lane == 0) tsc[r] = am > 0.f ? am * (1.0f / 127.0f) : 1.0f;
    }
}
__device__ __forceinline__ float ubf0(unsigned w) { float r; asm volatile("v_cvt_f32_ubyte0 %0, %1" : "=v"(r) : "v"(w)); return r; }
__device__ __forceinline__ float ubf1(unsigned w) { float r; asm volatile("v_cvt_f32_ubyte1 %0, %1" : "=v"(r) : "v"(w)); return r; }
__device__ __forceinline__ float ubf2(unsigned w) { float r; asm volatile("v_cvt_f32_ubyte2 %0, %1" : "=v"(r) : "v"(w)); return r; }
__device__ __forceinline__ float ubf3(unsigned w) { float r; asm volatile("v_cvt_f32_ubyte3 %0, %1" : "=v"(r) : "v"(w)); return r; }
#define TOUCH16(a, o) asm volatile("" : "+v"(a[(o)+0]), "+v"(a[(o)+1]), "+v"(a[(o)+2]), "+v"(a[(o)+3]), "+v"(a[(o)+4]), "+v"(a[(o)+5]), "+v"(a[(o)+6]), "+v"(a[(o)+7]), "+v"(a[(o)+8]), "+v"(a[(o)+9]), "+v"(a[(o)+10]), "+v"(a[(o)+11]), "+v"(a[(o)+12]), "+v"(a[(o)+13]), "+v"(a[(o)+14]), "+v"(a[(o)+15]))
__device__ __forceinline__ unsigned f2sortable(float f) { const unsigned u = __builtin_bit_cast(unsigned, f); return (u & 0x80000000u) ? ~u : (u | 0x80000000u); }
__device__ __forceinline__ float unsortable(unsigned k) { const unsigned u = (k & 0x80000000u) ? (k & 0x7fffffffu) : ~k; return __builtin_bit_cast(float, u); }
__device__ __forceinline__ void peer_phase(ArgsR A, int l, bool last, bool dry, LAS unsigned char* lds, int G, int tid) {
    const int wave = __builtin_amdgcn_readfirstlane(tid >> 6), lane = tid & 63;
    unsigned char* ws = A.ws;
    const bf16* Q = (const bf16*)(ws + WS_Q);
    const bf16* K1 = (const bf16*)(ws + WS_K1) + (size_t)l * 8 * 128 * 128; const bf16* K2 = (const bf16*)(ws + WS_K2) + (size_t)l * 8 * 128 * 128;
    const unsigned char* Ub = ws + WS_UB + (size_t)l * TAB_L; const unsigned char* Vb = ws + WS_VB + (size_t)l * TAB_L;
    const float* tscU = (const float*)(ws + WS_TSC) + (size_t)l * NEXP; const float* tscV = tscU + (size_t)DEPTH * NEXP;
    const float* ssp = (const float*)(ws + WS_SSP); const float* X = A.out; float* XO = dry ? (float*)(ws + WS_P) : A.out; bf16* xb = (bf16*)(ws + (dry ? WS_MIX : WS_XB)); float* rstd1 = (float*)(ws + (dry ? WS_PS : WS_RSTD1));
    const float* g2 = A.in[I_N2G] + l * DM; const float* gf = A.in[I_FNG];
    LAS unsigned* keysL = (LAS unsigned*)(lds + PE_KEYS); LAS unsigned* cab = (LAS unsigned*)(lds + PE_CAB); LAS v2u* ent = (LAS v2u*)(lds + PE_ENT); LAS unsigned* offs = (LAS unsigned*)(lds + PE_OFFS);
    LAS float* shqL = (LAS float*)(lds + PE_SHQ); LAS unsigned* ngt = (LAS unsigned*)(lds + PE_SHQ + 128); LAS float* cqs = (LAS float*)(lds + PE_SHQ + 256); LAS unsigned* ngt8 = (LAS unsigned*)(lds + PE_SHQ + 384); LAS v4u* h2qL = (LAS v4u*)(lds + PE_H2Q);
    if (tid < 64) { int a = 0, b = tid, found = 0;
        for (int aa = 0, base = 0; aa < 16; ++aa) { const int nbb = 16 / (aa + 1); if (!found && tid < base + nbb) { a = aa; b = tid - base; found = 1; } base += nbb; }
        cab[tid] = found ? (unsigned)(a * 16 + b) : 0xffu; }
    __syncthreads();
#pragma unroll 1
    for (int item = blockIdx.x; item < NT / 32; item += G) {
        const int tok0 = item * 32;
#pragma unroll 1
        for (int tt = 0; tt < 4; ++tt) { const int tl = wave * 4 + tt; const size_t t = (size_t)tok0 + tl;
            float s2 = (lane < 32) ? ssp[t * 32 + lane] : 0.f; s2 = wave_sum(s2);
            const float rstd2 = rsqrtf(s2 * (1.0f / DM) + RMS_EPS);
            float hf[32]; float am = 0.f;
#pragma unroll
            for (int j = 0; j < 2; ++j)
#pragma unroll
                for (int q = 0; q < 4; ++q) { const size_t e0 = 16 * (size_t)(lane + 64 * j) + 4 * q;
                    const f32x4 xa = *(const GAS f32x4*)(X + t * DM + e0), ga = *(const GAS f32x4*)(g2 + e0);
#pragma unroll
                    for (int k = 0; k < 4; ++k) { const float hv = xa[k] * rstd2 * ga[k]; hf[j * 16 + q * 4 + k] = hv; am = fmaxf(am, fabsf(hv)); } }
            am = wave_max(am); const float sc = am > 0.f ? 127.0f / am : 1.0f;
#pragma unroll
            for (int j = 0; j < 2; ++j) { unsigned wd[4];
#pragma unroll
                for (int q = 0; q < 4; ++q) wd[q] = (unsigned)((__float2int_rn(hf[j * 16 + q * 4 + 0] * sc) & 255) | ((__float2int_rn(hf[j * 16 + q * 4 + 1] * sc) & 255) << 8) | ((__float2int_rn(hf[j * 16 + q * 4 + 2] * sc) & 255) << 16) | ((__float2int_rn(hf[j * 16 + q * 4 + 3] * sc) & 255) << 24));
                v4u w; w.x = wd[0]; w.y = wd[1]; w.z = wd[2]; w.w = wd[3]; h2qL[(tl * 2 + j) * 64 + lane] = w; }
            if (lane == 0) shqL[tl] = am > 0.f ? am * (1.0f / 127.0f) : 1.0f; }
#pragma unroll 1
        for (int pass = 0; pass < 4; ++pass) {
            LAS unsigned* kl = keysL + (pass & 1) * 2048;
            { const int hh = wave >> 2, side = (wave >> 1) & 1, mt = wave & 1, h = 2 * pass + hh, fr = lane & 15, fq = lane >> 4;
                const bf16* qa = Q + (size_t)(tok0 + 16 * mt + fr) * DM + h * 256 + side * 128 + 8 * fq;
                const bf16* kb = (side ? K2 : K1) + (size_t)h * 128 * 128 + (size_t)fr * 128 + 8 * fq;
                bf16x8 af[4];
#pragma unroll
                for (int ks = 0; ks < 4; ++ks) af[ks] = *(const GAS bf16x8*)(qa + 32 * ks);
                unsigned key[8][4];
#pragma unroll
                for (int nt = 0; nt < 8; ++nt) { f32x4 acc = {0.f, 0.f, 0.f, 0.f};
#pragma unroll
                    for (int ks = 0; ks < 4; ++ks) { const bf16x8 bfr = *(const GAS bf16x8*)(kb + (size_t)nt * 16 * 128 + 32 * ks); acc = __builtin_amdgcn_mfma_f32_16x16x32_bf16(af[ks], bfr, acc, 0, 0, 0); }
#pragma unroll
                    for (int r = 0; r < 4; ++r) key[nt][r] = (f2sortable(acc[r]) & ~127u) | (unsigned)(nt * 16 + fr);
                    if (nt & 1) __builtin_amdgcn_sched_barrier(0); }
#define CE8(a, b) { const unsigned hi_ = max(key[a][r], key[b][r]), lo_ = min(key[a][r], key[b][r]); key[a][r] = hi_; key[b][r] = lo_; }
#pragma unroll
                for (int r = 0; r < 4; ++r) { CE8(0, 1) CE8(2, 3) CE8(4, 5) CE8(6, 7) CE8(0, 2) CE8(1, 3) CE8(4, 6) CE8(5, 7) CE8(1, 2) CE8(5, 6) CE8(0, 4) CE8(1, 5) CE8(2, 6) CE8(3, 7) CE8(2, 4) CE8(3, 5) CE8(1, 2) CE8(3, 4) CE8(5, 6) }
#undef CE8
                unsigned res[4] = {0u, 0u, 0u, 0u};
#pragma unroll 1
                for (int j = 0; j < 16; ++j) {
#pragma unroll
                    for (int r = 0; r < 4; ++r) {
                        const unsigned w = row_max_u(key[0][r]); const bool own = key[0][r] == w;
#pragma unroll
                        for (int nt = 0; nt < 7; ++nt) key[nt][r] = own ? key[nt + 1][r] : key[nt][r];
                        key[7][r] = own ? 0u : key[7][r];
                        res[r] = (fr == j) ? w : res[r]; } }
                const int rowb = (hh * 2 + side) * 32 + 16 * mt + 4 * fq;
#pragma unroll
                for (int r = 0; r < 4; ++r) kl[(rowb + r) * 16 + fr] = res[r]; }
            __syncthreads();
#pragma unroll 1
            for (int rnd = 0; rnd < 2; ++rnd) { const int fr = lane & 15, fq = lane >> 4, pidx = rnd * 32 + wave * 4 + fq, hh = pidx >> 5, tk = pidx & 31, h = 2 * pass + hh;
                const LAS unsigned* k1 = kl + ((hh * 2) * 32 + tk) * 16; const LAS unsigned* k2 = k1 + 32 * 16;
                unsigned ck[4];
#pragma unroll
                for (int sl = 0; sl < 4; ++sl) { const int ci = fr + 16 * sl; const unsigned ab = cab[ci];
                    const float v = unsortable(k1[(ab >> 4) & 15] & ~127u) + unsortable(k2[ab & 15] & ~127u);
                    ck[sl] = (ab == 0xffu) ? 0u : ((f2sortable(v) & ~63u) | (unsigned)ci); }
#define CE4(a, b) { const unsigned hi_ = max(ck[a], ck[b]), lo_ = min(ck[a], ck[b]); ck[a] = hi_; ck[b] = lo_; }
                CE4(0, 1) CE4(2, 3) CE4(0, 2) CE4(1, 3) CE4(1, 2)
#undef CE4
                unsigned rk = 0u;
#pragma unroll 1
                for (int j = 0; j < 16; ++j) { const unsigned w = row_max_u(ck[0]); const bool own = ck[0] == w;
                    ck[0] = own ? ck[1] : ck[0]; ck[1] = own ? ck[2] : ck[1]; ck[2] = own ? ck[3] : ck[2]; ck[3] = own ? 0u : ck[3];
                    rk = (fr == j) ? w : rk; }
                const unsigned ab = cab[rk & 63u]; const float v = unsortable(rk & ~63u);
                const float vmax = row_max_f(v), e = __expf(v - vmax), den = row_sum_f(e);
                const unsigned eid = (k1[(ab >> 4) & 15] & 127u) * 128u + (k2[ab & 15] & 127u);
                const float gsv = e * rcpf_(den) * tscV[eid];
                v2u wv; wv.x = eid; wv.y = __builtin_bit_cast(unsigned, gsv);
                ent[tk * 128 + h * 16 + fr] = wv; }
        }
        __syncthreads();
#pragma unroll 1
        for (int tt = 0; tt < 4; ++tt) { const int tl = wave * 4 + tt;
            const v2u e0 = ent[tl * 128 + lane], e1 = ent[tl * 128 + 64 + lane];
            const unsigned id0 = e0.x, id1 = e1.x; const unsigned s0 = id0 >> 10, s1 = id1 >> 10; const unsigned long long lt = (1ull << lane) - 1ull;
            unsigned base = 0, p0 = 0, p1 = 0, ngr = 0, ng8 = 0, pc = 0;
#pragma unroll 1
            for (unsigned s = 0; s < NSLICE; ++s) { const unsigned long long m0 = __ballot(s0 == s), m1 = __ballot(s1 == s); const unsigned c0 = __popcll(m0), c1 = __popcll(m1); ngr += (c0 + c1 + 3u) >> 2; pc += c0 + c1; if (s & 1u) { ng8 += (pc + 7u) >> 3; pc = 0; }
                if (s0 == s) p0 = base + __popcll(m0 & lt);
                if (s1 == s) p1 = base + c0 + __popcll(m1 & lt);
                if (lane == 0) offs[tl * 17 + s] = base;
                base += c0 + c1; }
            if (lane == 0) { offs[tl * 17 + NSLICE] = base; ngt[tl] = ngr; ngt8[tl] = ng8; }
            ent[tl * 128 + p0] = e0; ent[tl * 128 + p1] = e1; }
        const unsigned lo16 = (unsigned)lane * 16u;
#if defined(PROBE_VMASK) || defined(PROBE_UMASK)
        int IDM_ = 0xffffff;
#else
        constexpr int IDM_ = 0xffffff;
#endif
#define E_ADV(S, T, P, B1, NTOK, TLBASE) { P += 4; while (P >= B1 && S < NSLICE) { ++T; if (T == (NTOK)) { T = 0; ++S; } \
            if (S < NSLICE) { P = __builtin_amdgcn_readfirstlane((int)offs[((TLBASE) + T) * 17 + S]); B1 = __builtin_amdgcn_readfirstlane((int)offs[((TLBASE) + T) * 17 + S + 1]); } } \
            if (S >= NSLICE) { T = 0; P = 128; B1 = 128; } }
#define E_FETCH(X, T, P, B1, TLBASE, WITHSU) { X##tl = (TLBASE) + T; X##w = T; X##p = P; X##b1 = B1; \
            { const v2u w_ = ent[X##tl * 128 + min(P + (lane & 3), B1 - 1)]; X##ex = w_.x; X##ey = w_.y;        \
              _Pragma("unroll") for (int e = 0; e < 4; ++e) X##id[e] = __builtin_amdgcn_readlane((int)X##ex, e); X##suv = tscU[X##ex]; } }
#define E_LOAD(REG, TAB, X) { _Pragma("unroll") for (int e = 0; e < 4; ++e) { const GAS unsigned char* rb = (const GAS unsigned char*)(TAB) + (size_t)(X##id[e] & IDM_) * 2048; REG[e][0] = *(const GAS v4u*)(rb + lo16); REG[e][1] = *(const GAS v4u*)(rb + lo16 + 1024); } }
        {
#ifdef PROBE_UMASK
            IDM_ = dry ? PROBE_UMASK : 0xffffff;
#endif
            int Atl = 0, Aw = 0, Ap = 0, Ab1 = 0, Aid[4]; unsigned Aex = 0, Aey = 0; float Asuv = 0.f; int Btl = 0, Bw = 0, Bp = 0, Bb1 = 0, Bid[4]; unsigned Bex = 0, Bey = 0; float Bsuv = 0.f; v4u RA[4][2], RB[4][2];
            (void)Aw; (void)Bw;
#define U_COMP(X, REG) { const v4u hq0 = h2qL[(X##tl * 2 + 0) * 64 + lane], hq1 = h2qL[(X##tl * 2 + 1) * 64 + lane]; const float shq = shqL[X##tl]; int dd[4]; \
                _Pragma("unroll") for (int e = 0; e < 4; ++e) { int a0 = 0, a1 = 0; \
                    a0 = __builtin_amdgcn_sdot4((int)REG[e][0][0], (int)hq0[0], a0, false); a1 = __builtin_amdgcn_sdot4((int)REG[e][0][1], (int)hq0[1], a1, false); \
                    a0 = __builtin_amdgcn_sdot4((int)REG[e][0][2], (int)hq0[2], a0, false); a1 = __builtin_amdgcn_sdot4((int)REG[e][0][3], (int)hq0[3], a1, false); \
                    a0 = __builtin_amdgcn_sdot4((int)REG[e][1][0], (int)hq1[0], a0, false); a1 = __builtin_amdgcn_sdot4((int)REG[e][1][1], (int)hq1[1], a1, false); \
                    a0 = __builtin_amdgcn_sdot4((int)REG[e][1][2], (int)hq1[2], a0, false); a1 = __builtin_amdgcn_sdot4((int)REG[e][1][3], (int)hq1[3], a1, false); \
                    dd[e] = a0 + a1; } \
                const bool o1_ = (lane & 1) != 0, o2_ = (lane & 2) != 0; \
                const int r01_ = (o1_ ? dd[1] : dd[0]) + (int)dpp_rot_u<0xB1>((unsigned)(o1_ ? dd[0] : dd[1])); \
                const int r23_ = (o1_ ? dd[3] : dd[2]) + (int)dpp_rot_u<0xB1>((unsigned)(o1_ ? dd[2] : dd[3])); \
                int rr_ = (o2_ ? r23_ : r01_) + (int)dpp_rot_u<0x4E>((unsigned)(o2_ ? r01_ : r23_)); \
                rr_ += (int)dpp_rot_u<0x124>((unsigned)rr_); rr_ += (int)dpp_rot_u<0x128>((unsigned)rr_); \
                { const auto s32_ = __builtin_amdgcn_permlane32_swap(rr_, rr_, false, false); rr_ = s32_[0] + s32_[1]; const auto s16_ = __builtin_amdgcn_permlane16_swap(rr_, rr_, false, false); rr_ = s16_[0] + s16_[1]; } \
                const float cf = __builtin_bit_cast(float, X##ey) * gelu_tanh((float)rr_ * X##suv * shq); \
                if (lane < 4 && X##p + lane < X##b1) { v2u w2; w2.x = X##ex; w2.y = __builtin_bit_cast(unsigned, cf); ent[X##tl * 128 + X##p + lane] = w2; } }
            int us = 0, ut = -1, up = 0, ub1 = 0;
            const int ngU = __builtin_amdgcn_readfirstlane((int)(ngt[wave * 4] + ngt[wave * 4 + 1] + ngt[wave * 4 + 2] + ngt[wave * 4 + 3]));
            E_ADV(us, ut, up, ub1, 4, wave * 4);
            E_FETCH(A, ut, up, ub1, wave * 4, 1); E_LOAD(RA, Ub, A);
#pragma unroll 1
            for (int gi = 0; gi < ngU; gi += 2) {
                E_ADV(us, ut, up, ub1, 4, wave * 4); E_FETCH(B, ut, up, ub1, wave * 4, 1); E_LOAD(RB, Ub, B);
                U_COMP(A, RA);
                E_ADV(us, ut, up, ub1, 4, wave * 4); E_FETCH(A, ut, up, ub1, wave * 4, 1); E_LOAD(RA, Ub, A);
                U_COMP(B, RB);
            }
#undef U_COMP
        }
#pragma unroll 1
        for (int tt = 0; tt < 4; ++tt) { const int tl = wave * 4 + tt;
            const v2u e0 = ent[tl * 128 + lane], e1 = ent[tl * 128 + 64 + lane]; const unsigned b0_ = e0.y, b1_ = e1.y;
            const float c0 = __builtin_bit_cast(float, b0_), c1 = __builtin_bit_cast(float, b1_);
            const float am = wave_max(fmaxf(fabsf(c0), fabsf(c1))); const float sc = am > 0.f ? 127.0f / am : 0.f;
            v2u w0 = e0, w1 = e1; w0.y = (unsigned)__float2int_rn(c0 * sc); w1.y = (unsigned)__float2int_rn(c1 * sc);
            ent[tl * 128 + lane] = w0; ent[tl * 128 + 64 + lane] = w1;
            if (lane == 0) cqs[tl] = am * (1.0f / 127.0f); }
        {
            LAS unsigned* accL = (LAS unsigned*)(lds + PE_H2Q) + wave * 2048;
            float ssq0 = 0.f, ssq1 = 0.f, ssq2 = 0.f, ssq3 = 0.f;
            const int ngV = __builtin_amdgcn_readfirstlane((int)(ngt8[wave * 4] + ngt8[wave * 4 + 1] + ngt8[wave * 4 + 2] + ngt8[wave * 4 + 3]));
#if defined(PROBE_VMASK)
            IDM_ = dry ? PROBE_VMASK : 0xffffff;
#elif defined(PROBE_UMASK)
            IDM_ = 0xffffff;
#endif
#define V_ADV(S, T, P, B1) { P += 8; while (P >= B1 && S < NSLICE / 2) { ++T; if (T == 4) { T = 0; ++S; } \
                if (S < NSLICE / 2) { P = __builtin_amdgcn_readfirstlane((int)offs[(wave * 4 + T) * 17 + 2 * S]); B1 = __builtin_amdgcn_readfirstlane((int)offs[(wave * 4 + T) * 17 + 2 * S + 2]); } } \
                if (S >= NSLICE / 2) { T = 0; P = 128; B1 = 128; } }
#define V_FETCH(X, T, P, B1) { X##w = T; { const v2u w_ = ent[(wave * 4 + T) * 128 + min(P + (lane & 7), B1 - 1)]; const unsigned ex = w_.x, ey = w_.y; int cq_[8]; \
                _Pragma("unroll") for (int e = 0; e < 8; ++e) { X##id[e] = __builtin_amdgcn_readlane((int)ex, e); const int c_ = __builtin_amdgcn_readlane((int)ey, e); cq_[e] = (P + e < B1) ? (c_ & 255) : 0; } \
                X##c0 = cq_[0] | (cq_[1] << 8) | (cq_[2] << 16) | (cq_[3] << 24); X##c1 = cq_[4] | (cq_[5] << 8) | (cq_[6] << 16) | (cq_[7] << 24); } }
#define V_LOAD(REG, X) { _Pragma("unroll") for (int e = 0; e < 8; ++e) REG[e] = *(const GAS v4u*)(Vb + (size_t)(X##id[e] & IDM_) * 2048 + hoff); }
#define V_QUAD(Y, REG, O, CPK) { _Pragma("unroll") for (int w = 0; w < 4; ++w) { \
                const unsigned ab_lo = __builtin_amdgcn_perm(REG[O + 1][w], REG[O][w], 0x05010400u), ab_hi = __builtin_amdgcn_perm(REG[O + 1][w], REG[O][w], 0x07030602u); \
                const unsigned cd_lo = __builtin_amdgcn_perm(REG[O + 3][w], REG[O + 2][w], 0x05010400u), cd_hi = __builtin_amdgcn_perm(REG[O + 3][w], REG[O + 2][w], 0x07030602u); \
                Y[w * 4 + 0] = __builtin_amdgcn_sdot4((int)__builtin_amdgcn_perm(cd_lo, ab_lo, 0x05040100u), CPK, Y[w * 4 + 0], false); \
                Y[w * 4 + 1] = __builtin_amdgcn_sdot4((int)__builtin_amdgcn_perm(cd_lo, ab_lo, 0x07060302u), CPK, Y[w * 4 + 1], false); \
                Y[w * 4 + 2] = __builtin_amdgcn_sdot4((int)__builtin_amdgcn_perm(cd_hi, ab_hi, 0x05040100u), CPK, Y[w * 4 + 2], false); \
                Y[w * 4 + 3] = __builtin_amdgcn_sdot4((int)__builtin_amdgcn_perm(cd_hi, ab_hi, 0x07060302u), CPK, Y[w * 4 + 3], false); } }
#define V_COMP(X, REG) { if (X##w == 0) { V_QUAD(yA, REG, 0, X##c0) V_QUAD(yA, REG, 4, X##c1) } else if (X##w == 1) { V_QUAD(yB, REG, 0, X##c0) V_QUAD(yB, REG, 4, X##c1) } \
                else { int yt[16]; _Pragma("unroll") for (int i = 0; i < 16; ++i) yt[i] = 0; V_QUAD(yt, REG, 0, X##c0) V_QUAD(yt, REG, 4, X##c1) \
                    LAS unsigned* ap = accL + (X##w - 2) * 1024 + lane; _Pragma("unroll") for (int i = 0; i < 16; ++i) (void)__hip_atomic_fetch_add(ap + i * 64, (unsigned)yt[i], __ATOMIC_RELAXED, __HIP_MEMORY_SCOPE_WORKGROUP); } }
#define PV_EPI(TS, YI, SSQ) { const int tl_ = wave * 4 + (TS); const size_t t_ = (size_t)tok0 + tl_; const float cs_ = cqs[tl_]; float yv[16]; \
                _Pragma("unroll") for (int q = 0; q < 4; ++q) { const f32x4 xa = *(const GAS f32x4*)(X + t_ * DM + hoff + 4 * q); \
                    _Pragma("unroll") for (int k = 0; k < 4; ++k) { yv[q * 4 + k] = xa[k] + cs_ * (float)YI[q * 4 + k]; SSQ += yv[q * 4 + k] * yv[q * 4 + k]; } } \
                if (!last || half == 0) { _Pragma("unroll") for (int q = 0; q < 4; ++q) { f32x4 oa = {yv[q * 4 + 0], yv[q * 4 + 1], yv[q * 4 + 2], yv[q * 4 + 3]}; *(GAS f32x4*)(XO + t_ * DM + hoff + 4 * q) = oa; } } \
                if (!last) { v4u w0, w1; w0.x = pk2(yv[0], yv[1]); w0.y = pk2(yv[2], yv[3]); w0.z = pk2(yv[4], yv[5]); w0.w = pk2(yv[6], yv[7]); w1.x = pk2(yv[8], yv[9]); w1.y = pk2(yv[10], yv[11]); w1.z = pk2(yv[12], yv[13]); w1.w = pk2(yv[14], yv[15]); \
                    *(GAS v4u*)(xb + t_ * DM + hoff) = w0; *(GAS v4u*)(xb + t_ * DM + hoff + 8) = w1; } \
                if (half == 1) { const float rs = rsqrtf(wave_sum(SSQ) * (1.0f / DM) + RMS_EPS); \
                    if (!last) { if (lane == 0) rstd1[t_] = rs; } \
                    else { _Pragma("unroll") for (int q = 0; q < 4; ++q) { const f32x4 ga = *(const GAS f32x4*)(gf + hoff + 4 * q); \
                            f32x4 oa = {yv[q * 4 + 0] * rs * ga[0], yv[q * 4 + 1] * rs * ga[1], yv[q * 4 + 2] * rs * ga[2], yv[q * 4 + 3] * rs * ga[3]}; *(GAS f32x4*)(XO + t_ * DM + hoff + 4 * q) = oa; } \
                        _Pragma("unroll") for (int q = 0; q < 4; ++q) { const f32x4 ya = *(const GAS f32x4*)(XO + t_ * DM + lo16 + 4 * q), ga = *(const GAS f32x4*)(gf + lo16 + 4 * q);        \
                            f32x4 oa = {ya[0] * rs * ga[0], ya[1] * rs * ga[1], ya[2] * rs * ga[2], ya[3] * rs * ga[3]}; *(GAS f32x4*)(XO + t_ * DM + lo16 + 4 * q) = oa; } } } }
#pragma unroll 1
            for (int half = 0; half < 2; ++half) {
                const unsigned hoff = (unsigned)half * 1024u + lo16;
                int yA[16], yB[16];
#pragma unroll
                for (int i = 0; i < 16; ++i) { yA[i] = 0; yB[i] = 0; }
#pragma unroll
                for (int i = 0; i < 32; ++i) accL[i * 64 + lane] = 0u;
                {
                    int Aw = 0, Aid[8], Ac0 = 0, Ac1 = 0, Bw = 0, Bid[8], Bc0 = 0, Bc1 = 0; v4u RA[8], RB[8];
                    int us = 0, ut = -1, up = 0, ub1 = 0;
                    V_ADV(us, ut, up, ub1);
                    V_FETCH(A, ut, up, ub1); V_LOAD(RA, A);
#pragma unroll 1
                    for (int gi = 0; gi < ngV; gi += 2) {
                        V_ADV(us, ut, up, ub1); V_FETCH(B, ut, up, ub1); V_LOAD(RB, B);
                        V_COMP(A, RA);
                        V_ADV(us, ut, up, ub1); V_FETCH(A, ut, up, ub1); V_LOAD(RA, A);
                        V_COMP(B, RB);
                    }
                }
                PV_EPI(0, yA, ssq0);
                PV_EPI(1, yB, ssq1);
                { int yl[16];
#pragma unroll
                    for (int i = 0; i < 16; ++i) yl[i] = (int)accL[i * 64 + lane];
                    PV_EPI(2, yl, ssq2); }
                { int yl[16];
#pragma unroll
                    for (int i = 0; i < 16; ++i) yl[i] = (int)accL[1024 + i * 64 + lane];
                    PV_EPI(3, yl, ssq3); }
            }
#undef PV_EPI
#undef V_COMP
#undef V_QUAD
#undef V_LOAD
#undef V_FETCH
#undef V_ADV
#undef E_ADV
#undef E_FETCH
#undef E_LOAD
        }
        __syncthreads();
    }
}

#ifndef PROBE_ITEM
#define PROBE_ITEM -1
#endif
#define IREP(k) for (int irep = (PROBE_ITEM == (k)) ? 0 : 1; irep < 2; ++irep)
__device__ __forceinline__ void mix_p2(ArgsR A, int l, LAS unsigned char* lds, int G, int tid) {
    const int bx = blockIdx.x; (void)tid;
    IREP(1) for (int it = bx; it < 512; it += G) f_gla_p2(A, l, it, lds, pg8::fresh_tid());
    IREP(2) for (int it = bx; it < 512; it += G) f_ml_p2(A, l, it, lds, pg8::fresh_tid());
    IREP(3) for (int it = bx; it < 512; it += G) f_gdn_p2(A, l, it, lds, pg8::fresh_tid());
    IREP(4) for (int it = bx; it < 1024; it += G) f_lru_p2(A, l, it, lds, pg8::fresh_tid());
}
__device__ __forceinline__ void part_barrier(unsigned* word, unsigned nb, int tid) {
    asm volatile("s_waitcnt vmcnt(0)" ::: "memory");
    __syncthreads();
    if (tid == 0) {
        __builtin_amdgcn_fence(__ATOMIC_RELEASE, "agent");
        asm volatile("s_waitcnt vmcnt(0)" ::: "memory");
        __hip_atomic_fetch_add(word, 1u, __ATOMIC_RELAXED, __HIP_MEMORY_SCOPE_AGENT);
        unsigned sp = 0;
        while (__hip_atomic_load(word, __ATOMIC_RELAXED, __HIP_MEMORY_SCOPE_AGENT) < nb) { __builtin_amdgcn_s_sleep(2); if (++sp > (1u << 22)) break; }
        __builtin_amdgcn_fence(__ATOMIC_ACQUIRE, "agent");
        asm volatile("s_waitcnt vmcnt(0)" ::: "memory");
    }
    __syncthreads();
}
__device__ __forceinline__ void mix_p3(ArgsR A, int l, LAS unsigned char* lds, int G) {
    const int bx = blockIdx.x;
    const bool split = G > 32;
    int first = 0, nb = G;
    if (split) { if (bx < 16) { IREP(8) f_gdn_p3(A, l, bx, lds, pg8::fresh_tid()); return; } first = 16; nb = G - 16; }
    else { for (int it = bx; it < 16; it += G) f_gdn_p3(A, l, it, lds, pg8::fresh_tid()); }
    for (int it = bx - first; it < 516; it += nb) {
        if (it < 256) f_gla_p3(A, it, pg8::fresh_tid());
        else if (it < 512) f_ml_p3(A, it - 256, pg8::fresh_tid());
        else f_lru_p3(A, it - 512, pg8::fresh_tid());
    }
    IREP(7) { const int t2 = pg8::fresh_tid(); tab_convert(A, l, (bx - first) * NWAVES + __builtin_amdgcn_readfirstlane(t2 >> 6), nb * NWAVES, t2 & 63); }
    part_barrier((unsigned*)(A.ws + WS_CTL) + CW_PBAR + 64 * l, (unsigned)nb, pg8::fresh_tid());
    IREP(5) for (int it = bx - first; it < 512; it += nb) f_gla_p4(A, l, it, lds, pg8::fresh_tid());
    IREP(6) for (int it = nb - 1 - (bx - first); it < 512; it += nb) f_ml_p4(       A, l, it, lds, pg8::fresh_tid());
    for (int it = bx - first; it < 128; it += nb) f_lru_p4(A, it, pg8::fresh_tid());
}

#ifndef PROBE_PHASE
#define PROBE_PHASE -1
#endif
#ifndef MK_PER_PHASE
#define MK_PER_PHASE 0
#endif
#ifdef PROBE_DUP
constexpr int PPL = 7;
#else
constexpr int PPL = 6;
#endif
constexpr int NPHASE = 1 + PPL * DEPTH;
constexpr int CW_BAR = 4096;

__global__ void __launch_bounds__(NTHREADS, 2) mk_fwd(Args args) {
    extern __shared__ __attribute__((aligned(16))) unsigned char lds_raw[];
    LAS unsigned char* lds = (LAS unsigned char*)lds_raw;
    volatile LAS unsigned* MISC = (volatile LAS unsigned*)(lds + MISC_OFF);
    const int G = gridDim.x; const int bx = blockIdx.x;
    unsigned char* ws = args.ws;
    if (threadIdx.x < 64) MISC[threadIdx.x] = 0u;
    __syncthreads();
    XcdBarrier bar; bar.bar = (unsigned*)(ws + WS_CTL) + CW_BAR; bar.x = 0; bar.st = nullptr;
    if (!MK_PER_PHASE) bar = xcd_barrier_post((unsigned*)(ws + WS_CTL) + CW_BAR, MISC + 8);
    const int lo = args.ph_lo, hi = args.ph_hi;
#pragma unroll 1
    for (int ph = lo; ph < hi; ++ph) {
#ifdef PROBE_DUP
        const int l = ph > 0 ? (ph - 1) / PPL : 0, kx = ph > 0 ? (ph - 1) % PPL : -1, k = kx > PROBE_DUP ? kx - 1 : kx; const bool dry = (kx == PROBE_DUP);
#else
        const int l = ph > 0 ? (ph - 1) / PPL : 0, k = ph > 0 ? (ph - 1) % PPL : -1; const bool dry = false;
#endif
        if (k < 0) { const int t0 = pg8::fresh_tid(); const int vcu = (G % 8 == 0) ? (bx % 8) * (G / 8) + bx / 8 : bx; p0_prologue(*kargs(), lds, vcu, G, __builtin_amdgcn_readfirstlane(t0 >> 6), t0 & 63); }
        else if (k == 0) {
            pg8::Gemm g{(const pg8::bf16_t*)(ws + WS_XB), (const pg8::bf16_t*)(ws + WS_WIN + l * WIN_L), NT, NINP, DM}; pg8::StaticOrder S; S.init(NT, NINP, G, bx);
            pg8::EpiP E{(pg8::bf16_t*)(ws + WS_P), (float*)(ws + WS_PS), (const float*)(ws + WS_RSTD1)};
            pg8::gemm_phase<pg8::EpiP, pg8::StaticOrder, true, true>(lds, g, S, E); }
        else if (k == 1) mix_p2(*kargs(), l, lds, G, pg8::fresh_tid());
        else if (k == 2) mix_p3(*kargs(), l, lds, G);
        else if (k == 3) {
            pg8::Gemm g{(const pg8::bf16_t*)(ws + WS_MIX), (const pg8::bf16_t*)(ws + WS_WOUT + l * WSQ_L), NT, DM, DM}; pg8::StaticOrder S; S.init(NT, DM, G, bx);
            pg8::EpiX E{l == 0 ? args.in[I_X] : (const float*)args.out, dry ? (float*)(ws + WS_P) : args.out, (pg8::bf16_t*)(ws + (dry ? WS_Q : WS_XB)), (float*)(ws + (dry ? WS_PS : WS_SSP))};
            pg8::gemm_phase<pg8::EpiX, pg8::StaticOrder, true, true>(lds, g, S, E); }
        else if (k == 4) {
            pg8::Gemm g{(const pg8::bf16_t*)(ws + WS_XB), (const pg8::bf16_t*)(ws + WS_WQ + l * WSQ_L), NT, DM, DM}; pg8::StaticOrder S; S.init(NT, DM, G, bx);
            pg8::EpiQ E{(pg8::bf16_t*)(ws + WS_Q), (const float*)(ws + WS_SSP)};
            pg8::gemm_phase<pg8::EpiQ, pg8::StaticOrder, true, true>(lds, g, S, E); }
        else peer_phase(*kargs(), l, l == DEPTH - 1, dry, lds, G, pg8::fresh_tid());
        if (!MK_PER_PHASE && ph + 1 < hi) xcd_barrier(bar);
    }
}

extern "C" void kernel_launch(void* const* d_in, const int* in_sizes, int n_in, void* d_out, int out_size, void* d_ws, size_t ws_size, hipStream_t stream) {
    static int grid = 0;
    if (grid == 0) {
        if (n_in != N_IN || out_size != NT * DM || ws_size < WS_END) { fprintf(stderr, "kernel_launch: unexpected shapes: n_in %d out %d ws %zu (need %zu)\n", n_in, out_size, ws_size, (size_t)WS_END); grid = -1; return; }
        int dev = 0, cus = 0, per_cu = 0;
        if (hipGetDevice(&dev) != hipSuccess || hipDeviceGetAttribute(&cus, hipDeviceAttributeMultiprocessorCount, dev) != hipSuccess) { grid = -1; return; }
        if (hipFuncSetAttribute((const void*)mk_fwd, hipFuncAttributeMaxDynamicSharedMemorySize, LDS_BYTES) != hipSuccess) { fprintf(stderr, "kernel_launch: hipFuncSetAttribute failed\n"); grid = -1; return; }
        if (hipOccupancyMaxActiveBlocksPerMultiprocessor(&per_cu, (const void*)mk_fwd, NTHREADS, LDS_BYTES) != hipSuccess || per_cu < 1) { fprintf(stderr, "kernel_launch: occupancy query says %d blocks per CU\n", per_cu); (void)hipGetLastError(); grid = -1; return; }
        grid = cus;
    }
    if (grid < 0) return;
    if (hipMemsetAsync((char*)d_ws + WS_CTL, 0, CTL_ZERO_BYTES, stream) != hipSuccess) return;
    Args a{};
    for (int i = 0; i < N_IN; ++i) a.in[i] = (const float*)d_in[i];
    a.out = (float*)d_out; a.ws = (unsigned char*)d_ws;
#if MK_PER_PHASE
    for (int p = 0; p < NPHASE; ++p) { a.ph_lo = p; a.ph_hi = p + 1; a.li = 0; hipLaunchKernelGGL(mk_fwd, dim3(grid), dim3(NTHREADS), LDS_BYTES, stream, a); }
#else
    a.ph_lo = 0; a.ph_hi = NPHASE; a.li = 0;
    hipLaunchKernelGGL(mk_fwd, dim3(grid), dim3(NTHREADS), LDS_BYTES, stream, a);
#endif
}
```

```cpp
#include <hip/hip_runtime.h>
#include <cstdio>
#include <cstdint>
namespace pg8 {
__device__ __forceinline__ int fresh_tid() { int t = threadIdx.x; asm volatile("" : "+v"(t)); return t; }
#define PG8_LAS __attribute__((address_space(3)))
typedef unsigned short bf16_t;
typedef short bf16x8 __attribute__((ext_vector_type(8)));
typedef float f32x4 __attribute__((ext_vector_type(4)));
typedef unsigned u32x4 __attribute__((ext_vector_type(4)));
constexpr int BM = 256, BK = 64, HALF = 128, HTB = HALF * BK * 2  , STAGE_BYTES = 8 * HTB, NXCD = 8, WGM = 8;

__host__ __device__ __forceinline__ int lds_byte(int r, int c) { const int st = (r >> 4) * 2 + (c >> 5), rr = r & 15, cc = c & 31, ob = rr * 64 + cc * 2; return st * 1024 + (ob ^ (((ob >> 9) & 1) << 5)); }
__host__ __device__ __forceinline__ void stage_rc(int b, int& R, int& C) { const int st = b / 1024, sb = b % 1024, swz = sb ^ (((sb >> 9) & 1) << 5); R = (st >> 1) * 16 + swz / 64; C = (st & 1) * 32 + (swz % 64) / 2; }
__host__ __device__ __forceinline__ int perm32(int rho) { const int n = rho >> 4, i = rho & 15; return 8 * (i >> 2) + 4 * n + (i & 3); }

struct Unit { int pm, pn; };
struct Gemm { const bf16_t* A; const bf16_t* Bt; int M, N, K; };

struct StaticOrder {
    int nM, nN, nwg, G, c;
    __host__ __device__ void init(int M, int N, int G_, int c_) { nM = M / BM; nN = N / BM; nwg = nM * nN; G = G_; c = c_; }
    __host__ __device__ bool next(int i, Unit& u) const {
        const long L = (long)i * G + c; if (L >= nwg) return false;
        int wgid = (int)L; { const int q = nwg / NXCD, r = nwg % NXCD, xcd = wgid % NXCD, off = wgid / NXCD; wgid = (xcd < r ? xcd * (q + 1) : r * (q + 1) + (xcd - r) * q) + off; }
        const int nig = WGM * nN, gid = wgid / nig, fm = gid * WGM, gsz = (nM - fm) < WGM ? (nM - fm) : WGM;
        u.pm = fm + ((wgid % nig) % gsz); u.pn = (wgid % nig) / gsz; return true;
    }
    __device__ __forceinline__ void a_ready(const Unit&) const {}
    __device__ __forceinline__ void done(const Unit&) const {}
};


__device__ __forceinline__ unsigned cvt_pk_bf16(float lo, float hi) { unsigned r; asm volatile("v_cvt_pk_bf16_f32 %0, %1, %2" : "=v"(r) : "v"(lo), "v"(hi)); return r; }

struct EpiP {
    static constexpr bool PERM = true, AFTER_DRAIN = false;
    bf16_t* P; float* Ps; const float* rstd;
    __device__ __forceinline__ void operator()(const f32x4 (&acc)[2][2][4][2], const Unit& u, int wr, int wc, int fr, int fq) const {
        const int row0 = u.pm * BM + wr * 64 + fr;
        if (u.pn < 28) {
            const int col0 = u.pn * BM + wc * 32 + 8 * fq;
#pragma unroll
            for (int ai = 0; ai < 2; ++ai)
#pragma unroll
                for (int m = 0; m < 4; ++m) { const int row = row0 + ai * HALF + m * 16; const float r = rstd[row]; bf16_t* rowp = P + (size_t)row * 7168 + col0;
#pragma unroll
                    for (int bj = 0; bj < 2; ++bj) { const f32x4 v0 = acc[ai][bj][m][0] * r, v1 = acc[ai][bj][m][1] * r;
                        u32x4 w; w.x = cvt_pk_bf16(v0[0], v0[1]); w.y = cvt_pk_bf16(v0[2], v0[3]); w.z = cvt_pk_bf16(v1[0], v1[1]); w.w = cvt_pk_bf16(v1[2], v1[3]);
                        *(u32x4*)(rowp + bj * HALF) = w; } }
        } else if (wc == 0) {
#pragma unroll
            for (int ai = 0; ai < 2; ++ai)
#pragma unroll
                for (int m = 0; m < 4; ++m) { const int row = row0 + ai * HALF + m * 16; const float r = rstd[row]; float* p = Ps + (size_t)row * 32 + 8 * fq;
                    *(f32x4*)p = acc[ai][0][m][0] * r; *(f32x4*)(p + 4) = acc[ai][0][m][1] * r; }
        }
    }
};
struct EpiX {
    static constexpr bool PERM = true, AFTER_DRAIN = false;
    const float* xres; float* xout; bf16_t* xb; float* ssp;
    __device__ __forceinline__ void operator()(const f32x4 (&acc)[2][2][4][2], const Unit& u, int wr, int wc, int fr, int fq) const {
        const int row0 = u.pm * BM + wr * 64 + fr, col0 = u.pn * BM + wc * 32 + 8 * fq;
#pragma unroll
        for (int ai = 0; ai < 2; ++ai)
#pragma unroll
            for (int m = 0; m < 4; ++m) { const int row = row0 + ai * HALF + m * 16; float ss = 0.f;
#pragma unroll
                for (int bj = 0; bj < 2; ++bj) { const size_t off = (size_t)row * 2048 + col0 + bj * HALF;
                    const f32x4 r0 = *(const f32x4*)(xres + off), r1 = *(const f32x4*)(xres + off + 4);
                    const f32x4 v0 = acc[ai][bj][m][0] + r0, v1 = acc[ai][bj][m][1] + r1;
                    *(f32x4*)(xout + off) = v0; *(f32x4*)(xout + off + 4) = v1;
                    u32x4 w; w.x = cvt_pk_bf16(v0[0], v0[1]); w.y = cvt_pk_bf16(v0[2], v0[3]); w.z = cvt_pk_bf16(v1[0], v1[1]); w.w = cvt_pk_bf16(v1[2], v1[3]);
                    *(u32x4*)(xb + off) = w;
                    ss += (v0[0] * v0[0] + v0[1] * v0[1]) + (v0[2] * v0[2] + v0[3] * v0[3]) + (v1[0] * v1[0] + v1[1] * v1[1]) + (v1[2] * v1[2] + v1[3] * v1[3]); }
                ss += __shfl_xor(ss, 16); ss += __shfl_xor(ss, 32);
                if (fq == 0) ssp[(size_t)row * 32 + u.pn * 4 + wc] = ss; }
    }
};
struct EpiQ {
    static constexpr bool PERM = true, AFTER_DRAIN = false;
    bf16_t* Q; const float* ssp;
    __device__ __forceinline__ void operator()(const f32x4 (&acc)[2][2][4][2], const Unit& u, int wr, int wc, int fr, int fq) const {
        const int row0 = u.pm * BM + wr * 64 + fr, col0 = u.pn * BM + wc * 32 + 8 * fq;
#pragma unroll
        for (int ai = 0; ai < 2; ++ai)
#pragma unroll
            for (int m = 0; m < 4; ++m) { const int row = row0 + ai * HALF + m * 16;
                const f32x4* sp = (const f32x4*)(ssp + (size_t)row * 32 + 8 * fq); const f32x4 a = sp[0], b = sp[1];
                float s = ((a[0] + a[1]) + (a[2] + a[3])) + ((b[0] + b[1]) + (b[2] + b[3]));
                s += __shfl_xor(s, 16); s += __shfl_xor(s, 32);
                const float r = rsqrtf(s * (1.0f / 2048.0f) + 1e-6f); bf16_t* rowp = Q + (size_t)row * 2048 + col0;
#pragma unroll
                for (int bj = 0; bj < 2; ++bj) { const f32x4 v0 = acc[ai][bj][m][0] * r, v1 = acc[ai][bj][m][1] * r;
                    u32x4 w; w.x = cvt_pk_bf16(v0[0], v0[1]); w.y = cvt_pk_bf16(v0[2], v0[3]); w.z = cvt_pk_bf16(v1[0], v1[1]); w.w = cvt_pk_bf16(v1[2], v1[3]);
                    *(u32x4*)(rowp + bj * HALF) = w; } }
    }
};

template <class Epi, class Sched, bool ALIGN_EPI = false, bool SP2 = false>
__device__ __forceinline__ void gemm_phase(PG8_LAS unsigned char* lds, const Gemm g, const Sched& S, const Epi& E) {
    const int tid = fresh_tid(), wid = __builtin_amdgcn_readfirstlane(tid >> 6), lane = tid & 63, wr = wid >> 2, wc = wid & 3, fr = lane & 15, fq = lane >> 4;
    const int K = g.K, nt = K / BK;
    unsigned voffA[2], voffB[2];
#pragma unroll
    for (int i = 0; i < 2; ++i) { int R, C; stage_rc(tid * 16 + i * 8192, R, C); const int Rb = Epi::PERM ? ((R & ~31) + perm32(R & 31)) : R;
        voffA[i] = (unsigned)(R * K + C) * 2u; voffB[i] = (unsigned)(Rb * K + C) * 2u; }
    const size_t kstep = (size_t)(BK * 2);
    const size_t hstep = (size_t)HALF * K * 2;
    const size_t tstep = 2 * hstep;
    const unsigned ldsw = (unsigned)wid * 1024u;
    const int aoff = lds_byte(wr * 64 + fr, fq * 8), boff = lds_byte(wc * 32 + fr, fq * 8);
#define PG8_SA(b, h) (((b) * 2 + (h)) * HTB)
#define PG8_SB(b, h) ((4 + (b) * 2 + (h)) * HTB)
#define PG8_STAGE(bufoff, gbase, voff) do { _Pragma("unroll") for (int _i = 0; _i < 2; ++_i) \
        __builtin_amdgcn_global_load_lds((const unsigned*)((const char*)(gbase) + (voff)[_i]), (PG8_LAS unsigned*)(lds + (bufoff) + ldsw + _i * 8192), 16, 0, 0); } while (0)
#define PG8_LDA(dst, b, h) do { _Pragma("unroll") for (int m = 0; m < 4; ++m) _Pragma("unroll") for (int k = 0; k < 2; ++k) dst[m][k] = *(const PG8_LAS bf16x8*)(lds + PG8_SA(b, h) + aoff + m * 2048 + k * 1024); } while (0)
#define PG8_LDB(dst, b, h) do { _Pragma("unroll") for (int n = 0; n < 2; ++n) _Pragma("unroll") for (int k = 0; k < 2; ++k) dst[n][k] = *(const PG8_LAS bf16x8*)(lds + PG8_SB(b, h) + boff + n * 2048 + k * 1024); } while (0)
#define PG8_MMA(ai, bj, At, Bt) do { __builtin_amdgcn_s_setprio(1); _Pragma("unroll") for (int m = 0; m < 4; ++m) _Pragma("unroll") for (int n = 0; n < 2; ++n) _Pragma("unroll") for (int k = 0; k < 2; ++k) \
        acc[ai][bj][m][n] = __builtin_amdgcn_mfma_f32_16x16x32_bf16(Bt[n][k], At[m][k], acc[ai][bj][m][n], 0, 0, 0); __builtin_amdgcn_s_setprio(0); } while (0)
#define PG8_WAIT_V(n) asm volatile("s_waitcnt vmcnt(" #n ")" ::: "memory")
#define PG8_WAIT_L(n) asm volatile("s_waitcnt lgkmcnt(" #n ")" ::: "memory")
#define PG8_BAR __builtin_amdgcn_s_barrier()
#define PG8_SCHED __builtin_amdgcn_sched_barrier(0)
    Unit cur, nxt; int ui = 0;
    if (!S.next(0, cur)) return;
    f32x4 acc[2][2][4][2];
#pragma unroll
    for (int a = 0; a < 2; ++a)
#pragma unroll
        for (int b = 0; b < 2; ++b)
#pragma unroll
            for (int m = 0; m < 4; ++m)
#pragma unroll
                for (int n = 0; n < 2; ++n) acc[a][b][m][n] = (f32x4){0.f, 0.f, 0.f, 0.f};
    bf16x8 At[4][2], B0[2][2], B1[2][2];
    const char* cA = (const char*)g.A + (size_t)cur.pm * tstep; const char* cB = (const char*)g.Bt + (size_t)cur.pn * tstep;
    S.a_ready(cur);
    if constexpr (SP2) {
        PG8_STAGE(PG8_SB(0, 0), cB, voffB); PG8_STAGE(PG8_SB(0, 1), cB + hstep, voffB); PG8_STAGE(PG8_SA(0, 0), cA, voffA); PG8_STAGE(PG8_SA(0, 1), cA + hstep, voffA);
        if (wr == 1) PG8_BAR;
        PG8_WAIT_V(2); PG8_BAR;
        PG8_STAGE(PG8_SB(1, 0), cB + kstep, voffB); PG8_STAGE(PG8_SA(1, 0), cA + kstep, voffA); PG8_STAGE(PG8_SB(1, 1), cB + hstep + kstep, voffB);
        PG8_WAIT_V(6); PG8_BAR;
    } else {
        PG8_STAGE(PG8_SB(0, 0), cB, voffB); PG8_STAGE(PG8_SA(0, 0), cA, voffA); PG8_STAGE(PG8_SB(0, 1), cB + hstep, voffB); PG8_STAGE(PG8_SA(0, 1), cA + hstep, voffA);
        if (wr == 1) PG8_BAR;
        PG8_WAIT_V(4); PG8_BAR;
        PG8_STAGE(PG8_SB(1, 0), cB + kstep, voffB); PG8_STAGE(PG8_SA(1, 0), cA + kstep, voffA); PG8_STAGE(PG8_SB(1, 1), cB + hstep + kstep, voffB);
        PG8_WAIT_V(6); PG8_BAR;
    }
    for (;;) {
        const bool has_next = S.next(ui + 1, nxt);
        const char* nA = has_next ? (const char*)g.A + (size_t)nxt.pm * tstep : cA; const char* nB = has_next ? (const char*)g.Bt + (size_t)nxt.pn * tstep : cB;
        for (int t = 0; t < nt; t += 2) {
            const bool last = (t == nt - 2);
            const char* a1 = cA + (size_t)(t + 1) * kstep;
            const char* a2 = last ? nA : cA + (size_t)(t + 2) * kstep; const char* b2 = last ? nB : cB + (size_t)(t + 2) * kstep;
            const char* a3 = a2 + kstep; const char* b3 = b2 + kstep;
            if (last && has_next) S.a_ready(nxt);
            if constexpr (SP2) {
            PG8_LDB(B0, 0, 0); PG8_LDB(B1, 0, 1); PG8_SCHED; PG8_LDA(At, 0, 0); PG8_STAGE(PG8_SA(1, 1), a1 + hstep, voffA);
            PG8_WAIT_V(8); PG8_WAIT_L(0); PG8_BAR; PG8_MMA(0, 0, At, B0); PG8_MMA(0, 1, At, B1); PG8_BAR; PG8_SCHED;
            PG8_LDA(At, 0, 1); PG8_STAGE(PG8_SB(0, 0), b2, voffB); PG8_STAGE(PG8_SB(0, 1), b2 + hstep, voffB); PG8_STAGE(PG8_SA(0, 0), a2, voffA);
            PG8_WAIT_V(8); PG8_WAIT_L(0); PG8_BAR; PG8_MMA(1, 0, At, B0); PG8_MMA(1, 1, At, B1); PG8_BAR; PG8_SCHED;
            PG8_LDB(B0, 1, 0); PG8_LDB(B1, 1, 1); PG8_SCHED; PG8_LDA(At, 1, 0); PG8_STAGE(PG8_SA(0, 1), a2 + hstep, voffA);
            PG8_WAIT_V(8); PG8_WAIT_L(0); PG8_BAR; PG8_MMA(0, 0, At, B0); PG8_MMA(0, 1, At, B1); PG8_BAR; PG8_SCHED;
            PG8_LDA(At, 1, 1); PG8_STAGE(PG8_SB(1, 0), b3, voffB); PG8_STAGE(PG8_SB(1, 1), b3 + hstep, voffB); PG8_STAGE(PG8_SA(1, 0), a3, voffA);
            PG8_WAIT_V(8); PG8_WAIT_L(0); PG8_BAR; PG8_MMA(1, 0, At, B0); PG8_MMA(1, 1, At, B1); PG8_BAR; PG8_SCHED;
            } else {
            PG8_LDB(B0, 0, 0); PG8_SCHED; PG8_LDA(At, 0, 0); PG8_STAGE(PG8_SA(1, 1), a1 + hstep, voffA);
            PG8_WAIT_L(8); PG8_BAR; PG8_WAIT_L(0); PG8_MMA(0, 0, At, B0); PG8_BAR; PG8_SCHED;
            PG8_LDB(B1, 0, 1); PG8_STAGE(PG8_SB(0, 0), b2, voffB);
            PG8_BAR; PG8_WAIT_L(0); PG8_MMA(0, 1, At, B1); PG8_BAR;
            PG8_LDA(At, 0, 1); PG8_STAGE(PG8_SA(0, 0), a2, voffA);
            PG8_BAR; PG8_WAIT_L(0); PG8_MMA(1, 0, At, B0); PG8_BAR; PG8_SCHED;
            PG8_STAGE(PG8_SB(0, 1), b2 + hstep, voffB);
            PG8_WAIT_V(6); PG8_BAR; PG8_MMA(1, 1, At, B1); PG8_BAR;
            PG8_LDB(B0, 1, 0); PG8_SCHED; PG8_LDA(At, 1, 0); PG8_STAGE(PG8_SA(0, 1), a2 + hstep, voffA);
            PG8_WAIT_L(8); PG8_BAR; PG8_WAIT_L(0); PG8_MMA(0, 0, At, B0); PG8_BAR; PG8_SCHED;
            PG8_LDB(B1, 1, 1); PG8_STAGE(PG8_SB(1, 0), b3, voffB);
            PG8_BAR; PG8_WAIT_L(0); PG8_MMA(0, 1, At, B1); PG8_BAR;
            PG8_LDA(At, 1, 1); PG8_STAGE(PG8_SA(1, 0), a3, voffA);
            PG8_BAR; PG8_WAIT_L(0); PG8_MMA(1, 0, At, B0); PG8_BAR; PG8_SCHED;
            PG8_STAGE(PG8_SB(1, 1), b3 + hstep, voffB);
            PG8_WAIT_V(6); PG8_BAR; PG8_MMA(1, 1, At, B1); PG8_BAR;
            }
        }
        if constexpr (ALIGN_EPI) { if (wr == 0) PG8_BAR; }
        if constexpr (!Epi::AFTER_DRAIN) { E(acc, cur, wr, wc, fr, fq); S.done(cur); }
        if (!has_next) break;
#pragma unroll
        for (int a = 0; a < 2; ++a)
#pragma unroll
            for (int b = 0; b < 2; ++b)
#pragma unroll
                for (int m = 0; m < 4; ++m)
#pragma unroll
                    for (int n = 0; n < 2; ++n) acc[a][b][m][n] = (f32x4){0.f, 0.f, 0.f, 0.f};
        cur = nxt; cA = nA; cB = nB; ++ui;
        if constexpr (ALIGN_EPI) { if (wr == 1) PG8_BAR; }
    }
    PG8_WAIT_V(0);
    if constexpr (!ALIGN_EPI) { if (wr == 0) PG8_BAR; }
    PG8_BAR;
    if constexpr (Epi::AFTER_DRAIN) { E.fused(acc, cur, wr, wc, fr, fq, lds, wid, lane); S.done(cur); }
#undef PG8_SA
#undef PG8_SB
#undef PG8_STAGE
#undef PG8_LDA
#undef PG8_LDB
#undef PG8_MMA
#undef PG8_WAIT_V
#undef PG8_WAIT_L
#undef PG8_BAR
#undef PG8_SCHED
}
}

constexpr int NWAVES = 8, NTHREADS = 512;
constexpr int NT = 8192, DM = 2048, SEQ = 2048, NBATCH = 4, DEPTH = 2, CHK = 64, NCHK = 32, GW = 512, NH = 4, HD = 128;
constexpr int DIN = 7200, NINP = 7424, PBW = 7168;
constexpr int NEXP = 16384;
constexpr int PC_GLA_Q = 0, PC_GLA_K = 512, PC_GLA_V = 1024, PC_GLA_G = 1536, PC_LRU_X = 2048, PC_LRU_Y = 2560, PC_ML_Q = 3072, PC_ML_K = 3584, PC_ML_V = 4096, PC_ML_O = 4608,
              PC_GDN_Q = 5120, PC_GDN_K = 5632, PC_GDN_V = 6144, PC_GDN_G = 6656;
constexpr int PS_LR = 0, PS_MI = 16, PS_MF = 20, PS_GB = 24, PS_GA = 28;
constexpr float RMS_EPS = 1e-6f;
enum { I_X = 0, I_N1G, I_WIN, I_WOUT, I_GLA_W2, I_GLA_B2, I_GLA_NG, I_LRU_CW, I_LRU_CB, I_LRU_WA, I_LRU_BA, I_LRU_WX, I_LRU_BX, I_LRU_LAM, I_ML_IB, I_ML_FB, I_ML_NG,
       I_GDN_CW, I_GDN_ALOG, I_GDN_DTB, I_GDN_NG, I_N2G, I_PWQ, I_PK1, I_PK2, I_PU, I_PV, I_FNG, N_IN };

constexpr size_t MiB = 1u << 20;
constexpr size_t WS_CTL = 0, CTL_ZERO_BYTES = 1 * MiB;
constexpr size_t WS_WIN = 2 * MiB;
constexpr size_t WIN_L = (size_t)NINP * DM * 2;
constexpr size_t WS_WOUT = 60 * MiB;
constexpr size_t WS_WQ = 76 * MiB;
constexpr size_t WSQ_L = (size_t)DM * DM * 2;
constexpr size_t WS_K1 = 92 * MiB, WS_K2 = 92 * MiB + 512 * 1024;
constexpr size_t WS_RSTD1 = 93 * MiB;
constexpr size_t WS_SSP = 94 * MiB;
constexpr size_t WS_XB = 96 * MiB;
constexpr size_t WS_P = 128 * MiB;
constexpr size_t WS_PS = 240 * MiB;
constexpr size_t WS_MIX = 242 * MiB;
constexpr size_t WS_Q = 274 * MiB;
constexpr size_t WS_UB = 306 * MiB;
constexpr size_t WS_VB = 434 * MiB;
constexpr size_t TAB_L = (size_t)NEXP * DM * 2;
constexpr size_t WS_SCR = 562 * MiB;
constexpr size_t WS_END = 900 * MiB;

constexpr int LDS_BYTES = 155648;
constexpr int MISC_OFF = LDS_BYTES - 256;

#define GAS __attribute__((address_space(1)))
#define LAS __attribute__((address_space(3)))
typedef unsigned short bf16;
typedef unsigned v4u __attribute__((ext_vector_type(4)));
typedef unsigned v2u __attribute__((ext_vector_type(2)));
typedef float f32x4 __attribute__((ext_vector_type(4)));
typedef float f32x2 __attribute__((ext_vector_type(2)));
typedef short bf16x8 __attribute__((ext_vector_type(8)));
typedef short bf16x4 __attribute__((ext_vector_type(4)));
typedef __bf16 bf2_t __attribute__((ext_vector_type(2)));
typedef GAS unsigned gu32;
#define RLX_AGENT __ATOMIC_RELAXED, __HIP_MEMORY_SCOPE_AGENT
__device__ __forceinline__ unsigned f2bf(float f) { unsigned u = __builtin_bit_cast(unsigned, f); return (u + 0x7fffu + ((u >> 16) & 1u)) >> 16; }
__device__ __forceinline__ unsigned pk2(float lo, float hi) { return f2bf(lo) | (f2bf(hi) << 16); }
__device__ __forceinline__ float bf2f(unsigned b) { return __builtin_bit_cast(float, b << 16); }
__device__ __forceinline__ float bflo(unsigned w) { return __builtin_bit_cast(float, w << 16); }
__device__ __forceinline__ float bfhi(unsigned w) { return __builtin_bit_cast(float, w & 0xffff0000u); }
template <int CTRL> __device__ __forceinline__ unsigned dpp_rot_u(unsigned v) { return (unsigned)__builtin_amdgcn_update_dpp(0, (int)v, CTRL, 0xf, 0xf, false); }
__device__ __forceinline__ unsigned row_max_u(unsigned v) { v = max(v, dpp_rot_u<0x121>(v)); v = max(v, dpp_rot_u<0x122>(v)); v = max(v, dpp_rot_u<0x124>(v)); v = max(v, dpp_rot_u<0x128>(v)); return v; }
template <int CTRL> __device__ __forceinline__ float dpp_rotf(float v) { const unsigned u = __builtin_bit_cast(unsigned, v); return __builtin_bit_cast(float, dpp_rot_u<CTRL>(u)); }
__device__ __forceinline__ float row_max_f(float v) { v = fmaxf(v, dpp_rotf<0x121>(v)); v = fmaxf(v, dpp_rotf<0x122>(v)); v = fmaxf(v, dpp_rotf<0x124>(v)); v = fmaxf(v, dpp_rotf<0x128>(v)); return v; }
__device__ __forceinline__ float row_sum_f(float v) { v += dpp_rotf<0x121>(v); v += dpp_rotf<0x122>(v); v += dpp_rotf<0x124>(v); v += dpp_rotf<0x128>(v); return v; }

__device__ __forceinline__ float oct_sum_f(float v) { v += dpp_rotf<0xB1>(v); v += dpp_rotf<0x4E>(v); v += dpp_rotf<0x141>(v); return v; }
__device__ __forceinline__ float lane_bcast(float v, int l) { return __builtin_bit_cast(float, __builtin_amdgcn_readlane(__builtin_bit_cast(int, v), l)); }
__device__ __forceinline__ float wave_sum(float v) { const float r = row_sum_f(v); return (lane_bcast(r, 0) + lane_bcast(r, 16)) + (lane_bcast(r, 32) + lane_bcast(r, 48)); }
__device__ __forceinline__ float wave_max(float v) { const float r = row_max_f(v); return fmaxf(fmaxf(lane_bcast(r, 0), lane_bcast(r, 16)), fmaxf(lane_bcast(r, 32), lane_bcast(r, 48))); }
__device__ __forceinline__ float rcpf_(float x) { return __builtin_amdgcn_rcpf(x); }
__device__ __forceinline__ float sigmoidf_(float x) { return rcpf_(1.0f + __expf(-x)); }
__device__ __forceinline__ float siluf_(float x) { return x * rcpf_(1.0f + __expf(-x)); }
__device__ __forceinline__ float softplusf_(float x) { return fmaxf(x, 0.f) + __logf(1.0f + __expf(-fabsf(x))); }
__device__ __forceinline__ float logsigmoidf_(float x) { return fminf(x, 0.f) - __logf(1.0f + __expf(-fabsf(x))); }
__device__ __forceinline__ float gelu_tanh(float x) { const float u = 1.5957691216057308f * (x + 0.044715f * x * x * x); return x * rcpf_(1.0f + __expf(-u)); }

#define XB_TMO      128
#define XB_XCNT(j)  (256  + 64 * (j))
#define XB_XSUB(j)  (1280 + 64 * (j))
#define XB_XGEN(j)  (2304 + 64 * (j))
#define XB_TOP      3328
#define XB_TOPGEN   3392
#define XCD_BAR_WORDS 3456
#define XB_SPIN_CAP (1u << 18)

__device__ __forceinline__ unsigned xb_ld(unsigned* p)              { return __hip_atomic_load(p, __ATOMIC_RELAXED, __HIP_MEMORY_SCOPE_AGENT); }
__device__ __forceinline__ unsigned xb_add(unsigned* p, unsigned v) { return __hip_atomic_fetch_add(p, v, __ATOMIC_RELAXED, __HIP_MEMORY_SCOPE_AGENT); }
__device__ __forceinline__ unsigned xb_xcc_id() { return (unsigned)__builtin_amdgcn_s_getreg((3 << 11) | 20) & 0xFu; }
#define XB_SPIN(cond, bar) do { unsigned _sp = 0; while (cond) { __builtin_amdgcn_s_sleep(1); \
    if ((++_sp & 255u) == 0u) { if (xb_ld(&(bar)[XB_TMO])) break; if (_sp > XB_SPIN_CAP) { atomicAdd(&(bar)[XB_TMO], 1u); break; } } } } while (0)

struct XcdBarrier {
    unsigned* bar; unsigned x;
    volatile LAS unsigned* st;
};

__device__ __forceinline__ XcdBarrier xcd_barrier_post(unsigned* bar, volatile LAS unsigned* st) {
    XcdBarrier b; b.bar = bar; b.x = xb_xcc_id(); b.st = st;
    if (threadIdx.x == 0) (void)xb_add(&bar[XB_XCNT(b.x)], 1u);
    return b;
}
__device__ __forceinline__ void xcd_barrier_complete(unsigned* bar, unsigned x, unsigned& nloc, unsigned& nx) {
    const unsigned G = gridDim.x * gridDim.y * gridDim.z;
    unsigned sum, cnt, mine, sp = 0u;
    for (;;) {
        sum = 0u; cnt = 0u; mine = 0u;
#pragma unroll
        for (unsigned j = 0; j < 16; ++j) { const unsigned c = xb_ld(&bar[XB_XCNT(j)]); sum += c; cnt += (c > 0u) ? 1u : 0u; mine = (j == x) ? c : mine; }
        if (sum == G) break;
        __builtin_amdgcn_s_sleep(1);
        if ((++sp & 255u) == 0u) { if (xb_ld(&bar[XB_TMO])) break; if (sp > XB_SPIN_CAP) { atomicAdd(&bar[XB_TMO], 1u); break; } }
    }
    nloc = mine > 0u ? mine : 1u; nx = cnt > 0u ? cnt : 1u;
}

__device__ __forceinline__ void xcd_barrier(const XcdBarrier& b) {
    asm volatile("s_waitcnt vmcnt(0)" ::: "memory");
    __syncthreads();
    if (threadIdx.x == 0) {
        unsigned* bar = b.bar; asm volatile("" : "+s"(bar));
        __builtin_amdgcn_s_waitcnt(0);
        unsigned nloc = b.st[0], nx = b.st[1];
        if (nloc == 0u) { xcd_barrier_complete(bar, b.x, nloc, nx); b.st[0] = nloc; b.st[1] = nx; }
        const unsigned old = xb_add(&bar[XB_XSUB(b.x)], 1u);
        const unsigned gen = old / nloc;
        if (old + 1u == (gen + 1u) * nloc) {
            __builtin_amdgcn_fence(__ATOMIC_RELEASE, "agent");
            asm volatile("s_waitcnt vmcnt(0)" ::: "memory");
            const unsigned og = xb_add(&bar[XB_TOP], 1u);
            const unsigned tg = og / nx;
            if (og + 1u == (tg + 1u) * nx) xb_add(&bar[XB_TOPGEN], 1u);
            else XB_SPIN(xb_ld(&bar[XB_TOPGEN]) == tg, bar);
            __builtin_amdgcn_fence(__ATOMIC_ACQUIRE, "agent");
            xb_add(&bar[XB_XGEN(b.x)], 1u);
            asm volatile("s_waitcnt vmcnt(0)" ::: "memory");
        } else {
            XB_SPIN(xb_ld(&bar[XB_XGEN(b.x)]) == gen, bar);
            __builtin_amdgcn_fence(__ATOMIC_ACQUIRE, "agent");
            asm volatile("s_waitcnt vmcnt(0)" ::: "memory");
        }
    }
    __syncthreads();
}


struct Args { const float* in[N_IN]; float* out; unsigned char* ws; int ph_lo, ph_hi, li, pad; };
typedef const __attribute__((address_space(4))) Args& ArgsR;
__device__ __forceinline__ const __attribute__((address_space(4))) Args* kargs() { unsigned long long p = (unsigned long long)__builtin_amdgcn_kernarg_segment_ptr(); asm volatile("" : "+s"(p)); return (const __attribute__((address_space(4))) Args*)p; }

__device__ __forceinline__ int win_src_col(int n) {
    if (n < 2048) return n;
    if (n < 3072) return 2064 + (n - 2048);
    if (n < 5120) return 3088 + (n - 3072);
    if (n < 7168) return 5144 + (n - 5120);
    if (n < 7184) return 2048 + (n - 7168);
    if (n < 7192) return 5136 + (n - 7184);
    if (n < 7200) return n;
    return -1;
}
template <bool MAP>
__device__ __forceinline__ void p0_transpose_item(const float* W, int K, int Nsrc, int Ndst, const float* gain, bf16* WT, LAS float* scr, int item, int lane) {
    const int nblk = Ndst / 32, kb = item / nblk, nb = item % nblk, k0 = 64 * kb, n0 = 32 * nb;
    const int nn = n0 + (lane & 31); const int src = MAP ? win_src_col(nn) : nn;
    float tv[32];
#pragma unroll
    for (int i = 0; i < 32; ++i) { const int kk = 2 * i + (lane >> 5); tv[i] = (src >= 0) ? W[(size_t)(k0 + kk) * Nsrc + src] : 0.f; }
#pragma unroll
    for (int i = 0; i < 32; ++i) { const int kk = 2 * i + (lane >> 5); float v = tv[i]; if (gain) v *= gain[k0 + kk]; scr[kk * 33 + (lane & 31)] = v; }
    asm volatile("s_waitcnt lgkmcnt(0)" ::: "memory");
    const int c = lane & 7;
#pragma unroll
    for (int j = 0; j < 4; ++j) { const int n = (lane >> 3) + 8 * j; const LAS float* s = scr + (8 * c) * 33 + n;
        v4u o; o.x = pk2(s[0 * 33], s[1 * 33]); o.y = pk2(s[2 * 33], s[3 * 33]); o.z = pk2(s[4 * 33], s[5 * 33]); o.w = pk2(s[6 * 33], s[7 * 33]);
        *(GAS v4u*)(WT + (size_t)(n0 + n) * K + k0 + 8 * c) = o; }
    asm volatile("s_waitcnt lgkmcnt(0)" ::: "memory");
}
__device__ __forceinline__ void p0_convert(const float* src, bf16* dst, size_t n, size_t gtid, size_t gthreads) {
    for (size_t i = gtid * 8; i < n; i += gthreads * 8) {
        const f32x4 a = *(const GAS f32x4*)(src + i), b = *(const GAS f32x4*)(src + i + 4);
        v4u o; o.x = pk2(a[0], a[1]); o.y = pk2(a[2], a[3]); o.z = pk2(b[0], b[1]); o.w = pk2(b[2], b[3]);
        *(GAS v4u*)(dst + i) = o; }
}
__device__ __forceinline__ void p0_weights(ArgsR A, LAS unsigned char* lds, int l_lo, int l_hi, int gw, int NGW, int wave, int lane) {
    unsigned char* ws = A.ws;
    LAS float* scr = (LAS float*)(lds + wave * 16384);
    constexpr int I_IN = (DM / 64) * (NINP / 32), I_SQ = (DM / 64) * (DM / 32), I_LAYER = I_IN + 2 * I_SQ;
#pragma unroll 1
    for (int it = l_lo * I_LAYER + gw; it < l_hi * I_LAYER; it += NGW) {
        const int l = it / I_LAYER; int r = it % I_LAYER;
        if (r < I_IN) { p0_transpose_item<true>(A.in[I_WIN] + (size_t)l * DM * DIN, DM, DIN, NINP, A.in[I_N1G] + l * DM, (bf16*)(ws + WS_WIN + l * WIN_L), scr, r, lane); continue; } r -= I_IN;
        if (r < I_SQ) { p0_transpose_item<false>(A.in[I_WOUT] + (size_t)l * DM * DM, DM, DM, DM, nullptr, (bf16*)(ws + WS_WOUT + l * WSQ_L), scr, r, lane); continue; } r -= I_SQ;
        p0_transpose_item<false>(A.in[I_PWQ] + (size_t)l * DM * DM, DM, DM, DM, A.in[I_N2G] + l * DM, (bf16*)(ws + WS_WQ + l * WSQ_L), scr, r, lane);
    }
}
__device__ __forceinline__ void p0_prologue(ArgsR A, LAS unsigned char* lds, int vcu, int G, int wave, int lane) {
    unsigned char* ws = A.ws;
    const int gw = vcu * NWAVES + wave, NGW = G * NWAVES;
    p0_weights(A, lds, 0, 1, gw, NGW, wave, lane);
    const size_t gtid = (size_t)gw * 64 + lane, gthreads = (size_t)NGW * 64;
    p0_convert(A.in[I_PK1], (bf16*)(ws + WS_K1), (size_t)DEPTH * 8 * 128 * 128, gtid, gthreads);
    p0_convert(A.in[I_PK2], (bf16*)(ws + WS_K2), (size_t)DEPTH * 8 * 128 * 128, gtid, gthreads);
    const float* x = A.in[I_X]; bf16* xb = (bf16*)(ws + WS_XB); float* rstd1 = (float*)(ws + WS_RSTD1);
    for (int m = gw; m < NT; m += NGW) {
        const GAS f32x4* xr = (const GAS f32x4*)(x + (size_t)m * DM) + lane;
        f32x4 v[8]; float s = 0.f;
#pragma unroll
        for (int j = 0; j < 8; ++j) { v[j] = xr[64 * j]; s += (v[j][0] * v[j][0] + v[j][1] * v[j][1]) + (v[j][2] * v[j][2] + v[j][3] * v[j][3]); }
        s = wave_sum(s);
        GAS v2u* o = (GAS v2u*)(xb + (size_t)m * DM) + lane;
#pragma unroll
        for (int j = 0; j < 8; ++j) { v2u w; w.x = pk2(v[j][0], v[j][1]); w.y = pk2(v[j][2], v[j][3]); o[64 * j] = w; }
        if (lane == 0) rstd1[m] = rsqrtf(s * (1.0f / DM) + RMS_EPS);
    }
}

constexpr size_t WS_GLA_INC = 562 * MiB;
constexpr size_t WS_GLA_DEC = 594 * MiB;
constexpr size_t WS_GLA_ST = 595 * MiB;
constexpr size_t WS_ML_INC = 611 * MiB;
constexpr size_t WS_ML_N = 643 * MiB;
constexpr size_t WS_ML_SC = 643 * MiB + 512 * 1024;
constexpr size_t WS_ML_ST = 644 * MiB;
constexpr size_t WS_ML_NP = 660 * MiB;
constexpr size_t WS_ML_MP = 660 * MiB + 512 * 1024;
constexpr size_t WS_GDN_U0 = 661 * MiB, WS_GDN_W = 669 * MiB, WS_GDN_QD = 677 * MiB, WS_GDN_KE = 685 * MiB;
constexpr size_t WS_GDN_QK = 693 * MiB;
constexpr size_t WS_GDN_DE = 697 * MiB;
constexpr size_t WS_GDN_O = 698 * MiB;
constexpr size_t WS_LRU_HL = 714 * MiB, WS_LRU_AP = 730 * MiB;
constexpr size_t WS_LRU_CARRY = 746 * MiB;
static_assert(WS_LRU_CARRY + 4 * 32 * 512 * 4 <= WS_END, "ws map");

constexpr int CW_PBAR = 2048;
typedef short v4i16_t __attribute__((ext_vector_type(4)));
constexpr int LD128 = 136, LD64 = 72;

__device__ __forceinline__ bf16x8 frag_rd(const LAS bf16* t, int ld, int row0, int k0, int lane) { return *(const LAS bf16x8*)(t + (row0 + (lane & 15)) * ld + k0 + 8 * (lane >> 4)); }
__device__ __forceinline__ bf16x8 frag_rd_perm(const LAS bf16* t, int ld, int row0, int k0, int lane) {
    const LAS bf16* p = t + (row0 + (lane & 15)) * ld + k0 + 4 * (lane >> 4);
    const bf16x4 a = *(const LAS bf16x4*)p, b = *(const LAS bf16x4*)(p + 16);
    return (bf16x8){a[0], a[1], a[2], a[3], b[0], b[1], b[2], b[3]};
}
__device__ __forceinline__ bf16x8 frag_tr(const LAS bf16* t, int ld, int k0, int n0, int lane) {
    const int i = lane & 15, g = lane >> 4; const LAS bf16* p = t + (k0 + 8 * g + (i >> 2)) * ld + n0 + 4 * (i & 3);
    const v4i16_t a = __builtin_amdgcn_ds_read_tr16_b64_v4i16((LAS v4i16_t*)p), b = __builtin_amdgcn_ds_read_tr16_b64_v4i16((LAS v4i16_t*)(p + 4 * ld));
    return (bf16x8){a[0], a[1], a[2], a[3], b[0], b[1], b[2], b[3]};
}
__device__ __forceinline__ bf16x8 frag_tr_perm(const LAS bf16* t, int ld, int k0, int n0, int lane) {
    const int i = lane & 15, g = lane >> 4; const LAS bf16* p = t + (k0 + 4 * g + (i >> 2)) * ld + n0 + 4 * (i & 3);
    const v4i16_t a = __builtin_amdgcn_ds_read_tr16_b64_v4i16((LAS v4i16_t*)p), b = __builtin_amdgcn_ds_read_tr16_b64_v4i16((LAS v4i16_t*)(p + 16 * ld));
    return (bf16x8){a[0], a[1], a[2], a[3], b[0], b[1], b[2], b[3]};
}
__device__ __forceinline__ bf16x8 pack_acc(const f32x4& lo, const f32x4& hi) {
    v4u w; w.x = pg8::cvt_pk_bf16(lo[0], lo[1]); w.y = pg8::cvt_pk_bf16(lo[2], lo[3]); w.z = pg8::cvt_pk_bf16(hi[0], hi[1]); w.w = pg8::cvt_pk_bf16(hi[2], hi[3]);
    return __builtin_bit_cast(bf16x8, w);
}
#define MFMA16(a, b, c) __builtin_amdgcn_mfma_f32_16x16x32_bf16((a), (b), (c), 0, 0, 0)

template <int ROWS>
__device__ __forceinline__ void tile_g2l_128(const bf16* g, size_t gld, LAS bf16* t, int tid) {
#pragma unroll
    for (int i = 0; i < ROWS * 16 / NTHREADS; ++i) { const int idx = tid + i * NTHREADS, r = idx >> 4, c8 = (idx & 15) * 8;
        *(LAS v4u*)(t + r * LD128 + c8) = *(const GAS v4u*)(g + (size_t)r * gld + c8); }
}
template <int CTRL> __device__ __forceinline__ float dpp_shr_f(float v, float ident) { return __builtin_bit_cast(float, __builtin_amdgcn_update_dpp(__builtin_bit_cast(int, ident), __builtin_bit_cast(int, v), CTRL, 0xf, 0xf, false)); }
__device__ __forceinline__ float wave_scan_add(float v, int lane) {
    v += dpp_shr_f<0x111>(v, 0.f); v += dpp_shr_f<0x112>(v, 0.f); v += dpp_shr_f<0x114>(v, 0.f); v += dpp_shr_f<0x118>(v, 0.f);
    const float t0 = lane_bcast(v, 15), t1 = lane_bcast(v, 31), t2 = lane_bcast(v, 47); const int row = lane >> 4;
    return v + (row == 0 ? 0.f : row == 1 ? t0 : row == 2 ? t0 + t1 : (t0 + t1) + t2);
}
__device__ __forceinline__ float wave_scan_max(float v, int lane) {
    const float ninf = -__builtin_inff();
    v = fmaxf(v, dpp_shr_f<0x111>(v, ninf)); v = fmaxf(v, dpp_shr_f<0x112>(v, ninf)); v = fmaxf(v, dpp_shr_f<0x114>(v, ninf)); v = fmaxf(v, dpp_shr_f<0x118>(v, ninf));
    const float t0 = lane_bcast(v, 15), t1 = lane_bcast(v, 31), t2 = lane_bcast(v, 47); const int row = lane >> 4;
    return fmaxf(v, row == 0 ? ninf : row == 1 ? t0 : row == 2 ? fmaxf(t0, t1) : fmaxf(fmaxf(t0, t1), t2));
}

__device__ __forceinline__ void f_lru_p2(ArgsR A, int l, int item, LAS unsigned char* lds, int tid) {
    const int j = item & 7, n = (item >> 3) & 31, b = item >> 8;
    const bf16* P = (const bf16*)(A.ws + WS_P); float* HLg = (float*)(A.ws + WS_LRU_HL); float* APg = (float*)(A.ws + WS_LRU_AP);
    LAS float* xc = (LAS float*)(lds); LAS bf16* wab = (LAS bf16*)(lds + 20480); LAS bf16* xcb = (LAS bf16*)(lds + 29696); LAS bf16* wxb = (LAS bf16*)(lds + 38912);
    LAS float* aa = (LAS float*)(lds + 53248); LAS float* uu = (LAS float*)(lds + 69632); LAS float* segA = (LAS float*)(lds + 86016); LAS float* segH = (LAS float*)(lds + 88064);
    const float* wa = A.in[I_LRU_WA] + ((size_t)l * 8 + j) * 4096; const float* wx = A.in[I_LRU_WX] + ((size_t)l * 8 + j) * 4096;
    { const int k = tid >> 3, n8 = (tid & 7) * 8;
        const f32x4 a0 = *(const GAS f32x4*)(wa + k * 64 + n8), a1 = *(const GAS f32x4*)(wa + k * 64 + n8 + 4), x0 = *(const GAS f32x4*)(wx + k * 64 + n8), x1 = *(const GAS f32x4*)(wx + k * 64 + n8 + 4);
        v4u wv; wv.x = pk2(a0[0], a0[1]); wv.y = pk2(a0[2], a0[3]); wv.z = pk2(a1[0], a1[1]); wv.w = pk2(a1[2], a1[3]); *(LAS v4u*)(wab + k * LD64 + n8) = wv;
        wv.x = pk2(x0[0], x0[1]); wv.y = pk2(x0[2], x0[3]); wv.z = pk2(x1[0], x1[1]); wv.w = pk2(x1[2], x1[3]); *(LAS v4u*)(wxb + k * LD64 + n8) = wv; }
    const float* cw = A.in[I_LRU_CW] + (size_t)l * 4 * GW; const float* cb = A.in[I_LRU_CB] + l * GW;
    const size_t r0 = (size_t)b * SEQ + n * CHK;
    const int lane = tid & 63, wave = __builtin_amdgcn_readfirstlane(tid >> 6), fr = lane & 15, fq = lane >> 4, nt = wave & 3, mh = wave >> 2;
    const int chl = 16 * nt + fr;
    const float ba1 = A.in[I_LRU_BA][l * GW + j * 64 + chl], bx1 = A.in[I_LRU_BX][l * GW + j * 64 + chl], lam1 = A.in[I_LRU_LAM][l * GW + j * 64 + chl];
    { const int cc = tid & 63, c0 = (tid >> 6) * 8, ch = j * 64 + cc, pc = PC_LRU_X + ch; const long t0 = (long)n * CHK + c0;
        const float w0 = cw[ch], w1 = cw[GW + ch], w2 = cw[2 * GW + ch], w3 = cw[3 * GW + ch], bias = cb[ch];
        float xm3 = (t0 - 3 >= 0) ? bf2f(P[(r0 + c0 - 3) * PBW + pc]) : 0.f, xm2 = (t0 - 2 >= 0) ? bf2f(P[(r0 + c0 - 2) * PBW + pc]) : 0.f, xm1 = (t0 - 1 >= 0) ? bf2f(P[(r0 + c0 - 1) * PBW + pc]) : 0.f;
#pragma unroll
        for (int i = 0; i < 8; ++i) { const float x0 = bf2f(P[(r0 + c0 + i) * PBW + pc]); const float cv = w0 * xm3 + w1 * xm2 + w2 * xm1 + w3 * x0 + bias;
            xc[(c0 + i) * 65 + cc] = cv; xcb[(c0 + i) * LD64 + cc] = (bf16)f2bf(cv); xm3 = xm2; xm2 = xm1; xm1 = x0; } }
    __syncthreads();
    { f32x4 ra[2], ri[2];
#pragma unroll
        for (int m = 0; m < 2; ++m) { ra[m] = (f32x4){ba1, ba1, ba1, ba1}; ri[m] = (f32x4){bx1, bx1, bx1, bx1}; }
#pragma unroll
        for (int kk = 0; kk < 2; ++kk) { const bf16x8 fa = frag_tr(wab, LD64, 32 * kk, 16 * nt, lane), fx = frag_tr(wxb, LD64, 32 * kk, 16 * nt, lane);
#pragma unroll
            for (int m = 0; m < 2; ++m) { const bf16x8 xa = frag_rd(xcb, LD64, 16 * (2 * mh + m), 32 * kk, lane); ra[m] = MFMA16(xa, fa, ra[m]); ri[m] = MFMA16(xa, fx, ri[m]); } }
        const float spl = softplusf_(-lam1);
#pragma unroll
        for (int m = 0; m < 2; ++m)
#pragma unroll
            for (int r = 0; r < 4; ++r) { const int tok = 16 * (2 * mh + m) + 4 * fq + r; const float rg = sigmoidf_(ra[m][r]), ig = sigmoidf_(ri[m][r]);
                const float log_a = -8.0f * rg * spl; const float a = __expf(log_a), u = sqrtf(fmaxf(1.0f - a * a, 0.f)) * (ig * xc[tok * 65 + chl]);
                aa[tok * 64 + chl] = a; uu[tok * 64 + chl] = u; } }
    __syncthreads();
    const int cc = tid & 63, seg = tid >> 6;
    { float Ap = 1.f, Hl = 0.f;
#pragma unroll
        for (int i = 0; i < 8; ++i) { const int c = seg * 8 + i; const float a = aa[c * 64 + cc], u = uu[c * 64 + cc]; Hl = a * Hl + u; Ap *= a; aa[c * 64 + cc] = Ap; uu[c * 64 + cc] = Hl; }
        segA[seg * 64 + cc] = Ap; segH[seg * 64 + cc] = Hl; }
    __syncthreads();
    { float Ac = 1.f, Hc = 0.f;
#pragma unroll 1
        for (int s = 0; s < seg; ++s) { const float sa = segA[s * 64 + cc]; Hc = sa * Hc + segH[s * 64 + cc]; Ac *= sa; }
#pragma unroll
        for (int i = 0; i < 8; ++i) { const int c = seg * 8 + i; const float ap = aa[c * 64 + cc], hl = uu[c * 64 + cc];
            HLg[(r0 + c) * GW + j * 64 + cc] = ap * Hc + hl; APg[(r0 + c) * GW + j * 64 + cc] = ap * Ac; } }
    __syncthreads();
}
__device__ __forceinline__ void f_lru_p3(ArgsR A, int b, int tid) {
    const float* HLg = (const float*)(A.ws + WS_LRU_HL); const float* APg = (const float*)(A.ws + WS_LRU_AP); float* carry = (float*)(A.ws + WS_LRU_CARRY);
    float c = 0.f;
#pragma unroll 1
    for (int n0 = 0; n0 < NCHK; n0 += 16) { float ap[16], hl[16];
#pragma unroll
        for (int i = 0; i < 16; ++i) { const size_t t = (size_t)b * SEQ + (n0 + i) * CHK + 63; ap[i] = APg[t * GW + tid]; hl[i] = HLg[t * GW + tid]; }
#pragma unroll
        for (int i = 0; i < 16; ++i) { carry[((size_t)b * NCHK + n0 + i) * GW + tid] = c; c = ap[i] * c + hl[i]; } }
}
__device__ __forceinline__ void f_lru_p4(ArgsR A, int row0, int row1, int tid) {
    const bf16* P = (const bf16*)(A.ws + WS_P); bf16* mix = (bf16*)(A.ws + WS_MIX);
    const float* HLg = (const float*)(A.ws + WS_LRU_HL); const float* APg = (const float*)(A.ws + WS_LRU_AP); const float* carry = (const float*)(A.ws + WS_LRU_CARRY);
#pragma unroll 1
    for (int rb = row0; rb < row1; rb += 12) { float cr[12], ap[12], hl[12]; unsigned short yv[12];
#pragma unroll
        for (int i = 0; i < 12; ++i) { const int r = min(rb + i, row1 - 1); cr[i] = carry[(size_t)(r >> 6) * GW + tid]; ap[i] = APg[(size_t)r * GW + tid]; hl[i] = HLg[(size_t)r * GW + tid]; yv[i] = P[(size_t)r * PBW + PC_LRU_Y + tid]; }
#pragma unroll
        for (int i = 0; i < 12; ++i) if (rb + i < row1) mix[(size_t)(rb + i) * DM + 512 + tid] = (bf16)f2bf(gelu_tanh(bf2f(yv[i])) * (ap[i] * cr[i] + hl[i])); }
}

constexpr int FL_Q = 0, FL_K = 17408, FL_V = 34816, FL_ST = 52224, FL_SC = 87040, FL_BC = 96256, FL_LR = 129024, FL_SEG = 133120, FL_RS = 135168;
struct GlaW2 { float w[16]; float b2; };
__device__ __forceinline__ void gla_w2_load(ArgsR A, int l, int h, int tid, GlaW2& W) {
    const int d = tid & 127; const float* w2 = A.in[I_GLA_W2] + (size_t)l * 16 * GW + h * HD + d;
#pragma unroll
    for (int r = 0; r < 16; ++r) W.w[r] = w2[r * GW];
    W.b2 = A.in[I_GLA_B2][l * GW + h * HD + d];
}
__device__ __forceinline__ void gla_bcum(const GlaW2& W, LAS float* bc, LAS float* segt, const LAS float* lrs, int tid) {
    const int d = tid & 127, seg = tid >> 7; float run = 0.f;
#pragma unroll 4
    for (int i = 0; i < 16; ++i) { const int c = seg * 16 + i; float z = W.b2;
#pragma unroll
        for (int r = 0; r < 16; ++r) z += lrs[c * 16 + r] * W.w[r];
        run += logsigmoidf_(z) * (1.0f / 16.0f); bc[c * 128 + d] = run; }
    segt[seg * 128 + d] = run;
}
__device__ __forceinline__ void f_gla_p2(ArgsR A, int l, int item, LAS unsigned char* lds, int tid) {
    const int n = item & 31, h = (item >> 5) & 3, b = item >> 7; const int lane = tid & 63, wave = __builtin_amdgcn_readfirstlane(tid >> 6);
    const bf16* P = (const bf16*)(A.ws + WS_P); const float* Ps = (const float*)(A.ws + WS_PS);
    float* inc = (float*)(A.ws + WS_GLA_INC) + (size_t)item * 16384; float* dec = (float*)(A.ws + WS_GLA_DEC) + (size_t)item * 128;
    LAS bf16* ks = (LAS bf16*)(lds + FL_K); LAS bf16* vs = (LAS bf16*)(lds + FL_V); LAS float* bc = (LAS float*)(lds + FL_BC); LAS float* lrs = (LAS float*)(lds + FL_LR); LAS float* segt = (LAS float*)(lds + FL_SEG);
    const size_t r0 = (size_t)b * SEQ + n * CHK;
    GlaW2 W2; gla_w2_load(A, l, h, tid, W2);
    tile_g2l_128<64>(P + r0 * PBW + PC_GLA_K + h * HD, PBW, ks, tid);
    tile_g2l_128<64>(P + r0 * PBW + PC_GLA_V + h * HD, PBW, vs, tid);
    for (int i = tid; i < 64 * 16; i += NTHREADS) lrs[i] = Ps[(r0 + (i >> 4)) * 32 + PS_LR + (i & 15)];
    __syncthreads();
    gla_bcum(W2, bc, segt, lrs, tid);
    __syncthreads();
    { const int d = tid & 127, seg = tid >> 7; float pre = 0.f, tot = 0.f;
#pragma unroll
        for (int s = 0; s < 4; ++s) { const float v = segt[s * 128 + d]; if (s < seg) pre += v; tot += v; }
#pragma unroll 4
        for (int i = 0; i < 16; ++i) { const int c = seg * 16 + i; const float bcm = bc[c * 128 + d] + pre; ks[c * LD128 + d] = (bf16)f2bf(bf2f(ks[c * LD128 + d]) * __expf(tot - bcm)); }
        if (seg == 0) dec[d] = __expf(tot); }
    __syncthreads();
    { f32x4 acc[8];
#pragma unroll
        for (int nt = 0; nt < 8; ++nt) acc[nt] = (f32x4){0.f, 0.f, 0.f, 0.f};
#pragma unroll
        for (int kk = 0; kk < 2; ++kk) { const bf16x8 af = frag_tr(vs, LD128, 32 * kk, 16 * wave, lane);
#pragma unroll
            for (int nt = 0; nt < 8; ++nt) acc[nt] = MFMA16(af, frag_tr(ks, LD128, 32 * kk, 16 * nt, lane), acc[nt]); }
        const int fr = lane & 15, fq = lane >> 4;
#pragma unroll
        for (int nt = 0; nt < 8; ++nt)
#pragma unroll
            for (int r = 0; r < 4; ++r) inc[(16 * wave + 4 * fq + r) * 128 + 16 * nt + fr] = acc[nt][r]; }
    __syncthreads();
}
__device__ __forceinline__ void f_gla_p3(ArgsR A, int item, int tid) {
    const int bh = item >> 4, sl = item & 15; const int e = sl * 1024 + tid * 2, d = e & 127;
    const float* inc = (const float*)(A.ws + WS_GLA_INC) + (size_t)bh * 32 * 16384 + e; const float* dec = (const float*)(A.ws + WS_GLA_DEC) + (size_t)bh * 32 * 128 + d;
    bf16* st = (bf16*)(A.ws + WS_GLA_ST) + (size_t)bh * 32 * 16384 + e;
    float s0 = 0.f, s1 = 0.f;
#pragma unroll 1
    for (int n0 = 0; n0 < NCHK; n0 += 16) { f32x2 iv[16], dv[16];
#pragma unroll
        for (int i = 0; i < 16; ++i) { iv[i] = *(const GAS f32x2*)(inc + (size_t)(n0 + i) * 16384); dv[i] = *(const GAS f32x2*)(dec + (size_t)(n0 + i) * 128); }
#pragma unroll
        for (int i = 0; i < 16; ++i) { *(GAS unsigned*)(st + (size_t)(n0 + i) * 16384) = pk2(s0, s1); s0 = dv[i][0] * s0 + iv[i][0]; s1 = dv[i][1] * s1 + iv[i][1]; } }
}
__device__ __forceinline__ void f_gla_p4(ArgsR A, int l, int item, LAS unsigned char* lds, int tid) {
    const int n = item & 31, h = (item >> 5) & 3, b = item >> 7; const int lane = tid & 63, wave = __builtin_amdgcn_readfirstlane(tid >> 6), fr = lane & 15, fq = lane >> 4;
    const bf16* P = (const bf16*)(A.ws + WS_P); const float* Ps = (const float*)(A.ws + WS_PS); bf16* mix = (bf16*)(A.ws + WS_MIX);
    const bf16* stg = (const bf16*)(A.ws + WS_GLA_ST) + (size_t)item * 16384;
    LAS bf16* qs = (LAS bf16*)(lds + FL_Q); LAS bf16* ks = (LAS bf16*)(lds + FL_K); LAS bf16* vs = (LAS bf16*)(lds + FL_V); LAS bf16* sts = (LAS bf16*)(lds + FL_ST); LAS bf16* scs = (LAS bf16*)(lds + FL_SC);
    LAS float* bc = (LAS float*)(lds + FL_BC); LAS float* lrs = (LAS float*)(lds + FL_LR); LAS float* segt = (LAS float*)(lds + FL_SEG); LAS float* rsp = (LAS float*)(lds + FL_RS);
    const size_t r0 = (size_t)b * SEQ + n * CHK;
    GlaW2 W2; gla_w2_load(A, l, h, tid, W2);
    const float gn = A.in[I_GLA_NG][l * GW + h * HD + 16 * wave + fr];
    float gt[4][4];
#pragma unroll
    for (int mt = 0; mt < 4; ++mt)
#pragma unroll
        for (int r = 0; r < 4; ++r) gt[mt][r] = bf2f(P[(r0 + 16 * mt + 4 * fq + r) * PBW + PC_GLA_G + h * HD + 16 * wave + fr]);
    tile_g2l_128<64>(P + r0 * PBW + PC_GLA_Q + h * HD, PBW, qs, tid);
    tile_g2l_128<64>(P + r0 * PBW + PC_GLA_K + h * HD, PBW, ks, tid);
    tile_g2l_128<64>(P + r0 * PBW + PC_GLA_V + h * HD, PBW, vs, tid);
    tile_g2l_128<128>(stg, 128, sts, tid);
    for (int i = tid; i < 64 * 16; i += NTHREADS) lrs[i] = Ps[(r0 + (i >> 4)) * 32 + PS_LR + (i & 15)];
    __syncthreads();
    gla_bcum(W2, bc, segt, lrs, tid);
    __syncthreads();
    { const int d = tid & 127, seg = tid >> 7; float pre = 0.f;
#pragma unroll
        for (int s = 0; s < 4; ++s) { const float v = segt[s * 128 + d]; if (s < seg) pre += v; }
#pragma unroll 4
        for (int i = 0; i < 16; ++i) { const int c = seg * 16 + i; const float bcm = bc[c * 128 + d] + pre;
            qs[c * LD128 + d] = (bf16)f2bf(bf2f(qs[c * LD128 + d]) * __expf(bcm) * 0.08838834764831845f); ks[c * LD128 + d] = (bf16)f2bf(bf2f(ks[c * LD128 + d]) * __expf(-bcm)); } }
    __syncthreads();
    { const int mt = wave >> 1; f32x4 acc[2] = {{0.f, 0.f, 0.f, 0.f}, {0.f, 0.f, 0.f, 0.f}};
#pragma unroll
        for (int kk = 0; kk < 4; ++kk) { const bf16x8 af = frag_rd(qs, LD128, 16 * mt, 32 * kk, lane);
#pragma unroll
            for (int q = 0; q < 2; ++q) acc[q] = MFMA16(af, frag_rd(ks, LD128, 16 * (2 * (wave & 1) + q), 32 * kk, lane), acc[q]); }
#pragma unroll
        for (int q = 0; q < 2; ++q) { const int s = 16 * (2 * (wave & 1) + q) + fr;
#pragma unroll
            for (int r = 0; r < 4; ++r) { const int c = 16 * mt + 4 * fq + r; scs[c * LD64 + s] = (bf16)f2bf(s <= c ? acc[q][r] : 0.f); } } }
    __syncthreads();
    f32x4 o[4];
#pragma unroll
    for (int mt = 0; mt < 4; ++mt) o[mt] = (f32x4){0.f, 0.f, 0.f, 0.f};
#pragma unroll
    for (int kk = 0; kk < 2; ++kk) { const bf16x8 bfv = frag_tr(vs, LD128, 32 * kk, 16 * wave, lane);
#pragma unroll
        for (int mt = 0; mt < 4; ++mt) o[mt] = MFMA16(frag_rd(scs, LD64, 16 * mt, 32 * kk, lane), bfv, o[mt]); }
#pragma unroll
    for (int kk = 0; kk < 4; ++kk) { const bf16x8 bfs = frag_rd(sts, LD128, 16 * wave, 32 * kk, lane);
#pragma unroll
        for (int mt = 0; mt < 4; ++mt) o[mt] = MFMA16(frag_rd(qs, LD128, 16 * mt, 32 * kk, lane), bfs, o[mt]); }
#pragma unroll
    for (int mt = 0; mt < 4; ++mt)
#pragma unroll
        for (int r = 0; r < 4; ++r) { float s = o[mt][r] * o[mt][r]; s = row_sum_f(s);
            if (fr == 0) rsp[wave * 64 + 16 * mt + 4 * fq + r] = s; }
    __syncthreads();
#pragma unroll
    for (int mt = 0; mt < 4; ++mt)
#pragma unroll
        for (int r = 0; r < 4; ++r) { const int c = 16 * mt + 4 * fq + r; float ss = 0.f;
#pragma unroll
            for (int w = 0; w < 8; ++w) ss += rsp[w * 64 + c];
            const float rs = rsqrtf(ss * (1.0f / 128.0f) + RMS_EPS);
            mix[(r0 + c) * DM + h * HD + 16 * wave + fr] = (bf16)f2bf(o[mt][r] * rs * gn * siluf_(gt[mt][r])); }
    __syncthreads();
}

constexpr int FM_Q2 = 96256, FM_S = 129024;
__device__ __forceinline__ void f_ml_p2(ArgsR A, int l, int item, LAS unsigned char* lds, int tid) {
    const int n = item & 31, h = (item >> 5) & 3, b = item >> 7; const int lane = tid & 63, wave = __builtin_amdgcn_readfirstlane(tid >> 6);
    const bf16* P = (const bf16*)(A.ws + WS_P); const float* Ps = (const float*)(A.ws + WS_PS);
    float* inc = (float*)(A.ws + WS_ML_INC) + (size_t)item * 16384; float* incn = (float*)(A.ws + WS_ML_N) + (size_t)item * 128; float* scg = (float*)(A.ws + WS_ML_SC) + (size_t)item * 2;
    LAS bf16* ks = (LAS bf16*)(lds + FL_K); LAS bf16* vs = (LAS bf16*)(lds + FL_V); LAS float* sc = (LAS float*)(lds + FM_S);
    const size_t r0 = (size_t)b * SEQ + n * CHK;
    tile_g2l_128<64>(P + r0 * PBW + PC_ML_K + h * HD, PBW, ks, tid);
    tile_g2l_128<64>(P + r0 * PBW + PC_ML_V + h * HD, PBW, vs, tid);
    if (wave == 0) { const float lf = logsigmoidf_(Ps[(r0 + lane) * 32 + PS_MF + h] + A.in[I_ML_FB][l * NH + h]), ig = Ps[(r0 + lane) * 32 + PS_MI + h] + A.in[I_ML_IB][l * NH + h];
        const float bcum = wave_scan_add(lf, lane), blast = lane_bcast(bcum, 63), le = blast - bcum + ig, mloc = wave_max(le);
        sc[lane] = __expf(le - mloc) * 0.08838834764831845f; if (lane == 0) { scg[0] = mloc; scg[1] = blast; } }
    __syncthreads();
#pragma unroll
    for (int i = 0; i < 2; ++i) { const int idx = tid + i * NTHREADS, r = idx >> 4, c8 = (idx & 15) * 8; const float w = sc[r];
        v4u x = *(LAS v4u*)(ks + r * LD128 + c8);
        x.x = pk2(bflo(x.x) * w, bfhi(x.x) * w); x.y = pk2(bflo(x.y) * w, bfhi(x.y) * w); x.z = pk2(bflo(x.z) * w, bfhi(x.z) * w); x.w = pk2(bflo(x.w) * w, bfhi(x.w) * w);
        *(LAS v4u*)(ks + r * LD128 + c8) = x; }
    __syncthreads();
    if (tid < 128) { float s = 0.f;
#pragma unroll 8
        for (int c = 0; c < 64; ++c) s += bf2f(ks[c * LD128 + tid]);
        incn[tid] = s; }
    { f32x4 acc[8];
#pragma unroll
        for (int nt = 0; nt < 8; ++nt) acc[nt] = (f32x4){0.f, 0.f, 0.f, 0.f};
#pragma unroll
        for (int kk = 0; kk < 2; ++kk) { const bf16x8 af = frag_tr(vs, LD128, 32 * kk, 16 * wave, lane);
#pragma unroll
            for (int nt = 0; nt < 8; ++nt) acc[nt] = MFMA16(af, frag_tr(ks, LD128, 32 * kk, 16 * nt, lane), acc[nt]); }
        const int fr = lane & 15, fq = lane >> 4;
#pragma unroll
        for (int nt = 0; nt < 8; ++nt)
#pragma unroll
            for (int r = 0; r < 4; ++r) inc[(16 * wave + 4 * fq + r) * 128 + 16 * nt + fr] = acc[nt][r]; }
    __syncthreads();
}
__device__ __forceinline__ void f_ml_p3(ArgsR A, int item, int tid) {
    const int bh = item >> 4, sl = item & 15; const int e = sl * 1024 + tid * 2;
    const float* inc = (const float*)(A.ws + WS_ML_INC) + (size_t)bh * 32 * 16384 + e; const float* incn = (const float*)(A.ws + WS_ML_N) + (size_t)bh * 32 * 128;
    const float* scg = (const float*)(A.ws + WS_ML_SC) + (size_t)bh * 32 * 2;
    bf16* st = (bf16*)(A.ws + WS_ML_ST) + (size_t)bh * 32 * 16384 + e; float* np = (float*)(A.ws + WS_ML_NP) + (size_t)bh * 32 * 128; float* mp = (float*)(A.ws + WS_ML_MP) + (size_t)bh * 32;
    float c0 = 0.f, c1 = 0.f, nv = 0.f, m = 0.f; const int dn = sl * 8 + tid;
#pragma unroll 1
    for (int n0 = 0; n0 < NCHK; n0 += 16) { f32x2 iv[16], sg[16]; float nn[16];
#pragma unroll
        for (int i = 0; i < 16; ++i) { iv[i] = *(const GAS f32x2*)(inc + (size_t)(n0 + i) * 16384); sg[i] = *(const GAS f32x2*)(scg + 2 * (n0 + i)); nn[i] = (tid < 8) ? incn[(n0 + i) * 128 + dn] : 0.f; }
#pragma unroll
        for (int i = 0; i < 16; ++i) { const int n = n0 + i;
            *(GAS unsigned*)(st + (size_t)n * 16384) = pk2(c0, c1);
            if (tid < 8) np[n * 128 + dn] = nv;
            if (sl == 0 && tid == 0) mp[n] = m;
            const float ml = sg[i][0], bl = sg[i][1]; const float mn = fmaxf(bl + m, ml), ao = __expf(bl + m - mn), ai = __expf(ml - mn);
            c0 = ao * c0 + ai * iv[i][0]; c1 = ao * c1 + ai * iv[i][1];
            nv = ao * nv + ai * nn[i];
            m = mn; } }
}
__device__ __forceinline__ void f_ml_p4(ArgsR A, int l, int item, LAS unsigned char* lds, int tid) {
    const int n = item & 31, h = (item >> 5) & 3, b = item >> 7; const int lane = tid & 63, wave = __builtin_amdgcn_readfirstlane(tid >> 6), fr = lane & 15, fq = lane >> 4;
    const bf16* P = (const bf16*)(A.ws + WS_P); const float* Ps = (const float*)(A.ws + WS_PS); bf16* mix = (bf16*)(A.ws + WS_MIX);
    const bf16* stg = (const bf16*)(A.ws + WS_ML_ST) + (size_t)item * 16384; const float* npg = (const float*)(A.ws + WS_ML_NP) + (size_t)item * 128; const float mprev = ((const float*)(A.ws + WS_ML_MP))[item];
    LAS bf16* qs = (LAS bf16*)(lds + FL_Q); LAS bf16* ks = (LAS bf16*)(lds + FL_K); LAS bf16* vs = (LAS bf16*)(lds + FL_V); LAS bf16* sts = (LAS bf16*)(lds + FL_ST); LAS bf16* scs = (LAS bf16*)(lds + FL_SC);
    LAS bf16* q2 = (LAS bf16*)(lds + FM_Q2); LAS float* sc = (LAS float*)(lds + FM_S); LAS float* rsp = (LAS float*)(lds + FL_RS + 4096);
    const size_t r0 = (size_t)b * SEQ + n * CHK;
    const float gn = A.in[I_ML_NG][l * GW + h * HD + 16 * wave + fr];
    float ogt[4][4];
#pragma unroll
    for (int mt = 0; mt < 4; ++mt)
#pragma unroll
        for (int r = 0; r < 4; ++r) ogt[mt][r] = bf2f(P[(r0 + 16 * mt + 4 * fq + r) * PBW + PC_ML_O + h * HD + 16 * wave + fr]);
    tile_g2l_128<64>(P + r0 * PBW + PC_ML_Q + h * HD, PBW, qs, tid);
    tile_g2l_128<64>(P + r0 * PBW + PC_ML_K + h * HD, PBW, ks, tid);
    tile_g2l_128<64>(P + r0 * PBW + PC_ML_V + h * HD, PBW, vs, tid);
    tile_g2l_128<128>(stg, 128, sts, tid);
    if (wave == 0) { const float lf = logsigmoidf_(Ps[(r0 + lane) * 32 + PS_MF + h] + A.in[I_ML_FB][l * NH + h]), ig = Ps[(r0 + lane) * 32 + PS_MI + h] + A.in[I_ML_IB][l * NH + h];
        const float bcum = wave_scan_add(lf, lane), as = ig - bcum, pm = wave_scan_max(as, lane);
        const float mintra = bcum + pm, minter = bcum + mprev, mt = fmaxf(mintra, minter);
        sc[lane] = bcum - mt; sc[64 + lane] = as; sc[128 + lane] = __expf(minter - mt); sc[192 + lane] = __expf(-mt); }
    if (wave == 1) { sc[320 + lane] = npg[lane]; sc[384 + lane] = npg[64 + lane]; }
    __syncthreads();
#pragma unroll
    for (int i = 0; i < 2; ++i) { const int idx = tid + i * NTHREADS, r = idx >> 4, c8 = (idx & 15) * 8; const float w = sc[128 + r];
        v4u x = *(LAS v4u*)(qs + r * LD128 + c8);
        x.x = pk2(bflo(x.x) * w, bfhi(x.x) * w); x.y = pk2(bflo(x.y) * w, bfhi(x.y) * w); x.z = pk2(bflo(x.z) * w, bfhi(x.z) * w); x.w = pk2(bflo(x.w) * w, bfhi(x.w) * w);
        *(LAS v4u*)(q2 + r * LD128 + c8) = x; }
    { const int mt = wave >> 1; f32x4 acc[2] = {{0.f, 0.f, 0.f, 0.f}, {0.f, 0.f, 0.f, 0.f}};
#pragma unroll
        for (int kk = 0; kk < 4; ++kk) { const bf16x8 af = frag_rd(qs, LD128, 16 * mt, 32 * kk, lane);
#pragma unroll
            for (int q = 0; q < 2; ++q) acc[q] = MFMA16(af, frag_rd(ks, LD128, 16 * (2 * (wave & 1) + q), 32 * kk, lane), acc[q]); }
#pragma unroll
        for (int q = 0; q < 2; ++q) { const int s = 16 * (2 * (wave & 1) + q) + fr; const float asv = sc[64 + s];
#pragma unroll
            for (int r = 0; r < 4; ++r) { const int c = 16 * mt + 4 * fq + r; scs[c * LD64 + s] = (bf16)f2bf(s <= c ? acc[q][r] * 0.08838834764831845f * __expf(sc[c] + asv) : 0.f); } } }
    __syncthreads();
    { const int c = tid >> 3, part = tid & 7; float s = 0.f;
#pragma unroll
        for (int i = 0; i < 8; ++i) s += bf2f(scs[c * LD64 + part * 8 + i]);
#pragma unroll
        for (int i = 0; i < 16; ++i) s += bf2f(q2[c * LD128 + part * 16 + i]) * sc[320 + part * 16 + i];
        s = oct_sum_f(s);
        if (part == 0) sc[256 + c] = fmaxf(fabsf(s), sc[192 + c]); }
    f32x4 o[4];
#pragma unroll
    for (int mt = 0; mt < 4; ++mt) o[mt] = (f32x4){0.f, 0.f, 0.f, 0.f};
#pragma unroll
    for (int kk = 0; kk < 2; ++kk) { const bf16x8 bfv = frag_tr(vs, LD128, 32 * kk, 16 * wave, lane);
#pragma unroll
        for (int mt = 0; mt < 4; ++mt) o[mt] = MFMA16(frag_rd(scs, LD64, 16 * mt, 32 * kk, lane), bfv, o[mt]); }
#pragma unroll
    for (int kk = 0; kk < 4; ++kk) { const bf16x8 bfs = frag_rd(sts, LD128, 16 * wave, 32 * kk, lane);
#pragma unroll
        for (int mt = 0; mt < 4; ++mt) o[mt] = MFMA16(frag_rd(q2, LD128, 16 * mt, 32 * kk, lane), bfs, o[mt]); }
    __syncthreads();
#pragma unroll
    for (int mt = 0; mt < 4; ++mt)
#pragma unroll
        for (int r = 0; r < 4; ++r) { const int c = 16 * mt + 4 * fq + r;
            const float hv = o[mt][r] * rcpf_(sc[256 + c]) * sigmoidf_(ogt[mt][r]); o[mt][r] = hv;
            float s = hv * hv; s = row_sum_f(s);
            if (fr == 0) rsp[wave * 64 + c] = s; }
    __syncthreads();
#pragma unroll
    for (int mt = 0; mt < 4; ++mt)
#pragma unroll
        for (int r = 0; r < 4; ++r) { const int c = 16 * mt + 4 * fq + r; float ss = 0.f;
#pragma unroll
            for (int w = 0; w < 8; ++w) ss += rsp[w * 64 + c];
            mix[(r0 + c) * DM + 1024 + h * HD + 16 * wave + fr] = (bf16)f2bf(o[mt][r] * rsqrtf(ss * (1.0f / 128.0f) + RMS_EPS) * gn); }
    __syncthreads();
}

constexpr int FG_LM = 52224, FG_S = 129024, FG_RAW = 68608, FG_RAWT = 9216  ;
__device__ __forceinline__ int gdn_kperm(int k) { const int kb = k & ~31, jj = k & 31; return kb + (jj < 16 ? 8 * (jj >> 2) + (jj & 3) : 8 * ((jj - 16) >> 2) + 4 + (jj & 3)); }
__device__ __forceinline__ int gdn_swz(int ob) { return ob ^ (((ob >> 9) & 1) << 5); }
template <int C> struct GdnSolve {
    static __device__ __forceinline__ void run(float (&sol)[64], const LAS float* Lm) {
        if constexpr (C < 64) {
            float a0 = sol[C], a1 = 0.f, a2 = 0.f, a3 = 0.f;
#pragma unroll
            for (int q = 0; q < (C + 3) / 4; ++q) { const f32x4 lv = *(const LAS f32x4*)(Lm + C * 64 + 4 * q);
                a0 -= lv[0] * sol[4 * q]; if (4 * q + 1 < C) a1 -= lv[1] * sol[4 * q + 1]; if (4 * q + 2 < C) a2 -= lv[2] * sol[4 * q + 2]; if (4 * q + 3 < C) a3 -= lv[3] * sol[4 * q + 3]; }
            sol[C] = (a0 + a1) + (a2 + a3);
            GdnSolve<C + 1>::run(sol, Lm);
        }
    }
};
__device__ __forceinline__ void f_gdn_p2(ArgsR A, int l, int item, LAS unsigned char* lds, int tid) {
    const int n = item & 31, h = (item >> 5) & 3, b = item >> 7; const int lane = tid & 63, wave = __builtin_amdgcn_readfirstlane(tid >> 6), fr = lane & 15, fq = lane >> 4;
    const bf16* P = (const bf16*)(A.ws + WS_P); const float* Ps = (const float*)(A.ws + WS_PS);
    bf16* U0 = (bf16*)(A.ws + WS_GDN_U0) + (size_t)item * 8192; bf16* Wg = (bf16*)(A.ws + WS_GDN_W) + (size_t)item * 8192; bf16* QD = (bf16*)(A.ws + WS_GDN_QD) + (size_t)item * 8192;
    bf16* KE = (bf16*)(A.ws + WS_GDN_KE) + (size_t)item * 8192; bf16* QK = (bf16*)(A.ws + WS_GDN_QK) + (size_t)item * 4096; float* DE = (float*)(A.ws + WS_GDN_DE);
    LAS bf16* qs = (LAS bf16*)(lds + FL_Q); LAS bf16* ks = (LAS bf16*)(lds + FL_K); LAS bf16* vs = (LAS bf16*)(lds + FL_V); LAS float* Lm = (LAS float*)(lds + FG_LM); LAS float* sc = (LAS float*)(lds + FG_S);
    const float* cw = A.in[I_GDN_CW] + (size_t)l * 4 * 1536;
    const size_t r0 = (size_t)b * SEQ + n * CHK;
    float cwv[3][4];
#pragma unroll
    for (int part = 0; part < 3; ++part)
#pragma unroll
        for (int k = 0; k < 4; ++k) cwv[part][k] = cw[k * 1536 + part * 512 + h * HD + (tid & 127)];
    if (wave == 0) { const float bt = sigmoidf_(Ps[(r0 + lane) * 32 + PS_GB + h]);
        const float g = -__expf(A.in[I_GDN_ALOG][l * NH + h]) * softplusf_(Ps[(r0 + lane) * 32 + PS_GA + h] + A.in[I_GDN_DTB][l * NH + h]);
        const float gam = wave_scan_add(g, lane); sc[lane] = bt; sc[64 + lane] = gam; if (lane == 63) DE[item] = __expf(gam); }
    { LAS bf16* raw = (LAS bf16*)(lds + FG_RAW);
#pragma unroll
        for (int i = 0; i < 7; ++i) { const int idx = tid + i * NTHREADS; if (idx < 3 * 67 * 16) { const int part = idx / (67 * 16), pi = idx % (67 * 16), rr = pi >> 4, c8 = (pi & 15) * 8;
            const int pc = (part == 0 ? PC_GDN_Q : part == 1 ? PC_GDN_K : PC_GDN_V) + h * HD + c8; v4u w = {0u, 0u, 0u, 0u};
            if (n > 0 || rr >= 3) w = *(const GAS v4u*)(P + (r0 + rr - 3) * PBW + pc);
            *(LAS v4u*)(raw + part * FG_RAWT + rr * LD128 + c8) = w; } }
        __syncthreads();
        const int v = tid & 127, dq = tid >> 7;
#pragma unroll
        for (int part = 0; part < 3; ++part) {
            const float w0 = cwv[part][0], w1 = cwv[part][1], w2 = cwv[part][2], w3 = cwv[part][3];
            LAS bf16* dst = part == 0 ? qs : part == 1 ? ks : vs; const LAS bf16* src = raw + part * FG_RAWT + v;
            const int c0 = dq * 16;
            float xm3 = bf2f(src[(c0 + 0) * LD128]), xm2 = bf2f(src[(c0 + 1) * LD128]), xm1 = bf2f(src[(c0 + 2) * LD128]);
#pragma unroll
            for (int i = 0; i < 16; ++i) { const float x0 = bf2f(src[(c0 + i + 3) * LD128]); const float y = w0 * xm3 + w1 * xm2 + w2 * xm1 + w3 * x0;
                dst[(c0 + i) * LD128 + v] = (bf16)f2bf(siluf_(y)); xm3 = xm2; xm2 = xm1; xm1 = x0; } } }
    __syncthreads();
#pragma unroll 1
    for (int rr = 0; rr < 8; ++rr) { const int c = wave * 8 + rr;
        const float q1 = bf2f(qs[c * LD128 + lane]), q2 = bf2f(qs[c * LD128 + 64 + lane]), k1 = bf2f(ks[c * LD128 + lane]), k2 = bf2f(ks[c * LD128 + 64 + lane]);
        const float sq = wave_sum(q1 * q1 + q2 * q2), sk = wave_sum(k1 * k1 + k2 * k2);
        if (lane == 0) { sc[128 + c] = rsqrtf(sq + 1e-6f) * 0.08838834764831845f; sc[192 + c] = rsqrtf(sk + 1e-6f); } }
    __syncthreads();
    { const int mt = wave >> 1; f32x4 akk[2] = {{0.f, 0.f, 0.f, 0.f}, {0.f, 0.f, 0.f, 0.f}}, aqk[2] = {{0.f, 0.f, 0.f, 0.f}, {0.f, 0.f, 0.f, 0.f}};
#pragma unroll
        for (int kk = 0; kk < 4; ++kk) { const bf16x8 ak = frag_rd(ks, LD128, 16 * mt, 32 * kk, lane), aq = frag_rd(qs, LD128, 16 * mt, 32 * kk, lane);
#pragma unroll
            for (int q = 0; q < 2; ++q) { const bf16x8 bk = frag_rd(ks, LD128, 16 * (2 * (wave & 1) + q), 32 * kk, lane); akk[q] = MFMA16(ak, bk, akk[q]); aqk[q] = MFMA16(aq, bk, aqk[q]); } }
#pragma unroll
        for (int q = 0; q < 2; ++q) { const int s = 16 * (2 * (wave & 1) + q) + fr; const float rks = sc[192 + s], gs = sc[64 + s];
#pragma unroll
            for (int r = 0; r < 4; ++r) { const int c = 16 * mt + 4 * fq + r; const float dcy = __expf(sc[64 + c] - gs);
                Lm[c * 64 + s] = (s < c) ? sc[c] * akk[q][r] * sc[192 + c] * rks * dcy : 0.f;
                QK[c * 64 + gdn_kperm(s)] = (bf16)f2bf((s <= c) ? aqk[q][r] * sc[128 + c] * rks * dcy : 0.f); } } }
    __syncthreads();
    if (tid < 256) {
        float sol[64]; const bool isw = tid >= 128; const int j = tid & 127;
        const LAS float* LmO = Lm; asm volatile("" : "+v"(LmO));
#pragma unroll
        for (int c = 0; c < 64; ++c) { const float bt = sc[c]; sol[c] = isw ? bf2f(ks[c * LD128 + j]) * sc[192 + c] * bt * __expf(sc[64 + c]) : bf2f(vs[c * LD128 + j]) * bt; }
        GdnSolve<1>::run(sol, LmO);
        bf16* dst = isw ? Wg : U0;
#pragma unroll
        for (int c = 0; c < 64; ++c) dst[c * 128 + j] = (bf16)f2bf(sol[c]);
    } else {
        const int t2 = tid - 256; const float glast = sc[64 + 63];
#pragma unroll
        for (int i = 0; i < 8; ++i) { const int idx = t2 + i * 256, which = idx >> 10, pi = idx & 1023, r = pi >> 4, c8 = (pi & 15) * 8;
            const float w = which == 0 ? sc[128 + r] * __expf(sc[64 + r]) : sc[192 + r] * __expf(glast - sc[64 + r]);
            v4u x = *(LAS v4u*)((which == 0 ? qs : ks) + r * LD128 + c8);
            x.x = pk2(bflo(x.x) * w, bfhi(x.x) * w); x.y = pk2(bflo(x.y) * w, bfhi(x.y) * w); x.z = pk2(bflo(x.z) * w, bfhi(x.z) * w); x.w = pk2(bflo(x.w) * w, bfhi(x.w) * w);
            if (which == 0) { v2u lo_, hi_; lo_.x = x.x; lo_.y = x.y; hi_.x = x.z; hi_.y = x.w; *(GAS v2u*)(QD + r * 128 + gdn_kperm(c8)) = lo_; *(GAS v2u*)(QD + r * 128 + gdn_kperm(c8 + 4)) = hi_; }
            else *(GAS v4u*)(KE + r * 128 + c8) = x; }
    }
    __syncthreads();
}

constexpr int FC_W = 0, FC_QD = 17408, FC_KE = 34816, FC_U0 = 52224, FC_QK = 69632, FC_RS = 78848  , FC_G = 82944  , FC_RT = 100352  ;
__device__ __forceinline__ void f_gdn_p3(ArgsR A, int l, int bh, LAS unsigned char* lds, int tid) {
    const int lane = tid & 63, wave = __builtin_amdgcn_readfirstlane(tid >> 6), fr = lane & 15, fq = lane >> 4; const int b = bh >> 2, h = bh & 3;
    const bf16* U0 = (const bf16*)(A.ws + WS_GDN_U0) + (size_t)bh * 32 * 8192; const bf16* Wg = (const bf16*)(A.ws + WS_GDN_W) + (size_t)bh * 32 * 8192; const bf16* QD = (const bf16*)(A.ws + WS_GDN_QD) + (size_t)bh * 32 * 8192;
    const bf16* KE = (const bf16*)(A.ws + WS_GDN_KE) + (size_t)bh * 32 * 8192; const bf16* QK = (const bf16*)(A.ws + WS_GDN_QK) + (size_t)bh * 32 * 4096; const float* DE = (const float*)(A.ws + WS_GDN_DE) + bh * 32;
    const bf16* P = (const bf16*)(A.ws + WS_P); bf16* mix = (bf16*)(A.ws + WS_MIX); LAS float* rsp = (LAS float*)(lds + FC_RS); LAS float* rtp = (LAS float*)(lds + FC_RT); LAS bf16* gs = (LAS bf16*)(lds + FC_G);
    const float gn = A.in[I_GDN_NG][l * GW + h * HD + 16 * wave + fr];
    LAS bf16* ws_ = (LAS bf16*)(lds + FC_W); LAS bf16* qds = (LAS bf16*)(lds + FC_QD); LAS bf16* kes = (LAS bf16*)(lds + FC_KE); LAS bf16* u0s = (LAS bf16*)(lds + FC_U0); LAS bf16* qks = (LAS bf16*)(lds + FC_QK);
    LAS unsigned char* fbase = lds + gdn_swz(fr * 64 + fq * 16); asm volatile("" : "+v"(fbase));
    f32x4 S[8];
#pragma unroll
    for (int i = 0; i < 8; ++i) S[i] = (f32x4){0.f, 0.f, 0.f, 0.f};
    v4u st[11];
    auto issue = [&](int n) {
#pragma unroll
        for (int i = 0; i < 8; ++i) { const int idx = tid + i * NTHREADS, which = idx >> 10, pi = idx & 1023;
            const bf16* src = (which == 0 ? Wg : which == 1 ? QD : which == 2 ? KE : U0) + (size_t)n * 8192; st[i] = *(const GAS v4u*)(src + pi * 8); }
        st[8] = *(const GAS v4u*)(QK + (size_t)n * 4096 + tid * 8);
#pragma unroll
        for (int i = 0; i < 2; ++i) { const int idx = tid + i * NTHREADS, r = idx >> 4, c8 = (idx & 15) * 8; st[9 + i] = *(const GAS v4u*)(P + ((size_t)b * SEQ + n * CHK + r) * PBW + PC_GDN_G + h * HD + c8); }
    };
    auto commit = [&]() {
#pragma unroll
        for (int i = 0; i < 8; ++i) { const int idx = tid + i * NTHREADS, which = idx >> 10, pi = idx & 1023, r = pi >> 4, c8 = (pi & 15) * 8;
            const int sub = ((r >> 4) * 4 + ((pi & 15) >> 2)) * 1024, q = pi & 3;
            if (i < 2) {
                v2u lo_, hi_; lo_.x = st[i].x; lo_.y = st[i].y; hi_.x = st[i].z; hi_.y = st[i].w;
                *(LAS v2u*)(lds + FC_W + sub + gdn_swz((r & 15) * 64 + (2 * (q & 1)) * 16) + (q >> 1) * 8) = lo_; *(LAS v2u*)(lds + FC_W + sub + gdn_swz((r & 15) * 64 + (2 * (q & 1) + 1) * 16) + (q >> 1) * 8) = hi_; }
            else if (i < 4) *(LAS v4u*)(lds + FC_QD + sub + gdn_swz((r & 15) * 64 + q * 16)) = st[i];
            else *(LAS v4u*)((LAS bf16*)(lds + which * 17408) + r * LD128 + c8) = st[i]; }
        { const int r = tid >> 3; *(LAS v4u*)(lds + FC_QK + ((r >> 4) * 2 + ((tid & 7) >> 2)) * 1024 + gdn_swz((r & 15) * 64 + (tid & 3) * 16)) = st[8]; }
#pragma unroll
        for (int i = 0; i < 2; ++i) { const int idx = tid + i * NTHREADS, r = idx >> 4, c8 = (idx & 15) * 8; *(LAS v4u*)(gs + r * LD128 + c8) = st[9 + i]; }
    };
    const float dev = DE[lane & 31];
    issue(0);
    f32x4 op[4]; float gp[4][4];
#pragma unroll
    for (int mt = 0; mt < 4; ++mt) { op[mt] = (f32x4){0.f, 0.f, 0.f, 0.f};
#pragma unroll
        for (int r = 0; r < 4; ++r) gp[mt][r] = 0.f; }
#define CH_ROWTOT(nn) { float v_ = rsp[((nn) & 1) * 512 + (lane & 7) * 64 + 8 * wave + (lane >> 3)]; v_ = oct_sum_f(v_); if ((lane & 7) == 0) rtp[((nn) & 1) * 64 + 8 * wave + (lane >> 3)] = v_; }
#define CH_FINAL(nn) { const LAS float* rt_ = rtp + ((nn) & 1) * 64; const size_t rp_ = (size_t)b * SEQ + (nn) * CHK; \
        _Pragma("unroll") for (int mt = 0; mt < 4; ++mt) _Pragma("unroll") for (int r = 0; r < 4; ++r) { const int c = 16 * mt + 4 * fq + r; \
            mix[(rp_ + c) * DM + 1536 + h * HD + 16 * wave + fr] = (bf16)f2bf(op[mt][r] * rsqrtf(rt_[c] * (1.0f / 128.0f) + RMS_EPS) * gn * siluf_(gp[mt][r])); } }
#pragma unroll 1
    for (int n = 0; n < NCHK; ++n) {
        __syncthreads();
        if (n > 0) CH_ROWTOT(n - 1);
        commit();
        __syncthreads();
        if (n + 1 < NCHK) issue(n + 1);
        if (n > 0) CH_FINAL(n - 1);
        const float de = lane_bcast(dev, n);
#pragma unroll
        for (int mt = 0; mt < 4; ++mt) { const v4i16_t gv = __builtin_amdgcn_ds_read_tr16_b64_v4i16((LAS v4i16_t*)(gs + (16 * mt + 4 * fq + (fr >> 2)) * LD128 + 16 * wave + 4 * (fr & 3)));
#pragma unroll
            for (int r = 0; r < 4; ++r) gp[mt][r] = bf2f((unsigned)(unsigned short)gv[r]); }
        bf16x8 SB[4];
#pragma unroll
        for (int kb = 0; kb < 4; ++kb) SB[kb] = pack_acc(S[2 * kb], S[2 * kb + 1]);
        f32x4 u[4];
#pragma unroll
        for (int mt = 0; mt < 4; ++mt) { f32x4 ws2 = {0.f, 0.f, 0.f, 0.f}; op[mt] = (f32x4){0.f, 0.f, 0.f, 0.f};
#pragma unroll
            for (int kb = 0; kb < 4; ++kb) { ws2 = MFMA16(*(const LAS bf16x8*)(fbase + FC_W + (mt * 4 + kb) * 1024), SB[kb], ws2); op[mt] = MFMA16(*(const LAS bf16x8*)(fbase + FC_QD + (mt * 4 + kb) * 1024), SB[kb], op[mt]); }
            const v4i16_t uv = __builtin_amdgcn_ds_read_tr16_b64_v4i16((LAS v4i16_t*)(u0s + (16 * mt + 4 * fq + (fr >> 2)) * LD128 + 16 * wave + 4 * (fr & 3)));
#pragma unroll
            for (int r = 0; r < 4; ++r) u[mt][r] = bf2f((unsigned)(unsigned short)uv[r]) - ws2[r]; }
        const bf16x8 UB0 = pack_acc(u[0], u[1]), UB1 = pack_acc(u[2], u[3]);
#pragma unroll
        for (int mt = 0; mt < 4; ++mt) { op[mt] = MFMA16(*(const LAS bf16x8*)(fbase + FC_QK + (mt * 2) * 1024), UB0, op[mt]); op[mt] = MFMA16(*(const LAS bf16x8*)(fbase + FC_QK + (mt * 2 + 1) * 1024), UB1, op[mt]); }
#pragma unroll
        for (int dt = 0; dt < 8; ++dt) { f32x4 sn = S[dt] * de;
            sn = MFMA16(frag_tr_perm(kes, LD128, 0, 16 * dt, lane), UB0, sn); sn = MFMA16(frag_tr_perm(kes, LD128, 32, 16 * dt, lane), UB1, sn); S[dt] = sn; }
        LAS float* rs_ = rsp + (n & 1) * 512;
#pragma unroll
        for (int mt = 0; mt < 4; ++mt)
#pragma unroll
            for (int r = 0; r < 4; ++r) { float s = op[mt][r] * op[mt][r]; s = row_sum_f(s);
                if (fr == 0) rs_[wave * 64 + 16 * mt + 4 * fq + r] = s; }
    }
    __syncthreads();
    CH_ROWTOT(NCHK - 1);
    __syncthreads();
    CH_FINAL(NCHK - 1);
#undef CH_FINAL
#undef CH_ROWTOT
    __syncthreads();
}

#ifndef TAB_FP8
#define TAB_FP8 1
#endif
constexpr size_t WS_TSC = 93 * MiB + 256 * 1024;
constexpr int NSLICE = 16;
typedef int v2i_t __attribute__((ext_vector_type(2)));
constexpr int PE_KEYS = 0, PE_CAB = 16384, PE_ENT = 17408, PE_H2Q = 53248, PE_OFFS = 148480, PE_SHQ = 150656;
constexpr int PE_PK = 0, PE_VST = 17408;
static_assert(PE_VST + 8 * 16384 <= PE_OFFS && PE_SHQ + 512 <= MISC_OFF, "PEER LDS map");

__device__ __forceinline__ void tab_convert(ArgsR A, int l, int gw, int NGW, int lane) {
    unsigned char* ws = A.ws; float* tsc = (float*)(ws + WS_TSC);
#pragma unroll 1
    for (int q = gw; q < 2 * NEXP; q += NGW) {
        const int t = q / NEXP, rr = l * NEXP + q % NEXP, r = t * DEPTH * NEXP + rr;
        const float* src = A.in[t ? I_PV : I_PU] + (size_t)rr * DM;
        f32x4 v[8];
#pragma unroll
        for (int i = 0; i < 8; ++i) v[i] = *(const GAS f32x4*)(src + 4 * (lane + 64 * i));
        unsigned char* dst = ws + (t ? WS_VB : WS_UB) + (size_t)(rr / NEXP) * TAB_L + (size_t)(rr % NEXP) * DM;
        float am = 0.f;
#pragma unroll
        for (int i = 0; i < 8; ++i) am = fmaxf(fmaxf(am, fmaxf(fabsf(v[i][0]), fabsf(v[i][1]))), fmaxf(fabsf(v[i][2]), fabsf(v[i][3])));
        am = wave_max(am); const float sc = am > 0.f ? 127.0f / am : 1.0f; const int off = 0;
#pragma unroll
        for (int i = 0; i < 8; ++i) { const int q0 = __float2int_rn(v[i][0] * sc) + off, q1 = __float2int_rn(v[i][1] * sc) + off, q2 = __float2int_rn(v[i][2] * sc) + off, q3 = __float2int_rn(v[i][3] * sc) + off;
            *(GAS unsigned*)(dst + 4 * (lane + 64 * i)) = (unsigned)(q0 & 255) | ((unsigned)(q1 & 255) << 8) | ((unsigned)(q2 & 255) << 16) | ((unsigned)(q3 & 255) << 24); }
        if (lane == 0) tsc[r] = am > 0.f ? am * (1.0f / 127.0f) : 1.0f;
    }
}
__device__ __forceinline__ float ubf0(unsigned w) { float r; asm volatile("v_cvt_f32_ubyte0 %0, %1" : "=v"(r) : "v"(w)); return r; }
__device__ __forceinline__ float ubf1(unsigned w) { float r; asm volatile("v_cvt_f32_ubyte1 %0, %1" : "=v"(r) : "v"(w)); return r; }
__device__ __forceinline__ float ubf2(unsigned w) { float r; asm volatile("v_cvt_f32_ubyte2 %0, %1" : "=v"(r) : "v"(w)); return r; }
__device__ __forceinline__ float ubf3(unsigned w) { float r; asm volatile("v_cvt_f32_ubyte3 %0, %1" : "=v"(r) : "v"(w)); return r; }
#define TOUCH16(a, o) asm volatile("" : "+v"(a[(o)+0]), "+v"(a[(o)+1]), "+v"(a[(o)+2]), "+v"(a[(o)+3]), "+v"(a[(o)+4]), "+v"(a[(o)+5]), "+v"(a[(o)+6]), "+v"(a[(o)+7]), "+v"(a[(o)+8]), "+v"(a[(o)+9]), "+v"(a[(o)+10]), "+v"(a[(o)+11]), "+v"(a[(o)+12]), "+v"(a[(o)+13]), "+v"(a[(o)+14]), "+v"(a[(o)+15]))
__device__ __forceinline__ unsigned f2sortable(float f) { const unsigned u = __builtin_bit_cast(unsigned, f); return (u & 0x80000000u) ? ~u : (u | 0x80000000u); }
__device__ __forceinline__ float unsortable(unsigned k) { const unsigned u = (k & 0x80000000u) ? (k & 0x7fffffffu) : ~k; return __builtin_bit_cast(float, u); }
__device__ __forceinline__ void peer_phase(ArgsR A, int l, bool last, bool dry, LAS unsigned char* lds, int G, int tid) {
    const int wave = __builtin_amdgcn_readfirstlane(tid >> 6), lane = tid & 63;
    unsigned char* ws = A.ws;
    const bf16* Q = (const bf16*)(ws + WS_Q);
    const bf16* K1 = (const bf16*)(ws + WS_K1) + (size_t)l * 8 * 128 * 128; const bf16* K2 = (const bf16*)(ws + WS_K2) + (size_t)l * 8 * 128 * 128;
    const unsigned char* Ub = ws + WS_UB + (size_t)l * TAB_L; const unsigned char* Vb = ws + WS_VB + (size_t)l * TAB_L;
    const float* tscU = (const float*)(ws + WS_TSC) + (size_t)l * NEXP; const float* tscV = tscU + (size_t)DEPTH * NEXP;
    const float* ssp = (const float*)(ws + WS_SSP); const float* X = A.out; float* XO = dry ? (float*)(ws + WS_P) : A.out; bf16* xb = (bf16*)(ws + (dry ? WS_MIX : WS_XB)); float* rstd1 = (float*)(ws + (dry ? WS_PS : WS_RSTD1));
    const float* g2 = A.in[I_N2G] + l * DM; const float* gf = A.in[I_FNG];
    LAS unsigned* keysL = (LAS unsigned*)(lds + PE_KEYS); LAS unsigned* cab = (LAS unsigned*)(lds + PE_CAB); LAS v2u* ent = (LAS v2u*)(lds + PE_ENT); LAS unsigned* offs = (LAS unsigned*)(lds + PE_OFFS);
    LAS float* shqL = (LAS float*)(lds + PE_SHQ); LAS unsigned* ngt = (LAS unsigned*)(lds + PE_SHQ + 128); LAS float* cqs = (LAS float*)(lds + PE_SHQ + 256); LAS unsigned* ngt8 = (LAS unsigned*)(lds + PE_SHQ + 384); LAS v4u* h2qL = (LAS v4u*)(lds + PE_H2Q);
    if (tid < 64) { int a = 0, b = tid, found = 0;
        for (int aa = 0, base = 0; aa < 16; ++aa) { const int nbb = 16 / (aa + 1); if (!found && tid < base + nbb) { a = aa; b = tid - base; found = 1; } base += nbb; }
        cab[tid] = found ? (unsigned)(a * 16 + b) : 0xffu; }
    __syncthreads();
#pragma unroll 1
    for (int item = blockIdx.x; item < NT / 32; item += G) {
        const int tok0 = item * 32;
#pragma unroll 1
        for (int tt = 0; tt < 4; ++tt) { const int tl = wave * 4 + tt; const size_t t = (size_t)tok0 + tl;
            float s2 = (lane < 32) ? ssp[t * 32 + lane] : 0.f; s2 = wave_sum(s2);
            const float rstd2 = rsqrtf(s2 * (1.0f / DM) + RMS_EPS);
            float hf[32]; float am = 0.f;
#pragma unroll
            for (int j = 0; j < 2; ++j)
#pragma unroll
                for (int q = 0; q < 4; ++q) { const size_t e0 = 16 * (size_t)(lane + 64 * j) + 4 * q;
                    const f32x4 xa = *(const GAS f32x4*)(X + t * DM + e0), ga = *(const GAS f32x4*)(g2 + e0);
#pragma unroll
                    for (int k = 0; k < 4; ++k) { const float hv = xa[k] * rstd2 * ga[k]; hf[j * 16 + q * 4 + k] = hv; am = fmaxf(am, fabsf(hv)); } }
            am = wave_max(am); const float sc = am > 0.f ? 127.0f / am : 1.0f;
#pragma unroll
            for (int j = 0; j < 2; ++j) { unsigned wd[4];
#pragma unroll
                for (int q = 0; q < 4; ++q) wd[q] = (unsigned)((__float2int_rn(hf[j * 16 + q * 4 + 0] * sc) & 255) | ((__float2int_rn(hf[j * 16 + q * 4 + 1] * sc) & 255) << 8) | ((__float2int_rn(hf[j * 16 + q * 4 + 2] * sc) & 255) << 16) | ((__float2int_rn(hf[j * 16 + q * 4 + 3] * sc) & 255) << 24));
                v4u w; w.x = wd[0]; w.y = wd[1]; w.z = wd[2]; w.w = wd[3]; h2qL[(tl * 2 + j) * 64 + lane] = w; }
            if (lane == 0) shqL[tl] = am > 0.f ? am * (1.0f / 127.0f) : 1.0f; }
#pragma unroll 1
        for (int pass = 0; pass < 4; ++pass) {
            LAS unsigned* kl = keysL + (pass & 1) * 2048;
            { const int hh = wave >> 2, side = (wave >> 1) & 1, mt = wave & 1, h = 2 * pass + hh, fr = lane & 15, fq = lane >> 4;
                const bf16* qa = Q + (size_t)(tok0 + 16 * mt + fr) * DM + h * 256 + side * 128 + 8 * fq;
                const bf16* kb = (side ? K2 : K1) + (size_t)h * 128 * 128 + (size_t)fr * 128 + 8 * fq;
                bf16x8 af[4];
#pragma unroll
                for (int ks = 0; ks < 4; ++ks) af[ks] = *(const GAS bf16x8*)(qa + 32 * ks);
                unsigned key[8][4];
#pragma unroll
                for (int nt = 0; nt < 8; ++nt) { f32x4 acc = {0.f, 0.f, 0.f, 0.f};
#pragma unroll
                    for (int ks = 0; ks < 4; ++ks) { const bf16x8 bfr = *(const GAS bf16x8*)(kb + (size_t)nt * 16 * 128 + 32 * ks); acc = __builtin_amdgcn_mfma_f32_16x16x32_bf16(af[ks], bfr, acc, 0, 0, 0); }
#pragma unroll
                    for (int r = 0; r < 4; ++r) key[nt][r] = (f2sortable(acc[r]) & ~127u) | (unsigned)(nt * 16 + fr);
                    if (nt & 1) __builtin_amdgcn_sched_barrier(0); }
#define CE8(a, b) { const unsigned hi_ = max(key[a][r], key[b][r]), lo_ = min(key[a][r], key[b][r]); key[a][r] = hi_; key[b][r] = lo_; }
#pragma unroll
                for (int r = 0; r < 4; ++r) { CE8(0, 1) CE8(2, 3) CE8(4, 5) CE8(6, 7) CE8(0, 2) CE8(1, 3) CE8(4, 6) CE8(5, 7) CE8(1, 2) CE8(5, 6) CE8(0, 4) CE8(1, 5) CE8(2, 6) CE8(3, 7) CE8(2, 4) CE8(3, 5) CE8(1, 2) CE8(3, 4) CE8(5, 6) }
#undef CE8
                unsigned res[4] = {0u, 0u, 0u, 0u};
#pragma unroll 1
                for (int j = 0; j < 16; ++j) {
#pragma unroll
                    for (int r = 0; r < 4; ++r) {
                        const unsigned w = row_max_u(key[0][r]); const bool own = key[0][r] == w;
#pragma unroll
                        for (int nt = 0; nt < 7; ++nt) key[nt][r] = own ? key[nt + 1][r] : key[nt][r];
                        key[7][r] = own ? 0u : key[7][r];
                        res[r] = (fr == j) ? w : res[r]; } }
                const int rowb = (hh * 2 + side) * 32 + 16 * mt + 4 * fq;
#pragma unroll
                for (int r = 0; r < 4; ++r) kl[(rowb + r) * 16 + fr] = res[r]; }
            __syncthreads();
#pragma unroll 1
            for (int rnd = 0; rnd < 2; ++rnd) { const int fr = lane & 15, fq = lane >> 4, pidx = rnd * 32 + wave * 4 + fq, hh = pidx >> 5, tk = pidx & 31, h = 2 * pass + hh;
                const LAS unsigned* k1 = kl + ((hh * 2) * 32 + tk) * 16; const LAS unsigned* k2 = k1 + 32 * 16;
                unsigned ck[4];
#pragma unroll
                for (int sl = 0; sl < 4; ++sl) { const int ci = fr + 16 * sl; const unsigned ab = cab[ci];
                    const float v = unsortable(k1[(ab >> 4) & 15] & ~127u) + unsortable(k2[ab & 15] & ~127u);
                    ck[sl] = (ab == 0xffu) ? 0u : ((f2sortable(v) & ~63u) | (unsigned)ci); }
#define CE4(a, b) { const unsigned hi_ = max(ck[a], ck[b]), lo_ = min(ck[a], ck[b]); ck[a] = hi_; ck[b] = lo_; }
                CE4(0, 1) CE4(2, 3) CE4(0, 2) CE4(1, 3) CE4(1, 2)
#undef CE4
                unsigned rk = 0u;
#pragma unroll 1
                for (int j = 0; j < 16; ++j) { const unsigned w = row_max_u(ck[0]); const bool own = ck[0] == w;
                    ck[0] = own ? ck[1] : ck[0]; ck[1] = own ? ck[2] : ck[1]; ck[2] = own ? ck[3] : ck[2]; ck[3] = own ? 0u : ck[3];
                    rk = (fr == j) ? w : rk; }
                const unsigned ab = cab[rk & 63u]; const float v = unsortable(rk & ~63u);
                const float vmax = row_max_f(v), e = __expf(v - vmax), den = row_sum_f(e);
                const unsigned eid = (k1[(ab >> 4) & 15] & 127u) * 128u + (k2[ab & 15] & 127u);
                const float gsv = e * rcpf_(den) * tscV[eid];
                v2u wv; wv.x = eid; wv.y = __builtin_bit_cast(unsigned, gsv);
                ent[tk * 128 + h * 16 + fr] = wv; }
        }
        __syncthreads();
#pragma unroll 1
        for (int tt = 0; tt < 4; ++tt) { const int tl = wave * 4 + tt;
            const v2u e0 = ent[tl * 128 + lane], e1 = ent[tl * 128 + 64 + lane];
            const unsigned id0 = e0.x, id1 = e1.x; const unsigned s0 = id0 >> 10, s1 = id1 >> 10; const unsigned long long lt = (1ull << lane) - 1ull;
            unsigned base = 0, p0 = 0, p1 = 0, ngr = 0, ng8 = 0, pc = 0;
#pragma unroll 1
            for (unsigned s = 0; s < NSLICE; ++s) { const unsigned long long m0 = __ballot(s0 == s), m1 = __ballot(s1 == s); const unsigned c0 = __popcll(m0), c1 = __popcll(m1); ngr += (c0 + c1 + 3u) >> 2; pc += c0 + c1; if (s & 1u) { ng8 += (pc + 7u) >> 3; pc = 0; }
                if (s0 == s) p0 = base + __popcll(m0 & lt);
                if (s1 == s) p1 = base + c0 + __popcll(m1 & lt);
                if (lane == 0) offs[tl * 17 + s] = base;
                base += c0 + c1; }
            if (lane == 0) { offs[tl * 17 + NSLICE] = base; ngt[tl] = ngr; ngt8[tl] = ng8; }
            ent[tl * 128 + p0] = e0; ent[tl * 128 + p1] = e1; }
        const unsigned lo16 = (unsigned)lane * 16u;
#if defined(PROBE_VMASK) || defined(PROBE_UMASK)
        int IDM_ = 0xffffff;
#else
        constexpr int IDM_ = 0xffffff;
#endif
        const unsigned runU = offs[(wave * 4 + (lane & 3)) * 17 + (lane >> 2)] | (offs[(wave * 4 + (lane & 3)) * 17 + (lane >> 2) + 1] << 8);
#define E_ADV(K, T, P, B1) { P += 4; while (P >= B1 && K < 64) { ++K; if (K < 64) { const int pb_ = __builtin_amdgcn_readlane((int)runU, K); P = pb_ & 255; B1 = pb_ >> 8; } } \
            if (K >= 64) { T = 0; P = 128; B1 = 128; } else T = K & 3; }
#define E_ISSUE(T, P, B1) { Ntl = wave * 4 + T; Np = P; Nb1 = B1; Nev = ent[Ntl * 128 + min(P + (lane & 3), B1 - 1)]; }
#define E_TAKE(X) { X##tl = Ntl; X##p = Np; X##b1 = Nb1; X##ev = Nev; }
#define E_USE(X) { const unsigned ex_ = X##ev.x; _Pragma("unroll") for (int e = 0; e < 4; ++e) X##id[e] = __builtin_amdgcn_readlane((int)ex_, e); X##suv = tscU[ex_]; }
#define E_LOAD(REG, TAB, X) { _Pragma("unroll") for (int e = 0; e < 4; ++e) { const GAS unsigned char* rb = (const GAS unsigned char*)(TAB) + (size_t)(X##id[e] & IDM_) * 2048; REG[e][0] = *(const GAS v4u*)(rb + lo16); REG[e][1] = *(const GAS v4u*)(rb + lo16 + 1024); } }
        {
#ifdef PROBE_UMASK
            IDM_ = dry ? PROBE_UMASK : 0xffffff;
#endif
            int Atl = 0, Ap = 0, Ab1 = 0, Aid[4]; v2u Aev = {0u, 0u}; float Asuv = 0.f; int Btl = 0, Bp = 0, Bb1 = 0, Bid[4]; v2u Bev = {0u, 0u}; float Bsuv = 0.f; int Ntl = 0, Np = 0, Nb1 = 0; v2u Nev = {0u, 0u}; v4u RA[4][2], RB[4][2];
#define U_COMP(X, REG) { const v4u hq0 = h2qL[(X##tl * 2 + 0) * 64 + lane], hq1 = h2qL[(X##tl * 2 + 1) * 64 + lane]; const float shq = shqL[X##tl]; int dd[4]; \
                _Pragma("unroll") for (int e = 0; e < 4; ++e) { int a0 = 0, a1 = 0; \
                    a0 = __builtin_amdgcn_sdot4((int)REG[e][0][0], (int)hq0[0], a0, false); a1 = __builtin_amdgcn_sdot4((int)REG[e][0][1], (int)hq0[1], a1, false); \
                    a0 = __builtin_amdgcn_sdot4((int)REG[e][0][2], (int)hq0[2], a0, false); a1 = __builtin_amdgcn_sdot4((int)REG[e][0][3], (int)hq0[3], a1, false); \
                    a0 = __builtin_amdgcn_sdot4((int)REG[e][1][0], (int)hq1[0], a0, false); a1 = __builtin_amdgcn_sdot4((int)REG[e][1][1], (int)hq1[1], a1, false); \
                    a0 = __builtin_amdgcn_sdot4((int)REG[e][1][2], (int)hq1[2], a0, false); a1 = __builtin_amdgcn_sdot4((int)REG[e][1][3], (int)hq1[3], a1, false); \
                    dd[e] = a0 + a1; } \
                const bool o1_ = (lane & 1) != 0, o2_ = (lane & 2) != 0; \
                const int r01_ = (o1_ ? dd[1] : dd[0]) + (int)dpp_rot_u<0xB1>((unsigned)(o1_ ? dd[0] : dd[1])); \
                const int r23_ = (o1_ ? dd[3] : dd[2]) + (int)dpp_rot_u<0xB1>((unsigned)(o1_ ? dd[2] : dd[3])); \
                int rr_ = (o2_ ? r23_ : r01_) + (int)dpp_rot_u<0x4E>((unsigned)(o2_ ? r01_ : r23_)); \
                rr_ += (int)dpp_rot_u<0x124>((unsigned)rr_); rr_ += (int)dpp_rot_u<0x128>((unsigned)rr_); \
                { const auto s32_ = __builtin_amdgcn_permlane32_swap(rr_, rr_, false, false); rr_ = s32_[0] + s32_[1]; const auto s16_ = __builtin_amdgcn_permlane16_swap(rr_, rr_, false, false); rr_ = s16_[0] + s16_[1]; } \
                const unsigned ex_ = X##ev.x, ey_ = X##ev.y; const float cf = __builtin_bit_cast(float, ey_) * gelu_tanh((float)rr_ * X##suv * shq); \
                if (lane < 4 && X##p + lane < X##b1) { v2u w2; w2.x = ex_; w2.y = __builtin_bit_cast(unsigned, cf); ent[X##tl * 128 + X##p + lane] = w2; } }
            int uk = -1, ut = 0, up = 0, ub1 = 0;
            const int ngU = __builtin_amdgcn_readfirstlane((int)(ngt[wave * 4] + ngt[wave * 4 + 1] + ngt[wave * 4 + 2] + ngt[wave * 4 + 3]));
            E_ADV(uk, ut, up, ub1); E_ISSUE(ut, up, ub1); E_TAKE(A); E_USE(A); E_LOAD(RA, Ub, A);
            E_ADV(uk, ut, up, ub1); E_ISSUE(ut, up, ub1);
#pragma unroll 1
            for (int gi = 0; gi < ngU; gi += 2) {
                E_TAKE(B); E_USE(B); E_LOAD(RB, Ub, B); E_ADV(uk, ut, up, ub1); E_ISSUE(ut, up, ub1);
                U_COMP(A, RA);
                E_TAKE(A); E_USE(A); E_LOAD(RA, Ub, A); E_ADV(uk, ut, up, ub1); E_ISSUE(ut, up, ub1);
                U_COMP(B, RB);
            }
            { unsigned x_ = __builtin_bit_cast(unsigned, Asuv);
#pragma unroll
                for (int e = 0; e < 4; ++e)
#pragma unroll
                    for (int j = 0; j < 2; ++j) x_ ^= RA[e][j][0] ^ RA[e][j][1] ^ RA[e][j][2] ^ RA[e][j][3];
                asm volatile("" :: "v"(x_)); }
#undef U_COMP
#undef E_USE
#undef E_TAKE
#undef E_ISSUE
#undef E_ADV
#undef E_LOAD
        }
        { LAS unsigned* pk = (LAS unsigned*)(lds + PE_PK);
#pragma unroll 1
        for (int tt = 0; tt < 4; ++tt) { const int tl = wave * 4 + tt;
            const v2u e0 = ent[tl * 128 + lane], e1 = ent[tl * 128 + 64 + lane]; const unsigned a0_ = e0.x, a1_ = e1.x, b0_ = e0.y, b1_ = e1.y;
            const float c0 = __builtin_bit_cast(float, b0_), c1 = __builtin_bit_cast(float, b1_);
            const float am = wave_max(fmaxf(fabsf(c0), fabsf(c1))); const float sc = am > 0.f ? 127.0f / am : 0.f;
            pk[tl * 128 + lane] = a0_ | (((unsigned)__float2int_rn(c0 * sc) & 255u) << 16); pk[tl * 128 + 64 + lane] = a1_ | (((unsigned)__float2int_rn(c1 * sc) & 255u) << 16);
            if (lane == 0) cqs[tl] = am * (1.0f / 127.0f); } }
        __syncthreads();
        {
            const LAS unsigned* pk = (const LAS unsigned*)(lds + PE_PK);
            const unsigned stg = (unsigned)(size_t)(lds + PE_VST) + (unsigned)wave * 16384u;
            LAS unsigned char* rdp = lds + PE_VST + wave * 16384 + ((lane >> 5) * 256 + ((lane & 15) >> 1) * 32 + ((lane >> 4) & 1) * 16 + (lane & 1) * 8);
            asm volatile("" : "+v"(rdp));
            const unsigned plane16 = ((((unsigned)lane >> 4) << 1) | ((unsigned)lane & 1u)) * 16u; const int erow = (lane >> 1) & 7;
            const unsigned char* VbU = Vb;
            float ssq0 = 0.f, ssq1 = 0.f, ssq2 = 0.f, ssq3 = 0.f;
            const int ngV = __builtin_amdgcn_readfirstlane((int)(ngt8[wave * 4] + ngt8[wave * 4 + 1] + ngt8[wave * 4 + 2] + ngt8[wave * 4 + 3]));
#if defined(PROBE_VMASK)
            IDM_ = dry ? PROBE_VMASK : 0xffffff;
#elif defined(PROBE_UMASK)
            IDM_ = 0xffffff;
#endif
            const unsigned runV = offs[(wave * 4 + (lane & 3)) * 17 + 2 * ((lane >> 2) & 7)] | (offs[(wave * 4 + (lane & 3)) * 17 + 2 * ((lane >> 2) & 7) + 2] << 8);
#define V_ADV(K, T, P, B1) { P += 8; while (P >= B1 && K < 32) { ++K; if (K < 32) { const int pb_ = __builtin_amdgcn_readlane((int)runV, K); P = pb_ & 255; B1 = pb_ >> 8; } } \
                if (K >= 32) { T = 0; P = 128; B1 = 128; } else T = K & 3; }
#define V_ISSUE(T, P, B1) { Nw = T; Np = P; Nb1 = B1; Nev = pk[(wave * 4 + T) * 128 + min(P + erow, B1 - 1)]; }
#define V_TAKE(X) { X##w = Nw; X##p = Np; X##b1 = Nb1; X##ev = Nev; }
#define V_USE(X) { const unsigned ev_ = X##ev; X##goff = ((ev_ & 0xffffu) & (unsigned)IDM_) * 2048u + hoffD; const unsigned b_ = (X##p + erow < X##b1) ? ((ev_ >> 16) & 255u) : 0u; \
                const unsigned t1_ = b_ | (dpp_rot_u<0x102>(b_) << 8); const unsigned t2_ = t1_ | (dpp_rot_u<0x104>(t1_) << 16); \
                X##c0 = __builtin_amdgcn_readlane((int)t2_, 0); X##c1 = __builtin_amdgcn_readlane((int)t2_, 8); }
#define V_D1(MOFF, GOFF) "s_add_u32 m0, %3, " #MOFF "\n\tglobal_load_lds_dwordx4 %1, %2 offset:" #GOFF "\n\t"
#define V_LOAD0(X) { unsigned keep_; asm volatile("s_waitcnt lgkmcnt(0)\n\ts_mov_b32 %0, m0\n\t" V_D1(0, 0) V_D1(896, 128) V_D1(1792, 256) V_D1(2688, 384) V_D1(3584, 512) V_D1(4480, 640) V_D1(5376, 768) V_D1(6272, 896) \
                "s_mov_b32 m0, %0" : "=&s"(keep_) : "v"(X##goff), "s"(VbU), "s"(stg) : "memory", "scc"); }
#define V_LOAD1(X) { unsigned keep_; asm volatile("s_waitcnt lgkmcnt(0)\n\ts_mov_b32 %0, m0\n\t" V_D1(8192, 0) V_D1(9088, 128) V_D1(9984, 256) V_D1(10880, 384) V_D1(11776, 512) V_D1(12672, 640) V_D1(13568, 768) V_D1(14464, 896) \
                "s_mov_b32 m0, %0" : "=&s"(keep_) : "v"(X##goff), "s"(VbU), "s"(stg) : "memory", "scc"); }
#define V_ACC(Y, BUF, X) { _Pragma("unroll") for (int j = 0; j < 16; ++j) { const v2i_t r_ = __builtin_amdgcn_ds_read_tr8_b64_v2i32((LAS v2i_t*)(rdp + (BUF) * 8192 + j * 512)); \
                Y[j] = __builtin_amdgcn_sdot4(r_[0], X##c0, Y[j], false); Y[j] = __builtin_amdgcn_sdot4(r_[1], X##c1, Y[j], false); } }
#define V_COMP(BUF, X) { asm volatile("s_waitcnt vmcnt(8)" ::: "memory");        \
                if (X##w == 0) V_ACC(y0, BUF, X) else if (X##w == 1) V_ACC(y1, BUF, X) else if (X##w == 2) V_ACC(y2, BUF, X) else V_ACC(y3, BUF, X) }
#define PV_EPI(TS, YI, SSQ) { const int tl_ = wave * 4 + (TS); const size_t t_ = (size_t)tok0 + tl_; const float cs_ = cqs[tl_]; float yv[16]; const size_t cb_ = t_ * DM + hoff + lane; \
                _Pragma("unroll") for (int j = 0; j < 16; ++j) { const float xa = *(const GAS float*)(X + cb_ + j * 64); yv[j] = xa + cs_ * (float)YI[j]; SSQ += yv[j] * yv[j]; } \
                if (!last || half == 0) { _Pragma("unroll") for (int j = 0; j < 16; ++j) *(GAS float*)(XO + cb_ + j * 64) = yv[j]; } \
                if (!last) { _Pragma("unroll") for (int j = 0; j < 16; ++j) *(GAS bf16*)(xb + cb_ + j * 64) = (bf16)f2bf(yv[j]); } \
                if (half == 1) { const float rs = rsqrtf(wave_sum(SSQ) * (1.0f / DM) + RMS_EPS); \
                    if (!last) { if (lane == 0) rstd1[t_] = rs; } \
                    else { _Pragma("unroll") for (int j = 0; j < 16; ++j) *(GAS float*)(XO + cb_ + j * 64) = yv[j] * rs * *(const GAS float*)(gf + hoff + lane + j * 64); \
                        _Pragma("unroll") for (int j = 0; j < 16; ++j) { const float ya = *(const GAS float*)(XO + t_ * DM + lane + j * 64);        \
                            *(GAS float*)(XO + t_ * DM + lane + j * 64) = ya * rs * *(const GAS float*)(gf + lane + j * 64); } } } }
#pragma unroll 1
            for (int half = 0; half < 2; ++half) {
                const unsigned hoff = (unsigned)half * 1024u, hoffD = hoff + plane16;
                int y0[16], y1[16], y2[16], y3[16];
#pragma unroll
                for (int i = 0; i < 16; ++i) { y0[i] = 0; y1[i] = 0; y2[i] = 0; y3[i] = 0; }
                {
                    int Aw = 0, Ap = 0, Ab1 = 0, Ac0 = 0, Ac1 = 0, Bw = 0, Bp = 0, Bb1 = 0, Bc0 = 0, Bc1 = 0, Nw = 0, Np = 0, Nb1 = 0; unsigned Aev = 0u, Bev = 0u, Nev = 0u, Agoff = 0u, Bgoff = 0u;
                    int uk = -1, ut = 0, up = 0, ub1 = 0;
                    V_ADV(uk, ut, up, ub1); V_ISSUE(ut, up, ub1); V_TAKE(A); V_USE(A); V_LOAD0(A);
                    V_ADV(uk, ut, up, ub1); V_ISSUE(ut, up, ub1);
#pragma unroll 1
                    for (int gi = 0; gi < ngV; gi += 2) {
                        V_TAKE(B); V_USE(B); V_LOAD1(B); V_ADV(uk, ut, up, ub1); V_ISSUE(ut, up, ub1);
                        V_COMP(0, A);
                        V_TAKE(A); V_USE(A); V_LOAD0(A); V_ADV(uk, ut, up, ub1); V_ISSUE(ut, up, ub1);
                        V_COMP(1, B);
                    }
                    asm volatile("s_waitcnt vmcnt(0)" ::: "memory");
                }
                PV_EPI(0, y0, ssq0);
                PV_EPI(1, y1, ssq1);
                PV_EPI(2, y2, ssq2);
                PV_EPI(3, y3, ssq3);
            }
#undef PV_EPI
#undef V_COMP
#undef V_ACC
#undef V_LOAD0
#undef V_LOAD1
#undef V_D1
#undef V_USE
#undef V_TAKE
#undef V_ISSUE
#undef V_ADV
        }
        __syncthreads();
    }
}

#ifndef PROBE_ITEM
#define PROBE_ITEM -1
#endif
#ifndef PROBE_ITEMS
#define PROBE_ITEMS 0
#endif
#define IREP(k) for (int irep = (PROBE_ITEM == (k) || ((PROBE_ITEMS >> (k)) & 1)) ? 0 : 1; irep < 2; ++irep)
__device__ __forceinline__ void mix_p2(ArgsR A, int l, LAS unsigned char* lds, int G, int tid) {
    const int bx = blockIdx.x; (void)tid;
    IREP(1) for (int it = bx; it < 512; it += G) f_gla_p2(A, l, it, lds, pg8::fresh_tid());
    IREP(2) for (int it = bx; it < 512; it += G) f_ml_p2(A, l, it, lds, pg8::fresh_tid());
    IREP(3) for (int it = bx; it < 512; it += G) f_gdn_p2(A, l, it, lds, pg8::fresh_tid());
    IREP(4) for (int it = bx; it < 1024; it += G) f_lru_p2(A, l, it, lds, pg8::fresh_tid());
}
__device__ __forceinline__ void part_barrier(unsigned* word, unsigned nb, int tid) {
    asm volatile("s_waitcnt vmcnt(0)" ::: "memory");
    __syncthreads();
    if (tid == 0) {
        __builtin_amdgcn_fence(__ATOMIC_RELEASE, "agent");
        asm volatile("s_waitcnt vmcnt(0)" ::: "memory");
        __hip_atomic_fetch_add(word, 1u, __ATOMIC_RELAXED, __HIP_MEMORY_SCOPE_AGENT);
        unsigned sp = 0;
        while (__hip_atomic_load(word, __ATOMIC_RELAXED, __HIP_MEMORY_SCOPE_AGENT) < nb) { __builtin_amdgcn_s_sleep(2); if (++sp > (1u << 22)) break; }
        __builtin_amdgcn_fence(__ATOMIC_ACQUIRE, "agent");
        asm volatile("s_waitcnt vmcnt(0)" ::: "memory");
    }
    __syncthreads();
}
__device__ __forceinline__ void mix_p3(ArgsR A, int l, LAS unsigned char* lds, int G) {
    const int bx = blockIdx.x;
    const bool split = G > 32;
    int first = 0, nb = G;
    if (split) { if (bx < 16) { IREP(8) f_gdn_p3(A, l, bx, lds, pg8::fresh_tid()); return; } first = 16; nb = G - 16; }
    else { for (int it = bx; it < 16; it += G) f_gdn_p3(A, l, it, lds, pg8::fresh_tid()); }
    IREP(9) for (int it = bx - first; it < 516; it += nb) {
        if (it < 256) f_gla_p3(A, it, pg8::fresh_tid());
        else if (it < 512) f_ml_p3(A, it - 256, pg8::fresh_tid());
        else f_lru_p3(A, it - 512, pg8::fresh_tid());
    }
    IREP(7) { const int t2 = pg8::fresh_tid(); tab_convert(A, l, (bx - first) * NWAVES + __builtin_amdgcn_readfirstlane(t2 >> 6), nb * NWAVES, t2 & 63); }
    if (l == 0 && DEPTH > 1) { const int t3 = pg8::fresh_tid(); const int w3 = __builtin_amdgcn_readfirstlane(t3 >> 6); __syncthreads(); p0_weights(A, lds, 1, DEPTH, (bx - first) * NWAVES + w3, nb * NWAVES, w3, t3 & 63); }
    part_barrier((unsigned*)(A.ws + WS_CTL) + CW_PBAR + 64 * l, (unsigned)nb, pg8::fresh_tid());
    IREP(5) for (int it = bx - first; it < 512; it += nb) f_gla_p4(A, l, it, lds, pg8::fresh_tid());
    IREP(6) for (int it = nb - 1 - (bx - first); it < 512; it += nb) f_ml_p4(       A, l, it, lds, pg8::fresh_tid());
    IREP(10) { const int wi = bx - first; f_lru_p4(A, (int)((long)wi * NT / nb), (int)((long)(wi + 1) * NT / nb), pg8::fresh_tid()); }
}

#ifndef PROBE_PHASE
#define PROBE_PHASE -1
#endif
#ifndef MK_PER_PHASE
#define MK_PER_PHASE 0
#endif
#ifdef PROBE_DUP
constexpr int PPL = 7;
#else
constexpr int PPL = 6;
#endif
constexpr int NPHASE = 1 + PPL * DEPTH;
constexpr int CW_BAR = 4096;

__global__ void __launch_bounds__(NTHREADS, 2) mk_fwd(Args args) {
    extern __shared__ __attribute__((aligned(16))) unsigned char lds_raw[];
    LAS unsigned char* lds = (LAS unsigned char*)lds_raw;
    volatile LAS unsigned* MISC = (volatile LAS unsigned*)(lds + MISC_OFF);
    const int G = gridDim.x; const int bx = blockIdx.x;
    unsigned char* ws = args.ws;
    if (threadIdx.x < 64) MISC[threadIdx.x] = 0u;
    __syncthreads();
    XcdBarrier bar; bar.bar = (unsigned*)(ws + WS_CTL) + CW_BAR; bar.x = 0; bar.st = nullptr;
    if (!MK_PER_PHASE) bar = xcd_barrier_post((unsigned*)(ws + WS_CTL) + CW_BAR, MISC + 8);
    const int lo = args.ph_lo, hi = args.ph_hi;
#pragma unroll 1
    for (int ph = lo; ph < hi; ++ph) {
#ifdef PROBE_DUP
        const int l = ph > 0 ? (ph - 1) / PPL : 0, kx = ph > 0 ? (ph - 1) % PPL : -1, k = kx > PROBE_DUP ? kx - 1 : kx; const bool dry = (kx == PROBE_DUP);
#else
        const int l = ph > 0 ? (ph - 1) / PPL : 0, k = ph > 0 ? (ph - 1) % PPL : -1; const bool dry = false;
#endif
        if (k < 0) { const int t0 = pg8::fresh_tid(); const int vcu = (G % 8 == 0) ? (bx % 8) * (G / 8) + bx / 8 : bx; p0_prologue(*kargs(), lds, vcu, G, __builtin_amdgcn_readfirstlane(t0 >> 6), t0 & 63); }
        else if (k == 0) {
            pg8::Gemm g{(const pg8::bf16_t*)(ws + WS_XB), (const pg8::bf16_t*)(ws + WS_WIN + l * WIN_L), NT, NINP, DM}; pg8::StaticOrder S; S.init(NT, NINP, G, bx);
            pg8::EpiP E{(pg8::bf16_t*)(ws + WS_P), (float*)(ws + WS_PS), (const float*)(ws + WS_RSTD1)};
            pg8::gemm_phase<pg8::EpiP, pg8::StaticOrder, true, true>(lds, g, S, E); }
        else if (k == 1) mix_p2(*kargs(), l, lds, G, pg8::fresh_tid());
        else if (k == 2) mix_p3(*kargs(), l, lds, G);
        else if (k == 3) {
            pg8::Gemm g{(const pg8::bf16_t*)(ws + WS_MIX), (const pg8::bf16_t*)(ws + WS_WOUT + l * WSQ_L), NT, DM, DM}; pg8::StaticOrder S; S.init(NT, DM, G, bx);
            pg8::EpiX E{l == 0 ? args.in[I_X] : (const float*)args.out, dry ? (float*)(ws + WS_P) : args.out, (pg8::bf16_t*)(ws + (dry ? WS_Q : WS_XB)), (float*)(ws + (dry ? WS_PS : WS_SSP))};
            pg8::gemm_phase<pg8::EpiX, pg8::StaticOrder, true, true>(lds, g, S, E); }
        else if (k == 4) {
            pg8::Gemm g{(const pg8::bf16_t*)(ws + WS_XB), (const pg8::bf16_t*)(ws + WS_WQ + l * WSQ_L), NT, DM, DM}; pg8::StaticOrder S; S.init(NT, DM, G, bx);
            pg8::EpiQ E{(pg8::bf16_t*)(ws + WS_Q), (const float*)(ws + WS_SSP)};
            pg8::gemm_phase<pg8::EpiQ, pg8::StaticOrder, true, true>(lds, g, S, E); }
        else peer_phase(*kargs(), l, l == DEPTH - 1, dry, lds, G, pg8::fresh_tid());
        if (!MK_PER_PHASE && ph + 1 < hi) xcd_barrier(bar);
    }
}

extern "C" void kernel_launch(void* const* d_in, const int* in_sizes, int n_in, void* d_out, int out_size, void* d_ws, size_t ws_size, hipStream_t stream) {
    static int grid = 0;
    if (grid == 0) {
        if (n_in != N_IN || out_size != NT * DM || ws_size < WS_END) { fprintf(stderr, "kernel_launch: unexpected shapes: n_in %d out %d ws %zu (need %zu)\n", n_in, out_size, ws_size, (size_t)WS_END); grid = -1; return; }
        int dev = 0, cus = 0, per_cu = 0;
        if (hipGetDevice(&dev) != hipSuccess || hipDeviceGetAttribute(&cus, hipDeviceAttributeMultiprocessorCount, dev) != hipSuccess) { grid = -1; return; }
        if (hipFuncSetAttribute((const void*)mk_fwd, hipFuncAttributeMaxDynamicSharedMemorySize, LDS_BYTES) != hipSuccess) { fprintf(stderr, "kernel_launch: hipFuncSetAttribute failed\n"); grid = -1; return; }
        if (hipOccupancyMaxActiveBlocksPerMultiprocessor(&per_cu, (const void*)mk_fwd, NTHREADS, LDS_BYTES) != hipSuccess || per_cu < 1) { fprintf(stderr, "kernel_launch: occupancy query says %d blocks per CU\n", per_cu); (void)hipGetLastError(); grid = -1; return; }
        grid = cus;
    }
    if (grid < 0) return;
    if (hipMemsetAsync((char*)d_ws + WS_CTL, 0, CTL_ZERO_BYTES, stream) != hipSuccess) return;
    Args a{};
    for (int i = 0; i < N_IN; ++i) a.in[i] = (const float*)d_in[i];
    a.out = (float*)d_out; a.ws = (unsigned char*)d_ws;
#if MK_PER_PHASE
    for (int p = 0; p < NPHASE; ++p) { a.ph_lo = p; a.ph_hi = p + 1; a.li = 0; hipLaunchKernelGGL(mk_fwd, dim3(grid), dim3(NTHREADS), LDS_BYTES, stream, a); }
#else
    a.ph_lo = 0; a.ph_hi = NPHASE; a.li = 0;
    hipLaunchKernelGGL(mk_fwd, dim3(grid), dim3(NTHREADS), LDS_BYTES, stream, a);
#endif
}
```

```cpp
#include <hip/hip_runtime.h>
#include <cstdio>
#include <cstdint>
namespace pg8 {
__device__ __forceinline__ int fresh_tid() { int t = threadIdx.x; asm volatile("" : "+v"(t)); return t; }
#define PG8_LAS __attribute__((address_space(3)))
typedef unsigned short bf16_t;
typedef short bf16x8 __attribute__((ext_vector_type(8)));
typedef float f32x4 __attribute__((ext_vector_type(4)));
typedef unsigned u32x4 __attribute__((ext_vector_type(4)));
typedef int i32x4_t __attribute__((ext_vector_type(4)));
constexpr int BM = 256, BK = 64, HALF = 128, HTB = HALF * BK * 2  , STAGE_BYTES = 8 * HTB, NXCD = 8, WGM = 8;

__host__ __device__ __forceinline__ int lds_byte(int r, int c) { const int st = (r >> 4) * 2 + (c >> 5), rr = r & 15, cc = c & 31, ob = rr * 64 + cc * 2; return st * 1024 + (ob ^ (((ob >> 9) & 1) << 5)); }
__host__ __device__ __forceinline__ void stage_rc(int b, int& R, int& C) { const int st = b / 1024, sb = b % 1024, swz = sb ^ (((sb >> 9) & 1) << 5); R = (st >> 1) * 16 + swz / 64; C = (st & 1) * 32 + (swz % 64) / 2; }
__host__ __device__ __forceinline__ int perm32(int rho) { const int n = rho >> 4, i = rho & 15; return 8 * (i >> 2) + 4 * n + (i & 3); }

struct Unit { int pm, pn; };
struct Gemm { const bf16_t* A; const bf16_t* Bt; int M, N, K; };

struct StaticOrder {
    int nM, nN, nwg, G, c;
    __host__ __device__ void init(int M, int N, int G_, int c_) { nM = M / BM; nN = N / BM; nwg = nM * nN; G = G_; c = c_; }
    __host__ __device__ bool next(int i, Unit& u) const {
        const long L = (long)i * G + c; if (L >= nwg) return false;
        int wgid = (int)L; { const int q = nwg / NXCD, r = nwg % NXCD, xcd = wgid % NXCD, off = wgid / NXCD; wgid = (xcd < r ? xcd * (q + 1) : r * (q + 1) + (xcd - r) * q) + off; }
        const int nig = WGM * nN, gid = wgid / nig, fm = gid * WGM, gsz = (nM - fm) < WGM ? (nM - fm) : WGM;
        u.pm = fm + ((wgid % nig) % gsz); u.pn = (wgid % nig) / gsz; return true;
    }
    __device__ __forceinline__ void a_ready(const Unit&) const {}
    __device__ __forceinline__ void done(const Unit&) const {}
};


__device__ __forceinline__ unsigned cvt_pk_bf16(float lo, float hi) { unsigned r; asm volatile("v_cvt_pk_bf16_f32 %0, %1, %2" : "=v"(r) : "v"(lo), "v"(hi)); return r; }

struct EpiP {
    static constexpr bool PERM = true, AFTER_DRAIN = false, I8 = false;
    bf16_t* P; float* Ps; const float* rstd;
    __device__ __forceinline__ void operator()(const f32x4 (&acc)[2][2][4][2], const Unit& u, int wr, int wc, int fr, int fq) const {
        const int row0 = u.pm * BM + wr * 64 + fr;
        if (u.pn < 28) {
            const int col0 = u.pn * BM + wc * 32 + 8 * fq;
#pragma unroll
            for (int ai = 0; ai < 2; ++ai)
#pragma unroll
                for (int m = 0; m < 4; ++m) { const int row = row0 + ai * HALF + m * 16; const float r = rstd[row]; bf16_t* rowp = P + (size_t)row * 7168 + col0;
#pragma unroll
                    for (int bj = 0; bj < 2; ++bj) { const f32x4 v0 = acc[ai][bj][m][0] * r, v1 = acc[ai][bj][m][1] * r;
                        u32x4 w; w.x = cvt_pk_bf16(v0[0], v0[1]); w.y = cvt_pk_bf16(v0[2], v0[3]); w.z = cvt_pk_bf16(v1[0], v1[1]); w.w = cvt_pk_bf16(v1[2], v1[3]);
                        *(u32x4*)(rowp + bj * HALF) = w; } }
        } else if (wc == 0) {
#pragma unroll
            for (int ai = 0; ai < 2; ++ai)
#pragma unroll
                for (int m = 0; m < 4; ++m) { const int row = row0 + ai * HALF + m * 16; const float r = rstd[row]; float* p = Ps + (size_t)row * 32 + 8 * fq;
                    *(f32x4*)p = acc[ai][0][m][0] * r; *(f32x4*)(p + 4) = acc[ai][0][m][1] * r; }
        }
    }
};
struct EpiP8 {
    static constexpr bool PERM = true, AFTER_DRAIN = false, I8 = true;
    bf16_t* P; float* Ps; const float* rsq; const float* sw;
    __device__ __forceinline__ void operator()(const f32x4 (&acc)[2][2][4][2], const Unit& u, int wr, int wc, int fr, int fq) const {
        const int row0 = u.pm * BM + wr * 64 + fr;
        if (u.pn < 28) {
            const int col0 = u.pn * BM + wc * 32 + 8 * fq;
            f32x4 cs[2][2];
#pragma unroll
            for (int bj = 0; bj < 2; ++bj) { cs[bj][0] = *(const f32x4*)(sw + col0 + bj * HALF); cs[bj][1] = *(const f32x4*)(sw + col0 + bj * HALF + 4); }
#pragma unroll
            for (int ai = 0; ai < 2; ++ai)
#pragma unroll
                for (int m = 0; m < 4; ++m) { const int row = row0 + ai * HALF + m * 16; const float r = rsq[row]; bf16_t* rowp = P + (size_t)row * 7168 + col0;
#pragma unroll
                    for (int bj = 0; bj < 2; ++bj) { const i32x4_t a0 = __builtin_bit_cast(i32x4_t, acc[ai][bj][m][0]), a1 = __builtin_bit_cast(i32x4_t, acc[ai][bj][m][1]);
                        u32x4 w; w.x = cvt_pk_bf16((float)a0[0] * r * cs[bj][0][0], (float)a0[1] * r * cs[bj][0][1]); w.y = cvt_pk_bf16((float)a0[2] * r * cs[bj][0][2], (float)a0[3] * r * cs[bj][0][3]);
                        w.z = cvt_pk_bf16((float)a1[0] * r * cs[bj][1][0], (float)a1[1] * r * cs[bj][1][1]); w.w = cvt_pk_bf16((float)a1[2] * r * cs[bj][1][2], (float)a1[3] * r * cs[bj][1][3]);
                        *(u32x4*)(rowp + bj * HALF) = w; } }
        } else if (wc == 0) {
            const f32x4 c0 = *(const f32x4*)(sw + 7168 + 8 * fq), c1 = *(const f32x4*)(sw + 7168 + 8 * fq + 4);
#pragma unroll
            for (int ai = 0; ai < 2; ++ai)
#pragma unroll
                for (int m = 0; m < 4; ++m) { const int row = row0 + ai * HALF + m * 16; const float r = rsq[row]; float* p = Ps + (size_t)row * 32 + 8 * fq;
                    const i32x4_t a0 = __builtin_bit_cast(i32x4_t, acc[ai][0][m][0]), a1 = __builtin_bit_cast(i32x4_t, acc[ai][0][m][1]);
                    *(f32x4*)p = (f32x4){(float)a0[0] * r * c0[0], (float)a0[1] * r * c0[1], (float)a0[2] * r * c0[2], (float)a0[3] * r * c0[3]};
                    *(f32x4*)(p + 4) = (f32x4){(float)a1[0] * r * c1[0], (float)a1[1] * r * c1[1], (float)a1[2] * r * c1[2], (float)a1[3] * r * c1[3]}; }
        }
    }
};
struct EpiX {
    static constexpr bool PERM = true, AFTER_DRAIN = false, I8 = false;
    const float* xres; float* xout; bf16_t* xb; float* ssp; bool res16;
    __device__ __forceinline__ void operator()(const f32x4 (&acc)[2][2][4][2], const Unit& u, int wr, int wc, int fr, int fq) const {
        const int row0 = u.pm * BM + wr * 64 + fr, col0 = u.pn * BM + wc * 32 + 8 * fq;
#pragma unroll
        for (int ai = 0; ai < 2; ++ai)
#pragma unroll
            for (int m = 0; m < 4; ++m) { const int row = row0 + ai * HALF + m * 16; float ss = 0.f;
#pragma unroll
                for (int bj = 0; bj < 2; ++bj) { const size_t off = (size_t)row * 2048 + col0 + bj * HALF;
                    f32x4 r0, r1;
                    if (res16) { const u32x4 rw = *(const u32x4*)(xb + off); const unsigned a_ = rw.x, b_ = rw.y, c_ = rw.z, d_ = rw.w;
                        r0 = (f32x4){__builtin_bit_cast(float, a_ << 16), __builtin_bit_cast(float, a_ & 0xffff0000u), __builtin_bit_cast(float, b_ << 16), __builtin_bit_cast(float, b_ & 0xffff0000u)};
                        r1 = (f32x4){__builtin_bit_cast(float, c_ << 16), __builtin_bit_cast(float, c_ & 0xffff0000u), __builtin_bit_cast(float, d_ << 16), __builtin_bit_cast(float, d_ & 0xffff0000u)}; }
                    else { r0 = *(const f32x4*)(xres + off); r1 = *(const f32x4*)(xres + off + 4); }
                    const f32x4 v0 = acc[ai][bj][m][0] + r0, v1 = acc[ai][bj][m][1] + r1;
                    u32x4 w; w.x = cvt_pk_bf16(v0[0], v0[1]); w.y = cvt_pk_bf16(v0[2], v0[3]); w.z = cvt_pk_bf16(v1[0], v1[1]); w.w = cvt_pk_bf16(v1[2], v1[3]);
                    *(u32x4*)(xb + off) = w;
                    ss += (v0[0] * v0[0] + v0[1] * v0[1]) + (v0[2] * v0[2] + v0[3] * v0[3]) + (v1[0] * v1[0] + v1[1] * v1[1]) + (v1[2] * v1[2] + v1[3] * v1[3]); }
                ss += __shfl_xor(ss, 16); ss += __shfl_xor(ss, 32);
                if (fq == 0) ssp[(size_t)row * 32 + u.pn * 4 + wc] = ss; }
    }
};
struct EpiQ {
    static constexpr bool PERM = true, AFTER_DRAIN = false, I8 = false;
    bf16_t* Q; const float* ssp;
    __device__ __forceinline__ void operator()(const f32x4 (&acc)[2][2][4][2], const Unit& u, int wr, int wc, int fr, int fq) const {
        const int row0 = u.pm * BM + wr * 64 + fr, col0 = u.pn * BM + wc * 32 + 8 * fq;
#pragma unroll
        for (int ai = 0; ai < 2; ++ai)
#pragma unroll
            for (int m = 0; m < 4; ++m) { const int row = row0 + ai * HALF + m * 16;
                const f32x4* sp = (const f32x4*)(ssp + (size_t)row * 32 + 8 * fq); const f32x4 a = sp[0], b = sp[1];
                float s = ((a[0] + a[1]) + (a[2] + a[3])) + ((b[0] + b[1]) + (b[2] + b[3]));
                s += __shfl_xor(s, 16); s += __shfl_xor(s, 32);
                const float r = rsqrtf(s * (1.0f / 2048.0f) + 1e-6f); bf16_t* rowp = Q + (size_t)row * 2048 + col0;
#pragma unroll
                for (int bj = 0; bj < 2; ++bj) { const f32x4 v0 = acc[ai][bj][m][0] * r, v1 = acc[ai][bj][m][1] * r;
                    u32x4 w; w.x = cvt_pk_bf16(v0[0], v0[1]); w.y = cvt_pk_bf16(v0[2], v0[3]); w.z = cvt_pk_bf16(v1[0], v1[1]); w.w = cvt_pk_bf16(v1[2], v1[3]);
                    *(u32x4*)(rowp + bj * HALF) = w; } }
    }
};

template <bool I8> __device__ __forceinline__ f32x4 pg8_mma(const bf16x8& a, const bf16x8& b, const f32x4& c) {
    if constexpr (I8) return __builtin_bit_cast(f32x4, __builtin_amdgcn_mfma_i32_16x16x64_i8(__builtin_bit_cast(i32x4_t, a), __builtin_bit_cast(i32x4_t, b), __builtin_bit_cast(i32x4_t, c), 0, 0, 0));
    else return __builtin_amdgcn_mfma_f32_16x16x32_bf16(a, b, c, 0, 0, 0);
}
template <class Epi, class Sched, bool ALIGN_EPI = false, bool SP2 = false>
__device__ __forceinline__ void gemm_phase(PG8_LAS unsigned char* lds, const Gemm g, const Sched& S, const Epi& E) {
    const int tid = fresh_tid(), wid = __builtin_amdgcn_readfirstlane(tid >> 6), lane = tid & 63, wr = wid >> 2, wc = wid & 3, fr = lane & 15, fq = lane >> 4;
    const int K = g.K, nt = K / BK;
    unsigned voffA[2], voffB[2];
#pragma unroll
    for (int i = 0; i < 2; ++i) { int R, C; stage_rc(tid * 16 + i * 8192, R, C); const int Rb = Epi::PERM ? ((R & ~31) + perm32(R & 31)) : R;
        voffA[i] = (unsigned)(R * K + C) * 2u; voffB[i] = (unsigned)(Rb * K + C) * 2u; }
    const size_t kstep = (size_t)(BK * 2);
    const size_t hstep = (size_t)HALF * K * 2;
    const size_t tstep = 2 * hstep;
    const unsigned ldsw = (unsigned)wid * 1024u;
    const int aoff = lds_byte(wr * 64 + fr, fq * 8), boff = lds_byte(wc * 32 + fr, fq * 8);
#define PG8_SA(b, h) (((b) * 2 + (h)) * HTB)
#define PG8_SB(b, h) ((4 + (b) * 2 + (h)) * HTB)
#define PG8_STAGE(bufoff, gbase, voff) do { _Pragma("unroll") for (int _i = 0; _i < 2; ++_i) \
        __builtin_amdgcn_global_load_lds((const unsigned*)((const char*)(gbase) + (voff)[_i]), (PG8_LAS unsigned*)(lds + (bufoff) + ldsw + _i * 8192), 16, 0, 0); } while (0)
#define PG8_LDA(dst, b, h) do { _Pragma("unroll") for (int m = 0; m < 4; ++m) _Pragma("unroll") for (int k = 0; k < 2; ++k) dst[m][k] = *(const PG8_LAS bf16x8*)(lds + PG8_SA(b, h) + aoff + m * 2048 + k * 1024); } while (0)
#define PG8_LDB(dst, b, h) do { _Pragma("unroll") for (int n = 0; n < 2; ++n) _Pragma("unroll") for (int k = 0; k < 2; ++k) dst[n][k] = *(const PG8_LAS bf16x8*)(lds + PG8_SB(b, h) + boff + n * 2048 + k * 1024); } while (0)
#define PG8_MMA(ai, bj, At, Bt) do { __builtin_amdgcn_s_setprio(1); _Pragma("unroll") for (int m = 0; m < 4; ++m) _Pragma("unroll") for (int n = 0; n < 2; ++n) _Pragma("unroll") for (int k = 0; k < 2; ++k) \
        acc[ai][bj][m][n] = pg8_mma<Epi::I8>(Bt[n][k], At[m][k], acc[ai][bj][m][n]); __builtin_amdgcn_s_setprio(0); } while (0)
#define PG8_WAIT_V(n) asm volatile("s_waitcnt vmcnt(" #n ")" ::: "memory")
#define PG8_WAIT_L(n) asm volatile("s_waitcnt lgkmcnt(" #n ")" ::: "memory")
#define PG8_BAR __builtin_amdgcn_s_barrier()
#define PG8_SCHED __builtin_amdgcn_sched_barrier(0)
    Unit cur, nxt; int ui = 0;
    if (!S.next(0, cur)) return;
    f32x4 acc[2][2][4][2];
#pragma unroll
    for (int a = 0; a < 2; ++a)
#pragma unroll
        for (int b = 0; b < 2; ++b)
#pragma unroll
            for (int m = 0; m < 4; ++m)
#pragma unroll
                for (int n = 0; n < 2; ++n) acc[a][b][m][n] = (f32x4){0.f, 0.f, 0.f, 0.f};
    bf16x8 At[4][2], B0[2][2], B1[2][2];
    const char* cA = (const char*)g.A + (size_t)cur.pm * tstep; const char* cB = (const char*)g.Bt + (size_t)cur.pn * tstep;
    S.a_ready(cur);
    if constexpr (SP2) {
        PG8_STAGE(PG8_SB(0, 0), cB, voffB); PG8_STAGE(PG8_SB(0, 1), cB + hstep, voffB); PG8_STAGE(PG8_SA(0, 0), cA, voffA); PG8_STAGE(PG8_SA(0, 1), cA + hstep, voffA);
        if (wr == 1) PG8_BAR;
        PG8_WAIT_V(2); PG8_BAR;
        PG8_STAGE(PG8_SB(1, 0), cB + kstep, voffB); PG8_STAGE(PG8_SA(1, 0), cA + kstep, voffA); PG8_STAGE(PG8_SB(1, 1), cB + hstep + kstep, voffB);
        PG8_WAIT_V(6); PG8_BAR;
    } else {
        PG8_STAGE(PG8_SB(0, 0), cB, voffB); PG8_STAGE(PG8_SA(0, 0), cA, voffA); PG8_STAGE(PG8_SB(0, 1), cB + hstep, voffB); PG8_STAGE(PG8_SA(0, 1), cA + hstep, voffA);
        if (wr == 1) PG8_BAR;
        PG8_WAIT_V(4); PG8_BAR;
        PG8_STAGE(PG8_SB(1, 0), cB + kstep, voffB); PG8_STAGE(PG8_SA(1, 0), cA + kstep, voffA); PG8_STAGE(PG8_SB(1, 1), cB + hstep + kstep, voffB);
        PG8_WAIT_V(6); PG8_BAR;
    }
    for (;;) {
        const bool has_next = S.next(ui + 1, nxt);
        const char* nA = has_next ? (const char*)g.A + (size_t)nxt.pm * tstep : cA; const char* nB = has_next ? (const char*)g.Bt + (size_t)nxt.pn * tstep : cB;
        for (int t = 0; t < nt; t += 2) {
            const bool last = (t == nt - 2);
            const char* a1 = cA + (size_t)(t + 1) * kstep;
            const char* a2 = last ? nA : cA + (size_t)(t + 2) * kstep; const char* b2 = last ? nB : cB + (size_t)(t + 2) * kstep;
            const char* a3 = a2 + kstep; const char* b3 = b2 + kstep;
            if (last && has_next) S.a_ready(nxt);
            if constexpr (SP2) {
            PG8_LDB(B0, 0, 0); PG8_LDB(B1, 0, 1); PG8_SCHED; PG8_LDA(At, 0, 0); PG8_STAGE(PG8_SA(1, 1), a1 + hstep, voffA);
            PG8_WAIT_V(8); PG8_WAIT_L(0); PG8_BAR; PG8_MMA(0, 0, At, B0); PG8_MMA(0, 1, At, B1); PG8_BAR; PG8_SCHED;
            PG8_LDA(At, 0, 1); PG8_STAGE(PG8_SB(0, 0), b2, voffB); PG8_STAGE(PG8_SB(0, 1), b2 + hstep, voffB); PG8_STAGE(PG8_SA(0, 0), a2, voffA);
            PG8_WAIT_V(8); PG8_WAIT_L(0); PG8_BAR; PG8_MMA(1, 0, At, B0); PG8_MMA(1, 1, At, B1); PG8_BAR; PG8_SCHED;
            PG8_LDB(B0, 1, 0); PG8_LDB(B1, 1, 1); PG8_SCHED; PG8_LDA(At, 1, 0); PG8_STAGE(PG8_SA(0, 1), a2 + hstep, voffA);
            PG8_WAIT_V(8); PG8_WAIT_L(0); PG8_BAR; PG8_MMA(0, 0, At, B0); PG8_MMA(0, 1, At, B1); PG8_BAR; PG8_SCHED;
            PG8_LDA(At, 1, 1); PG8_STAGE(PG8_SB(1, 0), b3, voffB); PG8_STAGE(PG8_SB(1, 1), b3 + hstep, voffB); PG8_STAGE(PG8_SA(1, 0), a3, voffA);
            PG8_WAIT_V(8); PG8_WAIT_L(0); PG8_BAR; PG8_MMA(1, 0, At, B0); PG8_MMA(1, 1, At, B1); PG8_BAR; PG8_SCHED;
            } else {
            PG8_LDB(B0, 0, 0); PG8_SCHED; PG8_LDA(At, 0, 0); PG8_STAGE(PG8_SA(1, 1), a1 + hstep, voffA);
            PG8_WAIT_L(8); PG8_BAR; PG8_WAIT_L(0); PG8_MMA(0, 0, At, B0); PG8_BAR; PG8_SCHED;
            PG8_LDB(B1, 0, 1); PG8_STAGE(PG8_SB(0, 0), b2, voffB);
            PG8_BAR; PG8_WAIT_L(0); PG8_MMA(0, 1, At, B1); PG8_BAR;
            PG8_LDA(At, 0, 1); PG8_STAGE(PG8_SA(0, 0), a2, voffA);
            PG8_BAR; PG8_WAIT_L(0); PG8_MMA(1, 0, At, B0); PG8_BAR; PG8_SCHED;
            PG8_STAGE(PG8_SB(0, 1), b2 + hstep, voffB);
            PG8_WAIT_V(6); PG8_BAR; PG8_MMA(1, 1, At, B1); PG8_BAR;
            PG8_LDB(B0, 1, 0); PG8_SCHED; PG8_LDA(At, 1, 0); PG8_STAGE(PG8_SA(0, 1), a2 + hstep, voffA);
            PG8_WAIT_L(8); PG8_BAR; PG8_WAIT_L(0); PG8_MMA(0, 0, At, B0); PG8_BAR; PG8_SCHED;
            PG8_LDB(B1, 1, 1); PG8_STAGE(PG8_SB(1, 0), b3, voffB);
            PG8_BAR; PG8_WAIT_L(0); PG8_MMA(0, 1, At, B1); PG8_BAR;
            PG8_LDA(At, 1, 1); PG8_STAGE(PG8_SA(1, 0), a3, voffA);
            PG8_BAR; PG8_WAIT_L(0); PG8_MMA(1, 0, At, B0); PG8_BAR; PG8_SCHED;
            PG8_STAGE(PG8_SB(1, 1), b3 + hstep, voffB);
            PG8_WAIT_V(6); PG8_BAR; PG8_MMA(1, 1, At, B1); PG8_BAR;
            }
        }
        if constexpr (ALIGN_EPI) { if (wr == 0) PG8_BAR; }
        if constexpr (!Epi::AFTER_DRAIN) { E(acc, cur, wr, wc, fr, fq); S.done(cur); }
        if (!has_next) break;
#pragma unroll
        for (int a = 0; a < 2; ++a)
#pragma unroll
            for (int b = 0; b < 2; ++b)
#pragma unroll
                for (int m = 0; m < 4; ++m)
#pragma unroll
                    for (int n = 0; n < 2; ++n) acc[a][b][m][n] = (f32x4){0.f, 0.f, 0.f, 0.f};
        cur = nxt; cA = nA; cB = nB; ++ui;
        if constexpr (ALIGN_EPI) { if (wr == 1) PG8_BAR; }
    }
    PG8_WAIT_V(0);
    if constexpr (!ALIGN_EPI) { if (wr == 0) PG8_BAR; }
    PG8_BAR;
    if constexpr (Epi::AFTER_DRAIN) { E.fused(acc, cur, wr, wc, fr, fq, lds, wid, lane); S.done(cur); }
#undef PG8_SA
#undef PG8_SB
#undef PG8_STAGE
#undef PG8_LDA
#undef PG8_LDB
#undef PG8_MMA
#undef PG8_WAIT_V
#undef PG8_WAIT_L
#undef PG8_BAR
#undef PG8_SCHED
}
}

constexpr int NWAVES = 8, NTHREADS = 512;
constexpr int NT = 8192, DM = 2048, SEQ = 2048, NBATCH = 4, DEPTH = 2, CHK = 64, NCHK = 32, GW = 512, NH = 4, HD = 128;
constexpr int DIN = 7200, NINP = 7424, PBW = 7168;
constexpr int NEXP = 16384;
constexpr int PC_GLA_Q = 0, PC_GLA_K = 512, PC_GLA_V = 1024, PC_GLA_G = 1536, PC_LRU_X = 2048, PC_LRU_Y = 2560, PC_ML_Q = 3072, PC_ML_K = 3584, PC_ML_V = 4096, PC_ML_O = 4608,
              PC_GDN_Q = 5120, PC_GDN_K = 5632, PC_GDN_V = 6144, PC_GDN_G = 6656;
constexpr int PS_LR = 0, PS_MI = 16, PS_MF = 20, PS_GB = 24, PS_GA = 28;
constexpr float RMS_EPS = 1e-6f;
enum { I_X = 0, I_N1G, I_WIN, I_WOUT, I_GLA_W2, I_GLA_B2, I_GLA_NG, I_LRU_CW, I_LRU_CB, I_LRU_WA, I_LRU_BA, I_LRU_WX, I_LRU_BX, I_LRU_LAM, I_ML_IB, I_ML_FB, I_ML_NG,
       I_GDN_CW, I_GDN_ALOG, I_GDN_DTB, I_GDN_NG, I_N2G, I_PWQ, I_PK1, I_PK2, I_PU, I_PV, I_FNG, N_IN };

constexpr size_t MiB = 1u << 20;
constexpr size_t WS_CTL = 0, CTL_ZERO_BYTES = 1 * MiB;
constexpr size_t WS_WIN = 2 * MiB;
constexpr size_t WIN_L = (size_t)NINP * DM * 2;
constexpr size_t WS_WOUT = 60 * MiB;
constexpr size_t WS_WQ = 76 * MiB;
constexpr size_t WSQ_L = (size_t)DM * DM * 2;
constexpr size_t WS_K1 = 92 * MiB, WS_K2 = 92 * MiB + 512 * 1024;
constexpr size_t WS_RSTD1 = 93 * MiB;
constexpr size_t WS_SSP = 94 * MiB;
constexpr size_t WS_XB = 96 * MiB;
constexpr size_t WS_P = 128 * MiB;
constexpr size_t WS_PS = 240 * MiB;
constexpr size_t WS_MIX = 242 * MiB;
constexpr size_t WS_Q = 274 * MiB;
constexpr size_t WS_UB = 306 * MiB;
constexpr size_t WS_VB = 434 * MiB;
constexpr size_t TAB_L = (size_t)NEXP * DM * 2;
constexpr size_t WS_SCR = 562 * MiB;
constexpr size_t WS_XQ = 760 * MiB;
constexpr size_t WS_RSQ = 776 * MiB;
constexpr size_t WS_SW = 777 * MiB;
constexpr size_t WS_END = 900 * MiB;

constexpr int LDS_BYTES = 155648;
constexpr int MISC_OFF = LDS_BYTES - 256;

#define GAS __attribute__((address_space(1)))
#define LAS __attribute__((address_space(3)))
typedef unsigned short bf16;
typedef unsigned v4u __attribute__((ext_vector_type(4)));
typedef unsigned v2u __attribute__((ext_vector_type(2)));
typedef float f32x4 __attribute__((ext_vector_type(4)));
typedef float f32x2 __attribute__((ext_vector_type(2)));
typedef short bf16x8 __attribute__((ext_vector_type(8)));
typedef short bf16x4 __attribute__((ext_vector_type(4)));
typedef __bf16 bf2_t __attribute__((ext_vector_type(2)));
typedef GAS unsigned gu32;
#define RLX_AGENT __ATOMIC_RELAXED, __HIP_MEMORY_SCOPE_AGENT
__device__ __forceinline__ unsigned f2bf(float f) { unsigned u = __builtin_bit_cast(unsigned, f); return (u + 0x7fffu + ((u >> 16) & 1u)) >> 16; }
__device__ __forceinline__ unsigned pk2(float lo, float hi) { return f2bf(lo) | (f2bf(hi) << 16); }
__device__ __forceinline__ float bf2f(unsigned b) { return __builtin_bit_cast(float, b << 16); }
__device__ __forceinline__ float bflo(unsigned w) { return __builtin_bit_cast(float, w << 16); }
__device__ __forceinline__ float bfhi(unsigned w) { return __builtin_bit_cast(float, w & 0xffff0000u); }
template <int CTRL> __device__ __forceinline__ unsigned dpp_rot_u(unsigned v) { return (unsigned)__builtin_amdgcn_update_dpp(0, (int)v, CTRL, 0xf, 0xf, false); }
__device__ __forceinline__ unsigned row_max_u(unsigned v) { v = max(v, dpp_rot_u<0x121>(v)); v = max(v, dpp_rot_u<0x122>(v)); v = max(v, dpp_rot_u<0x124>(v)); v = max(v, dpp_rot_u<0x128>(v)); return v; }
template <int CTRL> __device__ __forceinline__ float dpp_rotf(float v) { const unsigned u = __builtin_bit_cast(unsigned, v); return __builtin_bit_cast(float, dpp_rot_u<CTRL>(u)); }
__device__ __forceinline__ float row_max_f(float v) { v = fmaxf(v, dpp_rotf<0x121>(v)); v = fmaxf(v, dpp_rotf<0x122>(v)); v = fmaxf(v, dpp_rotf<0x124>(v)); v = fmaxf(v, dpp_rotf<0x128>(v)); return v; }
__device__ __forceinline__ float row_sum_f(float v) { v += dpp_rotf<0x121>(v); v += dpp_rotf<0x122>(v); v += dpp_rotf<0x124>(v); v += dpp_rotf<0x128>(v); return v; }

__device__ __forceinline__ float oct_sum_f(float v) { v += dpp_rotf<0xB1>(v); v += dpp_rotf<0x4E>(v); v += dpp_rotf<0x141>(v); return v; }
__device__ __forceinline__ float lane_bcast(float v, int l) { return __builtin_bit_cast(float, __builtin_amdgcn_readlane(__builtin_bit_cast(int, v), l)); }
__device__ __forceinline__ float wave_sum(float v) { const float r = row_sum_f(v); return (lane_bcast(r, 0) + lane_bcast(r, 16)) + (lane_bcast(r, 32) + lane_bcast(r, 48)); }
__device__ __forceinline__ float wave_max(float v) { const float r = row_max_f(v); return fmaxf(fmaxf(lane_bcast(r, 0), lane_bcast(r, 16)), fmaxf(lane_bcast(r, 32), lane_bcast(r, 48))); }
__device__ __forceinline__ float rcpf_(float x) { return __builtin_amdgcn_rcpf(x); }
__device__ __forceinline__ float sigmoidf_(float x) { return rcpf_(1.0f + __expf(-x)); }
__device__ __forceinline__ float siluf_(float x) { return x * rcpf_(1.0f + __expf(-x)); }
__device__ __forceinline__ float softplusf_(float x) { return fmaxf(x, 0.f) + __logf(1.0f + __expf(-fabsf(x))); }
__device__ __forceinline__ float logsigmoidf_(float x) { return fminf(x, 0.f) - __logf(1.0f + __expf(-fabsf(x))); }
__device__ __forceinline__ float gelu_tanh(float x) { const float u = 1.5957691216057308f * (x + 0.044715f * x * x * x); return x * rcpf_(1.0f + __expf(-u)); }

#define XB_TMO      128
#define XB_XCNT(j)  (256  + 64 * (j))
#define XB_XSUB(j)  (1280 + 64 * (j))
#define XB_XGEN(j)  (2304 + 64 * (j))
#define XB_TOP      3328
#define XB_TOPGEN   3392
#define XCD_BAR_WORDS 3456
#define XB_SPIN_CAP (1u << 18)

__device__ __forceinline__ unsigned xb_ld(unsigned* p)              { return __hip_atomic_load(p, __ATOMIC_RELAXED, __HIP_MEMORY_SCOPE_AGENT); }
__device__ __forceinline__ unsigned xb_add(unsigned* p, unsigned v) { return __hip_atomic_fetch_add(p, v, __ATOMIC_RELAXED, __HIP_MEMORY_SCOPE_AGENT); }
__device__ __forceinline__ unsigned xb_xcc_id() { return (unsigned)__builtin_amdgcn_s_getreg((3 << 11) | 20) & 0xFu; }
#define XB_SPIN(cond, bar) do { unsigned _sp = 0; while (cond) { __builtin_amdgcn_s_sleep(1); \
    if ((++_sp & 255u) == 0u) { if (xb_ld(&(bar)[XB_TMO])) break; if (_sp > XB_SPIN_CAP) { atomicAdd(&(bar)[XB_TMO], 1u); break; } } } } while (0)

struct XcdBarrier {
    unsigned* bar; unsigned x;
    volatile LAS unsigned* st;
};

__device__ __forceinline__ XcdBarrier xcd_barrier_post(unsigned* bar, volatile LAS unsigned* st) {
    XcdBarrier b; b.bar = bar; b.x = xb_xcc_id(); b.st = st;
    if (threadIdx.x == 0) (void)xb_add(&bar[XB_XCNT(b.x)], 1u);
    return b;
}
__device__ __forceinline__ void xcd_barrier_complete(unsigned* bar, unsigned x, unsigned& nloc, unsigned& nx) {
    const unsigned G = gridDim.x * gridDim.y * gridDim.z;
    unsigned sum, cnt, mine, sp = 0u;
    for (;;) {
        sum = 0u; cnt = 0u; mine = 0u;
#pragma unroll
        for (unsigned j = 0; j < 16; ++j) { const unsigned c = xb_ld(&bar[XB_XCNT(j)]); sum += c; cnt += (c > 0u) ? 1u : 0u; mine = (j == x) ? c : mine; }
        if (sum == G) break;
        __builtin_amdgcn_s_sleep(1);
        if ((++sp & 255u) == 0u) { if (xb_ld(&bar[XB_TMO])) break; if (sp > XB_SPIN_CAP) { atomicAdd(&bar[XB_TMO], 1u); break; } }
    }
    nloc = mine > 0u ? mine : 1u; nx = cnt > 0u ? cnt : 1u;
}

__device__ __forceinline__ void xcd_barrier(const XcdBarrier& b) {
    asm volatile("s_waitcnt vmcnt(0)" ::: "memory");
    __syncthreads();
    if (threadIdx.x == 0) {
        unsigned* bar = b.bar; asm volatile("" : "+s"(bar));
        __builtin_amdgcn_s_waitcnt(0);
        unsigned nloc = b.st[0], nx = b.st[1];
        if (nloc == 0u) { xcd_barrier_complete(bar, b.x, nloc, nx); b.st[0] = nloc; b.st[1] = nx; }
        const unsigned old = xb_add(&bar[XB_XSUB(b.x)], 1u);
        const unsigned gen = old / nloc;
        if (old + 1u == (gen + 1u) * nloc) {
            __builtin_amdgcn_fence(__ATOMIC_RELEASE, "agent");
            asm volatile("s_waitcnt vmcnt(0)" ::: "memory");
            const unsigned og = xb_add(&bar[XB_TOP], 1u);
            const unsigned tg = og / nx;
            if (og + 1u == (tg + 1u) * nx) xb_add(&bar[XB_TOPGEN], 1u);
            else XB_SPIN(xb_ld(&bar[XB_TOPGEN]) == tg, bar);
            __builtin_amdgcn_fence(__ATOMIC_ACQUIRE, "agent");
            xb_add(&bar[XB_XGEN(b.x)], 1u);
            asm volatile("s_waitcnt vmcnt(0)" ::: "memory");
        } else {
            XB_SPIN(xb_ld(&bar[XB_XGEN(b.x)]) == gen, bar);
            __builtin_amdgcn_fence(__ATOMIC_ACQUIRE, "agent");
            asm volatile("s_waitcnt vmcnt(0)" ::: "memory");
        }
    }
    __syncthreads();
}


struct Args { const float* in[N_IN]; float* out; unsigned char* ws; int ph_lo, ph_hi, li, pad; };
typedef const __attribute__((address_space(4))) Args& ArgsR;
__device__ __forceinline__ const __attribute__((address_space(4))) Args* kargs() { unsigned long long p = (unsigned long long)__builtin_amdgcn_kernarg_segment_ptr(); asm volatile("" : "+s"(p)); return (const __attribute__((address_space(4))) Args*)p; }

__device__ __forceinline__ int win_src_col(int n) {
    if (n < 2048) return n;
    if (n < 3072) return 2064 + (n - 2048);
    if (n < 5120) return 3088 + (n - 3072);
    if (n < 7168) return 5144 + (n - 5120);
    if (n < 7184) return 2048 + (n - 7168);
    if (n < 7192) return 5136 + (n - 7184);
    if (n < 7200) return n;
    return -1;
}
template <bool MAP>
__device__ __forceinline__ void p0_transpose_item(const float* W, int K, int Nsrc, int Ndst, const float* gain, bf16* WT, LAS float* scr, int item, int lane) {
    const int nblk = Ndst / 32, kb = item / nblk, nb = item % nblk, k0 = 64 * kb, n0 = 32 * nb;
    const int nn = n0 + (lane & 31); const int src = MAP ? win_src_col(nn) : nn;
    float tv[32];
#pragma unroll
    for (int i = 0; i < 32; ++i) { const int kk = 2 * i + (lane >> 5); tv[i] = (src >= 0) ? __builtin_nontemporal_load((const GAS float*)(W + (size_t)(k0 + kk) * Nsrc + src)) : 0.f; }
#pragma unroll
    for (int i = 0; i < 32; ++i) { const int kk = 2 * i + (lane >> 5); float v = tv[i]; if (gain) v *= gain[k0 + kk]; scr[kk * 33 + (lane & 31)] = v; }
    asm volatile("s_waitcnt lgkmcnt(0)" ::: "memory");
    const int c = lane & 7;
#pragma unroll
    for (int j = 0; j < 4; ++j) { const int n = (lane >> 3) + 8 * j; const LAS float* s = scr + (8 * c) * 33 + n;
        v4u o; o.x = pk2(s[0 * 33], s[1 * 33]); o.y = pk2(s[2 * 33], s[3 * 33]); o.z = pk2(s[4 * 33], s[5 * 33]); o.w = pk2(s[6 * 33], s[7 * 33]);
        *(GAS v4u*)(WT + (size_t)(n0 + n) * K + k0 + 8 * c) = o; }
    asm volatile("s_waitcnt lgkmcnt(0)" ::: "memory");
}
__device__ __forceinline__ void p0_transpose_item_q8(ArgsR A, int l, LAS float* scr, int item, int lane, const LAS float* cml) {
    const float* W = A.in[I_WIN] + (size_t)l * DM * DIN; const float* gain = A.in[I_N1G] + l * DM;
    unsigned char* WT = A.ws + WS_WIN + (size_t)l * WIN_L; float* sw = (float*)(A.ws + WS_SW) + l * NINP;
    const int nblk = NINP / 32, kb = item / nblk, nb = item % nblk, k0 = 64 * kb, n0 = 32 * nb;
    const int nn = n0 + (lane & 31); const int src = win_src_col(nn);
    float tv[32];
#pragma unroll
    for (int i = 0; i < 32; ++i) { const int kk = 2 * i + (lane >> 5); tv[i] = (src >= 0) ? W[(size_t)(k0 + kk) * DIN + src] : 0.f; }
#pragma unroll
    for (int i = 0; i < 32; ++i) { const int kk = 2 * i + (lane >> 5); scr[kk * 33 + (lane & 31)] = tv[i] * gain[k0 + kk]; }
    asm volatile("s_waitcnt lgkmcnt(0)" ::: "memory");
    const int c = lane & 7;
#pragma unroll
    for (int j = 0; j < 4; ++j) { const int n = (lane >> 3) + 8 * j; const LAS float* s = scr + (8 * c) * 33 + n;
        const float cm = cml[n]; const float inv = cm > 0.f ? 127.0f / cm : 0.f;
        unsigned q[8];
#pragma unroll
        for (int e = 0; e < 8; ++e) q[e] = (unsigned)__float2int_rn(s[e * 33] * inv) & 255u;
        v2u o; o.x = q[0] | (q[1] << 8) | (q[2] << 16) | (q[3] << 24); o.y = q[4] | (q[5] << 8) | (q[6] << 16) | (q[7] << 24);
        *(GAS v2u*)(WT + (size_t)(n0 + n) * DM + k0 + 8 * c) = o;
        if (kb == 0 && c == 0) sw[n0 + n] = cm > 0.f ? cm * (1.0f / 127.0f) : 0.f; }
    asm volatile("s_waitcnt lgkmcnt(0)" ::: "memory");
}
__device__ __forceinline__ void p0_win_block(ArgsR A, int l, int nb, LAS unsigned char* lds, int wave, int lane) {
    const float* W = A.in[I_WIN] + (size_t)l * DM * DIN; const float* gain = A.in[I_N1G] + l * DM;
    LAS float* cmx = (LAS float*)(lds + NWAVES * 16384);
    const int src = win_src_col(32 * nb + (lane & 31)); float m = 0.f;
#pragma unroll 1
    for (int k0 = 256 * wave; k0 < 256 * wave + 256; k0 += 32) { float v[16];
#pragma unroll
        for (int i = 0; i < 16; ++i) v[i] = (src >= 0) ? W[(size_t)(k0 + 2 * i + (lane >> 5)) * DIN + src] : 0.f;
#pragma unroll
        for (int i = 0; i < 16; ++i) m = fmaxf(m, fabsf(v[i] * gain[k0 + 2 * i + (lane >> 5)])); }
    { const unsigned mb = __builtin_bit_cast(unsigned, m); const auto sw_ = __builtin_amdgcn_permlane32_swap(mb, mb, false, false); const unsigned m0 = sw_[0], m1 = sw_[1];
      m = fmaxf(__builtin_bit_cast(float, m0), __builtin_bit_cast(float, m1)); }
    __syncthreads();
    if (lane < 32) cmx[wave * 32 + lane] = m;
    __syncthreads();
    if (wave == 0 && lane < 32) { float c = cmx[lane];
#pragma unroll
        for (int w = 1; w < NWAVES; ++w) c = fmaxf(c, cmx[w * 32 + lane]);
        cmx[256 + lane] = c; }
    __syncthreads();
    LAS float* scr = (LAS float*)(lds + wave * 16384);
#pragma unroll 1
    for (int j4 = 0; j4 < 4; ++j4) p0_transpose_item_q8(A, l, scr, (4 * wave + j4) * (NINP / 32) + nb, lane, cmx + 256);
    __syncthreads();
}
__device__ __forceinline__ void p0_convert(const float* src, bf16* dst, size_t n, size_t gtid, size_t gthreads) {
    for (size_t i = gtid * 8; i < n; i += gthreads * 8) {
        const f32x4 a = *(const GAS f32x4*)(src + i), b = *(const GAS f32x4*)(src + i + 4);
        v4u o; o.x = pk2(a[0], a[1]); o.y = pk2(a[2], a[3]); o.z = pk2(b[0], b[1]); o.w = pk2(b[2], b[3]);
        *(GAS v4u*)(dst + i) = o; }
}
__device__ __forceinline__ void p0_weights(ArgsR A, LAS unsigned char* lds, int l_lo, int l_hi, int gw, int NGW, int wave, int lane) {
    unsigned char* ws = A.ws;
    LAS float* scr = (LAS float*)(lds + wave * 16384);
    constexpr int I_IN = (DM / 64) * (NINP / 32), I_SQ = (DM / 64) * (DM / 32), I_LAYER = I_IN + 2 * I_SQ;
#pragma unroll 1
    for (int it = l_lo * I_LAYER + gw; it < l_hi * I_LAYER; it += NGW) {
        const int l = it / I_LAYER; int r = it % I_LAYER;
        if (r < I_IN) continue;        r -= I_IN;
        if (r < I_SQ) { p0_transpose_item<false>(A.in[I_WOUT] + (size_t)l * DM * DM, DM, DM, DM, nullptr, (bf16*)(ws + WS_WOUT + l * WSQ_L), scr, r, lane); continue; } r -= I_SQ;
        p0_transpose_item<false>(A.in[I_PWQ] + (size_t)l * DM * DM, DM, DM, DM, A.in[I_N2G] + l * DM, (bf16*)(ws + WS_WQ + l * WSQ_L), scr, r, lane);
    }
}
__device__ __forceinline__ void p0_convert_keys(const float* src, bf16* dst, size_t gtid, size_t gthreads) {
    const size_t n8 = (size_t)DEPTH * 8 * 128 * 128 / 8;
    for (size_t d = gtid; d < n8; d += gthreads) { const size_t lh = d >> 11; const int w = (int)(d & 2047), nt = w >> 8, ks = (w >> 6) & 3, ln = w & 63;
        const float* sp = src + (lh * 128 + nt * 16 + (ln & 15)) * 128 + 32 * ks + 8 * (ln >> 4);
        const f32x4 a = *(const GAS f32x4*)(sp), b = *(const GAS f32x4*)(sp + 4);
        v4u o; o.x = pk2(a[0], a[1]); o.y = pk2(a[2], a[3]); o.z = pk2(b[0], b[1]); o.w = pk2(b[2], b[3]);
        *(GAS v4u*)(dst + d * 8) = o; }
}
__device__ __forceinline__ void p0_prologue(ArgsR A, LAS unsigned char* lds, int vcu, int G, int wave, int lane) {
    unsigned char* ws = A.ws;
    const int gw = vcu * NWAVES + wave, NGW = G * NWAVES;
    for (int nb = vcu; nb < NINP / 32; nb += G) p0_win_block(A, 0, nb, lds, wave, lane);
    p0_weights(A, lds, 0, 1, gw, NGW, wave, lane);
    const size_t gtid = (size_t)gw * 64 + lane, gthreads = (size_t)NGW * 64;
    p0_convert_keys(A.in[I_PK1], (bf16*)(ws + WS_K1), gtid, gthreads);
    p0_convert_keys(A.in[I_PK2], (bf16*)(ws + WS_K2), gtid, gthreads);
    const float* x = A.in[I_X]; unsigned char* xq = ws + WS_XQ; float* rsq = (float*)(ws + WS_RSQ);
    for (int m = gw; m < NT; m += NGW) {
        const GAS f32x4* xr = (const GAS f32x4*)(x + (size_t)m * DM) + lane;
        f32x4 v[8]; float s = 0.f, am = 0.f;
#pragma unroll
        for (int j = 0; j < 8; ++j) { v[j] = xr[64 * j]; s += (v[j][0] * v[j][0] + v[j][1] * v[j][1]) + (v[j][2] * v[j][2] + v[j][3] * v[j][3]);
            am = fmaxf(fmaxf(am, fmaxf(fabsf(v[j][0]), fabsf(v[j][1]))), fmaxf(fabsf(v[j][2]), fabsf(v[j][3]))); }
        s = wave_sum(s); am = wave_max(am); const float inv = am > 0.f ? 127.0f / am : 0.f;
        GAS unsigned* o = (GAS unsigned*)(xq + (size_t)m * DM) + lane;
#pragma unroll
        for (int j = 0; j < 8; ++j) o[64 * j] = ((unsigned)__float2int_rn(v[j][0] * inv) & 255u) | (((unsigned)__float2int_rn(v[j][1] * inv) & 255u) << 8) | (((unsigned)__float2int_rn(v[j][2] * inv) & 255u) << 16) | (((unsigned)__float2int_rn(v[j][3] * inv) & 255u) << 24);
        if (lane == 0) rsq[m] = rsqrtf(s * (1.0f / DM) + RMS_EPS) * am * (1.0f / 127.0f);
    }
}

constexpr size_t WS_GLA_INC = 562 * MiB;
constexpr size_t WS_GLA_DEC = 594 * MiB;
constexpr size_t WS_GLA_ST = 595 * MiB;
constexpr size_t WS_ML_INC = 611 * MiB;
constexpr size_t WS_ML_N = 643 * MiB;
constexpr size_t WS_ML_SC = 643 * MiB + 512 * 1024;
constexpr size_t WS_ML_ST = 644 * MiB;
constexpr size_t WS_ML_NP = 660 * MiB;
constexpr size_t WS_ML_MP = 660 * MiB + 512 * 1024;
constexpr size_t WS_GDN_U0 = 661 * MiB, WS_GDN_W = 669 * MiB, WS_GDN_QD = 677 * MiB, WS_GDN_KE = 685 * MiB;
constexpr size_t WS_GDN_QK = 693 * MiB;
constexpr size_t WS_GDN_DE = 697 * MiB;
constexpr size_t WS_GDN_O = 698 * MiB;
constexpr size_t WS_LRU_HL = 714 * MiB, WS_LRU_AP = 730 * MiB;
constexpr size_t WS_LRU_CARRY = 746 * MiB;
static_assert(WS_LRU_CARRY + 4 * 32 * 512 * 4 <= WS_END, "ws map");

constexpr int CW_PBAR = 2048;
typedef short v4i16_t __attribute__((ext_vector_type(4)));
constexpr int LD128 = 136, LD64 = 72;

__device__ __forceinline__ bf16x8 frag_rd(const LAS bf16* t, int ld, int row0, int k0, int lane) { return *(const LAS bf16x8*)(t + (row0 + (lane & 15)) * ld + k0 + 8 * (lane >> 4)); }
__device__ __forceinline__ bf16x8 frag_rd_perm(const LAS bf16* t, int ld, int row0, int k0, int lane) {
    const LAS bf16* p = t + (row0 + (lane & 15)) * ld + k0 + 4 * (lane >> 4);
    const bf16x4 a = *(const LAS bf16x4*)p, b = *(const LAS bf16x4*)(p + 16);
    return (bf16x8){a[0], a[1], a[2], a[3], b[0], b[1], b[2], b[3]};
}
__device__ __forceinline__ bf16x8 frag_tr(const LAS bf16* t, int ld, int k0, int n0, int lane) {
    const int i = lane & 15, g = lane >> 4; const LAS bf16* p = t + (k0 + 8 * g + (i >> 2)) * ld + n0 + 4 * (i & 3);
    const v4i16_t a = __builtin_amdgcn_ds_read_tr16_b64_v4i16((LAS v4i16_t*)p), b = __builtin_amdgcn_ds_read_tr16_b64_v4i16((LAS v4i16_t*)(p + 4 * ld));
    return (bf16x8){a[0], a[1], a[2], a[3], b[0], b[1], b[2], b[3]};
}
__device__ __forceinline__ bf16x8 frag_tr_perm(const LAS bf16* t, int ld, int k0, int n0, int lane) {
    const int i = lane & 15, g = lane >> 4; const LAS bf16* p = t + (k0 + 4 * g + (i >> 2)) * ld + n0 + 4 * (i & 3);
    const v4i16_t a = __builtin_amdgcn_ds_read_tr16_b64_v4i16((LAS v4i16_t*)p), b = __builtin_amdgcn_ds_read_tr16_b64_v4i16((LAS v4i16_t*)(p + 16 * ld));
    return (bf16x8){a[0], a[1], a[2], a[3], b[0], b[1], b[2], b[3]};
}
__device__ __forceinline__ bf16x8 pack_acc(const f32x4& lo, const f32x4& hi) {
    v4u w; w.x = pg8::cvt_pk_bf16(lo[0], lo[1]); w.y = pg8::cvt_pk_bf16(lo[2], lo[3]); w.z = pg8::cvt_pk_bf16(hi[0], hi[1]); w.w = pg8::cvt_pk_bf16(hi[2], hi[3]);
    return __builtin_bit_cast(bf16x8, w);
}
#define MFMA16(a, b, c) __builtin_amdgcn_mfma_f32_16x16x32_bf16((a), (b), (c), 0, 0, 0)

template <int ROWS, bool NT = false>
__device__ __forceinline__ void tile_g2l_128(const bf16* g, size_t gld, LAS bf16* t, int tid) {
#pragma unroll
    for (int i = 0; i < ROWS * 16 / NTHREADS; ++i) { const int idx = tid + i * NTHREADS, r = idx >> 4, c8 = (idx & 15) * 8;
        *(LAS v4u*)(t + r * LD128 + c8) = NT ? __builtin_nontemporal_load((const GAS v4u*)(g + (size_t)r * gld + c8)) : *(const GAS v4u*)(g + (size_t)r * gld + c8); }
}
template <int CTRL> __device__ __forceinline__ float dpp_shr_f(float v, float ident) { return __builtin_bit_cast(float, __builtin_amdgcn_update_dpp(__builtin_bit_cast(int, ident), __builtin_bit_cast(int, v), CTRL, 0xf, 0xf, false)); }
__device__ __forceinline__ float wave_scan_add(float v, int lane) {
    v += dpp_shr_f<0x111>(v, 0.f); v += dpp_shr_f<0x112>(v, 0.f); v += dpp_shr_f<0x114>(v, 0.f); v += dpp_shr_f<0x118>(v, 0.f);
    const float t0 = lane_bcast(v, 15), t1 = lane_bcast(v, 31), t2 = lane_bcast(v, 47); const int row = lane >> 4;
    return v + (row == 0 ? 0.f : row == 1 ? t0 : row == 2 ? t0 + t1 : (t0 + t1) + t2);
}
__device__ __forceinline__ float wave_scan_max(float v, int lane) {
    const float ninf = -__builtin_inff();
    v = fmaxf(v, dpp_shr_f<0x111>(v, ninf)); v = fmaxf(v, dpp_shr_f<0x112>(v, ninf)); v = fmaxf(v, dpp_shr_f<0x114>(v, ninf)); v = fmaxf(v, dpp_shr_f<0x118>(v, ninf));
    const float t0 = lane_bcast(v, 15), t1 = lane_bcast(v, 31), t2 = lane_bcast(v, 47); const int row = lane >> 4;
    return fmaxf(v, row == 0 ? ninf : row == 1 ? t0 : row == 2 ? fmaxf(t0, t1) : fmaxf(fmaxf(t0, t1), t2));
}

__device__ __forceinline__ void f_lru_p2(ArgsR A, int l, int item, LAS unsigned char* lds, int tid) {
    const int j = item & 7, n = (item >> 3) & 31, b = item >> 8;
    const bf16* P = (const bf16*)(A.ws + WS_P); float* HLg = (float*)(A.ws + WS_LRU_HL); float* APg = (float*)(A.ws + WS_LRU_AP);
    LAS float* xc = (LAS float*)(lds); LAS bf16* wab = (LAS bf16*)(lds + 20480); LAS bf16* xcb = (LAS bf16*)(lds + 29696); LAS bf16* wxb = (LAS bf16*)(lds + 38912);
    LAS float* aa = (LAS float*)(lds + 53248); LAS float* uu = (LAS float*)(lds + 69632); LAS float* segA = (LAS float*)(lds + 86016); LAS float* segH = (LAS float*)(lds + 88064);
    const float* wa = A.in[I_LRU_WA] + ((size_t)l * 8 + j) * 4096; const float* wx = A.in[I_LRU_WX] + ((size_t)l * 8 + j) * 4096;
    { const int k = tid >> 3, n8 = (tid & 7) * 8;
        const f32x4 a0 = *(const GAS f32x4*)(wa + k * 64 + n8), a1 = *(const GAS f32x4*)(wa + k * 64 + n8 + 4), x0 = *(const GAS f32x4*)(wx + k * 64 + n8), x1 = *(const GAS f32x4*)(wx + k * 64 + n8 + 4);
        v4u wv; wv.x = pk2(a0[0], a0[1]); wv.y = pk2(a0[2], a0[3]); wv.z = pk2(a1[0], a1[1]); wv.w = pk2(a1[2], a1[3]); *(LAS v4u*)(wab + k * LD64 + n8) = wv;
        wv.x = pk2(x0[0], x0[1]); wv.y = pk2(x0[2], x0[3]); wv.z = pk2(x1[0], x1[1]); wv.w = pk2(x1[2], x1[3]); *(LAS v4u*)(wxb + k * LD64 + n8) = wv; }
    const float* cw = A.in[I_LRU_CW] + (size_t)l * 4 * GW; const float* cb = A.in[I_LRU_CB] + l * GW;
    const size_t r0 = (size_t)b * SEQ + n * CHK;
    const int lane = tid & 63, wave = __builtin_amdgcn_readfirstlane(tid >> 6), fr = lane & 15, fq = lane >> 4, nt = wave & 3, mh = wave >> 2;
    const int chl = 16 * nt + fr;
    const float ba1 = A.in[I_LRU_BA][l * GW + j * 64 + chl], bx1 = A.in[I_LRU_BX][l * GW + j * 64 + chl], lam1 = A.in[I_LRU_LAM][l * GW + j * 64 + chl];
    { const int cc = tid & 63, c0 = (tid >> 6) * 8, ch = j * 64 + cc, pc = PC_LRU_X + ch; const long t0 = (long)n * CHK + c0;
        const float w0 = cw[ch], w1 = cw[GW + ch], w2 = cw[2 * GW + ch], w3 = cw[3 * GW + ch], bias = cb[ch];
        float xm3 = (t0 - 3 >= 0) ? bf2f(P[(r0 + c0 - 3) * PBW + pc]) : 0.f, xm2 = (t0 - 2 >= 0) ? bf2f(P[(r0 + c0 - 2) * PBW + pc]) : 0.f, xm1 = (t0 - 1 >= 0) ? bf2f(P[(r0 + c0 - 1) * PBW + pc]) : 0.f;
#pragma unroll
        for (int i = 0; i < 8; ++i) { const float x0 = bf2f(P[(r0 + c0 + i) * PBW + pc]); const float cv = w0 * xm3 + w1 * xm2 + w2 * xm1 + w3 * x0 + bias;
            xc[(c0 + i) * 65 + cc] = cv; xcb[(c0 + i) * LD64 + cc] = (bf16)f2bf(cv); xm3 = xm2; xm2 = xm1; xm1 = x0; } }
    __syncthreads();
    { f32x4 ra[2], ri[2];
#pragma unroll
        for (int m = 0; m < 2; ++m) { ra[m] = (f32x4){ba1, ba1, ba1, ba1}; ri[m] = (f32x4){bx1, bx1, bx1, bx1}; }
#pragma unroll
        for (int kk = 0; kk < 2; ++kk) { const bf16x8 fa = frag_tr(wab, LD64, 32 * kk, 16 * nt, lane), fx = frag_tr(wxb, LD64, 32 * kk, 16 * nt, lane);
#pragma unroll
            for (int m = 0; m < 2; ++m) { const bf16x8 xa = frag_rd(xcb, LD64, 16 * (2 * mh + m), 32 * kk, lane); ra[m] = MFMA16(xa, fa, ra[m]); ri[m] = MFMA16(xa, fx, ri[m]); } }
        const float spl = softplusf_(-lam1);
#pragma unroll
        for (int m = 0; m < 2; ++m)
#pragma unroll
            for (int r = 0; r < 4; ++r) { const int tok = 16 * (2 * mh + m) + 4 * fq + r; const float rg = sigmoidf_(ra[m][r]), ig = sigmoidf_(ri[m][r]);
                const float log_a = -8.0f * rg * spl; const float a = __expf(log_a), u = sqrtf(fmaxf(1.0f - a * a, 0.f)) * (ig * xc[tok * 65 + chl]);
                aa[tok * 64 + chl] = a; uu[tok * 64 + chl] = u; } }
    __syncthreads();
    const int cc = tid & 63, seg = tid >> 6;
    { float Ap = 1.f, Hl = 0.f;
#pragma unroll
        for (int i = 0; i < 8; ++i) { const int c = seg * 8 + i; const float a = aa[c * 64 + cc], u = uu[c * 64 + cc]; Hl = a * Hl + u; Ap *= a; aa[c * 64 + cc] = Ap; uu[c * 64 + cc] = Hl; }
        segA[seg * 64 + cc] = Ap; segH[seg * 64 + cc] = Hl; }
    __syncthreads();
    { float Ac = 1.f, Hc = 0.f;
#pragma unroll 1
        for (int s = 0; s < seg; ++s) { const float sa = segA[s * 64 + cc]; Hc = sa * Hc + segH[s * 64 + cc]; Ac *= sa; }
#pragma unroll
        for (int i = 0; i < 8; ++i) { const int c = seg * 8 + i; const float ap = aa[c * 64 + cc], hl = uu[c * 64 + cc];
            HLg[(r0 + c) * GW + j * 64 + cc] = ap * Hc + hl; APg[(r0 + c) * GW + j * 64 + cc] = ap * Ac; } }
    __syncthreads();
}
__device__ __forceinline__ void f_lru_p3(ArgsR A, int b, int tid) {
    const float* HLg = (const float*)(A.ws + WS_LRU_HL); const float* APg = (const float*)(A.ws + WS_LRU_AP); float* carry = (float*)(A.ws + WS_LRU_CARRY);
    float c = 0.f;
#pragma unroll 1
    for (int n0 = 0; n0 < NCHK; n0 += 16) { float ap[16], hl[16];
#pragma unroll
        for (int i = 0; i < 16; ++i) { const size_t t = (size_t)b * SEQ + (n0 + i) * CHK + 63; ap[i] = APg[t * GW + tid]; hl[i] = HLg[t * GW + tid]; }
#pragma unroll
        for (int i = 0; i < 16; ++i) { carry[((size_t)b * NCHK + n0 + i) * GW + tid] = c; c = ap[i] * c + hl[i]; } }
}
__device__ __forceinline__ void f_lru_p4(ArgsR A, int row0, int row1, int tid) {
    const bf16* P = (const bf16*)(A.ws + WS_P); bf16* mix = (bf16*)(A.ws + WS_MIX);
    const float* HLg = (const float*)(A.ws + WS_LRU_HL); const float* APg = (const float*)(A.ws + WS_LRU_AP); const float* carry = (const float*)(A.ws + WS_LRU_CARRY);
#pragma unroll 1
    for (int rb = row0; rb < row1; rb += 12) { float cr[12], ap[12], hl[12]; unsigned short yv[12];
#pragma unroll
        for (int i = 0; i < 12; ++i) { const int r = min(rb + i, row1 - 1); cr[i] = carry[(size_t)(r >> 6) * GW + tid]; ap[i] = __builtin_nontemporal_load((const GAS float*)(APg + (size_t)r * GW + tid)); hl[i] = __builtin_nontemporal_load((const GAS float*)(HLg + (size_t)r * GW + tid)); yv[i] = __builtin_nontemporal_load((const GAS unsigned short*)(P + (size_t)r * PBW + PC_LRU_Y + tid)); }
#pragma unroll
        for (int i = 0; i < 12; ++i) if (rb + i < row1) mix[(size_t)(rb + i) * DM + 512 + tid] = (bf16)f2bf(gelu_tanh(bf2f(yv[i])) * (ap[i] * cr[i] + hl[i])); }
}

constexpr int FL_Q = 0, FL_K = 17408, FL_V = 34816, FL_ST = 52224, FL_SC = 87040, FL_BC = 96256, FL_LR = 129024, FL_SEG = 133120, FL_RS = 135168;
struct GlaW2 { float w[16]; float b2; };
__device__ __forceinline__ void gla_w2_load(ArgsR A, int l, int h, int tid, GlaW2& W) {
    const int d = tid & 127; const float* w2 = A.in[I_GLA_W2] + (size_t)l * 16 * GW + h * HD + d;
#pragma unroll
    for (int r = 0; r < 16; ++r) W.w[r] = w2[r * GW];
    W.b2 = A.in[I_GLA_B2][l * GW + h * HD + d];
}
__device__ __forceinline__ void gla_bcum(const GlaW2& W, LAS float* bc, LAS float* segt, const LAS float* lrs, int tid) {
    const int d = tid & 127, seg = tid >> 7; float run = 0.f;
#pragma unroll 4
    for (int i = 0; i < 16; ++i) { const int c = seg * 16 + i; float z = W.b2;
#pragma unroll
        for (int r = 0; r < 16; ++r) z += lrs[c * 16 + r] * W.w[r];
        run += logsigmoidf_(z) * (1.0f / 16.0f); bc[c * 128 + d] = run; }
    segt[seg * 128 + d] = run;
}
__device__ __forceinline__ void f_gla_p2(ArgsR A, int l, int item, LAS unsigned char* lds, int tid) {
    const int n = item & 31, h = (item >> 5) & 3, b = item >> 7; const int lane = tid & 63, wave = __builtin_amdgcn_readfirstlane(tid >> 6);
    const bf16* P = (const bf16*)(A.ws + WS_P); const float* Ps = (const float*)(A.ws + WS_PS);
    bf16* inc = (bf16*)(A.ws + WS_GLA_INC) + (size_t)item * 16384; float* dec = (float*)(A.ws + WS_GLA_DEC) + (size_t)item * 128;
    LAS bf16* ks = (LAS bf16*)(lds + FL_K); LAS bf16* vs = (LAS bf16*)(lds + FL_V); LAS float* bc = (LAS float*)(lds + FL_BC); LAS float* lrs = (LAS float*)(lds + FL_LR); LAS float* segt = (LAS float*)(lds + FL_SEG);
    const size_t r0 = (size_t)b * SEQ + n * CHK;
    GlaW2 W2; gla_w2_load(A, l, h, tid, W2);
    tile_g2l_128<64>(P + r0 * PBW + PC_GLA_K + h * HD, PBW, ks, tid);
    tile_g2l_128<64>(P + r0 * PBW + PC_GLA_V + h * HD, PBW, vs, tid);
    for (int i = tid; i < 64 * 16; i += NTHREADS) lrs[i] = Ps[(r0 + (i >> 4)) * 32 + PS_LR + (i & 15)];
    __syncthreads();
    gla_bcum(W2, bc, segt, lrs, tid);
    __syncthreads();
    { const int d = tid & 127, seg = tid >> 7; float pre = 0.f, tot = 0.f;
#pragma unroll
        for (int s = 0; s < 4; ++s) { const float v = segt[s * 128 + d]; if (s < seg) pre += v; tot += v; }
#pragma unroll 4
        for (int i = 0; i < 16; ++i) { const int c = seg * 16 + i; const float bcm = bc[c * 128 + d] + pre; ks[c * LD128 + d] = (bf16)f2bf(bf2f(ks[c * LD128 + d]) * __expf(tot - bcm)); }
        if (seg == 0) dec[d] = __expf(tot); }
    __syncthreads();
    { f32x4 acc[8];
#pragma unroll
        for (int nt = 0; nt < 8; ++nt) acc[nt] = (f32x4){0.f, 0.f, 0.f, 0.f};
#pragma unroll
        for (int kk = 0; kk < 2; ++kk) { const bf16x8 af = frag_tr(vs, LD128, 32 * kk, 16 * wave, lane);
#pragma unroll
            for (int nt = 0; nt < 8; ++nt) acc[nt] = MFMA16(af, frag_tr(ks, LD128, 32 * kk, 16 * nt, lane), acc[nt]); }
        const int fr = lane & 15, fq = lane >> 4;
#pragma unroll
        for (int nt = 0; nt < 8; ++nt)
#pragma unroll
            for (int r = 0; r < 4; ++r) { const float o_ = acc[nt][r], nb_ = dpp_rotf<0xB1>(o_);
                if (!(fr & 1)) *(GAS unsigned*)(inc + (16 * wave + 4 * fq + r) * 128 + 16 * nt + fr) = pk2(o_, nb_); } }
    __syncthreads();
}
__device__ __forceinline__ void f_gla_p3(ArgsR A, int item, int tid) {
    const int bh = item >> 4, sl = item & 15; const int e = sl * 1024 + tid * 2, d = e & 127;
    const bf16* inc = (const bf16*)(A.ws + WS_GLA_INC) + (size_t)bh * 32 * 16384 + e; const float* dec = (const float*)(A.ws + WS_GLA_DEC) + (size_t)bh * 32 * 128 + d;
    bf16* st = (bf16*)(A.ws + WS_GLA_ST) + (size_t)bh * 32 * 16384 + e;
    float s0 = 0.f, s1 = 0.f;
#pragma unroll 1
    for (int n0 = 0; n0 < NCHK; n0 += 16) { unsigned iw[16]; f32x2 dv[16];
#pragma unroll
        for (int i = 0; i < 16; ++i) { iw[i] = __builtin_nontemporal_load((const GAS unsigned*)(inc + (size_t)(n0 + i) * 16384)); dv[i] = *(const GAS f32x2*)(dec + (size_t)(n0 + i) * 128); }
#pragma unroll
        for (int i = 0; i < 16; ++i) { *(GAS unsigned*)(st + (size_t)(n0 + i) * 16384) = pk2(s0, s1); s0 = dv[i][0] * s0 + bflo(iw[i]); s1 = dv[i][1] * s1 + bfhi(iw[i]); } }
}
__device__ __forceinline__ void f_gla_p4(ArgsR A, int l, int item, LAS unsigned char* lds, int tid) {
    const int n = item & 31, h = (item >> 5) & 3, b = item >> 7; const int lane = tid & 63, wave = __builtin_amdgcn_readfirstlane(tid >> 6), fr = lane & 15, fq = lane >> 4;
    const bf16* P = (const bf16*)(A.ws + WS_P); const float* Ps = (const float*)(A.ws + WS_PS); bf16* mix = (bf16*)(A.ws + WS_MIX);
    const bf16* stg = (const bf16*)(A.ws + WS_GLA_ST) + (size_t)item * 16384;
    LAS bf16* qs = (LAS bf16*)(lds + FL_Q); LAS bf16* ks = (LAS bf16*)(lds + FL_K); LAS bf16* vs = (LAS bf16*)(lds + FL_V); LAS bf16* sts = (LAS bf16*)(lds + FL_ST); LAS bf16* scs = (LAS bf16*)(lds + FL_SC);
    LAS float* bc = (LAS float*)(lds + FL_BC); LAS float* lrs = (LAS float*)(lds + FL_LR); LAS float* segt = (LAS float*)(lds + FL_SEG); LAS float* rsp = (LAS float*)(lds + FL_RS);
    const size_t r0 = (size_t)b * SEQ + n * CHK;
    GlaW2 W2; gla_w2_load(A, l, h, tid, W2);
    const float gn = A.in[I_GLA_NG][l * GW + h * HD + 16 * wave + fr];
    float gt[4][4];
#pragma unroll
    for (int mt = 0; mt < 4; ++mt)
#pragma unroll
        for (int r = 0; r < 4; ++r) gt[mt][r] = bf2f(P[(r0 + 16 * mt + 4 * fq + r) * PBW + PC_GLA_G + h * HD + 16 * wave + fr]);
    tile_g2l_128<64, true>(P + r0 * PBW + PC_GLA_Q + h * HD, PBW, qs, tid);
    tile_g2l_128<64, true>(P + r0 * PBW + PC_GLA_K + h * HD, PBW, ks, tid);
    tile_g2l_128<64, true>(P + r0 * PBW + PC_GLA_V + h * HD, PBW, vs, tid);
    tile_g2l_128<128, true>(stg, 128, sts, tid);
    for (int i = tid; i < 64 * 16; i += NTHREADS) lrs[i] = Ps[(r0 + (i >> 4)) * 32 + PS_LR + (i & 15)];
    __syncthreads();
    gla_bcum(W2, bc, segt, lrs, tid);
    __syncthreads();
    { const int d = tid & 127, seg = tid >> 7; float pre = 0.f;
#pragma unroll
        for (int s = 0; s < 4; ++s) { const float v = segt[s * 128 + d]; if (s < seg) pre += v; }
#pragma unroll 4
        for (int i = 0; i < 16; ++i) { const int c = seg * 16 + i; const float bcm = bc[c * 128 + d] + pre;
            qs[c * LD128 + d] = (bf16)f2bf(bf2f(qs[c * LD128 + d]) * __expf(bcm) * 0.08838834764831845f); ks[c * LD128 + d] = (bf16)f2bf(bf2f(ks[c * LD128 + d]) * __expf(-bcm)); } }
    __syncthreads();
    { const int mt = wave >> 1; f32x4 acc[2] = {{0.f, 0.f, 0.f, 0.f}, {0.f, 0.f, 0.f, 0.f}};
#pragma unroll
        for (int kk = 0; kk < 4; ++kk) { const bf16x8 af = frag_rd(qs, LD128, 16 * mt, 32 * kk, lane);
#pragma unroll
            for (int q = 0; q < 2; ++q) acc[q] = MFMA16(af, frag_rd(ks, LD128, 16 * (2 * (wave & 1) + q), 32 * kk, lane), acc[q]); }
#pragma unroll
        for (int q = 0; q < 2; ++q) { const int s = 16 * (2 * (wave & 1) + q) + fr;
#pragma unroll
            for (int r = 0; r < 4; ++r) { const int c = 16 * mt + 4 * fq + r; scs[c * LD64 + s] = (bf16)f2bf(s <= c ? acc[q][r] : 0.f); } } }
    __syncthreads();
    f32x4 o[4];
#pragma unroll
    for (int mt = 0; mt < 4; ++mt) o[mt] = (f32x4){0.f, 0.f, 0.f, 0.f};
#pragma unroll
    for (int kk = 0; kk < 2; ++kk) { const bf16x8 bfv = frag_tr(vs, LD128, 32 * kk, 16 * wave, lane);
#pragma unroll
        for (int mt = 0; mt < 4; ++mt) o[mt] = MFMA16(frag_rd(scs, LD64, 16 * mt, 32 * kk, lane), bfv, o[mt]); }
#pragma unroll
    for (int kk = 0; kk < 4; ++kk) { const bf16x8 bfs = frag_rd(sts, LD128, 16 * wave, 32 * kk, lane);
#pragma unroll
        for (int mt = 0; mt < 4; ++mt) o[mt] = MFMA16(frag_rd(qs, LD128, 16 * mt, 32 * kk, lane), bfs, o[mt]); }
#pragma unroll
    for (int mt = 0; mt < 4; ++mt)
#pragma unroll
        for (int r = 0; r < 4; ++r) { float s = o[mt][r] * o[mt][r]; s = row_sum_f(s);
            if (fr == 0) rsp[wave * 64 + 16 * mt + 4 * fq + r] = s; }
    __syncthreads();
#pragma unroll
    for (int mt = 0; mt < 4; ++mt)
#pragma unroll
        for (int r = 0; r < 4; ++r) { const int c = 16 * mt + 4 * fq + r; float ss = 0.f;
#pragma unroll
            for (int w = 0; w < 8; ++w) ss += rsp[w * 64 + c];
            const float rs = rsqrtf(ss * (1.0f / 128.0f) + RMS_EPS);
            mix[(r0 + c) * DM + h * HD + 16 * wave + fr] = (bf16)f2bf(o[mt][r] * rs * gn * siluf_(gt[mt][r])); }
    __syncthreads();
}

constexpr int FM_Q2 = 96256, FM_S = 129024;
__device__ __forceinline__ void f_ml_p2(ArgsR A, int l, int item, LAS unsigned char* lds, int tid) {
    const int n = item & 31, h = (item >> 5) & 3, b = item >> 7; const int lane = tid & 63, wave = __builtin_amdgcn_readfirstlane(tid >> 6);
    const bf16* P = (const bf16*)(A.ws + WS_P); const float* Ps = (const float*)(A.ws + WS_PS);
    bf16* inc = (bf16*)(A.ws + WS_ML_INC) + (size_t)item * 16384; float* incn = (float*)(A.ws + WS_ML_N) + (size_t)item * 128; float* scg = (float*)(A.ws + WS_ML_SC) + (size_t)item * 2;
    LAS bf16* ks = (LAS bf16*)(lds + FL_K); LAS bf16* vs = (LAS bf16*)(lds + FL_V); LAS float* sc = (LAS float*)(lds + FM_S);
    const size_t r0 = (size_t)b * SEQ + n * CHK;
    tile_g2l_128<64>(P + r0 * PBW + PC_ML_K + h * HD, PBW, ks, tid);
    tile_g2l_128<64>(P + r0 * PBW + PC_ML_V + h * HD, PBW, vs, tid);
    if (wave == 0) { const float lf = logsigmoidf_(Ps[(r0 + lane) * 32 + PS_MF + h] + A.in[I_ML_FB][l * NH + h]), ig = Ps[(r0 + lane) * 32 + PS_MI + h] + A.in[I_ML_IB][l * NH + h];
        const float bcum = wave_scan_add(lf, lane), blast = lane_bcast(bcum, 63), le = blast - bcum + ig, mloc = wave_max(le);
        sc[lane] = __expf(le - mloc) * 0.08838834764831845f; if (lane == 0) { scg[0] = mloc; scg[1] = blast; } }
    __syncthreads();
#pragma unroll
    for (int i = 0; i < 2; ++i) { const int idx = tid + i * NTHREADS, r = idx >> 4, c8 = (idx & 15) * 8; const float w = sc[r];
        v4u x = *(LAS v4u*)(ks + r * LD128 + c8);
        x.x = pk2(bflo(x.x) * w, bfhi(x.x) * w); x.y = pk2(bflo(x.y) * w, bfhi(x.y) * w); x.z = pk2(bflo(x.z) * w, bfhi(x.z) * w); x.w = pk2(bflo(x.w) * w, bfhi(x.w) * w);
        *(LAS v4u*)(ks + r * LD128 + c8) = x; }
    __syncthreads();
    if (tid < 128) { float s = 0.f;
#pragma unroll 8
        for (int c = 0; c < 64; ++c) s += bf2f(ks[c * LD128 + tid]);
        incn[tid] = s; }
    { f32x4 acc[8];
#pragma unroll
        for (int nt = 0; nt < 8; ++nt) acc[nt] = (f32x4){0.f, 0.f, 0.f, 0.f};
#pragma unroll
        for (int kk = 0; kk < 2; ++kk) { const bf16x8 af = frag_tr(vs, LD128, 32 * kk, 16 * wave, lane);
#pragma unroll
            for (int nt = 0; nt < 8; ++nt) acc[nt] = MFMA16(af, frag_tr(ks, LD128, 32 * kk, 16 * nt, lane), acc[nt]); }
        const int fr = lane & 15, fq = lane >> 4;
#pragma unroll
        for (int nt = 0; nt < 8; ++nt)
#pragma unroll
            for (int r = 0; r < 4; ++r) { const float o_ = acc[nt][r], nb_ = dpp_rotf<0xB1>(o_);
                if (!(fr & 1)) *(GAS unsigned*)(inc + (16 * wave + 4 * fq + r) * 128 + 16 * nt + fr) = pk2(o_, nb_); } }
    __syncthreads();
}
__device__ __forceinline__ void f_ml_p3(ArgsR A, int item, int tid) {
    const int bh = item >> 4, sl = item & 15; const int e = sl * 1024 + tid * 2;
    const bf16* inc = (const bf16*)(A.ws + WS_ML_INC) + (size_t)bh * 32 * 16384 + e; const float* incn = (const float*)(A.ws + WS_ML_N) + (size_t)bh * 32 * 128;
    const float* scg = (const float*)(A.ws + WS_ML_SC) + (size_t)bh * 32 * 2;
    bf16* st = (bf16*)(A.ws + WS_ML_ST) + (size_t)bh * 32 * 16384 + e; float* np = (float*)(A.ws + WS_ML_NP) + (size_t)bh * 32 * 128; float* mp = (float*)(A.ws + WS_ML_MP) + (size_t)bh * 32;
    float c0 = 0.f, c1 = 0.f, nv = 0.f, m = 0.f; const int dn = sl * 8 + tid;
#pragma unroll 1
    for (int n0 = 0; n0 < NCHK; n0 += 16) { unsigned iw[16]; f32x2 sg[16]; float nn[16];
#pragma unroll
        for (int i = 0; i < 16; ++i) { iw[i] = __builtin_nontemporal_load((const GAS unsigned*)(inc + (size_t)(n0 + i) * 16384)); sg[i] = *(const GAS f32x2*)(scg + 2 * (n0 + i)); nn[i] = (tid < 8) ? incn[(n0 + i) * 128 + dn] : 0.f; }
#pragma unroll
        for (int i = 0; i < 16; ++i) { const int n = n0 + i;
            *(GAS unsigned*)(st + (size_t)n * 16384) = pk2(c0, c1);
            if (tid < 8) np[n * 128 + dn] = nv;
            if (sl == 0 && tid == 0) mp[n] = m;
            const float ml = sg[i][0], bl = sg[i][1]; const float mn = fmaxf(bl + m, ml), ao = __expf(bl + m - mn), ai = __expf(ml - mn);
            c0 = ao * c0 + ai * bflo(iw[i]); c1 = ao * c1 + ai * bfhi(iw[i]);
            nv = ao * nv + ai * nn[i];
            m = mn; } }
}
__device__ __forceinline__ void f_ml_p4(ArgsR A, int l, int item, LAS unsigned char* lds, int tid) {
    const int n = item & 31, h = (item >> 5) & 3, b = item >> 7; const int lane = tid & 63, wave = __builtin_amdgcn_readfirstlane(tid >> 6), fr = lane & 15, fq = lane >> 4;
    const bf16* P = (const bf16*)(A.ws + WS_P); const float* Ps = (const float*)(A.ws + WS_PS); bf16* mix = (bf16*)(A.ws + WS_MIX);
    const bf16* stg = (const bf16*)(A.ws + WS_ML_ST) + (size_t)item * 16384; const float* npg = (const float*)(A.ws + WS_ML_NP) + (size_t)item * 128; const float mprev = ((const float*)(A.ws + WS_ML_MP))[item];
    LAS bf16* qs = (LAS bf16*)(lds + FL_Q); LAS bf16* ks = (LAS bf16*)(lds + FL_K); LAS bf16* vs = (LAS bf16*)(lds + FL_V); LAS bf16* sts = (LAS bf16*)(lds + FL_ST); LAS bf16* scs = (LAS bf16*)(lds + FL_SC);
    LAS bf16* q2 = (LAS bf16*)(lds + FM_Q2); LAS float* sc = (LAS float*)(lds + FM_S); LAS float* rsp = (LAS float*)(lds + FL_RS + 4096);
    const size_t r0 = (size_t)b * SEQ + n * CHK;
    const float gn = A.in[I_ML_NG][l * GW + h * HD + 16 * wave + fr];
    float ogt[4][4];
#pragma unroll
    for (int mt = 0; mt < 4; ++mt)
#pragma unroll
        for (int r = 0; r < 4; ++r) ogt[mt][r] = bf2f(P[(r0 + 16 * mt + 4 * fq + r) * PBW + PC_ML_O + h * HD + 16 * wave + fr]);
    tile_g2l_128<64, true>(P + r0 * PBW + PC_ML_Q + h * HD, PBW, qs, tid);
    tile_g2l_128<64, true>(P + r0 * PBW + PC_ML_K + h * HD, PBW, ks, tid);
    tile_g2l_128<64, true>(P + r0 * PBW + PC_ML_V + h * HD, PBW, vs, tid);
    tile_g2l_128<128, true>(stg, 128, sts, tid);
    if (wave == 0) { const float lf = logsigmoidf_(Ps[(r0 + lane) * 32 + PS_MF + h] + A.in[I_ML_FB][l * NH + h]), ig = Ps[(r0 + lane) * 32 + PS_MI + h] + A.in[I_ML_IB][l * NH + h];
        const float bcum = wave_scan_add(lf, lane), as = ig - bcum, pm = wave_scan_max(as, lane);
        const float mintra = bcum + pm, minter = bcum + mprev, mt = fmaxf(mintra, minter);
        sc[lane] = bcum - mt; sc[64 + lane] = as; sc[128 + lane] = __expf(minter - mt); sc[192 + lane] = __expf(-mt); }
    if (wave == 1) { sc[320 + lane] = npg[lane]; sc[384 + lane] = npg[64 + lane]; }
    __syncthreads();
#pragma unroll
    for (int i = 0; i < 2; ++i) { const int idx = tid + i * NTHREADS, r = idx >> 4, c8 = (idx & 15) * 8; const float w = sc[128 + r];
        v4u x = *(LAS v4u*)(qs + r * LD128 + c8);
        x.x = pk2(bflo(x.x) * w, bfhi(x.x) * w); x.y = pk2(bflo(x.y) * w, bfhi(x.y) * w); x.z = pk2(bflo(x.z) * w, bfhi(x.z) * w); x.w = pk2(bflo(x.w) * w, bfhi(x.w) * w);
        *(LAS v4u*)(q2 + r * LD128 + c8) = x; }
    { const int mt = wave >> 1; f32x4 acc[2] = {{0.f, 0.f, 0.f, 0.f}, {0.f, 0.f, 0.f, 0.f}};
#pragma unroll
        for (int kk = 0; kk < 4; ++kk) { const bf16x8 af = frag_rd(qs, LD128, 16 * mt, 32 * kk, lane);
#pragma unroll
            for (int q = 0; q < 2; ++q) acc[q] = MFMA16(af, frag_rd(ks, LD128, 16 * (2 * (wave & 1) + q), 32 * kk, lane), acc[q]); }
#pragma unroll
        for (int q = 0; q < 2; ++q) { const int s = 16 * (2 * (wave & 1) + q) + fr; const float asv = sc[64 + s];
#pragma unroll
            for (int r = 0; r < 4; ++r) { const int c = 16 * mt + 4 * fq + r; scs[c * LD64 + s] = (bf16)f2bf(s <= c ? acc[q][r] * 0.08838834764831845f * __expf(sc[c] + asv) : 0.f); } } }
    __syncthreads();
    { const int c = tid >> 3, part = tid & 7; float s = 0.f;
#pragma unroll
        for (int i = 0; i < 8; ++i) s += bf2f(scs[c * LD64 + part * 8 + i]);
#pragma unroll
        for (int i = 0; i < 16; ++i) s += bf2f(q2[c * LD128 + part * 16 + i]) * sc[320 + part * 16 + i];
        s = oct_sum_f(s);
        if (part == 0) sc[256 + c] = fmaxf(fabsf(s), sc[192 + c]); }
    f32x4 o[4];
#pragma unroll
    for (int mt = 0; mt < 4; ++mt) o[mt] = (f32x4){0.f, 0.f, 0.f, 0.f};
#pragma unroll
    for (int kk = 0; kk < 2; ++kk) { const bf16x8 bfv = frag_tr(vs, LD128, 32 * kk, 16 * wave, lane);
#pragma unroll
        for (int mt = 0; mt < 4; ++mt) o[mt] = MFMA16(frag_rd(scs, LD64, 16 * mt, 32 * kk, lane), bfv, o[mt]); }
#pragma unroll
    for (int kk = 0; kk < 4; ++kk) { const bf16x8 bfs = frag_rd(sts, LD128, 16 * wave, 32 * kk, lane);
#pragma unroll
        for (int mt = 0; mt < 4; ++mt) o[mt] = MFMA16(frag_rd(q2, LD128, 16 * mt, 32 * kk, lane), bfs, o[mt]); }
    __syncthreads();
#pragma unroll
    for (int mt = 0; mt < 4; ++mt)
#pragma unroll
        for (int r = 0; r < 4; ++r) { const int c = 16 * mt + 4 * fq + r;
            const float hv = o[mt][r] * rcpf_(sc[256 + c]) * sigmoidf_(ogt[mt][r]); o[mt][r] = hv;
            float s = hv * hv; s = row_sum_f(s);
            if (fr == 0) rsp[wave * 64 + c] = s; }
    __syncthreads();
#pragma unroll
    for (int mt = 0; mt < 4; ++mt)
#pragma unroll
        for (int r = 0; r < 4; ++r) { const int c = 16 * mt + 4 * fq + r; float ss = 0.f;
#pragma unroll
            for (int w = 0; w < 8; ++w) ss += rsp[w * 64 + c];
            mix[(r0 + c) * DM + 1024 + h * HD + 16 * wave + fr] = (bf16)f2bf(o[mt][r] * rsqrtf(ss * (1.0f / 128.0f) + RMS_EPS) * gn); }
    __syncthreads();
}

constexpr int FG_LM = 52224, FG_S = 129024, FG_RAW = 68608, FG_RAWT = 9216  ;
__device__ __forceinline__ int gdn_kperm(int k) { const int kb = k & ~31, jj = k & 31; return kb + (jj < 16 ? 8 * (jj >> 2) + (jj & 3) : 8 * ((jj - 16) >> 2) + 4 + (jj & 3)); }
__device__ __forceinline__ int gdn_swz(int ob) { return ob ^ (((ob >> 9) & 1) << 5); }
template <int C> struct GdnSolve {
    static __device__ __forceinline__ void run(float (&sol)[64], const LAS float* Lm) {
        if constexpr (C < 64) {
            float a0 = sol[C], a1 = 0.f, a2 = 0.f, a3 = 0.f;
#pragma unroll
            for (int q = 0; q < (C + 3) / 4; ++q) { const f32x4 lv = *(const LAS f32x4*)(Lm + C * 64 + 4 * q);
                a0 -= lv[0] * sol[4 * q]; if (4 * q + 1 < C) a1 -= lv[1] * sol[4 * q + 1]; if (4 * q + 2 < C) a2 -= lv[2] * sol[4 * q + 2]; if (4 * q + 3 < C) a3 -= lv[3] * sol[4 * q + 3]; }
            sol[C] = (a0 + a1) + (a2 + a3);
            GdnSolve<C + 1>::run(sol, Lm);
        }
    }
};
__device__ __forceinline__ void f_gdn_p2(ArgsR A, int l, int item, LAS unsigned char* lds, int tid) {
    const int n = item & 31, h = (item >> 5) & 3, b = item >> 7; const int lane = tid & 63, wave = __builtin_amdgcn_readfirstlane(tid >> 6), fr = lane & 15, fq = lane >> 4;
    const bf16* P = (const bf16*)(A.ws + WS_P); const float* Ps = (const float*)(A.ws + WS_PS);
    bf16* U0 = (bf16*)(A.ws + WS_GDN_U0) + (size_t)item * 8192; bf16* Wg = (bf16*)(A.ws + WS_GDN_W) + (size_t)item * 8192; bf16* QD = (bf16*)(A.ws + WS_GDN_QD) + (size_t)item * 8192;
    bf16* KE = (bf16*)(A.ws + WS_GDN_KE) + (size_t)item * 8192; bf16* QK = (bf16*)(A.ws + WS_GDN_QK) + (size_t)item * 4096; float* DE = (float*)(A.ws + WS_GDN_DE);
    LAS bf16* qs = (LAS bf16*)(lds + FL_Q); LAS bf16* ks = (LAS bf16*)(lds + FL_K); LAS bf16* vs = (LAS bf16*)(lds + FL_V); LAS float* Lm = (LAS float*)(lds + FG_LM); LAS float* sc = (LAS float*)(lds + FG_S);
    const float* cw = A.in[I_GDN_CW] + (size_t)l * 4 * 1536;
    const size_t r0 = (size_t)b * SEQ + n * CHK;
    float cwv[3][4];
#pragma unroll
    for (int part = 0; part < 3; ++part)
#pragma unroll
        for (int k = 0; k < 4; ++k) cwv[part][k] = cw[k * 1536 + part * 512 + h * HD + (tid & 127)];
    if (wave == 0) { const float bt = sigmoidf_(Ps[(r0 + lane) * 32 + PS_GB + h]);
        const float g = -__expf(A.in[I_GDN_ALOG][l * NH + h]) * softplusf_(Ps[(r0 + lane) * 32 + PS_GA + h] + A.in[I_GDN_DTB][l * NH + h]);
        const float gam = wave_scan_add(g, lane); sc[lane] = bt; sc[64 + lane] = gam; if (lane == 63) DE[item] = __expf(gam); }
    { LAS bf16* raw = (LAS bf16*)(lds + FG_RAW);
#pragma unroll
        for (int i = 0; i < 7; ++i) { const int idx = tid + i * NTHREADS; if (idx < 3 * 67 * 16) { const int part = idx / (67 * 16), pi = idx % (67 * 16), rr = pi >> 4, c8 = (pi & 15) * 8;
            const int pc = (part == 0 ? PC_GDN_Q : part == 1 ? PC_GDN_K : PC_GDN_V) + h * HD + c8; v4u w = {0u, 0u, 0u, 0u};
            if (n > 0 || rr >= 3) w = *(const GAS v4u*)(P + (r0 + rr - 3) * PBW + pc);
            *(LAS v4u*)(raw + part * FG_RAWT + rr * LD128 + c8) = w; } }
        __syncthreads();
        const int v = tid & 127, dq = tid >> 7;
#pragma unroll
        for (int part = 0; part < 3; ++part) {
            const float w0 = cwv[part][0], w1 = cwv[part][1], w2 = cwv[part][2], w3 = cwv[part][3];
            LAS bf16* dst = part == 0 ? qs : part == 1 ? ks : vs; const LAS bf16* src = raw + part * FG_RAWT + v;
            const int c0 = dq * 16;
            float xm3 = bf2f(src[(c0 + 0) * LD128]), xm2 = bf2f(src[(c0 + 1) * LD128]), xm1 = bf2f(src[(c0 + 2) * LD128]);
#pragma unroll
            for (int i = 0; i < 16; ++i) { const float x0 = bf2f(src[(c0 + i + 3) * LD128]); const float y = w0 * xm3 + w1 * xm2 + w2 * xm1 + w3 * x0;
                dst[(c0 + i) * LD128 + v] = (bf16)f2bf(siluf_(y)); xm3 = xm2; xm2 = xm1; xm1 = x0; } } }
    __syncthreads();
#pragma unroll 1
    for (int rr = 0; rr < 8; ++rr) { const int c = wave * 8 + rr;
        const float q1 = bf2f(qs[c * LD128 + lane]), q2 = bf2f(qs[c * LD128 + 64 + lane]), k1 = bf2f(ks[c * LD128 + lane]), k2 = bf2f(ks[c * LD128 + 64 + lane]);
        const float sq = wave_sum(q1 * q1 + q2 * q2), sk = wave_sum(k1 * k1 + k2 * k2);
        if (lane == 0) { sc[128 + c] = rsqrtf(sq + 1e-6f) * 0.08838834764831845f; sc[192 + c] = rsqrtf(sk + 1e-6f); } }
    __syncthreads();
    { const int mt = wave >> 1; f32x4 akk[2] = {{0.f, 0.f, 0.f, 0.f}, {0.f, 0.f, 0.f, 0.f}}, aqk[2] = {{0.f, 0.f, 0.f, 0.f}, {0.f, 0.f, 0.f, 0.f}};
#pragma unroll
        for (int kk = 0; kk < 4; ++kk) { const bf16x8 ak = frag_rd(ks, LD128, 16 * mt, 32 * kk, lane), aq = frag_rd(qs, LD128, 16 * mt, 32 * kk, lane);
#pragma unroll
            for (int q = 0; q < 2; ++q) { const bf16x8 bk = frag_rd(ks, LD128, 16 * (2 * (wave & 1) + q), 32 * kk, lane); akk[q] = MFMA16(ak, bk, akk[q]); aqk[q] = MFMA16(aq, bk, aqk[q]); } }
#pragma unroll
        for (int q = 0; q < 2; ++q) { const int s = 16 * (2 * (wave & 1) + q) + fr; const float rks = sc[192 + s], gs = sc[64 + s];
#pragma unroll
            for (int r = 0; r < 4; ++r) { const int c = 16 * mt + 4 * fq + r; const float dcy = __expf(sc[64 + c] - gs);
                Lm[c * 64 + s] = (s < c) ? sc[c] * akk[q][r] * sc[192 + c] * rks * dcy : 0.f;
                QK[c * 64 + gdn_kperm(s)] = (bf16)f2bf((s <= c) ? aqk[q][r] * sc[128 + c] * rks * dcy : 0.f); } } }
    __syncthreads();
    if (tid < 256) {
        float sol[64]; const bool isw = tid >= 128; const int j = tid & 127;
        const LAS float* LmO = Lm; asm volatile("" : "+v"(LmO));
#pragma unroll
        for (int c = 0; c < 64; ++c) { const float bt = sc[c]; sol[c] = isw ? bf2f(ks[c * LD128 + j]) * sc[192 + c] * bt * __expf(sc[64 + c]) : bf2f(vs[c * LD128 + j]) * bt; }
        GdnSolve<1>::run(sol, LmO);
        bf16* dst = isw ? Wg : U0;
#pragma unroll
        for (int c = 0; c < 64; ++c) dst[c * 128 + j] = (bf16)f2bf(sol[c]);
    } else {
        const int t2 = tid - 256; const float glast = sc[64 + 63];
#pragma unroll
        for (int i = 0; i < 8; ++i) { const int idx = t2 + i * 256, which = idx >> 10, pi = idx & 1023, r = pi >> 4, c8 = (pi & 15) * 8;
            const float w = which == 0 ? sc[128 + r] * __expf(sc[64 + r]) : sc[192 + r] * __expf(glast - sc[64 + r]);
            v4u x = *(LAS v4u*)((which == 0 ? qs : ks) + r * LD128 + c8);
            x.x = pk2(bflo(x.x) * w, bfhi(x.x) * w); x.y = pk2(bflo(x.y) * w, bfhi(x.y) * w); x.z = pk2(bflo(x.z) * w, bfhi(x.z) * w); x.w = pk2(bflo(x.w) * w, bfhi(x.w) * w);
            if (which == 0) { v2u lo_, hi_; lo_.x = x.x; lo_.y = x.y; hi_.x = x.z; hi_.y = x.w; *(GAS v2u*)(QD + r * 128 + gdn_kperm(c8)) = lo_; *(GAS v2u*)(QD + r * 128 + gdn_kperm(c8 + 4)) = hi_; }
            else *(GAS v4u*)(KE + r * 128 + c8) = x; }
    }
    __syncthreads();
}

constexpr int FC_W = 0, FC_QD = 17408, FC_KE = 34816, FC_U0 = 52224, FC_QK = 69632, FC_RS = 78848  , FC_G = 82944  , FC_RT = 100352  , FC_OS = 100864  ;
__device__ __forceinline__ void f_gdn_p3(ArgsR A, int l, int bh, LAS unsigned char* lds, int tid) {
    const int lane = tid & 63, wave = __builtin_amdgcn_readfirstlane(tid >> 6), fr = lane & 15, fq = lane >> 4; const int b = bh >> 2, h = bh & 3;
    const bf16* U0 = (const bf16*)(A.ws + WS_GDN_U0) + (size_t)bh * 32 * 8192; const bf16* Wg = (const bf16*)(A.ws + WS_GDN_W) + (size_t)bh * 32 * 8192; const bf16* QD = (const bf16*)(A.ws + WS_GDN_QD) + (size_t)bh * 32 * 8192;
    const bf16* KE = (const bf16*)(A.ws + WS_GDN_KE) + (size_t)bh * 32 * 8192; const bf16* QK = (const bf16*)(A.ws + WS_GDN_QK) + (size_t)bh * 32 * 4096; const float* DE = (const float*)(A.ws + WS_GDN_DE) + bh * 32;
    const bf16* P = (const bf16*)(A.ws + WS_P); bf16* mix = (bf16*)(A.ws + WS_MIX); LAS float* rsp = (LAS float*)(lds + FC_RS); LAS float* rtp = (LAS float*)(lds + FC_RT); LAS bf16* gs = (LAS bf16*)(lds + FC_G); LAS bf16* os = (LAS bf16*)(lds + FC_OS);
    const float gn = A.in[I_GDN_NG][l * GW + h * HD + 16 * wave + fr];
    LAS bf16* ws_ = (LAS bf16*)(lds + FC_W); LAS bf16* qds = (LAS bf16*)(lds + FC_QD); LAS bf16* kes = (LAS bf16*)(lds + FC_KE); LAS bf16* u0s = (LAS bf16*)(lds + FC_U0); LAS bf16* qks = (LAS bf16*)(lds + FC_QK);
    LAS unsigned char* fbase = lds + gdn_swz(fr * 64 + fq * 16); asm volatile("" : "+v"(fbase));
    f32x4 S[8];
#pragma unroll
    for (int i = 0; i < 8; ++i) S[i] = (f32x4){0.f, 0.f, 0.f, 0.f};
    v4u st[11];
    auto issue = [&](int n) {
#pragma unroll
        for (int i = 0; i < 8; ++i) { const int idx = tid + i * NTHREADS, which = idx >> 10, pi = idx & 1023;
            const bf16* src = (which == 0 ? Wg : which == 1 ? QD : which == 2 ? KE : U0) + (size_t)n * 8192; st[i] = __builtin_nontemporal_load((const GAS v4u*)(src + pi * 8)); }
        st[8] = __builtin_nontemporal_load((const GAS v4u*)(QK + (size_t)n * 4096 + tid * 8));
#pragma unroll
        for (int i = 0; i < 2; ++i) { const int idx = tid + i * NTHREADS, r = idx >> 4, c8 = (idx & 15) * 8; st[9 + i] = *(const GAS v4u*)(P + ((size_t)b * SEQ + n * CHK + r) * PBW + PC_GDN_G + h * HD + c8); }
    };
    auto commit = [&]() {
#pragma unroll
        for (int i = 0; i < 8; ++i) { const int idx = tid + i * NTHREADS, which = idx >> 10, pi = idx & 1023, r = pi >> 4, c8 = (pi & 15) * 8;
            const int sub = ((r >> 4) * 4 + ((pi & 15) >> 2)) * 1024, q = pi & 3;
            if (i < 2) {
                v2u lo_, hi_; lo_.x = st[i].x; lo_.y = st[i].y; hi_.x = st[i].z; hi_.y = st[i].w;
                *(LAS v2u*)(lds + FC_W + sub + gdn_swz((r & 15) * 64 + (2 * (q & 1)) * 16) + (q >> 1) * 8) = lo_; *(LAS v2u*)(lds + FC_W + sub + gdn_swz((r & 15) * 64 + (2 * (q & 1) + 1) * 16) + (q >> 1) * 8) = hi_; }
            else if (i < 4) *(LAS v4u*)(lds + FC_QD + sub + gdn_swz((r & 15) * 64 + q * 16)) = st[i];
            else *(LAS v4u*)((LAS bf16*)(lds + which * 17408) + r * LD128 + c8) = st[i]; }
        { const int r = tid >> 3; *(LAS v4u*)(lds + FC_QK + ((r >> 4) * 2 + ((tid & 7) >> 2)) * 1024 + gdn_swz((r & 15) * 64 + (tid & 3) * 16)) = st[8]; }
#pragma unroll
        for (int i = 0; i < 2; ++i) { const int idx = tid + i * NTHREADS, r = idx >> 4, c8 = (idx & 15) * 8; *(LAS v4u*)(gs + r * LD128 + c8) = st[9 + i]; }
    };
    const float dev = DE[lane & 31];
    issue(0);
    f32x4 op[4]; float gp[4][4];
#pragma unroll
    for (int mt = 0; mt < 4; ++mt) { op[mt] = (f32x4){0.f, 0.f, 0.f, 0.f};
#pragma unroll
        for (int r = 0; r < 4; ++r) gp[mt][r] = 0.f; }
#define CH_ROWTOT(nn) { float v_ = rsp[((nn) & 1) * 512 + (lane & 7) * 64 + 8 * wave + (lane >> 3)]; v_ = oct_sum_f(v_); if ((lane & 7) == 0) rtp[((nn) & 1) * 64 + 8 * wave + (lane >> 3)] = rsqrtf(v_ * (1.0f / 128.0f) + RMS_EPS); }
#define CH_FINAL(nn) { const LAS float* rt_ = rtp + ((nn) & 1) * 64; \
        _Pragma("unroll") for (int mt = 0; mt < 4; ++mt) { const f32x4 rn_ = *(const LAS f32x4*)(rt_ + 16 * mt + 4 * fq); \
            _Pragma("unroll") for (int r = 0; r < 4; ++r) { const int c = 16 * mt + 4 * fq + r; os[c * LD128 + 16 * wave + fr] = (bf16)f2bf(op[mt][r] * rn_[r] * gn * siluf_(gp[mt][r])); } } }
#define CH_STORE(nn) { const size_t rp_ = (size_t)b * SEQ + (nn) * CHK; \
        _Pragma("unroll") for (int i = 0; i < 2; ++i) { const int idx = tid + i * NTHREADS, r = idx >> 4, c8 = (idx & 15) * 8; *(GAS v4u*)(mix + (rp_ + r) * DM + 1536 + h * HD + c8) = *(const LAS v4u*)(os + r * LD128 + c8); } }
#pragma unroll 1
    for (int n = 0; n < NCHK; ++n) {
        __syncthreads();
        if (n > 1) CH_STORE(n - 2);
        if (n > 0) CH_ROWTOT(n - 1);
        commit();
        __syncthreads();
        if (n + 1 < NCHK) issue(n + 1);
        if (n > 0) CH_FINAL(n - 1);
        const float de = lane_bcast(dev, n);
#pragma unroll
        for (int mt = 0; mt < 4; ++mt) { const v4i16_t gv = __builtin_amdgcn_ds_read_tr16_b64_v4i16((LAS v4i16_t*)(gs + (16 * mt + 4 * fq + (fr >> 2)) * LD128 + 16 * wave + 4 * (fr & 3)));
#pragma unroll
            for (int r = 0; r < 4; ++r) gp[mt][r] = bf2f((unsigned)(unsigned short)gv[r]); }
        bf16x8 SB[4];
#pragma unroll
        for (int kb = 0; kb < 4; ++kb) SB[kb] = pack_acc(S[2 * kb], S[2 * kb + 1]);
        f32x4 u[4];
#pragma unroll
        for (int mt = 0; mt < 4; ++mt) { f32x4 ws2 = {0.f, 0.f, 0.f, 0.f}; op[mt] = (f32x4){0.f, 0.f, 0.f, 0.f};
#pragma unroll
            for (int kb = 0; kb < 4; ++kb) { ws2 = MFMA16(*(const LAS bf16x8*)(fbase + FC_W + (mt * 4 + kb) * 1024), SB[kb], ws2); op[mt] = MFMA16(*(const LAS bf16x8*)(fbase + FC_QD + (mt * 4 + kb) * 1024), SB[kb], op[mt]); }
            const v4i16_t uv = __builtin_amdgcn_ds_read_tr16_b64_v4i16((LAS v4i16_t*)(u0s + (16 * mt + 4 * fq + (fr >> 2)) * LD128 + 16 * wave + 4 * (fr & 3)));
#pragma unroll
            for (int r = 0; r < 4; ++r) u[mt][r] = bf2f((unsigned)(unsigned short)uv[r]) - ws2[r]; }
        const bf16x8 UB0 = pack_acc(u[0], u[1]), UB1 = pack_acc(u[2], u[3]);
#pragma unroll
        for (int mt = 0; mt < 4; ++mt) { op[mt] = MFMA16(*(const LAS bf16x8*)(fbase + FC_QK + (mt * 2) * 1024), UB0, op[mt]); op[mt] = MFMA16(*(const LAS bf16x8*)(fbase + FC_QK + (mt * 2 + 1) * 1024), UB1, op[mt]); }
#pragma unroll
        for (int dt = 0; dt < 8; ++dt) { f32x4 sn = S[dt] * de;
            sn = MFMA16(frag_tr_perm(kes, LD128, 0, 16 * dt, lane), UB0, sn); sn = MFMA16(frag_tr_perm(kes, LD128, 32, 16 * dt, lane), UB1, sn); S[dt] = sn; }
        LAS float* rs_ = rsp + (n & 1) * 512;
        { const bool b0_ = (fr & 1) != 0, b1_ = (fr & 2) != 0; float qv[4];
#pragma unroll
            for (int mt = 0; mt < 4; ++mt) { const float s0 = op[mt][0] * op[mt][0], s1 = op[mt][1] * op[mt][1], s2 = op[mt][2] * op[mt][2], s3 = op[mt][3] * op[mt][3];
                const float p01 = (b0_ ? s1 : s0) + dpp_rotf<0xB1>(b0_ ? s0 : s1), p23 = (b0_ ? s3 : s2) + dpp_rotf<0xB1>(b0_ ? s2 : s3);
                float q_ = (b1_ ? p23 : p01) + dpp_rotf<0x4E>(b1_ ? p01 : p23);
                q_ += dpp_rotf<0x124>(q_); q_ += dpp_rotf<0x128>(q_); qv[mt] = q_; }
            const int mw = fr >> 2; const float qs_ = mw == 0 ? qv[0] : mw == 1 ? qv[1] : mw == 2 ? qv[2] : qv[3];
            rs_[wave * 64 + 16 * mw + 4 * fq + (fr & 3)] = qs_; }
    }
    __syncthreads();
    CH_STORE(NCHK - 2);
    CH_ROWTOT(NCHK - 1);
    __syncthreads();
    CH_FINAL(NCHK - 1);
    __syncthreads();
    CH_STORE(NCHK - 1);
#undef CH_STORE
#undef CH_FINAL
#undef CH_ROWTOT
    __syncthreads();
}

#ifndef TAB_FP8
#define TAB_FP8 1
#endif
constexpr size_t WS_TSC = 93 * MiB + 256 * 1024;
constexpr int NSLICE = 16;
typedef int v2i_t __attribute__((ext_vector_type(2)));
constexpr int PE_KEYS = 0, PE_CAB = 16384, PE_ENT = 17408, PE_H2Q = 53248, PE_OFFS = 148480, PE_SHQ = 150656;
constexpr int PE_PK = 0, PE_VST = 17408;
static_assert(PE_VST + 8 * 16384 <= PE_OFFS && PE_SHQ + 768 + 512 <= MISC_OFF, "PEER LDS map");

__device__ __forceinline__ void tab_convert(ArgsR A, int l, int q0, int q1, int step, int lane) {
    unsigned char* ws = A.ws; float* tsc = (float*)(ws + WS_TSC);
#pragma unroll 1
    for (int q = q0; q < q1; q += step) {
        const int t = q / NEXP, rr = l * NEXP + q % NEXP, r = t * DEPTH * NEXP + rr;
        const float* src = A.in[t ? I_PV : I_PU] + (size_t)rr * DM;
        f32x4 v[8];
#pragma unroll
        for (int i = 0; i < 8; ++i) v[i] = __builtin_nontemporal_load((const GAS f32x4*)(src + 4 * (lane + 64 * i)));
        unsigned char* dst = ws + (t ? WS_VB : WS_UB) + (size_t)(rr / NEXP) * TAB_L + (size_t)(rr % NEXP) * DM;
        float am = 0.f;
#pragma unroll
        for (int i = 0; i < 8; ++i) am = fmaxf(fmaxf(am, fmaxf(fabsf(v[i][0]), fabsf(v[i][1]))), fmaxf(fabsf(v[i][2]), fabsf(v[i][3])));
        am = wave_max(am); const float sc = am > 0.f ? 127.0f / am : 1.0f; const int off = 0;
#pragma unroll
        for (int i = 0; i < 8; ++i) { const int q0 = __float2int_rn(v[i][0] * sc) + off, q1 = __float2int_rn(v[i][1] * sc) + off, q2 = __float2int_rn(v[i][2] * sc) + off, q3 = __float2int_rn(v[i][3] * sc) + off;
            *(GAS unsigned*)(dst + 4 * (lane + 64 * i)) = (unsigned)(q0 & 255) | ((unsigned)(q1 & 255) << 8) | ((unsigned)(q2 & 255) << 16) | ((unsigned)(q3 & 255) << 24); }
        if (lane == 0) tsc[r] = am > 0.f ? am * (1.0f / 127.0f) : 1.0f;
    }
}
__device__ __forceinline__ float ubf0(unsigned w) { float r; asm volatile("v_cvt_f32_ubyte0 %0, %1" : "=v"(r) : "v"(w)); return r; }
__device__ __forceinline__ float ubf1(unsigned w) { float r; asm volatile("v_cvt_f32_ubyte1 %0, %1" : "=v"(r) : "v"(w)); return r; }
__device__ __forceinline__ float ubf2(unsigned w) { float r; asm volatile("v_cvt_f32_ubyte2 %0, %1" : "=v"(r) : "v"(w)); return r; }
__device__ __forceinline__ float ubf3(unsigned w) { float r; asm volatile("v_cvt_f32_ubyte3 %0, %1" : "=v"(r) : "v"(w)); return r; }
#define TOUCH16(a, o) asm volatile("" : "+v"(a[(o)+0]), "+v"(a[(o)+1]), "+v"(a[(o)+2]), "+v"(a[(o)+3]), "+v"(a[(o)+4]), "+v"(a[(o)+5]), "+v"(a[(o)+6]), "+v"(a[(o)+7]), "+v"(a[(o)+8]), "+v"(a[(o)+9]), "+v"(a[(o)+10]), "+v"(a[(o)+11]), "+v"(a[(o)+12]), "+v"(a[(o)+13]), "+v"(a[(o)+14]), "+v"(a[(o)+15]))
__device__ __forceinline__ unsigned f2sortable(float f) { const unsigned u = __builtin_bit_cast(unsigned, f); return (u & 0x80000000u) ? ~u : (u | 0x80000000u); }
__device__ __forceinline__ float unsortable(unsigned k) { const unsigned u = (k & 0x80000000u) ? (k & 0x7fffffffu) : ~k; return __builtin_bit_cast(float, u); }
__device__ __forceinline__ void peer_phase(ArgsR A, int l, bool last, bool dry, LAS unsigned char* lds, int G, int tid) {
    const int wave = __builtin_amdgcn_readfirstlane(tid >> 6), lane = tid & 63;
    unsigned char* ws = A.ws;
    const bf16* Q = (const bf16*)(ws + WS_Q);
    const bf16* K1 = (const bf16*)(ws + WS_K1) + (size_t)l * 8 * 128 * 128; const bf16* K2 = (const bf16*)(ws + WS_K2) + (size_t)l * 8 * 128 * 128;
    const unsigned char* Ub = ws + WS_UB + (size_t)l * TAB_L; const unsigned char* Vb = ws + WS_VB + (size_t)l * TAB_L;
    const float* tscU = (const float*)(ws + WS_TSC) + (size_t)l * NEXP; const float* tscV = tscU + (size_t)DEPTH * NEXP;
    const float* ssp = (const float*)(ws + WS_SSP); const float* X = A.out; float* XO = dry ? (float*)(ws + WS_P) : A.out; bf16* xb = (bf16*)(ws + (dry ? WS_MIX : WS_XB));
    const float* g2 = A.in[I_N2G] + l * DM; const float* gf = A.in[I_FNG];
    LAS unsigned* keysL = (LAS unsigned*)(lds + PE_KEYS); LAS unsigned* cab = (LAS unsigned*)(lds + PE_CAB); LAS v2u* ent = (LAS v2u*)(lds + PE_ENT); LAS unsigned* offs = (LAS unsigned*)(lds + PE_OFFS);
    LAS float* shqL = (LAS float*)(lds + PE_SHQ); LAS unsigned* ngt = (LAS unsigned*)(lds + PE_SHQ + 128); LAS float* cqs = (LAS float*)(lds + PE_SHQ + 256); LAS unsigned* ngt8 = (LAS unsigned*)(lds + PE_SHQ + 384); LAS v4u* h2qL = (LAS v4u*)(lds + PE_H2Q);
    if (tid < 64) { int a = 0, b = tid, found = 0;
        for (int aa = 0, base = 0; aa < 16; ++aa) { const int nbb = 16 / (aa + 1); if (!found && tid < base + nbb) { a = aa; b = tid - base; found = 1; } base += nbb; }
        cab[tid] = found ? (unsigned)(a * 16 + b) : 0xffu; }
    __syncthreads();
#pragma unroll 1
    for (int item = blockIdx.x; item < NT / 32; item += G) {
        const int tok0 = item * 32; const bf16* xbr = (const bf16*)(ws + WS_XB);
#pragma unroll 1
        for (int tt = 0; tt < 4; ++tt) { const int tl = wave * 4 + tt; const size_t t = (size_t)tok0 + tl;
            float s2 = (lane < 32) ? ssp[t * 32 + lane] : 0.f; s2 = wave_sum(s2);
            const float rstd2 = rsqrtf(s2 * (1.0f / DM) + RMS_EPS);
            float hf[32]; float am = 0.f;
#pragma unroll
            for (int j = 0; j < 2; ++j) { const size_t eb = 16 * (size_t)(lane + 64 * j);
                const v4u xw0 = *(const GAS v4u*)(xbr + t * DM + eb), xw1 = *(const GAS v4u*)(xbr + t * DM + eb + 8);
                const unsigned xd[8] = {xw0.x, xw0.y, xw0.z, xw0.w, xw1.x, xw1.y, xw1.z, xw1.w};
#pragma unroll
                for (int q = 0; q < 4; ++q) { const f32x4 ga = *(const GAS f32x4*)(g2 + eb + 4 * q);
                    const float xa[4] = {bflo(xd[2 * q]), bfhi(xd[2 * q]), bflo(xd[2 * q + 1]), bfhi(xd[2 * q + 1])};
#pragma unroll
                    for (int k = 0; k < 4; ++k) { const float hv = xa[k] * rstd2 * ga[k]; hf[j * 16 + q * 4 + k] = hv; am = fmaxf(am, fabsf(hv)); } } }
            am = wave_max(am); const float sc = am > 0.f ? 127.0f / am : 1.0f;
#pragma unroll
            for (int j = 0; j < 2; ++j) { unsigned wd[4];
#pragma unroll
                for (int q = 0; q < 4; ++q) wd[q] = (unsigned)((__float2int_rn(hf[j * 16 + q * 4 + 0] * sc) & 255) | ((__float2int_rn(hf[j * 16 + q * 4 + 1] * sc) & 255) << 8) | ((__float2int_rn(hf[j * 16 + q * 4 + 2] * sc) & 255) << 16) | ((__float2int_rn(hf[j * 16 + q * 4 + 3] * sc) & 255) << 24));
                v4u w; w.x = wd[0]; w.y = wd[1]; w.z = wd[2]; w.w = wd[3]; h2qL[(tl * 2 + j) * 64 + lane] = w; }
            if (lane == 0) shqL[tl] = am > 0.f ? am * (1.0f / 127.0f) : 1.0f; }
#pragma unroll 1
        for (int pass = 0; pass < 2; ++pass) {
            LAS unsigned* kl = keysL;
            if (pass > 0) __syncthreads();
            { const int hq = wave >> 1, side = wave & 1, h = 4 * pass + hq, fr = lane & 15, fq = lane >> 4;
                const bf16* qa = Q + (size_t)(tok0 + fr) * DM + h * 256 + side * 128 + 8 * fq;
                const bf16* kb = (side ? K2 : K1) + (size_t)h * 128 * 128 + lane * 8;
                bf16x8 af[2][4];
#pragma unroll
                for (int mt = 0; mt < 2; ++mt)
#pragma unroll
                    for (int ks = 0; ks < 4; ++ks) af[mt][ks] = *(const GAS bf16x8*)(qa + (size_t)mt * 16 * DM + 32 * ks);
                unsigned key[8][8];
#pragma unroll
                for (int nt = 0; nt < 8; ++nt) { f32x4 acc0 = {0.f, 0.f, 0.f, 0.f}, acc1 = {0.f, 0.f, 0.f, 0.f};
#pragma unroll
                    for (int ks = 0; ks < 4; ++ks) { const bf16x8 bfr = *(const GAS bf16x8*)(kb + (nt * 4 + ks) * 512);
                        acc0 = __builtin_amdgcn_mfma_f32_16x16x32_bf16(af[0][ks], bfr, acc0, 0, 0, 0); acc1 = __builtin_amdgcn_mfma_f32_16x16x32_bf16(af[1][ks], bfr, acc1, 0, 0, 0); }
#pragma unroll
                    for (int r = 0; r < 4; ++r) { key[nt][r] = (f2sortable(acc0[r]) & ~127u) | (unsigned)(nt * 16 + fr); key[nt][4 + r] = (f2sortable(acc1[r]) & ~127u) | (unsigned)(nt * 16 + fr); }
                    __builtin_amdgcn_sched_barrier(0); }
#define CE8(a, b) { const unsigned hi_ = max(key[a][r], key[b][r]), lo_ = min(key[a][r], key[b][r]); key[a][r] = hi_; key[b][r] = lo_; }
#pragma unroll
                for (int r = 0; r < 8; ++r) { CE8(0, 1) CE8(2, 3) CE8(4, 5) CE8(6, 7) CE8(0, 2) CE8(1, 3) CE8(4, 6) CE8(5, 7) CE8(1, 2) CE8(5, 6) CE8(0, 4) CE8(1, 5) CE8(2, 6) CE8(3, 7) CE8(2, 4) CE8(3, 5) CE8(1, 2) CE8(3, 4) CE8(5, 6) }
#undef CE8
                const int rowb = (hq * 2 + side) * 32 + 4 * fq;
#pragma unroll
                for (int mt = 0; mt < 2; ++mt) {
                    unsigned res[4] = {0u, 0u, 0u, 0u};
#pragma unroll 1
                    for (int j = 0; j < 16; ++j) {
#pragma unroll
                        for (int r = 0; r < 4; ++r) {
                            const unsigned w = row_max_u(key[0][4 * mt + r]); const bool own = key[0][4 * mt + r] == w;
#pragma unroll
                            for (int nt = 0; nt < 7; ++nt) key[nt][4 * mt + r] = own ? key[nt + 1][4 * mt + r] : key[nt][4 * mt + r];
                            key[7][4 * mt + r] = own ? 0u : key[7][4 * mt + r];
                            res[r] = (fr == j) ? w : res[r]; } }
#pragma unroll
                    for (int r = 0; r < 4; ++r) kl[(rowb + 16 * mt + r) * 16 + fr] = res[r]; } }
            __syncthreads();
#pragma unroll 1
            for (int rnd = 0; rnd < 4; ++rnd) { const int fr = lane & 15, fq = lane >> 4, pidx = rnd * 32 + wave * 4 + fq, hh = pidx >> 5, tk = pidx & 31, h = 4 * pass + hh;
                const LAS unsigned* k1 = kl + ((hh * 2) * 32 + tk) * 16; const LAS unsigned* k2 = k1 + 32 * 16;
                unsigned ck[4];
#pragma unroll
                for (int sl = 0; sl < 4; ++sl) { const int ci = fr + 16 * sl; const unsigned ab = cab[ci];
                    const float v = unsortable(k1[(ab >> 4) & 15] & ~127u) + unsortable(k2[ab & 15] & ~127u);
                    ck[sl] = (ab == 0xffu) ? 0u : ((f2sortable(v) & ~63u) | (unsigned)ci); }
#define CE4(a, b) { const unsigned hi_ = max(ck[a], ck[b]), lo_ = min(ck[a], ck[b]); ck[a] = hi_; ck[b] = lo_; }
                CE4(0, 1) CE4(2, 3) CE4(0, 2) CE4(1, 3) CE4(1, 2)
#undef CE4
                unsigned rk = 0u;
#pragma unroll 1
                for (int j = 0; j < 16; ++j) { const unsigned w = row_max_u(ck[0]); const bool own = ck[0] == w;
                    ck[0] = own ? ck[1] : ck[0]; ck[1] = own ? ck[2] : ck[1]; ck[2] = own ? ck[3] : ck[2]; ck[3] = own ? 0u : ck[3];
                    rk = (fr == j) ? w : rk; }
                const unsigned ab = cab[rk & 63u]; const float v = unsortable(rk & ~63u);
                const float vmax = row_max_f(v), e = __expf(v - vmax), den = row_sum_f(e);
                const unsigned eid = (k1[(ab >> 4) & 15] & 127u) * 128u + (k2[ab & 15] & 127u);
                const float gsv = e * rcpf_(den) * tscV[eid];
                v2u wv; wv.x = eid; wv.y = __builtin_bit_cast(unsigned, gsv);
                ent[tk * 128 + h * 16 + fr] = wv; }
        }
        __syncthreads();
#pragma unroll 1
        for (int tt = 0; tt < 4; ++tt) { const int tl = wave * 4 + tt;
            const v2u e0 = ent[tl * 128 + lane], e1 = ent[tl * 128 + 64 + lane];
            const unsigned id0 = e0.x, id1 = e1.x; const unsigned s0 = id0 >> 10, s1 = id1 >> 10; const unsigned long long lt = (1ull << lane) - 1ull;
            unsigned base = 0, p0 = 0, p1 = 0, ngr = 0, ng8 = 0, pc = 0;
#pragma unroll 1
            for (unsigned s = 0; s < NSLICE; ++s) { const unsigned long long m0 = __ballot(s0 == s), m1 = __ballot(s1 == s); const unsigned c0 = __popcll(m0), c1 = __popcll(m1); ngr += (c0 + c1 + 3u) >> 2; pc += c0 + c1; if (s & 1u) { ng8 += (pc + 7u) >> 3; pc = 0; }
                if (s0 == s) p0 = base + __popcll(m0 & lt);
                if (s1 == s) p1 = base + c0 + __popcll(m1 & lt);
                if (lane == 0) offs[tl * 17 + s] = base;
                base += c0 + c1; }
            if (lane == 0) { offs[tl * 17 + NSLICE] = base; ngt[tl] = ngr; ngt8[tl] = ng8; }
            ent[tl * 128 + p0] = e0; ent[tl * 128 + p1] = e1; }
        const unsigned lo16 = (unsigned)lane * 16u;
#if defined(PROBE_VMASK) || defined(PROBE_UMASK)
        int IDM_ = 0xffffff;
#else
        constexpr int IDM_ = 0xffffff;
#endif
        unsigned ordLo, ordHi;
        { const int T_ = lane & 3, g0_ = lane >> 2, g1_ = 16 + (lane >> 2);
            const v2u f0_ = ent[(wave * 4 + T_) * 128 + 4 * g0_], f1_ = ent[(wave * 4 + T_) * 128 + 4 * g1_]; const unsigned i0_ = f0_.x, i1_ = f1_.x;
            const unsigned s0_ = (i0_ & 0x3fffu) >> 10, s1_ = (i1_ & 0x3fffu) >> 10; const unsigned long long lt_ = (1ull << lane) - 1ull; unsigned base_ = 0, p0_ = 0, p1_ = 0;
#pragma unroll 1
            for (unsigned sl_ = 0; sl_ < NSLICE; ++sl_) { const unsigned long long m0_ = __ballot(s0_ == sl_), m1_ = __ballot(s1_ == sl_); const unsigned c0_ = __popcll(m0_), c1_ = __popcll(m1_);
                if (s0_ == sl_) p0_ = base_ + __popcll(m0_ & lt_);
                if (s1_ == sl_) p1_ = base_ + c0_ + __popcll(m1_ & lt_);
                base_ += c0_ + c1_; }
            LAS unsigned char* ordL = lds + 50176 + wave * 128;
            ordL[p0_] = (unsigned char)lane; ordL[p1_] = (unsigned char)(64 + lane);
            ordLo = ordL[lane]; ordHi = ordL[64 + lane]; }
#define E_ADV(K, T, P, B1) { ++K; if (K >= 128) { T = 0; P = 128; B1 = 128; } else { const int c_ = __builtin_amdgcn_readlane((int)(K < 64 ? ordLo : ordHi), K & 63); T = c_ & 3; P = 4 * (c_ >> 2); B1 = 128; } }
#define E_ISSUE(T, P, B1) { Ntl = wave * 4 + T; Np = P; Nb1 = B1; Nev = ent[Ntl * 128 + min(P + (lane & 3), B1 - 1)]; }
#define E_TAKE(X) { X##tl = Ntl; X##p = Np; X##b1 = Nb1; X##ev = Nev; }
#define E_USE(X) { const unsigned ex_ = X##ev.x; _Pragma("unroll") for (int e = 0; e < 4; ++e) X##id[e] = __builtin_amdgcn_readlane((int)ex_, e); X##suv = tscU[ex_]; }
#define E_LOAD(REG, TAB, X) { _Pragma("unroll") for (int e = 0; e < 4; ++e) if (e == 0 || X##p + e < X##b1) { const unsigned ro_ = ((unsigned)X##id[e] & (unsigned)IDM_) * 2048u + lo16;        \
            REG[e][0] = *(const GAS v4u*)((const GAS unsigned char*)(TAB) + ro_); REG[e][1] = *(const GAS v4u*)((const GAS unsigned char*)(TAB) + ro_ + 1024u); } \
            else { REG[e][0] = (v4u){0u, 0u, 0u, 0u}; REG[e][1] = (v4u){0u, 0u, 0u, 0u}; } }
        {
#ifdef PROBE_UMASK
            IDM_ = dry ? PROBE_UMASK : 0xffffff;
#endif
            int Atl = 0, Ap = 0, Ab1 = 0, Aid[4]; v2u Aev = {0u, 0u}; float Asuv = 0.f; int Btl = 0, Bp = 0, Bb1 = 0, Bid[4]; v2u Bev = {0u, 0u}; float Bsuv = 0.f; int Ntl = 0, Np = 0, Nb1 = 0; v2u Nev = {0u, 0u}; v4u RA[4][2], RB[4][2];
#define U_COMP(X, REG) { const v4u hq0 = h2qL[(X##tl * 2 + 0) * 64 + lane], hq1 = h2qL[(X##tl * 2 + 1) * 64 + lane]; const float shq = shqL[X##tl]; int dd[4]; \
                _Pragma("unroll") for (int e = 0; e < 4; ++e) { int a0 = 0, a1 = 0; \
                    a0 = __builtin_amdgcn_sdot4((int)REG[e][0][0], (int)hq0[0], a0, false); a1 = __builtin_amdgcn_sdot4((int)REG[e][0][1], (int)hq0[1], a1, false); \
                    a0 = __builtin_amdgcn_sdot4((int)REG[e][0][2], (int)hq0[2], a0, false); a1 = __builtin_amdgcn_sdot4((int)REG[e][0][3], (int)hq0[3], a1, false); \
                    a0 = __builtin_amdgcn_sdot4((int)REG[e][1][0], (int)hq1[0], a0, false); a1 = __builtin_amdgcn_sdot4((int)REG[e][1][1], (int)hq1[1], a1, false); \
                    a0 = __builtin_amdgcn_sdot4((int)REG[e][1][2], (int)hq1[2], a0, false); a1 = __builtin_amdgcn_sdot4((int)REG[e][1][3], (int)hq1[3], a1, false); \
                    dd[e] = a0 + a1; } \
                const bool o1_ = (lane & 1) != 0, o2_ = (lane & 2) != 0; \
                const int r01_ = (o1_ ? dd[1] : dd[0]) + (int)dpp_rot_u<0xB1>((unsigned)(o1_ ? dd[0] : dd[1])); \
                const int r23_ = (o1_ ? dd[3] : dd[2]) + (int)dpp_rot_u<0xB1>((unsigned)(o1_ ? dd[2] : dd[3])); \
                int rr_ = (o2_ ? r23_ : r01_) + (int)dpp_rot_u<0x4E>((unsigned)(o2_ ? r01_ : r23_)); \
                rr_ += (int)dpp_rot_u<0x124>((unsigned)rr_); rr_ += (int)dpp_rot_u<0x128>((unsigned)rr_); \
                { const auto s32_ = __builtin_amdgcn_permlane32_swap(rr_, rr_, false, false); rr_ = s32_[0] + s32_[1]; const auto s16_ = __builtin_amdgcn_permlane16_swap(rr_, rr_, false, false); rr_ = s16_[0] + s16_[1]; } \
                const unsigned ex_ = X##ev.x, ey_ = X##ev.y; const float cf = __builtin_bit_cast(float, ey_) * gelu_tanh((float)rr_ * X##suv * shq); \
                if (lane < 4 && X##p + lane < X##b1) { v2u w2; w2.x = ex_; w2.y = __builtin_bit_cast(unsigned, cf); ent[X##tl * 128 + X##p + lane] = w2; } }
            int uk = -1, ut = 0, up = 0, ub1 = 0;
            const int ngU = 128;
            E_ADV(uk, ut, up, ub1); E_ISSUE(ut, up, ub1); E_TAKE(A); E_USE(A); E_LOAD(RA, Ub, A);
            E_ADV(uk, ut, up, ub1); E_ISSUE(ut, up, ub1);
#pragma unroll 1
            for (int gi = 0; gi < ngU; gi += 2) {
                E_TAKE(B); E_USE(B); E_LOAD(RB, Ub, B); E_ADV(uk, ut, up, ub1); E_ISSUE(ut, up, ub1);
                U_COMP(A, RA);
                E_TAKE(A); E_USE(A); E_LOAD(RA, Ub, A); E_ADV(uk, ut, up, ub1); E_ISSUE(ut, up, ub1);
                U_COMP(B, RB);
            }
            { unsigned x_ = __builtin_bit_cast(unsigned, Asuv);
#pragma unroll
                for (int e = 0; e < 4; ++e)
#pragma unroll
                    for (int j = 0; j < 2; ++j) x_ ^= RA[e][j][0] ^ RA[e][j][1] ^ RA[e][j][2] ^ RA[e][j][3];
                asm volatile("" :: "v"(x_)); }
#undef U_COMP
#undef E_USE
#undef E_TAKE
#undef E_ISSUE
#undef E_ADV
#undef E_LOAD
        }
        { LAS unsigned* pk = (LAS unsigned*)(lds + PE_PK);
#pragma unroll 1
        for (int tt = 0; tt < 4; ++tt) { const int tl = wave * 4 + tt;
            const v2u e0 = ent[tl * 128 + lane], e1 = ent[tl * 128 + 64 + lane]; const unsigned a0_ = e0.x, a1_ = e1.x, b0_ = e0.y, b1_ = e1.y;
            const float c0 = __builtin_bit_cast(float, b0_), c1 = __builtin_bit_cast(float, b1_);
            const float am = wave_max(fmaxf(fabsf(c0), fabsf(c1))); const float sc = am > 0.f ? 127.0f / am : 0.f;
            pk[tl * 128 + lane] = a0_ | (((unsigned)__float2int_rn(c0 * sc) & 255u) << 16); pk[tl * 128 + 64 + lane] = a1_ | (((unsigned)__float2int_rn(c1 * sc) & 255u) << 16);
            if (lane == 0) cqs[tl] = am * (1.0f / 127.0f); } }
        __syncthreads();
        {
            const LAS unsigned* pk = (const LAS unsigned*)(lds + PE_PK);
            const unsigned stg = (unsigned)(size_t)(lds + PE_VST) + (unsigned)wave * 16384u;
            LAS unsigned char* rdp = lds + PE_VST + wave * 16384 + ((lane >> 5) * 256 + ((lane & 15) >> 1) * 32 + ((lane >> 4) & 1) * 16 + (lane & 1) * 8);
            asm volatile("" : "+v"(rdp));
            const unsigned plane16 = ((((unsigned)lane >> 4) << 1) | ((unsigned)lane & 1u)) * 16u; const int erow = (lane >> 1) & 7;
            const unsigned char* VbU = Vb;
            LAS float* hst = (LAS float*)(lds + PE_SHQ + 512);
            const int ngV = 64;
#if defined(PROBE_VMASK)
            IDM_ = dry ? PROBE_VMASK : 0xffffff;
#elif defined(PROBE_UMASK)
            IDM_ = 0xffffff;
#endif
            const unsigned runV = offs[(wave * 4 + (lane & 3)) * 17 + 2 * ((lane >> 2) & 7)] | (offs[(wave * 4 + (lane & 3)) * 17 + 2 * ((lane >> 2) & 7) + 2] << 8);
            unsigned ordV;
            { const unsigned f_ = pk[(wave * 4 + (lane & 3)) * 128 + 8 * (lane >> 2)]; const unsigned s_ = (f_ & 0x3fffu) >> 11; const unsigned long long lt_ = (1ull << lane) - 1ull; unsigned base_ = 0, p_ = 0;
#pragma unroll 1
                for (unsigned sl_ = 0; sl_ < NSLICE / 2; ++sl_) { const unsigned long long m_ = __ballot(s_ == sl_); if (s_ == sl_) p_ = base_ + __popcll(m_ & lt_); base_ += __popcll(m_); }
                LAS unsigned char* ordL = lds + PE_SHQ + 768 + wave * 64; ordL[p_] = (unsigned char)lane; ordV = ordL[lane]; }
#define V_ADV(K, T, P, B1) { ++K; if (K >= 64) { T = 0; P = 128; B1 = 128; } else { const int c_ = __builtin_amdgcn_readlane((int)ordV, K); T = c_ & 3; P = 8 * (c_ >> 2); B1 = 128; } }
#define V_ISSUE(T, P, B1) { Nw = T; Np = P; Nb1 = B1; Nev = pk[(wave * 4 + T) * 128 + min(P + erow, B1 - 1)]; }
#define V_TAKE(X) { X##w = Nw; X##p = Np; X##b1 = Nb1; X##ev = Nev; }
#define V_USE(X) { const unsigned ev_ = X##ev; X##goff = ((ev_ & 0xffffu) & (unsigned)IDM_) * 2048u + hoffD; const unsigned b_ = (X##p + erow < X##b1) ? ((ev_ >> 16) & 255u) : 0u; \
                const unsigned t1_ = b_ | (dpp_rot_u<0x102>(b_) << 8); const unsigned t2_ = t1_ | (dpp_rot_u<0x104>(t1_) << 16); \
                X##c0 = __builtin_amdgcn_readlane((int)t2_, 0); X##c1 = __builtin_amdgcn_readlane((int)t2_, 8); \
                { const int nv_ = max(1, min(8, X##b1 - X##p)); const unsigned m16_ = (1u << (2 * nv_)) - 1u, m32_ = m16_ | (m16_ << 16); X##mk = (unsigned long long)m32_ | ((unsigned long long)m32_ << 32); } }
#define V_D1(MOFF, GOFF) "s_add_u32 m0, %4, " #MOFF "\n\tglobal_load_lds_dwordx4 %2, %3 offset:" #GOFF "\n\t"
#define V_LOAD0(X) { unsigned keep_; unsigned long long kx_; asm volatile("s_waitcnt lgkmcnt(0)\n\ts_mov_b32 %0, m0\n\ts_mov_b64 %1, exec\n\ts_mov_b64 exec, %5\n\t" V_D1(0, 0) V_D1(896, 128) V_D1(1792, 256) V_D1(2688, 384) V_D1(3584, 512) V_D1(4480, 640) V_D1(5376, 768) V_D1(6272, 896) \
                "s_mov_b64 exec, %1\n\ts_mov_b32 m0, %0" : "=&s"(keep_), "=&s"(kx_) : "v"(X##goff), "s"(VbU), "s"(stg), "s"(X##mk) : "memory", "scc"); }
#define V_LOAD1(X) { unsigned keep_; unsigned long long kx_; asm volatile("s_waitcnt lgkmcnt(0)\n\ts_mov_b32 %0, m0\n\ts_mov_b64 %1, exec\n\ts_mov_b64 exec, %5\n\t" V_D1(8192, 0) V_D1(9088, 128) V_D1(9984, 256) V_D1(10880, 384) V_D1(11776, 512) V_D1(12672, 640) V_D1(13568, 768) V_D1(14464, 896) \
                "s_mov_b64 exec, %1\n\ts_mov_b32 m0, %0" : "=&s"(keep_), "=&s"(kx_) : "v"(X##goff), "s"(VbU), "s"(stg), "s"(X##mk) : "memory", "scc"); }
#define V_ACC(Y, BUF, X) { _Pragma("unroll") for (int j = 0; j < 16; ++j) { const v2i_t r_ = __builtin_amdgcn_ds_read_tr8_b64_v2i32((LAS v2i_t*)(rdp + (BUF) * 8192 + j * 512)); \
                Y[j] = __builtin_amdgcn_sdot4(r_[0], X##c0, Y[j], false); Y[j] = __builtin_amdgcn_sdot4(r_[1], X##c1, Y[j], false); } }
#define V_COMP(BUF, X) { asm volatile("s_waitcnt vmcnt(8)" ::: "memory");        \
                if (X##w == 0) V_ACC(y0, BUF, X) else if (X##w == 1) V_ACC(y1, BUF, X) else if (X##w == 2) V_ACC(y2, BUF, X) else V_ACC(y3, BUF, X) }
            LAS float* Tq = (LAS float*)(lds + PE_VST + wave * 16384);
#define PV_EPI(TS, YI, SSQ, AMX) { const int tl_ = wave * 4 + (TS); const size_t t_ = (size_t)tok0 + tl_; const float cs_ = cqs[tl_]; f32x4 yq[4]; const size_t cb_ = t_ * DM + hoff + 4 * le; \
                _Pragma("unroll") for (int j = 0; j < 16; ++j) Tq[j * 64 + lane] = cs_ * (float)YI[j]; \
                _Pragma("unroll") for (int k = 0; k < 4; ++k) { const f32x4 d_ = *(const LAS f32x4*)(Tq + 4 * (lane + 64 * k)); const v2u xw_ = *(const GAS v2u*)(xbr + cb_ + 256 * k); const unsigned xw0_ = xw_.x, xw1_ = xw_.y; const float xa[4] = {bflo(xw0_), bfhi(xw0_), bflo(xw1_), bfhi(xw1_)}; \
                    yq[k] = (f32x4){xa[0] + d_[0], xa[1] + d_[1], xa[2] + d_[2], xa[3] + d_[3]}; SSQ += (yq[k][0] * yq[k][0] + yq[k][1] * yq[k][1]) + (yq[k][2] * yq[k][2] + yq[k][3] * yq[k][3]); \
                    AMX = fmaxf(fmaxf(AMX, fmaxf(fabsf(yq[k][0]), fabsf(yq[k][1]))), fmaxf(fabsf(yq[k][2]), fabsf(yq[k][3]))); } \
                if (!last || half == 0) { _Pragma("unroll") for (int k = 0; k < 4; ++k) { v2u w_; w_.x = pk2(yq[k][0], yq[k][1]); w_.y = pk2(yq[k][2], yq[k][3]); *(GAS v2u*)(xb + cb_ + 256 * k) = w_; } }        \
                if (half == 0) { const float s0_ = wave_sum(SSQ), a0_ = wave_max(AMX); if (lane == 0) { hst[tl_] = s0_; hst[32 + tl_] = a0_; } }        \
                if (half == 1) { const float rs = rsqrtf((wave_sum(SSQ) + hst[tl_]) * (1.0f / DM) + RMS_EPS); \
                    if (!last) { const float am_ = fmaxf(wave_max(AMX), hst[32 + tl_]), inv_ = am_ > 0.f ? 127.0f / am_ : 0.f;        \
                        unsigned char* xq = A.ws + (dry ? WS_Q : WS_XQ); float* rsqo = (float*)(A.ws + (dry ? WS_PS : WS_RSQ)); \
                        _Pragma("unroll") for (int k = 0; k < 4; ++k) { const v2u h0_ = *(const GAS v2u*)(xb + t_ * DM + 4 * le + 256 * k);        \
                            const unsigned hx_ = h0_.x, hy_ = h0_.y; \
                            *(GAS unsigned*)(xq + t_ * DM + 4 * le + 256 * k) = ((unsigned)__float2int_rn(bflo(hx_) * inv_) & 255u) | (((unsigned)__float2int_rn(bfhi(hx_) * inv_) & 255u) << 8) | (((unsigned)__float2int_rn(bflo(hy_) * inv_) & 255u) << 16) | (((unsigned)__float2int_rn(bfhi(hy_) * inv_) & 255u) << 24); \
                            *(GAS unsigned*)(xq + cb_ + 256 * k) = ((unsigned)__float2int_rn(yq[k][0] * inv_) & 255u) | (((unsigned)__float2int_rn(yq[k][1] * inv_) & 255u) << 8) | (((unsigned)__float2int_rn(yq[k][2] * inv_) & 255u) << 16) | (((unsigned)__float2int_rn(yq[k][3] * inv_) & 255u) << 24); } \
                        if (lane == 0) rsqo[t_] = rs * am_ * (1.0f / 127.0f); } \
                    else { _Pragma("unroll") for (int k = 0; k < 4; ++k) { const f32x4 ga = *(const GAS f32x4*)(gf + hoff + 4 * le + 256 * k); \
                            __builtin_nontemporal_store((f32x4){yq[k][0] * rs * ga[0], yq[k][1] * rs * ga[1], yq[k][2] * rs * ga[2], yq[k][3] * rs * ga[3]}, (GAS f32x4*)(XO + cb_ + 256 * k)); } \
                        _Pragma("unroll") for (int k = 0; k < 4; ++k) { const v2u yw_ = *(const GAS v2u*)(xb + t_ * DM + 4 * le + 256 * k); const unsigned yw0_ = yw_.x, yw1_ = yw_.y; const float ya[4] = {bflo(yw0_), bfhi(yw0_), bflo(yw1_), bfhi(yw1_)}; const f32x4 ga = *(const GAS f32x4*)(gf + 4 * le + 256 * k);        \
                            __builtin_nontemporal_store((f32x4){ya[0] * rs * ga[0], ya[1] * rs * ga[1], ya[2] * rs * ga[2], ya[3] * rs * ga[3]}, (GAS f32x4*)(XO + t_ * DM + 4 * le + 256 * k)); } } } }
#pragma unroll 1
            for (int half = 0; half < 2; ++half) {
                const unsigned hoff = (unsigned)half * 1024u, hoffD = hoff + plane16;
                int y0[16], y1[16], y2[16], y3[16];
#pragma unroll
                for (int i = 0; i < 16; ++i) { y0[i] = 0; y1[i] = 0; y2[i] = 0; y3[i] = 0; }
                {
                    int Aw = 0, Ap = 0, Ab1 = 0, Ac0 = 0, Ac1 = 0, Bw = 0, Bp = 0, Bb1 = 0, Bc0 = 0, Bc1 = 0, Nw = 0, Np = 0, Nb1 = 0; unsigned Aev = 0u, Bev = 0u, Nev = 0u, Agoff = 0u, Bgoff = 0u; unsigned long long Amk = ~0ull, Bmk = ~0ull;
                    int uk = -1, ut = 0, up = 0, ub1 = 0;
                    V_ADV(uk, ut, up, ub1); V_ISSUE(ut, up, ub1); V_TAKE(A); V_USE(A); V_LOAD0(A);
                    V_ADV(uk, ut, up, ub1); V_ISSUE(ut, up, ub1);
#pragma unroll 1
                    for (int gi = 0; gi < ngV; gi += 2) {
                        V_TAKE(B); V_USE(B); V_LOAD1(B); V_ADV(uk, ut, up, ub1); V_ISSUE(ut, up, ub1);
                        V_COMP(0, A);
                        V_TAKE(A); V_USE(A); V_LOAD0(A); V_ADV(uk, ut, up, ub1); V_ISSUE(ut, up, ub1);
                        V_COMP(1, B);
                    }
                    asm volatile("s_waitcnt vmcnt(0)" ::: "memory");
                }
                int le = lane; asm volatile("" : "+v"(le));
                { float sq_ = 0.f, ax_ = 0.f; PV_EPI(0, y0, sq_, ax_); }
                { float sq_ = 0.f, ax_ = 0.f; PV_EPI(1, y1, sq_, ax_); }
                { float sq_ = 0.f, ax_ = 0.f; PV_EPI(2, y2, sq_, ax_); }
                { float sq_ = 0.f, ax_ = 0.f; PV_EPI(3, y3, sq_, ax_); }
            }
#undef PV_EPI
#undef V_COMP
#undef V_ACC
#undef V_LOAD0
#undef V_LOAD1
#undef V_D1
#undef V_USE
#undef V_TAKE
#undef V_ISSUE
#undef V_ADV
        }
        __syncthreads();
    }
}

#ifndef PROBE_ITEM
#define PROBE_ITEM -1
#endif
#ifndef PROBE_ITEMS
#define PROBE_ITEMS 0
#endif
#define IREP(k) for (int irep = (PROBE_ITEM == (k) || ((PROBE_ITEMS >> (k)) & 1)) ? 0 : 1; irep < 2; ++irep)
__device__ __forceinline__ void mix_p2(ArgsR A, int l, LAS unsigned char* lds, int G, int tid) {
    const int bx = blockIdx.x; (void)tid;
    IREP(1) for (int it = bx; it < 512; it += G) f_gla_p2(A, l, it, lds, pg8::fresh_tid());
    IREP(2) for (int it = bx; it < 512; it += G) f_ml_p2(A, l, it, lds, pg8::fresh_tid());
    IREP(3) for (int it = bx; it < 512; it += G) f_gdn_p2(A, l, it, lds, pg8::fresh_tid());
    IREP(4) for (int it = bx; it < 1024; it += G) f_lru_p2(A, l, it, lds, pg8::fresh_tid());
}
__device__ __forceinline__ void part_barrier(unsigned* word, unsigned nb, int tid) {
    asm volatile("s_waitcnt vmcnt(0)" ::: "memory");
    __syncthreads();
    if (tid == 0) {
        __builtin_amdgcn_fence(__ATOMIC_RELEASE, "agent");
        asm volatile("s_waitcnt vmcnt(0)" ::: "memory");
        __hip_atomic_fetch_add(word, 1u, __ATOMIC_RELAXED, __HIP_MEMORY_SCOPE_AGENT);
        unsigned sp = 0;
        while (__hip_atomic_load(word, __ATOMIC_RELAXED, __HIP_MEMORY_SCOPE_AGENT) < nb) { __builtin_amdgcn_s_sleep(2); if (++sp > (1u << 22)) break; }
        __builtin_amdgcn_fence(__ATOMIC_ACQUIRE, "agent");
        asm volatile("s_waitcnt vmcnt(0)" ::: "memory");
    }
    __syncthreads();
}
__device__ __forceinline__ void mix_p3(ArgsR A, int l, LAS unsigned char* lds, int G) {
    const int bx = blockIdx.x;
    const bool split = G > 32;
    int first = 0, nb = G;
    if (split) { if (bx < 16) { IREP(8) f_gdn_p3(A, l, bx, lds, pg8::fresh_tid()); return; } first = 16; nb = G - 16; }
    else { for (int it = bx; it < 16; it += G) f_gdn_p3(A, l, it, lds, pg8::fresh_tid()); }
    const int wi = bx - first;
    IREP(9) for (int it = wi; it < 516; it += nb) {
        if (it < 256) f_gla_p3(A, it, pg8::fresh_tid());
        else if (it < 512) f_ml_p3(A, it - 256, pg8::fresh_tid());
        else f_lru_p3(A, it - 512, pg8::fresh_tid());
    }
    part_barrier((unsigned*)(A.ws + WS_CTL) + CW_PBAR + 64 * l, (unsigned)nb, pg8::fresh_tid());
    IREP(5) for (int it = wi; it < 512; it += nb) f_gla_p4(A, l, it, lds, pg8::fresh_tid());
    IREP(6) for (int it = nb - 1 - wi; it < 512; it += nb) f_ml_p4(       A, l, it, lds, pg8::fresh_tid());
    IREP(10) { f_lru_p4(A, (int)((long)wi * NT / nb), (int)((long)(wi + 1) * NT / nb), pg8::fresh_tid()); }
    if (l == 0 && DEPTH > 1) { const int t3 = pg8::fresh_tid(); const int w3 = __builtin_amdgcn_readfirstlane(t3 >> 6); __syncthreads(); for (int l2 = 1; l2 < DEPTH; ++l2) for (int cb = wi; cb < NINP / 32; cb += nb) p0_win_block(A, l2, cb, lds, w3, t3 & 63);
        p0_weights(A, lds, 1, DEPTH, wi * NWAVES + w3, nb * NWAVES, w3, t3 & 63); }
    IREP(7) { const int t2 = pg8::fresh_tid(); const int w2 = __builtin_amdgcn_readfirstlane(t2 >> 6);
        LAS float* red = (LAS float*)(lds); int q0, q1;
        if (nb <= NTHREADS) {
            const int ns_ = (t2 < 516) ? (516 - t2 + nb - 1) / nb : 0, ng_ = (t2 < 512) ? (512 - t2 + nb - 1) / nb : 0, tm_ = nb - 1 - t2, nm_ = (tm_ >= 0 && tm_ < 512) ? (512 - tm_ + nb - 1) / nb : 0;
            const float c_ = (t2 < nb) ? (float)(7 * ns_ + 13 * (ng_ + nm_)) : 0.f;
            const float sa = wave_sum(c_), sb = wave_sum(t2 < wi ? c_ : 0.f);
            __syncthreads();
            if ((t2 & 63) == 0) { red[w2] = sa; red[8 + w2] = sb; }
            __syncthreads();
            float S_ = 0.f, P_ = 0.f;
#pragma unroll
            for (int w = 0; w < 8; ++w) { S_ += red[w]; P_ += red[8 + w]; }
            const long long S = (long long)S_, P0 = (long long)P_, Tw = (long long)(7 * ((516 - wi + nb - 1) / nb) + 13 * (((512 - wi + nb - 1) / nb) + ((512 - (nb - 1 - wi) + nb - 1) / nb)));
            const long long R = 2 * NEXP; const long long a0 = (long long)wi * R / nb + ((long long)wi * S - (long long)nb * P0) * 2589 / (1024LL * nb), a1 = (long long)(wi + 1) * R / nb + ((long long)(wi + 1) * S - (long long)nb * (P0 + Tw)) * 2589 / (1024LL * nb);
            q0 = (int)(a0 < 0 ? 0 : a0 > R ? R : a0); q1 = (wi + 1 == nb) ? (int)R : (int)(a1 < 0 ? 0 : a1 > R ? R : a1);
            if (wi == 0) q0 = 0;
        } else { q0 = (int)((long long)wi * 2 * NEXP / nb); q1 = (int)((long long)(wi + 1) * 2 * NEXP / nb); }
        q0 = __builtin_amdgcn_readfirstlane(q0); q1 = __builtin_amdgcn_readfirstlane(q1);
        tab_convert(A, l, q0 + w2, q1, NWAVES, t2 & 63); }
}

#ifndef PROBE_PHASE
#define PROBE_PHASE -1
#endif
#ifndef MK_PER_PHASE
#define MK_PER_PHASE 0
#endif
#ifdef PROBE_DUP
constexpr int PPL = 7;
#else
constexpr int PPL = 6;
#endif
constexpr int NPHASE = 1 + PPL * DEPTH;
constexpr int CW_BAR = 4096;

__global__ void __launch_bounds__(NTHREADS, 2) mk_fwd(Args args) {
    extern __shared__ __attribute__((aligned(16))) unsigned char lds_raw[];
    LAS unsigned char* lds = (LAS unsigned char*)lds_raw;
    volatile LAS unsigned* MISC = (volatile LAS unsigned*)(lds + MISC_OFF);
    const int G = gridDim.x; const int bx = blockIdx.x;
    unsigned char* ws = args.ws;
    if (threadIdx.x < 64) MISC[threadIdx.x] = 0u;
    __syncthreads();
    XcdBarrier bar; bar.bar = (unsigned*)(ws + WS_CTL) + CW_BAR; bar.x = 0; bar.st = nullptr;
    if (!MK_PER_PHASE) bar = xcd_barrier_post((unsigned*)(ws + WS_CTL) + CW_BAR, MISC + 8);
    const int lo = args.ph_lo, hi = args.ph_hi;
#pragma unroll 1
    for (int ph = lo; ph < hi; ++ph) {
#ifdef PROBE_DUP
        const int l = ph > 0 ? (ph - 1) / PPL : 0, kx = ph > 0 ? (ph - 1) % PPL : -1, k = kx > PROBE_DUP ? kx - 1 : kx; const bool dry = (kx == PROBE_DUP);
#else
        const int l = ph > 0 ? (ph - 1) / PPL : 0, k = ph > 0 ? (ph - 1) % PPL : -1; const bool dry = false;
#endif
        if (k < 0) { const int t0 = pg8::fresh_tid(); const int vcu = (G % 8 == 0) ? (bx % 8) * (G / 8) + bx / 8 : bx; p0_prologue(*kargs(), lds, vcu, G, __builtin_amdgcn_readfirstlane(t0 >> 6), t0 & 63); }
        else if (k == 0) {
            pg8::Gemm g{(const pg8::bf16_t*)(ws + WS_XQ), (const pg8::bf16_t*)(ws + WS_WIN + l * WIN_L), NT, NINP, DM / 2}; pg8::StaticOrder S; S.init(NT, NINP, G, bx);
            pg8::EpiP8 E{(pg8::bf16_t*)(ws + WS_P), (float*)(ws + WS_PS), (const float*)(ws + WS_RSQ), (const float*)(ws + WS_SW) + l * NINP};
            pg8::gemm_phase<pg8::EpiP8, pg8::StaticOrder, true, true>(lds, g, S, E); }
        else if (k == 1) mix_p2(*kargs(), l, lds, G, pg8::fresh_tid());
        else if (k == 2) mix_p3(*kargs(), l, lds, G);
        else if (k == 3) {
            pg8::Gemm g{(const pg8::bf16_t*)(ws + WS_MIX), (const pg8::bf16_t*)(ws + WS_WOUT + l * WSQ_L), NT, DM, DM}; pg8::StaticOrder S; S.init(NT, DM, G, bx);
            pg8::EpiX E{args.in[I_X], args.out, (pg8::bf16_t*)(ws + WS_XB), (float*)(ws + WS_SSP), l > 0};
            pg8::gemm_phase<pg8::EpiX, pg8::StaticOrder, true, true>(lds, g, S, E); }
        else if (k == 4) {
            pg8::Gemm g{(const pg8::bf16_t*)(ws + WS_XB), (const pg8::bf16_t*)(ws + WS_WQ + l * WSQ_L), NT, DM, DM}; pg8::StaticOrder S; S.init(NT, DM, G, bx);
            pg8::EpiQ E{(pg8::bf16_t*)(ws + WS_Q), (const float*)(ws + WS_SSP)};
            pg8::gemm_phase<pg8::EpiQ, pg8::StaticOrder, true, true>(lds, g, S, E); }
        else peer_phase(*kargs(), l, l == DEPTH - 1, dry, lds, G, pg8::fresh_tid());
        if (!MK_PER_PHASE && ph + 1 < hi) xcd_barrier(bar);
    }
}

extern "C" void kernel_launch(void* const* d_in, const int* in_sizes, int n_in, void* d_out, int out_size, void* d_ws, size_t ws_size, hipStream_t stream) {
    static int grid = 0;
    if (grid == 0) {
        if (n_in != N_IN || out_size != NT * DM || ws_size < WS_END) { fprintf(stderr, "kernel_launch: unexpected shapes: n_in %d out %d ws %zu (need %zu)\n", n_in, out_size, ws_size, (size_t)WS_END); grid = -1; return; }
        int dev = 0, cus = 0, per_cu = 0;
        if (hipGetDevice(&dev) != hipSuccess || hipDeviceGetAttribute(&cus, hipDeviceAttributeMultiprocessorCount, dev) != hipSuccess) { grid = -1; return; }
        if (hipFuncSetAttribute((const void*)mk_fwd, hipFuncAttributeMaxDynamicSharedMemorySize, LDS_BYTES) != hipSuccess) { fprintf(stderr, "kernel_launch: hipFuncSetAttribute failed\n"); grid = -1; return; }
        if (hipOccupancyMaxActiveBlocksPerMultiprocessor(&per_cu, (const void*)mk_fwd, NTHREADS, LDS_BYTES) != hipSuccess || per_cu < 1) { fprintf(stderr, "kernel_launch: occupancy query says %d blocks per CU\n", per_cu); (void)hipGetLastError(); grid = -1; return; }
        grid = cus;
    }
    if (grid < 0) return;
    if (hipMemsetAsync((char*)d_ws + WS_CTL, 0, CTL_ZERO_BYTES, stream) != hipSuccess) return;
    Args a{};
    for (int i = 0; i < N_IN; ++i) a.in[i] = (const float*)d_in[i];
    a.out = (float*)d_out; a.ws = (unsigned char*)d_ws;
#if MK_PER_PHASE
    for (int p = 0; p < NPHASE; ++p) { a.ph_lo = p; a.ph_hi = p + 1; a.li = 0; hipLaunchKernelGGL(mk_fwd, dim3(grid), dim3(NTHREADS), LDS_BYTES, stream, a); }
#else
    a.ph_lo = 0; a.ph_hi = NPHASE; a.li = 0;
    hipLaunchKernelGGL(mk_fwd, dim3(grid), dim3(NTHREADS), LDS_BYTES, stream, a);
#endif
}
```
